# Optimizing an MI355X kernel written in HIP

```python
import math
import jax, jax.numpy as jnp
from jax import lax
import numpy as np

D_MODEL = 1024
BATCH = 2
SEQ = 16384
DEPTH = 4

N_MIXERS = 2
N_MLA = (DEPTH + 1) // 2
N_LRU = DEPTH // 2

MLA_HEADS = 8
QK_NOPE_DIM = 128
QK_ROPE_DIM = 64
V_HEAD_DIM = 128
Q_LORA_RANK = 384
KV_LORA_RANK = 256
ROPE_THETA = 10000.0
Q_BLOCK = 128
ATTN_SCALE = 1.0 / math.sqrt(QK_NOPE_DIM + QK_ROPE_DIM)

LRU_WIDTH = D_MODEL
LRU_BLOCKS = 8
LRU_BLOCK_SIZE = LRU_WIDTH // LRU_BLOCKS
CONV_WIDTH = 4
LRU_C = 8.0

FFN_HIDDEN = 4 * D_MODEL
NORM_EPS = 1e-6

kernel_name = "hybrid_mla_rglru_sandwich_trunk"


def _rmsnorm(x, g):
    x32 = x.astype(jnp.float32)
    y = x32 * lax.rsqrt(jnp.mean(x32 * x32, axis=-1, keepdims=True) + NORM_EPS)
    return (y * g.astype(jnp.float32)).astype(x.dtype)


def _rotary(x, cos, sin):
    half = x.shape[-1] // 2
    x1, x2 = x[..., :half], x[..., half:]
    return jnp.concatenate([x1 * cos - x2 * sin, x2 * cos + x1 * sin], axis=-1)


def _mla(h, positions, w_in, q_norm, kv_norm, w_uq, w_ukv, w_o):
    B, S, _ = h.shape
    H = MLA_HEADS
    proj = h @ w_in
    c_q = _rmsnorm(proj[..., :Q_LORA_RANK], q_norm)
    c_kv = _rmsnorm(proj[..., Q_LORA_RANK:Q_LORA_RANK + KV_LORA_RANK], kv_norm)
    k_rope = proj[..., Q_LORA_RANK + KV_LORA_RANK:]
    q = (c_q @ w_uq).reshape(B, S, H, QK_NOPE_DIM + QK_ROPE_DIM)
    q_nope, q_rope = q[..., :QK_NOPE_DIM], q[..., QK_NOPE_DIM:]
    kv = (c_kv @ w_ukv).reshape(B, S, H, QK_NOPE_DIM + V_HEAD_DIM)
    k_nope, v = kv[..., :QK_NOPE_DIM], kv[..., QK_NOPE_DIM:]

    inv_freq = ROPE_THETA ** (-jnp.arange(0, QK_ROPE_DIM, 2, dtype=jnp.float32) / QK_ROPE_DIM)
    ang = positions.astype(jnp.float32)[..., None] * inv_freq
    cos, sin = jnp.cos(ang).astype(h.dtype), jnp.sin(ang).astype(h.dtype)
    q_rope = _rotary(q_rope, cos[:, :, None, :], sin[:, :, None, :])
    k_rope = _rotary(k_rope, cos, sin)

    nqb = S // Q_BLOCK
    qn_b = q_nope.reshape(B, nqb, Q_BLOCK, H, QK_NOPE_DIM).transpose(1, 0, 2, 3, 4)
    qr_b = q_rope.reshape(B, nqb, Q_BLOCK, H, QK_ROPE_DIM).transpose(1, 0, 2, 3, 4)
    kpos = jnp.arange(S)

    def attend(args):
        qn, qr, blk = args
        s = (jnp.einsum('bqhd,bkhd->bhqk', qn, k_nope)
             + jnp.einsum('bqhr,bkr->bhqk', qr, k_rope)).astype(jnp.float32) * ATTN_SCALE
        qpos = blk * Q_BLOCK + jnp.arange(Q_BLOCK)
        s = jnp.where(kpos[None, :] <= qpos[:, None], s, -jnp.inf)
        p = jax.nn.softmax(s, axis=-1).astype(v.dtype)
        return jnp.einsum('bhqk,bkhd->bqhd', p, v)

    o = lax.map(attend, (qn_b, qr_b, jnp.arange(nqb)))
    o = o.transpose(1, 0, 2, 3, 4).reshape(B, S, H * V_HEAD_DIM)
    return o @ w_o


def _rglru_block(h, w_in, conv_w, conv_b, w_a, b_a, w_x, b_x, lam, w_out):
    B, S, _ = h.shape
    proj = h @ w_in
    gate = jax.nn.gelu(proj[..., :LRU_WIDTH], approximate=True)
    rec = proj[..., LRU_WIDTH:]
    xp = jnp.pad(rec, ((0, 0), (CONV_WIDTH - 1, 0), (0, 0)))
    xc = conv_b + sum(xp[:, k:k + S] * conv_w[k] for k in range(CONV_WIDTH))
    xc32 = xc.astype(jnp.float32)
    xb = xc32.reshape(B, S, LRU_BLOCKS, LRU_BLOCK_SIZE)
    r = jax.nn.sigmoid(jnp.einsum('bsnc,ncd->bsnd', xb, w_a.astype(jnp.float32)).reshape(B, S, LRU_WIDTH)
                       + b_a.astype(jnp.float32))
    i = jax.nn.sigmoid(jnp.einsum('bsnc,ncd->bsnd', xb, w_x.astype(jnp.float32)).reshape(B, S, LRU_WIDTH)
                       + b_x.astype(jnp.float32))
    log_a = -LRU_C * r * jax.nn.softplus(-lam.astype(jnp.float32))
    a = jnp.exp(log_a)
    b = jnp.sqrt(-jnp.expm1(2.0 * log_a)) * (i * xc32)

    def combine(left, right):
        a1, b1 = left
        a2, b2 = right
        return a1 * a2, a2 * b1 + b2

    _, hs = lax.associative_scan(combine, (a, b), axis=1)
    return (gate * hs.astype(h.dtype)) @ w_out


def _sq_relu_mlp(h, w_up, w_down):
    u = jax.nn.relu(h @ w_up)
    return (u * u) @ w_down


def setup_inputs(seed: int = 0) -> dict:
    key = jax.random.key(seed)
    ks = jax.random.split(key, 24)
    f32 = jnp.float32

    def nrm(k, shape, fan_in):
        return jax.random.normal(k, shape, f32) * (fan_in ** -0.5)

    def gain(k, shape):
        return 1.0 + 0.05 * jax.random.normal(k, shape, f32)

    x = jax.random.normal(ks[0], (BATCH, SEQ, D_MODEL), f32)
    positions = jnp.broadcast_to(jnp.arange(SEQ, dtype=jnp.int32), (BATCH, SEQ))
    mla_in = Q_LORA_RANK + KV_LORA_RANK + QK_ROPE_DIM
    u = jax.random.uniform(ks[14], (N_LRU, LRU_WIDTH), f32, 0.9, 0.999)
    s0 = u ** (1.0 / LRU_C)
    lam = jnp.log(s0) - jnp.log1p(-s0)
    return {
        "x": x,
        "positions": positions,
        "mix_pre_norm": gain(ks[1], (DEPTH, D_MODEL)),
        "mix_post_norm": gain(ks[2], (DEPTH, D_MODEL)),
        "ffn_pre_norm": gain(ks[3], (DEPTH, D_MODEL)),
        "ffn_post_norm": gain(ks[4], (DEPTH, D_MODEL)),
        "mla_w_in": nrm(ks[5], (N_MLA, D_MODEL, mla_in), D_MODEL),
        "mla_q_norm": gain(ks[6], (N_MLA, Q_LORA_RANK)),
        "mla_kv_norm": gain(ks[7], (N_MLA, KV_LORA_RANK)),
        "mla_w_uq": nrm(ks[8], (N_MLA, Q_LORA_RANK, MLA_HEADS * (QK_NOPE_DIM + QK_ROPE_DIM)), Q_LORA_RANK),
        "mla_w_ukv": nrm(ks[9], (N_MLA, KV_LORA_RANK, MLA_HEADS * (QK_NOPE_DIM + V_HEAD_DIM)), KV_LORA_RANK),
        "mla_w_o": nrm(ks[10], (N_MLA, MLA_HEADS * V_HEAD_DIM, D_MODEL), MLA_HEADS * V_HEAD_DIM),
        "lru_w_in": nrm(ks[11], (N_LRU, D_MODEL, 2 * LRU_WIDTH), D_MODEL),
        "lru_conv_w": nrm(ks[12], (N_LRU, CONV_WIDTH, LRU_WIDTH), CONV_WIDTH),
        "lru_conv_b": 0.01 * jax.random.normal(ks[13], (N_LRU, LRU_WIDTH), f32),
        "lru_w_a": nrm(ks[15], (N_LRU, LRU_BLOCKS, LRU_BLOCK_SIZE, LRU_BLOCK_SIZE), LRU_BLOCK_SIZE),
        "lru_b_a": 0.01 * jax.random.normal(ks[16], (N_LRU, LRU_WIDTH), f32),
        "lru_w_x": nrm(ks[17], (N_LRU, LRU_BLOCKS, LRU_BLOCK_SIZE, LRU_BLOCK_SIZE), LRU_BLOCK_SIZE),
        "lru_b_x": 0.01 * jax.random.normal(ks[18], (N_LRU, LRU_WIDTH), f32),
        "lru_lambda": lam,
        "lru_w_out": nrm(ks[19], (N_LRU, LRU_WIDTH, D_MODEL), LRU_WIDTH),
        "ffn_w_up": nrm(ks[20], (DEPTH, D_MODEL, FFN_HIDDEN), D_MODEL),
        "ffn_w_down": nrm(ks[21], (DEPTH, FFN_HIDDEN, D_MODEL), FFN_HIDDEN),
    }


def reference(x, positions, mix_pre_norm, mix_post_norm, ffn_pre_norm, ffn_post_norm,
              mla_w_in, mla_q_norm, mla_kv_norm, mla_w_uq, mla_w_ukv, mla_w_o,
              lru_w_in, lru_conv_w, lru_conv_b, lru_w_a, lru_b_a, lru_w_x, lru_b_x,
              lru_lambda, lru_w_out, ffn_w_up, ffn_w_down):
    for layer in range(DEPTH):
        j = layer // N_MIXERS
        hn = _rmsnorm(x, mix_pre_norm[layer])
        if layer % N_MIXERS == 0:
            y = _mla(hn, positions, mla_w_in[j], mla_q_norm[j], mla_kv_norm[j],
                     mla_w_uq[j], mla_w_ukv[j], mla_w_o[j])
        else:
            y = _rglru_block(hn, lru_w_in[j], lru_conv_w[j], lru_conv_b[j], lru_w_a[j], lru_b_a[j],
                             lru_w_x[j], lru_b_x[j], lru_lambda[j], lru_w_out[j])
        x = x + _rmsnorm(y, mix_post_norm[layer])
        hn = _rmsnorm(x, ffn_pre_norm[layer])
        y = _sq_relu_mlp(hn, ffn_w_up[layer], ffn_w_down[layer])
        x = x + _rmsnorm(y, ffn_post_norm[layer])
    return x
```

```cpp
#include <hip/hip_runtime.h>
#include <hip/hip_bf16.h>
#include <hip/hip_cooperative_groups.h>
#include <cstdio>
#include <cstdint>
namespace cg = cooperative_groups;

__device__ __forceinline__ float xor1f(float v)  { return __int_as_float(__builtin_amdgcn_mov_dpp(__float_as_int(v), 0xB1, 0xF, 0xF, false)); }
__device__ __forceinline__ float xor2f(float v)  { return __int_as_float(__builtin_amdgcn_mov_dpp(__float_as_int(v), 0x4E, 0xF, 0xF, false)); }
__device__ __forceinline__ float xor4f(float v)  { return __int_as_float(__builtin_amdgcn_ds_swizzle(__float_as_int(v), 0x101F)); }
__device__ __forceinline__ float xor8f(float v)  { return __int_as_float(__builtin_amdgcn_ds_swizzle(__float_as_int(v), 0x201F)); }
__device__ __forceinline__ float xor16f(float v) { return __int_as_float(__builtin_amdgcn_ds_swizzle(__float_as_int(v), 0x401F)); }
__device__ __forceinline__ float sum32f(float v) { auto rr = __builtin_amdgcn_permlane32_swap(__float_as_uint(v), __float_as_uint(v), false, false); return __uint_as_float(rr[0]) + __uint_as_float(rr[1]); }
__device__ __forceinline__ int lane_id_fresh() { int l; asm volatile("v_mbcnt_lo_u32_b32 %0, -1, 0\n\tv_mbcnt_hi_u32_b32 %0, -1, %0" : "=v"(l)); return l; }
namespace pg8 {
#define PG8_LAS __attribute__((address_space(3)))
typedef unsigned short bf16_t;
typedef short bf16x8 __attribute__((ext_vector_type(8)));
typedef float f32x4 __attribute__((ext_vector_type(4)));
typedef unsigned u32x4 __attribute__((ext_vector_type(4)));
constexpr int BM = 256, BK = 64, HALF = 128, HTB = HALF * BK * 2  , STAGE_BYTES = 8 * HTB, NXCD = 8, WGM = 8;

__host__ __device__ __forceinline__ int lds_byte(int r, int c) { const int st = (r >> 4) * 2 + (c >> 5), rr = r & 15, cc = c & 31, ob = rr * 64 + cc * 2; return st * 1024 + (ob ^ (((ob >> 9) & 1) << 5)); }
__host__ __device__ __forceinline__ void stage_rc(int b, int& R, int& C) { const int st = b / 1024, sb = b % 1024, swz = sb ^ (((sb >> 9) & 1) << 5); R = (st >> 1) * 16 + swz / 64; C = (st & 1) * 32 + (swz % 64) / 2; }
__host__ __device__ __forceinline__ int perm32(int rho) { const int n = rho >> 4, i = rho & 15; return 8 * (i >> 2) + 4 * n + (i & 3); }

struct Unit { int pm, pn; };
struct Gemm { const bf16_t* A; const bf16_t* Bt; int M, N, K; int lda, ldb; int apn; };

struct StaticOrder {
    int nM, nN, nwg, G, c;
    __host__ __device__ void init(int M, int N, int G_, int c_) { nM = M / BM; nN = N / BM; nwg = nM * nN; G = G_; c = c_; }
    __host__ __device__ bool next(int i, Unit& u) const {
        const long L = (long)i * G + c; if (L >= nwg) return false;
        int wgid = (int)L; { const int q = nwg / NXCD, r = nwg % NXCD, xcd = wgid % NXCD, off = wgid / NXCD; wgid = (xcd < r ? xcd * (q + 1) : r * (q + 1) + (xcd - r) * q) + off; }
        const int nig = WGM * nN, gid = wgid / nig, fm = gid * WGM, gsz = (nM - fm) < WGM ? (nM - fm) : WGM;
        u.pm = fm + ((wgid % nig) % gsz); u.pn = (wgid % nig) / gsz; return true;
    }
    __device__ __forceinline__ void a_ready(const Unit&) const {}
    __device__ __forceinline__ void done(const Unit&) const {}
};

__device__ __forceinline__ unsigned cvt_pk_bf16(float lo, float hi) { unsigned r; asm volatile("v_cvt_pk_bf16_f32 %0, %1, %2" : "=v"(r) : "v"(lo), "v"(hi)); return r; }
__device__ __forceinline__ float gelu_tanh(float x) {
    const float z = 0.7978845608028654f * (x + 0.044715f * x * x * x);
    const float e = __expf(2.0f * z);
    const float th = 1.0f - 2.0f / (1.0f + e);
    return 0.5f * x * (1.0f + th);
}
struct EpiB {
    static constexpr bool PERM = true, AFTER_DRAIN = false, FUSED = false;
    bf16_t* O; int ldc; int split_cols; size_t split_stride; int mode;
    __device__ __forceinline__ void operator()(const f32x4 (&acc)[2][2][4][2], const Unit& u, int wr, int wc, int fr, int fq) const {
        const int row0 = u.pm * BM + wr * 64 + fr; int colt = u.pn * BM; bf16_t* base = O; int t = 0;
        if (split_cols) { t = colt / split_cols; base += (size_t)t * split_stride; colt -= t * split_cols; }
        const int act = (mode == 1) ? 1 : ((mode == 2 && t == 0) ? 2 : 0);
        const int col0 = colt + wc * 32 + 8 * fq;
#pragma unroll
        for (int ai = 0; ai < 2; ++ai)
#pragma unroll
            for (int m = 0; m < 4; ++m) { bf16_t* rowp = base + (size_t)(row0 + ai * HALF + m * 16) * ldc + col0;
#pragma unroll
                for (int bj = 0; bj < 2; ++bj) { f32x4 v0 = acc[ai][bj][m][0], v1 = acc[ai][bj][m][1];
                    if (act == 1) {
#pragma unroll
                        for (int e = 0; e < 4; ++e) { const float a = fmaxf(v0[e], 0.f), b = fmaxf(v1[e], 0.f); v0[e] = a * a; v1[e] = b * b; } }
                    else if (act == 2) {
#pragma unroll
                        for (int e = 0; e < 4; ++e) { v0[e] = gelu_tanh(v0[e]); v1[e] = gelu_tanh(v1[e]); } }
                    u32x4 w; w.x = cvt_pk_bf16(v0[0], v0[1]); w.y = cvt_pk_bf16(v0[2], v0[3]); w.z = cvt_pk_bf16(v1[0], v1[1]); w.w = cvt_pk_bf16(v1[2], v1[3]);
                    *(u32x4*)(rowp + bj * HALF) = w; } }
    }
};
__device__ __forceinline__ float bf2f(unsigned short h) { return __uint_as_float(((unsigned)h) << 16); }
__device__ __forceinline__ float sigmoidf_(float x) { return 1.0f / (1.0f + __expf(-x)); }
struct EpiGate {
    static constexpr bool PERM = false, AFTER_DRAIN = false, FUSED = false;
    const bf16_t* xc; float* Aout; float* Bout; const float* b_a; const float* b_x; const float* lam;
    __device__ __forceinline__ void operator()(const f32x4 (&acc)[2][2][4][2], const Unit& u, int wr, int wc, int fr, int fq) const {
#pragma unroll
        for (int n = 0; n < 2; ++n) {
            const int ch0 = 128 * u.pn + 32 * wc + 16 * n + 4 * fq;
            const f32x4 ba = *(const f32x4*)(b_a + ch0), bx = *(const f32x4*)(b_x + ch0), lm = *(const f32x4*)(lam + ch0);
            f32x4 sp;
#pragma unroll
            for (int e = 0; e < 4; ++e) sp[e] = -8.0f * log1pf(__expf(-lm[e]));
#pragma unroll
            for (int ai = 0; ai < 2; ++ai)
#pragma unroll
                for (int m = 0; m < 4; ++m) {
                    const size_t off = (size_t)(u.pm * BM + ai * HALF + wr * 64 + m * 16 + fr) * 1024 + ch0;
                    const uint2 xr = *(const uint2*)(xc + off);
                    float xv[4] = { __uint_as_float(xr.x << 16), __uint_as_float(xr.x & 0xffff0000u), __uint_as_float(xr.y << 16), __uint_as_float(xr.y & 0xffff0000u) };
                    f32x4 av, bv;
#pragma unroll
                    for (int e = 0; e < 4; ++e) {
                        const float r = sigmoidf_(acc[ai][0][m][n][e] + ba[e]);
                        const float ig = sigmoidf_(acc[ai][1][m][n][e] + bx[e]);
                        const float la = sp[e] * r;
                        av[e] = __expf(la);
                        bv[e] = sqrtf(fmaxf(-expm1f(2.0f * la), 0.f)) * (ig * xv[e]);
                    }
                    *(f32x4*)(Aout + off) = av; *(f32x4*)(Bout + off) = bv;
                }
        }
    }
};

struct RowStats {
    float* xbuf;
    unsigned* cnt;
    unsigned target;
    __device__ __forceinline__ void run(const f32x4 (&v)[2][2][4][2], const Unit& u, int wr, int wc, int fr, int fq, PG8_LAS unsigned char* xl, int wid, int lane) const {
        PG8_LAS float* P = (PG8_LAS float*)xl;
        PG8_LAS float* S = (PG8_LAS float*)(xl + 4096);
#pragma unroll
        for (int ai = 0; ai < 2; ++ai)
#pragma unroll
            for (int m = 0; m < 4; ++m) {
                float s = 0.f;
#pragma unroll
                for (int bj = 0; bj < 2; ++bj)
#pragma unroll
                    for (int n = 0; n < 2; ++n) { const f32x4 x = v[ai][bj][m][n]; s += (x[0] * x[0] + x[1] * x[1]) + (x[2] * x[2] + x[3] * x[3]); }
                s += xor16f(s); s = sum32f(s);
                if (fq == 0) P[(ai * HALF + wr * 64 + m * 16 + fr) * 4 + wc] = s;
            }
        asm volatile("s_waitcnt lgkmcnt(0)" ::: "memory"); __builtin_amdgcn_s_barrier(); asm volatile("" ::: "memory");
        const int row = wid * 32 + (lane & 31);
        if (lane < 32) { const float t = (P[row * 4 + 0] + P[row * 4 + 1]) + (P[row * 4 + 2] + P[row * 4 + 3]);
            __hip_atomic_store(xbuf + (size_t)(u.pm * BM + row) * 4 + u.pn, t, __ATOMIC_RELAXED, __HIP_MEMORY_SCOPE_AGENT); }
        asm volatile("s_waitcnt vmcnt(0)" ::: "memory");
        if (lane == 0) __hip_atomic_fetch_add(cnt + 64 * u.pm, 1u, __ATOMIC_RELAXED, __HIP_MEMORY_SCOPE_AGENT);
        if (wid == 0) { unsigned sp = 0;
            while ((unsigned)__builtin_amdgcn_readfirstlane(__hip_atomic_load(cnt + 64 * u.pm, __ATOMIC_RELAXED, __HIP_MEMORY_SCOPE_AGENT)) < target) { __builtin_amdgcn_s_sleep(2); if (++sp > (1u << 18)) break; }
            __builtin_amdgcn_fence(__ATOMIC_ACQUIRE, "agent"); }
        asm volatile("s_waitcnt vmcnt(0) lgkmcnt(0)" ::: "memory"); __builtin_amdgcn_s_barrier(); asm volatile("" ::: "memory");
        if (lane < 32) { float* slot = xbuf + (size_t)(u.pm * BM + row) * 4; float t = 0.f;
#pragma unroll
            for (int k = 0; k < 4; ++k) t += __hip_atomic_load(slot + k, __ATOMIC_RELAXED, __HIP_MEMORY_SCOPE_AGENT);
            S[row] = t; }
        asm volatile("s_waitcnt lgkmcnt(0)" ::: "memory"); __builtin_amdgcn_s_barrier(); asm volatile("" ::: "memory");
    }
};
struct EpiNormRes {
    static constexpr bool PERM = false, AFTER_DRAIN = false, FUSED = true;
    float* x; bf16_t* hn; const float* gpost; const float* gpre; RowStats st1, st2; PG8_LAS unsigned char* xl;
    __device__ __forceinline__ void fused(f32x4 (&acc)[2][2][4][2], const Unit& u, int wr, int wc, int fr, int fq, int wid, int lane) const {
        typedef unsigned u32x2v __attribute__((ext_vector_type(2)));
        const PG8_LAS float* S = (const PG8_LAS float*)(xl + 4096);
        const int col0 = u.pn * BM + wc * 32 + 4 * fq;
        st1.run(acc, u, wr, wc, fr, fq, xl, wid, lane);
#pragma unroll
        for (int ai = 0; ai < 2; ++ai)
#pragma unroll
            for (int m = 0; m < 4; ++m) { const int r = ai * HALF + wr * 64 + m * 16 + fr; const float rstd = rsqrtf(S[r] * (1.0f / 1024.0f) + 1e-6f); const size_t off = (size_t)(u.pm * BM + r) * 1024 + col0;
#pragma unroll
                for (int bj = 0; bj < 2; ++bj)
#pragma unroll
                    for (int n = 0; n < 2; ++n) { const f32x4 xs = *(const f32x4*)(x + off + bj * HALF + n * 16); const f32x4 gv = *(const f32x4*)(gpost + col0 + bj * HALF + n * 16);
                        acc[ai][bj][m][n] = xs + (acc[ai][bj][m][n] * rstd) * gv; }
                asm volatile("" : "+v"(acc[ai][0][m][0]), "+v"(acc[ai][0][m][1]), "+v"(acc[ai][1][m][0]), "+v"(acc[ai][1][m][1]));
                if (m & 1) asm volatile("" ::: "memory"); }
        if (gpre) {
            st2.run(acc, u, wr, wc, fr, fq, xl, wid, lane);
#pragma unroll
            for (int ai = 0; ai < 2; ++ai)
#pragma unroll
                for (int m = 0; m < 4; ++m) { const int r = ai * HALF + wr * 64 + m * 16 + fr; const float rstd = rsqrtf(S[r] * (1.0f / 1024.0f) + 1e-6f); const size_t off = (size_t)(u.pm * BM + r) * 1024 + col0;
#pragma unroll
                    for (int bj = 0; bj < 2; ++bj)
#pragma unroll
                        for (int n = 0; n < 2; ++n) { const f32x4 x1 = acc[ai][bj][m][n]; *(f32x4*)(x + off + bj * HALF + n * 16) = x1;
                            const f32x4 gv = *(const f32x4*)(gpre + col0 + bj * HALF + n * 16); const f32x4 o = (x1 * rstd) * gv;
                            u32x2v w; w.x = cvt_pk_bf16(o[0], o[1]); w.y = cvt_pk_bf16(o[2], o[3]); *(u32x2v*)(hn + off + bj * HALF + n * 16) = w; }
                    asm volatile("" ::: "memory"); }
        } else {
#pragma unroll
            for (int ai = 0; ai < 2; ++ai)
#pragma unroll
                for (int m = 0; m < 4; ++m) { const int r = ai * HALF + wr * 64 + m * 16 + fr; const size_t off = (size_t)(u.pm * BM + r) * 1024 + col0;
#pragma unroll
                    for (int bj = 0; bj < 2; ++bj)
#pragma unroll
                        for (int n = 0; n < 2; ++n) *(f32x4*)(x + off + bj * HALF + n * 16) = acc[ai][bj][m][n]; }
        }
    }
};

template <class Epi, class Sched, bool ALIGN_EPI>
__device__ __forceinline__ void gemm_phase(PG8_LAS unsigned char* lds, const Gemm g, const Sched& S, const Epi& E, int tid0) {
    int tid_ = tid0; asm volatile("" : "+v"(tid_));
    const int tid = tid_, wid = __builtin_amdgcn_readfirstlane(tid >> 6), lane = tid & 63, wr = wid >> 2, wc = wid & 3, fr = lane & 15, fq = lane >> 4;
    const int K = g.K, nt = K / BK;
    unsigned voffA[2], voffB[2];
#pragma unroll
    for (int i = 0; i < 2; ++i) { int R, C; stage_rc(tid * 16 + i * 8192, R, C); const int Rb = Epi::PERM ? ((R & ~31) + perm32(R & 31)) : R;
        voffA[i] = (unsigned)(R * g.lda + C) * 2u; voffB[i] = (unsigned)(Rb * g.ldb + C) * 2u; }
    const size_t kstep = (size_t)(BK * 2);
    const size_t hstepA = (size_t)HALF * g.lda * 2, hstepB = (size_t)HALF * g.ldb * 2;
    const size_t tstepA = 2 * hstepA, tstepB = 2 * hstepB;
    const unsigned ldsw = (unsigned)wid * 1024u;
    const int aoff = lds_byte(wr * 64 + fr, fq * 8), boff = lds_byte(wc * 32 + fr, fq * 8);
#define PG8_SA(b, h) (((b) * 2 + (h)) * HTB)
#define PG8_SB(b, h) ((4 + (b) * 2 + (h)) * HTB)
#define PG8_STAGE(bufoff, gbase, voff) do { _Pragma("unroll") for (int _i = 0; _i < 2; ++_i) \
        __builtin_amdgcn_global_load_lds((const unsigned*)((const char*)(gbase) + (voff)[_i]), (PG8_LAS unsigned*)(lds + (bufoff) + ldsw + _i * 8192), 16, 0, 0); } while (0)
#define PG8_LDA(dst, b, h) do { _Pragma("unroll") for (int m = 0; m < 4; ++m) _Pragma("unroll") for (int k = 0; k < 2; ++k) dst[m][k] = *(const PG8_LAS bf16x8*)(lds + PG8_SA(b, h) + aoff + m * 2048 + k * 1024); } while (0)
#define PG8_LDB(dst, b, h) do { _Pragma("unroll") for (int n = 0; n < 2; ++n) _Pragma("unroll") for (int k = 0; k < 2; ++k) dst[n][k] = *(const PG8_LAS bf16x8*)(lds + PG8_SB(b, h) + boff + n * 2048 + k * 1024); } while (0)
#define PG8_MMA(ai, bj, At, Bt) do { __builtin_amdgcn_s_setprio(1); _Pragma("unroll") for (int m = 0; m < 4; ++m) _Pragma("unroll") for (int n = 0; n < 2; ++n) _Pragma("unroll") for (int k = 0; k < 2; ++k) \
        acc[ai][bj][m][n] = __builtin_amdgcn_mfma_f32_16x16x32_bf16(Bt[n][k], At[m][k], acc[ai][bj][m][n], 0, 0, 0); __builtin_amdgcn_s_setprio(0); } while (0)
#define PG8_WAIT_V(n) asm volatile("s_waitcnt vmcnt(" #n ")" ::: "memory")
#define PG8_WAIT_L(n) asm volatile("s_waitcnt lgkmcnt(" #n ")" ::: "memory")
#define PG8_BAR __builtin_amdgcn_s_barrier()
#define PG8_SCHED __builtin_amdgcn_sched_barrier(0)
    Unit cur, nxt; int ui = 0;
    if (!S.next(0, cur)) return;
    f32x4 acc[2][2][4][2];
#pragma unroll
    for (int a = 0; a < 2; ++a)
#pragma unroll
        for (int b = 0; b < 2; ++b)
#pragma unroll
            for (int m = 0; m < 4; ++m)
#pragma unroll
                for (int n = 0; n < 2; ++n) acc[a][b][m][n] = (f32x4){0.f, 0.f, 0.f, 0.f};
    bf16x8 At[4][2], B0[2][2], B1[2][2];
    const char* cA = (const char*)g.A + (size_t)cur.pm * tstepA + (size_t)(cur.pn >> 1) * (size_t)g.apn; const char* cB = (const char*)g.Bt + (size_t)cur.pn * tstepB;
    S.a_ready(cur);
    PG8_STAGE(PG8_SB(0, 0), cB, voffB); PG8_STAGE(PG8_SB(0, 1), cB + hstepB, voffB); PG8_STAGE(PG8_SA(0, 0), cA, voffA); PG8_STAGE(PG8_SA(0, 1), cA + hstepA, voffA);
    if (wr == 1) PG8_BAR;
    PG8_WAIT_V(2); PG8_BAR;
    PG8_STAGE(PG8_SB(1, 0), cB + kstep, voffB); PG8_STAGE(PG8_SA(1, 0), cA + kstep, voffA); PG8_STAGE(PG8_SB(1, 1), cB + hstepB + kstep, voffB);
    PG8_WAIT_V(6); PG8_BAR;
    for (;;) {
        const bool has_next = S.next(ui + 1, nxt);
        const char* nA = has_next ? (const char*)g.A + (size_t)nxt.pm * tstepA + (size_t)(nxt.pn >> 1) * (size_t)g.apn : cA; const char* nB = has_next ? (const char*)g.Bt + (size_t)nxt.pn * tstepB : cB;
        for (int t = 0; t < nt; t += 2) {
            const bool last = (t == nt - 2);
            const char* a1 = cA + (size_t)(t + 1) * kstep;
            const char* a2 = last ? nA : cA + (size_t)(t + 2) * kstep; const char* b2 = last ? nB : cB + (size_t)(t + 2) * kstep;
            const char* a3 = a2 + kstep; const char* b3 = b2 + kstep;
            if (last && has_next) S.a_ready(nxt);
            PG8_LDB(B0, 0, 0); PG8_LDB(B1, 0, 1); PG8_SCHED; PG8_LDA(At, 0, 0); PG8_STAGE(PG8_SA(1, 1), a1 + hstepA, voffA);
            PG8_WAIT_V(8); PG8_WAIT_L(0); PG8_BAR; PG8_MMA(0, 0, At, B0); PG8_MMA(0, 1, At, B1); PG8_BAR; PG8_SCHED;
            PG8_LDA(At, 0, 1); PG8_STAGE(PG8_SB(0, 0), b2, voffB); PG8_STAGE(PG8_SB(0, 1), b2 + hstepB, voffB); PG8_STAGE(PG8_SA(0, 0), a2, voffA);
            PG8_WAIT_V(8); PG8_WAIT_L(0); PG8_BAR; PG8_MMA(1, 0, At, B0); PG8_MMA(1, 1, At, B1); PG8_BAR; PG8_SCHED;
            PG8_LDB(B0, 1, 0); PG8_LDB(B1, 1, 1); PG8_SCHED; PG8_LDA(At, 1, 0); PG8_STAGE(PG8_SA(0, 1), a2 + hstepA, voffA);
            PG8_WAIT_V(8); PG8_WAIT_L(0); PG8_BAR; PG8_MMA(0, 0, At, B0); PG8_MMA(0, 1, At, B1); PG8_BAR; PG8_SCHED;
            PG8_LDA(At, 1, 1); PG8_STAGE(PG8_SB(1, 0), b3, voffB); PG8_STAGE(PG8_SB(1, 1), b3 + hstepB, voffB); PG8_STAGE(PG8_SA(1, 0), a3, voffA);
            PG8_WAIT_V(8); PG8_WAIT_L(0); PG8_BAR; PG8_MMA(1, 0, At, B0); PG8_MMA(1, 1, At, B1); PG8_BAR; PG8_SCHED;
        }
        if constexpr (ALIGN_EPI) { if (wr == 0) PG8_BAR; }
        if constexpr (Epi::FUSED) E.fused(acc, cur, wr, wc, fr, fq, wid, lane); else E(acc, cur, wr, wc, fr, fq);
        S.done(cur);
        if (!has_next) break;
#pragma unroll
        for (int a = 0; a < 2; ++a)
#pragma unroll
            for (int b = 0; b < 2; ++b)
#pragma unroll
                for (int m = 0; m < 4; ++m)
#pragma unroll
                    for (int n = 0; n < 2; ++n) acc[a][b][m][n] = (f32x4){0.f, 0.f, 0.f, 0.f};
        cur = nxt; cA = nA; cB = nB; ++ui;
        if constexpr (ALIGN_EPI) { if (wr == 1) PG8_BAR; }
    }
    PG8_WAIT_V(0);
    if constexpr (!ALIGN_EPI) { if (wr == 0) PG8_BAR; }
    PG8_BAR;
#undef PG8_SA
#undef PG8_SB
#undef PG8_STAGE
#undef PG8_LDA
#undef PG8_LDB
#undef PG8_MMA
#undef PG8_WAIT_V
#undef PG8_WAIT_L
#undef PG8_BAR
#undef PG8_SCHED
}
}
namespace att {
typedef unsigned short u16;
typedef short bf16x8 __attribute__((ext_vector_type(8)));
typedef short s16x4 __attribute__((ext_vector_type(4)));
typedef float f32x16 __attribute__((ext_vector_type(16)));
typedef float f32x4 __attribute__((ext_vector_type(4)));
typedef unsigned u32x4 __attribute__((ext_vector_type(4)));
constexpr int SEQ = 16384, NW = 8, QBLK = 32, KVBLK = 64, QB = NW * QBLK;
constexpr int LDQ = 1536, LDK = 2048, LDKR = 64, LDO = 1024;
#ifndef ATT_NQREG
#define ATT_NQREG 4
#endif
constexpr int NQREG = ATT_NQREG, NQREG_L = 8 - NQREG;
constexpr int SHM_V = KVBLK * 128 * 2, SHM_K = KVBLK * 128 * 2, SHM_KR = KVBLK * 64 * 2;
constexpr int OFF_V = 0, OFF_K = 2 * SHM_V, OFF_KR = OFF_K + 2 * SHM_K, OFF_WS = OFF_KR + 2 * SHM_KR, OFF_QR = OFF_WS + NW * 64 * 4, QR_WAVE = (NQREG_L + 4) * 1024, LDS_BYTES = OFF_QR + NW * QR_WAVE;
constexpr float SCALE = 0.07216878364870322f;
constexpr float THR = 8.f;

#define KSWZ(row, colB) ((row) * 256 + ((colB) ^ (((row) & 7) << 4)))
#define KRSWZ(row, colB) ((row) * 128 + ((colB) ^ (((row) & 7) << 4)))
#define SBAR() __builtin_amdgcn_sched_barrier(0)
__device__ __forceinline__ int v_st(int k, int c) { const int kk = (k & ~0xC) | ((k & 4) << 1) | ((k & 8) >> 1); return ((kk >> 3) * 4 + (c >> 5)) * 512 + ((kk & 7) * 32 + (c & 31)) * 2; }
__device__ __forceinline__ int v_rd_base(int lane) { return ((lane & 3) << 3) | (((lane >> 2) & 3) << 6) | (((lane >> 4) & 1) << 5) | (((lane >> 5) & 1) << 8); }
constexpr int v_rd_off(int d0, int ks, int half) { return d0 * 512 + ks * 4096 + half * 2048; }
__device__ __forceinline__ int crow(int r, int hi) { return (r & 3) + 8 * (r >> 2) + 4 * hi; }
__device__ __forceinline__ unsigned cvtpk(float lo, float hi) { unsigned r; asm volatile("v_cvt_pk_bf16_f32 %0, %1, %2" : "=v"(r) : "v"(lo), "v"(hi)); return r; }
__device__ __forceinline__ bf16x8 load8(const u16* p) { return *reinterpret_cast<const bf16x8*>(p); }
__device__ __forceinline__ void mask_tile(f32x16& p0, f32x16& p1, int dq, unsigned W) {
    const float NEG = -__builtin_inff();
#pragma unroll
    for (int r = 0; r < 16; ++r) {
        const int c = (r & 3) + 8 * (r >> 2);
        if ((unsigned)(dq - c) >= W) p0[r] = NEG;
        if ((unsigned)(dq - c - 32) >= W) p1[r] = NEG;
    }
}
__device__ __forceinline__ void partialSM(f32x16& p0, f32x16& p1, float& m_reg, float& mn, float& alpha) {
    float pmax = p0[0]; for (int r = 1; r < 16; ++r) pmax = fmaxf(pmax, p0[r]); for (int r = 0; r < 16; ++r) pmax = fmaxf(pmax, p1[r]);
    { auto rr = __builtin_amdgcn_permlane32_swap(__float_as_uint(pmax), __float_as_uint(pmax), false, false);
      pmax = fmaxf(__uint_as_float(rr[0]), __uint_as_float(rr[1])); }
    constexpr float C2 = 1.4426950408889634f * SCALE;
    if (__builtin_expect(__all((pmax - m_reg) * SCALE <= THR), 1)) { mn = m_reg; alpha = 1.f; }
    else { mn = fmaxf(m_reg, pmax); alpha = __builtin_amdgcn_exp2f((m_reg - mn) * C2); m_reg = mn; }
    const float mnL = -mn * C2;
    for (int r = 0; r < 16; ++r) p0[r] = fmaf(p0[r], C2, mnL); for (int r = 0; r < 16; ++r) p1[r] = fmaf(p1[r], C2, mnL);
    for (int r = 0; r < 16; ++r) p0[r] = __builtin_amdgcn_exp2f(p0[r]);
}
__device__ __forceinline__ void finishSM(f32x16& p0, f32x16& p1, float alpha, float& l_reg, bf16x8& pa0, bf16x8& pa1, bf16x8& pa2, bf16x8& pa3) {
    for (int r = 0; r < 16; ++r) p1[r] = __builtin_amdgcn_exp2f(p1[r]);
    float ps = 0; for (int r = 0; r < 16; ++r) ps += p0[r]; for (int r = 0; r < 16; ++r) ps += p1[r];
    { auto rr = __builtin_amdgcn_permlane32_swap(__float_as_uint(ps), __float_as_uint(ps), false, false);
      ps = __uint_as_float(rr[0]) + __uint_as_float(rr[1]); }
    l_reg = l_reg * alpha + ps;
#define PK4(P, B_, OUT) do { unsigned a0 = cvtpk(P[B_+0], P[B_+1]), a1 = cvtpk(P[B_+2], P[B_+3]);                          \
        unsigned b0 = cvtpk(P[B_+4], P[B_+5]), b1 = cvtpk(P[B_+6], P[B_+7]);                                             \
        auto r0 = __builtin_amdgcn_permlane32_swap(a0, b0, false, false); auto r1 = __builtin_amdgcn_permlane32_swap(a1, b1, false, false); \
        u32x4 w = {r0[0], r1[0], r0[1], r1[1]}; OUT = *reinterpret_cast<bf16x8*>(&w); } while (0)
    PK4(p0, 0, pa0); PK4(p0, 8, pa1); PK4(p1, 0, pa2); PK4(p1, 8, pa3);
#undef PK4
}
template <int KB>
__device__ __forceinline__ void qkt(f32x16& p0, f32x16& p1, const char* K_lds, const char* KR_lds, const bf16x8* qrl, int r32, int hi, const bf16x8* qr) {
    p0 = f32x16{}; p1 = f32x16{};
    const char* kb[4];
#pragma unroll
    for (int dd = 0; dd < 4; ++dd) kb[dd] = K_lds + KB * SHM_K + KSWZ(r32, (dd * 16 + hi * 8) * 2);
#pragma unroll
    for (int d0 = 0; d0 < 8; ++d0) { const char* a = kb[d0 & 3] + (d0 >> 2) * 128;
        bf16x8 b0 = *reinterpret_cast<const bf16x8*>(a);
        bf16x8 b1 = *reinterpret_cast<const bf16x8*>(a + 32 * 256);
        bf16x8 q; if (d0 < NQREG) q = qr[d0]; else q = qrl[(d0 - NQREG) * 64];
        p0 = __builtin_amdgcn_mfma_f32_32x32x16_bf16(b0, q, p0, 0, 0, 0);
        p1 = __builtin_amdgcn_mfma_f32_32x32x16_bf16(b1, q, p1, 0, 0, 0); }
#pragma unroll
    for (int d = 0; d < 4; ++d) { const char* a = KR_lds + KB * SHM_KR + KRSWZ(r32, (d * 16 + hi * 8) * 2);
        bf16x8 b0 = *reinterpret_cast<const bf16x8*>(a);
        bf16x8 b1 = *reinterpret_cast<const bf16x8*>(a + 32 * 128);
        bf16x8 q = qrl[(NQREG_L + d) * 64];
        p0 = __builtin_amdgcn_mfma_f32_32x32x16_bf16(b0, q, p0, 0, 0, 0);
        p1 = __builtin_amdgcn_mfma_f32_32x32x16_bf16(b1, q, p1, 0, 0, 0); }
}
template <int VB>
__device__ __forceinline__ void pv_tile(f32x16* o, int vb0, bf16x8 pa0, bf16x8 pa1, bf16x8 pa2, bf16x8 pa3) {
#define TRRD(dst, off) asm volatile("ds_read_b64_tr_b16 %0, %1 offset:%2" : "=&v"(dst) : "v"(vb0), "i"(off) : "memory")
#define PV_D0(d0) do { s16x4 l0, l1, l2, l3, h0, h1, h2, h3; constexpr int b_ = OFF_V + VB * SHM_V + v_rd_off(d0, 0, 0); \
        TRRD(l0, b_); TRRD(h0, b_ + 2048); TRRD(l1, b_ + 4096); TRRD(h1, b_ + 6144); TRRD(l2, b_ + 8192); TRRD(h2, b_ + 10240); TRRD(l3, b_ + 12288); TRRD(h3, b_ + 14336); \
        asm volatile("s_waitcnt lgkmcnt(0)" ::: "memory"); SBAR();   \
        o[d0] = __builtin_amdgcn_mfma_f32_32x32x16_bf16(pa0, (bf16x8){l0[0], l0[1], l0[2], l0[3], h0[0], h0[1], h0[2], h0[3]}, o[d0], 0, 0, 0);   \
        o[d0] = __builtin_amdgcn_mfma_f32_32x32x16_bf16(pa1, (bf16x8){l1[0], l1[1], l1[2], l1[3], h1[0], h1[1], h1[2], h1[3]}, o[d0], 0, 0, 0);   \
        o[d0] = __builtin_amdgcn_mfma_f32_32x32x16_bf16(pa2, (bf16x8){l2[0], l2[1], l2[2], l2[3], h2[0], h2[1], h2[2], h2[3]}, o[d0], 0, 0, 0);   \
        o[d0] = __builtin_amdgcn_mfma_f32_32x32x16_bf16(pa3, (bf16x8){l3[0], l3[1], l3[2], l3[3], h3[0], h3[1], h3[2], h3[3]}, o[d0], 0, 0, 0); } while (0)
    PV_D0(0); PV_D0(1); PV_D0(2); PV_D0(3);
#undef PV_D0
#undef TRRD
}

struct BlockRef { const u16* Q; const u16* K; const u16* V; const u16* KR; u16* O; int P0; };
struct Seam { bf16x8 st_v0, st_v1; };
#define ROWK(p, k0, rr) ((p) + (size_t)((k0) + (rr)) * LDK + sc)
#define VMW() asm volatile("s_waitcnt vmcnt(0)" ::: "memory")
#define VMWN(n) asm volatile("s_waitcnt vmcnt(%0)" :: "i"(n) : "memory")
#define ATT_LAS __attribute__((address_space(3)))
#define SLOAD_H(Kp, Vp, KRp, k0, bf) do { S.st_v0 = load8(ROWK(Vp, k0, sr)); S.st_v1 = load8(ROWK(Vp, k0, 32 + sr));              \
        __builtin_amdgcn_global_load_lds((const unsigned*)((Kp) + (size_t)((k0) + sr) * LDK + ksc), (ATT_LAS unsigned*)(ldsL + OFF_K + (bf) * SHM_K + wid * 1024), 16, 0, 0); \
        __builtin_amdgcn_global_load_lds((const unsigned*)((Kp) + (size_t)((k0) + 32 + sr) * LDK + ksc), (ATT_LAS unsigned*)(ldsL + OFF_K + (bf) * SHM_K + 8192 + wid * 1024), 16, 0, 0); \
        __builtin_amdgcn_global_load_lds((const unsigned*)((KRp) + (size_t)((k0) + krr) * LDKR + krsc), (ATT_LAS unsigned*)(ldsL + OFF_KR + (bf) * SHM_KR + wid * 1024), 16, 0, 0); } while (0)
#define SWRITE_HK(bf) do { } while (0)
#define SWRITE_HV(bf) do { *(bf16x8*)(V_lds + (bf) * SHM_V + vst0) = S.st_v0; *(bf16x8*)(V_lds + (bf) * SHM_V + vst1) = S.st_v1; } while (0)
#define SWRITE_H(bf) do { SWRITE_HV(bf); SWRITE_HK(bf); } while (0)
__device__ __forceinline__ void attn_prime(const BlockRef& cur, char* lds, Seam& S, int tid0) {
    int tid_ = tid0; asm volatile("" : "+v"(tid_));
    const int tid = tid_, wid = __builtin_amdgcn_readfirstlane(tid >> 6), lane = tid & 63, r32 = lane & 31, hi = lane >> 5;
    const int sr = tid >> 4, sc = (tid & 15) * 8, ksc = ((tid & 15) ^ (sr & 7)) * 8;
    const int krr = tid >> 3, krsc = ((tid & 7) ^ (krr & 7)) * 8; ATT_LAS unsigned char* ldsL = (ATT_LAS unsigned char*)lds;
    SLOAD_H(cur.K, cur.V, cur.KR, 0, 0); VMW();
    __syncthreads();
}
__device__ __forceinline__ void attn_block(const BlockRef& cur, const BlockRef& nxt, char* lds, Seam& S, int tid0) {
    int tid_ = tid0; asm volatile("" : "+v"(tid_));
    const int tid = tid_, wid = __builtin_amdgcn_readfirstlane(tid >> 6), lane = tid & 63, r32 = lane & 31, hi = lane >> 5;
    const unsigned W = 0x40000000u;
    const int NT = (cur.P0 + QB - 1) / KVBLK + 1;
    const int qlo = cur.P0 + wid * QBLK, qm = qlo + r32 - 4 * hi;
    char* V_lds = lds + OFF_V; char* K_lds = lds + OFF_K; char* KR_lds = lds + OFF_KR;
    float* ws = (float*)(lds + OFF_WS) + wid * 64; float* li_l = ws, * al_l = ws + 32;
    bf16x8* qrl = (bf16x8*)(lds + OFF_QR + wid * QR_WAVE) + lane;
    float m_reg = -1e30f, l_reg = 0; f32x16 o[4] = {};
    const int sr = tid >> 4, sc = (tid & 15) * 8, vst0 = v_st(sr, sc), vst1 = v_st(32 + sr, sc), ksc = ((tid & 15) ^ (sr & 7)) * 8;
    const int krr = tid >> 3, krsc = ((tid & 7) ^ (krr & 7)) * 8; ATT_LAS unsigned char* ldsL = (ATT_LAS unsigned char*)lds;
    const int vb0 = (int)(uintptr_t)lds + v_rd_base(lane);
    const u16* Kh = cur.K; const u16* Vh = cur.V; const u16* KRh = cur.KR;
#define RESC(a) do { if (__any((a) < 1.f)) { if (hi == 0) al_l[r32] = (a); asm volatile("s_waitcnt lgkmcnt(0)" ::: "memory");              \
                     for (int d_ = 0; d_ < 4; ++d_) for (int r = 0; r < 16; ++r) o[d_][r] *= al_l[crow(r, hi)]; } } while (0)
#define KBASE(t) ((t) * KVBLK)
#define MASKT(P0_, P1_, t) do { const int kb_ = KBASE(t); if (kb_ + KVBLK - 1 > qlo) mask_tile(P0_, P1_, qm - kb_, W); } while (0)
#define SEAM_K0() do { VMW(); SWRITE_HK(0); SBAR(); } while (0)
    f32x16 pA0, pA1, pB0, pB1; float mnA, mnB, alA, alB; bf16x8 pa0, pa1, pa2, pa3;
    bf16x8 qr[NQREG > 0 ? NQREG : 1];
    { const u16* qp = cur.Q + (size_t)(wid * QBLK + r32) * LDQ + hi * 8;
#pragma unroll
      for (int d = 0; d < NQREG_L + 4; ++d) qrl[d * 64] = load8(qp + (NQREG + d) * 16);
#pragma unroll
      for (int d0 = 0; d0 < NQREG; ++d0) qr[d0] = load8(qp + d0 * 16); }
    SWRITE_HV(0); SBAR();
    if (NT > 1) SLOAD_H(Kh, Vh, KRh, KBASE(1), 1);
    SBAR(); qkt<0>(pA0, pA1, K_lds, KR_lds, qrl, r32, hi, qr);
    MASKT(pA0, pA1, 0); partialSM(pA0, pA1, m_reg, mnA, alA);
    if (NT > 1) { VMW(); SWRITE_H(1); }
    __syncthreads();
#define HALF_STEP(PX0, PX1, mnX, alX, PY0, PY1, alY, t, KB, VB, SB) do {                                                      \
        SBAR(); qkt<KB>(PX0, PX1, K_lds, KR_lds, qrl, r32, hi, qr);                                                          \
        finishSM(PY0, PY1, alY, l_reg, pa0, pa1, pa2, pa3); SBAR();                                                           \
        if ((t) + 1 < NT) { SLOAD_H(Kh, Vh, KRh, KBASE((t) + 1), SB); SBAR(); }                                                   \
        pv_tile<VB>(o, vb0, pa0, pa1, pa2, pa3); MASKT(PX0, PX1, (t)); partialSM(PX0, PX1, m_reg, mnX, alX);                  \
        __syncthreads();                                                                                                      \
        if ((t) + 1 < NT) { VMW(); SWRITE_H(SB); }                                                                            \
        RESC(alX); __syncthreads(); } while (0)
    for (int t = 1; t + 1 < NT; t += 2) {
        HALF_STEP(pB0, pB1, mnB, alB, pA0, pA1, alA, t, 1, 0, 0);
        HALF_STEP(pA0, pA1, mnA, alA, pB0, pB1, alB, t + 1, 0, 1, 1);
    }
    const bool even = (NT & 1) == 0;
    if (even) { SBAR(); qkt<1>(pB0, pB1, K_lds, KR_lds, qrl, r32, hi, qr); SBAR(); }
    SLOAD_H(nxt.K, nxt.V, nxt.KR, 0, 0); SBAR();
    finishSM(pA0, pA1, alA, l_reg, pa0, pa1, pa2, pa3); SBAR();
    pv_tile<0>(o, vb0, pa0, pa1, pa2, pa3);
    if (even) { MASKT(pB0, pB1, NT - 1); partialSM(pB0, pB1, m_reg, mnB, alB); __syncthreads(); RESC(alB);
        finishSM(pB0, pB1, alB, l_reg, pa0, pa1, pa2, pa3); SBAR(); pv_tile<1>(o, vb0, pa0, pa1, pa2, pa3); }
    SBAR(); SEAM_K0();
    if (hi == 0) li_l[r32] = l_reg; asm volatile("s_waitcnt lgkmcnt(0)" ::: "memory");
    float rli[16];
#pragma unroll
    for (int r = 0; r < 16; ++r) rli[r] = __builtin_amdgcn_rcpf(li_l[crow(r, hi)]);
    u16* Ow = cur.O + (size_t)(wid * QBLK) * LDO;
#pragma unroll
    for (int r = 0; r < 16; ++r) { const int orow = crow(r, hi);
#pragma unroll
        for (int d0 = 0; d0 < 4; ++d0) { const float v = o[d0][r] * rli[r];
            const float vn = xor1f(v);
            if ((r32 & 1) == 0) *(unsigned*)(Ow + (size_t)orow * LDO + d0 * 32 + r32) = cvtpk(v, vn); } }
    __syncthreads();
#undef RESC
#undef KBASE
#undef MASKT
#undef SEAM_K0
#undef HALF_STEP
}
struct Tensors { const u16* q; const u16* kv; const u16* kr; u16* o; };
__device__ __forceinline__ BlockRef make_ref(const Tensors& T, int L, int pass) {
    const int bh = (L & 7) + 8 * (L >> 8), x = (L >> 3) & 31, b = bh >> 3, h = bh & 7, qb = pass ? 63 - x : x;
    BlockRef r; const size_t row0 = (size_t)b * SEQ;
    r.Q = T.q + (row0 + (size_t)qb * QB) * LDQ + h * 192; r.K = T.kv + row0 * LDK + h * 256; r.V = r.K + 128; r.KR = T.kr + row0 * LDKR;
    r.O = T.o + (row0 + (size_t)qb * QB) * LDO + h * 128; r.P0 = qb * QB;
    return r;
}
__device__ __forceinline__ void attn_phase(char* lds, const Tensors& T, int tid0) {
    const int total = 512, stride = gridDim.x;
    int L = blockIdx.x; if (L >= total) return;
    int pass = 0;
    BlockRef cur = make_ref(T, L, 0);
    Seam S;
    attn_prime(cur, lds, S, tid0);
    for (;;) {
        const bool more_pass = pass == 0, more_item = L + stride < total, last = !more_pass && !more_item;
        int passn = pass + 1, Ln = L;
        if (!more_pass) { passn = 0; Ln = more_item ? L + stride : L; }
        const BlockRef nxt = last ? cur : make_ref(T, Ln, passn);
        attn_block(cur, nxt, lds, S, tid0);
        if (last) break;
        cur = nxt; pass = passn; L = Ln;
    }
}
#undef ROWK
#undef VMW
#undef VMWN
#undef SLOAD_H
#undef SWRITE_HK
#undef SWRITE_HV
#undef SWRITE_H
#undef SBAR
}
namespace xb {
#define LAS __attribute__((address_space(3)))
#define XB_TMO      128
#define XB_XCNT(j)  (256  + 64 * (j))
#define XB_XSUB(j)  (1280 + 64 * (j))
#define XB_XGEN(j)  (2304 + 64 * (j))
#define XB_TOP      3328
#define XB_TOPGEN   3392
#define XCD_BAR_WORDS 3456
#define XB_SPIN_CAP (1u << 18)

__device__ __forceinline__ unsigned xb_ld(unsigned* p)              { return __hip_atomic_load(p, __ATOMIC_RELAXED, __HIP_MEMORY_SCOPE_AGENT); }
__device__ __forceinline__ unsigned xb_add(unsigned* p, unsigned v) { return __hip_atomic_fetch_add(p, v, __ATOMIC_RELAXED, __HIP_MEMORY_SCOPE_AGENT); }
__device__ __forceinline__ unsigned xb_xcc_id() { return (unsigned)__builtin_amdgcn_s_getreg((3 << 11) | 20) & 0xFu; }
#define XB_SPIN(cond, bar) do { unsigned _sp = 0; while (cond) { __builtin_amdgcn_s_sleep(1); \
    if ((++_sp & 255u) == 0u) { if (xb_ld(&(bar)[XB_TMO])) break; if (_sp > XB_SPIN_CAP) { atomicAdd(&(bar)[XB_TMO], 1u); break; } } } } while (0)

struct XcdBarrier {
    unsigned* bar; unsigned x;
    volatile LAS unsigned* st;
};

__device__ __forceinline__ XcdBarrier xcd_barrier_post(unsigned* bar, volatile LAS unsigned* st) {
    XcdBarrier b; b.bar = bar; b.x = xb_xcc_id(); b.st = st;
    if (threadIdx.x == 0) (void)xb_add(&bar[XB_XCNT(b.x)], 1u);
    return b;
}
__device__ __forceinline__ void xcd_barrier_complete(unsigned* bar, unsigned x, unsigned& nloc, unsigned& nx) {
    const unsigned G = gridDim.x * gridDim.y * gridDim.z;
    unsigned sum, cnt, mine, sp = 0u;
    for (;;) {
        sum = 0u; cnt = 0u; mine = 0u;
#pragma unroll
        for (unsigned j = 0; j < 16; ++j) { const unsigned c = xb_ld(&bar[XB_XCNT(j)]); sum += c; cnt += (c > 0u) ? 1u : 0u; mine = (j == x) ? c : mine; }
        if (sum == G) break;
        __builtin_amdgcn_s_sleep(1);
        if ((++sp & 255u) == 0u) { if (xb_ld(&bar[XB_TMO])) break; if (sp > XB_SPIN_CAP) { atomicAdd(&bar[XB_TMO], 1u); break; } }
    }
    nloc = mine > 0u ? mine : 1u; nx = cnt > 0u ? cnt : 1u;
}

__device__ __forceinline__ void xcd_barrier(const XcdBarrier& b, bool t0  ) {
    asm volatile("s_waitcnt vmcnt(0)" ::: "memory");
    __syncthreads();
    if (t0) {
        unsigned* bar = b.bar;
        __builtin_amdgcn_s_waitcnt(0);
        unsigned nloc = b.st[0], nx = b.st[1];
        if (nloc == 0u) { xcd_barrier_complete(bar, b.x, nloc, nx); b.st[0] = nloc; b.st[1] = nx; }
        const unsigned old = xb_add(&bar[XB_XSUB(b.x)], 1u);
        const unsigned gen = old / nloc;
        if (old + 1u == (gen + 1u) * nloc) {
            __builtin_amdgcn_fence(__ATOMIC_RELEASE, "agent");
            asm volatile("s_waitcnt vmcnt(0)" ::: "memory");
            const unsigned og = xb_add(&bar[XB_TOP], 1u);
            const unsigned tg = og / nx;
            if (og + 1u == (tg + 1u) * nx) xb_add(&bar[XB_TOPGEN], 1u);
            else XB_SPIN(xb_ld(&bar[XB_TOPGEN]) == tg, bar);
            __builtin_amdgcn_fence(__ATOMIC_ACQUIRE, "agent");
            xb_add(&bar[XB_XGEN(b.x)], 1u);
            asm volatile("s_waitcnt vmcnt(0)" ::: "memory");
        } else {
            XB_SPIN(xb_ld(&bar[XB_XGEN(b.x)]) == gen, bar);
            __builtin_amdgcn_fence(__ATOMIC_ACQUIRE, "agent");
            asm volatile("s_waitcnt vmcnt(0)" ::: "memory");
        }
    }
    __syncthreads();
}
#undef LAS
}
#ifndef PROBE_ATT_REPS
#define PROBE_ATT_REPS 1
#endif
#ifndef PROBE_SYNC_REPS
#define PROBE_SYNC_REPS 1
#endif
#ifndef PROBE_THIN_REPS
#define PROBE_THIN_REPS 1
#endif
#ifndef PROBE_GEMM_REPS
#define PROBE_GEMM_REPS 1
#endif
namespace mk {
typedef unsigned short u16;
typedef float f32x4 __attribute__((ext_vector_type(4)));
constexpr int M = 32768, D = 1024, SEQ = 16384;
constexpr float EPS = 1e-6f;
constexpr size_t MB = (size_t)1 << 20;
__host__ __device__ constexpr size_t WT_MLA(int j) { return (size_t)j * 6 * MB; }
__host__ __device__ constexpr size_t WT_LRU(int j) { return 12 * MB + (size_t)j * 8 * MB; }
__host__ __device__ constexpr size_t WT_FFN(int l) { return 28 * MB + (size_t)l * 16 * MB; }
constexpr size_t OFF_UQ = 3 * MB / 2, OFF_UKV = 11 * MB / 4, OFF_WO = 15 * MB / 4, OFF_GT = 4 * MB, OFF_LOUT = 5 * MB, OFF_DOWN = 8 * MB;
constexpr size_t WS_COS = 96 * MB, WS_SIN = 100 * MB, WS_SA = 104 * MB, WS_SB = 105 * MB;
constexpr size_t WS_HN = 112 * MB, WS_Y = 176 * MB, WS_U = 240 * MB, WS_END = 496 * MB;
constexpr size_t U_PROJ = 0, U_CQ = 48 * MB, U_CKV = 72 * MB, U_KR = 88 * MB, U_Q = 96 * MB, U_O = 192 * MB;
constexpr size_t U_GATE = 0, U_XC = 64 * MB, U_REC = 128 * MB, U_B = 128 * MB;
constexpr int SCAN_L = 128, SCAN_NC = SEQ / SCAN_L;

__device__ __forceinline__ unsigned f2bf(float f) { unsigned u = __float_as_uint(f); return (u + 0x7fffu + ((u >> 16) & 1u)) >> 16; }
__device__ __forceinline__ unsigned pk2(float lo, float hi) { return f2bf(lo) | (f2bf(hi) << 16); }
__device__ __forceinline__ float bflo(unsigned w) { return __uint_as_float(w << 16); }
__device__ __forceinline__ float bfhi(unsigned w) { return __uint_as_float(w & 0xffff0000u); }
__device__ __forceinline__ float bf1(u16 h) { return __uint_as_float(((unsigned)h) << 16); }
__device__ __forceinline__ float wave_sum(float v) {
    v += xor1f(v); v += xor2f(v); v += xor4f(v); v += xor8f(v); v += xor16f(v);
    return sum32f(v);
}
__device__ __forceinline__ void transpose_item(const float* W, int ldw, u16* WT, int ldt, int nblk, float* scr, int item, int lane) {
    const int kb = item / nblk, nb = item % nblk, k0 = 64 * kb, n0 = 32 * nb;
#pragma unroll 8
    for (int i = 0; i < 32; ++i) { const int kk = 2 * i + (lane >> 5); scr[kk * 33 + (lane & 31)] = W[(size_t)(k0 + kk) * ldw + n0 + (lane & 31)]; }
    asm volatile("s_waitcnt lgkmcnt(0)" ::: "memory");
    const int c = lane & 7;
#pragma unroll
    for (int j = 0; j < 4; ++j) { const int n = (lane >> 3) + 8 * j; const float* s = scr + (8 * c) * 33 + n;
        uint4 o; o.x = pk2(s[0 * 33], s[1 * 33]); o.y = pk2(s[2 * 33], s[3 * 33]); o.z = pk2(s[4 * 33], s[5 * 33]); o.w = pk2(s[6 * 33], s[7 * 33]);
        *(uint4*)(WT + (size_t)(n0 + n) * ldt + k0 + 8 * c) = o; }
    asm volatile("s_waitcnt lgkmcnt(0)" ::: "memory");
}
struct Params { const float* in[23]; float* out; unsigned char* ws; };
enum { I_X = 0, I_POS, I_MIXPRE, I_MIXPOST, I_FFNPRE, I_FFNPOST, I_MLA_WIN, I_MLA_QN, I_MLA_KVN, I_MLA_WUQ, I_MLA_WUKV, I_MLA_WO,
       I_LRU_WIN, I_LRU_CW, I_LRU_CB, I_LRU_WA, I_LRU_BA, I_LRU_WX, I_LRU_BX, I_LRU_LAM, I_LRU_WOUT, I_FFN_UP, I_FFN_DOWN };

__device__ __forceinline__ void prologue_weights(const __attribute__((address_space(4))) Params& p, float* scr, int gw, int NGW, int lane) {
    u16* wt = (u16*)p.ws;
    constexpr int IT_MLA = 352 + 288 + 256 + 512, IT_LRU = 1024 + 128 + 512, IT_FFN = 4096, TOTAL = 2 * IT_MLA + 2 * IT_LRU + 4 * IT_FFN;
    for (int it = gw; it < TOTAL; it += NGW) {
        int r = it; const float* W; int ldw, ldt, nblk; u16* WT;
        if (r < 2 * IT_MLA) { const int j = r / IT_MLA; r -= j * IT_MLA; u16* base = wt + WT_MLA(j) / 2;
            if (r < 352) { W = p.in[I_MLA_WIN] + (size_t)j * 1024 * 704; ldw = 704; nblk = 22; WT = base; ldt = 1024; }
            else if (r < 640) { r -= 352; W = p.in[I_MLA_WUQ] + (size_t)j * 384 * 1536; ldw = 1536; nblk = 48; WT = base + OFF_UQ / 2; ldt = 384; }
            else if (r < 896) { r -= 640; W = p.in[I_MLA_WUKV] + (size_t)j * 256 * 2048; ldw = 2048; nblk = 64; WT = base + OFF_UKV / 2; ldt = 256; }
            else { r -= 896; W = p.in[I_MLA_WO] + (size_t)j * 1024 * 1024; ldw = 1024; nblk = 32; WT = base + OFF_WO / 2; ldt = 1024; }
        } else if (r < 2 * IT_MLA + 2 * IT_LRU) { r -= 2 * IT_MLA; const int j = r / IT_LRU; r -= j * IT_LRU; u16* base = wt + WT_LRU(j) / 2;
            if (r < 1024) { W = p.in[I_LRU_WIN] + (size_t)j * 1024 * 2048; ldw = 2048; nblk = 64; WT = base; ldt = 1024; }
            else if (r < 1152) { r -= 1024; const int which = r >> 3, gt = which >> 3, n = which & 7; r &= 7;
                W = p.in[gt ? I_LRU_WX : I_LRU_WA] + (size_t)j * 8 * 128 * 128 + (size_t)n * 128 * 128; ldw = 128; nblk = 4;
                WT = base + OFF_GT / 2 + (size_t)(n * 256 + gt * 128) * 256 + 128 * (n & 1); ldt = 256; }
            else { r -= 1152; W = p.in[I_LRU_WOUT] + (size_t)j * 1024 * 1024; ldw = 1024; nblk = 32; WT = base + OFF_LOUT / 2; ldt = 1024; }
        } else { r -= 2 * IT_MLA + 2 * IT_LRU; const int l = r / IT_FFN; r -= l * IT_FFN; u16* base = wt + WT_FFN(l) / 2;
            if (r < 2048) { W = p.in[I_FFN_UP] + (size_t)l * 1024 * 4096; ldw = 4096; nblk = 128; WT = base; ldt = 1024; }
            else { r -= 2048; W = p.in[I_FFN_DOWN] + (size_t)l * 4096 * 1024; ldw = 1024; nblk = 32; WT = base + OFF_DOWN / 2; ldt = 4096; }
        }
        transpose_item(W, ldw, WT, ldt, nblk, scr, r, lane);
    }
}
__device__ __forceinline__ void rowop(const u16* y, const float* xin, float* xout, u16* hn, const float* gpost, const float* gpre, int gw, int NGW, int lane) {
    f32x4 gp[4], gq[4];
#pragma unroll
    for (int j = 0; j < 4; ++j) { gp[j] = gpost ? *(const f32x4*)(gpost + j * 256 + lane * 4) : (f32x4){0.f, 0.f, 0.f, 0.f}; gq[j] = gpre ? *(const f32x4*)(gpre + j * 256 + lane * 4) : (f32x4){0.f, 0.f, 0.f, 0.f}; }
    for (int row = gw; row < M; row += NGW) {
        f32x4 xv[4];
#pragma unroll
        for (int j = 0; j < 4; ++j) xv[j] = *(const f32x4*)(xin + (size_t)row * D + j * 256 + lane * 4);
        if (y) {
            f32x4 yv[4]; float ss = 0.f;
#pragma unroll
            for (int j = 0; j < 4; ++j) { const uint2 w = *(const uint2*)(y + (size_t)row * D + j * 256 + lane * 4);
                yv[j] = (f32x4){bflo(w.x), bfhi(w.x), bflo(w.y), bfhi(w.y)}; ss += (yv[j].x * yv[j].x + yv[j].y * yv[j].y) + (yv[j].z * yv[j].z + yv[j].w * yv[j].w); }
            const float r = rsqrtf(wave_sum(ss) * (1.f / D) + EPS);
#pragma unroll
            for (int j = 0; j < 4; ++j) xv[j] = xv[j] + (yv[j] * r) * gp[j];
        }
#pragma unroll
        for (int j = 0; j < 4; ++j) *(f32x4*)(xout + (size_t)row * D + j * 256 + lane * 4) = xv[j];
        if (gpre) {
            float s2 = 0.f;
#pragma unroll
            for (int j = 0; j < 4; ++j) s2 += (xv[j].x * xv[j].x + xv[j].y * xv[j].y) + (xv[j].z * xv[j].z + xv[j].w * xv[j].w);
            const float r2 = rsqrtf(wave_sum(s2) * (1.f / D) + EPS);
#pragma unroll
            for (int j = 0; j < 4; ++j) { const f32x4 h = (xv[j] * r2) * gq[j]; uint2 w; w.x = pk2(h.x, h.y); w.y = pk2(h.z, h.w);
                *(uint2*)(hn + (size_t)row * D + j * 256 + lane * 4) = w; }
        }
    }
}
__device__ __forceinline__ void qkvnorm(const u16* proj, u16* cq, u16* ckv, u16* kr, const float* qn, const float* kvn, const float* ctab, const float* stab, int gw, int NGW, int lane) {
    float gq[6], gk[4];
#pragma unroll
    for (int j = 0; j < 6; ++j) gq[j] = qn[lane + 64 * j];
#pragma unroll
    for (int j = 0; j < 4; ++j) gk[j] = kvn[lane + 64 * j];
    for (int row = gw; row < M; row += NGW) {
        const u16* pr = proj + (size_t)row * 768;
        float a[6], b[4], s1 = 0.f, s2 = 0.f;
#pragma unroll
        for (int j = 0; j < 6; ++j) { a[j] = bf1(pr[lane + 64 * j]); s1 += a[j] * a[j]; }
#pragma unroll
        for (int j = 0; j < 4; ++j) { b[j] = bf1(pr[384 + lane + 64 * j]); s2 += b[j] * b[j]; }
        const float x1 = bf1(pr[640 + (lane & 31)]), x2 = bf1(pr[672 + (lane & 31)]);
        const float r1 = rsqrtf(wave_sum(s1) * (1.f / 384.f) + EPS), r2 = rsqrtf(wave_sum(s2) * (1.f / 256.f) + EPS);
#pragma unroll
        for (int j = 0; j < 6; ++j) cq[(size_t)row * 384 + lane + 64 * j] = (u16)f2bf(a[j] * r1 * gq[j]);
#pragma unroll
        for (int j = 0; j < 4; ++j) ckv[(size_t)row * 256 + lane + 64 * j] = (u16)f2bf(b[j] * r2 * gk[j]);
        const float c = ctab[(size_t)row * 32 + (lane & 31)], s = stab[(size_t)row * 32 + (lane & 31)];
        kr[(size_t)row * 64 + lane] = (u16)f2bf(lane < 32 ? x1 * c - x2 * s : x2 * c + x1 * s);
    }
}
__device__ __forceinline__ void qrope(u16* q, const float* ctab, const float* stab, int gw, int NGW, int lane) {
    for (int row = gw; row < M; row += NGW) {
        u16* qr = q + (size_t)row * 1536; const int i = lane & 31;
        const float c = ctab[(size_t)row * 32 + i], s = stab[(size_t)row * 32 + i];
#pragma unroll
        for (int j = 0; j < 4; ++j) { const int h = 2 * j + (lane >> 5); u16* pp = qr + h * 192 + 128 + i;
            const float x1 = bf1(pp[0]), x2 = bf1(pp[32]);
            pp[0] = (u16)f2bf(x1 * c - x2 * s); pp[32] = (u16)f2bf(x2 * c + x1 * s); }
    }
}
__device__ __forceinline__ void conv_phase(const u16* rec, u16* xc, const float* cw, const float* cb, int gtid, int NGT) {
    for (int idx = gtid; idx < M * 128; idx += NGT) {
        const int row = idx >> 7, c0 = (idx & 127) * 8, s = row & (SEQ - 1);
        float acc[8];
#pragma unroll
        for (int e = 0; e < 8; ++e) acc[e] = cb[c0 + e];
#pragma unroll
        for (int k = 0; k < 4; ++k) { if (s - 3 + k >= 0) {
            const uint4 w = *(const uint4*)(rec + (size_t)(row - 3 + k) * D + c0);
            const float v[8] = {bflo(w.x), bfhi(w.x), bflo(w.y), bfhi(w.y), bflo(w.z), bfhi(w.z), bflo(w.w), bfhi(w.w)};
#pragma unroll
            for (int e = 0; e < 8; ++e) acc[e] += v[e] * cw[k * D + c0 + e]; } }
        uint4 o; o.x = pk2(acc[0], acc[1]); o.y = pk2(acc[2], acc[3]); o.z = pk2(acc[4], acc[5]); o.w = pk2(acc[6], acc[7]);
        *(uint4*)(xc + (size_t)row * D + c0) = o;
    }
}
__device__ __forceinline__ void scanA(const float* A, const float* B, float* SA, float* SB, int tid) {
    for (int item = blockIdx.x; item < 2 * SCAN_NC * 2; item += gridDim.x) {
        const int half = item & 1, c = (item >> 1) % SCAN_NC, b = item / (2 * SCAN_NC), ch = half * 512 + tid;
        const size_t base = ((size_t)b * SEQ + (size_t)c * SCAN_L) * D + ch;
        float h = 0.f, P = 1.f;
        for (int t0 = 0; t0 < SCAN_L; t0 += 16) {
            float av[16], bv[16];
#pragma unroll
            for (int u = 0; u < 16; ++u) { av[u] = A[base + (size_t)(t0 + u) * D]; bv[u] = B[base + (size_t)(t0 + u) * D]; }
#pragma unroll
            for (int u = 0; u < 16; ++u) { h = av[u] * h + bv[u]; P *= av[u]; }
        }
        SA[((size_t)b * SCAN_NC + c) * D + ch] = P; SB[((size_t)b * SCAN_NC + c) * D + ch] = h;
    }
}
__device__ __forceinline__ void scanC(const float* A, const float* B, const float* SA, const float* SB, const u16* gate, u16* hg, int tid) {
    for (int item = blockIdx.x; item < 2 * SCAN_NC * 2; item += gridDim.x) {
        const int half = item & 1, c = (item >> 1) % SCAN_NC, b = item / (2 * SCAN_NC), ch = half * 512 + tid;
        const size_t base = ((size_t)b * SEQ + (size_t)c * SCAN_L) * D + ch;
        float h = 0.f;
        for (int cc = 0; cc < c; ++cc) { const size_t so = ((size_t)b * SCAN_NC + cc) * D + ch; h = SA[so] * h + SB[so]; }
        for (int t0 = 0; t0 < SCAN_L; t0 += 16) {
            float av[16], bv[16]; u16 gv[16];
#pragma unroll
            for (int u = 0; u < 16; ++u) { av[u] = A[base + (size_t)(t0 + u) * D]; bv[u] = B[base + (size_t)(t0 + u) * D]; gv[u] = gate[base + (size_t)(t0 + u) * D]; }
#pragma unroll
            for (int u = 0; u < 16; ++u) { h = av[u] * h + bv[u]; hg[base + (size_t)(t0 + u) * D] = (u16)f2bf(bf1(gv[u]) * h); }
        }
    }
}

constexpr int LDS_MAIN = att::LDS_BYTES > pg8::STAGE_BYTES ? att::LDS_BYTES : pg8::STAGE_BYTES, LDS_BYTES = LDS_MAIN + 16;
constexpr size_t WS_BAR = 106 * MB;
constexpr size_t WS_CNT1 = WS_BAR + 16384, WS_CNT2 = WS_BAR + 49152, CTL_BYTES = 81920, WS_XS1 = 107 * MB, WS_XS2 = 107 * MB + MB / 2;
constexpr int XL_OFF = 131072;
static_assert(XL_OFF + 8192 <= LDS_MAIN && XCD_BAR_WORDS * 4 <= 16384 && att::LDS_BYTES <= LDS_MAIN && pg8::STAGE_BYTES <= LDS_MAIN && LDS_BYTES <= 160 * 1024, "LDS map");

__global__ void __launch_bounds__(512, 2) fwd_mega(Params p_arg) {
    extern __shared__ __attribute__((aligned(16))) unsigned char lds[];
    cg::grid_group grid = cg::this_grid();
    (void)p_arg;
    volatile __attribute__((address_space(3))) unsigned* bst = (volatile __attribute__((address_space(3))) unsigned*)((__attribute__((address_space(3))) unsigned char*)lds + LDS_MAIN);
    if (threadIdx.x < 4) bst[threadIdx.x] = 0u;
    __syncthreads();
    const int wave_s = __builtin_amdgcn_readfirstlane(threadIdx.x >> 6);
    const xb::XcdBarrier bar = xb::xcd_barrier_post((unsigned*)(p_arg.ws + WS_BAR), bst);
    typedef const __attribute__((address_space(4))) Params* KParams;
    KParams pp = (KParams)__builtin_amdgcn_kernarg_segment_ptr();
#define FRESH() int tid_ = wave_s * 64 + lane_id_fresh(); asm volatile("" : "+v"(tid_)); asm volatile("" : "+s"(pp)); const __attribute__((address_space(4))) Params& p = *pp; \
    const int tid = tid_, lane = tid & 63, wave = __builtin_amdgcn_readfirstlane(tid >> 6); \
    const int G = gridDim.x, gw = blockIdx.x * 8 + wave, NGW = G * 8, gtid = blockIdx.x * 512 + tid, NGT = G * 512; \
    unsigned char* ws = p.ws; float* x = p.out; u16* hn = (u16*)(ws + WS_HN); u16* ybuf = (u16*)(ws + WS_Y); unsigned char* U = ws + WS_U; \
    float* ctab = (float*)(ws + WS_COS); float* stab = (float*)(ws + WS_SIN); float* SA = (float*)(ws + WS_SA); float* SB = (float*)(ws + WS_SB); \
    (void)lane; (void)wave; (void)gw; (void)NGW; (void)gtid; (void)NGT; (void)x; (void)hn; (void)ybuf; (void)U; (void)ctab; (void)stab; (void)SA; (void)SB;
    {
    FRESH();

    prologue_weights(p, (float*)lds + wave * (64 * 33), gw, NGW, lane);
    for (int i = gtid; i < 2 * 2048 * 16; i += NGT) { const int j = i >> 15, row = (i >> 4) & 2047, chn = i & 15, n = row >> 8;
        *(uint4*)((u16*)(ws + WT_LRU(j) + OFF_GT) + (size_t)row * 256 + 128 * ((n & 1) ^ 1) + chn * 8) = make_uint4(0u, 0u, 0u, 0u); }
    { const int* pos = (const int*)p.in[I_POS];
      for (int i = gtid; i < M * 32; i += NGT) { const int row = i >> 5, f = i & 31;
        const float inv = __builtin_amdgcn_exp2f(-(float)f * (13.287712379549449f / 32.f));
        const float ang = (float)pos[row] * inv;
        double rev = (double)ang * 0.15915494309189535; rev -= __builtin_rint(rev);
        ctab[i] = __builtin_amdgcn_cosf((float)rev); stab[i] = __builtin_amdgcn_sinf((float)rev); } }
    rowop(nullptr, p.in[I_X], x, hn, nullptr, p.in[I_MIXPRE], gw, NGW, lane);
    }
    grid.sync();

#pragma nounroll
    for (int layer = 0; layer < 4; ++layer) {
#pragma nounroll
        for (int op = 0; op < 10; ++op) {
            FRESH();
            const int j = layer >> 1; const bool lru = (layer & 1) != 0;
            const u16* wtm = (const u16*)(ws + WT_MLA(j)); const u16* wtl = (const u16*)(ws + WT_LRU(j)); const u16* wtf = (const u16*)(ws + WT_FFN(layer));
            int gk = 0;
            pg8::Gemm g{}; pg8::EpiB E{};
            if (op == 6 || op == 9) continue;
            const float* gpost = p.in[op == 5 ? I_MIXPOST : I_FFNPOST] + layer * D;
            const float* gpre = op == 5 ? p.in[I_FFNPRE] + layer * D : (layer < 3 ? p.in[I_MIXPRE] + (layer + 1) * D : nullptr);
            if (op == 7) { gk = 1; g = pg8::Gemm{hn, wtf, M, 4096, 1024, 1024, 1024, 0}; E = pg8::EpiB{(u16*)U, 4096, 0, 0, 1}; }
            else if (op == 8) { gk = 3; g = pg8::Gemm{(const u16*)U, wtf + OFF_DOWN / 2, M, 1024, 4096, 4096, 4096, 0}; }
            else if (!lru) {
                u16* proj = (u16*)(U + U_PROJ); u16* cq = (u16*)(U + U_CQ); u16* ckv = (u16*)(U + U_CKV); u16* kr = (u16*)(U + U_KR); u16* q = (u16*)(U + U_Q); u16* o = (u16*)(U + U_O); u16* kv = hn;
                if (op == 0) { gk = 1; g = pg8::Gemm{hn, wtm, M, 768, 1024, 1024, 1024, 0}; E = pg8::EpiB{proj, 768, 0, 0, 0}; }
                else if (op == 1) for (int rep = 0; rep < PROBE_THIN_REPS; ++rep) qkvnorm(proj, cq, ckv, kr, p.in[I_MLA_QN] + j * 384, p.in[I_MLA_KVN] + j * 256, ctab, stab, gw, NGW, lane);
                else if (op == 2) { gk = 1; g = pg8::Gemm{cq, wtm + OFF_UQ / 2, M, 1536, 384, 384, 384, 0}; E = pg8::EpiB{q, 1536, 0, 0, 0}; }
                else if (op == 3) { qrope(q, ctab, stab, gw, NGW, lane); gk = 1; g = pg8::Gemm{ckv, wtm + OFF_UKV / 2, M, 2048, 256, 256, 256, 0}; E = pg8::EpiB{kv, 2048, 0, 0, 0}; }
                else if (op == 4) { const att::Tensors T{q, kv, kr, o}; for (int rep = 0; rep < PROBE_ATT_REPS; ++rep) att::attn_phase((char*)lds, T, tid); }
                else { gk = 3; g = pg8::Gemm{o, wtm + OFF_WO / 2, M, 1024, 1024, 1024, 1024, 0}; }
            } else {
                u16* gate = (u16*)(U + U_GATE); u16* xc = (u16*)(U + U_XC); u16* rec = (u16*)(U + U_REC); float* Bb = (float*)(U + U_B); float* Ab = (float*)hn; u16* hg = xc;
                if (op == 0) { gk = 1; g = pg8::Gemm{hn, wtl, M, 2048, 1024, 1024, 1024, 0}; E = pg8::EpiB{gate, 1024, 1024, (size_t)(U_REC - U_GATE) / 2, 2}; }
                else if (op == 1) for (int rep = 0; rep < PROBE_THIN_REPS; ++rep) conv_phase(rec, xc, p.in[I_LRU_CW] + j * 4 * D, p.in[I_LRU_CB] + j * D, gtid, NGT);
                else if (op == 2) { gk = 2; g = pg8::Gemm{xc, wtl + OFF_GT / 2, M, 2048, 256, 1024, 256, 512}; }
                else if (op == 3) for (int rep = 0; rep < PROBE_THIN_REPS; ++rep) scanA(Ab, Bb, SA, SB, tid);
                else if (op == 4) for (int rep = 0; rep < PROBE_THIN_REPS; ++rep) scanC(Ab, Bb, SA, SB, gate, hg, tid);
                else { gk = 3; g = pg8::Gemm{hg, wtl + OFF_LOUT / 2, M, 1024, 1024, 1024, 1024, 0}; }
            }
            for (int rep = 0; rep < PROBE_GEMM_REPS; ++rep)
            if (gk == 1) { pg8::StaticOrder S; S.init(g.M, g.N, G, (int)blockIdx.x);
                pg8::gemm_phase<pg8::EpiB, pg8::StaticOrder, true>((PG8_LAS unsigned char*)lds, g, S, E, tid); }
            else if (gk == 2) { pg8::StaticOrder S; S.init(g.M, g.N, G, (int)blockIdx.x);
                const pg8::EpiGate EG{(const u16*)(U + U_XC), (float*)hn, (float*)(U + U_B), p.in[I_LRU_BA] + j * D, p.in[I_LRU_BX] + j * D, p.in[I_LRU_LAM] + j * D};
                pg8::gemm_phase<pg8::EpiGate, pg8::StaticOrder, true>((PG8_LAS unsigned char*)lds, g, S, EG, tid); }
            else if (gk == 3) { pg8::StaticOrder S; S.init(g.M, g.N, G, (int)blockIdx.x);
                const unsigned target = 32u * (unsigned)(layer * 2 + (op == 8 ? 2 : 1));
                const pg8::RowStats st1{(float*)(ws + WS_XS1), (unsigned*)(ws + WS_CNT1), target}, st2{(float*)(ws + WS_XS2), (unsigned*)(ws + WS_CNT2), target};
                const pg8::EpiNormRes EN{x, hn, gpost, gpre, st1, st2, (PG8_LAS unsigned char*)lds + XL_OFF};
                pg8::gemm_phase<pg8::EpiNormRes, pg8::StaticOrder, true>((PG8_LAS unsigned char*)lds, g, S, EN, tid); }
            if (!(layer == 3 && op == 8)) { for (int rep = 0; rep < PROBE_SYNC_REPS; ++rep) xb::xcd_barrier(bar, tid == 0); }
        }
    }
}
}

extern "C" void kernel_launch(void* const* d_in, const int* in_sizes, int n_in, void* d_out, int out_size, void* d_ws, size_t ws_size, hipStream_t stream) {
    static int grid = 0;
    if (grid == 0) {
        if (n_in != 23 || in_sizes[0] != mk::M * mk::D || out_size != mk::M * mk::D || ws_size < mk::WS_END) {
            fprintf(stderr, "kernel_launch: unexpected shapes (n_in %d, in0 %d, out %d, ws %zu); nothing launched\n", n_in, n_in > 0 ? in_sizes[0] : -1, out_size, ws_size); grid = -1; return; }
        int dev = 0, cus = 0, per_cu = 0;
        (void)hipGetDevice(&dev); (void)hipDeviceGetAttribute(&cus, hipDeviceAttributeMultiprocessorCount, dev);
        if (hipFuncSetAttribute((const void*)mk::fwd_mega, hipFuncAttributeMaxDynamicSharedMemorySize, mk::LDS_BYTES) != hipSuccess) { fprintf(stderr, "kernel_launch: hipFuncSetAttribute failed\n"); grid = -1; return; }
        if (hipOccupancyMaxActiveBlocksPerMultiprocessor(&per_cu, (const void*)mk::fwd_mega, 512, mk::LDS_BYTES) != hipSuccess || per_cu < 1) { fprintf(stderr, "kernel_launch: occupancy query says %d blocks per CU\n", per_cu); per_cu = 1; }
        (void)hipGetLastError();
        grid = cus > 0 ? cus : 256;
    }
    if (grid < 0) return;
    mk::Params p{};
    for (int i = 0; i < 23; ++i) p.in[i] = (const float*)d_in[i];
    p.out = (float*)d_out; p.ws = (unsigned char*)d_ws;
    if (hipMemsetAsync((char*)d_ws + mk::WS_BAR, 0, mk::CTL_BYTES, stream) != hipSuccess) { fprintf(stderr, "kernel_launch: hipMemsetAsync failed\n"); return; }
    void* args[] = {&p};
    hipError_t e = hipLaunchCooperativeKernel((const void*)mk::fwd_mega, dim3(grid), dim3(512), args, mk::LDS_BYTES, stream);
    if (e != hipSuccess) fprintf(stderr, "kernel_launch: cooperative launch failed: %s (grid %d)\n", hipGetErrorString(e), grid);
}
```

```cpp
#include <hip/hip_runtime.h>
#include <hip/hip_bf16.h>
#include <hip/hip_cooperative_groups.h>
#include <cstdio>
#include <cstdint>
namespace cg = cooperative_groups;

__device__ __forceinline__ float xor1f(float v)  { return __int_as_float(__builtin_amdgcn_mov_dpp(__float_as_int(v), 0xB1, 0xF, 0xF, false)); }
__device__ __forceinline__ float xor2f(float v)  { return __int_as_float(__builtin_amdgcn_mov_dpp(__float_as_int(v), 0x4E, 0xF, 0xF, false)); }
__device__ __forceinline__ float xor4f(float v)  { return __int_as_float(__builtin_amdgcn_ds_swizzle(__float_as_int(v), 0x101F)); }
__device__ __forceinline__ float xor8f(float v)  { return __int_as_float(__builtin_amdgcn_ds_swizzle(__float_as_int(v), 0x201F)); }
__device__ __forceinline__ float xor16f(float v) { return __int_as_float(__builtin_amdgcn_ds_swizzle(__float_as_int(v), 0x401F)); }
__device__ __forceinline__ float sum32f(float v) { auto rr = __builtin_amdgcn_permlane32_swap(__float_as_uint(v), __float_as_uint(v), false, false); return __uint_as_float(rr[0]) + __uint_as_float(rr[1]); }
__device__ __forceinline__ int lane_id_fresh() { int l; asm volatile("v_mbcnt_lo_u32_b32 %0, -1, 0\n\tv_mbcnt_hi_u32_b32 %0, -1, %0" : "=v"(l)); return l; }
namespace pg8 {
#define PG8_LAS __attribute__((address_space(3)))
typedef unsigned short bf16_t;
typedef short bf16x8 __attribute__((ext_vector_type(8)));
typedef float f32x4 __attribute__((ext_vector_type(4)));
typedef unsigned u32x4 __attribute__((ext_vector_type(4)));
constexpr int BM = 256, BK = 64, HALF = 128, HTB = HALF * BK * 2  , STAGE_BYTES = 8 * HTB, NXCD = 8, WGM = 8;

__host__ __device__ __forceinline__ int lds_byte(int r, int c) { const int st = (r >> 4) * 2 + (c >> 5), rr = r & 15, cc = c & 31, ob = rr * 64 + cc * 2; return st * 1024 + (ob ^ (((ob >> 9) & 1) << 5)); }
__host__ __device__ __forceinline__ void stage_rc(int b, int& R, int& C) { const int st = b / 1024, sb = b % 1024, swz = sb ^ (((sb >> 9) & 1) << 5); R = (st >> 1) * 16 + swz / 64; C = (st & 1) * 32 + (swz % 64) / 2; }
__host__ __device__ __forceinline__ int perm32(int rho) { const int n = rho >> 4, i = rho & 15; return 8 * (i >> 2) + 4 * n + (i & 3); }

struct Unit { int pm, pn; };
struct Gemm { const bf16_t* A; const bf16_t* Bt; int M, N, K; int lda, ldb; int apn; };

struct StaticOrder {
    int nM, nN, nwg, G, c;
    __host__ __device__ void init(int M, int N, int G_, int c_) { nM = M / BM; nN = N / BM; nwg = nM * nN; G = G_; c = c_; }
    __host__ __device__ bool next(int i, Unit& u) const {
        const long L = (long)i * G + c; if (L >= nwg) return false;
        int wgid = (int)L; { const int q = nwg / NXCD, r = nwg % NXCD, xcd = wgid % NXCD, off = wgid / NXCD; wgid = (xcd < r ? xcd * (q + 1) : r * (q + 1) + (xcd - r) * q) + off; }
        const int nig = WGM * nN, gid = wgid / nig, fm = gid * WGM, gsz = (nM - fm) < WGM ? (nM - fm) : WGM;
        u.pm = fm + ((wgid % nig) % gsz); u.pn = (wgid % nig) / gsz; return true;
    }
    __device__ __forceinline__ void a_ready(const Unit&) const {}
    __device__ __forceinline__ void done(const Unit&) const {}
};

__device__ __forceinline__ unsigned cvt_pk_bf16(float lo, float hi) { unsigned r; asm volatile("v_cvt_pk_bf16_f32 %0, %1, %2" : "=v"(r) : "v"(lo), "v"(hi)); return r; }
__device__ __forceinline__ float gelu_tanh(float x) {
    const float z = 0.7978845608028654f * (x + 0.044715f * x * x * x);
    const float e = __expf(2.0f * z);
    const float th = 1.0f - 2.0f * __builtin_amdgcn_rcpf(1.0f + e);
    return 0.5f * x * (1.0f + th);
}
struct EpiB {
    static constexpr bool PERM = true, AFTER_DRAIN = false, FUSED = false;
    bf16_t* O; int ldc; int split_cols; size_t split_stride; int mode;
    __device__ __forceinline__ void operator()(const f32x4 (&acc)[2][2][4][2], const Unit& u, int wr, int wc, int fr, int fq) const {
        const int row0 = u.pm * BM + wr * 64 + fr; int colt = u.pn * BM; bf16_t* base = O; int t = 0;
        if (split_cols) { t = colt / split_cols; base += (size_t)t * split_stride; colt -= t * split_cols; }
        const int act = (mode == 1) ? 1 : ((mode == 2 && t == 0) ? 2 : 0);
        const int col0 = colt + wc * 32 + 8 * fq;
#pragma unroll
        for (int ai = 0; ai < 2; ++ai)
#pragma unroll
            for (int m = 0; m < 4; ++m) { bf16_t* rowp = base + (size_t)(row0 + ai * HALF + m * 16) * ldc + col0;
#pragma unroll
                for (int bj = 0; bj < 2; ++bj) { f32x4 v0 = acc[ai][bj][m][0], v1 = acc[ai][bj][m][1];
                    if (act == 1) {
#pragma unroll
                        for (int e = 0; e < 4; ++e) { const float a = fmaxf(v0[e], 0.f), b = fmaxf(v1[e], 0.f); v0[e] = a * a; v1[e] = b * b; } }
                    else if (act == 2) {
#pragma unroll
                        for (int e = 0; e < 4; ++e) { v0[e] = gelu_tanh(v0[e]); v1[e] = gelu_tanh(v1[e]); } }
                    u32x4 w; w.x = cvt_pk_bf16(v0[0], v0[1]); w.y = cvt_pk_bf16(v0[2], v0[3]); w.z = cvt_pk_bf16(v1[0], v1[1]); w.w = cvt_pk_bf16(v1[2], v1[3]);
                    *(u32x4*)(rowp + bj * HALF) = w; } }
    }
};
__device__ __forceinline__ float bf2f(unsigned short h) { return __uint_as_float(((unsigned)h) << 16); }
__device__ __forceinline__ float sigmoidf_(float x) { return __builtin_amdgcn_rcpf(1.0f + __expf(-x)); }
__device__ __forceinline__ float one_minus_exp(float t) { const float ser = -t * (1.0f + t * (0.5f + t * (0.16666667f + t * (0.041666668f + t * 0.008333334f)))); return t > -0.25f ? ser : 1.0f - __expf(t); }
struct EpiGate {
    static constexpr bool PERM = false, AFTER_DRAIN = false, FUSED = false;
    const bf16_t* xc; float* Aout; float* Bout; const float* b_a; const float* b_x; const float* lam;
    __device__ __forceinline__ void operator()(const f32x4 (&acc)[2][2][4][2], const Unit& u, int wr, int wc, int fr, int fq) const {
#pragma unroll
        for (int n = 0; n < 2; ++n) {
            const int ch0 = 128 * u.pn + 32 * wc + 16 * n + 4 * fq;
            const f32x4 ba = *(const f32x4*)(b_a + ch0), bx = *(const f32x4*)(b_x + ch0), lm = *(const f32x4*)(lam + ch0);
            f32x4 sp;
#pragma unroll
            for (int e = 0; e < 4; ++e) sp[e] = -8.0f * log1pf(__expf(-lm[e]));
#pragma unroll
            for (int ai = 0; ai < 2; ++ai)
#pragma unroll
                for (int m = 0; m < 4; ++m) {
                    const size_t off = (size_t)(u.pm * BM + ai * HALF + wr * 64 + m * 16 + fr) * 1024 + ch0;
                    const uint2 xr = *(const uint2*)(xc + off);
                    float xv[4] = { __uint_as_float(xr.x << 16), __uint_as_float(xr.x & 0xffff0000u), __uint_as_float(xr.y << 16), __uint_as_float(xr.y & 0xffff0000u) };
                    f32x4 av, bv;
#pragma unroll
                    for (int e = 0; e < 4; ++e) {
                        const float r = sigmoidf_(acc[ai][0][m][n][e] + ba[e]);
                        const float ig = sigmoidf_(acc[ai][1][m][n][e] + bx[e]);
                        const float la = sp[e] * r;
                        av[e] = __expf(la);
                        bv[e] = __builtin_amdgcn_sqrtf(fmaxf(one_minus_exp(2.0f * la), 0.f)) * (ig * xv[e]);
                    }
                    *(f32x4*)(Aout + off) = av; *(f32x4*)(Bout + off) = bv;
                }
        }
    }
};

struct RowStats {
    float* xbuf;
    unsigned* cnt;
    unsigned target;
    __device__ __forceinline__ void run(const f32x4 (&v)[2][2][4][2], const Unit& u, int wr, int wc, int fr, int fq, PG8_LAS unsigned char* xl, int wid, int lane) const {
        PG8_LAS float* P = (PG8_LAS float*)xl;
        PG8_LAS float* S = (PG8_LAS float*)(xl + 4096);
#pragma unroll
        for (int ai = 0; ai < 2; ++ai)
#pragma unroll
            for (int m = 0; m < 4; ++m) {
                float s = 0.f;
#pragma unroll
                for (int bj = 0; bj < 2; ++bj)
#pragma unroll
                    for (int n = 0; n < 2; ++n) { const f32x4 x = v[ai][bj][m][n]; s += (x[0] * x[0] + x[1] * x[1]) + (x[2] * x[2] + x[3] * x[3]); }
                s += xor16f(s); s = sum32f(s);
                if (fq == 0) P[(ai * HALF + wr * 64 + m * 16 + fr) * 4 + wc] = s;
            }
        asm volatile("s_waitcnt lgkmcnt(0)" ::: "memory"); __builtin_amdgcn_s_barrier(); asm volatile("" ::: "memory");
        const int row = wid * 32 + (lane & 31);
        if (lane < 32) { const float t = (P[row * 4 + 0] + P[row * 4 + 1]) + (P[row * 4 + 2] + P[row * 4 + 3]);
            __hip_atomic_store(xbuf + (size_t)(u.pm * BM + row) * 4 + u.pn, t, __ATOMIC_RELAXED, __HIP_MEMORY_SCOPE_AGENT); }
        asm volatile("s_waitcnt vmcnt(0)" ::: "memory");
        if (lane == 0) __hip_atomic_fetch_add(cnt + 64 * u.pm, 1u, __ATOMIC_RELAXED, __HIP_MEMORY_SCOPE_AGENT);
        if (wid == 0) { unsigned sp = 0;
            while ((unsigned)__builtin_amdgcn_readfirstlane(__hip_atomic_load(cnt + 64 * u.pm, __ATOMIC_RELAXED, __HIP_MEMORY_SCOPE_AGENT)) < target) { __builtin_amdgcn_s_sleep(2); if (++sp > (1u << 18)) break; }
            __builtin_amdgcn_fence(__ATOMIC_ACQUIRE, "agent"); }
        asm volatile("s_waitcnt vmcnt(0) lgkmcnt(0)" ::: "memory"); __builtin_amdgcn_s_barrier(); asm volatile("" ::: "memory");
        if (lane < 32) { float* slot = xbuf + (size_t)(u.pm * BM + row) * 4; float t = 0.f;
#pragma unroll
            for (int k = 0; k < 4; ++k) t += __hip_atomic_load(slot + k, __ATOMIC_RELAXED, __HIP_MEMORY_SCOPE_AGENT);
            S[row] = t; }
        asm volatile("s_waitcnt lgkmcnt(0)" ::: "memory"); __builtin_amdgcn_s_barrier(); asm volatile("" ::: "memory");
    }
};
struct EpiNormRes {
    static constexpr bool PERM = false, AFTER_DRAIN = false, FUSED = true;
    float* x; bf16_t* hn; const float* gpost; const float* gpre; RowStats st1, st2; PG8_LAS unsigned char* xl;
    __device__ __forceinline__ void fused(f32x4 (&acc)[2][2][4][2], const Unit& u, int wr, int wc, int fr, int fq, int wid, int lane) const {
        typedef unsigned u32x2v __attribute__((ext_vector_type(2)));
        const PG8_LAS float* S = (const PG8_LAS float*)(xl + 4096);
        const int col0 = u.pn * BM + wc * 32 + 4 * fq;
        st1.run(acc, u, wr, wc, fr, fq, xl, wid, lane);
#pragma unroll
        for (int ai = 0; ai < 2; ++ai)
#pragma unroll
            for (int m = 0; m < 4; ++m) { const int r = ai * HALF + wr * 64 + m * 16 + fr; const float rstd = rsqrtf(S[r] * (1.0f / 1024.0f) + 1e-6f); const size_t off = (size_t)(u.pm * BM + r) * 1024 + col0;
#pragma unroll
                for (int bj = 0; bj < 2; ++bj)
#pragma unroll
                    for (int n = 0; n < 2; ++n) { const f32x4 xs = *(const f32x4*)(x + off + bj * HALF + n * 16); const f32x4 gv = *(const f32x4*)(gpost + col0 + bj * HALF + n * 16);
                        acc[ai][bj][m][n] = xs + (acc[ai][bj][m][n] * rstd) * gv; }
                asm volatile("" : "+v"(acc[ai][0][m][0]), "+v"(acc[ai][0][m][1]), "+v"(acc[ai][1][m][0]), "+v"(acc[ai][1][m][1]));
                if (m & 1) asm volatile("" ::: "memory"); }
        if (gpre) {
            st2.run(acc, u, wr, wc, fr, fq, xl, wid, lane);
#pragma unroll
            for (int ai = 0; ai < 2; ++ai)
#pragma unroll
                for (int m = 0; m < 4; ++m) { const int r = ai * HALF + wr * 64 + m * 16 + fr; const float rstd = rsqrtf(S[r] * (1.0f / 1024.0f) + 1e-6f); const size_t off = (size_t)(u.pm * BM + r) * 1024 + col0;
#pragma unroll
                    for (int bj = 0; bj < 2; ++bj)
#pragma unroll
                        for (int n = 0; n < 2; ++n) { const f32x4 x1 = acc[ai][bj][m][n]; *(f32x4*)(x + off + bj * HALF + n * 16) = x1;
                            const f32x4 gv = *(const f32x4*)(gpre + col0 + bj * HALF + n * 16); const f32x4 o = (x1 * rstd) * gv;
                            u32x2v w; w.x = cvt_pk_bf16(o[0], o[1]); w.y = cvt_pk_bf16(o[2], o[3]); *(u32x2v*)(hn + off + bj * HALF + n * 16) = w; }
                    asm volatile("" ::: "memory"); }
        } else {
#pragma unroll
            for (int ai = 0; ai < 2; ++ai)
#pragma unroll
                for (int m = 0; m < 4; ++m) { const int r = ai * HALF + wr * 64 + m * 16 + fr; const size_t off = (size_t)(u.pm * BM + r) * 1024 + col0;
#pragma unroll
                    for (int bj = 0; bj < 2; ++bj)
#pragma unroll
                        for (int n = 0; n < 2; ++n) *(f32x4*)(x + off + bj * HALF + n * 16) = acc[ai][bj][m][n]; }
        }
    }
};

template <class Epi, class Sched, bool ALIGN_EPI>
__device__ __forceinline__ void gemm_phase(PG8_LAS unsigned char* lds, const Gemm g, const Sched& S, const Epi& E, int tid0) {
    int tid_ = tid0; asm volatile("" : "+v"(tid_));
    const int tid = tid_, wid = __builtin_amdgcn_readfirstlane(tid >> 6), lane = tid & 63, wr = wid >> 2, wc = wid & 3, fr = lane & 15, fq = lane >> 4;
    const int K = g.K, nt = K / BK;
    unsigned voffA[2], voffB[2];
#pragma unroll
    for (int i = 0; i < 2; ++i) { int R, C; stage_rc(tid * 16 + i * 8192, R, C); const int Rb = Epi::PERM ? ((R & ~31) + perm32(R & 31)) : R;
        voffA[i] = (unsigned)(R * g.lda + C) * 2u; voffB[i] = (unsigned)(Rb * g.ldb + C) * 2u; }
    const size_t kstep = (size_t)(BK * 2);
    const size_t hstepA = (size_t)HALF * g.lda * 2, hstepB = (size_t)HALF * g.ldb * 2;
    const size_t tstepA = 2 * hstepA, tstepB = 2 * hstepB;
    const unsigned ldsw = (unsigned)wid * 1024u;
    const int aoff = lds_byte(wr * 64 + fr, fq * 8), boff = lds_byte(wc * 32 + fr, fq * 8);
#define PG8_SA(b, h) (((b) * 2 + (h)) * HTB)
#define PG8_SB(b, h) ((4 + (b) * 2 + (h)) * HTB)
#define PG8_STAGE(bufoff, gbase, voff) do { _Pragma("unroll") for (int _i = 0; _i < 2; ++_i) \
        __builtin_amdgcn_global_load_lds((const unsigned*)((const char*)(gbase) + (voff)[_i]), (PG8_LAS unsigned*)(lds + (bufoff) + ldsw + _i * 8192), 16, 0, 0); } while (0)
#define PG8_LDA(dst, b, h) do { _Pragma("unroll") for (int m = 0; m < 4; ++m) _Pragma("unroll") for (int k = 0; k < 2; ++k) dst[m][k] = *(const PG8_LAS bf16x8*)(lds + PG8_SA(b, h) + aoff + m * 2048 + k * 1024); } while (0)
#define PG8_LDB(dst, b, h) do { _Pragma("unroll") for (int n = 0; n < 2; ++n) _Pragma("unroll") for (int k = 0; k < 2; ++k) dst[n][k] = *(const PG8_LAS bf16x8*)(lds + PG8_SB(b, h) + boff + n * 2048 + k * 1024); } while (0)
#define PG8_MMA(ai, bj, At, Bt) do { __builtin_amdgcn_s_setprio(1); _Pragma("unroll") for (int m = 0; m < 4; ++m) _Pragma("unroll") for (int n = 0; n < 2; ++n) _Pragma("unroll") for (int k = 0; k < 2; ++k) \
        acc[ai][bj][m][n] = __builtin_amdgcn_mfma_f32_16x16x32_bf16(Bt[n][k], At[m][k], acc[ai][bj][m][n], 0, 0, 0); __builtin_amdgcn_s_setprio(0); } while (0)
#define PG8_WAIT_V(n) asm volatile("s_waitcnt vmcnt(" #n ")" ::: "memory")
#define PG8_WAIT_L(n) asm volatile("s_waitcnt lgkmcnt(" #n ")" ::: "memory")
#define PG8_BAR __builtin_amdgcn_s_barrier()
#define PG8_SCHED __builtin_amdgcn_sched_barrier(0)
    Unit cur, nxt; int ui = 0;
    if (!S.next(0, cur)) return;
    f32x4 acc[2][2][4][2];
#pragma unroll
    for (int a = 0; a < 2; ++a)
#pragma unroll
        for (int b = 0; b < 2; ++b)
#pragma unroll
            for (int m = 0; m < 4; ++m)
#pragma unroll
                for (int n = 0; n < 2; ++n) acc[a][b][m][n] = (f32x4){0.f, 0.f, 0.f, 0.f};
    bf16x8 At[4][2], B0[2][2], B1[2][2];
    const char* cA = (const char*)g.A + (size_t)cur.pm * tstepA + (size_t)(cur.pn >> 1) * (size_t)g.apn; const char* cB = (const char*)g.Bt + (size_t)cur.pn * tstepB;
    S.a_ready(cur);
    PG8_STAGE(PG8_SB(0, 0), cB, voffB); PG8_STAGE(PG8_SB(0, 1), cB + hstepB, voffB); PG8_STAGE(PG8_SA(0, 0), cA, voffA); PG8_STAGE(PG8_SA(0, 1), cA + hstepA, voffA);
    if (wr == 1) PG8_BAR;
    PG8_WAIT_V(2); PG8_BAR;
    PG8_STAGE(PG8_SB(1, 0), cB + kstep, voffB); PG8_STAGE(PG8_SA(1, 0), cA + kstep, voffA); PG8_STAGE(PG8_SB(1, 1), cB + hstepB + kstep, voffB);
    PG8_WAIT_V(6); PG8_BAR;
    for (;;) {
        const bool has_next = S.next(ui + 1, nxt);
        const char* nA = has_next ? (const char*)g.A + (size_t)nxt.pm * tstepA + (size_t)(nxt.pn >> 1) * (size_t)g.apn : cA; const char* nB = has_next ? (const char*)g.Bt + (size_t)nxt.pn * tstepB : cB;
        for (int t = 0; t < nt; t += 2) {
            const bool last = (t == nt - 2);
            const char* a1 = cA + (size_t)(t + 1) * kstep;
            const char* a2 = last ? nA : cA + (size_t)(t + 2) * kstep; const char* b2 = last ? nB : cB + (size_t)(t + 2) * kstep;
            const char* a3 = a2 + kstep; const char* b3 = b2 + kstep;
            if (last && has_next) S.a_ready(nxt);
            PG8_LDB(B0, 0, 0); PG8_LDB(B1, 0, 1); PG8_SCHED; PG8_LDA(At, 0, 0); PG8_STAGE(PG8_SA(1, 1), a1 + hstepA, voffA);
            PG8_WAIT_V(8); PG8_WAIT_L(0); PG8_BAR; PG8_MMA(0, 0, At, B0); PG8_MMA(0, 1, At, B1); PG8_BAR; PG8_SCHED;
            PG8_LDA(At, 0, 1); PG8_STAGE(PG8_SB(0, 0), b2, voffB); PG8_STAGE(PG8_SB(0, 1), b2 + hstepB, voffB); PG8_STAGE(PG8_SA(0, 0), a2, voffA);
            PG8_WAIT_V(8); PG8_WAIT_L(0); PG8_BAR; PG8_MMA(1, 0, At, B0); PG8_MMA(1, 1, At, B1); PG8_BAR; PG8_SCHED;
            PG8_LDB(B0, 1, 0); PG8_LDB(B1, 1, 1); PG8_SCHED; PG8_LDA(At, 1, 0); PG8_STAGE(PG8_SA(0, 1), a2 + hstepA, voffA);
            PG8_WAIT_V(8); PG8_WAIT_L(0); PG8_BAR; PG8_MMA(0, 0, At, B0); PG8_MMA(0, 1, At, B1); PG8_BAR; PG8_SCHED;
            PG8_LDA(At, 1, 1); PG8_STAGE(PG8_SB(1, 0), b3, voffB); PG8_STAGE(PG8_SB(1, 1), b3 + hstepB, voffB); PG8_STAGE(PG8_SA(1, 0), a3, voffA);
            PG8_WAIT_V(8); PG8_WAIT_L(0); PG8_BAR; PG8_MMA(1, 0, At, B0); PG8_MMA(1, 1, At, B1); PG8_BAR; PG8_SCHED;
        }
        if constexpr (ALIGN_EPI) { if (wr == 0) PG8_BAR; }
        if constexpr (Epi::FUSED) E.fused(acc, cur, wr, wc, fr, fq, wid, lane); else E(acc, cur, wr, wc, fr, fq);
        S.done(cur);
        if (!has_next) break;
#pragma unroll
        for (int a = 0; a < 2; ++a)
#pragma unroll
            for (int b = 0; b < 2; ++b)
#pragma unroll
                for (int m = 0; m < 4; ++m)
#pragma unroll
                    for (int n = 0; n < 2; ++n) acc[a][b][m][n] = (f32x4){0.f, 0.f, 0.f, 0.f};
        cur = nxt; cA = nA; cB = nB; ++ui;
        if constexpr (ALIGN_EPI) { if (wr == 1) PG8_BAR; }
    }
    PG8_WAIT_V(0);
    if constexpr (!ALIGN_EPI) { if (wr == 0) PG8_BAR; }
    PG8_BAR;
#undef PG8_SA
#undef PG8_SB
#undef PG8_STAGE
#undef PG8_LDA
#undef PG8_LDB
#undef PG8_MMA
#undef PG8_WAIT_V
#undef PG8_WAIT_L
#undef PG8_BAR
#undef PG8_SCHED
}
}
namespace att {
typedef unsigned short u16;
typedef short bf16x8 __attribute__((ext_vector_type(8)));
typedef short s16x4 __attribute__((ext_vector_type(4)));
typedef float f32x16 __attribute__((ext_vector_type(16)));
typedef float f32x4 __attribute__((ext_vector_type(4)));
typedef unsigned u32x4 __attribute__((ext_vector_type(4)));
constexpr int SEQ = 16384, NW = 8, QBLK = 32, KVBLK = 64, QB = NW * QBLK;
constexpr int LDQ = 1536, LDK = 2048, LDKR = 64, LDO = 1024;
#ifndef ATT_NQREG
#define ATT_NQREG 4
#endif
constexpr int NQREG = ATT_NQREG, NQREG_L = 8 - NQREG;
constexpr int SHM_V = KVBLK * 128 * 2, SHM_K = KVBLK * 128 * 2, SHM_KR = KVBLK * 64 * 2;
constexpr int OFF_V = 0, OFF_K = 2 * SHM_V, OFF_KR = OFF_K + 2 * SHM_K, OFF_WS = OFF_KR + 2 * SHM_KR, OFF_QR = OFF_WS + NW * 64 * 4, QR_WAVE = (NQREG_L + 4) * 1024, LDS_BYTES = OFF_QR + NW * QR_WAVE;
constexpr float SCALE = 0.07216878364870322f;
constexpr float THR = 8.f;

#define KSWZ(row, colB) ((row) * 256 + ((colB) ^ (((row) & 7) << 4)))
#define KRSWZ(row, colB) ((row) * 128 + ((colB) ^ (((row) & 7) << 4)))
#define SBAR() __builtin_amdgcn_sched_barrier(0)
__device__ __forceinline__ int v_st(int k, int c) { const int kk = (k & ~0xC) | ((k & 4) << 1) | ((k & 8) >> 1); return ((kk >> 3) * 4 + (c >> 5)) * 512 + ((kk & 7) * 32 + (c & 31)) * 2; }
__device__ __forceinline__ int v_rd_base(int lane) { return ((lane & 3) << 3) | (((lane >> 2) & 3) << 6) | (((lane >> 4) & 1) << 5) | (((lane >> 5) & 1) << 8); }
constexpr int v_rd_off(int d0, int ks, int half) { return d0 * 512 + ks * 4096 + half * 2048; }
__device__ __forceinline__ int crow(int r, int hi) { return (r & 3) + 8 * (r >> 2) + 4 * hi; }
__device__ __forceinline__ unsigned cvtpk(float lo, float hi) { unsigned r; asm volatile("v_cvt_pk_bf16_f32 %0, %1, %2" : "=v"(r) : "v"(lo), "v"(hi)); return r; }
__device__ __forceinline__ bf16x8 load8(const u16* p) { return *reinterpret_cast<const bf16x8*>(p); }
__device__ __forceinline__ void mask_tile(f32x16& p0, f32x16& p1, int dq, unsigned W) {
    const float NEG = -__builtin_inff();
#pragma unroll
    for (int r = 0; r < 16; ++r) {
        const int c = (r & 3) + 8 * (r >> 2);
        if ((unsigned)(dq - c) >= W) p0[r] = NEG;
        if ((unsigned)(dq - c - 32) >= W) p1[r] = NEG;
    }
}
__device__ __forceinline__ void partialSM(f32x16& p0, f32x16& p1, float& m_reg, float& mn, float& alpha) {
    float pmax = p0[0]; for (int r = 1; r < 16; ++r) pmax = fmaxf(pmax, p0[r]); for (int r = 0; r < 16; ++r) pmax = fmaxf(pmax, p1[r]);
    { auto rr = __builtin_amdgcn_permlane32_swap(__float_as_uint(pmax), __float_as_uint(pmax), false, false);
      pmax = fmaxf(__uint_as_float(rr[0]), __uint_as_float(rr[1])); }
    constexpr float C2 = 1.4426950408889634f * SCALE;
    if (__builtin_expect(__all((pmax - m_reg) * SCALE <= THR), 1)) { mn = m_reg; alpha = 1.f; }
    else { mn = fmaxf(m_reg, pmax); alpha = __builtin_amdgcn_exp2f((m_reg - mn) * C2); m_reg = mn; }
    const float mnL = -mn * C2;
    for (int r = 0; r < 16; ++r) p0[r] = fmaf(p0[r], C2, mnL); for (int r = 0; r < 16; ++r) p1[r] = fmaf(p1[r], C2, mnL);
    for (int r = 0; r < 16; ++r) p0[r] = __builtin_amdgcn_exp2f(p0[r]);
}
__device__ __forceinline__ void finishSM(f32x16& p0, f32x16& p1, float alpha, float& l_reg, bf16x8& pa0, bf16x8& pa1, bf16x8& pa2, bf16x8& pa3) {
    for (int r = 0; r < 16; ++r) p1[r] = __builtin_amdgcn_exp2f(p1[r]);
    float ps = 0; for (int r = 0; r < 16; ++r) ps += p0[r]; for (int r = 0; r < 16; ++r) ps += p1[r];
    { auto rr = __builtin_amdgcn_permlane32_swap(__float_as_uint(ps), __float_as_uint(ps), false, false);
      ps = __uint_as_float(rr[0]) + __uint_as_float(rr[1]); }
    l_reg = l_reg * alpha + ps;
#define PK4(P, B_, OUT) do { unsigned a0 = cvtpk(P[B_+0], P[B_+1]), a1 = cvtpk(P[B_+2], P[B_+3]);                          \
        unsigned b0 = cvtpk(P[B_+4], P[B_+5]), b1 = cvtpk(P[B_+6], P[B_+7]);                                             \
        auto r0 = __builtin_amdgcn_permlane32_swap(a0, b0, false, false); auto r1 = __builtin_amdgcn_permlane32_swap(a1, b1, false, false); \
        u32x4 w = {r0[0], r1[0], r0[1], r1[1]}; OUT = *reinterpret_cast<bf16x8*>(&w); } while (0)
    PK4(p0, 0, pa0); PK4(p0, 8, pa1); PK4(p1, 0, pa2); PK4(p1, 8, pa3);
#undef PK4
}
template <int KB>
__device__ __forceinline__ void qkt(f32x16& p0, f32x16& p1, const char* K_lds, const char* KR_lds, const bf16x8* qrl, int r32, int hi, const bf16x8* qr) {
    p0 = f32x16{}; p1 = f32x16{};
    __builtin_amdgcn_s_setprio(1);
    const char* kb[4];
#pragma unroll
    for (int dd = 0; dd < 4; ++dd) kb[dd] = K_lds + KB * SHM_K + KSWZ(r32, (dd * 16 + hi * 8) * 2);
#pragma unroll
    for (int d0 = 0; d0 < 8; ++d0) { const char* a = kb[d0 & 3] + (d0 >> 2) * 128;
        bf16x8 b0 = *reinterpret_cast<const bf16x8*>(a);
        bf16x8 b1 = *reinterpret_cast<const bf16x8*>(a + 32 * 256);
        bf16x8 q; if (d0 < NQREG) q = qr[d0]; else q = qrl[(d0 - NQREG) * 64];
        p0 = __builtin_amdgcn_mfma_f32_32x32x16_bf16(b0, q, p0, 0, 0, 0);
        p1 = __builtin_amdgcn_mfma_f32_32x32x16_bf16(b1, q, p1, 0, 0, 0); }
#pragma unroll
    for (int d = 0; d < 4; ++d) { const char* a = KR_lds + KB * SHM_KR + KRSWZ(r32, (d * 16 + hi * 8) * 2);
        bf16x8 b0 = *reinterpret_cast<const bf16x8*>(a);
        bf16x8 b1 = *reinterpret_cast<const bf16x8*>(a + 32 * 128);
        bf16x8 q = qrl[(NQREG_L + d) * 64];
        p0 = __builtin_amdgcn_mfma_f32_32x32x16_bf16(b0, q, p0, 0, 0, 0);
        p1 = __builtin_amdgcn_mfma_f32_32x32x16_bf16(b1, q, p1, 0, 0, 0); }
    __builtin_amdgcn_s_setprio(0);
}
template <int VB>
__device__ __forceinline__ void pv_tile(f32x16* o, int vb0, bf16x8 pa0, bf16x8 pa1, bf16x8 pa2, bf16x8 pa3) {
#define TRRD(dst, off) asm volatile("ds_read_b64_tr_b16 %0, %1 offset:%2" : "=&v"(dst) : "v"(vb0), "i"(off) : "memory")
#define PV_D0(d0) do { s16x4 l0, l1, l2, l3, h0, h1, h2, h3; constexpr int b_ = OFF_V + VB * SHM_V + v_rd_off(d0, 0, 0); \
        TRRD(l0, b_); TRRD(h0, b_ + 2048); TRRD(l1, b_ + 4096); TRRD(h1, b_ + 6144); TRRD(l2, b_ + 8192); TRRD(h2, b_ + 10240); TRRD(l3, b_ + 12288); TRRD(h3, b_ + 14336); \
        asm volatile("s_waitcnt lgkmcnt(0)" ::: "memory"); SBAR();   \
        o[d0] = __builtin_amdgcn_mfma_f32_32x32x16_bf16(pa0, (bf16x8){l0[0], l0[1], l0[2], l0[3], h0[0], h0[1], h0[2], h0[3]}, o[d0], 0, 0, 0);   \
        o[d0] = __builtin_amdgcn_mfma_f32_32x32x16_bf16(pa1, (bf16x8){l1[0], l1[1], l1[2], l1[3], h1[0], h1[1], h1[2], h1[3]}, o[d0], 0, 0, 0);   \
        o[d0] = __builtin_amdgcn_mfma_f32_32x32x16_bf16(pa2, (bf16x8){l2[0], l2[1], l2[2], l2[3], h2[0], h2[1], h2[2], h2[3]}, o[d0], 0, 0, 0);   \
        o[d0] = __builtin_amdgcn_mfma_f32_32x32x16_bf16(pa3, (bf16x8){l3[0], l3[1], l3[2], l3[3], h3[0], h3[1], h3[2], h3[3]}, o[d0], 0, 0, 0); } while (0)
    __builtin_amdgcn_s_setprio(1); PV_D0(0); PV_D0(1); PV_D0(2); PV_D0(3); __builtin_amdgcn_s_setprio(0);
#undef PV_D0
#undef TRRD
}

struct BlockRef { const u16* Q; const u16* K; const u16* V; const u16* KR; u16* O; int P0; };
struct Seam { bf16x8 st_v0, st_v1; };
#define ROWK(p, k0, rr) ((p) + (size_t)((k0) + (rr)) * LDK + sc)
#define VMW() asm volatile("s_waitcnt vmcnt(0)" ::: "memory")
#define VMWN(n) asm volatile("s_waitcnt vmcnt(%0)" :: "i"(n) : "memory")
#define ATT_LAS __attribute__((address_space(3)))
#define SLOAD_H(Kp, Vp, KRp, k0, bf) do { S.st_v0 = load8(ROWK(Vp, k0, sr)); S.st_v1 = load8(ROWK(Vp, k0, 32 + sr));              \
        __builtin_amdgcn_global_load_lds((const unsigned*)((Kp) + (size_t)((k0) + sr) * LDK + ksc), (ATT_LAS unsigned*)(ldsL + OFF_K + (bf) * SHM_K + wid * 1024), 16, 0, 0); \
        __builtin_amdgcn_global_load_lds((const unsigned*)((Kp) + (size_t)((k0) + 32 + sr) * LDK + ksc), (ATT_LAS unsigned*)(ldsL + OFF_K + (bf) * SHM_K + 8192 + wid * 1024), 16, 0, 0); \
        __builtin_amdgcn_global_load_lds((const unsigned*)((KRp) + (size_t)((k0) + krr) * LDKR + krsc), (ATT_LAS unsigned*)(ldsL + OFF_KR + (bf) * SHM_KR + wid * 1024), 16, 0, 0); } while (0)
#define SWRITE_HK(bf) do { } while (0)
#define SWRITE_HV(bf) do { *(bf16x8*)(V_lds + (bf) * SHM_V + vst0) = S.st_v0; *(bf16x8*)(V_lds + (bf) * SHM_V + vst1) = S.st_v1; } while (0)
#define SWRITE_H(bf) do { SWRITE_HV(bf); SWRITE_HK(bf); } while (0)
__device__ __forceinline__ void attn_prime(const BlockRef& cur, char* lds, Seam& S, int tid0) {
    int tid_ = tid0; asm volatile("" : "+v"(tid_));
    const int tid = tid_, wid = __builtin_amdgcn_readfirstlane(tid >> 6), lane = tid & 63, r32 = lane & 31, hi = lane >> 5;
    const int sr = tid >> 4, sc = (tid & 15) * 8, ksc = ((tid & 15) ^ (sr & 7)) * 8;
    const int krr = tid >> 3, krsc = ((tid & 7) ^ (krr & 7)) * 8; ATT_LAS unsigned char* ldsL = (ATT_LAS unsigned char*)lds;
    SLOAD_H(cur.K, cur.V, cur.KR, 0, 0); VMW();
    __syncthreads();
}
__device__ __forceinline__ void attn_block(const BlockRef& cur, const BlockRef& nxt, char* lds, Seam& S, int tid0) {
    int tid_ = tid0; asm volatile("" : "+v"(tid_));
    const int tid = tid_, wid = __builtin_amdgcn_readfirstlane(tid >> 6), lane = tid & 63, r32 = lane & 31, hi = lane >> 5;
    const unsigned W = 0x40000000u;
    const int NT = (cur.P0 + QB - 1) / KVBLK + 1;
    const int qlo = cur.P0 + wid * QBLK, qm = qlo + r32 - 4 * hi;
    char* V_lds = lds + OFF_V; char* K_lds = lds + OFF_K; char* KR_lds = lds + OFF_KR;
    float* ws = (float*)(lds + OFF_WS) + wid * 64; float* li_l = ws, * al_l = ws + 32;
    bf16x8* qrl = (bf16x8*)(lds + OFF_QR + wid * QR_WAVE) + lane;
    float m_reg = -1e30f, l_reg = 0; f32x16 o[4] = {};
    const int sr = tid >> 4, sc = (tid & 15) * 8, vst0 = v_st(sr, sc), vst1 = v_st(32 + sr, sc), ksc = ((tid & 15) ^ (sr & 7)) * 8;
    const int krr = tid >> 3, krsc = ((tid & 7) ^ (krr & 7)) * 8; ATT_LAS unsigned char* ldsL = (ATT_LAS unsigned char*)lds;
    const int vb0 = (int)(uintptr_t)lds + v_rd_base(lane);
    const u16* Kh = cur.K; const u16* Vh = cur.V; const u16* KRh = cur.KR;
#define RESC(a) do { if (__any((a) < 1.f)) { if (hi == 0) al_l[r32] = (a); asm volatile("s_waitcnt lgkmcnt(0)" ::: "memory");              \
                     for (int d_ = 0; d_ < 4; ++d_) for (int r = 0; r < 16; ++r) o[d_][r] *= al_l[crow(r, hi)]; } } while (0)
#define KBASE(t) ((t) * KVBLK)
#define MASKT(P0_, P1_, t) do { const int kb_ = KBASE(t); if (kb_ + KVBLK - 1 > qlo) mask_tile(P0_, P1_, qm - kb_, W); } while (0)
#define SEAM_K0() do { VMW(); SWRITE_HK(0); SBAR(); } while (0)
    f32x16 pA0, pA1, pB0, pB1; float mnA, mnB, alA, alB; bf16x8 pa0, pa1, pa2, pa3;
    bf16x8 qr[NQREG > 0 ? NQREG : 1];
    { const u16* qp = cur.Q + (size_t)(wid * QBLK + r32) * LDQ + hi * 8;
#pragma unroll
      for (int d = 0; d < NQREG_L + 4; ++d) qrl[d * 64] = load8(qp + (NQREG + d) * 16);
#pragma unroll
      for (int d0 = 0; d0 < NQREG; ++d0) qr[d0] = load8(qp + d0 * 16); }
    SWRITE_HV(0); SBAR();
    if (NT > 1) SLOAD_H(Kh, Vh, KRh, KBASE(1), 1);
    SBAR(); qkt<0>(pA0, pA1, K_lds, KR_lds, qrl, r32, hi, qr);
    MASKT(pA0, pA1, 0); partialSM(pA0, pA1, m_reg, mnA, alA);
    if (NT > 1) { VMW(); SWRITE_H(1); }
    __syncthreads();
#define HALF_STEP(PX0, PX1, mnX, alX, PY0, PY1, alY, t, KB, VB, SB) do {                                                      \
        SBAR(); qkt<KB>(PX0, PX1, K_lds, KR_lds, qrl, r32, hi, qr);                                                          \
        finishSM(PY0, PY1, alY, l_reg, pa0, pa1, pa2, pa3); SBAR();                                                           \
        if ((t) + 1 < NT) { SLOAD_H(Kh, Vh, KRh, KBASE((t) + 1), SB); SBAR(); }                                                   \
        pv_tile<VB>(o, vb0, pa0, pa1, pa2, pa3); MASKT(PX0, PX1, (t)); partialSM(PX0, PX1, m_reg, mnX, alX);                  \
        __syncthreads();                                                                                                      \
        if ((t) + 1 < NT) { VMW(); SWRITE_H(SB); }                                                                            \
        RESC(alX); __syncthreads(); } while (0)
    for (int t = 1; t + 1 < NT; t += 2) {
        HALF_STEP(pB0, pB1, mnB, alB, pA0, pA1, alA, t, 1, 0, 0);
        HALF_STEP(pA0, pA1, mnA, alA, pB0, pB1, alB, t + 1, 0, 1, 1);
    }
    const bool even = (NT & 1) == 0;
    if (even) { SBAR(); qkt<1>(pB0, pB1, K_lds, KR_lds, qrl, r32, hi, qr); SBAR(); }
    SLOAD_H(nxt.K, nxt.V, nxt.KR, 0, 0); SBAR();
    finishSM(pA0, pA1, alA, l_reg, pa0, pa1, pa2, pa3); SBAR();
    pv_tile<0>(o, vb0, pa0, pa1, pa2, pa3);
    if (even) { MASKT(pB0, pB1, NT - 1); partialSM(pB0, pB1, m_reg, mnB, alB); __syncthreads(); RESC(alB);
        finishSM(pB0, pB1, alB, l_reg, pa0, pa1, pa2, pa3); SBAR(); pv_tile<1>(o, vb0, pa0, pa1, pa2, pa3); }
    SBAR(); SEAM_K0();
    if (hi == 0) li_l[r32] = l_reg; asm volatile("s_waitcnt lgkmcnt(0)" ::: "memory");
    float rli[16];
#pragma unroll
    for (int r = 0; r < 16; ++r) rli[r] = __builtin_amdgcn_rcpf(li_l[crow(r, hi)]);
    u16* Ow = cur.O + (size_t)(wid * QBLK) * LDO;
#pragma unroll
    for (int r = 0; r < 16; ++r) { const int orow = crow(r, hi);
#pragma unroll
        for (int d0 = 0; d0 < 4; ++d0) { const float v = o[d0][r] * rli[r];
            const float vn = xor1f(v);
            if ((r32 & 1) == 0) *(unsigned*)(Ow + (size_t)orow * LDO + d0 * 32 + r32) = cvtpk(v, vn); } }
    __syncthreads();
#undef RESC
#undef KBASE
#undef MASKT
#undef SEAM_K0
#undef HALF_STEP
}
struct Tensors { const u16* q; const u16* kv; const u16* kr; u16* o; };
__device__ __forceinline__ BlockRef make_ref(const Tensors& T, int L, int pass) {
    const int bh = (L & 7) + 8 * (L >> 8), x = (L >> 3) & 31, b = bh >> 3, h = bh & 7, qb = pass ? 63 - x : x;
    BlockRef r; const size_t row0 = (size_t)b * SEQ;
    r.Q = T.q + (row0 + (size_t)qb * QB) * LDQ + h * 192; r.K = T.kv + row0 * LDK + h * 256; r.V = r.K + 128; r.KR = T.kr + row0 * LDKR;
    r.O = T.o + (row0 + (size_t)qb * QB) * LDO + h * 128; r.P0 = qb * QB;
    return r;
}
__device__ __forceinline__ void attn_phase(char* lds, const Tensors& T, int tid0) {
    const int total = 512, stride = gridDim.x;
    int L = blockIdx.x; if (L >= total) return;
    int pass = 0;
    BlockRef cur = make_ref(T, L, 0);
    Seam S;
    attn_prime(cur, lds, S, tid0);
    for (;;) {
        const bool more_pass = pass == 0, more_item = L + stride < total, last = !more_pass && !more_item;
        int passn = pass + 1, Ln = L;
        if (!more_pass) { passn = 0; Ln = more_item ? L + stride : L; }
        const BlockRef nxt = last ? cur : make_ref(T, Ln, passn);
        attn_block(cur, nxt, lds, S, tid0);
        if (last) break;
        cur = nxt; pass = passn; L = Ln;
    }
}
#undef ROWK
#undef VMW
#undef VMWN
#undef SLOAD_H
#undef SWRITE_HK
#undef SWRITE_HV
#undef SWRITE_H
#undef SBAR
}
namespace xb {
#define LAS __attribute__((address_space(3)))
#define XB_TMO      128
#define XB_XCNT(j)  (256  + 64 * (j))
#define XB_XSUB(j)  (1280 + 64 * (j))
#define XB_XGEN(j)  (2304 + 64 * (j))
#define XB_TOP      3328
#define XB_TOPGEN   3392
#define XCD_BAR_WORDS 3456
#define XB_SPIN_CAP (1u << 18)

__device__ __forceinline__ unsigned xb_ld(unsigned* p)              { return __hip_atomic_load(p, __ATOMIC_RELAXED, __HIP_MEMORY_SCOPE_AGENT); }
__device__ __forceinline__ unsigned xb_add(unsigned* p, unsigned v) { return __hip_atomic_fetch_add(p, v, __ATOMIC_RELAXED, __HIP_MEMORY_SCOPE_AGENT); }
__device__ __forceinline__ unsigned xb_xcc_id() { return (unsigned)__builtin_amdgcn_s_getreg((3 << 11) | 20) & 0xFu; }
#define XB_SPIN(cond, bar) do { unsigned _sp = 0; while (cond) { __builtin_amdgcn_s_sleep(1); \
    if ((++_sp & 255u) == 0u) { if (xb_ld(&(bar)[XB_TMO])) break; if (_sp > XB_SPIN_CAP) { atomicAdd(&(bar)[XB_TMO], 1u); break; } } } } while (0)

struct XcdBarrier {
    unsigned* bar; unsigned x;
    volatile LAS unsigned* st;
};

__device__ __forceinline__ XcdBarrier xcd_barrier_post(unsigned* bar, volatile LAS unsigned* st) {
    XcdBarrier b; b.bar = bar; b.x = xb_xcc_id(); b.st = st;
    if (threadIdx.x == 0) (void)xb_add(&bar[XB_XCNT(b.x)], 1u);
    return b;
}
__device__ __forceinline__ void xcd_barrier_complete(unsigned* bar, unsigned x, unsigned& nloc, unsigned& nx) {
    const unsigned G = gridDim.x * gridDim.y * gridDim.z;
    unsigned sum, cnt, mine, sp = 0u;
    for (;;) {
        sum = 0u; cnt = 0u; mine = 0u;
#pragma unroll
        for (unsigned j = 0; j < 16; ++j) { const unsigned c = xb_ld(&bar[XB_XCNT(j)]); sum += c; cnt += (c > 0u) ? 1u : 0u; mine = (j == x) ? c : mine; }
        if (sum == G) break;
        __builtin_amdgcn_s_sleep(1);
        if ((++sp & 255u) == 0u) { if (xb_ld(&bar[XB_TMO])) break; if (sp > XB_SPIN_CAP) { atomicAdd(&bar[XB_TMO], 1u); break; } }
    }
    nloc = mine > 0u ? mine : 1u; nx = cnt > 0u ? cnt : 1u;
}

__device__ __forceinline__ void xcd_barrier(const XcdBarrier& b, bool t0  ) {
    asm volatile("s_waitcnt vmcnt(0)" ::: "memory");
    __syncthreads();
    if (t0) {
        unsigned* bar = b.bar;
        __builtin_amdgcn_s_waitcnt(0);
        unsigned nloc = b.st[0], nx = b.st[1];
        if (nloc == 0u) { xcd_barrier_complete(bar, b.x, nloc, nx); b.st[0] = nloc; b.st[1] = nx; }
        const unsigned old = xb_add(&bar[XB_XSUB(b.x)], 1u);
        const unsigned gen = old / nloc;
        if (old + 1u == (gen + 1u) * nloc) {
            __builtin_amdgcn_fence(__ATOMIC_RELEASE, "agent");
            asm volatile("s_waitcnt vmcnt(0)" ::: "memory");
            const unsigned og = xb_add(&bar[XB_TOP], 1u);
            const unsigned tg = og / nx;
            if (og + 1u == (tg + 1u) * nx) xb_add(&bar[XB_TOPGEN], 1u);
            else XB_SPIN(xb_ld(&bar[XB_TOPGEN]) == tg, bar);
            __builtin_amdgcn_fence(__ATOMIC_ACQUIRE, "agent");
            xb_add(&bar[XB_XGEN(b.x)], 1u);
            asm volatile("s_waitcnt vmcnt(0)" ::: "memory");
        } else {
            XB_SPIN(xb_ld(&bar[XB_XGEN(b.x)]) == gen, bar);
            __builtin_amdgcn_fence(__ATOMIC_ACQUIRE, "agent");
            asm volatile("s_waitcnt vmcnt(0)" ::: "memory");
        }
    }
    __syncthreads();
}
#undef LAS
}
#ifndef PROBE_ATT_REPS
#define PROBE_ATT_REPS 1
#endif
#ifndef PROBE_SYNC_REPS
#define PROBE_SYNC_REPS 1
#endif
#ifndef PROBE_THIN_REPS
#define PROBE_THIN_REPS 1
#endif
#ifndef PROBE_PRO_REPS
#define PROBE_PRO_REPS 1
#endif
#ifndef PROBE_GEMM_REPS
#define PROBE_GEMM_REPS 1
#endif
namespace mk {
typedef unsigned short u16;
typedef float f32x4 __attribute__((ext_vector_type(4)));
constexpr int M = 32768, D = 1024, SEQ = 16384;
constexpr float EPS = 1e-6f;
constexpr size_t MB = (size_t)1 << 20;
__host__ __device__ constexpr size_t WT_MLA(int j) { return (size_t)j * 6 * MB; }
__host__ __device__ constexpr size_t WT_LRU(int j) { return 12 * MB + (size_t)j * 8 * MB; }
__host__ __device__ constexpr size_t WT_FFN(int l) { return 28 * MB + (size_t)l * 16 * MB; }
constexpr size_t OFF_UQ = 3 * MB / 2, OFF_UKV = 11 * MB / 4, OFF_WO = 15 * MB / 4, OFF_GT = 4 * MB, OFF_LOUT = 5 * MB, OFF_DOWN = 8 * MB;
constexpr size_t WS_COS = 96 * MB, WS_SIN = 100 * MB, WS_SA = 104 * MB, WS_SB = 105 * MB;
constexpr size_t WS_HN = 112 * MB, WS_Y = 176 * MB, WS_U = 240 * MB, WS_END = 496 * MB;
constexpr size_t U_PROJ = 0, U_CQ = 48 * MB, U_CKV = 72 * MB, U_KR = 88 * MB, U_Q = 96 * MB, U_O = 192 * MB;
constexpr size_t U_GATE = 0, U_XC = 64 * MB, U_REC = 128 * MB, U_B = 128 * MB;
constexpr int SCAN_L = 128, SCAN_NC = SEQ / SCAN_L;

__device__ __forceinline__ unsigned f2bf(float f) { unsigned u = __float_as_uint(f); return (u + 0x7fffu + ((u >> 16) & 1u)) >> 16; }
__device__ __forceinline__ unsigned pk2(float lo, float hi) { return f2bf(lo) | (f2bf(hi) << 16); }
__device__ __forceinline__ float bflo(unsigned w) { return __uint_as_float(w << 16); }
__device__ __forceinline__ float bfhi(unsigned w) { return __uint_as_float(w & 0xffff0000u); }
__device__ __forceinline__ float bf1(u16 h) { return __uint_as_float(((unsigned)h) << 16); }
__device__ __forceinline__ float wave_sum(float v) {
    v += xor1f(v); v += xor2f(v); v += xor4f(v); v += xor8f(v); v += xor16f(v);
    return sum32f(v);
}
__device__ __forceinline__ void transpose_item(const float* W, int ldw, u16* WT, int ldt, int nblk, float* scr, int item, int lane) {
    const int kb = item / nblk, nb = item % nblk, k0 = 64 * kb, n0 = 32 * nb;
#pragma unroll 8
    for (int i = 0; i < 32; ++i) { const int kk = 2 * i + (lane >> 5); scr[kk * 33 + (lane & 31)] = W[(size_t)(k0 + kk) * ldw + n0 + (lane & 31)]; }
    asm volatile("s_waitcnt lgkmcnt(0)" ::: "memory");
    const int c = lane & 7;
#pragma unroll
    for (int j = 0; j < 4; ++j) { const int n = (lane >> 3) + 8 * j; const float* s = scr + (8 * c) * 33 + n;
        uint4 o; o.x = pk2(s[0 * 33], s[1 * 33]); o.y = pk2(s[2 * 33], s[3 * 33]); o.z = pk2(s[4 * 33], s[5 * 33]); o.w = pk2(s[6 * 33], s[7 * 33]);
        *(uint4*)(WT + (size_t)(n0 + n) * ldt + k0 + 8 * c) = o; }
    asm volatile("s_waitcnt lgkmcnt(0)" ::: "memory");
}
struct Params { const float* in[23]; float* out; unsigned char* ws; };
enum { I_X = 0, I_POS, I_MIXPRE, I_MIXPOST, I_FFNPRE, I_FFNPOST, I_MLA_WIN, I_MLA_QN, I_MLA_KVN, I_MLA_WUQ, I_MLA_WUKV, I_MLA_WO,
       I_LRU_WIN, I_LRU_CW, I_LRU_CB, I_LRU_WA, I_LRU_BA, I_LRU_WX, I_LRU_BX, I_LRU_LAM, I_LRU_WOUT, I_FFN_UP, I_FFN_DOWN };

__device__ __forceinline__ void prologue_weights(const __attribute__((address_space(4))) Params& p, float* scr, int gw, int NGW, int lane) {
    u16* wt = (u16*)p.ws;
    constexpr int IT_MLA = 352 + 288 + 256 + 512, IT_LRU = 1024 + 128 + 512, IT_FFN = 4096, TOTAL = 2 * IT_MLA + 2 * IT_LRU + 4 * IT_FFN;
    for (int it = gw; it < TOTAL; it += NGW) {
        int r = it; const float* W; int ldw, ldt, nblk; u16* WT;
        if (r < 2 * IT_MLA) { const int j = r / IT_MLA; r -= j * IT_MLA; u16* base = wt + WT_MLA(j) / 2;
            if (r < 352) { W = p.in[I_MLA_WIN] + (size_t)j * 1024 * 704; ldw = 704; nblk = 22; WT = base; ldt = 1024; }
            else if (r < 640) { r -= 352; W = p.in[I_MLA_WUQ] + (size_t)j * 384 * 1536; ldw = 1536; nblk = 48; WT = base + OFF_UQ / 2; ldt = 384; }
            else if (r < 896) { r -= 640; W = p.in[I_MLA_WUKV] + (size_t)j * 256 * 2048; ldw = 2048; nblk = 64; WT = base + OFF_UKV / 2; ldt = 256; }
            else { r -= 896; W = p.in[I_MLA_WO] + (size_t)j * 1024 * 1024; ldw = 1024; nblk = 32; WT = base + OFF_WO / 2; ldt = 1024; }
        } else if (r < 2 * IT_MLA + 2 * IT_LRU) { r -= 2 * IT_MLA; const int j = r / IT_LRU; r -= j * IT_LRU; u16* base = wt + WT_LRU(j) / 2;
            if (r < 1024) { W = p.in[I_LRU_WIN] + (size_t)j * 1024 * 2048; ldw = 2048; nblk = 64; WT = base; ldt = 1024; }
            else if (r < 1152) { r -= 1024; const int which = r >> 3, gt = which >> 3, n = which & 7; r &= 7;
                W = p.in[gt ? I_LRU_WX : I_LRU_WA] + (size_t)j * 8 * 128 * 128 + (size_t)n * 128 * 128; ldw = 128; nblk = 4;
                WT = base + OFF_GT / 2 + (size_t)(n * 256 + gt * 128) * 256 + 128 * (n & 1); ldt = 256; }
            else { r -= 1152; W = p.in[I_LRU_WOUT] + (size_t)j * 1024 * 1024; ldw = 1024; nblk = 32; WT = base + OFF_LOUT / 2; ldt = 1024; }
        } else { r -= 2 * IT_MLA + 2 * IT_LRU; const int l = r / IT_FFN; r -= l * IT_FFN; u16* base = wt + WT_FFN(l) / 2;
            if (r < 2048) { W = p.in[I_FFN_UP] + (size_t)l * 1024 * 4096; ldw = 4096; nblk = 128; WT = base; ldt = 1024; }
            else { r -= 2048; W = p.in[I_FFN_DOWN] + (size_t)l * 4096 * 1024; ldw = 1024; nblk = 32; WT = base + OFF_DOWN / 2; ldt = 4096; }
        }
        transpose_item(W, ldw, WT, ldt, nblk, scr, r, lane);
    }
}
__device__ __forceinline__ void rowop(const u16* y, const float* xin, float* xout, u16* hn, const float* gpost, const float* gpre, int gw, int NGW, int lane) {
    f32x4 gp[4], gq[4];
#pragma unroll
    for (int j = 0; j < 4; ++j) { gp[j] = gpost ? *(const f32x4*)(gpost + j * 256 + lane * 4) : (f32x4){0.f, 0.f, 0.f, 0.f}; gq[j] = gpre ? *(const f32x4*)(gpre + j * 256 + lane * 4) : (f32x4){0.f, 0.f, 0.f, 0.f}; }
    for (int row = gw; row < M; row += NGW) {
        f32x4 xv[4];
#pragma unroll
        for (int j = 0; j < 4; ++j) xv[j] = *(const f32x4*)(xin + (size_t)row * D + j * 256 + lane * 4);
        if (y) {
            f32x4 yv[4]; float ss = 0.f;
#pragma unroll
            for (int j = 0; j < 4; ++j) { const uint2 w = *(const uint2*)(y + (size_t)row * D + j * 256 + lane * 4);
                yv[j] = (f32x4){bflo(w.x), bfhi(w.x), bflo(w.y), bfhi(w.y)}; ss += (yv[j].x * yv[j].x + yv[j].y * yv[j].y) + (yv[j].z * yv[j].z + yv[j].w * yv[j].w); }
            const float r = rsqrtf(wave_sum(ss) * (1.f / D) + EPS);
#pragma unroll
            for (int j = 0; j < 4; ++j) xv[j] = xv[j] + (yv[j] * r) * gp[j];
        }
#pragma unroll
        for (int j = 0; j < 4; ++j) *(f32x4*)(xout + (size_t)row * D + j * 256 + lane * 4) = xv[j];
        if (gpre) {
            float s2 = 0.f;
#pragma unroll
            for (int j = 0; j < 4; ++j) s2 += (xv[j].x * xv[j].x + xv[j].y * xv[j].y) + (xv[j].z * xv[j].z + xv[j].w * xv[j].w);
            const float r2 = rsqrtf(wave_sum(s2) * (1.f / D) + EPS);
#pragma unroll
            for (int j = 0; j < 4; ++j) { const f32x4 h = (xv[j] * r2) * gq[j]; uint2 w; w.x = pk2(h.x, h.y); w.y = pk2(h.z, h.w);
                *(uint2*)(hn + (size_t)row * D + j * 256 + lane * 4) = w; }
        }
    }
}
__device__ __forceinline__ void qkvnorm(const u16* proj, u16* cq, u16* ckv, u16* kr, const float* qn, const float* kvn, const float* ctab, const float* stab, int gw, int NGW, int lane) {
    float gq[6], gk[4];
#pragma unroll
    for (int j = 0; j < 6; ++j) gq[j] = qn[lane + 64 * j];
#pragma unroll
    for (int j = 0; j < 4; ++j) gk[j] = kvn[lane + 64 * j];
    for (int row = gw; row < M; row += NGW) {
        const u16* pr = proj + (size_t)row * 768;
        float a[6], b[4], s1 = 0.f, s2 = 0.f;
#pragma unroll
        for (int j = 0; j < 6; ++j) { a[j] = bf1(pr[lane + 64 * j]); s1 += a[j] * a[j]; }
#pragma unroll
        for (int j = 0; j < 4; ++j) { b[j] = bf1(pr[384 + lane + 64 * j]); s2 += b[j] * b[j]; }
        const float x1 = bf1(pr[640 + (lane & 31)]), x2 = bf1(pr[672 + (lane & 31)]);
        const float r1 = rsqrtf(wave_sum(s1) * (1.f / 384.f) + EPS), r2 = rsqrtf(wave_sum(s2) * (1.f / 256.f) + EPS);
#pragma unroll
        for (int j = 0; j < 6; ++j) cq[(size_t)row * 384 + lane + 64 * j] = (u16)f2bf(a[j] * r1 * gq[j]);
#pragma unroll
        for (int j = 0; j < 4; ++j) ckv[(size_t)row * 256 + lane + 64 * j] = (u16)f2bf(b[j] * r2 * gk[j]);
        const float c = ctab[(size_t)row * 32 + (lane & 31)], s = stab[(size_t)row * 32 + (lane & 31)];
        kr[(size_t)row * 64 + lane] = (u16)f2bf(lane < 32 ? x1 * c - x2 * s : x2 * c + x1 * s);
    }
}
__device__ __forceinline__ void qrope(u16* q, const float* ctab, const float* stab, int gw, int NGW, int lane) {
    for (int row = gw; row < M; row += NGW) {
        u16* qr = q + (size_t)row * 1536; const int i = lane & 31;
        const float c = ctab[(size_t)row * 32 + i], s = stab[(size_t)row * 32 + i];
#pragma unroll
        for (int j = 0; j < 4; ++j) { const int h = 2 * j + (lane >> 5); u16* pp = qr + h * 192 + 128 + i;
            const float x1 = bf1(pp[0]), x2 = bf1(pp[32]);
            pp[0] = (u16)f2bf(x1 * c - x2 * s); pp[32] = (u16)f2bf(x2 * c + x1 * s); }
    }
}
__device__ __forceinline__ void conv_phase(const u16* rec, u16* xc, const float* cw, const float* cb, int gtid, int NGT) {
    for (int idx = gtid; idx < M * 128; idx += NGT) {
        const int row = idx >> 7, c0 = (idx & 127) * 8, s = row & (SEQ - 1);
        float acc[8];
#pragma unroll
        for (int e = 0; e < 8; ++e) acc[e] = cb[c0 + e];
#pragma unroll
        for (int k = 0; k < 4; ++k) { if (s - 3 + k >= 0) {
            const uint4 w = *(const uint4*)(rec + (size_t)(row - 3 + k) * D + c0);
            const float v[8] = {bflo(w.x), bfhi(w.x), bflo(w.y), bfhi(w.y), bflo(w.z), bfhi(w.z), bflo(w.w), bfhi(w.w)};
#pragma unroll
            for (int e = 0; e < 8; ++e) acc[e] += v[e] * cw[k * D + c0 + e]; } }
        uint4 o; o.x = pk2(acc[0], acc[1]); o.y = pk2(acc[2], acc[3]); o.z = pk2(acc[4], acc[5]); o.w = pk2(acc[6], acc[7]);
        *(uint4*)(xc + (size_t)row * D + c0) = o;
    }
}
__device__ __forceinline__ void scanA(const float* A, const float* B, float* SA, float* SB, int tid) {
    for (int item = blockIdx.x; item < 2 * SCAN_NC * 2; item += gridDim.x) {
        const int half = item & 1, c = (item >> 1) % SCAN_NC, b = item / (2 * SCAN_NC), ch = half * 512 + tid;
        const size_t base = ((size_t)b * SEQ + (size_t)c * SCAN_L) * D + ch;
        float h = 0.f, P = 1.f;
        for (int t0 = 0; t0 < SCAN_L; t0 += 16) {
            float av[16], bv[16];
#pragma unroll
            for (int u = 0; u < 16; ++u) { av[u] = A[base + (size_t)(t0 + u) * D]; bv[u] = B[base + (size_t)(t0 + u) * D]; }
#pragma unroll
            for (int u = 0; u < 16; ++u) { h = av[u] * h + bv[u]; P *= av[u]; }
        }
        SA[((size_t)b * SCAN_NC + c) * D + ch] = P; SB[((size_t)b * SCAN_NC + c) * D + ch] = h;
    }
}
__device__ __forceinline__ void scanC(const float* A, const float* B, const float* SA, const float* SB, const u16* gate, u16* hg, int tid) {
    for (int item = blockIdx.x; item < 2 * SCAN_NC * 2; item += gridDim.x) {
        const int half = item & 1, c = (item >> 1) % SCAN_NC, b = item / (2 * SCAN_NC), ch = half * 512 + tid;
        const size_t base = ((size_t)b * SEQ + (size_t)c * SCAN_L) * D + ch;
        float h = 0.f;
        for (int cc = 0; cc < c; ++cc) { const size_t so = ((size_t)b * SCAN_NC + cc) * D + ch; h = SA[so] * h + SB[so]; }
        for (int t0 = 0; t0 < SCAN_L; t0 += 16) {
            float av[16], bv[16]; u16 gv[16];
#pragma unroll
            for (int u = 0; u < 16; ++u) { av[u] = A[base + (size_t)(t0 + u) * D]; bv[u] = B[base + (size_t)(t0 + u) * D]; gv[u] = gate[base + (size_t)(t0 + u) * D]; }
#pragma unroll
            for (int u = 0; u < 16; ++u) { h = av[u] * h + bv[u]; hg[base + (size_t)(t0 + u) * D] = (u16)f2bf(bf1(gv[u]) * h); }
        }
    }
}

constexpr int LDS_MAIN = att::LDS_BYTES > pg8::STAGE_BYTES ? att::LDS_BYTES : pg8::STAGE_BYTES, LDS_BYTES = LDS_MAIN + 16;
constexpr size_t WS_BAR = 106 * MB;
constexpr size_t WS_CNT1 = WS_BAR + 16384, WS_CNT2 = WS_BAR + 49152, CTL_BYTES = 81920, WS_XS1 = 107 * MB, WS_XS2 = 107 * MB + MB / 2;
constexpr int XL_OFF = 131072;
static_assert(XL_OFF + 8192 <= LDS_MAIN && XCD_BAR_WORDS * 4 <= 16384 && att::LDS_BYTES <= LDS_MAIN && pg8::STAGE_BYTES <= LDS_MAIN && LDS_BYTES <= 160 * 1024, "LDS map");

__global__ void __launch_bounds__(512, 2) fwd_mega(Params p_arg) {
    extern __shared__ __attribute__((aligned(16))) unsigned char lds[];
    cg::grid_group grid = cg::this_grid();
    (void)p_arg;
    volatile __attribute__((address_space(3))) unsigned* bst = (volatile __attribute__((address_space(3))) unsigned*)((__attribute__((address_space(3))) unsigned char*)lds + LDS_MAIN);
    if (threadIdx.x < 4) bst[threadIdx.x] = 0u;
    __syncthreads();
    const int wave_s = __builtin_amdgcn_readfirstlane(threadIdx.x >> 6);
    const xb::XcdBarrier bar = xb::xcd_barrier_post((unsigned*)(p_arg.ws + WS_BAR), bst);
    typedef const __attribute__((address_space(4))) Params* KParams;
    KParams pp = (KParams)__builtin_amdgcn_kernarg_segment_ptr();
#define FRESH() int tid_ = wave_s * 64 + lane_id_fresh(); asm volatile("" : "+v"(tid_)); asm volatile("" : "+s"(pp)); const __attribute__((address_space(4))) Params& p = *pp; \
    const int tid = tid_, lane = tid & 63, wave = __builtin_amdgcn_readfirstlane(tid >> 6); \
    const int G = gridDim.x, gw = blockIdx.x * 8 + wave, NGW = G * 8, gtid = blockIdx.x * 512 + tid, NGT = G * 512; \
    unsigned char* ws = p.ws; float* x = p.out; u16* hn = (u16*)(ws + WS_HN); u16* ybuf = (u16*)(ws + WS_Y); unsigned char* U = ws + WS_U; \
    float* ctab = (float*)(ws + WS_COS); float* stab = (float*)(ws + WS_SIN); float* SA = (float*)(ws + WS_SA); float* SB = (float*)(ws + WS_SB); \
    (void)lane; (void)wave; (void)gw; (void)NGW; (void)gtid; (void)NGT; (void)x; (void)hn; (void)ybuf; (void)U; (void)ctab; (void)stab; (void)SA; (void)SB;
    {
    FRESH();

    for (int prep = 0; prep < PROBE_PRO_REPS; ++prep) {
    prologue_weights(p, (float*)lds + wave * (64 * 33), gw, NGW, lane);
    for (int i = gtid; i < 2 * 2048 * 16; i += NGT) { const int j = i >> 15, row = (i >> 4) & 2047, chn = i & 15, n = row >> 8;
        *(uint4*)((u16*)(ws + WT_LRU(j) + OFF_GT) + (size_t)row * 256 + 128 * ((n & 1) ^ 1) + chn * 8) = make_uint4(0u, 0u, 0u, 0u); }
    { const int* pos = (const int*)p.in[I_POS];
      for (int i = gtid; i < M * 32; i += NGT) { const int row = i >> 5, f = i & 31;
        const float inv = __builtin_amdgcn_exp2f(-(float)f * (13.287712379549449f / 32.f));
        const float ang = (float)pos[row] * inv;
        double rev = (double)ang * 0.15915494309189535; rev -= __builtin_rint(rev);
        ctab[i] = __builtin_amdgcn_cosf((float)rev); stab[i] = __builtin_amdgcn_sinf((float)rev); } }
    rowop(nullptr, p.in[I_X], x, hn, nullptr, p.in[I_MIXPRE], gw, NGW, lane);
    }
    }
    grid.sync();

#pragma nounroll
    for (int layer = 0; layer < 4; ++layer) {
#pragma nounroll
        for (int op = 0; op < 10; ++op) {
            FRESH();
            const int j = layer >> 1; const bool lru = (layer & 1) != 0;
            const u16* wtm = (const u16*)(ws + WT_MLA(j)); const u16* wtl = (const u16*)(ws + WT_LRU(j)); const u16* wtf = (const u16*)(ws + WT_FFN(layer));
            int gk = 0;
            pg8::Gemm g{}; pg8::EpiB E{};
            if (op == 6 || op == 9) continue;
            const float* gpost = p.in[op == 5 ? I_MIXPOST : I_FFNPOST] + layer * D;
            const float* gpre = op == 5 ? p.in[I_FFNPRE] + layer * D : (layer < 3 ? p.in[I_MIXPRE] + (layer + 1) * D : nullptr);
            if (op == 7) { gk = 1; g = pg8::Gemm{hn, wtf, M, 4096, 1024, 1024, 1024, 0}; E = pg8::EpiB{(u16*)U, 4096, 0, 0, 1}; }
            else if (op == 8) { gk = 3; g = pg8::Gemm{(const u16*)U, wtf + OFF_DOWN / 2, M, 1024, 4096, 4096, 4096, 0}; }
            else if (!lru) {
                u16* proj = (u16*)(U + U_PROJ); u16* cq = (u16*)(U + U_CQ); u16* ckv = (u16*)(U + U_CKV); u16* kr = (u16*)(U + U_KR); u16* q = (u16*)(U + U_Q); u16* o = (u16*)(U + U_O); u16* kv = hn;
                if (op == 0) { gk = 1; g = pg8::Gemm{hn, wtm, M, 768, 1024, 1024, 1024, 0}; E = pg8::EpiB{proj, 768, 0, 0, 0}; }
                else if (op == 1) for (int rep = 0; rep < PROBE_THIN_REPS; ++rep) qkvnorm(proj, cq, ckv, kr, p.in[I_MLA_QN] + j * 384, p.in[I_MLA_KVN] + j * 256, ctab, stab, gw, NGW, lane);
                else if (op == 2) { gk = 1; g = pg8::Gemm{cq, wtm + OFF_UQ / 2, M, 1536, 384, 384, 384, 0}; E = pg8::EpiB{q, 1536, 0, 0, 0}; }
                else if (op == 3) { qrope(q, ctab, stab, gw, NGW, lane); gk = 1; g = pg8::Gemm{ckv, wtm + OFF_UKV / 2, M, 2048, 256, 256, 256, 0}; E = pg8::EpiB{kv, 2048, 0, 0, 0}; }
                else if (op == 4) { const att::Tensors T{q, kv, kr, o}; for (int rep = 0; rep < PROBE_ATT_REPS; ++rep) att::attn_phase((char*)lds, T, tid); }
                else { gk = 3; g = pg8::Gemm{o, wtm + OFF_WO / 2, M, 1024, 1024, 1024, 1024, 0}; }
            } else {
                u16* gate = (u16*)(U + U_GATE); u16* xc = (u16*)(U + U_XC); u16* rec = (u16*)(U + U_REC); float* Bb = (float*)(U + U_B); float* Ab = (float*)hn; u16* hg = xc;
                if (op == 0) { gk = 1; g = pg8::Gemm{hn, wtl, M, 2048, 1024, 1024, 1024, 0}; E = pg8::EpiB{gate, 1024, 1024, (size_t)(U_REC - U_GATE) / 2, 2}; }
                else if (op == 1) for (int rep = 0; rep < PROBE_THIN_REPS; ++rep) conv_phase(rec, xc, p.in[I_LRU_CW] + j * 4 * D, p.in[I_LRU_CB] + j * D, gtid, NGT);
                else if (op == 2) { gk = 2; g = pg8::Gemm{xc, wtl + OFF_GT / 2, M, 2048, 256, 1024, 256, 512}; }
                else if (op == 3) for (int rep = 0; rep < PROBE_THIN_REPS; ++rep) scanA(Ab, Bb, SA, SB, tid);
                else if (op == 4) for (int rep = 0; rep < PROBE_THIN_REPS; ++rep) scanC(Ab, Bb, SA, SB, gate, hg, tid);
                else { gk = 3; g = pg8::Gemm{hg, wtl + OFF_LOUT / 2, M, 1024, 1024, 1024, 1024, 0}; }
            }
            for (int rep = 0; rep < PROBE_GEMM_REPS; ++rep)
            if (gk == 1) { pg8::StaticOrder S; S.init(g.M, g.N, G, (int)blockIdx.x);
                pg8::gemm_phase<pg8::EpiB, pg8::StaticOrder, true>((PG8_LAS unsigned char*)lds, g, S, E, tid); }
            else if (gk == 2) { pg8::StaticOrder S; S.init(g.M, g.N, G, (int)blockIdx.x);
                const pg8::EpiGate EG{(const u16*)(U + U_XC), (float*)hn, (float*)(U + U_B), p.in[I_LRU_BA] + j * D, p.in[I_LRU_BX] + j * D, p.in[I_LRU_LAM] + j * D};
                pg8::gemm_phase<pg8::EpiGate, pg8::StaticOrder, true>((PG8_LAS unsigned char*)lds, g, S, EG, tid); }
            else if (gk == 3) { pg8::StaticOrder S; S.init(g.M, g.N, G, (int)blockIdx.x);
                const unsigned target = 32u * (unsigned)(layer * 2 + (op == 8 ? 2 : 1));
                const pg8::RowStats st1{(float*)(ws + WS_XS1), (unsigned*)(ws + WS_CNT1), target}, st2{(float*)(ws + WS_XS2), (unsigned*)(ws + WS_CNT2), target};
                const pg8::EpiNormRes EN{x, hn, gpost, gpre, st1, st2, (PG8_LAS unsigned char*)lds + XL_OFF};
                pg8::gemm_phase<pg8::EpiNormRes, pg8::StaticOrder, true>((PG8_LAS unsigned char*)lds, g, S, EN, tid); }
            if (!(layer == 3 && op == 8)) { for (int rep = 0; rep < PROBE_SYNC_REPS; ++rep) xb::xcd_barrier(bar, tid == 0); }
        }
    }
}
}

extern "C" void kernel_launch(void* const* d_in, const int* in_sizes, int n_in, void* d_out, int out_size, void* d_ws, size_t ws_size, hipStream_t stream) {
    static int grid = 0;
    if (grid == 0) {
        if (n_in != 23 || in_sizes[0] != mk::M * mk::D || out_size != mk::M * mk::D || ws_size < mk::WS_END) {
            fprintf(stderr, "kernel_launch: unexpected shapes (n_in %d, in0 %d, out %d, ws %zu); nothing launched\n", n_in, n_in > 0 ? in_sizes[0] : -1, out_size, ws_size); grid = -1; return; }
        int dev = 0, cus = 0, per_cu = 0;
        (void)hipGetDevice(&dev); (void)hipDeviceGetAttribute(&cus, hipDeviceAttributeMultiprocessorCount, dev);
        if (hipFuncSetAttribute((const void*)mk::fwd_mega, hipFuncAttributeMaxDynamicSharedMemorySize, mk::LDS_BYTES) != hipSuccess) { fprintf(stderr, "kernel_launch: hipFuncSetAttribute failed\n"); grid = -1; return; }
        if (hipOccupancyMaxActiveBlocksPerMultiprocessor(&per_cu, (const void*)mk::fwd_mega, 512, mk::LDS_BYTES) != hipSuccess || per_cu < 1) { fprintf(stderr, "kernel_launch: occupancy query says %d blocks per CU\n", per_cu); per_cu = 1; }
        (void)hipGetLastError();
        grid = cus > 0 ? cus : 256;
    }
    if (grid < 0) return;
    mk::Params p{};
    for (int i = 0; i < 23; ++i) p.in[i] = (const float*)d_in[i];
    p.out = (float*)d_out; p.ws = (unsigned char*)d_ws;
    if (hipMemsetAsync((char*)d_ws + mk::WS_BAR, 0, mk::CTL_BYTES, stream) != hipSuccess) { fprintf(stderr, "kernel_launch: hipMemsetAsync failed\n"); return; }
    void* args[] = {&p};
    hipError_t e = hipLaunchCooperativeKernel((const void*)mk::fwd_mega, dim3(grid), dim3(512), args, mk::LDS_BYTES, stream);
    if (e != hipSuccess) fprintf(stderr, "kernel_launch: cooperative launch failed: %s (grid %d)\n", hipGetErrorString(e), grid);
}
```

```cpp
#include <hip/hip_runtime.h>
#include <hip/hip_bf16.h>
#include <hip/hip_cooperative_groups.h>
#include <cstdio>
#include <cstdint>
namespace cg = cooperative_groups;

__device__ __forceinline__ float xor1f(float v)  { return __int_as_float(__builtin_amdgcn_mov_dpp(__float_as_int(v), 0xB1, 0xF, 0xF, false)); }
__device__ __forceinline__ float xor2f(float v)  { return __int_as_float(__builtin_amdgcn_mov_dpp(__float_as_int(v), 0x4E, 0xF, 0xF, false)); }
__device__ __forceinline__ float xor4f(float v)  { return __int_as_float(__builtin_amdgcn_ds_swizzle(__float_as_int(v), 0x101F)); }
__device__ __forceinline__ float xor8f(float v)  { return __int_as_float(__builtin_amdgcn_ds_swizzle(__float_as_int(v), 0x201F)); }
__device__ __forceinline__ float xor16f(float v) { return __int_as_float(__builtin_amdgcn_ds_swizzle(__float_as_int(v), 0x401F)); }
__device__ __forceinline__ float sum32f(float v) { auto rr = __builtin_amdgcn_permlane32_swap(__float_as_uint(v), __float_as_uint(v), false, false); return __uint_as_float(rr[0]) + __uint_as_float(rr[1]); }
__device__ __forceinline__ int lane_id_fresh() { int l; asm volatile("v_mbcnt_lo_u32_b32 %0, -1, 0\n\tv_mbcnt_hi_u32_b32 %0, -1, %0" : "=v"(l)); return l; }
namespace pg8 {
#define PG8_LAS __attribute__((address_space(3)))
typedef unsigned short bf16_t;
typedef short bf16x8 __attribute__((ext_vector_type(8)));
typedef float f32x4 __attribute__((ext_vector_type(4)));
typedef unsigned u32x4 __attribute__((ext_vector_type(4)));
constexpr int BM = 256, BK = 64, HALF = 128, HTB = HALF * BK * 2  , STAGE_BYTES = 8 * HTB, NXCD = 8, WGM = 8;

__host__ __device__ __forceinline__ int lds_byte(int r, int c) { const int st = (r >> 4) * 2 + (c >> 5), rr = r & 15, cc = c & 31, ob = rr * 64 + cc * 2; return st * 1024 + (ob ^ (((ob >> 9) & 1) << 5)); }
__host__ __device__ __forceinline__ void stage_rc(int b, int& R, int& C) { const int st = b / 1024, sb = b % 1024, swz = sb ^ (((sb >> 9) & 1) << 5); R = (st >> 1) * 16 + swz / 64; C = (st & 1) * 32 + (swz % 64) / 2; }
__host__ __device__ __forceinline__ int perm32(int rho) { const int n = rho >> 4, i = rho & 15; return 8 * (i >> 2) + 4 * n + (i & 3); }

struct Unit { int pm, pn; };
struct Gemm { const bf16_t* A; const bf16_t* Bt; int M, N, K; int lda, ldb; int apn; };

struct StaticOrder {
    int nM, nN, nwg, G, c;
    __host__ __device__ void init(int M, int N, int G_, int c_) { nM = M / BM; nN = N / BM; nwg = nM * nN; G = G_; c = c_; }
    __host__ __device__ bool next(int i, Unit& u) const {
        const long L = (long)i * G + c; if (L >= nwg) return false;
        int wgid = (int)L; { const int q = nwg / NXCD, r = nwg % NXCD, xcd = wgid % NXCD, off = wgid / NXCD; wgid = (xcd < r ? xcd * (q + 1) : r * (q + 1) + (xcd - r) * q) + off; }
        const int nig = WGM * nN, gid = wgid / nig, fm = gid * WGM, gsz = (nM - fm) < WGM ? (nM - fm) : WGM;
        u.pm = fm + ((wgid % nig) % gsz); u.pn = (wgid % nig) / gsz; return true;
    }
    __device__ __forceinline__ void a_ready(const Unit&) const {}
    __device__ __forceinline__ void done(const Unit&) const {}
};

__device__ __forceinline__ unsigned cvt_pk_bf16(float lo, float hi) { unsigned r; asm volatile("v_cvt_pk_bf16_f32 %0, %1, %2" : "=v"(r) : "v"(lo), "v"(hi)); return r; }
__device__ __forceinline__ float gelu_tanh(float x) {
    const float z = 0.7978845608028654f * (x + 0.044715f * x * x * x);
    const float e = __expf(2.0f * z);
    const float th = 1.0f - 2.0f * __builtin_amdgcn_rcpf(1.0f + e);
    return 0.5f * x * (1.0f + th);
}
struct EpiB {
    static constexpr bool PERM = true, AFTER_DRAIN = false, FUSED = false;
    bf16_t* O; int ldc; int split_cols; size_t split_stride; int mode;
    __device__ __forceinline__ void operator()(const f32x4 (&acc)[2][2][4][2], const Unit& u, int wr, int wc, int fr, int fq) const {
        const int row0 = u.pm * BM + wr * 64 + fr; int colt = u.pn * BM; bf16_t* base = O; int t = 0;
        if (split_cols) { t = colt / split_cols; base += (size_t)t * split_stride; colt -= t * split_cols; }
        const int act = (mode == 1) ? 1 : ((mode == 2 && t == 0) ? 2 : 0);
        const int col0 = colt + wc * 32 + 8 * fq;
#pragma unroll
        for (int ai = 0; ai < 2; ++ai)
#pragma unroll
            for (int m = 0; m < 4; ++m) { bf16_t* rowp = base + (size_t)(row0 + ai * HALF + m * 16) * ldc + col0;
#pragma unroll
                for (int bj = 0; bj < 2; ++bj) { f32x4 v0 = acc[ai][bj][m][0], v1 = acc[ai][bj][m][1];
                    if (act == 1) {
#pragma unroll
                        for (int e = 0; e < 4; ++e) { const float a = fmaxf(v0[e], 0.f), b = fmaxf(v1[e], 0.f); v0[e] = a * a; v1[e] = b * b; } }
                    else if (act == 2) {
#pragma unroll
                        for (int e = 0; e < 4; ++e) { v0[e] = gelu_tanh(v0[e]); v1[e] = gelu_tanh(v1[e]); } }
                    u32x4 w; w.x = cvt_pk_bf16(v0[0], v0[1]); w.y = cvt_pk_bf16(v0[2], v0[3]); w.z = cvt_pk_bf16(v1[0], v1[1]); w.w = cvt_pk_bf16(v1[2], v1[3]);
                    *(u32x4*)(rowp + bj * HALF) = w; } }
    }
};
__device__ __forceinline__ float bf2f(unsigned short h) { return __uint_as_float(((unsigned)h) << 16); }
__device__ __forceinline__ float sigmoidf_(float x) { return __builtin_amdgcn_rcpf(1.0f + __expf(-x)); }
__device__ __forceinline__ float one_minus_exp(float t) { const float ser = -t * (1.0f + t * (0.5f + t * (0.16666667f + t * (0.041666668f + t * 0.008333334f)))); return t > -0.25f ? ser : 1.0f - __expf(t); }
struct EpiGate {
    static constexpr bool PERM = false, AFTER_DRAIN = false, FUSED = false;
    const bf16_t* xc; bf16_t* Aout; bf16_t* Bout; const float* b_a; const float* b_x; const float* lam;
    __device__ __forceinline__ void operator()(const f32x4 (&acc)[2][2][4][2], const Unit& u, int wr, int wc, int fr, int fq) const {
#pragma unroll
        for (int n = 0; n < 2; ++n) {
            const int ch0 = 128 * u.pn + 32 * wc + 16 * n + 4 * fq;
            const f32x4 ba = *(const f32x4*)(b_a + ch0), bx = *(const f32x4*)(b_x + ch0), lm = *(const f32x4*)(lam + ch0);
            f32x4 sp;
#pragma unroll
            for (int e = 0; e < 4; ++e) sp[e] = -8.0f * log1pf(__expf(-lm[e]));
#pragma unroll
            for (int ai = 0; ai < 2; ++ai)
#pragma unroll
                for (int m = 0; m < 4; ++m) {
                    const size_t off = (size_t)(u.pm * BM + ai * HALF + wr * 64 + m * 16 + fr) * 1024 + ch0;
                    const uint2 xr = *(const uint2*)(xc + off);
                    float xv[4] = { __uint_as_float(xr.x << 16), __uint_as_float(xr.x & 0xffff0000u), __uint_as_float(xr.y << 16), __uint_as_float(xr.y & 0xffff0000u) };
                    f32x4 av, bv;
#pragma unroll
                    for (int e = 0; e < 4; ++e) {
                        const float r = sigmoidf_(acc[ai][0][m][n][e] + ba[e]);
                        const float ig = sigmoidf_(acc[ai][1][m][n][e] + bx[e]);
                        const float la = sp[e] * r;
                        av[e] = la;
                        bv[e] = __builtin_amdgcn_sqrtf(fmaxf(one_minus_exp(2.0f * la), 0.f)) * (ig * xv[e]);
                    }
                    uint2 wa, wb; wa.x = cvt_pk_bf16(av[0], av[1]); wa.y = cvt_pk_bf16(av[2], av[3]); wb.x = cvt_pk_bf16(bv[0], bv[1]); wb.y = cvt_pk_bf16(bv[2], bv[3]);
                    *(uint2*)(Aout + off) = wa; *(uint2*)(Bout + off) = wb;
                }
        }
    }
};

struct RowStats {
    float* xbuf;
    unsigned* cnt;
    unsigned target;
    __device__ __forceinline__ void run(const f32x4 (&v)[2][2][4][2], const Unit& u, int wr, int wc, int fr, int fq, PG8_LAS unsigned char* xl, int wid, int lane) const {
        PG8_LAS float* P = (PG8_LAS float*)xl;
        PG8_LAS float* S = (PG8_LAS float*)(xl + 4096);
#pragma unroll
        for (int ai = 0; ai < 2; ++ai)
#pragma unroll
            for (int m = 0; m < 4; ++m) {
                float s = 0.f;
#pragma unroll
                for (int bj = 0; bj < 2; ++bj)
#pragma unroll
                    for (int n = 0; n < 2; ++n) { const f32x4 x = v[ai][bj][m][n]; s += (x[0] * x[0] + x[1] * x[1]) + (x[2] * x[2] + x[3] * x[3]); }
                s += xor16f(s); s = sum32f(s);
                if (fq == 0) P[(ai * HALF + wr * 64 + m * 16 + fr) * 4 + wc] = s;
            }
        asm volatile("s_waitcnt lgkmcnt(0)" ::: "memory"); __builtin_amdgcn_s_barrier(); asm volatile("" ::: "memory");
        const int row = wid * 32 + (lane & 31);
        if (lane < 32) { const float t = (P[row * 4 + 0] + P[row * 4 + 1]) + (P[row * 4 + 2] + P[row * 4 + 3]);
            __hip_atomic_store(xbuf + (size_t)(u.pm * BM + row) * 4 + u.pn, t, __ATOMIC_RELAXED, __HIP_MEMORY_SCOPE_AGENT); }
        asm volatile("s_waitcnt vmcnt(0)" ::: "memory");
        if (lane == 0) __hip_atomic_fetch_add(cnt + 64 * u.pm, 1u, __ATOMIC_RELAXED, __HIP_MEMORY_SCOPE_AGENT);
        if (wid == 0) { unsigned sp = 0;
            while ((unsigned)__builtin_amdgcn_readfirstlane(__hip_atomic_load(cnt + 64 * u.pm, __ATOMIC_RELAXED, __HIP_MEMORY_SCOPE_AGENT)) < target) { __builtin_amdgcn_s_sleep(2); if (++sp > (1u << 18)) break; }
            __builtin_amdgcn_fence(__ATOMIC_ACQUIRE, "agent"); }
        asm volatile("s_waitcnt vmcnt(0) lgkmcnt(0)" ::: "memory"); __builtin_amdgcn_s_barrier(); asm volatile("" ::: "memory");
        if (lane < 32) { float* slot = xbuf + (size_t)(u.pm * BM + row) * 4; float t = 0.f;
#pragma unroll
            for (int k = 0; k < 4; ++k) t += __hip_atomic_load(slot + k, __ATOMIC_RELAXED, __HIP_MEMORY_SCOPE_AGENT);
            S[row] = t; }
        asm volatile("s_waitcnt lgkmcnt(0)" ::: "memory"); __builtin_amdgcn_s_barrier(); asm volatile("" ::: "memory");
    }
};
struct EpiNormRes {
    static constexpr bool PERM = false, AFTER_DRAIN = false, FUSED = true;
    bf16_t* hn; float* rs; float* out; const float* gprev; const float* gpost; const float* gpre; RowStats st1, st2; PG8_LAS unsigned char* xl;
    __device__ __forceinline__ void fused(f32x4 (&acc)[2][2][4][2], const Unit& u, int wr, int wc, int fr, int fq, int wid, int lane) const {
        typedef unsigned u32x2v __attribute__((ext_vector_type(2)));
        const PG8_LAS float* S = (const PG8_LAS float*)(xl + 4096);
        const int col0 = u.pn * BM + wc * 32 + 4 * fq;
        st1.run(acc, u, wr, wc, fr, fq, xl, wid, lane);
#pragma unroll
        for (int ai = 0; ai < 2; ++ai)
#pragma unroll
            for (int m = 0; m < 4; ++m) { const int r = ai * HALF + wr * 64 + m * 16 + fr; const float rstd = rsqrtf(S[r] * (1.0f / 1024.0f) + 1e-6f); const size_t off = (size_t)(u.pm * BM + r) * 1024 + col0;
                const float rsc = rs[u.pm * BM + r];
#pragma unroll
                for (int bj = 0; bj < 2; ++bj)
#pragma unroll
                    for (int n = 0; n < 2; ++n) { const u32x2v hw = *(const u32x2v*)(hn + off + bj * HALF + n * 16);
                        const f32x4 gp = *(const f32x4*)(gprev + col0 + bj * HALF + n * 16); const f32x4 gv = *(const f32x4*)(gpost + col0 + bj * HALF + n * 16);
                        f32x4 xs; xs[0] = __uint_as_float(hw.x << 16) * __builtin_amdgcn_rcpf(gp[0]); xs[1] = __uint_as_float(hw.x & 0xffff0000u) * __builtin_amdgcn_rcpf(gp[1]);
                        xs[2] = __uint_as_float(hw.y << 16) * __builtin_amdgcn_rcpf(gp[2]); xs[3] = __uint_as_float(hw.y & 0xffff0000u) * __builtin_amdgcn_rcpf(gp[3]);
                        acc[ai][bj][m][n] = xs * rsc + (acc[ai][bj][m][n] * rstd) * gv; }
                asm volatile("" : "+v"(acc[ai][0][m][0]), "+v"(acc[ai][0][m][1]), "+v"(acc[ai][1][m][0]), "+v"(acc[ai][1][m][1]));
                if (m & 1) asm volatile("" ::: "memory"); }
        if (gpre) {
            st2.run(acc, u, wr, wc, fr, fq, xl, wid, lane);
#pragma unroll
            for (int ai = 0; ai < 2; ++ai)
#pragma unroll
                for (int m = 0; m < 4; ++m) { const int r = ai * HALF + wr * 64 + m * 16 + fr; const float ms = S[r] * (1.0f / 1024.0f) + 1e-6f; const float rstd = rsqrtf(ms); const size_t off = (size_t)(u.pm * BM + r) * 1024 + col0;
                    if (u.pn == 0 && wc == 0 && fq == 0) rs[u.pm * BM + r] = ms * rstd;
#pragma unroll
                    for (int bj = 0; bj < 2; ++bj)
#pragma unroll
                        for (int n = 0; n < 2; ++n) { const f32x4 x1 = acc[ai][bj][m][n];
                            const f32x4 gv = *(const f32x4*)(gpre + col0 + bj * HALF + n * 16); const f32x4 o = (x1 * rstd) * gv;
                            u32x2v w; w.x = cvt_pk_bf16(o[0], o[1]); w.y = cvt_pk_bf16(o[2], o[3]); *(u32x2v*)(hn + off + bj * HALF + n * 16) = w; }
                    asm volatile("" ::: "memory"); }
        } else {
#pragma unroll
            for (int ai = 0; ai < 2; ++ai)
#pragma unroll
                for (int m = 0; m < 4; ++m) { const int r = ai * HALF + wr * 64 + m * 16 + fr; const size_t off = (size_t)(u.pm * BM + r) * 1024 + col0;
#pragma unroll
                    for (int bj = 0; bj < 2; ++bj)
#pragma unroll
                        for (int n = 0; n < 2; ++n) *(f32x4*)(out + off + bj * HALF + n * 16) = acc[ai][bj][m][n]; }
        }
    }
};

template <class Epi, class Sched, bool ALIGN_EPI>
__device__ __forceinline__ void gemm_phase(PG8_LAS unsigned char* lds, const Gemm g, const Sched& S, const Epi& E, int tid0) {
    int tid_ = tid0; asm volatile("" : "+v"(tid_));
    const int tid = tid_, wid = __builtin_amdgcn_readfirstlane(tid >> 6), lane = tid & 63, wr = wid >> 2, wc = wid & 3, fr = lane & 15, fq = lane >> 4;
    const int K = g.K, nt = K / BK;
    unsigned voffA[2], voffB[2];
#pragma unroll
    for (int i = 0; i < 2; ++i) { int R, C; stage_rc(tid * 16 + i * 8192, R, C); const int Rb = Epi::PERM ? ((R & ~31) + perm32(R & 31)) : R;
        voffA[i] = (unsigned)(R * g.lda + C) * 2u; voffB[i] = (unsigned)(Rb * g.ldb + C) * 2u; }
    const size_t kstep = (size_t)(BK * 2);
    const size_t hstepA = (size_t)HALF * g.lda * 2, hstepB = (size_t)HALF * g.ldb * 2;
    const size_t tstepA = 2 * hstepA, tstepB = 2 * hstepB;
    const unsigned ldsw = (unsigned)wid * 1024u;
    const int aoff = lds_byte(wr * 64 + fr, fq * 8), boff = lds_byte(wc * 32 + fr, fq * 8);
#define PG8_SA(b, h) (((b) * 2 + (h)) * HTB)
#define PG8_SB(b, h) ((4 + (b) * 2 + (h)) * HTB)
#define PG8_STAGE(bufoff, gbase, voff) do { _Pragma("unroll") for (int _i = 0; _i < 2; ++_i) \
        __builtin_amdgcn_global_load_lds((const unsigned*)((const char*)(gbase) + (voff)[_i]), (PG8_LAS unsigned*)(lds + (bufoff) + ldsw + _i * 8192), 16, 0, 0); } while (0)
#define PG8_LDA(dst, b, h) do { _Pragma("unroll") for (int m = 0; m < 4; ++m) _Pragma("unroll") for (int k = 0; k < 2; ++k) dst[m][k] = *(const PG8_LAS bf16x8*)(lds + PG8_SA(b, h) + aoff + m * 2048 + k * 1024); } while (0)
#define PG8_LDB(dst, b, h) do { _Pragma("unroll") for (int n = 0; n < 2; ++n) _Pragma("unroll") for (int k = 0; k < 2; ++k) dst[n][k] = *(const PG8_LAS bf16x8*)(lds + PG8_SB(b, h) + boff + n * 2048 + k * 1024); } while (0)
#define PG8_MMA(ai, bj, At, Bt) do { __builtin_amdgcn_s_setprio(1); _Pragma("unroll") for (int m = 0; m < 4; ++m) _Pragma("unroll") for (int n = 0; n < 2; ++n) _Pragma("unroll") for (int k = 0; k < 2; ++k) \
        acc[ai][bj][m][n] = __builtin_amdgcn_mfma_f32_16x16x32_bf16(Bt[n][k], At[m][k], acc[ai][bj][m][n], 0, 0, 0); __builtin_amdgcn_s_setprio(0); } while (0)
#define PG8_WAIT_V(n) asm volatile("s_waitcnt vmcnt(" #n ")" ::: "memory")
#define PG8_WAIT_L(n) asm volatile("s_waitcnt lgkmcnt(" #n ")" ::: "memory")
#define PG8_BAR __builtin_amdgcn_s_barrier()
#define PG8_SCHED __builtin_amdgcn_sched_barrier(0)
    Unit cur, nxt; int ui = 0;
    if (!S.next(0, cur)) return;
    f32x4 acc[2][2][4][2];
#pragma unroll
    for (int a = 0; a < 2; ++a)
#pragma unroll
        for (int b = 0; b < 2; ++b)
#pragma unroll
            for (int m = 0; m < 4; ++m)
#pragma unroll
                for (int n = 0; n < 2; ++n) acc[a][b][m][n] = (f32x4){0.f, 0.f, 0.f, 0.f};
    bf16x8 At[4][2], B0[2][2], B1[2][2];
    const char* cA = (const char*)g.A + (size_t)cur.pm * tstepA + (size_t)(cur.pn >> 1) * (size_t)g.apn; const char* cB = (const char*)g.Bt + (size_t)cur.pn * tstepB;
    S.a_ready(cur);
    PG8_STAGE(PG8_SB(0, 0), cB, voffB); PG8_STAGE(PG8_SB(0, 1), cB + hstepB, voffB); PG8_STAGE(PG8_SA(0, 0), cA, voffA); PG8_STAGE(PG8_SA(0, 1), cA + hstepA, voffA);
    if (wr == 1) PG8_BAR;
    PG8_WAIT_V(2); PG8_BAR;
    PG8_STAGE(PG8_SB(1, 0), cB + kstep, voffB); PG8_STAGE(PG8_SA(1, 0), cA + kstep, voffA); PG8_STAGE(PG8_SB(1, 1), cB + hstepB + kstep, voffB);
    PG8_WAIT_V(6); PG8_BAR;
    for (;;) {
        const bool has_next = S.next(ui + 1, nxt);
        const char* nA = has_next ? (const char*)g.A + (size_t)nxt.pm * tstepA + (size_t)(nxt.pn >> 1) * (size_t)g.apn : cA; const char* nB = has_next ? (const char*)g.Bt + (size_t)nxt.pn * tstepB : cB;
        for (int t = 0; t < nt; t += 2) {
            const bool last = (t == nt - 2);
            const char* a1 = cA + (size_t)(t + 1) * kstep;
            const char* a2 = last ? nA : cA + (size_t)(t + 2) * kstep; const char* b2 = last ? nB : cB + (size_t)(t + 2) * kstep;
            const char* a3 = a2 + kstep; const char* b3 = b2 + kstep;
            if (last && has_next) S.a_ready(nxt);
            PG8_LDB(B0, 0, 0); PG8_LDB(B1, 0, 1); PG8_SCHED; PG8_LDA(At, 0, 0); PG8_STAGE(PG8_SA(1, 1), a1 + hstepA, voffA);
            PG8_WAIT_V(8); PG8_WAIT_L(0); PG8_BAR; PG8_MMA(0, 0, At, B0); PG8_MMA(0, 1, At, B1); PG8_BAR; PG8_SCHED;
            PG8_LDA(At, 0, 1); PG8_STAGE(PG8_SB(0, 0), b2, voffB); PG8_STAGE(PG8_SB(0, 1), b2 + hstepB, voffB); PG8_STAGE(PG8_SA(0, 0), a2, voffA);
            PG8_WAIT_V(8); PG8_WAIT_L(0); PG8_BAR; PG8_MMA(1, 0, At, B0); PG8_MMA(1, 1, At, B1); PG8_BAR; PG8_SCHED;
            PG8_LDB(B0, 1, 0); PG8_LDB(B1, 1, 1); PG8_SCHED; PG8_LDA(At, 1, 0); PG8_STAGE(PG8_SA(0, 1), a2 + hstepA, voffA);
            PG8_WAIT_V(8); PG8_WAIT_L(0); PG8_BAR; PG8_MMA(0, 0, At, B0); PG8_MMA(0, 1, At, B1); PG8_BAR; PG8_SCHED;
            PG8_LDA(At, 1, 1); PG8_STAGE(PG8_SB(1, 0), b3, voffB); PG8_STAGE(PG8_SB(1, 1), b3 + hstepB, voffB); PG8_STAGE(PG8_SA(1, 0), a3, voffA);
            PG8_WAIT_V(8); PG8_WAIT_L(0); PG8_BAR; PG8_MMA(1, 0, At, B0); PG8_MMA(1, 1, At, B1); PG8_BAR; PG8_SCHED;
        }
        if constexpr (ALIGN_EPI) { if (wr == 0) PG8_BAR; }
        if constexpr (Epi::FUSED) E.fused(acc, cur, wr, wc, fr, fq, wid, lane); else E(acc, cur, wr, wc, fr, fq);
        S.done(cur);
        if (!has_next) break;
#pragma unroll
        for (int a = 0; a < 2; ++a)
#pragma unroll
            for (int b = 0; b < 2; ++b)
#pragma unroll
                for (int m = 0; m < 4; ++m)
#pragma unroll
                    for (int n = 0; n < 2; ++n) acc[a][b][m][n] = (f32x4){0.f, 0.f, 0.f, 0.f};
        cur = nxt; cA = nA; cB = nB; ++ui;
        if constexpr (ALIGN_EPI) { if (wr == 1) PG8_BAR; }
    }
    PG8_WAIT_V(0);
    if constexpr (!ALIGN_EPI) { if (wr == 0) PG8_BAR; }
    PG8_BAR;
#undef PG8_SA
#undef PG8_SB
#undef PG8_STAGE
#undef PG8_LDA
#undef PG8_LDB
#undef PG8_MMA
#undef PG8_WAIT_V
#undef PG8_WAIT_L
#undef PG8_BAR
#undef PG8_SCHED
}
}
namespace att {
typedef unsigned short u16;
typedef short bf16x8 __attribute__((ext_vector_type(8)));
typedef short s16x4 __attribute__((ext_vector_type(4)));
typedef float f32x16 __attribute__((ext_vector_type(16)));
typedef float f32x4 __attribute__((ext_vector_type(4)));
typedef unsigned u32x4 __attribute__((ext_vector_type(4)));
constexpr int SEQ = 16384, NW = 8, QBLK = 32, KVBLK = 64, QB = NW * QBLK;
constexpr int LDQ = 1536, LDK = 2048, LDKR = 64, LDO = 1024;
#ifndef ATT_NQREG
#define ATT_NQREG 4
#endif
constexpr int NQREG = ATT_NQREG, NQREG_L = 8 - NQREG;
constexpr int SHM_V = KVBLK * 128 * 2, SHM_K = KVBLK * 128 * 2, SHM_KR = KVBLK * 64 * 2;
constexpr int OFF_V = 0, OFF_K = 2 * SHM_V, OFF_KR = OFF_K + 2 * SHM_K, OFF_WS = OFF_KR + 2 * SHM_KR, OFF_QR = OFF_WS + NW * 64 * 4, QR_WAVE = (NQREG_L + 4) * 1024, LDS_BYTES = OFF_QR + NW * QR_WAVE;
constexpr float SCALE = 0.07216878364870322f;
constexpr float THR = 8.f;

#define KSWZ(row, colB) ((row) * 256 + ((colB) ^ (((row) & 7) << 4)))
#define KRSWZ(row, colB) ((row) * 128 + ((colB) ^ (((row) & 7) << 4)))
#define SBAR() __builtin_amdgcn_sched_barrier(0)
__device__ __forceinline__ int v_st(int k, int c) { const int kk = (k & ~0xC) | ((k & 4) << 1) | ((k & 8) >> 1); return ((kk >> 3) * 4 + (c >> 5)) * 512 + ((kk & 7) * 32 + (c & 31)) * 2; }
__device__ __forceinline__ int v_rd_base(int lane) { return ((lane & 3) << 3) | (((lane >> 2) & 3) << 6) | (((lane >> 4) & 1) << 5) | (((lane >> 5) & 1) << 8); }
constexpr int v_rd_off(int d0, int ks, int half) { return d0 * 512 + ks * 4096 + half * 2048; }
__device__ __forceinline__ int crow(int r, int hi) { return (r & 3) + 8 * (r >> 2) + 4 * hi; }
__device__ __forceinline__ unsigned cvtpk(float lo, float hi) { unsigned r; asm volatile("v_cvt_pk_bf16_f32 %0, %1, %2" : "=v"(r) : "v"(lo), "v"(hi)); return r; }
__device__ __forceinline__ bf16x8 load8(const u16* p) { return *reinterpret_cast<const bf16x8*>(p); }
__device__ __forceinline__ void mask_tile(f32x16& p0, f32x16& p1, int dq, unsigned W) {
    const float NEG = -__builtin_inff();
#pragma unroll
    for (int r = 0; r < 16; ++r) {
        const int c = (r & 3) + 8 * (r >> 2);
        if ((unsigned)(dq - c) >= W) p0[r] = NEG;
        if ((unsigned)(dq - c - 32) >= W) p1[r] = NEG;
    }
}
__device__ __forceinline__ void partialSM(f32x16& p0, f32x16& p1, float& m_reg, float& mn, float& alpha) {
    float pmax = p0[0]; for (int r = 1; r < 16; ++r) pmax = fmaxf(pmax, p0[r]); for (int r = 0; r < 16; ++r) pmax = fmaxf(pmax, p1[r]);
    { auto rr = __builtin_amdgcn_permlane32_swap(__float_as_uint(pmax), __float_as_uint(pmax), false, false);
      pmax = fmaxf(__uint_as_float(rr[0]), __uint_as_float(rr[1])); }
    constexpr float C2 = 1.4426950408889634f * SCALE;
    if (__builtin_expect(__all((pmax - m_reg) * SCALE <= THR), 1)) { mn = m_reg; alpha = 1.f; }
    else { mn = fmaxf(m_reg, pmax); alpha = __builtin_amdgcn_exp2f((m_reg - mn) * C2); m_reg = mn; }
    const float mnL = -mn * C2;
    for (int r = 0; r < 16; ++r) p0[r] = fmaf(p0[r], C2, mnL); for (int r = 0; r < 16; ++r) p1[r] = fmaf(p1[r], C2, mnL);
    for (int r = 0; r < 16; ++r) p0[r] = __builtin_amdgcn_exp2f(p0[r]);
}
__device__ __forceinline__ void finishSM(f32x16& p0, f32x16& p1, float alpha, float& l_reg, bf16x8& pa0, bf16x8& pa1, bf16x8& pa2, bf16x8& pa3) {
    for (int r = 0; r < 16; ++r) p1[r] = __builtin_amdgcn_exp2f(p1[r]);
    float ps = 0; for (int r = 0; r < 16; ++r) ps += p0[r]; for (int r = 0; r < 16; ++r) ps += p1[r];
    { auto rr = __builtin_amdgcn_permlane32_swap(__float_as_uint(ps), __float_as_uint(ps), false, false);
      ps = __uint_as_float(rr[0]) + __uint_as_float(rr[1]); }
    l_reg = l_reg * alpha + ps;
#define PK4(P, B_, OUT) do { unsigned a0 = cvtpk(P[B_+0], P[B_+1]), a1 = cvtpk(P[B_+2], P[B_+3]);                          \
        unsigned b0 = cvtpk(P[B_+4], P[B_+5]), b1 = cvtpk(P[B_+6], P[B_+7]);                                             \
        auto r0 = __builtin_amdgcn_permlane32_swap(a0, b0, false, false); auto r1 = __builtin_amdgcn_permlane32_swap(a1, b1, false, false); \
        u32x4 w = {r0[0], r1[0], r0[1], r1[1]}; OUT = *reinterpret_cast<bf16x8*>(&w); } while (0)
    PK4(p0, 0, pa0); PK4(p0, 8, pa1); PK4(p1, 0, pa2); PK4(p1, 8, pa3);
#undef PK4
}
template <int KB>
__device__ __forceinline__ void qkt(f32x16& p0, f32x16& p1, const char* K_lds, const char* KR_lds, const bf16x8* qrl, int r32, int hi, const bf16x8* qr) {
    p0 = f32x16{}; p1 = f32x16{};
    __builtin_amdgcn_s_setprio(1);
    const char* kb[4];
#pragma unroll
    for (int dd = 0; dd < 4; ++dd) kb[dd] = K_lds + KB * SHM_K + KSWZ(r32, (dd * 16 + hi * 8) * 2);
#pragma unroll
    for (int d0 = 0; d0 < 8; ++d0) { const char* a = kb[d0 & 3] + (d0 >> 2) * 128;
        bf16x8 b0 = *reinterpret_cast<const bf16x8*>(a);
        bf16x8 b1 = *reinterpret_cast<const bf16x8*>(a + 32 * 256);
        bf16x8 q; if (d0 < NQREG) q = qr[d0]; else q = qrl[(d0 - NQREG) * 64];
        p0 = __builtin_amdgcn_mfma_f32_32x32x16_bf16(b0, q, p0, 0, 0, 0);
        p1 = __builtin_amdgcn_mfma_f32_32x32x16_bf16(b1, q, p1, 0, 0, 0); }
#pragma unroll
    for (int d = 0; d < 4; ++d) { const char* a = KR_lds + KB * SHM_KR + KRSWZ(r32, (d * 16 + hi * 8) * 2);
        bf16x8 b0 = *reinterpret_cast<const bf16x8*>(a);
        bf16x8 b1 = *reinterpret_cast<const bf16x8*>(a + 32 * 128);
        bf16x8 q = qrl[(NQREG_L + d) * 64];
        p0 = __builtin_amdgcn_mfma_f32_32x32x16_bf16(b0, q, p0, 0, 0, 0);
        p1 = __builtin_amdgcn_mfma_f32_32x32x16_bf16(b1, q, p1, 0, 0, 0); }
    __builtin_amdgcn_s_setprio(0);
}
template <int VB>
__device__ __forceinline__ void pv_tile(f32x16* o, int vb0, bf16x8 pa0, bf16x8 pa1, bf16x8 pa2, bf16x8 pa3) {
#define TRRD(dst, off) asm volatile("ds_read_b64_tr_b16 %0, %1 offset:%2" : "=&v"(dst) : "v"(vb0), "i"(off) : "memory")
#define PV_D0(d0) do { s16x4 l0, l1, l2, l3, h0, h1, h2, h3; constexpr int b_ = OFF_V + VB * SHM_V + v_rd_off(d0, 0, 0); \
        TRRD(l0, b_); TRRD(h0, b_ + 2048); TRRD(l1, b_ + 4096); TRRD(h1, b_ + 6144); TRRD(l2, b_ + 8192); TRRD(h2, b_ + 10240); TRRD(l3, b_ + 12288); TRRD(h3, b_ + 14336); \
        asm volatile("s_waitcnt lgkmcnt(0)" ::: "memory"); SBAR();   \
        o[d0] = __builtin_amdgcn_mfma_f32_32x32x16_bf16(pa0, (bf16x8){l0[0], l0[1], l0[2], l0[3], h0[0], h0[1], h0[2], h0[3]}, o[d0], 0, 0, 0);   \
        o[d0] = __builtin_amdgcn_mfma_f32_32x32x16_bf16(pa1, (bf16x8){l1[0], l1[1], l1[2], l1[3], h1[0], h1[1], h1[2], h1[3]}, o[d0], 0, 0, 0);   \
        o[d0] = __builtin_amdgcn_mfma_f32_32x32x16_bf16(pa2, (bf16x8){l2[0], l2[1], l2[2], l2[3], h2[0], h2[1], h2[2], h2[3]}, o[d0], 0, 0, 0);   \
        o[d0] = __builtin_amdgcn_mfma_f32_32x32x16_bf16(pa3, (bf16x8){l3[0], l3[1], l3[2], l3[3], h3[0], h3[1], h3[2], h3[3]}, o[d0], 0, 0, 0); } while (0)
    __builtin_amdgcn_s_setprio(1); PV_D0(0); PV_D0(1); PV_D0(2); PV_D0(3); __builtin_amdgcn_s_setprio(0);
#undef PV_D0
#undef TRRD
}

struct BlockRef { const u16* Q; const u16* K; const u16* V; const u16* KR; u16* O; int P0; };
struct Seam { bf16x8 st_v0, st_v1; };
#define ROWK(p, k0, rr) ((p) + (size_t)((k0) + (rr)) * LDK + sc)
#define VMW() asm volatile("s_waitcnt vmcnt(0)" ::: "memory")
#define VMWN(n) asm volatile("s_waitcnt vmcnt(%0)" :: "i"(n) : "memory")
#define ATT_LAS __attribute__((address_space(3)))
#define SLOAD_H(Kp, Vp, KRp, k0, bf) do { S.st_v0 = load8(ROWK(Vp, k0, sr)); S.st_v1 = load8(ROWK(Vp, k0, 32 + sr));              \
        __builtin_amdgcn_global_load_lds((const unsigned*)((Kp) + (size_t)((k0) + sr) * LDK + ksc), (ATT_LAS unsigned*)(ldsL + OFF_K + (bf) * SHM_K + wid * 1024), 16, 0, 0); \
        __builtin_amdgcn_global_load_lds((const unsigned*)((Kp) + (size_t)((k0) + 32 + sr) * LDK + ksc), (ATT_LAS unsigned*)(ldsL + OFF_K + (bf) * SHM_K + 8192 + wid * 1024), 16, 0, 0); \
        __builtin_amdgcn_global_load_lds((const unsigned*)((KRp) + (size_t)((k0) + krr) * LDKR + krsc), (ATT_LAS unsigned*)(ldsL + OFF_KR + (bf) * SHM_KR + wid * 1024), 16, 0, 0); } while (0)
#define SWRITE_HK(bf) do { } while (0)
#define SWRITE_HV(bf) do { *(bf16x8*)(V_lds + (bf) * SHM_V + vst0) = S.st_v0; *(bf16x8*)(V_lds + (bf) * SHM_V + vst1) = S.st_v1; } while (0)
#define SWRITE_H(bf) do { SWRITE_HV(bf); SWRITE_HK(bf); } while (0)
__device__ __forceinline__ void attn_prime(const BlockRef& cur, char* lds, Seam& S, int tid0) {
    int tid_ = tid0; asm volatile("" : "+v"(tid_));
    const int tid = tid_, wid = __builtin_amdgcn_readfirstlane(tid >> 6), lane = tid & 63, r32 = lane & 31, hi = lane >> 5;
    const int sr = tid >> 4, sc = (tid & 15) * 8, ksc = ((tid & 15) ^ (sr & 7)) * 8;
    const int krr = tid >> 3, krsc = ((tid & 7) ^ (krr & 7)) * 8; ATT_LAS unsigned char* ldsL = (ATT_LAS unsigned char*)lds;
    SLOAD_H(cur.K, cur.V, cur.KR, 0, 0); VMW();
    __syncthreads();
}
__device__ __forceinline__ void attn_block(const BlockRef& cur, const BlockRef& nxt, char* lds, Seam& S, int tid0) {
    int tid_ = tid0; asm volatile("" : "+v"(tid_));
    const int tid = tid_, wid = __builtin_amdgcn_readfirstlane(tid >> 6), lane = tid & 63, r32 = lane & 31, hi = lane >> 5;
    const unsigned W = 0x40000000u;
    const int NT = (cur.P0 + QB - 1) / KVBLK + 1;
    const int qlo = cur.P0 + wid * QBLK, qm = qlo + r32 - 4 * hi;
    char* V_lds = lds + OFF_V; char* K_lds = lds + OFF_K; char* KR_lds = lds + OFF_KR;
    float* ws = (float*)(lds + OFF_WS) + wid * 64; float* li_l = ws, * al_l = ws + 32;
    bf16x8* qrl = (bf16x8*)(lds + OFF_QR + wid * QR_WAVE) + lane;
    float m_reg = -1e30f, l_reg = 0; f32x16 o[4] = {};
    const int sr = tid >> 4, sc = (tid & 15) * 8, vst0 = v_st(sr, sc), vst1 = v_st(32 + sr, sc), ksc = ((tid & 15) ^ (sr & 7)) * 8;
    const int krr = tid >> 3, krsc = ((tid & 7) ^ (krr & 7)) * 8; ATT_LAS unsigned char* ldsL = (ATT_LAS unsigned char*)lds;
    const int vb0 = (int)(uintptr_t)lds + v_rd_base(lane);
    const u16* Kh = cur.K; const u16* Vh = cur.V; const u16* KRh = cur.KR;
#define RESC(a) do { if (__any((a) < 1.f)) { if (hi == 0) al_l[r32] = (a); asm volatile("s_waitcnt lgkmcnt(0)" ::: "memory");              \
                     for (int d_ = 0; d_ < 4; ++d_) for (int r = 0; r < 16; ++r) o[d_][r] *= al_l[crow(r, hi)]; } } while (0)
#define KBASE(t) ((t) * KVBLK)
#define MASKT(P0_, P1_, t) do { const int kb_ = KBASE(t); if (kb_ + KVBLK - 1 > qlo) mask_tile(P0_, P1_, qm - kb_, W); } while (0)
#define SEAM_K0() do { VMW(); SWRITE_HK(0); SBAR(); } while (0)
    f32x16 pA0, pA1, pB0, pB1; float mnA, mnB, alA, alB; bf16x8 pa0, pa1, pa2, pa3;
    bf16x8 qr[NQREG > 0 ? NQREG : 1];
    { const u16* qp = cur.Q + (size_t)(wid * QBLK + r32) * LDQ + hi * 8;
#pragma unroll
      for (int d = 0; d < NQREG_L + 4; ++d) qrl[d * 64] = load8(qp + (NQREG + d) * 16);
#pragma unroll
      for (int d0 = 0; d0 < NQREG; ++d0) qr[d0] = load8(qp + d0 * 16); }
    SWRITE_HV(0); SBAR();
    if (NT > 1) SLOAD_H(Kh, Vh, KRh, KBASE(1), 1);
    SBAR(); qkt<0>(pA0, pA1, K_lds, KR_lds, qrl, r32, hi, qr);
    MASKT(pA0, pA1, 0); partialSM(pA0, pA1, m_reg, mnA, alA);
    if (NT > 1) { VMW(); SWRITE_H(1); }
    __syncthreads();
#define HALF_STEP(PX0, PX1, mnX, alX, PY0, PY1, alY, t, KB, VB, SB) do {                                                      \
        SBAR(); qkt<KB>(PX0, PX1, K_lds, KR_lds, qrl, r32, hi, qr);                                                          \
        finishSM(PY0, PY1, alY, l_reg, pa0, pa1, pa2, pa3); SBAR();                                                           \
        if ((t) + 1 < NT) { SLOAD_H(Kh, Vh, KRh, KBASE((t) + 1), SB); SBAR(); }                                                   \
        pv_tile<VB>(o, vb0, pa0, pa1, pa2, pa3); MASKT(PX0, PX1, (t)); partialSM(PX0, PX1, m_reg, mnX, alX);                  \
        __syncthreads();                                                                                                      \
        if ((t) + 1 < NT) { VMW(); SWRITE_H(SB); }                                                                            \
        RESC(alX); __syncthreads(); } while (0)
    for (int t = 1; t + 1 < NT; t += 2) {
        HALF_STEP(pB0, pB1, mnB, alB, pA0, pA1, alA, t, 1, 0, 0);
        HALF_STEP(pA0, pA1, mnA, alA, pB0, pB1, alB, t + 1, 0, 1, 1);
    }
    const bool even = (NT & 1) == 0;
    if (even) { SBAR(); qkt<1>(pB0, pB1, K_lds, KR_lds, qrl, r32, hi, qr); SBAR(); }
    SLOAD_H(nxt.K, nxt.V, nxt.KR, 0, 0); SBAR();
    finishSM(pA0, pA1, alA, l_reg, pa0, pa1, pa2, pa3); SBAR();
    pv_tile<0>(o, vb0, pa0, pa1, pa2, pa3);
    if (even) { MASKT(pB0, pB1, NT - 1); partialSM(pB0, pB1, m_reg, mnB, alB); __syncthreads(); RESC(alB);
        finishSM(pB0, pB1, alB, l_reg, pa0, pa1, pa2, pa3); SBAR(); pv_tile<1>(o, vb0, pa0, pa1, pa2, pa3); }
    SBAR(); SEAM_K0();
    if (hi == 0) li_l[r32] = l_reg; asm volatile("s_waitcnt lgkmcnt(0)" ::: "memory");
    float rli[16];
#pragma unroll
    for (int r = 0; r < 16; ++r) rli[r] = __builtin_amdgcn_rcpf(li_l[crow(r, hi)]);
    u16* Ow = cur.O + (size_t)(wid * QBLK) * LDO;
#pragma unroll
    for (int r = 0; r < 16; ++r) { const int orow = crow(r, hi);
#pragma unroll
        for (int d0 = 0; d0 < 4; ++d0) { const float v = o[d0][r] * rli[r];
            const float vn = xor1f(v);
            if ((r32 & 1) == 0) *(unsigned*)(Ow + (size_t)orow * LDO + d0 * 32 + r32) = cvtpk(v, vn); } }
    __syncthreads();
#undef RESC
#undef KBASE
#undef MASKT
#undef SEAM_K0
#undef HALF_STEP
}
struct Tensors { const u16* q; const u16* kv; const u16* kr; u16* o; };
__device__ __forceinline__ BlockRef make_ref(const Tensors& T, int L, int pass) {
    const int bh = (L & 7) + 8 * (L >> 8), x = (L >> 3) & 31, b = bh >> 3, h = bh & 7, qb = pass ? 63 - x : x;
    BlockRef r; const size_t row0 = (size_t)b * SEQ;
    r.Q = T.q + (row0 + (size_t)qb * QB) * LDQ + h * 192; r.K = T.kv + row0 * LDK + h * 256; r.V = r.K + 128; r.KR = T.kr + row0 * LDKR;
    r.O = T.o + (row0 + (size_t)qb * QB) * LDO + h * 128; r.P0 = qb * QB;
    return r;
}
__device__ __forceinline__ void attn_phase(char* lds, const Tensors& T, int tid0) {
    const int total = 512, stride = gridDim.x;
    int L = blockIdx.x; if (L >= total) return;
    int pass = 0;
    BlockRef cur = make_ref(T, L, 0);
    Seam S;
    attn_prime(cur, lds, S, tid0);
    for (;;) {
        const bool more_pass = pass == 0, more_item = L + stride < total, last = !more_pass && !more_item;
        int passn = pass + 1, Ln = L;
        if (!more_pass) { passn = 0; Ln = more_item ? L + stride : L; }
        const BlockRef nxt = last ? cur : make_ref(T, Ln, passn);
        attn_block(cur, nxt, lds, S, tid0);
        if (last) break;
        cur = nxt; pass = passn; L = Ln;
    }
}
#undef ROWK
#undef VMW
#undef VMWN
#undef SLOAD_H
#undef SWRITE_HK
#undef SWRITE_HV
#undef SWRITE_H
#undef SBAR
}
namespace xb {
#define LAS __attribute__((address_space(3)))
#define XB_TMO      128
#define XB_XCNT(j)  (256  + 64 * (j))
#define XB_XSUB(j)  (1280 + 64 * (j))
#define XB_XGEN(j)  (2304 + 64 * (j))
#define XB_TOP      3328
#define XB_TOPGEN   3392
#define XCD_BAR_WORDS 3456
#define XB_SPIN_CAP (1u << 18)

__device__ __forceinline__ unsigned xb_ld(unsigned* p)              { return __hip_atomic_load(p, __ATOMIC_RELAXED, __HIP_MEMORY_SCOPE_AGENT); }
__device__ __forceinline__ unsigned xb_add(unsigned* p, unsigned v) { return __hip_atomic_fetch_add(p, v, __ATOMIC_RELAXED, __HIP_MEMORY_SCOPE_AGENT); }
__device__ __forceinline__ unsigned xb_xcc_id() { return (unsigned)__builtin_amdgcn_s_getreg((3 << 11) | 20) & 0xFu; }
#define XB_SPIN(cond, bar) do { unsigned _sp = 0; while (cond) { __builtin_amdgcn_s_sleep(1); \
    if ((++_sp & 255u) == 0u) { if (xb_ld(&(bar)[XB_TMO])) break; if (_sp > XB_SPIN_CAP) { atomicAdd(&(bar)[XB_TMO], 1u); break; } } } } while (0)

struct XcdBarrier {
    unsigned* bar; unsigned x;
    volatile LAS unsigned* st;
};

__device__ __forceinline__ XcdBarrier xcd_barrier_post(unsigned* bar, volatile LAS unsigned* st) {
    XcdBarrier b; b.bar = bar; b.x = xb_xcc_id(); b.st = st;
    if (threadIdx.x == 0) (void)xb_add(&bar[XB_XCNT(b.x)], 1u);
    return b;
}
__device__ __forceinline__ void xcd_barrier_complete(unsigned* bar, unsigned x, unsigned& nloc, unsigned& nx) {
    const unsigned G = gridDim.x * gridDim.y * gridDim.z;
    unsigned sum, cnt, mine, sp = 0u;
    for (;;) {
        sum = 0u; cnt = 0u; mine = 0u;
#pragma unroll
        for (unsigned j = 0; j < 16; ++j) { const unsigned c = xb_ld(&bar[XB_XCNT(j)]); sum += c; cnt += (c > 0u) ? 1u : 0u; mine = (j == x) ? c : mine; }
        if (sum == G) break;
        __builtin_amdgcn_s_sleep(1);
        if ((++sp & 255u) == 0u) { if (xb_ld(&bar[XB_TMO])) break; if (sp > XB_SPIN_CAP) { atomicAdd(&bar[XB_TMO], 1u); break; } }
    }
    nloc = mine > 0u ? mine : 1u; nx = cnt > 0u ? cnt : 1u;
}

__device__ __forceinline__ void xcd_barrier(const XcdBarrier& b, bool t0  ) {
    asm volatile("s_waitcnt vmcnt(0)" ::: "memory");
    __syncthreads();
    if (t0) {
        unsigned* bar = b.bar;
        __builtin_amdgcn_s_waitcnt(0);
        unsigned nloc = b.st[0], nx = b.st[1];
        if (nloc == 0u) { xcd_barrier_complete(bar, b.x, nloc, nx); b.st[0] = nloc; b.st[1] = nx; }
        const unsigned old = xb_add(&bar[XB_XSUB(b.x)], 1u);
        const unsigned gen = old / nloc;
        if (old + 1u == (gen + 1u) * nloc) {
            __builtin_amdgcn_fence(__ATOMIC_RELEASE, "agent");
            asm volatile("s_waitcnt vmcnt(0)" ::: "memory");
            const unsigned og = xb_add(&bar[XB_TOP], 1u);
            const unsigned tg = og / nx;
            if (og + 1u == (tg + 1u) * nx) xb_add(&bar[XB_TOPGEN], 1u);
            else XB_SPIN(xb_ld(&bar[XB_TOPGEN]) == tg, bar);
            __builtin_amdgcn_fence(__ATOMIC_ACQUIRE, "agent");
            xb_add(&bar[XB_XGEN(b.x)], 1u);
            asm volatile("s_waitcnt vmcnt(0)" ::: "memory");
        } else {
            XB_SPIN(xb_ld(&bar[XB_XGEN(b.x)]) == gen, bar);
            __builtin_amdgcn_fence(__ATOMIC_ACQUIRE, "agent");
            asm volatile("s_waitcnt vmcnt(0)" ::: "memory");
        }
    }
    __syncthreads();
}
#undef LAS
}
#ifndef PROBE_ATT_REPS
#define PROBE_ATT_REPS 1
#endif
#ifndef PROBE_SYNC_REPS
#define PROBE_SYNC_REPS 1
#endif
#ifndef PROBE_THIN_REPS
#define PROBE_THIN_REPS 1
#endif
#ifndef PROBE_PRO_REPS
#define PROBE_PRO_REPS 1
#endif
#ifndef PROBE_GEMM_REPS
#define PROBE_GEMM_REPS 1
#endif
namespace mk {
typedef unsigned short u16;
typedef float f32x4 __attribute__((ext_vector_type(4)));
constexpr int M = 32768, D = 1024, SEQ = 16384;
constexpr float EPS = 1e-6f;
constexpr size_t MB = (size_t)1 << 20;
__host__ __device__ constexpr size_t WT_MLA(int j) { return (size_t)j * 6 * MB; }
__host__ __device__ constexpr size_t WT_LRU(int j) { return 12 * MB + (size_t)j * 8 * MB; }
__host__ __device__ constexpr size_t WT_FFN(int l) { return 28 * MB + (size_t)l * 16 * MB; }
constexpr size_t OFF_UQ = 3 * MB / 2, OFF_UKV = 11 * MB / 4, OFF_WO = 15 * MB / 4, OFF_GT = 4 * MB, OFF_LOUT = 5 * MB, OFF_DOWN = 8 * MB;
constexpr size_t WS_COS = 96 * MB, WS_SIN = 100 * MB, WS_SA = 104 * MB, WS_SB = 105 * MB;
constexpr size_t WS_HN = 112 * MB, WS_Y = 176 * MB, WS_U = 240 * MB, WS_END = 496 * MB;
constexpr size_t U_PROJ = 64 * MB, U_CQ = 112 * MB, U_CKV = 136 * MB, U_KR = 152 * MB, U_Q = 160 * MB, U_O = 64 * MB;
constexpr size_t U_GATE = 0, U_XC = 64 * MB, U_REC = 128 * MB, U_LA = 128 * MB, U_B = 192 * MB;
constexpr size_t WS_RS = 108 * MB;
constexpr int SCAN_L = 128, SCAN_NC = SEQ / SCAN_L;

__device__ __forceinline__ unsigned f2bf(float f) { unsigned u = __float_as_uint(f); return (u + 0x7fffu + ((u >> 16) & 1u)) >> 16; }
__device__ __forceinline__ unsigned pk2(float lo, float hi) { return f2bf(lo) | (f2bf(hi) << 16); }
__device__ __forceinline__ float bflo(unsigned w) { return __uint_as_float(w << 16); }
__device__ __forceinline__ float bfhi(unsigned w) { return __uint_as_float(w & 0xffff0000u); }
__device__ __forceinline__ float bf1(u16 h) { return __uint_as_float(((unsigned)h) << 16); }
__device__ __forceinline__ float wave_sum(float v) {
    v += xor1f(v); v += xor2f(v); v += xor4f(v); v += xor8f(v); v += xor16f(v);
    return sum32f(v);
}
__device__ __forceinline__ void transpose_item(const float* W, int ldw, u16* WT, int ldt, int nblk, float* scr, int item, int lane) {
    const int kb = item / nblk, nb = item % nblk, k0 = 64 * kb, n0 = 32 * nb;
#pragma unroll 8
    for (int i = 0; i < 32; ++i) { const int kk = 2 * i + (lane >> 5); scr[kk * 33 + (lane & 31)] = W[(size_t)(k0 + kk) * ldw + n0 + (lane & 31)]; }
    asm volatile("s_waitcnt lgkmcnt(0)" ::: "memory");
    const int c = lane & 7;
#pragma unroll
    for (int j = 0; j < 4; ++j) { const int n = (lane >> 3) + 8 * j; const float* s = scr + (8 * c) * 33 + n;
        uint4 o; o.x = pk2(s[0 * 33], s[1 * 33]); o.y = pk2(s[2 * 33], s[3 * 33]); o.z = pk2(s[4 * 33], s[5 * 33]); o.w = pk2(s[6 * 33], s[7 * 33]);
        *(uint4*)(WT + (size_t)(n0 + n) * ldt + k0 + 8 * c) = o; }
    asm volatile("s_waitcnt lgkmcnt(0)" ::: "memory");
}
struct Params { const float* in[23]; float* out; unsigned char* ws; };
enum { I_X = 0, I_POS, I_MIXPRE, I_MIXPOST, I_FFNPRE, I_FFNPOST, I_MLA_WIN, I_MLA_QN, I_MLA_KVN, I_MLA_WUQ, I_MLA_WUKV, I_MLA_WO,
       I_LRU_WIN, I_LRU_CW, I_LRU_CB, I_LRU_WA, I_LRU_BA, I_LRU_WX, I_LRU_BX, I_LRU_LAM, I_LRU_WOUT, I_FFN_UP, I_FFN_DOWN };

__device__ __forceinline__ void prologue_weights(const __attribute__((address_space(4))) Params& p, float* scr, int gw, int NGW, int lane) {
    u16* wt = (u16*)p.ws;
    constexpr int IT_MLA = 352 + 288 + 256 + 512, IT_LRU = 1024 + 128 + 512, IT_FFN = 4096, TOTAL = 2 * IT_MLA + 2 * IT_LRU + 4 * IT_FFN;
    for (int it = gw; it < TOTAL; it += NGW) {
        int r = it; const float* W; int ldw, ldt, nblk; u16* WT;
        if (r < 2 * IT_MLA) { const int j = r / IT_MLA; r -= j * IT_MLA; u16* base = wt + WT_MLA(j) / 2;
            if (r < 352) { W = p.in[I_MLA_WIN] + (size_t)j * 1024 * 704; ldw = 704; nblk = 22; WT = base; ldt = 1024; }
            else if (r < 640) { r -= 352; W = p.in[I_MLA_WUQ] + (size_t)j * 384 * 1536; ldw = 1536; nblk = 48; WT = base + OFF_UQ / 2; ldt = 384; }
            else if (r < 896) { r -= 640; W = p.in[I_MLA_WUKV] + (size_t)j * 256 * 2048; ldw = 2048; nblk = 64; WT = base + OFF_UKV / 2; ldt = 256; }
            else { r -= 896; W = p.in[I_MLA_WO] + (size_t)j * 1024 * 1024; ldw = 1024; nblk = 32; WT = base + OFF_WO / 2; ldt = 1024; }
        } else if (r < 2 * IT_MLA + 2 * IT_LRU) { r -= 2 * IT_MLA; const int j = r / IT_LRU; r -= j * IT_LRU; u16* base = wt + WT_LRU(j) / 2;
            if (r < 1024) { W = p.in[I_LRU_WIN] + (size_t)j * 1024 * 2048; ldw = 2048; nblk = 64; WT = base; ldt = 1024; }
            else if (r < 1152) { r -= 1024; const int which = r >> 3, gt = which >> 3, n = which & 7; r &= 7;
                W = p.in[gt ? I_LRU_WX : I_LRU_WA] + (size_t)j * 8 * 128 * 128 + (size_t)n * 128 * 128; ldw = 128; nblk = 4;
                WT = base + OFF_GT / 2 + (size_t)(n * 256 + gt * 128) * 256 + 128 * (n & 1); ldt = 256; }
            else { r -= 1152; W = p.in[I_LRU_WOUT] + (size_t)j * 1024 * 1024; ldw = 1024; nblk = 32; WT = base + OFF_LOUT / 2; ldt = 1024; }
        } else { r -= 2 * IT_MLA + 2 * IT_LRU; const int l = r / IT_FFN; r -= l * IT_FFN; u16* base = wt + WT_FFN(l) / 2;
            if (r < 2048) { W = p.in[I_FFN_UP] + (size_t)l * 1024 * 4096; ldw = 4096; nblk = 128; WT = base; ldt = 1024; }
            else { r -= 2048; W = p.in[I_FFN_DOWN] + (size_t)l * 4096 * 1024; ldw = 1024; nblk = 32; WT = base + OFF_DOWN / 2; ldt = 4096; }
        }
        transpose_item(W, ldw, WT, ldt, nblk, scr, r, lane);
    }
}
__device__ __forceinline__ void rowop(const u16* y, const float* xin, float* xout, u16* hn, float* rs, const float* gpost, const float* gpre, int gw, int NGW, int lane) {
    f32x4 gp[4], gq[4];
#pragma unroll
    for (int j = 0; j < 4; ++j) { gp[j] = gpost ? *(const f32x4*)(gpost + j * 256 + lane * 4) : (f32x4){0.f, 0.f, 0.f, 0.f}; gq[j] = gpre ? *(const f32x4*)(gpre + j * 256 + lane * 4) : (f32x4){0.f, 0.f, 0.f, 0.f}; }
    for (int row = gw; row < M; row += NGW) {
        f32x4 xv[4];
#pragma unroll
        for (int j = 0; j < 4; ++j) xv[j] = *(const f32x4*)(xin + (size_t)row * D + j * 256 + lane * 4);
        if (y) {
            f32x4 yv[4]; float ss = 0.f;
#pragma unroll
            for (int j = 0; j < 4; ++j) { const uint2 w = *(const uint2*)(y + (size_t)row * D + j * 256 + lane * 4);
                yv[j] = (f32x4){bflo(w.x), bfhi(w.x), bflo(w.y), bfhi(w.y)}; ss += (yv[j].x * yv[j].x + yv[j].y * yv[j].y) + (yv[j].z * yv[j].z + yv[j].w * yv[j].w); }
            const float r = rsqrtf(wave_sum(ss) * (1.f / D) + EPS);
#pragma unroll
            for (int j = 0; j < 4; ++j) xv[j] = xv[j] + (yv[j] * r) * gp[j];
        }
        if (xout) {
#pragma unroll
        for (int j = 0; j < 4; ++j) *(f32x4*)(xout + (size_t)row * D + j * 256 + lane * 4) = xv[j]; }
        if (gpre) {
            float s2 = 0.f;
#pragma unroll
            for (int j = 0; j < 4; ++j) s2 += (xv[j].x * xv[j].x + xv[j].y * xv[j].y) + (xv[j].z * xv[j].z + xv[j].w * xv[j].w);
            const float ms2 = wave_sum(s2) * (1.f / D) + EPS; const float r2 = rsqrtf(ms2);
            if (rs && lane == 0) rs[row] = ms2 * r2;
#pragma unroll
            for (int j = 0; j < 4; ++j) { const f32x4 h = (xv[j] * r2) * gq[j]; uint2 w; w.x = pk2(h.x, h.y); w.y = pk2(h.z, h.w);
                *(uint2*)(hn + (size_t)row * D + j * 256 + lane * 4) = w; }
        }
    }
}
__device__ __forceinline__ void qkvnorm(const u16* proj, u16* cq, u16* ckv, u16* kr, const float* qn, const float* kvn, const float* ctab, const float* stab, int gw, int NGW, int lane) {
    float gq[6], gk[4];
#pragma unroll
    for (int j = 0; j < 6; ++j) gq[j] = qn[lane + 64 * j];
#pragma unroll
    for (int j = 0; j < 4; ++j) gk[j] = kvn[lane + 64 * j];
    for (int row = gw; row < M; row += NGW) {
        const u16* pr = proj + (size_t)row * 768;
        float a[6], b[4], s1 = 0.f, s2 = 0.f;
#pragma unroll
        for (int j = 0; j < 6; ++j) { a[j] = bf1(pr[lane + 64 * j]); s1 += a[j] * a[j]; }
#pragma unroll
        for (int j = 0; j < 4; ++j) { b[j] = bf1(pr[384 + lane + 64 * j]); s2 += b[j] * b[j]; }
        const float x1 = bf1(pr[640 + (lane & 31)]), x2 = bf1(pr[672 + (lane & 31)]);
        const float r1 = rsqrtf(wave_sum(s1) * (1.f / 384.f) + EPS), r2 = rsqrtf(wave_sum(s2) * (1.f / 256.f) + EPS);
#pragma unroll
        for (int j = 0; j < 6; ++j) cq[(size_t)row * 384 + lane + 64 * j] = (u16)f2bf(a[j] * r1 * gq[j]);
#pragma unroll
        for (int j = 0; j < 4; ++j) ckv[(size_t)row * 256 + lane + 64 * j] = (u16)f2bf(b[j] * r2 * gk[j]);
        const float c = ctab[(size_t)row * 32 + (lane & 31)], s = stab[(size_t)row * 32 + (lane & 31)];
        kr[(size_t)row * 64 + lane] = (u16)f2bf(lane < 32 ? x1 * c - x2 * s : x2 * c + x1 * s);
    }
}
__device__ __forceinline__ void qrope(u16* q, const float* ctab, const float* stab, int gw, int NGW, int lane) {
    for (int row = gw; row < M; row += NGW) {
        u16* qr = q + (size_t)row * 1536; const int i = lane & 31;
        const float c = ctab[(size_t)row * 32 + i], s = stab[(size_t)row * 32 + i];
#pragma unroll
        for (int j = 0; j < 4; ++j) { const int h = 2 * j + (lane >> 5); u16* pp = qr + h * 192 + 128 + i;
            const float x1 = bf1(pp[0]), x2 = bf1(pp[32]);
            pp[0] = (u16)f2bf(x1 * c - x2 * s); pp[32] = (u16)f2bf(x2 * c + x1 * s); }
    }
}
__device__ __forceinline__ void conv_phase(const u16* rec, u16* xc, const float* cw, const float* cb, int gtid, int NGT) {
    for (int idx = gtid; idx < M * 128; idx += NGT) {
        const int row = idx >> 7, c0 = (idx & 127) * 8, s = row & (SEQ - 1);
        float acc[8];
#pragma unroll
        for (int e = 0; e < 8; ++e) acc[e] = cb[c0 + e];
#pragma unroll
        for (int k = 0; k < 4; ++k) { if (s - 3 + k >= 0) {
            const uint4 w = *(const uint4*)(rec + (size_t)(row - 3 + k) * D + c0);
            const float v[8] = {bflo(w.x), bfhi(w.x), bflo(w.y), bfhi(w.y), bflo(w.z), bfhi(w.z), bflo(w.w), bfhi(w.w)};
#pragma unroll
            for (int e = 0; e < 8; ++e) acc[e] += v[e] * cw[k * D + c0 + e]; } }
        uint4 o; o.x = pk2(acc[0], acc[1]); o.y = pk2(acc[2], acc[3]); o.z = pk2(acc[4], acc[5]); o.w = pk2(acc[6], acc[7]);
        *(uint4*)(xc + (size_t)row * D + c0) = o;
    }
}
__device__ __forceinline__ void scanA(const u16* A, const u16* B, float* SA, float* SB, int tid) {
    for (int item = blockIdx.x; item < 2 * SCAN_NC * 2; item += gridDim.x) {
        const int half = item & 1, c = (item >> 1) % SCAN_NC, b = item / (2 * SCAN_NC), ch = half * 512 + tid;
        const size_t base = ((size_t)b * SEQ + (size_t)c * SCAN_L) * D + ch;
        float h = 0.f, P = 1.f;
        for (int t0 = 0; t0 < SCAN_L; t0 += 16) {
            u16 aw[16], bw[16];
#pragma unroll
            for (int u = 0; u < 16; ++u) { aw[u] = A[base + (size_t)(t0 + u) * D]; bw[u] = B[base + (size_t)(t0 + u) * D]; }
#pragma unroll
            for (int u = 0; u < 16; ++u) { const float a = __expf(bf1(aw[u])); h = a * h + bf1(bw[u]); P *= a; }
        }
        SA[((size_t)b * SCAN_NC + c) * D + ch] = P; SB[((size_t)b * SCAN_NC + c) * D + ch] = h;
    }
}
__device__ __forceinline__ void scanC(const u16* A, const u16* B, const float* SA, const float* SB, const u16* gate, u16* hg, int tid) {
    for (int item = blockIdx.x; item < 2 * SCAN_NC * 2; item += gridDim.x) {
        const int half = item & 1, c = (item >> 1) % SCAN_NC, b = item / (2 * SCAN_NC), ch = half * 512 + tid;
        const size_t base = ((size_t)b * SEQ + (size_t)c * SCAN_L) * D + ch;
        float h = 0.f;
        for (int cc = 0; cc < c; ++cc) { const size_t so = ((size_t)b * SCAN_NC + cc) * D + ch; h = SA[so] * h + SB[so]; }
        for (int t0 = 0; t0 < SCAN_L; t0 += 16) {
            u16 aw[16], bw[16], gv[16];
#pragma unroll
            for (int u = 0; u < 16; ++u) { aw[u] = A[base + (size_t)(t0 + u) * D]; bw[u] = B[base + (size_t)(t0 + u) * D]; gv[u] = gate[base + (size_t)(t0 + u) * D]; }
#pragma unroll
            for (int u = 0; u < 16; ++u) { h = __expf(bf1(aw[u])) * h + bf1(bw[u]); hg[base + (size_t)(t0 + u) * D] = (u16)f2bf(bf1(gv[u]) * h); }
        }
    }
}

constexpr int LDS_MAIN = att::LDS_BYTES > pg8::STAGE_BYTES ? att::LDS_BYTES : pg8::STAGE_BYTES, LDS_BYTES = LDS_MAIN + 16;
constexpr size_t WS_BAR = 106 * MB;
constexpr size_t WS_CNT1 = WS_BAR + 16384, WS_CNT2 = WS_BAR + 49152, CTL_BYTES = 81920, WS_XS1 = 107 * MB, WS_XS2 = 107 * MB + MB / 2;
constexpr int XL_OFF = 131072;
static_assert(XL_OFF + 8192 <= LDS_MAIN && XCD_BAR_WORDS * 4 <= 16384 && att::LDS_BYTES <= LDS_MAIN && pg8::STAGE_BYTES <= LDS_MAIN && LDS_BYTES <= 160 * 1024, "LDS map");

__global__ void __launch_bounds__(512, 2) fwd_mega(Params p_arg) {
    extern __shared__ __attribute__((aligned(16))) unsigned char lds[];
    cg::grid_group grid = cg::this_grid();
    (void)p_arg;
    volatile __attribute__((address_space(3))) unsigned* bst = (volatile __attribute__((address_space(3))) unsigned*)((__attribute__((address_space(3))) unsigned char*)lds + LDS_MAIN);
    if (threadIdx.x < 4) bst[threadIdx.x] = 0u;
    __syncthreads();
    const int wave_s = __builtin_amdgcn_readfirstlane(threadIdx.x >> 6);
    const unsigned bar_x = xb::xb_xcc_id();
    (void)xb::xcd_barrier_post((unsigned*)(p_arg.ws + WS_BAR), bst);
#define GRID_BAR() do { unsigned bx_ = bar_x; asm volatile("" : "+s"(bx_)); xb::XcdBarrier bb_; bb_.bar = (unsigned*)(ws + WS_BAR); bb_.x = bx_; bb_.st = bst; xb::xcd_barrier(bb_, tid == 0); } while (0)
    typedef const __attribute__((address_space(4))) Params* KParams;
    KParams pp = (KParams)__builtin_amdgcn_kernarg_segment_ptr();
#define FRESH() int tid_ = wave_s * 64 + lane_id_fresh(); asm volatile("" : "+v"(tid_)); asm volatile("" : "+s"(pp)); const __attribute__((address_space(4))) Params& p = *pp; \
    const int tid = tid_, lane = tid & 63, wave = __builtin_amdgcn_readfirstlane(tid >> 6); \
    const int G = gridDim.x, gw = blockIdx.x * 8 + wave, NGW = G * 8, gtid = blockIdx.x * 512 + tid, NGT = G * 512; \
    unsigned char* ws = p.ws; float* x = p.out; u16* hn = (u16*)(ws + WS_HN); u16* ybuf = (u16*)(ws + WS_Y); unsigned char* U = ws + WS_U; \
    float* ctab = (float*)(ws + WS_COS); float* stab = (float*)(ws + WS_SIN); float* SA = (float*)(ws + WS_SA); float* SB = (float*)(ws + WS_SB); \
    (void)lane; (void)wave; (void)gw; (void)NGW; (void)gtid; (void)NGT; (void)x; (void)hn; (void)ybuf; (void)U; (void)ctab; (void)stab; (void)SA; (void)SB;
    {
    FRESH();

    for (int prep = 0; prep < PROBE_PRO_REPS; ++prep) {
    prologue_weights(p, (float*)lds + wave * (64 * 33), gw, NGW, lane);
    for (int i = gtid; i < 2 * 2048 * 16; i += NGT) { const int j = i >> 15, row = (i >> 4) & 2047, chn = i & 15, n = row >> 8;
        *(uint4*)((u16*)(ws + WT_LRU(j) + OFF_GT) + (size_t)row * 256 + 128 * ((n & 1) ^ 1) + chn * 8) = make_uint4(0u, 0u, 0u, 0u); }
    { const int* pos = (const int*)p.in[I_POS];
      for (int i = gtid; i < M * 32; i += NGT) { const int row = i >> 5, f = i & 31;
        const float inv = __builtin_amdgcn_exp2f(-(float)f * (13.287712379549449f / 32.f));
        const float ang = (float)pos[row] * inv;
        double rev = (double)ang * 0.15915494309189535; rev -= __builtin_rint(rev);
        ctab[i] = __builtin_amdgcn_cosf((float)rev); stab[i] = __builtin_amdgcn_sinf((float)rev); } }
    rowop(nullptr, p.in[I_X], nullptr, hn, (float*)(ws + WS_RS), nullptr, p.in[I_MIXPRE], gw, NGW, lane);
    }
    if (ws == nullptr) grid.sync();
    GRID_BAR();
    }

#pragma nounroll
    for (int layer = 0; layer < 4; ++layer) {
#pragma nounroll
        for (int op = 0; op < 10; ++op) {
            FRESH();
            const int j = layer >> 1; const bool lru = (layer & 1) != 0;
            const u16* wtm = (const u16*)(ws + WT_MLA(j)); const u16* wtl = (const u16*)(ws + WT_LRU(j)); const u16* wtf = (const u16*)(ws + WT_FFN(layer));
            int gk = 0;
            pg8::Gemm g{}; pg8::EpiB E{};
            if (op == 6 || op == 9) continue;
            const float* gprev = p.in[op == 5 ? I_MIXPRE : I_FFNPRE] + layer * D;
            const float* gpost = p.in[op == 5 ? I_MIXPOST : I_FFNPOST] + layer * D;
            const float* gpre = op == 5 ? p.in[I_FFNPRE] + layer * D : (layer < 3 ? p.in[I_MIXPRE] + (layer + 1) * D : nullptr);
            if (op == 7) { gk = 1; g = pg8::Gemm{hn, wtf, M, 4096, 1024, 1024, 1024, 0}; E = pg8::EpiB{(u16*)U, 4096, 0, 0, 1}; }
            else if (op == 8) { gk = 3; g = pg8::Gemm{(const u16*)U, wtf + OFF_DOWN / 2, M, 1024, 4096, 4096, 4096, 0}; }
            else if (!lru) {
                u16* proj = (u16*)(U + U_PROJ); u16* cq = (u16*)(U + U_CQ); u16* ckv = (u16*)(U + U_CKV); u16* kr = (u16*)(U + U_KR); u16* q = (u16*)(U + U_Q); u16* o = (u16*)(U + U_O); u16* kv = ybuf;
                if (op == 0) { gk = 1; g = pg8::Gemm{hn, wtm, M, 768, 1024, 1024, 1024, 0}; E = pg8::EpiB{proj, 768, 0, 0, 0}; }
                else if (op == 1) for (int rep = 0; rep < PROBE_THIN_REPS; ++rep) qkvnorm(proj, cq, ckv, kr, p.in[I_MLA_QN] + j * 384, p.in[I_MLA_KVN] + j * 256, ctab, stab, gw, NGW, lane);
                else if (op == 2) { gk = 1; g = pg8::Gemm{cq, wtm + OFF_UQ / 2, M, 1536, 384, 384, 384, 0}; E = pg8::EpiB{q, 1536, 0, 0, 0}; }
                else if (op == 3) { qrope(q, ctab, stab, gw, NGW, lane); gk = 1; g = pg8::Gemm{ckv, wtm + OFF_UKV / 2, M, 2048, 256, 256, 256, 0}; E = pg8::EpiB{kv, 2048, 0, 0, 0}; }
                else if (op == 4) { const att::Tensors T{q, kv, kr, o}; for (int rep = 0; rep < PROBE_ATT_REPS; ++rep) att::attn_phase((char*)lds, T, tid); }
                else { gk = 3; g = pg8::Gemm{o, wtm + OFF_WO / 2, M, 1024, 1024, 1024, 1024, 0}; }
            } else {
                u16* gate = (u16*)(U + U_GATE); u16* xc = (u16*)(U + U_XC); u16* rec = (u16*)(U + U_REC); u16* Bb = (u16*)(U + U_B); u16* Ab = (u16*)(U + U_LA); u16* hg = xc;
                if (op == 0) { gk = 1; g = pg8::Gemm{hn, wtl, M, 2048, 1024, 1024, 1024, 0}; E = pg8::EpiB{gate, 1024, 1024, (size_t)(U_REC - U_GATE) / 2, 2}; }
                else if (op == 1) for (int rep = 0; rep < PROBE_THIN_REPS; ++rep) conv_phase(rec, xc, p.in[I_LRU_CW] + j * 4 * D, p.in[I_LRU_CB] + j * D, gtid, NGT);
                else if (op == 2) { gk = 2; g = pg8::Gemm{xc, wtl + OFF_GT / 2, M, 2048, 256, 1024, 256, 512}; }
                else if (op == 3) for (int rep = 0; rep < PROBE_THIN_REPS; ++rep) scanA(Ab, Bb, SA, SB, tid);
                else if (op == 4) for (int rep = 0; rep < PROBE_THIN_REPS; ++rep) scanC(Ab, Bb, SA, SB, gate, hg, tid);
                else { gk = 3; g = pg8::Gemm{hg, wtl + OFF_LOUT / 2, M, 1024, 1024, 1024, 1024, 0}; }
            }
            for (int rep = 0; rep < PROBE_GEMM_REPS; ++rep)
            if (gk == 1) { pg8::StaticOrder S; S.init(g.M, g.N, G, (int)blockIdx.x);
                pg8::gemm_phase<pg8::EpiB, pg8::StaticOrder, true>((PG8_LAS unsigned char*)lds, g, S, E, tid); }
            else if (gk == 2) { pg8::StaticOrder S; S.init(g.M, g.N, G, (int)blockIdx.x);
                const pg8::EpiGate EG{(const u16*)(U + U_XC), (u16*)(U + U_LA), (u16*)(U + U_B), p.in[I_LRU_BA] + j * D, p.in[I_LRU_BX] + j * D, p.in[I_LRU_LAM] + j * D};
                pg8::gemm_phase<pg8::EpiGate, pg8::StaticOrder, true>((PG8_LAS unsigned char*)lds, g, S, EG, tid); }
            else if (gk == 3) { pg8::StaticOrder S; S.init(g.M, g.N, G, (int)blockIdx.x);
                const unsigned target = 32u * (unsigned)(layer * 2 + (op == 8 ? 2 : 1));
                const pg8::RowStats st1{(float*)(ws + WS_XS1), (unsigned*)(ws + WS_CNT1), target}, st2{(float*)(ws + WS_XS2), (unsigned*)(ws + WS_CNT2), target};
                const pg8::EpiNormRes EN{hn, (float*)(ws + WS_RS), x, gprev, gpost, gpre, st1, st2, (PG8_LAS unsigned char*)lds + XL_OFF};
                pg8::gemm_phase<pg8::EpiNormRes, pg8::StaticOrder, true>((PG8_LAS unsigned char*)lds, g, S, EN, tid); }
            if (!(layer == 3 && op == 8)) { for (int rep = 0; rep < PROBE_SYNC_REPS; ++rep) GRID_BAR(); }
        }
    }
}
}

extern "C" void kernel_launch(void* const* d_in, const int* in_sizes, int n_in, void* d_out, int out_size, void* d_ws, size_t ws_size, hipStream_t stream) {
    static int grid = 0;
    if (grid == 0) {
        if (n_in != 23 || in_sizes[0] != mk::M * mk::D || out_size != mk::M * mk::D || ws_size < mk::WS_END) {
            fprintf(stderr, "kernel_launch: unexpected shapes (n_in %d, in0 %d, out %d, ws %zu); nothing launched\n", n_in, n_in > 0 ? in_sizes[0] : -1, out_size, ws_size); grid = -1; return; }
        int dev = 0, cus = 0, per_cu = 0;
        (void)hipGetDevice(&dev); (void)hipDeviceGetAttribute(&cus, hipDeviceAttributeMultiprocessorCount, dev);
        if (hipFuncSetAttribute((const void*)mk::fwd_mega, hipFuncAttributeMaxDynamicSharedMemorySize, mk::LDS_BYTES) != hipSuccess) { fprintf(stderr, "kernel_launch: hipFuncSetAttribute failed\n"); grid = -1; return; }
        if (hipOccupancyMaxActiveBlocksPerMultiprocessor(&per_cu, (const void*)mk::fwd_mega, 512, mk::LDS_BYTES) != hipSuccess || per_cu < 1) { fprintf(stderr, "kernel_launch: occupancy query says %d blocks per CU\n", per_cu); per_cu = 1; }
        (void)hipGetLastError();
        grid = cus > 0 ? cus : 256;
    }
    if (grid < 0) return;
    mk::Params p{};
    for (int i = 0; i < 23; ++i) p.in[i] = (const float*)d_in[i];
    p.out = (float*)d_out; p.ws = (unsigned char*)d_ws;
    if (hipMemsetAsync((char*)d_ws + mk::WS_BAR, 0, mk::CTL_BYTES, stream) != hipSuccess) { fprintf(stderr, "kernel_launch: hipMemsetAsync failed\n"); return; }
    void* args[] = {&p};
    hipError_t e = hipLaunchCooperativeKernel((const void*)mk::fwd_mega, dim3(grid), dim3(512), args, mk::LDS_BYTES, stream);
    if (e != hipSuccess) fprintf(stderr, "kernel_launch: cooperative launch failed: %s (grid %d)\n", hipGetErrorString(e), grid);
}
```

```cpp
#include <hip/hip_runtime.h>
#include <hip/hip_bf16.h>
#include <hip/hip_cooperative_groups.h>
#include <cstdio>
#include <cstdint>
namespace cg = cooperative_groups;

__device__ __forceinline__ float xor1f(float v)  { return __int_as_float(__builtin_amdgcn_mov_dpp(__float_as_int(v), 0xB1, 0xF, 0xF, false)); }
__device__ __forceinline__ float xor2f(float v)  { return __int_as_float(__builtin_amdgcn_mov_dpp(__float_as_int(v), 0x4E, 0xF, 0xF, false)); }
__device__ __forceinline__ float xor4f(float v)  { return __int_as_float(__builtin_amdgcn_ds_swizzle(__float_as_int(v), 0x101F)); }
__device__ __forceinline__ float xor8f(float v)  { return __int_as_float(__builtin_amdgcn_ds_swizzle(__float_as_int(v), 0x201F)); }
__device__ __forceinline__ float xor16f(float v) { return __int_as_float(__builtin_amdgcn_ds_swizzle(__float_as_int(v), 0x401F)); }
__device__ __forceinline__ float sum32f(float v) { auto rr = __builtin_amdgcn_permlane32_swap(__float_as_uint(v), __float_as_uint(v), false, false); return __uint_as_float(rr[0]) + __uint_as_float(rr[1]); }
__device__ __forceinline__ int lane_id_fresh() { int l; asm volatile("v_mbcnt_lo_u32_b32 %0, -1, 0\n\tv_mbcnt_hi_u32_b32 %0, -1, %0" : "=v"(l)); return l; }
namespace pg8 {
#define PG8_LAS __attribute__((address_space(3)))
typedef unsigned short bf16_t;
typedef short bf16x8 __attribute__((ext_vector_type(8)));
typedef float f32x4 __attribute__((ext_vector_type(4)));
typedef unsigned u32x4 __attribute__((ext_vector_type(4)));
constexpr int BM = 256, BK = 64, HALF = 128, HTB = HALF * BK * 2  , STAGE_BYTES = 8 * HTB, NXCD = 8, WGM = 8;

__host__ __device__ __forceinline__ int lds_byte(int r, int c) { const int st = (r >> 4) * 2 + (c >> 5), rr = r & 15, cc = c & 31, ob = rr * 64 + cc * 2; return st * 1024 + (ob ^ (((ob >> 9) & 1) << 5)); }
__host__ __device__ __forceinline__ void stage_rc(int b, int& R, int& C) { const int st = b / 1024, sb = b % 1024, swz = sb ^ (((sb >> 9) & 1) << 5); R = (st >> 1) * 16 + swz / 64; C = (st & 1) * 32 + (swz % 64) / 2; }
__host__ __device__ __forceinline__ int perm32(int rho) { const int n = rho >> 4, i = rho & 15; return 8 * (i >> 2) + 4 * n + (i & 3); }

struct Unit { int pm, pn; };
struct Gemm { const bf16_t* A; const bf16_t* Bt; int M, N, K; int lda, ldb; int apn; };

struct StaticOrder {
    int nM, nN, nwg, G, c;
    __host__ __device__ void init(int M, int N, int G_, int c_) { nM = M / BM; nN = N / BM; nwg = nM * nN; G = G_; c = c_; }
    __host__ __device__ bool next(int i, Unit& u) const {
        const long L = (long)i * G + c; if (L >= nwg) return false;
        int wgid = (int)L; { const int q = nwg / NXCD, r = nwg % NXCD, xcd = wgid % NXCD, off = wgid / NXCD; wgid = (xcd < r ? xcd * (q + 1) : r * (q + 1) + (xcd - r) * q) + off; }
        const int nig = WGM * nN, gid = wgid / nig, fm = gid * WGM, gsz = (nM - fm) < WGM ? (nM - fm) : WGM;
        u.pm = fm + ((wgid % nig) % gsz); u.pn = (wgid % nig) / gsz; return true;
    }
    __device__ __forceinline__ void a_ready(const Unit&) const {}
    __device__ __forceinline__ void done(const Unit&) const {}
};

__device__ __forceinline__ unsigned cvt_pk_bf16(float lo, float hi) { unsigned r; asm volatile("v_cvt_pk_bf16_f32 %0, %1, %2" : "=v"(r) : "v"(lo), "v"(hi)); return r; }
__device__ __forceinline__ float gelu_tanh(float x) {
    const float z = 0.7978845608028654f * (x + 0.044715f * x * x * x);
    const float e = __expf(2.0f * z);
    const float th = 1.0f - 2.0f * __builtin_amdgcn_rcpf(1.0f + e);
    return 0.5f * x * (1.0f + th);
}
struct EpiB {
    static constexpr bool PERM = true, AFTER_DRAIN = false, FUSED = false;
    bf16_t* O; int ldc; int split_cols; size_t split_stride; int mode;
    __device__ __forceinline__ void operator()(const f32x4 (&acc)[2][2][4][2], const Unit& u, int wr, int wc, int fr, int fq) const {
        const int row0 = u.pm * BM + wr * 64 + fr; int colt = u.pn * BM; bf16_t* base = O; int t = 0;
        if (split_cols) { t = colt / split_cols; base += (size_t)t * split_stride; colt -= t * split_cols; }
        const int act = (mode == 1) ? 1 : ((mode == 2 && t == 0) ? 2 : 0);
        const int col0 = colt + wc * 32 + 8 * fq;
#pragma unroll
        for (int ai = 0; ai < 2; ++ai)
#pragma unroll
            for (int m = 0; m < 4; ++m) { bf16_t* rowp = base + (size_t)(row0 + ai * HALF + m * 16) * ldc + col0;
#pragma unroll
                for (int bj = 0; bj < 2; ++bj) { f32x4 v0 = acc[ai][bj][m][0], v1 = acc[ai][bj][m][1];
                    if (act == 1) {
#pragma unroll
                        for (int e = 0; e < 4; ++e) { const float a = fmaxf(v0[e], 0.f), b = fmaxf(v1[e], 0.f); v0[e] = a * a; v1[e] = b * b; } }
                    else if (act == 2) {
#pragma unroll
                        for (int e = 0; e < 4; ++e) { v0[e] = gelu_tanh(v0[e]); v1[e] = gelu_tanh(v1[e]); } }
                    u32x4 w; w.x = cvt_pk_bf16(v0[0], v0[1]); w.y = cvt_pk_bf16(v0[2], v0[3]); w.z = cvt_pk_bf16(v1[0], v1[1]); w.w = cvt_pk_bf16(v1[2], v1[3]);
                    *(u32x4*)(rowp + bj * HALF) = w; } }
    }
};
__device__ __forceinline__ float bf2f(unsigned short h) { return __uint_as_float(((unsigned)h) << 16); }
__device__ __forceinline__ float sigmoidf_(float x) { return __builtin_amdgcn_rcpf(1.0f + __expf(-x)); }
__device__ __forceinline__ float one_minus_exp(float t) { const float ser = -t * (1.0f + t * (0.5f + t * (0.16666667f + t * (0.041666668f + t * 0.008333334f)))); return t > -0.25f ? ser : 1.0f - __expf(t); }
struct EpiGate {
    static constexpr bool PERM = false, AFTER_DRAIN = false, FUSED = false;
    const bf16_t* xc; bf16_t* Aout; bf16_t* Bout; const float* b_a; const float* b_x; const float* lam;
    __device__ __forceinline__ void operator()(const f32x4 (&acc)[2][2][4][2], const Unit& u, int wr, int wc, int fr, int fq) const {
#pragma unroll
        for (int n = 0; n < 2; ++n) {
            const int ch0 = 128 * u.pn + 32 * wc + 16 * n + 4 * fq;
            const f32x4 ba = *(const f32x4*)(b_a + ch0), bx = *(const f32x4*)(b_x + ch0), lm = *(const f32x4*)(lam + ch0);
            f32x4 sp;
#pragma unroll
            for (int e = 0; e < 4; ++e) sp[e] = -8.0f * log1pf(__expf(-lm[e]));
#pragma unroll
            for (int ai = 0; ai < 2; ++ai)
#pragma unroll
                for (int m = 0; m < 4; ++m) {
                    const size_t off = (size_t)(u.pm * BM + ai * HALF + wr * 64 + m * 16 + fr) * 1024 + ch0;
                    const uint2 xr = *(const uint2*)(xc + off);
                    float xv[4] = { __uint_as_float(xr.x << 16), __uint_as_float(xr.x & 0xffff0000u), __uint_as_float(xr.y << 16), __uint_as_float(xr.y & 0xffff0000u) };
                    f32x4 av, bv;
#pragma unroll
                    for (int e = 0; e < 4; ++e) {
                        const float r = sigmoidf_(acc[ai][0][m][n][e] + ba[e]);
                        const float ig = sigmoidf_(acc[ai][1][m][n][e] + bx[e]);
                        const float la = sp[e] * r;
                        av[e] = la;
                        bv[e] = __builtin_amdgcn_sqrtf(fmaxf(one_minus_exp(2.0f * la), 0.f)) * (ig * xv[e]);
                    }
                    uint2 wa, wb; wa.x = cvt_pk_bf16(av[0], av[1]); wa.y = cvt_pk_bf16(av[2], av[3]); wb.x = cvt_pk_bf16(bv[0], bv[1]); wb.y = cvt_pk_bf16(bv[2], bv[3]);
                    *(uint2*)(Aout + off) = wa; *(uint2*)(Bout + off) = wb;
                }
        }
    }
};

struct RowStats {
    float* xbuf;
    unsigned* cnt;
    unsigned target;
    __device__ __forceinline__ void run(const f32x4 (&v)[2][2][4][2], const Unit& u, int wr, int wc, int fr, int fq, PG8_LAS unsigned char* xl, int wid, int lane) const {
        PG8_LAS float* P = (PG8_LAS float*)xl;
        PG8_LAS float* S = (PG8_LAS float*)(xl + 4096);
#pragma unroll
        for (int ai = 0; ai < 2; ++ai)
#pragma unroll
            for (int m = 0; m < 4; ++m) {
                float s = 0.f;
#pragma unroll
                for (int bj = 0; bj < 2; ++bj)
#pragma unroll
                    for (int n = 0; n < 2; ++n) { const f32x4 x = v[ai][bj][m][n]; s += (x[0] * x[0] + x[1] * x[1]) + (x[2] * x[2] + x[3] * x[3]); }
                s += xor16f(s); s = sum32f(s);
                if (fq == 0) P[(ai * HALF + wr * 64 + m * 16 + fr) * 4 + wc] = s;
            }
        asm volatile("s_waitcnt lgkmcnt(0)" ::: "memory"); __builtin_amdgcn_s_barrier(); asm volatile("" ::: "memory");
        const int row = wid * 32 + (lane & 31);
        if (lane < 32) { const float t = (P[row * 4 + 0] + P[row * 4 + 1]) + (P[row * 4 + 2] + P[row * 4 + 3]);
            __hip_atomic_store(xbuf + (size_t)(u.pm * BM + row) * 4 + u.pn, t, __ATOMIC_RELAXED, __HIP_MEMORY_SCOPE_AGENT); }
        asm volatile("s_waitcnt vmcnt(0)" ::: "memory");
        if (lane == 0) __hip_atomic_fetch_add(cnt + 64 * u.pm, 1u, __ATOMIC_RELAXED, __HIP_MEMORY_SCOPE_AGENT);
        if (wid == 0) { unsigned sp = 0;
            while ((unsigned)__builtin_amdgcn_readfirstlane(__hip_atomic_load(cnt + 64 * u.pm, __ATOMIC_RELAXED, __HIP_MEMORY_SCOPE_AGENT)) < target) { __builtin_amdgcn_s_sleep(2); if (++sp > (1u << 18)) break; }
            __builtin_amdgcn_fence(__ATOMIC_ACQUIRE, "agent"); }
        asm volatile("s_waitcnt vmcnt(0) lgkmcnt(0)" ::: "memory"); __builtin_amdgcn_s_barrier(); asm volatile("" ::: "memory");
        if (lane < 32) { float* slot = xbuf + (size_t)(u.pm * BM + row) * 4; float t = 0.f;
#pragma unroll
            for (int k = 0; k < 4; ++k) t += __hip_atomic_load(slot + k, __ATOMIC_RELAXED, __HIP_MEMORY_SCOPE_AGENT);
            S[row] = t; }
        asm volatile("s_waitcnt lgkmcnt(0)" ::: "memory"); __builtin_amdgcn_s_barrier(); asm volatile("" ::: "memory");
    }
};
struct EpiNormRes {
    static constexpr bool PERM = false, AFTER_DRAIN = false, FUSED = true;
    bf16_t* hn; float* rs; float* out; const float* gprev; const float* gpost; const float* gpre; RowStats st1, st2; PG8_LAS unsigned char* xl;
    __device__ __forceinline__ void fused(f32x4 (&acc)[2][2][4][2], const Unit& u, int wr, int wc, int fr, int fq, int wid, int lane) const {
        typedef unsigned u32x2v __attribute__((ext_vector_type(2)));
        const PG8_LAS float* S = (const PG8_LAS float*)(xl + 4096);
        const int col0 = u.pn * BM + wc * 32 + 4 * fq;
        st1.run(acc, u, wr, wc, fr, fq, xl, wid, lane);
#pragma unroll
        for (int ai = 0; ai < 2; ++ai)
#pragma unroll
            for (int m = 0; m < 4; ++m) { const int r = ai * HALF + wr * 64 + m * 16 + fr; const float rstd = rsqrtf(S[r] * (1.0f / 1024.0f) + 1e-6f); const size_t off = (size_t)(u.pm * BM + r) * 1024 + col0;
                const float rsc = rs[u.pm * BM + r];
#pragma unroll
                for (int bj = 0; bj < 2; ++bj)
#pragma unroll
                    for (int n = 0; n < 2; ++n) { const u32x2v hw = *(const u32x2v*)(hn + off + bj * HALF + n * 16);
                        const f32x4 gp = *(const f32x4*)(gprev + col0 + bj * HALF + n * 16); const f32x4 gv = *(const f32x4*)(gpost + col0 + bj * HALF + n * 16);
                        f32x4 xs; xs[0] = __uint_as_float(hw.x << 16) * __builtin_amdgcn_rcpf(gp[0]); xs[1] = __uint_as_float(hw.x & 0xffff0000u) * __builtin_amdgcn_rcpf(gp[1]);
                        xs[2] = __uint_as_float(hw.y << 16) * __builtin_amdgcn_rcpf(gp[2]); xs[3] = __uint_as_float(hw.y & 0xffff0000u) * __builtin_amdgcn_rcpf(gp[3]);
                        acc[ai][bj][m][n] = xs * rsc + (acc[ai][bj][m][n] * rstd) * gv; }
                asm volatile("" : "+v"(acc[ai][0][m][0]), "+v"(acc[ai][0][m][1]), "+v"(acc[ai][1][m][0]), "+v"(acc[ai][1][m][1]));
                if (m & 1) asm volatile("" ::: "memory"); }
        if (gpre) {
            st2.run(acc, u, wr, wc, fr, fq, xl, wid, lane);
#pragma unroll
            for (int ai = 0; ai < 2; ++ai)
#pragma unroll
                for (int m = 0; m < 4; ++m) { const int r = ai * HALF + wr * 64 + m * 16 + fr; const float ms = S[r] * (1.0f / 1024.0f) + 1e-6f; const float rstd = rsqrtf(ms); const size_t off = (size_t)(u.pm * BM + r) * 1024 + col0;
                    if (u.pn == 0 && wc == 0 && fq == 0) rs[u.pm * BM + r] = ms * rstd;
#pragma unroll
                    for (int bj = 0; bj < 2; ++bj)
#pragma unroll
                        for (int n = 0; n < 2; ++n) { const f32x4 x1 = acc[ai][bj][m][n];
                            const f32x4 gv = *(const f32x4*)(gpre + col0 + bj * HALF + n * 16); const f32x4 o = (x1 * rstd) * gv;
                            u32x2v w; w.x = cvt_pk_bf16(o[0], o[1]); w.y = cvt_pk_bf16(o[2], o[3]); *(u32x2v*)(hn + off + bj * HALF + n * 16) = w; }
                    asm volatile("" ::: "memory"); }
        } else {
#pragma unroll
            for (int ai = 0; ai < 2; ++ai)
#pragma unroll
                for (int m = 0; m < 4; ++m) { const int r = ai * HALF + wr * 64 + m * 16 + fr; const size_t off = (size_t)(u.pm * BM + r) * 1024 + col0;
#pragma unroll
                    for (int bj = 0; bj < 2; ++bj)
#pragma unroll
                        for (int n = 0; n < 2; ++n) *(f32x4*)(out + off + bj * HALF + n * 16) = acc[ai][bj][m][n]; }
        }
    }
};

template <class Epi, class Sched, bool ALIGN_EPI>
__device__ __forceinline__ void gemm_phase(PG8_LAS unsigned char* lds, const Gemm g, const Sched& S, const Epi& E, int tid0) {
    int tid_ = tid0; asm volatile("" : "+v"(tid_));
    const int tid = tid_, wid = __builtin_amdgcn_readfirstlane(tid >> 6), lane = tid & 63, wr = wid >> 2, wc = wid & 3, fr = lane & 15, fq = lane >> 4;
    const int K = g.K, nt = K / BK;
    unsigned voffA[2], voffB[2];
#pragma unroll
    for (int i = 0; i < 2; ++i) { int R, C; stage_rc(tid * 16 + i * 8192, R, C); const int Rb = Epi::PERM ? ((R & ~31) + perm32(R & 31)) : R;
        voffA[i] = (unsigned)(R * g.lda + C) * 2u; voffB[i] = (unsigned)(Rb * g.ldb + C) * 2u; }
    const size_t kstep = (size_t)(BK * 2);
    const size_t hstepA = (size_t)HALF * g.lda * 2, hstepB = (size_t)HALF * g.ldb * 2;
    const size_t tstepA = 2 * hstepA, tstepB = 2 * hstepB;
    const unsigned ldsw = (unsigned)wid * 1024u;
    const int aoff = lds_byte(wr * 64 + fr, fq * 8), boff = lds_byte(wc * 32 + fr, fq * 8);
#define PG8_SA(b, h) (((b) * 2 + (h)) * HTB)
#define PG8_SB(b, h) ((4 + (b) * 2 + (h)) * HTB)
#define PG8_STAGE(bufoff, gbase, voff) do { _Pragma("unroll") for (int _i = 0; _i < 2; ++_i) \
        __builtin_amdgcn_global_load_lds((const unsigned*)((const char*)(gbase) + (voff)[_i]), (PG8_LAS unsigned*)(lds + (bufoff) + ldsw + _i * 8192), 16, 0, 0); } while (0)
#define PG8_LDA(dst, b, h) do { _Pragma("unroll") for (int m = 0; m < 4; ++m) _Pragma("unroll") for (int k = 0; k < 2; ++k) dst[m][k] = *(const PG8_LAS bf16x8*)(lds + PG8_SA(b, h) + aoff + m * 2048 + k * 1024); } while (0)
#define PG8_LDB(dst, b, h) do { _Pragma("unroll") for (int n = 0; n < 2; ++n) _Pragma("unroll") for (int k = 0; k < 2; ++k) dst[n][k] = *(const PG8_LAS bf16x8*)(lds + PG8_SB(b, h) + boff + n * 2048 + k * 1024); } while (0)
#define PG8_MMA(ai, bj, At, Bt) do { __builtin_amdgcn_s_setprio(1); _Pragma("unroll") for (int m = 0; m < 4; ++m) _Pragma("unroll") for (int n = 0; n < 2; ++n) _Pragma("unroll") for (int k = 0; k < 2; ++k) \
        acc[ai][bj][m][n] = __builtin_amdgcn_mfma_f32_16x16x32_bf16(Bt[n][k], At[m][k], acc[ai][bj][m][n], 0, 0, 0); __builtin_amdgcn_s_setprio(0); } while (0)
#define PG8_WAIT_V(n) asm volatile("s_waitcnt vmcnt(" #n ")" ::: "memory")
#define PG8_WAIT_L(n) asm volatile("s_waitcnt lgkmcnt(" #n ")" ::: "memory")
#define PG8_BAR __builtin_amdgcn_s_barrier()
#define PG8_SCHED __builtin_amdgcn_sched_barrier(0)
    Unit cur, nxt; int ui = 0;
    if (!S.next(0, cur)) return;
    f32x4 acc[2][2][4][2];
#pragma unroll
    for (int a = 0; a < 2; ++a)
#pragma unroll
        for (int b = 0; b < 2; ++b)
#pragma unroll
            for (int m = 0; m < 4; ++m)
#pragma unroll
                for (int n = 0; n < 2; ++n) acc[a][b][m][n] = (f32x4){0.f, 0.f, 0.f, 0.f};
    bf16x8 At[4][2], B0[2][2], B1[2][2];
    const char* cA = (const char*)g.A + (size_t)cur.pm * tstepA + (size_t)(cur.pn >> 1) * (size_t)g.apn; const char* cB = (const char*)g.Bt + (size_t)cur.pn * tstepB;
    S.a_ready(cur);
    PG8_STAGE(PG8_SB(0, 0), cB, voffB); PG8_STAGE(PG8_SB(0, 1), cB + hstepB, voffB); PG8_STAGE(PG8_SA(0, 0), cA, voffA); PG8_STAGE(PG8_SA(0, 1), cA + hstepA, voffA);
    if (wr == 1) PG8_BAR;
    PG8_WAIT_V(2); PG8_BAR;
    PG8_STAGE(PG8_SB(1, 0), cB + kstep, voffB); PG8_STAGE(PG8_SA(1, 0), cA + kstep, voffA); PG8_STAGE(PG8_SB(1, 1), cB + hstepB + kstep, voffB);
    PG8_WAIT_V(6); PG8_BAR;
    for (;;) {
        const bool has_next = S.next(ui + 1, nxt);
        const char* nA = has_next ? (const char*)g.A + (size_t)nxt.pm * tstepA + (size_t)(nxt.pn >> 1) * (size_t)g.apn : cA; const char* nB = has_next ? (const char*)g.Bt + (size_t)nxt.pn * tstepB : cB;
        for (int t = 0; t < nt; t += 2) {
            const bool last = (t == nt - 2);
            const char* a1 = cA + (size_t)(t + 1) * kstep;
            const char* a2 = last ? nA : cA + (size_t)(t + 2) * kstep; const char* b2 = last ? nB : cB + (size_t)(t + 2) * kstep;
            const char* a3 = a2 + kstep; const char* b3 = b2 + kstep;
            if (last && has_next) S.a_ready(nxt);
            PG8_LDB(B0, 0, 0); PG8_LDB(B1, 0, 1); PG8_SCHED; PG8_LDA(At, 0, 0); PG8_STAGE(PG8_SA(1, 1), a1 + hstepA, voffA);
            PG8_WAIT_V(8); PG8_WAIT_L(0); PG8_BAR; PG8_MMA(0, 0, At, B0); PG8_MMA(0, 1, At, B1); PG8_BAR; PG8_SCHED;
            PG8_LDA(At, 0, 1); PG8_STAGE(PG8_SB(0, 0), b2, voffB); PG8_STAGE(PG8_SB(0, 1), b2 + hstepB, voffB); PG8_STAGE(PG8_SA(0, 0), a2, voffA);
            PG8_WAIT_V(8); PG8_WAIT_L(0); PG8_BAR; PG8_MMA(1, 0, At, B0); PG8_MMA(1, 1, At, B1); PG8_BAR; PG8_SCHED;
            PG8_LDB(B0, 1, 0); PG8_LDB(B1, 1, 1); PG8_SCHED; PG8_LDA(At, 1, 0); PG8_STAGE(PG8_SA(0, 1), a2 + hstepA, voffA);
            PG8_WAIT_V(8); PG8_WAIT_L(0); PG8_BAR; PG8_MMA(0, 0, At, B0); PG8_MMA(0, 1, At, B1); PG8_BAR; PG8_SCHED;
            PG8_LDA(At, 1, 1); PG8_STAGE(PG8_SB(1, 0), b3, voffB); PG8_STAGE(PG8_SB(1, 1), b3 + hstepB, voffB); PG8_STAGE(PG8_SA(1, 0), a3, voffA);
            PG8_WAIT_V(8); PG8_WAIT_L(0); PG8_BAR; PG8_MMA(1, 0, At, B0); PG8_MMA(1, 1, At, B1); PG8_BAR; PG8_SCHED;
        }
        if constexpr (ALIGN_EPI) { if (wr == 0) PG8_BAR; }
        if constexpr (Epi::FUSED) E.fused(acc, cur, wr, wc, fr, fq, wid, lane); else E(acc, cur, wr, wc, fr, fq);
        S.done(cur);
        if (!has_next) break;
#pragma unroll
        for (int a = 0; a < 2; ++a)
#pragma unroll
            for (int b = 0; b < 2; ++b)
#pragma unroll
                for (int m = 0; m < 4; ++m)
#pragma unroll
                    for (int n = 0; n < 2; ++n) acc[a][b][m][n] = (f32x4){0.f, 0.f, 0.f, 0.f};
        cur = nxt; cA = nA; cB = nB; ++ui;
        if constexpr (ALIGN_EPI) { if (wr == 1) PG8_BAR; }
    }
    PG8_WAIT_V(0);
    if constexpr (!ALIGN_EPI) { if (wr == 0) PG8_BAR; }
    PG8_BAR;
#undef PG8_SA
#undef PG8_SB
#undef PG8_STAGE
#undef PG8_LDA
#undef PG8_LDB
#undef PG8_MMA
#undef PG8_WAIT_V
#undef PG8_WAIT_L
#undef PG8_BAR
#undef PG8_SCHED
}
}
namespace att {
typedef unsigned short u16;
typedef short bf16x8 __attribute__((ext_vector_type(8)));
typedef short s16x4 __attribute__((ext_vector_type(4)));
typedef float f32x16 __attribute__((ext_vector_type(16)));
typedef float f32x4 __attribute__((ext_vector_type(4)));
typedef unsigned u32x4 __attribute__((ext_vector_type(4)));
constexpr int SEQ = 16384, NW = 8, QBLK = 32, KVBLK = 64, QB = NW * QBLK;
constexpr int LDQ = 1536, LDK = 2048, LDKR = 64, LDO = 1024;
#ifndef ATT_NQREG
#define ATT_NQREG 4
#endif
constexpr int NQREG = ATT_NQREG, NQREG_L = 8 - NQREG;
constexpr int SHM_V = KVBLK * 128 * 2, SHM_K = KVBLK * 128 * 2, SHM_KR = KVBLK * 64 * 2;
constexpr int OFF_V = 0, OFF_K = 2 * SHM_V, OFF_KR = OFF_K + 2 * SHM_K, OFF_WS = OFF_KR + 2 * SHM_KR, OFF_QR = OFF_WS + NW * 64 * 4, QR_WAVE = (NQREG_L + 4) * 1024, LDS_BYTES = OFF_QR + NW * QR_WAVE;
constexpr float SCALE = 0.07216878364870322f;
constexpr float THR = 8.f;

#define KSWZ(row, colB) ((row) * 256 + ((colB) ^ (((row) & 7) << 4)))
#define KRSWZ(row, colB) ((row) * 128 + ((colB) ^ (((row) & 7) << 4)))
#define SBAR() __builtin_amdgcn_sched_barrier(0)
__device__ __forceinline__ int v_st(int k, int c) { const int kk = (k & ~0xC) | ((k & 4) << 1) | ((k & 8) >> 1); return ((kk >> 3) * 4 + (c >> 5)) * 512 + ((kk & 7) * 32 + (c & 31)) * 2; }
__device__ __forceinline__ int v_rd_base(int lane) { return ((lane & 3) << 3) | (((lane >> 2) & 3) << 6) | (((lane >> 4) & 1) << 5) | (((lane >> 5) & 1) << 8); }
constexpr int v_rd_off(int d0, int ks, int half) { return d0 * 512 + ks * 4096 + half * 2048; }
__device__ __forceinline__ int crow(int r, int hi) { return (r & 3) + 8 * (r >> 2) + 4 * hi; }
__device__ __forceinline__ unsigned cvtpk(float lo, float hi) { unsigned r; asm volatile("v_cvt_pk_bf16_f32 %0, %1, %2" : "=v"(r) : "v"(lo), "v"(hi)); return r; }
__device__ __forceinline__ bf16x8 load8(const u16* p) { return *reinterpret_cast<const bf16x8*>(p); }
__device__ __forceinline__ void mask_tile(f32x16& p0, f32x16& p1, int dq, unsigned W) {
    const float NEG = -__builtin_inff();
#pragma unroll
    for (int r = 0; r < 16; ++r) {
        const int c = (r & 3) + 8 * (r >> 2);
        if ((unsigned)(dq - c) >= W) p0[r] = NEG;
        if ((unsigned)(dq - c - 32) >= W) p1[r] = NEG;
    }
}
__device__ __forceinline__ void partialSM(f32x16& p0, f32x16& p1, float& m_reg, float& mn, float& alpha) {
    float pmax = p0[0]; for (int r = 1; r < 16; ++r) pmax = fmaxf(pmax, p0[r]); for (int r = 0; r < 16; ++r) pmax = fmaxf(pmax, p1[r]);
    { auto rr = __builtin_amdgcn_permlane32_swap(__float_as_uint(pmax), __float_as_uint(pmax), false, false);
      pmax = fmaxf(__uint_as_float(rr[0]), __uint_as_float(rr[1])); }
    constexpr float C2 = 1.4426950408889634f * SCALE;
    if (__builtin_expect(__all((pmax - m_reg) * SCALE <= THR), 1)) { mn = m_reg; alpha = 1.f; }
    else { mn = fmaxf(m_reg, pmax); alpha = __builtin_amdgcn_exp2f((m_reg - mn) * C2); m_reg = mn; }
    const float mnL = -mn * C2;
    for (int r = 0; r < 16; ++r) p0[r] = fmaf(p0[r], C2, mnL); for (int r = 0; r < 16; ++r) p1[r] = fmaf(p1[r], C2, mnL);
    for (int r = 0; r < 16; ++r) p0[r] = __builtin_amdgcn_exp2f(p0[r]);
}
__device__ __forceinline__ void finishSM(f32x16& p0, f32x16& p1, float alpha, float& l_reg, bf16x8& pa0, bf16x8& pa1, bf16x8& pa2, bf16x8& pa3) {
    for (int r = 0; r < 16; ++r) p1[r] = __builtin_amdgcn_exp2f(p1[r]);
    float ps = 0; for (int r = 0; r < 16; ++r) ps += p0[r]; for (int r = 0; r < 16; ++r) ps += p1[r];
    { auto rr = __builtin_amdgcn_permlane32_swap(__float_as_uint(ps), __float_as_uint(ps), false, false);
      ps = __uint_as_float(rr[0]) + __uint_as_float(rr[1]); }
    l_reg = l_reg * alpha + ps;
#define PK4(P, B_, OUT) do { unsigned a0 = cvtpk(P[B_+0], P[B_+1]), a1 = cvtpk(P[B_+2], P[B_+3]);                          \
        unsigned b0 = cvtpk(P[B_+4], P[B_+5]), b1 = cvtpk(P[B_+6], P[B_+7]);                                             \
        auto r0 = __builtin_amdgcn_permlane32_swap(a0, b0, false, false); auto r1 = __builtin_amdgcn_permlane32_swap(a1, b1, false, false); \
        u32x4 w = {r0[0], r1[0], r0[1], r1[1]}; OUT = *reinterpret_cast<bf16x8*>(&w); } while (0)
    PK4(p0, 0, pa0); PK4(p0, 8, pa1); PK4(p1, 0, pa2); PK4(p1, 8, pa3);
#undef PK4
}
template <int KB>
__device__ __forceinline__ void qkt(f32x16& p0, f32x16& p1, const char* K_lds, const char* KR_lds, const bf16x8* qrl, int r32, int hi, const bf16x8* qr) {
    p0 = f32x16{}; p1 = f32x16{};
    __builtin_amdgcn_s_setprio(1);
    const char* kb[4];
#pragma unroll
    for (int dd = 0; dd < 4; ++dd) kb[dd] = K_lds + KB * SHM_K + KSWZ(r32, (dd * 16 + hi * 8) * 2);
#pragma unroll
    for (int d0 = 0; d0 < 8; ++d0) { const char* a = kb[d0 & 3] + (d0 >> 2) * 128;
        bf16x8 b0 = *reinterpret_cast<const bf16x8*>(a);
        bf16x8 b1 = *reinterpret_cast<const bf16x8*>(a + 32 * 256);
        bf16x8 q; if (d0 < NQREG) q = qr[d0]; else q = qrl[(d0 - NQREG) * 64];
        p0 = __builtin_amdgcn_mfma_f32_32x32x16_bf16(b0, q, p0, 0, 0, 0);
        p1 = __builtin_amdgcn_mfma_f32_32x32x16_bf16(b1, q, p1, 0, 0, 0); }
#pragma unroll
    for (int d = 0; d < 4; ++d) { const char* a = KR_lds + KB * SHM_KR + KRSWZ(r32, (d * 16 + hi * 8) * 2);
        bf16x8 b0 = *reinterpret_cast<const bf16x8*>(a);
        bf16x8 b1 = *reinterpret_cast<const bf16x8*>(a + 32 * 128);
        bf16x8 q = qrl[(NQREG_L + d) * 64];
        p0 = __builtin_amdgcn_mfma_f32_32x32x16_bf16(b0, q, p0, 0, 0, 0);
        p1 = __builtin_amdgcn_mfma_f32_32x32x16_bf16(b1, q, p1, 0, 0, 0); }
    __builtin_amdgcn_s_setprio(0);
}
template <int VB>
__device__ __forceinline__ void pv_tile(f32x16* o, int vb0, bf16x8 pa0, bf16x8 pa1, bf16x8 pa2, bf16x8 pa3) {
#define TRRD(dst, off) asm volatile("ds_read_b64_tr_b16 %0, %1 offset:%2" : "=&v"(dst) : "v"(vb0), "i"(off) : "memory")
#define PV_D0(d0) do { s16x4 l0, l1, l2, l3, h0, h1, h2, h3; constexpr int b_ = OFF_V + VB * SHM_V + v_rd_off(d0, 0, 0); \
        TRRD(l0, b_); TRRD(h0, b_ + 2048); TRRD(l1, b_ + 4096); TRRD(h1, b_ + 6144); TRRD(l2, b_ + 8192); TRRD(h2, b_ + 10240); TRRD(l3, b_ + 12288); TRRD(h3, b_ + 14336); \
        asm volatile("s_waitcnt lgkmcnt(0)" ::: "memory"); SBAR();   \
        o[d0] = __builtin_amdgcn_mfma_f32_32x32x16_bf16(pa0, (bf16x8){l0[0], l0[1], l0[2], l0[3], h0[0], h0[1], h0[2], h0[3]}, o[d0], 0, 0, 0);   \
        o[d0] = __builtin_amdgcn_mfma_f32_32x32x16_bf16(pa1, (bf16x8){l1[0], l1[1], l1[2], l1[3], h1[0], h1[1], h1[2], h1[3]}, o[d0], 0, 0, 0);   \
        o[d0] = __builtin_amdgcn_mfma_f32_32x32x16_bf16(pa2, (bf16x8){l2[0], l2[1], l2[2], l2[3], h2[0], h2[1], h2[2], h2[3]}, o[d0], 0, 0, 0);   \
        o[d0] = __builtin_amdgcn_mfma_f32_32x32x16_bf16(pa3, (bf16x8){l3[0], l3[1], l3[2], l3[3], h3[0], h3[1], h3[2], h3[3]}, o[d0], 0, 0, 0); } while (0)
    __builtin_amdgcn_s_setprio(1); PV_D0(0); PV_D0(1); PV_D0(2); PV_D0(3); __builtin_amdgcn_s_setprio(0);
#undef PV_D0
#undef TRRD
}

struct BlockRef { const u16* Q; const u16* K; const u16* V; const u16* KR; u16* O; int P0; int row0; };
struct Seam { bf16x8 st_v0, st_v1; };
#define ROWK(p, k0, rr) ((p) + (size_t)((k0) + (rr)) * LDK + sc)
#define VMW() asm volatile("s_waitcnt vmcnt(0)" ::: "memory")
#define VMWN(n) asm volatile("s_waitcnt vmcnt(%0)" :: "i"(n) : "memory")
#define ATT_LAS __attribute__((address_space(3)))
#define SLOAD_H(Kp, Vp, KRp, k0, bf) do { S.st_v0 = load8(ROWK(Vp, k0, sr)); S.st_v1 = load8(ROWK(Vp, k0, 32 + sr));              \
        __builtin_amdgcn_global_load_lds((const unsigned*)((Kp) + (size_t)((k0) + sr) * LDK + ksc), (ATT_LAS unsigned*)(ldsL + OFF_K + (bf) * SHM_K + wid * 1024), 16, 0, 0); \
        __builtin_amdgcn_global_load_lds((const unsigned*)((Kp) + (size_t)((k0) + 32 + sr) * LDK + ksc), (ATT_LAS unsigned*)(ldsL + OFF_K + (bf) * SHM_K + 8192 + wid * 1024), 16, 0, 0); \
        __builtin_amdgcn_global_load_lds((const unsigned*)((KRp) + (size_t)((k0) + krr) * LDKR + krsc), (ATT_LAS unsigned*)(ldsL + OFF_KR + (bf) * SHM_KR + wid * 1024), 16, 0, 0); } while (0)
#define SWRITE_HK(bf) do { } while (0)
#define SWRITE_HV(bf) do { *(bf16x8*)(V_lds + (bf) * SHM_V + vst0) = S.st_v0; *(bf16x8*)(V_lds + (bf) * SHM_V + vst1) = S.st_v1; } while (0)
#define SWRITE_H(bf) do { SWRITE_HV(bf); SWRITE_HK(bf); } while (0)
__device__ __forceinline__ void attn_prime(const BlockRef& cur, char* lds, Seam& S, int tid0) {
    int tid_ = tid0; asm volatile("" : "+v"(tid_));
    const int tid = tid_, wid = __builtin_amdgcn_readfirstlane(tid >> 6), lane = tid & 63, r32 = lane & 31, hi = lane >> 5;
    const int sr = tid >> 4, sc = (tid & 15) * 8, ksc = ((tid & 15) ^ (sr & 7)) * 8;
    const int krr = tid >> 3, krsc = ((tid & 7) ^ (krr & 7)) * 8; ATT_LAS unsigned char* ldsL = (ATT_LAS unsigned char*)lds;
    SLOAD_H(cur.K, cur.V, cur.KR, 0, 0); VMW();
    __syncthreads();
}
__device__ __forceinline__ void attn_block(const BlockRef& cur, const BlockRef& nxt, char* lds, Seam& S, int tid0, const float* ctab, const float* stab) {
    int tid_ = tid0; asm volatile("" : "+v"(tid_));
    const int tid = tid_, wid = __builtin_amdgcn_readfirstlane(tid >> 6), lane = tid & 63, r32 = lane & 31, hi = lane >> 5;
    const unsigned W = 0x40000000u;
    const int NT = (cur.P0 + QB - 1) / KVBLK + 1;
    const int qlo = cur.P0 + wid * QBLK, qm = qlo + r32 - 4 * hi;
    char* V_lds = lds + OFF_V; char* K_lds = lds + OFF_K; char* KR_lds = lds + OFF_KR;
    float* ws = (float*)(lds + OFF_WS) + wid * 64; float* li_l = ws, * al_l = ws + 32;
    bf16x8* qrl = (bf16x8*)(lds + OFF_QR + wid * QR_WAVE) + lane;
    float m_reg = -1e30f, l_reg = 0; f32x16 o[4] = {};
    const int sr = tid >> 4, sc = (tid & 15) * 8, vst0 = v_st(sr, sc), vst1 = v_st(32 + sr, sc), ksc = ((tid & 15) ^ (sr & 7)) * 8;
    const int krr = tid >> 3, krsc = ((tid & 7) ^ (krr & 7)) * 8; ATT_LAS unsigned char* ldsL = (ATT_LAS unsigned char*)lds;
    const int vb0 = (int)(uintptr_t)lds + v_rd_base(lane);
    const u16* Kh = cur.K; const u16* Vh = cur.V; const u16* KRh = cur.KR;
#define RESC(a) do { if (__any((a) < 1.f)) { if (hi == 0) al_l[r32] = (a); asm volatile("s_waitcnt lgkmcnt(0)" ::: "memory");              \
                     for (int d_ = 0; d_ < 4; ++d_) for (int r = 0; r < 16; ++r) o[d_][r] *= al_l[crow(r, hi)]; } } while (0)
#define KBASE(t) ((t) * KVBLK)
#define MASKT(P0_, P1_, t) do { const int kb_ = KBASE(t); if (kb_ + KVBLK - 1 > qlo) mask_tile(P0_, P1_, qm - kb_, W); } while (0)
#define SEAM_K0() do { VMW(); SWRITE_HK(0); SBAR(); } while (0)
    f32x16 pA0, pA1, pB0, pB1; float mnA, mnB, alA, alB; bf16x8 pa0, pa1, pa2, pa3;
    bf16x8 qr[NQREG > 0 ? NQREG : 1];
    { const u16* qp = cur.Q + (size_t)(wid * QBLK + r32) * LDQ + hi * 8;
#pragma unroll
      for (int d = 0; d < NQREG_L; ++d) qrl[d * 64] = load8(qp + (NQREG + d) * 16);
      const size_t trow = (size_t)(cur.row0 + wid * QBLK + r32) * 32 + hi * 8;
#pragma unroll
      for (int pr = 0; pr < 2; ++pr) {
          const bf16x8 x1 = load8(qp + 128 + pr * 16), x2 = load8(qp + 128 + 32 + pr * 16);
          const f32x4 c0 = *(const f32x4*)(ctab + trow + pr * 16), c1 = *(const f32x4*)(ctab + trow + pr * 16 + 4), s0 = *(const f32x4*)(stab + trow + pr * 16), s1 = *(const f32x4*)(stab + trow + pr * 16 + 4);
          float o1[8], o2[8];
#pragma unroll
          for (int e = 0; e < 8; ++e) { const float a = __uint_as_float(((unsigned)(unsigned short)x1[e]) << 16), b = __uint_as_float(((unsigned)(unsigned short)x2[e]) << 16);
              const float cc = e < 4 ? c0[e & 3] : c1[e & 3], ss = e < 4 ? s0[e & 3] : s1[e & 3]; o1[e] = a * cc - b * ss; o2[e] = b * cc + a * ss; }
          u32x4 w1 = {cvtpk(o1[0], o1[1]), cvtpk(o1[2], o1[3]), cvtpk(o1[4], o1[5]), cvtpk(o1[6], o1[7])}, w2 = {cvtpk(o2[0], o2[1]), cvtpk(o2[2], o2[3]), cvtpk(o2[4], o2[5]), cvtpk(o2[6], o2[7])};
          qrl[(NQREG_L + pr) * 64] = *reinterpret_cast<bf16x8*>(&w1); qrl[(NQREG_L + 2 + pr) * 64] = *reinterpret_cast<bf16x8*>(&w2); }
#pragma unroll
      for (int d0 = 0; d0 < NQREG; ++d0) qr[d0] = load8(qp + d0 * 16); }
    SWRITE_HV(0); SBAR();
    if (NT > 1) SLOAD_H(Kh, Vh, KRh, KBASE(1), 1);
    SBAR(); qkt<0>(pA0, pA1, K_lds, KR_lds, qrl, r32, hi, qr);
    MASKT(pA0, pA1, 0); partialSM(pA0, pA1, m_reg, mnA, alA);
    if (NT > 1) { VMW(); SWRITE_H(1); }
    __syncthreads();
#define HALF_STEP(PX0, PX1, mnX, alX, PY0, PY1, alY, t, KB, VB, SB) do {                                                      \
        SBAR(); qkt<KB>(PX0, PX1, K_lds, KR_lds, qrl, r32, hi, qr);                                                          \
        finishSM(PY0, PY1, alY, l_reg, pa0, pa1, pa2, pa3); SBAR();                                                           \
        if ((t) + 1 < NT) { SLOAD_H(Kh, Vh, KRh, KBASE((t) + 1), SB); SBAR(); }                                                   \
        pv_tile<VB>(o, vb0, pa0, pa1, pa2, pa3); MASKT(PX0, PX1, (t)); partialSM(PX0, PX1, m_reg, mnX, alX);                  \
        __syncthreads();                                                                                                      \
        if ((t) + 1 < NT) { VMW(); SWRITE_H(SB); }                                                                            \
        RESC(alX); __syncthreads(); } while (0)
    for (int t = 1; t + 1 < NT; t += 2) {
        HALF_STEP(pB0, pB1, mnB, alB, pA0, pA1, alA, t, 1, 0, 0);
        HALF_STEP(pA0, pA1, mnA, alA, pB0, pB1, alB, t + 1, 0, 1, 1);
    }
    const bool even = (NT & 1) == 0;
    if (even) { SBAR(); qkt<1>(pB0, pB1, K_lds, KR_lds, qrl, r32, hi, qr); SBAR(); }
    SLOAD_H(nxt.K, nxt.V, nxt.KR, 0, 0); SBAR();
    finishSM(pA0, pA1, alA, l_reg, pa0, pa1, pa2, pa3); SBAR();
    pv_tile<0>(o, vb0, pa0, pa1, pa2, pa3);
    if (even) { MASKT(pB0, pB1, NT - 1); partialSM(pB0, pB1, m_reg, mnB, alB); __syncthreads(); RESC(alB);
        finishSM(pB0, pB1, alB, l_reg, pa0, pa1, pa2, pa3); SBAR(); pv_tile<1>(o, vb0, pa0, pa1, pa2, pa3); }
    SBAR(); SEAM_K0();
    if (hi == 0) li_l[r32] = l_reg; asm volatile("s_waitcnt lgkmcnt(0)" ::: "memory");
    float rli[16];
#pragma unroll
    for (int r = 0; r < 16; ++r) rli[r] = __builtin_amdgcn_rcpf(li_l[crow(r, hi)]);
    u16* Ow = cur.O + (size_t)(wid * QBLK) * LDO;
#pragma unroll
    for (int r = 0; r < 16; ++r) { const int orow = crow(r, hi);
#pragma unroll
        for (int d0 = 0; d0 < 4; ++d0) { const float v = o[d0][r] * rli[r];
            const float vn = xor1f(v);
            if ((r32 & 1) == 0) *(unsigned*)(Ow + (size_t)orow * LDO + d0 * 32 + r32) = cvtpk(v, vn); } }
    __syncthreads();
#undef RESC
#undef KBASE
#undef MASKT
#undef SEAM_K0
#undef HALF_STEP
}
struct Tensors { const u16* q; const u16* kv; const u16* kr; u16* o; const float* ctab; const float* stab; };
__device__ __forceinline__ BlockRef make_ref(const Tensors& T, int L, int pass) {
    const int bh = (L & 7) + 8 * (L >> 8), x = (L >> 3) & 31, b = bh >> 3, h = bh & 7, qb = pass ? 63 - x : x;
    BlockRef r; const size_t row0 = (size_t)b * SEQ;
    r.Q = T.q + (row0 + (size_t)qb * QB) * LDQ + h * 192; r.K = T.kv + row0 * LDK + h * 256; r.V = r.K + 128; r.KR = T.kr + row0 * LDKR;
    r.O = T.o + (row0 + (size_t)qb * QB) * LDO + h * 128; r.P0 = qb * QB; r.row0 = b * SEQ + qb * QB;
    return r;
}
__device__ __forceinline__ void attn_phase(char* lds, const Tensors& T, int tid0) {
    const int total = 512, stride = gridDim.x;
    int L = blockIdx.x; if (L >= total) return;
    int pass = 0;
    BlockRef cur = make_ref(T, L, 0);
    Seam S;
    attn_prime(cur, lds, S, tid0);
    for (;;) {
        const bool more_pass = pass == 0, more_item = L + stride < total, last = !more_pass && !more_item;
        int passn = pass + 1, Ln = L;
        if (!more_pass) { passn = 0; Ln = more_item ? L + stride : L; }
        const BlockRef nxt = last ? cur : make_ref(T, Ln, passn);
        attn_block(cur, nxt, lds, S, tid0, T.ctab, T.stab);
        if (last) break;
        cur = nxt; pass = passn; L = Ln;
    }
}
#undef ROWK
#undef VMW
#undef VMWN
#undef SLOAD_H
#undef SWRITE_HK
#undef SWRITE_HV
#undef SWRITE_H
#undef SBAR
}
namespace xb {
#define LAS __attribute__((address_space(3)))
#define XB_TMO      128
#define XB_XCNT(j)  (256  + 64 * (j))
#define XB_XSUB(j)  (1280 + 64 * (j))
#define XB_XGEN(j)  (2304 + 64 * (j))
#define XB_TOP      3328
#define XB_TOPGEN   3392
#define XCD_BAR_WORDS 3456
#define XB_SPIN_CAP (1u << 18)

__device__ __forceinline__ unsigned xb_ld(unsigned* p)              { return __hip_atomic_load(p, __ATOMIC_RELAXED, __HIP_MEMORY_SCOPE_AGENT); }
__device__ __forceinline__ unsigned xb_add(unsigned* p, unsigned v) { return __hip_atomic_fetch_add(p, v, __ATOMIC_RELAXED, __HIP_MEMORY_SCOPE_AGENT); }
__device__ __forceinline__ unsigned xb_xcc_id() { return (unsigned)__builtin_amdgcn_s_getreg((3 << 11) | 20) & 0xFu; }
#define XB_SPIN(cond, bar) do { unsigned _sp = 0; while (cond) { __builtin_amdgcn_s_sleep(1); \
    if ((++_sp & 255u) == 0u) { if (xb_ld(&(bar)[XB_TMO])) break; if (_sp > XB_SPIN_CAP) { atomicAdd(&(bar)[XB_TMO], 1u); break; } } } } while (0)

struct XcdBarrier {
    unsigned* bar; unsigned x;
    volatile LAS unsigned* st;
};

__device__ __forceinline__ XcdBarrier xcd_barrier_post(unsigned* bar, volatile LAS unsigned* st) {
    XcdBarrier b; b.bar = bar; b.x = xb_xcc_id(); b.st = st;
    if (threadIdx.x == 0) (void)xb_add(&bar[XB_XCNT(b.x)], 1u);
    return b;
}
__device__ __forceinline__ void xcd_barrier_complete(unsigned* bar, unsigned x, unsigned& nloc, unsigned& nx) {
    const unsigned G = gridDim.x * gridDim.y * gridDim.z;
    unsigned sum, cnt, mine, sp = 0u;
    for (;;) {
        sum = 0u; cnt = 0u; mine = 0u;
#pragma unroll
        for (unsigned j = 0; j < 16; ++j) { const unsigned c = xb_ld(&bar[XB_XCNT(j)]); sum += c; cnt += (c > 0u) ? 1u : 0u; mine = (j == x) ? c : mine; }
        if (sum == G) break;
        __builtin_amdgcn_s_sleep(1);
        if ((++sp & 255u) == 0u) { if (xb_ld(&bar[XB_TMO])) break; if (sp > XB_SPIN_CAP) { atomicAdd(&bar[XB_TMO], 1u); break; } }
    }
    nloc = mine > 0u ? mine : 1u; nx = cnt > 0u ? cnt : 1u;
}

__device__ __forceinline__ void xcd_barrier(const XcdBarrier& b, bool t0  ) {
    asm volatile("s_waitcnt vmcnt(0)" ::: "memory");
    __syncthreads();
    if (t0) {
        unsigned* bar = b.bar;
        __builtin_amdgcn_s_waitcnt(0);
        unsigned nloc = b.st[0], nx = b.st[1];
        if (nloc == 0u) { xcd_barrier_complete(bar, b.x, nloc, nx); b.st[0] = nloc; b.st[1] = nx; }
        const unsigned old = xb_add(&bar[XB_XSUB(b.x)], 1u);
        const unsigned gen = old / nloc;
        if (old + 1u == (gen + 1u) * nloc) {
            __builtin_amdgcn_fence(__ATOMIC_RELEASE, "agent");
            asm volatile("s_waitcnt vmcnt(0)" ::: "memory");
            const unsigned og = xb_add(&bar[XB_TOP], 1u);
            const unsigned tg = og / nx;
            if (og + 1u == (tg + 1u) * nx) xb_add(&bar[XB_TOPGEN], 1u);
            else XB_SPIN(xb_ld(&bar[XB_TOPGEN]) == tg, bar);
            __builtin_amdgcn_fence(__ATOMIC_ACQUIRE, "agent");
            xb_add(&bar[XB_XGEN(b.x)], 1u);
            asm volatile("s_waitcnt vmcnt(0)" ::: "memory");
        } else {
            XB_SPIN(xb_ld(&bar[XB_XGEN(b.x)]) == gen, bar);
            __builtin_amdgcn_fence(__ATOMIC_ACQUIRE, "agent");
            asm volatile("s_waitcnt vmcnt(0)" ::: "memory");
        }
    }
    __syncthreads();
}
#undef LAS
}
#ifndef PROBE_ATT_REPS
#define PROBE_ATT_REPS 1
#endif
#ifndef PROBE_SYNC_REPS
#define PROBE_SYNC_REPS 1
#endif
#ifndef PROBE_THIN_REPS
#define PROBE_THIN_REPS 1
#endif
#ifndef PROBE_PRO_REPS
#define PROBE_PRO_REPS 1
#endif
#ifndef PROBE_GEMM_REPS
#define PROBE_GEMM_REPS 1
#endif
namespace mk {
typedef unsigned short u16;
typedef float f32x4 __attribute__((ext_vector_type(4)));
constexpr int M = 32768, D = 1024, SEQ = 16384;
constexpr float EPS = 1e-6f;
constexpr size_t MB = (size_t)1 << 20;
__host__ __device__ constexpr size_t WT_MLA(int j) { return (size_t)j * 6 * MB; }
__host__ __device__ constexpr size_t WT_LRU(int j) { return 12 * MB + (size_t)j * 8 * MB; }
__host__ __device__ constexpr size_t WT_FFN(int l) { return 28 * MB + (size_t)l * 16 * MB; }
constexpr size_t OFF_UQ = 3 * MB / 2, OFF_UKV = 11 * MB / 4, OFF_WO = 15 * MB / 4, OFF_GT = 4 * MB, OFF_LOUT = 5 * MB, OFF_DOWN = 8 * MB;
constexpr size_t WS_COS = 96 * MB, WS_SIN = 100 * MB, WS_SA = 104 * MB, WS_SB = 105 * MB;
constexpr size_t WS_HN = 112 * MB, WS_Y = 176 * MB, WS_U = 240 * MB, WS_END = 496 * MB;
constexpr size_t U_PROJ = 64 * MB, U_CQ = 112 * MB, U_CKV = 136 * MB, U_KR = 152 * MB, U_Q = 160 * MB, U_O = 64 * MB;
constexpr size_t U_GATE = 0, U_XC = 64 * MB, U_REC = 128 * MB, U_LA = 128 * MB, U_B = 192 * MB;
constexpr size_t WS_RS = 108 * MB;
constexpr int SCAN_L = 128, SCAN_NC = SEQ / SCAN_L;

__device__ __forceinline__ unsigned f2bf(float f) { unsigned u = __float_as_uint(f); return (u + 0x7fffu + ((u >> 16) & 1u)) >> 16; }
__device__ __forceinline__ unsigned pk2(float lo, float hi) { return f2bf(lo) | (f2bf(hi) << 16); }
__device__ __forceinline__ float bflo(unsigned w) { return __uint_as_float(w << 16); }
__device__ __forceinline__ float bfhi(unsigned w) { return __uint_as_float(w & 0xffff0000u); }
__device__ __forceinline__ float bf1(u16 h) { return __uint_as_float(((unsigned)h) << 16); }
__device__ __forceinline__ float wave_sum(float v) {
    v += xor1f(v); v += xor2f(v); v += xor4f(v); v += xor8f(v); v += xor16f(v);
    return sum32f(v);
}
__device__ __forceinline__ void transpose_item(const float* W, int ldw, u16* WT, int ldt, int nblk, float* scr, int item, int lane) {
    const int kb = item / nblk, nb = item % nblk, k0 = 64 * kb, n0 = 32 * nb;
#pragma unroll
    for (int i = 0; i < 8; ++i) { const int kk = 8 * i + (lane >> 3); const f32x4 v = *(const f32x4*)(W + (size_t)(k0 + kk) * ldw + n0 + (lane & 7) * 4);
        float* s = scr + kk * 33 + (lane & 7) * 4; s[0] = v.x; s[1] = v.y; s[2] = v.z; s[3] = v.w; }
    asm volatile("s_waitcnt lgkmcnt(0)" ::: "memory");
    const int c = lane & 7;
#pragma unroll
    for (int j = 0; j < 4; ++j) { const int n = (lane >> 3) + 8 * j; const float* s = scr + (8 * c) * 33 + n;
        uint4 o; o.x = pk2(s[0 * 33], s[1 * 33]); o.y = pk2(s[2 * 33], s[3 * 33]); o.z = pk2(s[4 * 33], s[5 * 33]); o.w = pk2(s[6 * 33], s[7 * 33]);
        *(uint4*)(WT + (size_t)(n0 + n) * ldt + k0 + 8 * c) = o; }
    asm volatile("s_waitcnt lgkmcnt(0)" ::: "memory");
}
struct Params { const float* in[23]; float* out; unsigned char* ws; };
enum { I_X = 0, I_POS, I_MIXPRE, I_MIXPOST, I_FFNPRE, I_FFNPOST, I_MLA_WIN, I_MLA_QN, I_MLA_KVN, I_MLA_WUQ, I_MLA_WUKV, I_MLA_WO,
       I_LRU_WIN, I_LRU_CW, I_LRU_CB, I_LRU_WA, I_LRU_BA, I_LRU_WX, I_LRU_BX, I_LRU_LAM, I_LRU_WOUT, I_FFN_UP, I_FFN_DOWN };

__device__ __forceinline__ void prologue_weights(const __attribute__((address_space(4))) Params& p, float* scr, int gw, int NGW, int lane) {
    u16* wt = (u16*)p.ws;
    constexpr int IT_MLA = 352 + 288 + 256 + 512, IT_LRU = 1024 + 128 + 512, IT_FFN = 4096, TOTAL = 2 * IT_MLA + 2 * IT_LRU + 4 * IT_FFN;
    for (int it = gw; it < TOTAL; it += NGW) {
        int r = it; const float* W; int ldw, ldt, nblk; u16* WT;
        if (r < 2 * IT_MLA) { const int j = r / IT_MLA; r -= j * IT_MLA; u16* base = wt + WT_MLA(j) / 2;
            if (r < 352) { W = p.in[I_MLA_WIN] + (size_t)j * 1024 * 704; ldw = 704; nblk = 22; WT = base; ldt = 1024; }
            else if (r < 640) { r -= 352; W = p.in[I_MLA_WUQ] + (size_t)j * 384 * 1536; ldw = 1536; nblk = 48; WT = base + OFF_UQ / 2; ldt = 384; }
            else if (r < 896) { r -= 640; W = p.in[I_MLA_WUKV] + (size_t)j * 256 * 2048; ldw = 2048; nblk = 64; WT = base + OFF_UKV / 2; ldt = 256; }
            else { r -= 896; W = p.in[I_MLA_WO] + (size_t)j * 1024 * 1024; ldw = 1024; nblk = 32; WT = base + OFF_WO / 2; ldt = 1024; }
        } else if (r < 2 * IT_MLA + 2 * IT_LRU) { r -= 2 * IT_MLA; const int j = r / IT_LRU; r -= j * IT_LRU; u16* base = wt + WT_LRU(j) / 2;
            if (r < 1024) { W = p.in[I_LRU_WIN] + (size_t)j * 1024 * 2048; ldw = 2048; nblk = 64; WT = base; ldt = 1024; }
            else if (r < 1152) { r -= 1024; const int which = r >> 3, gt = which >> 3, n = which & 7; r &= 7;
                W = p.in[gt ? I_LRU_WX : I_LRU_WA] + (size_t)j * 8 * 128 * 128 + (size_t)n * 128 * 128; ldw = 128; nblk = 4;
                WT = base + OFF_GT / 2 + (size_t)(n * 256 + gt * 128) * 256 + 128 * (n & 1); ldt = 256; }
            else { r -= 1152; W = p.in[I_LRU_WOUT] + (size_t)j * 1024 * 1024; ldw = 1024; nblk = 32; WT = base + OFF_LOUT / 2; ldt = 1024; }
        } else { r -= 2 * IT_MLA + 2 * IT_LRU; const int l = r / IT_FFN; r -= l * IT_FFN; u16* base = wt + WT_FFN(l) / 2;
            if (r < 2048) { W = p.in[I_FFN_UP] + (size_t)l * 1024 * 4096; ldw = 4096; nblk = 128; WT = base; ldt = 1024; }
            else { r -= 2048; W = p.in[I_FFN_DOWN] + (size_t)l * 4096 * 1024; ldw = 1024; nblk = 32; WT = base + OFF_DOWN / 2; ldt = 4096; }
        }
        transpose_item(W, ldw, WT, ldt, nblk, scr, r, lane);
    }
}
__device__ __forceinline__ void rowop(const u16* y, const float* xin, float* xout, u16* hn, float* rs, const float* gpost, const float* gpre, int gw, int NGW, int lane) {
    f32x4 gp[4], gq[4];
#pragma unroll
    for (int j = 0; j < 4; ++j) { gp[j] = gpost ? *(const f32x4*)(gpost + j * 256 + lane * 4) : (f32x4){0.f, 0.f, 0.f, 0.f}; gq[j] = gpre ? *(const f32x4*)(gpre + j * 256 + lane * 4) : (f32x4){0.f, 0.f, 0.f, 0.f}; }
    for (int row = gw; row < M; row += NGW) {
        f32x4 xv[4];
#pragma unroll
        for (int j = 0; j < 4; ++j) xv[j] = *(const f32x4*)(xin + (size_t)row * D + j * 256 + lane * 4);
        if (y) {
            f32x4 yv[4]; float ss = 0.f;
#pragma unroll
            for (int j = 0; j < 4; ++j) { const uint2 w = *(const uint2*)(y + (size_t)row * D + j * 256 + lane * 4);
                yv[j] = (f32x4){bflo(w.x), bfhi(w.x), bflo(w.y), bfhi(w.y)}; ss += (yv[j].x * yv[j].x + yv[j].y * yv[j].y) + (yv[j].z * yv[j].z + yv[j].w * yv[j].w); }
            const float r = rsqrtf(wave_sum(ss) * (1.f / D) + EPS);
#pragma unroll
            for (int j = 0; j < 4; ++j) xv[j] = xv[j] + (yv[j] * r) * gp[j];
        }
        if (xout) {
#pragma unroll
        for (int j = 0; j < 4; ++j) *(f32x4*)(xout + (size_t)row * D + j * 256 + lane * 4) = xv[j]; }
        if (gpre) {
            float s2 = 0.f;
#pragma unroll
            for (int j = 0; j < 4; ++j) s2 += (xv[j].x * xv[j].x + xv[j].y * xv[j].y) + (xv[j].z * xv[j].z + xv[j].w * xv[j].w);
            const float ms2 = wave_sum(s2) * (1.f / D) + EPS; const float r2 = rsqrtf(ms2);
            if (rs && lane == 0) rs[row] = ms2 * r2;
#pragma unroll
            for (int j = 0; j < 4; ++j) { const f32x4 h = (xv[j] * r2) * gq[j]; uint2 w; w.x = pk2(h.x, h.y); w.y = pk2(h.z, h.w);
                *(uint2*)(hn + (size_t)row * D + j * 256 + lane * 4) = w; }
        }
    }
}
__device__ __forceinline__ void qkvnorm(const u16* proj, u16* cq, u16* ckv, u16* kr, const float* qn, const float* kvn, const float* ctab, const float* stab, int gw, int NGW, int lane) {
    float gq[6], gk[4];
#pragma unroll
    for (int j = 0; j < 6; ++j) gq[j] = qn[lane + 64 * j];
#pragma unroll
    for (int j = 0; j < 4; ++j) gk[j] = kvn[lane + 64 * j];
    for (int row = gw; row < M; row += NGW) {
        const u16* pr = proj + (size_t)row * 768;
        float a[6], b[4], s1 = 0.f, s2 = 0.f;
#pragma unroll
        for (int j = 0; j < 6; ++j) { a[j] = bf1(pr[lane + 64 * j]); s1 += a[j] * a[j]; }
#pragma unroll
        for (int j = 0; j < 4; ++j) { b[j] = bf1(pr[384 + lane + 64 * j]); s2 += b[j] * b[j]; }
        const float x1 = bf1(pr[640 + (lane & 31)]), x2 = bf1(pr[672 + (lane & 31)]);
        const float r1 = rsqrtf(wave_sum(s1) * (1.f / 384.f) + EPS), r2 = rsqrtf(wave_sum(s2) * (1.f / 256.f) + EPS);
#pragma unroll
        for (int j = 0; j < 6; ++j) cq[(size_t)row * 384 + lane + 64 * j] = (u16)f2bf(a[j] * r1 * gq[j]);
#pragma unroll
        for (int j = 0; j < 4; ++j) ckv[(size_t)row * 256 + lane + 64 * j] = (u16)f2bf(b[j] * r2 * gk[j]);
        const float c = ctab[(size_t)row * 32 + (lane & 31)], s = stab[(size_t)row * 32 + (lane & 31)];
        kr[(size_t)row * 64 + lane] = (u16)f2bf(lane < 32 ? x1 * c - x2 * s : x2 * c + x1 * s);
    }
}
__device__ __forceinline__ void qrope(u16* q, const float* ctab, const float* stab, int gw, int NGW, int lane) {
    for (int row = gw; row < M; row += NGW) {
        u16* qr = q + (size_t)row * 1536; const int i = lane & 31;
        const float c = ctab[(size_t)row * 32 + i], s = stab[(size_t)row * 32 + i];
#pragma unroll
        for (int j = 0; j < 4; ++j) { const int h = 2 * j + (lane >> 5); u16* pp = qr + h * 192 + 128 + i;
            const float x1 = bf1(pp[0]), x2 = bf1(pp[32]);
            pp[0] = (u16)f2bf(x1 * c - x2 * s); pp[32] = (u16)f2bf(x2 * c + x1 * s); }
    }
}
__device__ __forceinline__ void conv_phase(const u16* rec, u16* xc, const float* cw, const float* cb, int gtid, int NGT) {
    for (int idx = gtid; idx < M * 128; idx += NGT) {
        const int row = idx >> 7, c0 = (idx & 127) * 8, s = row & (SEQ - 1);
        float acc[8];
#pragma unroll
        for (int e = 0; e < 8; ++e) acc[e] = cb[c0 + e];
#pragma unroll
        for (int k = 0; k < 4; ++k) { if (s - 3 + k >= 0) {
            const uint4 w = *(const uint4*)(rec + (size_t)(row - 3 + k) * D + c0);
            const float v[8] = {bflo(w.x), bfhi(w.x), bflo(w.y), bfhi(w.y), bflo(w.z), bfhi(w.z), bflo(w.w), bfhi(w.w)};
#pragma unroll
            for (int e = 0; e < 8; ++e) acc[e] += v[e] * cw[k * D + c0 + e]; } }
        uint4 o; o.x = pk2(acc[0], acc[1]); o.y = pk2(acc[2], acc[3]); o.z = pk2(acc[4], acc[5]); o.w = pk2(acc[6], acc[7]);
        *(uint4*)(xc + (size_t)row * D + c0) = o;
    }
}
__device__ __forceinline__ void scanA(const u16* A, const u16* B, float* SA, float* SB, int tid) {
    for (int item = blockIdx.x; item < 2 * SCAN_NC * 2; item += gridDim.x) {
        const int half = item & 1, c = (item >> 1) % SCAN_NC, b = item / (2 * SCAN_NC), ch = half * 512 + tid;
        const size_t base = ((size_t)b * SEQ + (size_t)c * SCAN_L) * D + ch;
        float h = 0.f, P = 1.f;
        for (int t0 = 0; t0 < SCAN_L; t0 += 16) {
            u16 aw[16], bw[16];
#pragma unroll
            for (int u = 0; u < 16; ++u) { aw[u] = A[base + (size_t)(t0 + u) * D]; bw[u] = B[base + (size_t)(t0 + u) * D]; }
#pragma unroll
            for (int u = 0; u < 16; ++u) { const float a = __expf(bf1(aw[u])); h = a * h + bf1(bw[u]); P *= a; }
        }
        SA[((size_t)b * SCAN_NC + c) * D + ch] = P; SB[((size_t)b * SCAN_NC + c) * D + ch] = h;
    }
}
__device__ __forceinline__ void scanC(const u16* A, const u16* B, const float* SA, const float* SB, const u16* gate, u16* hg, int tid) {
    for (int item = blockIdx.x; item < 2 * SCAN_NC * 2; item += gridDim.x) {
        const int half = item & 1, c = (item >> 1) % SCAN_NC, b = item / (2 * SCAN_NC), ch = half * 512 + tid;
        const size_t base = ((size_t)b * SEQ + (size_t)c * SCAN_L) * D + ch;
        float h = 0.f;
        for (int cc = 0; cc < c; ++cc) { const size_t so = ((size_t)b * SCAN_NC + cc) * D + ch; h = SA[so] * h + SB[so]; }
        for (int t0 = 0; t0 < SCAN_L; t0 += 16) {
            u16 aw[16], bw[16], gv[16];
#pragma unroll
            for (int u = 0; u < 16; ++u) { aw[u] = A[base + (size_t)(t0 + u) * D]; bw[u] = B[base + (size_t)(t0 + u) * D]; gv[u] = gate[base + (size_t)(t0 + u) * D]; }
#pragma unroll
            for (int u = 0; u < 16; ++u) { h = __expf(bf1(aw[u])) * h + bf1(bw[u]); hg[base + (size_t)(t0 + u) * D] = (u16)f2bf(bf1(gv[u]) * h); }
        }
    }
}

constexpr int LDS_MAIN = att::LDS_BYTES > pg8::STAGE_BYTES ? att::LDS_BYTES : pg8::STAGE_BYTES, LDS_BYTES = LDS_MAIN + 16;
constexpr size_t WS_BAR = 106 * MB;
constexpr size_t WS_CNT1 = WS_BAR + 16384, WS_CNT2 = WS_BAR + 49152, CTL_BYTES = 81920, WS_XS1 = 107 * MB, WS_XS2 = 107 * MB + MB / 2;
constexpr int XL_OFF = 131072;
static_assert(XL_OFF + 8192 <= LDS_MAIN && XCD_BAR_WORDS * 4 <= 16384 && att::LDS_BYTES <= LDS_MAIN && pg8::STAGE_BYTES <= LDS_MAIN && LDS_BYTES <= 160 * 1024, "LDS map");

__global__ void __launch_bounds__(512, 2) fwd_mega(Params p_arg) {
    extern __shared__ __attribute__((aligned(16))) unsigned char lds[];
    cg::grid_group grid = cg::this_grid();
    (void)p_arg;
    volatile __attribute__((address_space(3))) unsigned* bst = (volatile __attribute__((address_space(3))) unsigned*)((__attribute__((address_space(3))) unsigned char*)lds + LDS_MAIN);
    if (threadIdx.x < 4) bst[threadIdx.x] = 0u;
    __syncthreads();
    const int wave_s = __builtin_amdgcn_readfirstlane(threadIdx.x >> 6);
    const unsigned bar_x = xb::xb_xcc_id();
    (void)xb::xcd_barrier_post((unsigned*)(p_arg.ws + WS_BAR), bst);
#define GRID_BAR() do { unsigned bx_ = bar_x; asm volatile("" : "+s"(bx_)); xb::XcdBarrier bb_; bb_.bar = (unsigned*)(ws + WS_BAR); bb_.x = bx_; bb_.st = bst; xb::xcd_barrier(bb_, tid == 0); } while (0)
    typedef const __attribute__((address_space(4))) Params* KParams;
    KParams pp = (KParams)__builtin_amdgcn_kernarg_segment_ptr();
#define FRESH() int tid_ = wave_s * 64 + lane_id_fresh(); asm volatile("" : "+v"(tid_)); asm volatile("" : "+s"(pp)); const __attribute__((address_space(4))) Params& p = *pp; \
    const int tid = tid_, lane = tid & 63, wave = __builtin_amdgcn_readfirstlane(tid >> 6); \
    const int G = gridDim.x, gw = blockIdx.x * 8 + wave, NGW = G * 8, gtid = blockIdx.x * 512 + tid, NGT = G * 512; \
    unsigned char* ws = p.ws; float* x = p.out; u16* hn = (u16*)(ws + WS_HN); u16* ybuf = (u16*)(ws + WS_Y); unsigned char* U = ws + WS_U; \
    float* ctab = (float*)(ws + WS_COS); float* stab = (float*)(ws + WS_SIN); float* SA = (float*)(ws + WS_SA); float* SB = (float*)(ws + WS_SB); \
    (void)lane; (void)wave; (void)gw; (void)NGW; (void)gtid; (void)NGT; (void)x; (void)hn; (void)ybuf; (void)U; (void)ctab; (void)stab; (void)SA; (void)SB;
    {
    FRESH();

    for (int prep = 0; prep < PROBE_PRO_REPS; ++prep) {
    prologue_weights(p, (float*)lds + wave * (64 * 33), gw, NGW, lane);
    for (int i = gtid; i < 2 * 2048 * 16; i += NGT) { const int j = i >> 15, row = (i >> 4) & 2047, chn = i & 15, n = row >> 8;
        *(uint4*)((u16*)(ws + WT_LRU(j) + OFF_GT) + (size_t)row * 256 + 128 * ((n & 1) ^ 1) + chn * 8) = make_uint4(0u, 0u, 0u, 0u); }
    { const int* pos = (const int*)p.in[I_POS];
      for (int i = gtid; i < M * 32; i += NGT) { const int row = i >> 5, f = i & 31;
        const float inv = __builtin_amdgcn_exp2f(-(float)f * (13.287712379549449f / 32.f));
        const float ang = (float)pos[row] * inv;
        double rev = (double)ang * 0.15915494309189535; rev -= __builtin_rint(rev);
        ctab[i] = __builtin_amdgcn_cosf((float)rev); stab[i] = __builtin_amdgcn_sinf((float)rev); } }
    rowop(nullptr, p.in[I_X], nullptr, hn, (float*)(ws + WS_RS), nullptr, p.in[I_MIXPRE], gw, NGW, lane);
    }
    if (ws == nullptr) grid.sync();
    GRID_BAR();
    }

#pragma nounroll
    for (int layer = 0; layer < 4; ++layer) {
#pragma nounroll
        for (int op = 0; op < 10; ++op) {
            FRESH();
            const int j = layer >> 1; const bool lru = (layer & 1) != 0;
            const u16* wtm = (const u16*)(ws + WT_MLA(j)); const u16* wtl = (const u16*)(ws + WT_LRU(j)); const u16* wtf = (const u16*)(ws + WT_FFN(layer));
            int gk = 0;
            pg8::Gemm g{}; pg8::EpiB E{};
            if (op == 6 || op == 9) continue;
            const float* gprev = p.in[op == 5 ? I_MIXPRE : I_FFNPRE] + layer * D;
            const float* gpost = p.in[op == 5 ? I_MIXPOST : I_FFNPOST] + layer * D;
            const float* gpre = op == 5 ? p.in[I_FFNPRE] + layer * D : (layer < 3 ? p.in[I_MIXPRE] + (layer + 1) * D : nullptr);
            if (op == 7) { gk = 1; g = pg8::Gemm{hn, wtf, M, 4096, 1024, 1024, 1024, 0}; E = pg8::EpiB{(u16*)U, 4096, 0, 0, 1}; }
            else if (op == 8) { gk = 3; g = pg8::Gemm{(const u16*)U, wtf + OFF_DOWN / 2, M, 1024, 4096, 4096, 4096, 0}; }
            else if (!lru) {
                u16* proj = (u16*)(U + U_PROJ); u16* cq = (u16*)(U + U_CQ); u16* ckv = (u16*)(U + U_CKV); u16* kr = (u16*)(U + U_KR); u16* q = (u16*)(U + U_Q); u16* o = (u16*)(U + U_O); u16* kv = ybuf;
                if (op == 0) { gk = 1; g = pg8::Gemm{hn, wtm, M, 768, 1024, 1024, 1024, 0}; E = pg8::EpiB{proj, 768, 0, 0, 0}; }
                else if (op == 1) for (int rep = 0; rep < PROBE_THIN_REPS; ++rep) qkvnorm(proj, cq, ckv, kr, p.in[I_MLA_QN] + j * 384, p.in[I_MLA_KVN] + j * 256, ctab, stab, gw, NGW, lane);
                else if (op == 2) { gk = 1; g = pg8::Gemm{cq, wtm + OFF_UQ / 2, M, 1536, 384, 384, 384, 0}; E = pg8::EpiB{q, 1536, 0, 0, 0}; }
                else if (op == 3) { gk = 1; g = pg8::Gemm{ckv, wtm + OFF_UKV / 2, M, 2048, 256, 256, 256, 0}; E = pg8::EpiB{kv, 2048, 0, 0, 0}; }
                else if (op == 4) { const att::Tensors T{q, kv, kr, o, ctab, stab}; for (int rep = 0; rep < PROBE_ATT_REPS; ++rep) att::attn_phase((char*)lds, T, tid); }
                else { gk = 3; g = pg8::Gemm{o, wtm + OFF_WO / 2, M, 1024, 1024, 1024, 1024, 0}; }
            } else {
                u16* gate = (u16*)(U + U_GATE); u16* xc = (u16*)(U + U_XC); u16* rec = (u16*)(U + U_REC); u16* Bb = (u16*)(U + U_B); u16* Ab = (u16*)(U + U_LA); u16* hg = xc;
                if (op == 0) { gk = 1; g = pg8::Gemm{hn, wtl, M, 2048, 1024, 1024, 1024, 0}; E = pg8::EpiB{gate, 1024, 1024, (size_t)(U_REC - U_GATE) / 2, 2}; }
                else if (op == 1) for (int rep = 0; rep < PROBE_THIN_REPS; ++rep) conv_phase(rec, xc, p.in[I_LRU_CW] + j * 4 * D, p.in[I_LRU_CB] + j * D, gtid, NGT);
                else if (op == 2) { gk = 2; g = pg8::Gemm{xc, wtl + OFF_GT / 2, M, 2048, 256, 1024, 256, 512}; }
                else if (op == 3) for (int rep = 0; rep < PROBE_THIN_REPS; ++rep) scanA(Ab, Bb, SA, SB, tid);
                else if (op == 4) for (int rep = 0; rep < PROBE_THIN_REPS; ++rep) scanC(Ab, Bb, SA, SB, gate, hg, tid);
                else { gk = 3; g = pg8::Gemm{hg, wtl + OFF_LOUT / 2, M, 1024, 1024, 1024, 1024, 0}; }
            }
            for (int rep = 0; rep < PROBE_GEMM_REPS; ++rep)
            if (gk == 1) { pg8::StaticOrder S; S.init(g.M, g.N, G, (int)blockIdx.x);
                pg8::gemm_phase<pg8::EpiB, pg8::StaticOrder, true>((PG8_LAS unsigned char*)lds, g, S, E, tid); }
            else if (gk == 2) { pg8::StaticOrder S; S.init(g.M, g.N, G, (int)blockIdx.x);
                const pg8::EpiGate EG{(const u16*)(U + U_XC), (u16*)(U + U_LA), (u16*)(U + U_B), p.in[I_LRU_BA] + j * D, p.in[I_LRU_BX] + j * D, p.in[I_LRU_LAM] + j * D};
                pg8::gemm_phase<pg8::EpiGate, pg8::StaticOrder, true>((PG8_LAS unsigned char*)lds, g, S, EG, tid); }
            else if (gk == 3) { pg8::StaticOrder S; S.init(g.M, g.N, G, (int)blockIdx.x);
                const unsigned target = 32u * (unsigned)(layer * 2 + (op == 8 ? 2 : 1));
                const pg8::RowStats st1{(float*)(ws + WS_XS1), (unsigned*)(ws + WS_CNT1), target}, st2{(float*)(ws + WS_XS2), (unsigned*)(ws + WS_CNT2), target};
                const pg8::EpiNormRes EN{hn, (float*)(ws + WS_RS), x, gprev, gpost, gpre, st1, st2, (PG8_LAS unsigned char*)lds + XL_OFF};
                pg8::gemm_phase<pg8::EpiNormRes, pg8::StaticOrder, true>((PG8_LAS unsigned char*)lds, g, S, EN, tid); }
            if (!(layer == 3 && op == 8) && !(!lru && op == 2)) { for (int rep = 0; rep < PROBE_SYNC_REPS; ++rep) GRID_BAR(); }
        }
    }
}
}

extern "C" void kernel_launch(void* const* d_in, const int* in_sizes, int n_in, void* d_out, int out_size, void* d_ws, size_t ws_size, hipStream_t stream) {
    static int grid = 0;
    if (grid == 0) {
        if (n_in != 23 || in_sizes[0] != mk::M * mk::D || out_size != mk::M * mk::D || ws_size < mk::WS_END) {
            fprintf(stderr, "kernel_launch: unexpected shapes (n_in %d, in0 %d, out %d, ws %zu); nothing launched\n", n_in, n_in > 0 ? in_sizes[0] : -1, out_size, ws_size); grid = -1; return; }
        int dev = 0, cus = 0, per_cu = 0;
        (void)hipGetDevice(&dev); (void)hipDeviceGetAttribute(&cus, hipDeviceAttributeMultiprocessorCount, dev);
        if (hipFuncSetAttribute((const void*)mk::fwd_mega, hipFuncAttributeMaxDynamicSharedMemorySize, mk::LDS_BYTES) != hipSuccess) { fprintf(stderr, "kernel_launch: hipFuncSetAttribute failed\n"); grid = -1; return; }
        if (hipOccupancyMaxActiveBlocksPerMultiprocessor(&per_cu, (const void*)mk::fwd_mega, 512, mk::LDS_BYTES) != hipSuccess || per_cu < 1) { fprintf(stderr, "kernel_launch: occupancy query says %d blocks per CU\n", per_cu); per_cu = 1; }
        (void)hipGetLastError();
        grid = cus > 0 ? cus : 256;
    }
    if (grid < 0) return;
    mk::Params p{};
    for (int i = 0; i < 23; ++i) p.in[i] = (const float*)d_in[i];
    p.out = (float*)d_out; p.ws = (unsigned char*)d_ws;
    if (hipMemsetAsync((char*)d_ws + mk::WS_BAR, 0, mk::CTL_BYTES, stream) != hipSuccess) { fprintf(stderr, "kernel_launch: hipMemsetAsync failed\n"); return; }
    void* args[] = {&p};
    hipError_t e = hipLaunchCooperativeKernel((const void*)mk::fwd_mega, dim3(grid), dim3(512), args, mk::LDS_BYTES, stream);
    if (e != hipSuccess) fprintf(stderr, "kernel_launch: cooperative launch failed: %s (grid %d)\n", hipGetErrorString(e), grid);
}
```

```cpp
#include <hip/hip_runtime.h>
#include <hip/hip_bf16.h>
#include <hip/hip_cooperative_groups.h>
#include <cstdio>
#include <cstdint>
namespace cg = cooperative_groups;

__device__ __forceinline__ float xor1f(float v)  { return __int_as_float(__builtin_amdgcn_mov_dpp(__float_as_int(v), 0xB1, 0xF, 0xF, false)); }
__device__ __forceinline__ float xor2f(float v)  { return __int_as_float(__builtin_amdgcn_mov_dpp(__float_as_int(v), 0x4E, 0xF, 0xF, false)); }
__device__ __forceinline__ float xor4f(float v)  { return __int_as_float(__builtin_amdgcn_ds_swizzle(__float_as_int(v), 0x101F)); }
__device__ __forceinline__ float xor8f(float v)  { return __int_as_float(__builtin_amdgcn_ds_swizzle(__float_as_int(v), 0x201F)); }
__device__ __forceinline__ float xor16f(float v) { return __int_as_float(__builtin_amdgcn_ds_swizzle(__float_as_int(v), 0x401F)); }
__device__ __forceinline__ float sum32f(float v) { auto rr = __builtin_amdgcn_permlane32_swap(__float_as_uint(v), __float_as_uint(v), false, false); return __uint_as_float(rr[0]) + __uint_as_float(rr[1]); }
__device__ __forceinline__ int lane_id_fresh() { int l; asm volatile("v_mbcnt_lo_u32_b32 %0, -1, 0\n\tv_mbcnt_hi_u32_b32 %0, -1, %0" : "=v"(l)); return l; }
namespace pg8 {
#define PG8_LAS __attribute__((address_space(3)))
typedef unsigned short bf16_t;
typedef short bf16x8 __attribute__((ext_vector_type(8)));
typedef float f32x4 __attribute__((ext_vector_type(4)));
typedef unsigned u32x4 __attribute__((ext_vector_type(4)));
constexpr int BM = 256, BK = 64, HALF = 128, HTB = HALF * BK * 2  , STAGE_BYTES = 8 * HTB, NXCD = 8, WGM = 8;

__host__ __device__ __forceinline__ int lds_byte(int r, int c) { const int st = (r >> 4) * 2 + (c >> 5), rr = r & 15, cc = c & 31, ob = rr * 64 + cc * 2; return st * 1024 + (ob ^ (((ob >> 9) & 1) << 5)); }
__host__ __device__ __forceinline__ void stage_rc(int b, int& R, int& C) { const int st = b / 1024, sb = b % 1024, swz = sb ^ (((sb >> 9) & 1) << 5); R = (st >> 1) * 16 + swz / 64; C = (st & 1) * 32 + (swz % 64) / 2; }
__host__ __device__ __forceinline__ int perm32(int rho) { const int n = rho >> 4, i = rho & 15; return 8 * (i >> 2) + 4 * n + (i & 3); }

struct Unit { int pm, pn; };
struct Gemm { const bf16_t* A; const bf16_t* Bt; int M, N, K; int lda, ldb; int apn; };

struct StaticOrder {
    int nM, nN, nwg, G, c;
    __host__ __device__ void init(int M, int N, int G_, int c_) { nM = M / BM; nN = N / BM; nwg = nM * nN; G = G_; c = c_; }
    __host__ __device__ bool next(int i, Unit& u) const {
        const long L = (long)i * G + c; if (L >= nwg) return false;
        int wgid = (int)L; { const int q = nwg / NXCD, r = nwg % NXCD, xcd = wgid % NXCD, off = wgid / NXCD; wgid = (xcd < r ? xcd * (q + 1) : r * (q + 1) + (xcd - r) * q) + off; }
        const int nig = WGM * nN, gid = wgid / nig, fm = gid * WGM, gsz = (nM - fm) < WGM ? (nM - fm) : WGM;
        u.pm = fm + ((wgid % nig) % gsz); u.pn = (wgid % nig) / gsz; return true;
    }
    __device__ __forceinline__ void a_ready(const Unit&) const {}
    __device__ __forceinline__ void done(const Unit&) const {}
};

__device__ __forceinline__ unsigned cvt_pk_bf16(float lo, float hi) { unsigned r; asm volatile("v_cvt_pk_bf16_f32 %0, %1, %2" : "=v"(r) : "v"(lo), "v"(hi)); return r; }
__device__ __forceinline__ float gelu_tanh(float x) {
    const float z = 0.7978845608028654f * (x + 0.044715f * x * x * x);
    const float e = __expf(2.0f * z);
    const float th = 1.0f - 2.0f * __builtin_amdgcn_rcpf(1.0f + e);
    return 0.5f * x * (1.0f + th);
}
struct EpiB {
    static constexpr bool PERM = true, AFTER_DRAIN = false, FUSED = false;
    bf16_t* O; int ldc; int split_cols; size_t split_stride; int mode;
    const float* rss;
    __device__ __forceinline__ void operator()(const f32x4 (&acc)[2][2][4][2], const Unit& u, int wr, int wc, int fr, int fq) const {
        const int row0 = u.pm * BM + wr * 64 + fr; int colt = u.pn * BM; bf16_t* base = O; int t = 0;
        if (split_cols) { t = colt / split_cols; base += (size_t)t * split_stride; colt -= t * split_cols; }
        const int act = (mode == 1) ? 1 : ((mode == 2 && t == 0) ? 2 : 0);
        const int col0 = colt + wc * 32 + 8 * fq;
#pragma unroll
        for (int ai = 0; ai < 2; ++ai)
#pragma unroll
            for (int m = 0; m < 4; ++m) { bf16_t* rowp = base + (size_t)(row0 + ai * HALF + m * 16) * ldc + col0;
                float rsc = 1.0f; if (rss) { const f32x4 pp = *(const f32x4*)(rss + (size_t)(row0 + ai * HALF + m * 16) * 4); rsc = rsqrtf(((pp[0] + pp[1]) + (pp[2] + pp[3])) * (1.0f / 1024.0f) + 1e-6f); }
#pragma unroll
                for (int bj = 0; bj < 2; ++bj) { f32x4 v0 = acc[ai][bj][m][0] * rsc, v1 = acc[ai][bj][m][1] * rsc;
                    if (act == 1) {
#pragma unroll
                        for (int e = 0; e < 4; ++e) { const float a = fmaxf(v0[e], 0.f), b = fmaxf(v1[e], 0.f); v0[e] = a * a; v1[e] = b * b; } }
                    else if (act == 2) {
#pragma unroll
                        for (int e = 0; e < 4; ++e) { v0[e] = gelu_tanh(v0[e]); v1[e] = gelu_tanh(v1[e]); } }
                    u32x4 w; w.x = cvt_pk_bf16(v0[0], v0[1]); w.y = cvt_pk_bf16(v0[2], v0[3]); w.z = cvt_pk_bf16(v1[0], v1[1]); w.w = cvt_pk_bf16(v1[2], v1[3]);
                    *(u32x4*)(rowp + bj * HALF) = w; } }
    }
};
__device__ __forceinline__ float bf2f(unsigned short h) { return __uint_as_float(((unsigned)h) << 16); }
__device__ __forceinline__ float sigmoidf_(float x) { return __builtin_amdgcn_rcpf(1.0f + __expf(-x)); }
__device__ __forceinline__ float one_minus_exp(float t) { const float ser = -t * (1.0f + t * (0.5f + t * (0.16666667f + t * (0.041666668f + t * 0.008333334f)))); return t > -0.25f ? ser : 1.0f - __expf(t); }
struct EpiGate {
    static constexpr bool PERM = false, AFTER_DRAIN = false, FUSED = false;
    const bf16_t* xc; bf16_t* Aout; bf16_t* Bout; const float* b_a; const float* b_x; const float* lam;
    __device__ __forceinline__ void operator()(const f32x4 (&acc)[2][2][4][2], const Unit& u, int wr, int wc, int fr, int fq) const {
#pragma unroll
        for (int n = 0; n < 2; ++n) {
            const int ch0 = 128 * u.pn + 32 * wc + 16 * n + 4 * fq;
            const f32x4 ba = *(const f32x4*)(b_a + ch0), bx = *(const f32x4*)(b_x + ch0), lm = *(const f32x4*)(lam + ch0);
            f32x4 sp;
#pragma unroll
            for (int e = 0; e < 4; ++e) sp[e] = -8.0f * log1pf(__expf(-lm[e]));
#pragma unroll
            for (int ai = 0; ai < 2; ++ai)
#pragma unroll
                for (int m = 0; m < 4; ++m) {
                    const size_t off = (size_t)(u.pm * BM + ai * HALF + wr * 64 + m * 16 + fr) * 1024 + ch0;
                    const uint2 xr = *(const uint2*)(xc + off);
                    float xv[4] = { __uint_as_float(xr.x << 16), __uint_as_float(xr.x & 0xffff0000u), __uint_as_float(xr.y << 16), __uint_as_float(xr.y & 0xffff0000u) };
                    f32x4 av, bv;
#pragma unroll
                    for (int e = 0; e < 4; ++e) {
                        const float r = sigmoidf_(acc[ai][0][m][n][e] + ba[e]);
                        const float ig = sigmoidf_(acc[ai][1][m][n][e] + bx[e]);
                        const float la = sp[e] * r;
                        av[e] = la;
                        bv[e] = __builtin_amdgcn_sqrtf(fmaxf(one_minus_exp(2.0f * la), 0.f)) * (ig * xv[e]);
                    }
                    uint2 wa, wb; wa.x = cvt_pk_bf16(av[0], av[1]); wa.y = cvt_pk_bf16(av[2], av[3]); wb.x = cvt_pk_bf16(bv[0], bv[1]); wb.y = cvt_pk_bf16(bv[2], bv[3]);
                    *(uint2*)(Aout + off) = wa; *(uint2*)(Bout + off) = wb;
                }
        }
    }
};

struct RowStats {
    float* xbuf;
    unsigned* cnt;
    unsigned target;
    __device__ __forceinline__ void run(const f32x4 (&v)[2][2][4][2], const Unit& u, int wr, int wc, int fr, int fq, PG8_LAS unsigned char* xl, int wid, int lane) const {
        PG8_LAS float* P = (PG8_LAS float*)xl;
        PG8_LAS float* S = (PG8_LAS float*)(xl + 4096);
#pragma unroll
        for (int ai = 0; ai < 2; ++ai)
#pragma unroll
            for (int m = 0; m < 4; ++m) {
                float s = 0.f;
#pragma unroll
                for (int bj = 0; bj < 2; ++bj)
#pragma unroll
                    for (int n = 0; n < 2; ++n) { const f32x4 x = v[ai][bj][m][n]; s += (x[0] * x[0] + x[1] * x[1]) + (x[2] * x[2] + x[3] * x[3]); }
                s += xor16f(s); s = sum32f(s);
                if (fq == 0) P[(ai * HALF + wr * 64 + m * 16 + fr) * 4 + wc] = s;
            }
        asm volatile("s_waitcnt lgkmcnt(0)" ::: "memory"); __builtin_amdgcn_s_barrier(); asm volatile("" ::: "memory");
        const int row = wid * 32 + (lane & 31);
        if (lane < 32) { const float t = (P[row * 4 + 0] + P[row * 4 + 1]) + (P[row * 4 + 2] + P[row * 4 + 3]);
            __hip_atomic_store(xbuf + (size_t)(u.pm * BM + row) * 4 + u.pn, t, __ATOMIC_RELAXED, __HIP_MEMORY_SCOPE_AGENT); }
        asm volatile("s_waitcnt vmcnt(0)" ::: "memory");
        if (lane == 0) __hip_atomic_fetch_add(cnt + 64 * u.pm, 1u, __ATOMIC_RELAXED, __HIP_MEMORY_SCOPE_AGENT);
        if (wid == 0) { unsigned sp = 0;
            while ((unsigned)__builtin_amdgcn_readfirstlane(__hip_atomic_load(cnt + 64 * u.pm, __ATOMIC_RELAXED, __HIP_MEMORY_SCOPE_AGENT)) < target) { __builtin_amdgcn_s_sleep(2); if (++sp > (1u << 18)) break; }
            __builtin_amdgcn_fence(__ATOMIC_ACQUIRE, "agent"); }
        asm volatile("s_waitcnt vmcnt(0) lgkmcnt(0)" ::: "memory"); __builtin_amdgcn_s_barrier(); asm volatile("" ::: "memory");
        if (lane < 32) { float* slot = xbuf + (size_t)(u.pm * BM + row) * 4; float t = 0.f;
#pragma unroll
            for (int k = 0; k < 4; ++k) t += __hip_atomic_load(slot + k, __ATOMIC_RELAXED, __HIP_MEMORY_SCOPE_AGENT);
            S[row] = t; }
        asm volatile("s_waitcnt lgkmcnt(0)" ::: "memory"); __builtin_amdgcn_s_barrier(); asm volatile("" ::: "memory");
    }
};
struct EpiNormRes {
    static constexpr bool PERM = false, AFTER_DRAIN = false, FUSED = true;
    bf16_t* hn; float* xs2; float* out; const float* gprev; const float* gpost; const float* gpre; RowStats st1; PG8_LAS unsigned char* xl;
    const float* s_in;
    __device__ __forceinline__ void fused(f32x4 (&acc)[2][2][4][2], const Unit& u, int wr, int wc, int fr, int fq, int wid, int lane) const {
        typedef unsigned u32x2v __attribute__((ext_vector_type(2)));
        PG8_LAS float* P = (PG8_LAS float*)xl;
        const PG8_LAS float* S = (const PG8_LAS float*)(xl + 4096);
        const int col0 = u.pn * BM + wc * 32 + 4 * fq;
        st1.run(acc, u, wr, wc, fr, fq, xl, wid, lane);
#pragma unroll
        for (int ai = 0; ai < 2; ++ai)
#pragma unroll
            for (int m = 0; m < 4; ++m) { const int r = ai * HALF + wr * 64 + m * 16 + fr; float rstd = rsqrtf(S[r] * (1.0f / 1024.0f) + 1e-6f); const size_t off = (size_t)(u.pm * BM + r) * 1024 + col0;
                if (s_in) { const f32x4 pp = *(const f32x4*)(s_in + (size_t)(u.pm * BM + r) * 4); const float s2 = __builtin_amdgcn_rcpf(((pp[0] + pp[1]) + (pp[2] + pp[3])) * (1.0f / 1024.0f) + 1e-6f);
                    rstd = rsqrtf(S[r] * (1.0f / 1024.0f) * s2 * s2 + 1e-6f) * s2; }
#pragma unroll
                for (int bj = 0; bj < 2; ++bj)
#pragma unroll
                    for (int n = 0; n < 2; ++n) { const u32x2v hw = *(const u32x2v*)(hn + off + bj * HALF + n * 16);
                        const f32x4 gp = *(const f32x4*)(gprev + col0 + bj * HALF + n * 16); const f32x4 gv = *(const f32x4*)(gpost + col0 + bj * HALF + n * 16);
                        f32x4 xs; xs[0] = __uint_as_float(hw.x << 16) * __builtin_amdgcn_rcpf(gp[0]); xs[1] = __uint_as_float(hw.x & 0xffff0000u) * __builtin_amdgcn_rcpf(gp[1]);
                        xs[2] = __uint_as_float(hw.y << 16) * __builtin_amdgcn_rcpf(gp[2]); xs[3] = __uint_as_float(hw.y & 0xffff0000u) * __builtin_amdgcn_rcpf(gp[3]);
                        acc[ai][bj][m][n] = xs + (acc[ai][bj][m][n] * rstd) * gv; }
                asm volatile("" : "+v"(acc[ai][0][m][0]), "+v"(acc[ai][0][m][1]), "+v"(acc[ai][1][m][0]), "+v"(acc[ai][1][m][1]));
                if (m & 1) asm volatile("" ::: "memory"); }
        if (gpre) {
#pragma unroll
            for (int ai = 0; ai < 2; ++ai)
#pragma unroll
                for (int m = 0; m < 4; ++m) {
                    float s = 0.f;
#pragma unroll
                    for (int bj = 0; bj < 2; ++bj)
#pragma unroll
                        for (int n = 0; n < 2; ++n) { const f32x4 x = acc[ai][bj][m][n]; s += (x[0] * x[0] + x[1] * x[1]) + (x[2] * x[2] + x[3] * x[3]); }
                    s += xor16f(s); s = sum32f(s);
                    if (fq == 0) P[(ai * HALF + wr * 64 + m * 16 + fr) * 4 + wc] = s;
                }
            asm volatile("s_waitcnt lgkmcnt(0)" ::: "memory"); __builtin_amdgcn_s_barrier(); asm volatile("" ::: "memory");
            { const int row = wid * 32 + (lane & 31);
              if (lane < 32) xs2[(size_t)(u.pm * BM + row) * 4 + u.pn] = (P[row * 4 + 0] + P[row * 4 + 1]) + (P[row * 4 + 2] + P[row * 4 + 3]); }
#pragma unroll
            for (int ai = 0; ai < 2; ++ai)
#pragma unroll
                for (int m = 0; m < 4; ++m) { const int r = ai * HALF + wr * 64 + m * 16 + fr; const size_t off = (size_t)(u.pm * BM + r) * 1024 + col0;
#pragma unroll
                    for (int bj = 0; bj < 2; ++bj)
#pragma unroll
                        for (int n = 0; n < 2; ++n) { const f32x4 gv = *(const f32x4*)(gpre + col0 + bj * HALF + n * 16); const f32x4 o = acc[ai][bj][m][n] * gv;
                            u32x2v w; w.x = cvt_pk_bf16(o[0], o[1]); w.y = cvt_pk_bf16(o[2], o[3]); *(u32x2v*)(hn + off + bj * HALF + n * 16) = w; }
                    asm volatile("" ::: "memory"); }
            asm volatile("s_waitcnt lgkmcnt(0)" ::: "memory"); __builtin_amdgcn_s_barrier(); asm volatile("" ::: "memory");
        } else {
#pragma unroll
            for (int ai = 0; ai < 2; ++ai)
#pragma unroll
                for (int m = 0; m < 4; ++m) { const int r = ai * HALF + wr * 64 + m * 16 + fr; const size_t off = (size_t)(u.pm * BM + r) * 1024 + col0;
#pragma unroll
                    for (int bj = 0; bj < 2; ++bj)
#pragma unroll
                        for (int n = 0; n < 2; ++n) *(f32x4*)(out + off + bj * HALF + n * 16) = acc[ai][bj][m][n]; }
        }
    }
};

template <class Epi, class Sched, bool ALIGN_EPI>
__device__ __forceinline__ void gemm_phase(PG8_LAS unsigned char* lds, const Gemm g, const Sched& S, const Epi& E, int tid0) {
    int tid_ = tid0; asm volatile("" : "+v"(tid_));
    const int tid = tid_, wid = __builtin_amdgcn_readfirstlane(tid >> 6), lane = tid & 63, wr = wid >> 2, wc = wid & 3, fr = lane & 15, fq = lane >> 4;
    const int K = g.K, nt = K / BK;
    unsigned voffA[2], voffB[2];
#pragma unroll
    for (int i = 0; i < 2; ++i) { int R, C; stage_rc(tid * 16 + i * 8192, R, C); const int Rb = Epi::PERM ? ((R & ~31) + perm32(R & 31)) : R;
        voffA[i] = (unsigned)(R * g.lda + C) * 2u; voffB[i] = (unsigned)(Rb * g.ldb + C) * 2u; }
    const size_t kstep = (size_t)(BK * 2);
    const size_t hstepA = (size_t)HALF * g.lda * 2, hstepB = (size_t)HALF * g.ldb * 2;
    const size_t tstepA = 2 * hstepA, tstepB = 2 * hstepB;
    const unsigned ldsw = (unsigned)wid * 1024u;
    const int aoff = lds_byte(wr * 64 + fr, fq * 8), boff = lds_byte(wc * 32 + fr, fq * 8);
#define PG8_SA(b, h) (((b) * 2 + (h)) * HTB)
#define PG8_SB(b, h) ((4 + (b) * 2 + (h)) * HTB)
#define PG8_STAGE(bufoff, gbase, voff) do { _Pragma("unroll") for (int _i = 0; _i < 2; ++_i) \
        __builtin_amdgcn_global_load_lds((const unsigned*)((const char*)(gbase) + (voff)[_i]), (PG8_LAS unsigned*)(lds + (bufoff) + ldsw + _i * 8192), 16, 0, 0); } while (0)
#define PG8_LDA(dst, b, h) do { _Pragma("unroll") for (int m = 0; m < 4; ++m) _Pragma("unroll") for (int k = 0; k < 2; ++k) dst[m][k] = *(const PG8_LAS bf16x8*)(lds + PG8_SA(b, h) + aoff + m * 2048 + k * 1024); } while (0)
#define PG8_LDB(dst, b, h) do { _Pragma("unroll") for (int n = 0; n < 2; ++n) _Pragma("unroll") for (int k = 0; k < 2; ++k) dst[n][k] = *(const PG8_LAS bf16x8*)(lds + PG8_SB(b, h) + boff + n * 2048 + k * 1024); } while (0)
#define PG8_MMA(ai, bj, At, Bt) do { __builtin_amdgcn_s_setprio(1); _Pragma("unroll") for (int m = 0; m < 4; ++m) _Pragma("unroll") for (int n = 0; n < 2; ++n) _Pragma("unroll") for (int k = 0; k < 2; ++k) \
        acc[ai][bj][m][n] = __builtin_amdgcn_mfma_f32_16x16x32_bf16(Bt[n][k], At[m][k], acc[ai][bj][m][n], 0, 0, 0); __builtin_amdgcn_s_setprio(0); } while (0)
#define PG8_WAIT_V(n) asm volatile("s_waitcnt vmcnt(" #n ")" ::: "memory")
#define PG8_WAIT_L(n) asm volatile("s_waitcnt lgkmcnt(" #n ")" ::: "memory")
#define PG8_BAR __builtin_amdgcn_s_barrier()
#define PG8_SCHED __builtin_amdgcn_sched_barrier(0)
    Unit cur, nxt; int ui = 0;
    if (!S.next(0, cur)) return;
    f32x4 acc[2][2][4][2];
#pragma unroll
    for (int a = 0; a < 2; ++a)
#pragma unroll
        for (int b = 0; b < 2; ++b)
#pragma unroll
            for (int m = 0; m < 4; ++m)
#pragma unroll
                for (int n = 0; n < 2; ++n) acc[a][b][m][n] = (f32x4){0.f, 0.f, 0.f, 0.f};
    bf16x8 At[4][2], B0[2][2], B1[2][2];
    const char* cA = (const char*)g.A + (size_t)cur.pm * tstepA + (size_t)(cur.pn >> 1) * (size_t)g.apn; const char* cB = (const char*)g.Bt + (size_t)cur.pn * tstepB;
    S.a_ready(cur);
    PG8_STAGE(PG8_SB(0, 0), cB, voffB); PG8_STAGE(PG8_SB(0, 1), cB + hstepB, voffB); PG8_STAGE(PG8_SA(0, 0), cA, voffA); PG8_STAGE(PG8_SA(0, 1), cA + hstepA, voffA);
    if (wr == 1) PG8_BAR;
    PG8_WAIT_V(2); PG8_BAR;
    PG8_STAGE(PG8_SB(1, 0), cB + kstep, voffB); PG8_STAGE(PG8_SA(1, 0), cA + kstep, voffA); PG8_STAGE(PG8_SB(1, 1), cB + hstepB + kstep, voffB);
    PG8_WAIT_V(6); PG8_BAR;
    for (;;) {
        const bool has_next = S.next(ui + 1, nxt);
        const char* nA = has_next ? (const char*)g.A + (size_t)nxt.pm * tstepA + (size_t)(nxt.pn >> 1) * (size_t)g.apn : cA; const char* nB = has_next ? (const char*)g.Bt + (size_t)nxt.pn * tstepB : cB;
        for (int t = 0; t < nt; t += 2) {
            const bool last = (t == nt - 2);
            const char* a1 = cA + (size_t)(t + 1) * kstep;
            const char* a2 = last ? nA : cA + (size_t)(t + 2) * kstep; const char* b2 = last ? nB : cB + (size_t)(t + 2) * kstep;
            const char* a3 = a2 + kstep; const char* b3 = b2 + kstep;
            if (last && has_next) S.a_ready(nxt);
            PG8_LDB(B0, 0, 0); PG8_LDB(B1, 0, 1); PG8_SCHED; PG8_LDA(At, 0, 0); PG8_STAGE(PG8_SA(1, 1), a1 + hstepA, voffA);
            PG8_WAIT_V(8); PG8_WAIT_L(0); PG8_BAR; PG8_MMA(0, 0, At, B0); PG8_MMA(0, 1, At, B1); PG8_BAR; PG8_SCHED;
            PG8_LDA(At, 0, 1); PG8_STAGE(PG8_SB(0, 0), b2, voffB); PG8_STAGE(PG8_SB(0, 1), b2 + hstepB, voffB); PG8_STAGE(PG8_SA(0, 0), a2, voffA);
            PG8_WAIT_V(8); PG8_WAIT_L(0); PG8_BAR; PG8_MMA(1, 0, At, B0); PG8_MMA(1, 1, At, B1); PG8_BAR; PG8_SCHED;
            PG8_LDB(B0, 1, 0); PG8_LDB(B1, 1, 1); PG8_SCHED; PG8_LDA(At, 1, 0); PG8_STAGE(PG8_SA(0, 1), a2 + hstepA, voffA);
            PG8_WAIT_V(8); PG8_WAIT_L(0); PG8_BAR; PG8_MMA(0, 0, At, B0); PG8_MMA(0, 1, At, B1); PG8_BAR; PG8_SCHED;
            PG8_LDA(At, 1, 1); PG8_STAGE(PG8_SB(1, 0), b3, voffB); PG8_STAGE(PG8_SB(1, 1), b3 + hstepB, voffB); PG8_STAGE(PG8_SA(1, 0), a3, voffA);
            PG8_WAIT_V(8); PG8_WAIT_L(0); PG8_BAR; PG8_MMA(1, 0, At, B0); PG8_MMA(1, 1, At, B1); PG8_BAR; PG8_SCHED;
        }
        if constexpr (ALIGN_EPI) { if (wr == 0) PG8_BAR; }
        if constexpr (Epi::FUSED) E.fused(acc, cur, wr, wc, fr, fq, wid, lane); else E(acc, cur, wr, wc, fr, fq);
        S.done(cur);
        if (!has_next) break;
#pragma unroll
        for (int a = 0; a < 2; ++a)
#pragma unroll
            for (int b = 0; b < 2; ++b)
#pragma unroll
                for (int m = 0; m < 4; ++m)
#pragma unroll
                    for (int n = 0; n < 2; ++n) acc[a][b][m][n] = (f32x4){0.f, 0.f, 0.f, 0.f};
        cur = nxt; cA = nA; cB = nB; ++ui;
        if constexpr (ALIGN_EPI) { if (wr == 1) PG8_BAR; }
    }
    PG8_WAIT_V(0);
    if constexpr (!ALIGN_EPI) { if (wr == 0) PG8_BAR; }
    PG8_BAR;
#undef PG8_SA
#undef PG8_SB
#undef PG8_STAGE
#undef PG8_LDA
#undef PG8_LDB
#undef PG8_MMA
#undef PG8_WAIT_V
#undef PG8_WAIT_L
#undef PG8_BAR
#undef PG8_SCHED
}
}
namespace att {
typedef unsigned short u16;
typedef short bf16x8 __attribute__((ext_vector_type(8)));
typedef short s16x4 __attribute__((ext_vector_type(4)));
typedef float f32x16 __attribute__((ext_vector_type(16)));
typedef float f32x4 __attribute__((ext_vector_type(4)));
typedef unsigned u32x4 __attribute__((ext_vector_type(4)));
constexpr int SEQ = 16384, NW = 8, QBLK = 32, KVBLK = 64, QB = NW * QBLK;
constexpr int LDQ = 1536, LDK = 2048, LDKR = 64, LDO = 1024;
#ifndef ATT_NQREG
#define ATT_NQREG 4
#endif
constexpr int NQREG = ATT_NQREG, NQREG_L = 8 - NQREG;
constexpr int SHM_V = KVBLK * 128 * 2, SHM_K = KVBLK * 128 * 2, SHM_KR = KVBLK * 64 * 2;
constexpr int OFF_V = 0, OFF_K = 2 * SHM_V, OFF_KR = OFF_K + 2 * SHM_K, OFF_WS = OFF_KR + 2 * SHM_KR, OFF_QR = OFF_WS + NW * 64 * 4, QR_WAVE = (NQREG_L + 4) * 1024, LDS_BYTES = OFF_QR + NW * QR_WAVE;
constexpr float SCALE = 0.07216878364870322f;
constexpr float THR = 8.f;

#define KSWZ(row, colB) ((row) * 256 + ((colB) ^ (((row) & 7) << 4)))
#define KRSWZ(row, colB) ((row) * 128 + ((colB) ^ (((row) & 7) << 4)))
#define SBAR() __builtin_amdgcn_sched_barrier(0)
__device__ __forceinline__ int v_st(int k, int c) { const int kk = (k & ~0xC) | ((k & 4) << 1) | ((k & 8) >> 1); return ((kk >> 3) * 4 + (c >> 5)) * 512 + ((kk & 7) * 32 + (c & 31)) * 2; }
__device__ __forceinline__ int v_rd_base(int lane) { return ((lane & 3) << 3) | (((lane >> 2) & 3) << 6) | (((lane >> 4) & 1) << 5) | (((lane >> 5) & 1) << 8); }
constexpr int v_rd_off(int d0, int ks, int half) { return d0 * 512 + ks * 4096 + half * 2048; }
__device__ __forceinline__ int crow(int r, int hi) { return (r & 3) + 8 * (r >> 2) + 4 * hi; }
__device__ __forceinline__ unsigned cvtpk(float lo, float hi) { unsigned r; asm volatile("v_cvt_pk_bf16_f32 %0, %1, %2" : "=v"(r) : "v"(lo), "v"(hi)); return r; }
__device__ __forceinline__ bf16x8 load8(const u16* p) { return *reinterpret_cast<const bf16x8*>(p); }
__device__ __forceinline__ void mask_tile(f32x16& p0, f32x16& p1, int dq, unsigned W) {
    const float NEG = -__builtin_inff();
#pragma unroll
    for (int r = 0; r < 16; ++r) {
        const int c = (r & 3) + 8 * (r >> 2);
        if ((unsigned)(dq - c) >= W) p0[r] = NEG;
        if ((unsigned)(dq - c - 32) >= W) p1[r] = NEG;
    }
}
__device__ __forceinline__ void partialSM(f32x16& p0, f32x16& p1, float& m_reg, float& mn, float& alpha) {
    float pmax = p0[0]; for (int r = 1; r < 16; ++r) pmax = fmaxf(pmax, p0[r]); for (int r = 0; r < 16; ++r) pmax = fmaxf(pmax, p1[r]);
    { auto rr = __builtin_amdgcn_permlane32_swap(__float_as_uint(pmax), __float_as_uint(pmax), false, false);
      pmax = fmaxf(__uint_as_float(rr[0]), __uint_as_float(rr[1])); }
    constexpr float C2 = 1.4426950408889634f * SCALE;
    if (__builtin_expect(__all((pmax - m_reg) * SCALE <= THR), 1)) { mn = m_reg; alpha = 1.f; }
    else { mn = fmaxf(m_reg, pmax); alpha = __builtin_amdgcn_exp2f((m_reg - mn) * C2); m_reg = mn; }
    const float mnL = -mn * C2;
    for (int r = 0; r < 16; ++r) p0[r] = fmaf(p0[r], C2, mnL); for (int r = 0; r < 16; ++r) p1[r] = fmaf(p1[r], C2, mnL);
    for (int r = 0; r < 16; ++r) p0[r] = __builtin_amdgcn_exp2f(p0[r]);
}
__device__ __forceinline__ void finishSM(f32x16& p0, f32x16& p1, float alpha, float& l_reg, bf16x8& pa0, bf16x8& pa1, bf16x8& pa2, bf16x8& pa3) {
    for (int r = 0; r < 16; ++r) p1[r] = __builtin_amdgcn_exp2f(p1[r]);
    float ps = 0; for (int r = 0; r < 16; ++r) ps += p0[r]; for (int r = 0; r < 16; ++r) ps += p1[r];
    { auto rr = __builtin_amdgcn_permlane32_swap(__float_as_uint(ps), __float_as_uint(ps), false, false);
      ps = __uint_as_float(rr[0]) + __uint_as_float(rr[1]); }
    l_reg = l_reg * alpha + ps;
#define PK4(P, B_, OUT) do { unsigned a0 = cvtpk(P[B_+0], P[B_+1]), a1 = cvtpk(P[B_+2], P[B_+3]);                          \
        unsigned b0 = cvtpk(P[B_+4], P[B_+5]), b1 = cvtpk(P[B_+6], P[B_+7]);                                             \
        auto r0 = __builtin_amdgcn_permlane32_swap(a0, b0, false, false); auto r1 = __builtin_amdgcn_permlane32_swap(a1, b1, false, false); \
        u32x4 w = {r0[0], r1[0], r0[1], r1[1]}; OUT = *reinterpret_cast<bf16x8*>(&w); } while (0)
    PK4(p0, 0, pa0); PK4(p0, 8, pa1); PK4(p1, 0, pa2); PK4(p1, 8, pa3);
#undef PK4
}
template <int KB>
__device__ __forceinline__ void qkt(f32x16& p0, f32x16& p1, const char* K_lds, const char* KR_lds, const bf16x8* qrl, int r32, int hi, const bf16x8* qr) {
    p0 = f32x16{}; p1 = f32x16{};
    __builtin_amdgcn_s_setprio(1);
    const char* kb[4];
#pragma unroll
    for (int dd = 0; dd < 4; ++dd) kb[dd] = K_lds + KB * SHM_K + KSWZ(r32, (dd * 16 + hi * 8) * 2);
#pragma unroll
    for (int d0 = 0; d0 < 8; ++d0) { const char* a = kb[d0 & 3] + (d0 >> 2) * 128;
        bf16x8 b0 = *reinterpret_cast<const bf16x8*>(a);
        bf16x8 b1 = *reinterpret_cast<const bf16x8*>(a + 32 * 256);
        bf16x8 q; if (d0 < NQREG) q = qr[d0]; else q = qrl[(d0 - NQREG) * 64];
        p0 = __builtin_amdgcn_mfma_f32_32x32x16_bf16(b0, q, p0, 0, 0, 0);
        p1 = __builtin_amdgcn_mfma_f32_32x32x16_bf16(b1, q, p1, 0, 0, 0); }
#pragma unroll
    for (int d = 0; d < 4; ++d) { const char* a = KR_lds + KB * SHM_KR + KRSWZ(r32, (d * 16 + hi * 8) * 2);
        bf16x8 b0 = *reinterpret_cast<const bf16x8*>(a);
        bf16x8 b1 = *reinterpret_cast<const bf16x8*>(a + 32 * 128);
        bf16x8 q = qrl[(NQREG_L + d) * 64];
        p0 = __builtin_amdgcn_mfma_f32_32x32x16_bf16(b0, q, p0, 0, 0, 0);
        p1 = __builtin_amdgcn_mfma_f32_32x32x16_bf16(b1, q, p1, 0, 0, 0); }
    __builtin_amdgcn_s_setprio(0);
}
template <int VB>
__device__ __forceinline__ void pv_tile(f32x16* o, int vb0, bf16x8 pa0, bf16x8 pa1, bf16x8 pa2, bf16x8 pa3) {
#define TRRD(dst, off) asm volatile("ds_read_b64_tr_b16 %0, %1 offset:%2" : "=&v"(dst) : "v"(vb0), "i"(off) : "memory")
#define PV_D0(d0) do { s16x4 l0, l1, l2, l3, h0, h1, h2, h3; constexpr int b_ = OFF_V + VB * SHM_V + v_rd_off(d0, 0, 0); \
        TRRD(l0, b_); TRRD(h0, b_ + 2048); TRRD(l1, b_ + 4096); TRRD(h1, b_ + 6144); TRRD(l2, b_ + 8192); TRRD(h2, b_ + 10240); TRRD(l3, b_ + 12288); TRRD(h3, b_ + 14336); \
        asm volatile("s_waitcnt lgkmcnt(0)" ::: "memory"); SBAR();   \
        o[d0] = __builtin_amdgcn_mfma_f32_32x32x16_bf16(pa0, (bf16x8){l0[0], l0[1], l0[2], l0[3], h0[0], h0[1], h0[2], h0[3]}, o[d0], 0, 0, 0);   \
        o[d0] = __builtin_amdgcn_mfma_f32_32x32x16_bf16(pa1, (bf16x8){l1[0], l1[1], l1[2], l1[3], h1[0], h1[1], h1[2], h1[3]}, o[d0], 0, 0, 0);   \
        o[d0] = __builtin_amdgcn_mfma_f32_32x32x16_bf16(pa2, (bf16x8){l2[0], l2[1], l2[2], l2[3], h2[0], h2[1], h2[2], h2[3]}, o[d0], 0, 0, 0);   \
        o[d0] = __builtin_amdgcn_mfma_f32_32x32x16_bf16(pa3, (bf16x8){l3[0], l3[1], l3[2], l3[3], h3[0], h3[1], h3[2], h3[3]}, o[d0], 0, 0, 0); } while (0)
    __builtin_amdgcn_s_setprio(1); PV_D0(0); PV_D0(1); PV_D0(2); PV_D0(3); __builtin_amdgcn_s_setprio(0);
#undef PV_D0
#undef TRRD
}

struct BlockRef { const u16* Q; const u16* K; const u16* V; const u16* KR; u16* O; int P0; int row0; };
struct Seam { bf16x8 st_v0, st_v1; };
#define ROWK(p, k0, rr) ((p) + (size_t)((k0) + (rr)) * LDK + sc)
#define VMW() asm volatile("s_waitcnt vmcnt(0)" ::: "memory")
#define VMWN(n) asm volatile("s_waitcnt vmcnt(%0)" :: "i"(n) : "memory")
#define ATT_LAS __attribute__((address_space(3)))
#define SLOAD_H(Kp, Vp, KRp, k0, bf) do { S.st_v0 = load8(ROWK(Vp, k0, sr)); S.st_v1 = load8(ROWK(Vp, k0, 32 + sr));              \
        __builtin_amdgcn_global_load_lds((const unsigned*)((Kp) + (size_t)((k0) + sr) * LDK + ksc), (ATT_LAS unsigned*)(ldsL + OFF_K + (bf) * SHM_K + wid * 1024), 16, 0, 0); \
        __builtin_amdgcn_global_load_lds((const unsigned*)((Kp) + (size_t)((k0) + 32 + sr) * LDK + ksc), (ATT_LAS unsigned*)(ldsL + OFF_K + (bf) * SHM_K + 8192 + wid * 1024), 16, 0, 0); \
        __builtin_amdgcn_global_load_lds((const unsigned*)((KRp) + (size_t)((k0) + krr) * LDKR + krsc), (ATT_LAS unsigned*)(ldsL + OFF_KR + (bf) * SHM_KR + wid * 1024), 16, 0, 0); } while (0)
#define SWRITE_HK(bf) do { } while (0)
#define SWRITE_HV(bf) do { *(bf16x8*)(V_lds + (bf) * SHM_V + vst0) = S.st_v0; *(bf16x8*)(V_lds + (bf) * SHM_V + vst1) = S.st_v1; } while (0)
#define SWRITE_H(bf) do { SWRITE_HV(bf); SWRITE_HK(bf); } while (0)
__device__ __forceinline__ void attn_prime(const BlockRef& cur, char* lds, Seam& S, int tid0) {
    int tid_ = tid0; asm volatile("" : "+v"(tid_));
    const int tid = tid_, wid = __builtin_amdgcn_readfirstlane(tid >> 6), lane = tid & 63, r32 = lane & 31, hi = lane >> 5;
    const int sr = tid >> 4, sc = (tid & 15) * 8, ksc = ((tid & 15) ^ (sr & 7)) * 8;
    const int krr = tid >> 3, krsc = ((tid & 7) ^ (krr & 7)) * 8; ATT_LAS unsigned char* ldsL = (ATT_LAS unsigned char*)lds;
    SLOAD_H(cur.K, cur.V, cur.KR, 0, 0); VMW();
    __syncthreads();
}
__device__ __forceinline__ void attn_block(const BlockRef& cur, const BlockRef& nxt, char* lds, Seam& S, int tid0, const float* ctab, const float* stab) {
    int tid_ = tid0; asm volatile("" : "+v"(tid_));
    const int tid = tid_, wid = __builtin_amdgcn_readfirstlane(tid >> 6), lane = tid & 63, r32 = lane & 31, hi = lane >> 5;
    const unsigned W = 0x40000000u;
    const int NT = (cur.P0 + QB - 1) / KVBLK + 1;
    const int qlo = cur.P0 + wid * QBLK, qm = qlo + r32 - 4 * hi;
    char* V_lds = lds + OFF_V; char* K_lds = lds + OFF_K; char* KR_lds = lds + OFF_KR;
    float* ws = (float*)(lds + OFF_WS) + wid * 64; float* li_l = ws, * al_l = ws + 32;
    bf16x8* qrl = (bf16x8*)(lds + OFF_QR + wid * QR_WAVE) + lane;
    float m_reg = -1e30f, l_reg = 0; f32x16 o[4] = {};
    const int sr = tid >> 4, sc = (tid & 15) * 8, vst0 = v_st(sr, sc), vst1 = v_st(32 + sr, sc), ksc = ((tid & 15) ^ (sr & 7)) * 8;
    const int krr = tid >> 3, krsc = ((tid & 7) ^ (krr & 7)) * 8; ATT_LAS unsigned char* ldsL = (ATT_LAS unsigned char*)lds;
    const int vb0 = (int)(uintptr_t)lds + v_rd_base(lane);
    const u16* Kh = cur.K; const u16* Vh = cur.V; const u16* KRh = cur.KR;
#define RESC(a) do { if (__any((a) < 1.f)) { if (hi == 0) al_l[r32] = (a); asm volatile("s_waitcnt lgkmcnt(0)" ::: "memory");              \
                     for (int d_ = 0; d_ < 4; ++d_) for (int r = 0; r < 16; ++r) o[d_][r] *= al_l[crow(r, hi)]; } } while (0)
#define KBASE(t) ((t) * KVBLK)
#define MASKT(P0_, P1_, t) do { const int kb_ = KBASE(t); if (kb_ + KVBLK - 1 > qlo) mask_tile(P0_, P1_, qm - kb_, W); } while (0)
#define SEAM_K0() do { VMW(); SWRITE_HK(0); SBAR(); } while (0)
    f32x16 pA0, pA1, pB0, pB1; float mnA, mnB, alA, alB; bf16x8 pa0, pa1, pa2, pa3;
    bf16x8 qr[NQREG > 0 ? NQREG : 1];
    { const u16* qp = cur.Q + (size_t)(wid * QBLK + r32) * LDQ + hi * 8;
#pragma unroll
      for (int d = 0; d < NQREG_L; ++d) qrl[d * 64] = load8(qp + (NQREG + d) * 16);
      const size_t trow = (size_t)(cur.row0 + wid * QBLK + r32) * 32 + hi * 8;
#pragma unroll
      for (int pr = 0; pr < 2; ++pr) {
          const bf16x8 x1 = load8(qp + 128 + pr * 16), x2 = load8(qp + 128 + 32 + pr * 16);
          const f32x4 c0 = *(const f32x4*)(ctab + trow + pr * 16), c1 = *(const f32x4*)(ctab + trow + pr * 16 + 4), s0 = *(const f32x4*)(stab + trow + pr * 16), s1 = *(const f32x4*)(stab + trow + pr * 16 + 4);
          float o1[8], o2[8];
#pragma unroll
          for (int e = 0; e < 8; ++e) { const float a = __uint_as_float(((unsigned)(unsigned short)x1[e]) << 16), b = __uint_as_float(((unsigned)(unsigned short)x2[e]) << 16);
              const float cc = e < 4 ? c0[e & 3] : c1[e & 3], ss = e < 4 ? s0[e & 3] : s1[e & 3]; o1[e] = a * cc - b * ss; o2[e] = b * cc + a * ss; }
          u32x4 w1 = {cvtpk(o1[0], o1[1]), cvtpk(o1[2], o1[3]), cvtpk(o1[4], o1[5]), cvtpk(o1[6], o1[7])}, w2 = {cvtpk(o2[0], o2[1]), cvtpk(o2[2], o2[3]), cvtpk(o2[4], o2[5]), cvtpk(o2[6], o2[7])};
          qrl[(NQREG_L + pr) * 64] = *reinterpret_cast<bf16x8*>(&w1); qrl[(NQREG_L + 2 + pr) * 64] = *reinterpret_cast<bf16x8*>(&w2); }
#pragma unroll
      for (int d0 = 0; d0 < NQREG; ++d0) qr[d0] = load8(qp + d0 * 16); }
    SWRITE_HV(0); SBAR();
    if (NT > 1) SLOAD_H(Kh, Vh, KRh, KBASE(1), 1);
    SBAR(); qkt<0>(pA0, pA1, K_lds, KR_lds, qrl, r32, hi, qr);
    MASKT(pA0, pA1, 0); partialSM(pA0, pA1, m_reg, mnA, alA);
    if (NT > 1) { VMW(); SWRITE_H(1); }
    __syncthreads();
#define HALF_STEP(PX0, PX1, mnX, alX, PY0, PY1, alY, t, KB, VB, SB) do {                                                      \
        SBAR(); qkt<KB>(PX0, PX1, K_lds, KR_lds, qrl, r32, hi, qr);                                                          \
        finishSM(PY0, PY1, alY, l_reg, pa0, pa1, pa2, pa3); SBAR();                                                           \
        if ((t) + 1 < NT) { SLOAD_H(Kh, Vh, KRh, KBASE((t) + 1), SB); SBAR(); }                                                   \
        pv_tile<VB>(o, vb0, pa0, pa1, pa2, pa3); MASKT(PX0, PX1, (t)); partialSM(PX0, PX1, m_reg, mnX, alX);                  \
        __syncthreads();                                                                                                      \
        if ((t) + 1 < NT) { VMW(); SWRITE_H(SB); }                                                                            \
        RESC(alX); __syncthreads(); } while (0)
    for (int t = 1; t + 1 < NT; t += 2) {
        HALF_STEP(pB0, pB1, mnB, alB, pA0, pA1, alA, t, 1, 0, 0);
        HALF_STEP(pA0, pA1, mnA, alA, pB0, pB1, alB, t + 1, 0, 1, 1);
    }
    const bool even = (NT & 1) == 0;
    if (even) { SBAR(); qkt<1>(pB0, pB1, K_lds, KR_lds, qrl, r32, hi, qr); SBAR(); }
    SLOAD_H(nxt.K, nxt.V, nxt.KR, 0, 0); SBAR();
    finishSM(pA0, pA1, alA, l_reg, pa0, pa1, pa2, pa3); SBAR();
    pv_tile<0>(o, vb0, pa0, pa1, pa2, pa3);
    if (even) { MASKT(pB0, pB1, NT - 1); partialSM(pB0, pB1, m_reg, mnB, alB); __syncthreads(); RESC(alB);
        finishSM(pB0, pB1, alB, l_reg, pa0, pa1, pa2, pa3); SBAR(); pv_tile<1>(o, vb0, pa0, pa1, pa2, pa3); }
    SBAR(); SEAM_K0();
    if (hi == 0) li_l[r32] = l_reg; asm volatile("s_waitcnt lgkmcnt(0)" ::: "memory");
    float rli[16];
#pragma unroll
    for (int r = 0; r < 16; ++r) rli[r] = __builtin_amdgcn_rcpf(li_l[crow(r, hi)]);
    u16* Ow = cur.O + (size_t)(wid * QBLK) * LDO;
#pragma unroll
    for (int r = 0; r < 16; ++r) { const int orow = crow(r, hi);
#pragma unroll
        for (int d0 = 0; d0 < 4; ++d0) { const float v = o[d0][r] * rli[r];
            const float vn = xor1f(v);
            if ((r32 & 1) == 0) *(unsigned*)(Ow + (size_t)orow * LDO + d0 * 32 + r32) = cvtpk(v, vn); } }
    __syncthreads();
#undef RESC
#undef KBASE
#undef MASKT
#undef SEAM_K0
#undef HALF_STEP
}
struct Tensors { const u16* q; const u16* kv; const u16* kr; u16* o; const float* ctab; const float* stab; };
__device__ __forceinline__ BlockRef make_ref(const Tensors& T, int L, int pass) {
    const int bh = (L & 7) + 8 * (L >> 8), x = (L >> 3) & 31, b = bh >> 3, h = bh & 7, qb = pass ? 63 - x : x;
    BlockRef r; const size_t row0 = (size_t)b * SEQ;
    r.Q = T.q + (row0 + (size_t)qb * QB) * LDQ + h * 192; r.K = T.kv + row0 * LDK + h * 256; r.V = r.K + 128; r.KR = T.kr + row0 * LDKR;
    r.O = T.o + (row0 + (size_t)qb * QB) * LDO + h * 128; r.P0 = qb * QB; r.row0 = b * SEQ + qb * QB;
    return r;
}
__device__ __forceinline__ void attn_phase(char* lds, const Tensors& T, int tid0) {
    const int total = 512, stride = gridDim.x;
    int L = blockIdx.x; if (L >= total) return;
    int pass = 0;
    BlockRef cur = make_ref(T, L, 0);
    Seam S;
    attn_prime(cur, lds, S, tid0);
    for (;;) {
        const bool more_pass = pass == 0, more_item = L + stride < total, last = !more_pass && !more_item;
        int passn = pass + 1, Ln = L;
        if (!more_pass) { passn = 0; Ln = more_item ? L + stride : L; }
        const BlockRef nxt = last ? cur : make_ref(T, Ln, passn);
        attn_block(cur, nxt, lds, S, tid0, T.ctab, T.stab);
        if (last) break;
        cur = nxt; pass = passn; L = Ln;
    }
}
#undef ROWK
#undef VMW
#undef VMWN
#undef SLOAD_H
#undef SWRITE_HK
#undef SWRITE_HV
#undef SWRITE_H
#undef SBAR
}
namespace xb {
#define LAS __attribute__((address_space(3)))
#define XB_TMO      128
#define XB_XCNT(j)  (256  + 64 * (j))
#define XB_XSUB(j)  (1280 + 64 * (j))
#define XB_XGEN(j)  (2304 + 64 * (j))
#define XB_TOP      3328
#define XB_TOPGEN   3392
#define XCD_BAR_WORDS 3456
#define XB_SPIN_CAP (1u << 18)

__device__ __forceinline__ unsigned xb_ld(unsigned* p)              { return __hip_atomic_load(p, __ATOMIC_RELAXED, __HIP_MEMORY_SCOPE_AGENT); }
__device__ __forceinline__ unsigned xb_add(unsigned* p, unsigned v) { return __hip_atomic_fetch_add(p, v, __ATOMIC_RELAXED, __HIP_MEMORY_SCOPE_AGENT); }
__device__ __forceinline__ unsigned xb_xcc_id() { return (unsigned)__builtin_amdgcn_s_getreg((3 << 11) | 20) & 0xFu; }
#define XB_SPIN(cond, bar) do { unsigned _sp = 0; while (cond) { __builtin_amdgcn_s_sleep(1); \
    if ((++_sp & 255u) == 0u) { if (xb_ld(&(bar)[XB_TMO])) break; if (_sp > XB_SPIN_CAP) { atomicAdd(&(bar)[XB_TMO], 1u); break; } } } } while (0)

struct XcdBarrier {
    unsigned* bar; unsigned x;
    volatile LAS unsigned* st;
};

__device__ __forceinline__ XcdBarrier xcd_barrier_post(unsigned* bar, volatile LAS unsigned* st) {
    XcdBarrier b; b.bar = bar; b.x = xb_xcc_id(); b.st = st;
    if (threadIdx.x == 0) (void)xb_add(&bar[XB_XCNT(b.x)], 1u);
    return b;
}
__device__ __forceinline__ void xcd_barrier_complete(unsigned* bar, unsigned x, unsigned& nloc, unsigned& nx) {
    const unsigned G = gridDim.x * gridDim.y * gridDim.z;
    unsigned sum, cnt, mine, sp = 0u;
    for (;;) {
        sum = 0u; cnt = 0u; mine = 0u;
#pragma unroll
        for (unsigned j = 0; j < 16; ++j) { const unsigned c = xb_ld(&bar[XB_XCNT(j)]); sum += c; cnt += (c > 0u) ? 1u : 0u; mine = (j == x) ? c : mine; }
        if (sum == G) break;
        __builtin_amdgcn_s_sleep(1);
        if ((++sp & 255u) == 0u) { if (xb_ld(&bar[XB_TMO])) break; if (sp > XB_SPIN_CAP) { atomicAdd(&bar[XB_TMO], 1u); break; } }
    }
    nloc = mine > 0u ? mine : 1u; nx = cnt > 0u ? cnt : 1u;
}

__device__ __forceinline__ void xcd_barrier(const XcdBarrier& b, bool t0  ) {
    asm volatile("s_waitcnt vmcnt(0)" ::: "memory");
    __syncthreads();
    if (t0) {
        unsigned* bar = b.bar;
        __builtin_amdgcn_s_waitcnt(0);
        unsigned nloc = b.st[0], nx = b.st[1];
        if (nloc == 0u) { xcd_barrier_complete(bar, b.x, nloc, nx); b.st[0] = nloc; b.st[1] = nx; }
        const unsigned old = xb_add(&bar[XB_XSUB(b.x)], 1u);
        const unsigned gen = old / nloc;
        if (old + 1u == (gen + 1u) * nloc) {
            __builtin_amdgcn_fence(__ATOMIC_RELEASE, "agent");
            asm volatile("s_waitcnt vmcnt(0)" ::: "memory");
            const unsigned og = xb_add(&bar[XB_TOP], 1u);
            const unsigned tg = og / nx;
            if (og + 1u == (tg + 1u) * nx) xb_add(&bar[XB_TOPGEN], 1u);
            else XB_SPIN(xb_ld(&bar[XB_TOPGEN]) == tg, bar);
            __builtin_amdgcn_fence(__ATOMIC_ACQUIRE, "agent");
            xb_add(&bar[XB_XGEN(b.x)], 1u);
            asm volatile("s_waitcnt vmcnt(0)" ::: "memory");
        } else {
            XB_SPIN(xb_ld(&bar[XB_XGEN(b.x)]) == gen, bar);
            __builtin_amdgcn_fence(__ATOMIC_ACQUIRE, "agent");
            asm volatile("s_waitcnt vmcnt(0)" ::: "memory");
        }
    }
    __syncthreads();
}
#undef LAS
}
#ifndef PROBE_ATT_REPS
#define PROBE_ATT_REPS 1
#endif
#ifndef PROBE_SYNC_REPS
#define PROBE_SYNC_REPS 1
#endif
#ifndef PROBE_THIN_REPS
#define PROBE_THIN_REPS 1
#endif
#ifndef PROBE_PRO_REPS
#define PROBE_PRO_REPS 1
#endif
#ifndef PROBE_GEMM_REPS
#define PROBE_GEMM_REPS 1
#endif
namespace mk {
typedef unsigned short u16;
typedef float f32x4 __attribute__((ext_vector_type(4)));
constexpr int M = 32768, D = 1024, SEQ = 16384;
constexpr float EPS = 1e-6f;
constexpr size_t MB = (size_t)1 << 20;
__host__ __device__ constexpr size_t WT_MLA(int j) { return (size_t)j * 6 * MB; }
__host__ __device__ constexpr size_t WT_LRU(int j) { return 12 * MB + (size_t)j * 8 * MB; }
__host__ __device__ constexpr size_t WT_FFN(int l) { return 28 * MB + (size_t)l * 16 * MB; }
constexpr size_t OFF_UQ = 3 * MB / 2, OFF_UKV = 11 * MB / 4, OFF_WO = 15 * MB / 4, OFF_GT = 4 * MB, OFF_LOUT = 5 * MB, OFF_DOWN = 8 * MB;
constexpr size_t WS_COS = 96 * MB, WS_SIN = 100 * MB, WS_SA = 104 * MB, WS_SB = 105 * MB;
constexpr size_t WS_HN = 112 * MB, WS_Y = 176 * MB, WS_U = 240 * MB, WS_END = 496 * MB;
constexpr size_t U_PROJ = 64 * MB, U_CQ = 112 * MB, U_CKV = 136 * MB, U_KR = 152 * MB, U_Q = 160 * MB, U_O = 64 * MB;
constexpr size_t U_GATE = 0, U_XC = 64 * MB, U_REC = 128 * MB, U_LA = 128 * MB, U_B = 192 * MB;
constexpr size_t WS_XSA = 108 * MB, WS_XSB = 109 * MB;
constexpr size_t WS_RS = 108 * MB;
constexpr int SCAN_L = 128, SCAN_NC = SEQ / SCAN_L;

__device__ __forceinline__ unsigned f2bf(float f) { unsigned u = __float_as_uint(f); return (u + 0x7fffu + ((u >> 16) & 1u)) >> 16; }
__device__ __forceinline__ unsigned pk2(float lo, float hi) { return f2bf(lo) | (f2bf(hi) << 16); }
__device__ __forceinline__ float bflo(unsigned w) { return __uint_as_float(w << 16); }
__device__ __forceinline__ float bfhi(unsigned w) { return __uint_as_float(w & 0xffff0000u); }
__device__ __forceinline__ float bf1(u16 h) { return __uint_as_float(((unsigned)h) << 16); }
__device__ __forceinline__ float wave_sum(float v) {
    v += xor1f(v); v += xor2f(v); v += xor4f(v); v += xor8f(v); v += xor16f(v);
    return sum32f(v);
}
__device__ __forceinline__ void transpose_item(const float* W, int ldw, u16* WT, int ldt, int nblk, float* scr, int item, int lane) {
    const int kb = item / nblk, nb = item % nblk, k0 = 64 * kb, n0 = 32 * nb;
#pragma unroll
    for (int i = 0; i < 8; ++i) { const int kk = 8 * i + (lane >> 3); const f32x4 v = *(const f32x4*)(W + (size_t)(k0 + kk) * ldw + n0 + (lane & 7) * 4);
        float* s = scr + kk * 33 + (lane & 7) * 4; s[0] = v.x; s[1] = v.y; s[2] = v.z; s[3] = v.w; }
    asm volatile("s_waitcnt lgkmcnt(0)" ::: "memory");
    const int c = lane & 7;
#pragma unroll
    for (int j = 0; j < 4; ++j) { const int n = (lane >> 3) + 8 * j; const float* s = scr + (8 * c) * 33 + n;
        uint4 o; o.x = pk2(s[0 * 33], s[1 * 33]); o.y = pk2(s[2 * 33], s[3 * 33]); o.z = pk2(s[4 * 33], s[5 * 33]); o.w = pk2(s[6 * 33], s[7 * 33]);
        *(uint4*)(WT + (size_t)(n0 + n) * ldt + k0 + 8 * c) = o; }
    asm volatile("s_waitcnt lgkmcnt(0)" ::: "memory");
}
struct Params { const float* in[23]; float* out; unsigned char* ws; };
enum { I_X = 0, I_POS, I_MIXPRE, I_MIXPOST, I_FFNPRE, I_FFNPOST, I_MLA_WIN, I_MLA_QN, I_MLA_KVN, I_MLA_WUQ, I_MLA_WUKV, I_MLA_WO,
       I_LRU_WIN, I_LRU_CW, I_LRU_CB, I_LRU_WA, I_LRU_BA, I_LRU_WX, I_LRU_BX, I_LRU_LAM, I_LRU_WOUT, I_FFN_UP, I_FFN_DOWN };

__device__ __forceinline__ void prologue_weights(const __attribute__((address_space(4))) Params& p, float* scr, int gw, int NGW, int lane) {
    u16* wt = (u16*)p.ws;
    constexpr int IT_MLA = 352 + 288 + 256 + 512, IT_LRU = 1024 + 128 + 512, IT_FFN = 4096, TOTAL = 2 * IT_MLA + 2 * IT_LRU + 4 * IT_FFN;
    for (int it = gw; it < TOTAL; it += NGW) {
        int r = it; const float* W; int ldw, ldt, nblk; u16* WT;
        if (r < 2 * IT_MLA) { const int j = r / IT_MLA; r -= j * IT_MLA; u16* base = wt + WT_MLA(j) / 2;
            if (r < 352) { W = p.in[I_MLA_WIN] + (size_t)j * 1024 * 704; ldw = 704; nblk = 22; WT = base; ldt = 1024; }
            else if (r < 640) { r -= 352; W = p.in[I_MLA_WUQ] + (size_t)j * 384 * 1536; ldw = 1536; nblk = 48; WT = base + OFF_UQ / 2; ldt = 384; }
            else if (r < 896) { r -= 640; W = p.in[I_MLA_WUKV] + (size_t)j * 256 * 2048; ldw = 2048; nblk = 64; WT = base + OFF_UKV / 2; ldt = 256; }
            else { r -= 896; W = p.in[I_MLA_WO] + (size_t)j * 1024 * 1024; ldw = 1024; nblk = 32; WT = base + OFF_WO / 2; ldt = 1024; }
        } else if (r < 2 * IT_MLA + 2 * IT_LRU) { r -= 2 * IT_MLA; const int j = r / IT_LRU; r -= j * IT_LRU; u16* base = wt + WT_LRU(j) / 2;
            if (r < 1024) { W = p.in[I_LRU_WIN] + (size_t)j * 1024 * 2048; ldw = 2048; nblk = 64; WT = base; ldt = 1024; }
            else if (r < 1152) { r -= 1024; const int which = r >> 3, gt = which >> 3, n = which & 7; r &= 7;
                W = p.in[gt ? I_LRU_WX : I_LRU_WA] + (size_t)j * 8 * 128 * 128 + (size_t)n * 128 * 128; ldw = 128; nblk = 4;
                WT = base + OFF_GT / 2 + (size_t)(n * 256 + gt * 128) * 256 + 128 * (n & 1); ldt = 256; }
            else { r -= 1152; W = p.in[I_LRU_WOUT] + (size_t)j * 1024 * 1024; ldw = 1024; nblk = 32; WT = base + OFF_LOUT / 2; ldt = 1024; }
        } else { r -= 2 * IT_MLA + 2 * IT_LRU; const int l = r / IT_FFN; r -= l * IT_FFN; u16* base = wt + WT_FFN(l) / 2;
            if (r < 2048) { W = p.in[I_FFN_UP] + (size_t)l * 1024 * 4096; ldw = 4096; nblk = 128; WT = base; ldt = 1024; }
            else { r -= 2048; W = p.in[I_FFN_DOWN] + (size_t)l * 4096 * 1024; ldw = 1024; nblk = 32; WT = base + OFF_DOWN / 2; ldt = 4096; }
        }
        transpose_item(W, ldw, WT, ldt, nblk, scr, r, lane);
    }
}
__device__ __forceinline__ void rowop(const u16* y, const float* xin, float* xout, u16* hn, float* rs, const float* gpost, const float* gpre, int gw, int NGW, int lane) {
    f32x4 gp[4], gq[4];
#pragma unroll
    for (int j = 0; j < 4; ++j) { gp[j] = gpost ? *(const f32x4*)(gpost + j * 256 + lane * 4) : (f32x4){0.f, 0.f, 0.f, 0.f}; gq[j] = gpre ? *(const f32x4*)(gpre + j * 256 + lane * 4) : (f32x4){0.f, 0.f, 0.f, 0.f}; }
    for (int row = gw; row < M; row += NGW) {
        f32x4 xv[4];
#pragma unroll
        for (int j = 0; j < 4; ++j) xv[j] = *(const f32x4*)(xin + (size_t)row * D + j * 256 + lane * 4);
        if (y) {
            f32x4 yv[4]; float ss = 0.f;
#pragma unroll
            for (int j = 0; j < 4; ++j) { const uint2 w = *(const uint2*)(y + (size_t)row * D + j * 256 + lane * 4);
                yv[j] = (f32x4){bflo(w.x), bfhi(w.x), bflo(w.y), bfhi(w.y)}; ss += (yv[j].x * yv[j].x + yv[j].y * yv[j].y) + (yv[j].z * yv[j].z + yv[j].w * yv[j].w); }
            const float r = rsqrtf(wave_sum(ss) * (1.f / D) + EPS);
#pragma unroll
            for (int j = 0; j < 4; ++j) xv[j] = xv[j] + (yv[j] * r) * gp[j];
        }
        if (xout) {
#pragma unroll
        for (int j = 0; j < 4; ++j) *(f32x4*)(xout + (size_t)row * D + j * 256 + lane * 4) = xv[j]; }
        if (gpre) {
            float s2 = 0.f;
#pragma unroll
            for (int j = 0; j < 4; ++j) s2 += (xv[j].x * xv[j].x + xv[j].y * xv[j].y) + (xv[j].z * xv[j].z + xv[j].w * xv[j].w);
            const float tot2 = wave_sum(s2); const float r2 = 1.0f;
            if (rs && lane < 4) rs[(size_t)row * 4 + lane] = lane == 0 ? tot2 : 0.f;
#pragma unroll
            for (int j = 0; j < 4; ++j) { const f32x4 h = (xv[j] * r2) * gq[j]; uint2 w; w.x = pk2(h.x, h.y); w.y = pk2(h.z, h.w);
                *(uint2*)(hn + (size_t)row * D + j * 256 + lane * 4) = w; }
        }
    }
}
__device__ __forceinline__ void qkvnorm(const u16* proj, u16* cq, u16* ckv, u16* kr, const float* qn, const float* kvn, const float* ctab, const float* stab, const float* rss, int gw, int NGW, int lane) {
    float gq[6], gk[4];
#pragma unroll
    for (int j = 0; j < 6; ++j) gq[j] = qn[lane + 64 * j];
#pragma unroll
    for (int j = 0; j < 4; ++j) gk[j] = kvn[lane + 64 * j];
    for (int row = gw; row < M; row += NGW) {
        const u16* pr = proj + (size_t)row * 768;
        const f32x4 pp = *(const f32x4*)(rss + (size_t)row * 4); const float rsc = rsqrtf(((pp[0] + pp[1]) + (pp[2] + pp[3])) * (1.f / D) + EPS);
        float a[6], b[4], s1 = 0.f, s2 = 0.f;
#pragma unroll
        for (int j = 0; j < 6; ++j) { a[j] = bf1(pr[lane + 64 * j]) * rsc; s1 += a[j] * a[j]; }
#pragma unroll
        for (int j = 0; j < 4; ++j) { b[j] = bf1(pr[384 + lane + 64 * j]) * rsc; s2 += b[j] * b[j]; }
        const float x1 = bf1(pr[640 + (lane & 31)]) * rsc, x2 = bf1(pr[672 + (lane & 31)]) * rsc;
        const float r1 = rsqrtf(wave_sum(s1) * (1.f / 384.f) + EPS), r2 = rsqrtf(wave_sum(s2) * (1.f / 256.f) + EPS);
#pragma unroll
        for (int j = 0; j < 6; ++j) cq[(size_t)row * 384 + lane + 64 * j] = (u16)f2bf(a[j] * r1 * gq[j]);
#pragma unroll
        for (int j = 0; j < 4; ++j) ckv[(size_t)row * 256 + lane + 64 * j] = (u16)f2bf(b[j] * r2 * gk[j]);
        const float c = ctab[(size_t)row * 32 + (lane & 31)], s = stab[(size_t)row * 32 + (lane & 31)];
        kr[(size_t)row * 64 + lane] = (u16)f2bf(lane < 32 ? x1 * c - x2 * s : x2 * c + x1 * s);
    }
}
__device__ __forceinline__ void qrope(u16* q, const float* ctab, const float* stab, int gw, int NGW, int lane) {
    for (int row = gw; row < M; row += NGW) {
        u16* qr = q + (size_t)row * 1536; const int i = lane & 31;
        const float c = ctab[(size_t)row * 32 + i], s = stab[(size_t)row * 32 + i];
#pragma unroll
        for (int j = 0; j < 4; ++j) { const int h = 2 * j + (lane >> 5); u16* pp = qr + h * 192 + 128 + i;
            const float x1 = bf1(pp[0]), x2 = bf1(pp[32]);
            pp[0] = (u16)f2bf(x1 * c - x2 * s); pp[32] = (u16)f2bf(x2 * c + x1 * s); }
    }
}
__device__ __forceinline__ void conv_phase(const u16* rec, u16* xc, const float* cw, const float* cb, int gtid, int NGT) {
    for (int idx = gtid; idx < M * 128; idx += NGT) {
        const int row = idx >> 7, c0 = (idx & 127) * 8, s = row & (SEQ - 1);
        float acc[8];
#pragma unroll
        for (int e = 0; e < 8; ++e) acc[e] = cb[c0 + e];
#pragma unroll
        for (int k = 0; k < 4; ++k) { if (s - 3 + k >= 0) {
            const uint4 w = *(const uint4*)(rec + (size_t)(row - 3 + k) * D + c0);
            const float v[8] = {bflo(w.x), bfhi(w.x), bflo(w.y), bfhi(w.y), bflo(w.z), bfhi(w.z), bflo(w.w), bfhi(w.w)};
#pragma unroll
            for (int e = 0; e < 8; ++e) acc[e] += v[e] * cw[k * D + c0 + e]; } }
        uint4 o; o.x = pk2(acc[0], acc[1]); o.y = pk2(acc[2], acc[3]); o.z = pk2(acc[4], acc[5]); o.w = pk2(acc[6], acc[7]);
        *(uint4*)(xc + (size_t)row * D + c0) = o;
    }
}
__device__ __forceinline__ void scanA(const u16* A, const u16* B, float* SA, float* SB, int tid) {
    for (int item = blockIdx.x; item < 2 * SCAN_NC * 2; item += gridDim.x) {
        const int half = item & 1, c = (item >> 1) % SCAN_NC, b = item / (2 * SCAN_NC), ch = half * 512 + tid;
        const size_t base = ((size_t)b * SEQ + (size_t)c * SCAN_L) * D + ch;
        float h = 0.f, P = 1.f;
        for (int t0 = 0; t0 < SCAN_L; t0 += 16) {
            u16 aw[16], bw[16];
#pragma unroll
            for (int u = 0; u < 16; ++u) { aw[u] = A[base + (size_t)(t0 + u) * D]; bw[u] = B[base + (size_t)(t0 + u) * D]; }
#pragma unroll
            for (int u = 0; u < 16; ++u) { const float a = __expf(bf1(aw[u])); h = a * h + bf1(bw[u]); P *= a; }
        }
        SA[((size_t)b * SCAN_NC + c) * D + ch] = P; SB[((size_t)b * SCAN_NC + c) * D + ch] = h;
    }
}
__device__ __forceinline__ void scanC(const u16* A, const u16* B, const float* SA, const float* SB, const u16* gate, u16* hg, int tid) {
    for (int item = blockIdx.x; item < 2 * SCAN_NC * 2; item += gridDim.x) {
        const int half = item & 1, c = (item >> 1) % SCAN_NC, b = item / (2 * SCAN_NC), ch = half * 512 + tid;
        const size_t base = ((size_t)b * SEQ + (size_t)c * SCAN_L) * D + ch;
        float h = 0.f;
        for (int cc = 0; cc < c; ++cc) { const size_t so = ((size_t)b * SCAN_NC + cc) * D + ch; h = SA[so] * h + SB[so]; }
        for (int t0 = 0; t0 < SCAN_L; t0 += 16) {
            u16 aw[16], bw[16], gv[16];
#pragma unroll
            for (int u = 0; u < 16; ++u) { aw[u] = A[base + (size_t)(t0 + u) * D]; bw[u] = B[base + (size_t)(t0 + u) * D]; gv[u] = gate[base + (size_t)(t0 + u) * D]; }
#pragma unroll
            for (int u = 0; u < 16; ++u) { h = __expf(bf1(aw[u])) * h + bf1(bw[u]); hg[base + (size_t)(t0 + u) * D] = (u16)f2bf(bf1(gv[u]) * h); }
        }
    }
}

constexpr int LDS_GEMM = pg8::STAGE_BYTES + 8192, LDS_MAIN = att::LDS_BYTES > LDS_GEMM ? att::LDS_BYTES : LDS_GEMM, LDS_BYTES = LDS_MAIN + 16;
constexpr size_t WS_BAR = 106 * MB;
constexpr size_t WS_CNT1 = WS_BAR + 16384, WS_CNT2 = WS_BAR + 49152, CTL_BYTES = 81920, WS_XS1 = 107 * MB, WS_XS2 = 107 * MB + MB / 2;
constexpr int XL_OFF = 131072;
static_assert(XL_OFF + 8192 <= LDS_MAIN && XCD_BAR_WORDS * 4 <= 16384 && att::LDS_BYTES <= LDS_MAIN && pg8::STAGE_BYTES <= LDS_MAIN && LDS_BYTES <= 160 * 1024, "LDS map");

__global__ void __launch_bounds__(512, 2) fwd_mega(Params p_arg) {
    extern __shared__ __attribute__((aligned(16))) unsigned char lds[];
    cg::grid_group grid = cg::this_grid();
    (void)p_arg;
    volatile __attribute__((address_space(3))) unsigned* bst = (volatile __attribute__((address_space(3))) unsigned*)((__attribute__((address_space(3))) unsigned char*)lds + LDS_MAIN);
    if (threadIdx.x < 4) bst[threadIdx.x] = 0u;
    __syncthreads();
    const int wave_s = __builtin_amdgcn_readfirstlane(threadIdx.x >> 6);
    const unsigned bar_x = xb::xb_xcc_id();
    (void)xb::xcd_barrier_post((unsigned*)(p_arg.ws + WS_BAR), bst);
#define GRID_BAR() do { unsigned bx_ = bar_x; asm volatile("" : "+s"(bx_)); xb::XcdBarrier bb_; bb_.bar = (unsigned*)(ws + WS_BAR); bb_.x = bx_; bb_.st = bst; xb::xcd_barrier(bb_, tid == 0); } while (0)
    typedef const __attribute__((address_space(4))) Params* KParams;
    KParams pp = (KParams)__builtin_amdgcn_kernarg_segment_ptr();
#define FRESH() int tid_ = wave_s * 64 + lane_id_fresh(); asm volatile("" : "+v"(tid_)); asm volatile("" : "+s"(pp)); const __attribute__((address_space(4))) Params& p = *pp; \
    const int tid = tid_, lane = tid & 63, wave = __builtin_amdgcn_readfirstlane(tid >> 6); \
    const int G = gridDim.x, gw = blockIdx.x * 8 + wave, NGW = G * 8, gtid = blockIdx.x * 512 + tid, NGT = G * 512; \
    unsigned char* ws = p.ws; float* x = p.out; u16* hn = (u16*)(ws + WS_HN); u16* ybuf = (u16*)(ws + WS_Y); unsigned char* U = ws + WS_U; \
    float* ctab = (float*)(ws + WS_COS); float* stab = (float*)(ws + WS_SIN); float* SA = (float*)(ws + WS_SA); float* SB = (float*)(ws + WS_SB); \
    (void)lane; (void)wave; (void)gw; (void)NGW; (void)gtid; (void)NGT; (void)x; (void)hn; (void)ybuf; (void)U; (void)ctab; (void)stab; (void)SA; (void)SB;
    {
    FRESH();

    for (int prep = 0; prep < PROBE_PRO_REPS; ++prep) {
    prologue_weights(p, (float*)lds + wave * (64 * 33), gw, NGW, lane);
    for (int i = gtid; i < 2 * 2048 * 16; i += NGT) { const int j = i >> 15, row = (i >> 4) & 2047, chn = i & 15, n = row >> 8;
        *(uint4*)((u16*)(ws + WT_LRU(j) + OFF_GT) + (size_t)row * 256 + 128 * ((n & 1) ^ 1) + chn * 8) = make_uint4(0u, 0u, 0u, 0u); }
    { const int* pos = (const int*)p.in[I_POS];
      for (int i = gtid; i < M * 32; i += NGT) { const int row = i >> 5, f = i & 31;
        const float inv = __builtin_amdgcn_exp2f(-(float)f * (13.287712379549449f / 32.f));
        const float ang = (float)pos[row] * inv;
        double rev = (double)ang * 0.15915494309189535; rev -= __builtin_rint(rev);
        ctab[i] = __builtin_amdgcn_cosf((float)rev); stab[i] = __builtin_amdgcn_sinf((float)rev); } }
    rowop(nullptr, p.in[I_X], nullptr, hn, (float*)(ws + WS_XSB), nullptr, p.in[I_MIXPRE], gw, NGW, lane);
    }
    if (ws == nullptr) grid.sync();
    GRID_BAR();
    }

#pragma nounroll
    for (int layer = 0; layer < 4; ++layer) {
#pragma nounroll
        for (int op = 0; op < 10; ++op) {
            FRESH();
            const int j = layer >> 1; const bool lru = (layer & 1) != 0;
            const u16* wtm = (const u16*)(ws + WT_MLA(j)); const u16* wtl = (const u16*)(ws + WT_LRU(j)); const u16* wtf = (const u16*)(ws + WT_FFN(layer));
            int gk = 0;
            pg8::Gemm g{}; pg8::EpiB E{};
            if (op == 6 || op == 9) continue;
            const float* gprev = p.in[op == 5 ? I_MIXPRE : I_FFNPRE] + layer * D;
            const float* gpost = p.in[op == 5 ? I_MIXPOST : I_FFNPOST] + layer * D;
            const float* gpre = op == 5 ? p.in[I_FFNPRE] + layer * D : (layer < 3 ? p.in[I_MIXPRE] + (layer + 1) * D : nullptr);
            if (op == 7) { gk = 1; g = pg8::Gemm{hn, wtf, M, 4096, 1024, 1024, 1024, 0}; E = pg8::EpiB{(u16*)U, 4096, 0, 0, 1, nullptr}; }
            else if (op == 8) { gk = 3; g = pg8::Gemm{(const u16*)U, wtf + OFF_DOWN / 2, M, 1024, 4096, 4096, 4096, 0}; }
            else if (!lru) {
                u16* proj = (u16*)(U + U_PROJ); u16* cq = (u16*)(U + U_CQ); u16* ckv = (u16*)(U + U_CKV); u16* kr = (u16*)(U + U_KR); u16* q = (u16*)(U + U_Q); u16* o = (u16*)(U + U_O); u16* kv = ybuf;
                if (op == 0) { gk = 1; g = pg8::Gemm{hn, wtm, M, 768, 1024, 1024, 1024, 0}; E = pg8::EpiB{proj, 768, 0, 0, 0, nullptr}; }
                else if (op == 1) for (int rep = 0; rep < PROBE_THIN_REPS; ++rep) qkvnorm(proj, cq, ckv, kr, p.in[I_MLA_QN] + j * 384, p.in[I_MLA_KVN] + j * 256, ctab, stab, (const float*)(ws + WS_XSB), gw, NGW, lane);
                else if (op == 2) { gk = 1; g = pg8::Gemm{cq, wtm + OFF_UQ / 2, M, 1536, 384, 384, 384, 0}; E = pg8::EpiB{q, 1536, 0, 0, 0, nullptr}; }
                else if (op == 3) { gk = 1; g = pg8::Gemm{ckv, wtm + OFF_UKV / 2, M, 2048, 256, 256, 256, 0}; E = pg8::EpiB{kv, 2048, 0, 0, 0, nullptr}; }
                else if (op == 4) { const att::Tensors T{q, kv, kr, o, ctab, stab}; for (int rep = 0; rep < PROBE_ATT_REPS; ++rep) att::attn_phase((char*)lds, T, tid); }
                else { gk = 3; g = pg8::Gemm{o, wtm + OFF_WO / 2, M, 1024, 1024, 1024, 1024, 0}; }
            } else {
                u16* gate = (u16*)(U + U_GATE); u16* xc = (u16*)(U + U_XC); u16* rec = (u16*)(U + U_REC); u16* Bb = (u16*)(U + U_B); u16* Ab = (u16*)(U + U_LA); u16* hg = xc;
                if (op == 0) { gk = 1; g = pg8::Gemm{hn, wtl, M, 2048, 1024, 1024, 1024, 0}; E = pg8::EpiB{gate, 1024, 1024, (size_t)(U_REC - U_GATE) / 2, 2, (const float*)(ws + WS_XSB)}; }
                else if (op == 1) for (int rep = 0; rep < PROBE_THIN_REPS; ++rep) conv_phase(rec, xc, p.in[I_LRU_CW] + j * 4 * D, p.in[I_LRU_CB] + j * D, gtid, NGT);
                else if (op == 2) { gk = 2; g = pg8::Gemm{xc, wtl + OFF_GT / 2, M, 2048, 256, 1024, 256, 512}; }
                else if (op == 3) for (int rep = 0; rep < PROBE_THIN_REPS; ++rep) scanA(Ab, Bb, SA, SB, tid);
                else if (op == 4) for (int rep = 0; rep < PROBE_THIN_REPS; ++rep) scanC(Ab, Bb, SA, SB, gate, hg, tid);
                else { gk = 3; g = pg8::Gemm{hg, wtl + OFF_LOUT / 2, M, 1024, 1024, 1024, 1024, 0}; }
            }
            for (int rep = 0; rep < PROBE_GEMM_REPS; ++rep)
            if (gk == 1) { pg8::StaticOrder S; S.init(g.M, g.N, G, (int)blockIdx.x);
                pg8::gemm_phase<pg8::EpiB, pg8::StaticOrder, true>((PG8_LAS unsigned char*)lds, g, S, E, tid); }
            else if (gk == 2) { pg8::StaticOrder S; S.init(g.M, g.N, G, (int)blockIdx.x);
                const pg8::EpiGate EG{(const u16*)(U + U_XC), (u16*)(U + U_LA), (u16*)(U + U_B), p.in[I_LRU_BA] + j * D, p.in[I_LRU_BX] + j * D, p.in[I_LRU_LAM] + j * D};
                pg8::gemm_phase<pg8::EpiGate, pg8::StaticOrder, true>((PG8_LAS unsigned char*)lds, g, S, EG, tid); }
            else if (gk == 3) { pg8::StaticOrder S; S.init(g.M, g.N, G, (int)blockIdx.x);
                const unsigned target = 32u * (unsigned)(layer * 2 + (op == 8 ? 2 : 1));
                const pg8::RowStats st1{(float*)(ws + WS_XS1), (unsigned*)(ws + WS_CNT1), target};
                const pg8::EpiNormRes EN{hn, (float*)(ws + (op == 8 ? WS_XSB : WS_XSA)), x, gprev, gpost, gpre, st1, (PG8_LAS unsigned char*)lds + XL_OFF, op == 8 ? (const float*)(ws + WS_XSA) : nullptr};
                pg8::gemm_phase<pg8::EpiNormRes, pg8::StaticOrder, true>((PG8_LAS unsigned char*)lds, g, S, EN, tid); }
            if (!(layer == 3 && op == 8) && !(!lru && op == 2)) { for (int rep = 0; rep < PROBE_SYNC_REPS; ++rep) GRID_BAR(); }
        }
    }
}
}

extern "C" void kernel_launch(void* const* d_in, const int* in_sizes, int n_in, void* d_out, int out_size, void* d_ws, size_t ws_size, hipStream_t stream) {
    static int grid = 0;
    if (grid == 0) {
        if (n_in != 23 || in_sizes[0] != mk::M * mk::D || out_size != mk::M * mk::D || ws_size < mk::WS_END) {
            fprintf(stderr, "kernel_launch: unexpected shapes (n_in %d, in0 %d, out %d, ws %zu); nothing launched\n", n_in, n_in > 0 ? in_sizes[0] : -1, out_size, ws_size); grid = -1; return; }
        int dev = 0, cus = 0, per_cu = 0;
        (void)hipGetDevice(&dev); (void)hipDeviceGetAttribute(&cus, hipDeviceAttributeMultiprocessorCount, dev);
        if (hipFuncSetAttribute((const void*)mk::fwd_mega, hipFuncAttributeMaxDynamicSharedMemorySize, mk::LDS_BYTES) != hipSuccess) { fprintf(stderr, "kernel_launch: hipFuncSetAttribute failed\n"); grid = -1; return; }
        if (hipOccupancyMaxActiveBlocksPerMultiprocessor(&per_cu, (const void*)mk::fwd_mega, 512, mk::LDS_BYTES) != hipSuccess || per_cu < 1) { fprintf(stderr, "kernel_launch: occupancy query says %d blocks per CU\n", per_cu); per_cu = 1; }
        (void)hipGetLastError();
        grid = cus > 0 ? cus : 256;
    }
    if (grid < 0) return;
    mk::Params p{};
    for (int i = 0; i < 23; ++i) p.in[i] = (const float*)d_in[i];
    p.out = (float*)d_out; p.ws = (unsigned char*)d_ws;
    if (hipMemsetAsync((char*)d_ws + mk::WS_BAR, 0, mk::CTL_BYTES, stream) != hipSuccess) { fprintf(stderr, "kernel_launch: hipMemsetAsync failed\n"); return; }
    void* args[] = {&p};
    hipError_t e = hipLaunchCooperativeKernel((const void*)mk::fwd_mega, dim3(grid), dim3(512), args, mk::LDS_BYTES, stream);
    if (e != hipSuccess) fprintf(stderr, "kernel_launch: cooperative launch failed: %s (grid %d)\n", hipGetErrorString(e), grid);
}
```

```cpp
#include <hip/hip_runtime.h>
#include <hip/hip_bf16.h>
#include <hip/hip_cooperative_groups.h>
#include <cstdio>
#include <cstdint>
namespace cg = cooperative_groups;

__device__ __forceinline__ float xor1f(float v)  { return __int_as_float(__builtin_amdgcn_mov_dpp(__float_as_int(v), 0xB1, 0xF, 0xF, false)); }
__device__ __forceinline__ float xor2f(float v)  { return __int_as_float(__builtin_amdgcn_mov_dpp(__float_as_int(v), 0x4E, 0xF, 0xF, false)); }
__device__ __forceinline__ float xor4f(float v)  { return __int_as_float(__builtin_amdgcn_ds_swizzle(__float_as_int(v), 0x101F)); }
__device__ __forceinline__ float xor8f(float v)  { return __int_as_float(__builtin_amdgcn_ds_swizzle(__float_as_int(v), 0x201F)); }
__device__ __forceinline__ float xor16f(float v) { return __int_as_float(__builtin_amdgcn_ds_swizzle(__float_as_int(v), 0x401F)); }
__device__ __forceinline__ float sum32f(float v) { auto rr = __builtin_amdgcn_permlane32_swap(__float_as_uint(v), __float_as_uint(v), false, false); return __uint_as_float(rr[0]) + __uint_as_float(rr[1]); }
__device__ __forceinline__ int lane_id_fresh() { int l; asm volatile("v_mbcnt_lo_u32_b32 %0, -1, 0\n\tv_mbcnt_hi_u32_b32 %0, -1, %0" : "=v"(l)); return l; }
namespace pg8 {
#define PG8_LAS __attribute__((address_space(3)))
typedef unsigned short bf16_t;
typedef short bf16x8 __attribute__((ext_vector_type(8)));
typedef float f32x4 __attribute__((ext_vector_type(4)));
typedef unsigned u32x4 __attribute__((ext_vector_type(4)));
constexpr int BM = 256, BK = 64, HALF = 128, HTB = HALF * BK * 2  , STAGE_BYTES = 8 * HTB, NXCD = 8, WGM = 8;

__host__ __device__ __forceinline__ int lds_byte(int r, int c) { const int st = (r >> 4) * 2 + (c >> 5), rr = r & 15, cc = c & 31, ob = rr * 64 + cc * 2; return st * 1024 + (ob ^ (((ob >> 9) & 1) << 5)); }
__host__ __device__ __forceinline__ void stage_rc(int b, int& R, int& C) { const int st = b / 1024, sb = b % 1024, swz = sb ^ (((sb >> 9) & 1) << 5); R = (st >> 1) * 16 + swz / 64; C = (st & 1) * 32 + (swz % 64) / 2; }
__host__ __device__ __forceinline__ int perm32(int rho) { const int n = rho >> 4, i = rho & 15; return 8 * (i >> 2) + 4 * n + (i & 3); }

struct Unit { int pm, pn; };
struct Gemm { const bf16_t* A; const bf16_t* Bt; int M, N, K; int lda, ldb; int apn; };

struct StaticOrder {
    int nM, nN, nwg, G, c;
    __host__ __device__ void init(int M, int N, int G_, int c_) { nM = M / BM; nN = N / BM; nwg = nM * nN; G = G_; c = c_; }
    __host__ __device__ bool next(int i, Unit& u) const {
        const long L = (long)i * G + c; if (L >= nwg) return false;
        int wgid = (int)L; { const int q = nwg / NXCD, r = nwg % NXCD, xcd = wgid % NXCD, off = wgid / NXCD; wgid = (xcd < r ? xcd * (q + 1) : r * (q + 1) + (xcd - r) * q) + off; }
        const int nig = WGM * nN, gid = wgid / nig, fm = gid * WGM, gsz = (nM - fm) < WGM ? (nM - fm) : WGM;
        u.pm = fm + ((wgid % nig) % gsz); u.pn = (wgid % nig) / gsz; return true;
    }
    __device__ __forceinline__ void a_ready(const Unit&) const {}
    __device__ __forceinline__ void done(const Unit&) const {}
};

__device__ __forceinline__ unsigned cvt_pk_bf16(float lo, float hi) { unsigned r; asm volatile("v_cvt_pk_bf16_f32 %0, %1, %2" : "=v"(r) : "v"(lo), "v"(hi)); return r; }
__device__ __forceinline__ float gelu_tanh(float x) {
    const float z = 0.7978845608028654f * (x + 0.044715f * x * x * x);
    const float e = __expf(2.0f * z);
    const float th = 1.0f - 2.0f * __builtin_amdgcn_rcpf(1.0f + e);
    return 0.5f * x * (1.0f + th);
}
struct EpiB {
    static constexpr bool PERM = true, AFTER_DRAIN = false, FUSED = false;
    bf16_t* O; int ldc; int split_cols; size_t split_stride; int mode;
    const float* rss;
    __device__ __forceinline__ void operator()(const f32x4 (&acc)[2][2][4][2], const Unit& u, int wr, int wc, int fr, int fq) const {
        const int row0 = u.pm * BM + wr * 64 + fr; int colt = u.pn * BM; bf16_t* base = O; int t = 0;
        if (split_cols) { t = colt / split_cols; base += (size_t)t * split_stride; colt -= t * split_cols; }
        const int act = (mode == 1) ? 1 : ((mode == 2 && t == 0) ? 2 : 0);
        const int col0 = colt + wc * 32 + 8 * fq;
#pragma unroll
        for (int ai = 0; ai < 2; ++ai)
#pragma unroll
            for (int m = 0; m < 4; ++m) { bf16_t* rowp = base + (size_t)(row0 + ai * HALF + m * 16) * ldc + col0;
                float rsc = 1.0f; if (rss) { const f32x4 pp = *(const f32x4*)(rss + (size_t)(row0 + ai * HALF + m * 16) * 4); rsc = rsqrtf(((pp[0] + pp[1]) + (pp[2] + pp[3])) * (1.0f / 1024.0f) + 1e-6f); }
#pragma unroll
                for (int bj = 0; bj < 2; ++bj) { f32x4 v0 = acc[ai][bj][m][0] * rsc, v1 = acc[ai][bj][m][1] * rsc;
                    if (act == 1) {
#pragma unroll
                        for (int e = 0; e < 4; ++e) { const float a = fmaxf(v0[e], 0.f), b = fmaxf(v1[e], 0.f); v0[e] = a * a; v1[e] = b * b; } }
                    else if (act == 2) {
#pragma unroll
                        for (int e = 0; e < 4; ++e) { v0[e] = gelu_tanh(v0[e]); v1[e] = gelu_tanh(v1[e]); } }
                    u32x4 w; w.x = cvt_pk_bf16(v0[0], v0[1]); w.y = cvt_pk_bf16(v0[2], v0[3]); w.z = cvt_pk_bf16(v1[0], v1[1]); w.w = cvt_pk_bf16(v1[2], v1[3]);
                    *(u32x4*)(rowp + bj * HALF) = w; } }
    }
};
__device__ __forceinline__ float bf2f(unsigned short h) { return __uint_as_float(((unsigned)h) << 16); }
__device__ __forceinline__ float sigmoidf_(float x) { return __builtin_amdgcn_rcpf(1.0f + __expf(-x)); }
__device__ __forceinline__ float one_minus_exp(float t) { const float ser = -t * (1.0f + t * (0.5f + t * (0.16666667f + t * (0.041666668f + t * 0.008333334f)))); return t > -0.25f ? ser : 1.0f - __expf(t); }
struct EpiGate {
    static constexpr bool PERM = false, AFTER_DRAIN = false, FUSED = false;
    const bf16_t* xc; bf16_t* Aout; bf16_t* Bout; const float* b_a; const float* b_x; const float* lam;
    __device__ __forceinline__ void operator()(const f32x4 (&acc)[2][2][4][2], const Unit& u, int wr, int wc, int fr, int fq) const {
#pragma unroll
        for (int n = 0; n < 2; ++n) {
            const int ch0 = 128 * u.pn + 32 * wc + 16 * n + 4 * fq;
            const f32x4 ba = *(const f32x4*)(b_a + ch0), bx = *(const f32x4*)(b_x + ch0), lm = *(const f32x4*)(lam + ch0);
            f32x4 sp;
#pragma unroll
            for (int e = 0; e < 4; ++e) sp[e] = -8.0f * log1pf(__expf(-lm[e]));
#pragma unroll
            for (int ai = 0; ai < 2; ++ai)
#pragma unroll
                for (int m = 0; m < 4; ++m) {
                    const size_t off = (size_t)(u.pm * BM + ai * HALF + wr * 64 + m * 16 + fr) * 1024 + ch0;
                    const uint2 xr = *(const uint2*)(xc + off);
                    float xv[4] = { __uint_as_float(xr.x << 16), __uint_as_float(xr.x & 0xffff0000u), __uint_as_float(xr.y << 16), __uint_as_float(xr.y & 0xffff0000u) };
                    f32x4 av, bv;
#pragma unroll
                    for (int e = 0; e < 4; ++e) {
                        const float r = sigmoidf_(acc[ai][0][m][n][e] + ba[e]);
                        const float ig = sigmoidf_(acc[ai][1][m][n][e] + bx[e]);
                        const float la = sp[e] * r;
                        av[e] = la;
                        bv[e] = __builtin_amdgcn_sqrtf(fmaxf(one_minus_exp(2.0f * la), 0.f)) * (ig * xv[e]);
                    }
                    uint2 wa, wb; wa.x = cvt_pk_bf16(av[0], av[1]); wa.y = cvt_pk_bf16(av[2], av[3]); wb.x = cvt_pk_bf16(bv[0], bv[1]); wb.y = cvt_pk_bf16(bv[2], bv[3]);
                    *(uint2*)(Aout + off) = wa; *(uint2*)(Bout + off) = wb;
                }
        }
    }
};

struct RowStats {
    float* xbuf;
    unsigned* cnt;
    unsigned target;
    __device__ __forceinline__ void run(const f32x4 (&v)[2][2][4][2], const Unit& u, int wr, int wc, int fr, int fq, PG8_LAS unsigned char* xl, int wid, int lane) const {
        PG8_LAS float* P = (PG8_LAS float*)xl;
        PG8_LAS float* S = (PG8_LAS float*)(xl + 4096);
#pragma unroll
        for (int ai = 0; ai < 2; ++ai)
#pragma unroll
            for (int m = 0; m < 4; ++m) {
                float s = 0.f;
#pragma unroll
                for (int bj = 0; bj < 2; ++bj)
#pragma unroll
                    for (int n = 0; n < 2; ++n) { const f32x4 x = v[ai][bj][m][n]; s += (x[0] * x[0] + x[1] * x[1]) + (x[2] * x[2] + x[3] * x[3]); }
                s += xor16f(s); s = sum32f(s);
                if (fq == 0) P[(ai * HALF + wr * 64 + m * 16 + fr) * 4 + wc] = s;
            }
        asm volatile("s_waitcnt lgkmcnt(0)" ::: "memory"); __builtin_amdgcn_s_barrier(); asm volatile("" ::: "memory");
        const int row = wid * 32 + (lane & 31);
        if (lane < 32) { const float t = (P[row * 4 + 0] + P[row * 4 + 1]) + (P[row * 4 + 2] + P[row * 4 + 3]);
            __hip_atomic_store(xbuf + (size_t)(u.pm * BM + row) * 4 + u.pn, t, __ATOMIC_RELAXED, __HIP_MEMORY_SCOPE_AGENT); }
        asm volatile("s_waitcnt vmcnt(0)" ::: "memory");
        if (lane == 0) __hip_atomic_fetch_add(cnt + 64 * u.pm, 1u, __ATOMIC_RELAXED, __HIP_MEMORY_SCOPE_AGENT);
        if (wid == 0) { unsigned sp = 0;
            while ((unsigned)__builtin_amdgcn_readfirstlane(__hip_atomic_load(cnt + 64 * u.pm, __ATOMIC_RELAXED, __HIP_MEMORY_SCOPE_AGENT)) < target) { __builtin_amdgcn_s_sleep(2); if (++sp > (1u << 18)) break; }
            __builtin_amdgcn_fence(__ATOMIC_ACQUIRE, "agent"); }
        asm volatile("s_waitcnt vmcnt(0) lgkmcnt(0)" ::: "memory"); __builtin_amdgcn_s_barrier(); asm volatile("" ::: "memory");
        if (lane < 32) { float* slot = xbuf + (size_t)(u.pm * BM + row) * 4; float t = 0.f;
#pragma unroll
            for (int k = 0; k < 4; ++k) t += __hip_atomic_load(slot + k, __ATOMIC_RELAXED, __HIP_MEMORY_SCOPE_AGENT);
            S[row] = t; }
        asm volatile("s_waitcnt lgkmcnt(0)" ::: "memory"); __builtin_amdgcn_s_barrier(); asm volatile("" ::: "memory");
    }
};
struct EpiNormRes {
    static constexpr bool PERM = false, AFTER_DRAIN = false, FUSED = true;
    bf16_t* hn; float* xs2; float* out; const float* gprev; const float* gpost; const float* gpre; RowStats st1; PG8_LAS unsigned char* xl;
    const float* s_in;
    __device__ __forceinline__ void fused(f32x4 (&acc)[2][2][4][2], const Unit& u, int wr, int wc, int fr, int fq, int wid, int lane) const {
        typedef unsigned u32x2v __attribute__((ext_vector_type(2)));
        PG8_LAS float* P = (PG8_LAS float*)xl;
        const PG8_LAS float* S = (const PG8_LAS float*)(xl + 4096);
        const int col0 = u.pn * BM + wc * 32 + 4 * fq;
        st1.run(acc, u, wr, wc, fr, fq, xl, wid, lane);
#pragma unroll
        for (int ai = 0; ai < 2; ++ai)
#pragma unroll
            for (int m = 0; m < 4; ++m) { const int r = ai * HALF + wr * 64 + m * 16 + fr; float rstd = rsqrtf(S[r] * (1.0f / 1024.0f) + 1e-6f); const size_t off = (size_t)(u.pm * BM + r) * 1024 + col0;
                if (s_in) { const f32x4 pp = *(const f32x4*)(s_in + (size_t)(u.pm * BM + r) * 4); const float s2 = __builtin_amdgcn_rcpf(((pp[0] + pp[1]) + (pp[2] + pp[3])) * (1.0f / 1024.0f) + 1e-6f);
                    rstd = rsqrtf(S[r] * (1.0f / 1024.0f) * s2 * s2 + 1e-6f) * s2; }
#pragma unroll
                for (int bj = 0; bj < 2; ++bj)
#pragma unroll
                    for (int n = 0; n < 2; ++n) { const u32x2v hw = *(const u32x2v*)(hn + off + bj * HALF + n * 16);
                        const f32x4 gp = *(const f32x4*)(gprev + col0 + bj * HALF + n * 16); const f32x4 gv = *(const f32x4*)(gpost + col0 + bj * HALF + n * 16);
                        f32x4 xs; xs[0] = __uint_as_float(hw.x << 16) * __builtin_amdgcn_rcpf(gp[0]); xs[1] = __uint_as_float(hw.x & 0xffff0000u) * __builtin_amdgcn_rcpf(gp[1]);
                        xs[2] = __uint_as_float(hw.y << 16) * __builtin_amdgcn_rcpf(gp[2]); xs[3] = __uint_as_float(hw.y & 0xffff0000u) * __builtin_amdgcn_rcpf(gp[3]);
                        acc[ai][bj][m][n] = xs + (acc[ai][bj][m][n] * rstd) * gv; }
                asm volatile("" : "+v"(acc[ai][0][m][0]), "+v"(acc[ai][0][m][1]), "+v"(acc[ai][1][m][0]), "+v"(acc[ai][1][m][1]));
                if (m & 1) asm volatile("" ::: "memory"); }
        if (gpre) {
#pragma unroll
            for (int ai = 0; ai < 2; ++ai)
#pragma unroll
                for (int m = 0; m < 4; ++m) {
                    float s = 0.f;
#pragma unroll
                    for (int bj = 0; bj < 2; ++bj)
#pragma unroll
                        for (int n = 0; n < 2; ++n) { const f32x4 x = acc[ai][bj][m][n]; s += (x[0] * x[0] + x[1] * x[1]) + (x[2] * x[2] + x[3] * x[3]); }
                    s += xor16f(s); s = sum32f(s);
                    if (fq == 0) P[(ai * HALF + wr * 64 + m * 16 + fr) * 4 + wc] = s;
                }
            asm volatile("s_waitcnt lgkmcnt(0)" ::: "memory"); __builtin_amdgcn_s_barrier(); asm volatile("" ::: "memory");
            { const int row = wid * 32 + (lane & 31);
              if (lane < 32) xs2[(size_t)(u.pm * BM + row) * 4 + u.pn] = (P[row * 4 + 0] + P[row * 4 + 1]) + (P[row * 4 + 2] + P[row * 4 + 3]); }
#pragma unroll
            for (int ai = 0; ai < 2; ++ai)
#pragma unroll
                for (int m = 0; m < 4; ++m) { const int r = ai * HALF + wr * 64 + m * 16 + fr; const size_t off = (size_t)(u.pm * BM + r) * 1024 + col0;
#pragma unroll
                    for (int bj = 0; bj < 2; ++bj)
#pragma unroll
                        for (int n = 0; n < 2; ++n) { const f32x4 gv = *(const f32x4*)(gpre + col0 + bj * HALF + n * 16); const f32x4 o = acc[ai][bj][m][n] * gv;
                            u32x2v w; w.x = cvt_pk_bf16(o[0], o[1]); w.y = cvt_pk_bf16(o[2], o[3]); *(u32x2v*)(hn + off + bj * HALF + n * 16) = w; }
                    asm volatile("" ::: "memory"); }
            asm volatile("s_waitcnt lgkmcnt(0)" ::: "memory"); __builtin_amdgcn_s_barrier(); asm volatile("" ::: "memory");
        } else {
#pragma unroll
            for (int ai = 0; ai < 2; ++ai)
#pragma unroll
                for (int m = 0; m < 4; ++m) { const int r = ai * HALF + wr * 64 + m * 16 + fr; const size_t off = (size_t)(u.pm * BM + r) * 1024 + col0;
#pragma unroll
                    for (int bj = 0; bj < 2; ++bj)
#pragma unroll
                        for (int n = 0; n < 2; ++n) *(f32x4*)(out + off + bj * HALF + n * 16) = acc[ai][bj][m][n]; }
        }
    }
};

template <class Epi, class Sched, bool ALIGN_EPI>
__device__ __forceinline__ void gemm_phase(PG8_LAS unsigned char* lds, const Gemm g, const Sched& S, const Epi& E, int tid0) {
    int tid_ = tid0; asm volatile("" : "+v"(tid_));
    const int tid = tid_, wid = __builtin_amdgcn_readfirstlane(tid >> 6), lane = tid & 63, wr = wid >> 2, wc = wid & 3, fr = lane & 15, fq = lane >> 4;
    const int K = g.K, nt = K / BK;
    unsigned voffA[2], voffB[2];
#pragma unroll
    for (int i = 0; i < 2; ++i) { int R, C; stage_rc(tid * 16 + i * 8192, R, C); const int Rb = Epi::PERM ? ((R & ~31) + perm32(R & 31)) : R;
        voffA[i] = (unsigned)(R * g.lda + C) * 2u; voffB[i] = (unsigned)(Rb * g.ldb + C) * 2u; }
    const size_t kstep = (size_t)(BK * 2);
    const size_t hstepA = (size_t)HALF * g.lda * 2, hstepB = (size_t)HALF * g.ldb * 2;
    const size_t tstepA = 2 * hstepA, tstepB = 2 * hstepB;
    const unsigned ldsw = (unsigned)wid * 1024u;
    const int aoff = lds_byte(wr * 64 + fr, fq * 8), boff = lds_byte(wc * 32 + fr, fq * 8);
#define PG8_SA(b, h) (((b) * 2 + (h)) * HTB)
#define PG8_SB(b, h) ((4 + (b) * 2 + (h)) * HTB)
#define PG8_STAGE(bufoff, gbase, voff) do { _Pragma("unroll") for (int _i = 0; _i < 2; ++_i) \
        __builtin_amdgcn_global_load_lds((const unsigned*)((const char*)(gbase) + (voff)[_i]), (PG8_LAS unsigned*)(lds + (bufoff) + ldsw + _i * 8192), 16, 0, 0); } while (0)
#define PG8_LDA(dst, b, h) do { _Pragma("unroll") for (int m = 0; m < 4; ++m) _Pragma("unroll") for (int k = 0; k < 2; ++k) dst[m][k] = *(const PG8_LAS bf16x8*)(lds + PG8_SA(b, h) + aoff + m * 2048 + k * 1024); } while (0)
#define PG8_LDB(dst, b, h) do { _Pragma("unroll") for (int n = 0; n < 2; ++n) _Pragma("unroll") for (int k = 0; k < 2; ++k) dst[n][k] = *(const PG8_LAS bf16x8*)(lds + PG8_SB(b, h) + boff + n * 2048 + k * 1024); } while (0)
#define PG8_MMA(ai, bj, At, Bt) do { __builtin_amdgcn_s_setprio(1); _Pragma("unroll") for (int m = 0; m < 4; ++m) _Pragma("unroll") for (int n = 0; n < 2; ++n) _Pragma("unroll") for (int k = 0; k < 2; ++k) \
        acc[ai][bj][m][n] = __builtin_amdgcn_mfma_f32_16x16x32_bf16(Bt[n][k], At[m][k], acc[ai][bj][m][n], 0, 0, 0); __builtin_amdgcn_s_setprio(0); } while (0)
#define PG8_WAIT_V(n) asm volatile("s_waitcnt vmcnt(" #n ")" ::: "memory")
#define PG8_WAIT_L(n) asm volatile("s_waitcnt lgkmcnt(" #n ")" ::: "memory")
#define PG8_BAR __builtin_amdgcn_s_barrier()
#define PG8_SCHED __builtin_amdgcn_sched_barrier(0)
    Unit cur, nxt; int ui = 0;
    if (!S.next(0, cur)) return;
    f32x4 acc[2][2][4][2];
#pragma unroll
    for (int a = 0; a < 2; ++a)
#pragma unroll
        for (int b = 0; b < 2; ++b)
#pragma unroll
            for (int m = 0; m < 4; ++m)
#pragma unroll
                for (int n = 0; n < 2; ++n) acc[a][b][m][n] = (f32x4){0.f, 0.f, 0.f, 0.f};
    bf16x8 At[4][2], B0[2][2], B1[2][2];
    const char* cA = (const char*)g.A + (size_t)cur.pm * tstepA + (size_t)(cur.pn >> 1) * (size_t)g.apn; const char* cB = (const char*)g.Bt + (size_t)cur.pn * tstepB;
    S.a_ready(cur);
    PG8_STAGE(PG8_SB(0, 0), cB, voffB); PG8_STAGE(PG8_SB(0, 1), cB + hstepB, voffB); PG8_STAGE(PG8_SA(0, 0), cA, voffA); PG8_STAGE(PG8_SA(0, 1), cA + hstepA, voffA);
    if (wr == 1) PG8_BAR;
    PG8_WAIT_V(2); PG8_BAR;
    PG8_STAGE(PG8_SB(1, 0), cB + kstep, voffB); PG8_STAGE(PG8_SA(1, 0), cA + kstep, voffA); PG8_STAGE(PG8_SB(1, 1), cB + hstepB + kstep, voffB);
    PG8_WAIT_V(6); PG8_BAR;
    for (;;) {
        const bool has_next = S.next(ui + 1, nxt);
        const char* nA = has_next ? (const char*)g.A + (size_t)nxt.pm * tstepA + (size_t)(nxt.pn >> 1) * (size_t)g.apn : cA; const char* nB = has_next ? (const char*)g.Bt + (size_t)nxt.pn * tstepB : cB;
        for (int t = 0; t < nt; t += 2) {
            const bool last = (t == nt - 2);
            const char* a1 = cA + (size_t)(t + 1) * kstep;
            const char* a2 = last ? nA : cA + (size_t)(t + 2) * kstep; const char* b2 = last ? nB : cB + (size_t)(t + 2) * kstep;
            const char* a3 = a2 + kstep; const char* b3 = b2 + kstep;
            if (last && has_next) S.a_ready(nxt);
            PG8_LDB(B0, 0, 0); PG8_LDB(B1, 0, 1); PG8_SCHED; PG8_LDA(At, 0, 0); PG8_STAGE(PG8_SA(1, 1), a1 + hstepA, voffA);
            PG8_WAIT_V(8); PG8_WAIT_L(0); PG8_BAR; PG8_MMA(0, 0, At, B0); PG8_MMA(0, 1, At, B1); PG8_BAR; PG8_SCHED;
            PG8_LDA(At, 0, 1); PG8_STAGE(PG8_SB(0, 0), b2, voffB); PG8_STAGE(PG8_SB(0, 1), b2 + hstepB, voffB); PG8_STAGE(PG8_SA(0, 0), a2, voffA);
            PG8_WAIT_V(8); PG8_WAIT_L(0); PG8_BAR; PG8_MMA(1, 0, At, B0); PG8_MMA(1, 1, At, B1); PG8_BAR; PG8_SCHED;
            PG8_LDB(B0, 1, 0); PG8_LDB(B1, 1, 1); PG8_SCHED; PG8_LDA(At, 1, 0); PG8_STAGE(PG8_SA(0, 1), a2 + hstepA, voffA);
            PG8_WAIT_V(8); PG8_WAIT_L(0); PG8_BAR; PG8_MMA(0, 0, At, B0); PG8_MMA(0, 1, At, B1); PG8_BAR; PG8_SCHED;
            PG8_LDA(At, 1, 1); PG8_STAGE(PG8_SB(1, 0), b3, voffB); PG8_STAGE(PG8_SB(1, 1), b3 + hstepB, voffB); PG8_STAGE(PG8_SA(1, 0), a3, voffA);
            PG8_WAIT_V(8); PG8_WAIT_L(0); PG8_BAR; PG8_MMA(1, 0, At, B0); PG8_MMA(1, 1, At, B1); PG8_BAR; PG8_SCHED;
        }
        if constexpr (ALIGN_EPI) { if (wr == 0) PG8_BAR; }
        if constexpr (Epi::FUSED) E.fused(acc, cur, wr, wc, fr, fq, wid, lane); else E(acc, cur, wr, wc, fr, fq);
        S.done(cur);
        if (!has_next) break;
#pragma unroll
        for (int a = 0; a < 2; ++a)
#pragma unroll
            for (int b = 0; b < 2; ++b)
#pragma unroll
                for (int m = 0; m < 4; ++m)
#pragma unroll
                    for (int n = 0; n < 2; ++n) acc[a][b][m][n] = (f32x4){0.f, 0.f, 0.f, 0.f};
        cur = nxt; cA = nA; cB = nB; ++ui;
        if constexpr (ALIGN_EPI) { if (wr == 1) PG8_BAR; }
    }
    PG8_WAIT_V(0);
    if constexpr (!ALIGN_EPI) { if (wr == 0) PG8_BAR; }
    PG8_BAR;
#undef PG8_SA
#undef PG8_SB
#undef PG8_STAGE
#undef PG8_LDA
#undef PG8_LDB
#undef PG8_MMA
#undef PG8_WAIT_V
#undef PG8_WAIT_L
#undef PG8_BAR
#undef PG8_SCHED
}
}
namespace att {
typedef unsigned short u16;
typedef short bf16x8 __attribute__((ext_vector_type(8)));
typedef short s16x4 __attribute__((ext_vector_type(4)));
typedef float f32x16 __attribute__((ext_vector_type(16)));
typedef float f32x4 __attribute__((ext_vector_type(4)));
typedef unsigned u32x4 __attribute__((ext_vector_type(4)));
constexpr int SEQ = 16384, NW = 8, QBLK = 32, KVBLK = 64, QB = NW * QBLK;
constexpr int LDQ = 1536, LDK = 2048, LDKR = 64, LDO = 1024;
#ifndef ATT_NQREG
#define ATT_NQREG 4
#endif
constexpr int NQREG = ATT_NQREG, NQREG_L = 8 - NQREG;
constexpr int SHM_V = KVBLK * 128 * 2, SHM_K = KVBLK * 128 * 2, SHM_KR = KVBLK * 64 * 2;
constexpr int OFF_V = 0, OFF_K = 2 * SHM_V, OFF_KR = OFF_K + 2 * SHM_K, OFF_WS = OFF_KR + 2 * SHM_KR, OFF_QR = OFF_WS + NW * 64 * 4, QR_WAVE = (NQREG_L + 4) * 1024, LDS_BYTES = OFF_QR + NW * QR_WAVE;
constexpr float SCALE = 0.07216878364870322f;
constexpr float THR = 8.f;

#define KSWZ(row, colB) ((row) * 256 + ((colB) ^ (((row) & 7) << 4)))
#define KRSWZ(row, colB) ((row) * 128 + ((colB) ^ (((row) & 7) << 4)))
#define SBAR() __builtin_amdgcn_sched_barrier(0)
__device__ __forceinline__ int v_st(int k, int c) { const int kk = (k & ~0xC) | ((k & 4) << 1) | ((k & 8) >> 1); return ((kk >> 3) * 4 + (c >> 5)) * 512 + ((kk & 7) * 32 + (c & 31)) * 2; }
__device__ __forceinline__ int v_rd_base(int lane) { return ((lane & 3) << 3) | (((lane >> 2) & 3) << 6) | (((lane >> 4) & 1) << 5) | (((lane >> 5) & 1) << 8); }
constexpr int v_rd_off(int d0, int ks, int half) { return d0 * 512 + ks * 4096 + half * 2048; }
__device__ __forceinline__ int crow(int r, int hi) { return (r & 3) + 8 * (r >> 2) + 4 * hi; }
__device__ __forceinline__ unsigned cvtpk(float lo, float hi) { unsigned r; asm volatile("v_cvt_pk_bf16_f32 %0, %1, %2" : "=v"(r) : "v"(lo), "v"(hi)); return r; }
__device__ __forceinline__ bf16x8 load8(const u16* p) { return *reinterpret_cast<const bf16x8*>(p); }
__device__ __forceinline__ void mask_tile(f32x16& p0, f32x16& p1, int dq, unsigned W) {
    const float NEG = -__builtin_inff();
#pragma unroll
    for (int r = 0; r < 16; ++r) {
        const int c = (r & 3) + 8 * (r >> 2);
        if ((unsigned)(dq - c) >= W) p0[r] = NEG;
        if ((unsigned)(dq - c - 32) >= W) p1[r] = NEG;
    }
}
__device__ __forceinline__ void partialSM(f32x16& p0, f32x16& p1, float& m_reg, float& mn, float& alpha) {
    float pmax = p0[0]; for (int r = 1; r < 16; ++r) pmax = fmaxf(pmax, p0[r]); for (int r = 0; r < 16; ++r) pmax = fmaxf(pmax, p1[r]);
    { auto rr = __builtin_amdgcn_permlane32_swap(__float_as_uint(pmax), __float_as_uint(pmax), false, false);
      pmax = fmaxf(__uint_as_float(rr[0]), __uint_as_float(rr[1])); }
    constexpr float C2 = 1.4426950408889634f * SCALE;
    if (__builtin_expect(__all((pmax - m_reg) * SCALE <= THR), 1)) { mn = m_reg; alpha = 1.f; }
    else { mn = fmaxf(m_reg, pmax); alpha = __builtin_amdgcn_exp2f((m_reg - mn) * C2); m_reg = mn; }
    const float mnL = -mn * C2;
    for (int r = 0; r < 16; ++r) p0[r] = fmaf(p0[r], C2, mnL); for (int r = 0; r < 16; ++r) p1[r] = fmaf(p1[r], C2, mnL);
    for (int r = 0; r < 16; ++r) p0[r] = __builtin_amdgcn_exp2f(p0[r]);
}
__device__ __forceinline__ void finishSM(f32x16& p0, f32x16& p1, float alpha, float& l_reg, bf16x8& pa0, bf16x8& pa1, bf16x8& pa2, bf16x8& pa3) {
    for (int r = 0; r < 16; ++r) p1[r] = __builtin_amdgcn_exp2f(p1[r]);
    float ps = 0; for (int r = 0; r < 16; ++r) ps += p0[r]; for (int r = 0; r < 16; ++r) ps += p1[r];
    { auto rr = __builtin_amdgcn_permlane32_swap(__float_as_uint(ps), __float_as_uint(ps), false, false);
      ps = __uint_as_float(rr[0]) + __uint_as_float(rr[1]); }
    l_reg = l_reg * alpha + ps;
#define PK4(P, B_, OUT) do { unsigned a0 = cvtpk(P[B_+0], P[B_+1]), a1 = cvtpk(P[B_+2], P[B_+3]);                          \
        unsigned b0 = cvtpk(P[B_+4], P[B_+5]), b1 = cvtpk(P[B_+6], P[B_+7]);                                             \
        auto r0 = __builtin_amdgcn_permlane32_swap(a0, b0, false, false); auto r1 = __builtin_amdgcn_permlane32_swap(a1, b1, false, false); \
        u32x4 w = {r0[0], r1[0], r0[1], r1[1]}; OUT = *reinterpret_cast<bf16x8*>(&w); } while (0)
    PK4(p0, 0, pa0); PK4(p0, 8, pa1); PK4(p1, 0, pa2); PK4(p1, 8, pa3);
#undef PK4
}
#ifndef ATT_PF
#define ATT_PF 2
#endif
#define QK_SB() __builtin_amdgcn_sched_barrier(0x406)
#define QK_LOAD(s, SET) do { if ((s) < 8) { const char* a_ = kb[(s) & 3] + ((s) >> 2) * 128; fb0[SET] = *reinterpret_cast<const bf16x8*>(a_); fb1[SET] = *reinterpret_cast<const bf16x8*>(a_ + 32 * 256); \
            if ((s) < NQREG) fq[SET] = qr[(s) < NQREG ? (s) : 0]; else fq[SET] = qrl[((s) - NQREG) * 64]; } \
        else { const char* a_ = krb[((s) - 8) & 3]; fb0[SET] = *reinterpret_cast<const bf16x8*>(a_); fb1[SET] = *reinterpret_cast<const bf16x8*>(a_ + 32 * 128); fq[SET] = qrl[(NQREG_L + (s) - 8) * 64]; } } while (0)
template <int KB>
__device__ __forceinline__ void qkt(f32x16& p0, f32x16& p1, const char* K_lds, const char* KR_lds, const bf16x8* qrl, int r32, int hi, const bf16x8* qr) {
    constexpr int PF = ATT_PF, NS = PF + 1;
    p0 = f32x16{}; p1 = f32x16{};
    const char* kb[4]; const char* krb[4];
#pragma unroll
    for (int dd = 0; dd < 4; ++dd) { kb[dd] = K_lds + KB * SHM_K + KSWZ(r32, (dd * 16 + hi * 8) * 2); krb[dd] = KR_lds + KB * SHM_KR + KRSWZ(r32, (dd * 16 + hi * 8) * 2); }
    bf16x8 fb0[NS], fb1[NS], fq[NS];
#pragma unroll
    for (int s = 0; s < PF; ++s) QK_LOAD(s, s % NS);
#pragma unroll
    for (int s = 0; s < 12; ++s) {
        QK_SB();
        if (s + PF < 12) QK_LOAD(s + PF, (s + PF) % NS);
        QK_SB();
        p0 = __builtin_amdgcn_mfma_f32_32x32x16_bf16(fb0[s % NS], fq[s % NS], p0, 0, 0, 0);
        p1 = __builtin_amdgcn_mfma_f32_32x32x16_bf16(fb1[s % NS], fq[s % NS], p1, 0, 0, 0);
    }
    QK_SB();
}
#undef QK_LOAD
template <int VB>
__device__ __forceinline__ void pv_tile(f32x16* o, int vb0, bf16x8 pa0, bf16x8 pa1, bf16x8 pa2, bf16x8 pa3) {
#define TRRD(dst, off) asm volatile("ds_read_b64_tr_b16 %0, %1 offset:%2" : "=&v"(dst) : "v"(vb0), "i"(off) : "memory")
#define PV_D0(d0) do { s16x4 l0, l1, l2, l3, h0, h1, h2, h3; constexpr int b_ = OFF_V + VB * SHM_V + v_rd_off(d0, 0, 0); \
        TRRD(l0, b_); TRRD(h0, b_ + 2048); TRRD(l1, b_ + 4096); TRRD(h1, b_ + 6144); TRRD(l2, b_ + 8192); TRRD(h2, b_ + 10240); TRRD(l3, b_ + 12288); TRRD(h3, b_ + 14336); \
        asm volatile("s_waitcnt lgkmcnt(0)" ::: "memory"); SBAR();   \
        o[d0] = __builtin_amdgcn_mfma_f32_32x32x16_bf16(pa0, (bf16x8){l0[0], l0[1], l0[2], l0[3], h0[0], h0[1], h0[2], h0[3]}, o[d0], 0, 0, 0);   \
        o[d0] = __builtin_amdgcn_mfma_f32_32x32x16_bf16(pa1, (bf16x8){l1[0], l1[1], l1[2], l1[3], h1[0], h1[1], h1[2], h1[3]}, o[d0], 0, 0, 0);   \
        o[d0] = __builtin_amdgcn_mfma_f32_32x32x16_bf16(pa2, (bf16x8){l2[0], l2[1], l2[2], l2[3], h2[0], h2[1], h2[2], h2[3]}, o[d0], 0, 0, 0);   \
        o[d0] = __builtin_amdgcn_mfma_f32_32x32x16_bf16(pa3, (bf16x8){l3[0], l3[1], l3[2], l3[3], h3[0], h3[1], h3[2], h3[3]}, o[d0], 0, 0, 0); } while (0)
    __builtin_amdgcn_s_setprio(1); PV_D0(0); PV_D0(1); PV_D0(2); PV_D0(3); __builtin_amdgcn_s_setprio(0);
#undef PV_D0
#undef TRRD
}

struct BlockRef { const u16* Q; const u16* K; const u16* V; const u16* KR; u16* O; int P0; int row0; };
struct Seam { bf16x8 st_v0, st_v1; };
#define ROWK(p, k0, rr) ((p) + (size_t)((k0) + (rr)) * LDK + sc)
#define VMW() asm volatile("s_waitcnt vmcnt(0)" ::: "memory")
#define VMWN(n) asm volatile("s_waitcnt vmcnt(%0)" :: "i"(n) : "memory")
#define ATT_LAS __attribute__((address_space(3)))
#define SLOAD_H(Kp, Vp, KRp, k0, bf) do { S.st_v0 = load8(ROWK(Vp, k0, sr)); S.st_v1 = load8(ROWK(Vp, k0, 32 + sr));              \
        __builtin_amdgcn_global_load_lds((const unsigned*)((Kp) + (size_t)((k0) + sr) * LDK + ksc), (ATT_LAS unsigned*)(ldsL + OFF_K + (bf) * SHM_K + wid * 1024), 16, 0, 0); \
        __builtin_amdgcn_global_load_lds((const unsigned*)((Kp) + (size_t)((k0) + 32 + sr) * LDK + ksc), (ATT_LAS unsigned*)(ldsL + OFF_K + (bf) * SHM_K + 8192 + wid * 1024), 16, 0, 0); \
        __builtin_amdgcn_global_load_lds((const unsigned*)((KRp) + (size_t)((k0) + krr) * LDKR + krsc), (ATT_LAS unsigned*)(ldsL + OFF_KR + (bf) * SHM_KR + wid * 1024), 16, 0, 0); } while (0)
#define SWRITE_HK(bf) do { } while (0)
#define SWRITE_HV(bf) do { *(bf16x8*)(V_lds + (bf) * SHM_V + vst0) = S.st_v0; *(bf16x8*)(V_lds + (bf) * SHM_V + vst1) = S.st_v1; } while (0)
#define SWRITE_H(bf) do { SWRITE_HV(bf); SWRITE_HK(bf); } while (0)
__device__ __forceinline__ void attn_prime(const BlockRef& cur, char* lds, Seam& S, int tid0) {
    int tid_ = tid0; asm volatile("" : "+v"(tid_));
    const int tid = tid_, wid = __builtin_amdgcn_readfirstlane(tid >> 6), lane = tid & 63, r32 = lane & 31, hi = lane >> 5;
    const int sr = tid >> 4, sc = (tid & 15) * 8, ksc = ((tid & 15) ^ (sr & 7)) * 8;
    const int krr = tid >> 3, krsc = ((tid & 7) ^ (krr & 7)) * 8; ATT_LAS unsigned char* ldsL = (ATT_LAS unsigned char*)lds;
    SLOAD_H(cur.K, cur.V, cur.KR, 0, 0); VMW();
    __syncthreads();
}
__device__ __forceinline__ void attn_block(const BlockRef& cur, const BlockRef& nxt, char* lds, Seam& S, int tid0, const float* ctab, const float* stab) {
    int tid_ = tid0; asm volatile("" : "+v"(tid_));
    const int tid = tid_, wid = __builtin_amdgcn_readfirstlane(tid >> 6), lane = tid & 63, r32 = lane & 31, hi = lane >> 5;
    const unsigned W = 0x40000000u;
    const int NT = (cur.P0 + QB - 1) / KVBLK + 1;
    const int qlo = cur.P0 + wid * QBLK, qm = qlo + r32 - 4 * hi;
    char* V_lds = lds + OFF_V; char* K_lds = lds + OFF_K; char* KR_lds = lds + OFF_KR;
    float* ws = (float*)(lds + OFF_WS) + wid * 64; float* li_l = ws, * al_l = ws + 32;
    bf16x8* qrl = (bf16x8*)(lds + OFF_QR + wid * QR_WAVE) + lane;
    float m_reg = -1e30f, l_reg = 0; f32x16 o[4] = {};
    const int sr = tid >> 4, sc = (tid & 15) * 8, vst0 = v_st(sr, sc), vst1 = v_st(32 + sr, sc), ksc = ((tid & 15) ^ (sr & 7)) * 8;
    const int krr = tid >> 3, krsc = ((tid & 7) ^ (krr & 7)) * 8; ATT_LAS unsigned char* ldsL = (ATT_LAS unsigned char*)lds;
    const int vb0 = (int)(uintptr_t)lds + v_rd_base(lane);
    const u16* Kh = cur.K; const u16* Vh = cur.V; const u16* KRh = cur.KR;
#define RESC(a) do { if (__any((a) < 1.f)) { if (hi == 0) al_l[r32] = (a); asm volatile("s_waitcnt lgkmcnt(0)" ::: "memory");              \
                     for (int d_ = 0; d_ < 4; ++d_) for (int r = 0; r < 16; ++r) o[d_][r] *= al_l[crow(r, hi)]; } } while (0)
#define KBASE(t) ((t) * KVBLK)
#define MASKT(P0_, P1_, t) do { const int kb_ = KBASE(t); if (kb_ + KVBLK - 1 > qlo) mask_tile(P0_, P1_, qm - kb_, W); } while (0)
#define SEAM_K0() do { VMW(); SWRITE_HK(0); SBAR(); } while (0)
    f32x16 pA0, pA1, pB0, pB1; float mnA, mnB, alA, alB; bf16x8 pa0, pa1, pa2, pa3;
    bf16x8 qr[NQREG > 0 ? NQREG : 1];
    { const u16* qp = cur.Q + (size_t)(wid * QBLK + r32) * LDQ + hi * 8;
#pragma unroll
      for (int d = 0; d < NQREG_L; ++d) qrl[d * 64] = load8(qp + (NQREG + d) * 16);
      const size_t trow = (size_t)(cur.row0 + wid * QBLK + r32) * 32 + hi * 8;
#pragma unroll
      for (int pr = 0; pr < 2; ++pr) {
          const bf16x8 x1 = load8(qp + 128 + pr * 16), x2 = load8(qp + 128 + 32 + pr * 16);
          const f32x4 c0 = *(const f32x4*)(ctab + trow + pr * 16), c1 = *(const f32x4*)(ctab + trow + pr * 16 + 4), s0 = *(const f32x4*)(stab + trow + pr * 16), s1 = *(const f32x4*)(stab + trow + pr * 16 + 4);
          float o1[8], o2[8];
#pragma unroll
          for (int e = 0; e < 8; ++e) { const float a = __uint_as_float(((unsigned)(unsigned short)x1[e]) << 16), b = __uint_as_float(((unsigned)(unsigned short)x2[e]) << 16);
              const float cc = e < 4 ? c0[e & 3] : c1[e & 3], ss = e < 4 ? s0[e & 3] : s1[e & 3]; o1[e] = a * cc - b * ss; o2[e] = b * cc + a * ss; }
          u32x4 w1 = {cvtpk(o1[0], o1[1]), cvtpk(o1[2], o1[3]), cvtpk(o1[4], o1[5]), cvtpk(o1[6], o1[7])}, w2 = {cvtpk(o2[0], o2[1]), cvtpk(o2[2], o2[3]), cvtpk(o2[4], o2[5]), cvtpk(o2[6], o2[7])};
          qrl[(NQREG_L + pr) * 64] = *reinterpret_cast<bf16x8*>(&w1); qrl[(NQREG_L + 2 + pr) * 64] = *reinterpret_cast<bf16x8*>(&w2); }
#pragma unroll
      for (int d0 = 0; d0 < NQREG; ++d0) qr[d0] = load8(qp + d0 * 16); }
    SWRITE_HV(0); SBAR();
    if (NT > 1) SLOAD_H(Kh, Vh, KRh, KBASE(1), 1);
    SBAR(); qkt<0>(pA0, pA1, K_lds, KR_lds, qrl, r32, hi, qr);
    MASKT(pA0, pA1, 0); partialSM(pA0, pA1, m_reg, mnA, alA);
    if (NT > 1) { VMW(); SWRITE_H(1); }
    __syncthreads();
#define HALF_STEP(PX0, PX1, mnX, alX, PY0, PY1, alY, t, KB, VB, SB) do {                                                      \
        SBAR(); qkt<KB>(PX0, PX1, K_lds, KR_lds, qrl, r32, hi, qr);                                                          \
        finishSM(PY0, PY1, alY, l_reg, pa0, pa1, pa2, pa3); SBAR();                                                           \
        if ((t) + 1 < NT) { SLOAD_H(Kh, Vh, KRh, KBASE((t) + 1), SB); SBAR(); }                                                   \
        pv_tile<VB>(o, vb0, pa0, pa1, pa2, pa3); MASKT(PX0, PX1, (t)); partialSM(PX0, PX1, m_reg, mnX, alX);                  \
        __syncthreads();                                                                                                      \
        if ((t) + 1 < NT) { VMW(); SWRITE_H(SB); }                                                                            \
        RESC(alX); __syncthreads(); } while (0)
    for (int t = 1; t + 1 < NT; t += 2) {
        HALF_STEP(pB0, pB1, mnB, alB, pA0, pA1, alA, t, 1, 0, 0);
        HALF_STEP(pA0, pA1, mnA, alA, pB0, pB1, alB, t + 1, 0, 1, 1);
    }
    const bool even = (NT & 1) == 0;
    if (even) { SBAR(); qkt<1>(pB0, pB1, K_lds, KR_lds, qrl, r32, hi, qr); SBAR(); }
    SLOAD_H(nxt.K, nxt.V, nxt.KR, 0, 0); SBAR();
    finishSM(pA0, pA1, alA, l_reg, pa0, pa1, pa2, pa3); SBAR();
    pv_tile<0>(o, vb0, pa0, pa1, pa2, pa3);
    if (even) { MASKT(pB0, pB1, NT - 1); partialSM(pB0, pB1, m_reg, mnB, alB); __syncthreads(); RESC(alB);
        finishSM(pB0, pB1, alB, l_reg, pa0, pa1, pa2, pa3); SBAR(); pv_tile<1>(o, vb0, pa0, pa1, pa2, pa3); }
    SBAR(); SEAM_K0();
    if (hi == 0) li_l[r32] = l_reg; asm volatile("s_waitcnt lgkmcnt(0)" ::: "memory");
    float rli[16];
#pragma unroll
    for (int r = 0; r < 16; ++r) rli[r] = __builtin_amdgcn_rcpf(li_l[crow(r, hi)]);
    u16* Ow = cur.O + (size_t)(wid * QBLK) * LDO;
#pragma unroll
    for (int r = 0; r < 16; ++r) { const int orow = crow(r, hi);
#pragma unroll
        for (int d0 = 0; d0 < 4; ++d0) { const float v = o[d0][r] * rli[r];
            const float vn = xor1f(v);
            if ((r32 & 1) == 0) *(unsigned*)(Ow + (size_t)orow * LDO + d0 * 32 + r32) = cvtpk(v, vn); } }
    __syncthreads();
#undef RESC
#undef KBASE
#undef MASKT
#undef SEAM_K0
#undef HALF_STEP
}
struct Tensors { const u16* q; const u16* kv; const u16* kr; u16* o; const float* ctab; const float* stab; };
__device__ __forceinline__ BlockRef make_ref(const Tensors& T, int L, int pass) {
    const int bh = (L & 7) + 8 * (L >> 8), x = (L >> 3) & 31, b = bh >> 3, h = bh & 7, qb = pass ? 63 - x : x;
    BlockRef r; const size_t row0 = (size_t)b * SEQ;
    r.Q = T.q + (row0 + (size_t)qb * QB) * LDQ + h * 192; r.K = T.kv + row0 * LDK + h * 256; r.V = r.K + 128; r.KR = T.kr + row0 * LDKR;
    r.O = T.o + (row0 + (size_t)qb * QB) * LDO + h * 128; r.P0 = qb * QB; r.row0 = b * SEQ + qb * QB;
    return r;
}
__device__ __forceinline__ void attn_phase(char* lds, const Tensors& T, int tid0) {
    const int total = 512, stride = gridDim.x;
    int L = blockIdx.x; if (L >= total) return;
    int pass = 0;
    BlockRef cur = make_ref(T, L, 0);
    Seam S;
    attn_prime(cur, lds, S, tid0);
    for (;;) {
        const bool more_pass = pass == 0, more_item = L + stride < total, last = !more_pass && !more_item;
        int passn = pass + 1, Ln = L;
        if (!more_pass) { passn = 0; Ln = more_item ? L + stride : L; }
        const BlockRef nxt = last ? cur : make_ref(T, Ln, passn);
        attn_block(cur, nxt, lds, S, tid0, T.ctab, T.stab);
        if (last) break;
        cur = nxt; pass = passn; L = Ln;
    }
}
#undef ROWK
#undef VMW
#undef VMWN
#undef SLOAD_H
#undef SWRITE_HK
#undef SWRITE_HV
#undef SWRITE_H
#undef SBAR
}
namespace xb {
#define LAS __attribute__((address_space(3)))
#define XB_TMO      128
#define XB_XCNT(j)  (256  + 64 * (j))
#define XB_XSUB(j)  (1280 + 64 * (j))
#define XB_XGEN(j)  (2304 + 64 * (j))
#define XB_TOP      3328
#define XB_TOPGEN   3392
#define XCD_BAR_WORDS 3456
#define XB_SPIN_CAP (1u << 18)

__device__ __forceinline__ unsigned xb_ld(unsigned* p)              { return __hip_atomic_load(p, __ATOMIC_RELAXED, __HIP_MEMORY_SCOPE_AGENT); }
__device__ __forceinline__ unsigned xb_add(unsigned* p, unsigned v) { return __hip_atomic_fetch_add(p, v, __ATOMIC_RELAXED, __HIP_MEMORY_SCOPE_AGENT); }
__device__ __forceinline__ unsigned xb_xcc_id() { return (unsigned)__builtin_amdgcn_s_getreg((3 << 11) | 20) & 0xFu; }
#define XB_SPIN(cond, bar) do { unsigned _sp = 0; while (cond) { __builtin_amdgcn_s_sleep(1); \
    if ((++_sp & 255u) == 0u) { if (xb_ld(&(bar)[XB_TMO])) break; if (_sp > XB_SPIN_CAP) { atomicAdd(&(bar)[XB_TMO], 1u); break; } } } } while (0)

struct XcdBarrier {
    unsigned* bar; unsigned x;
    volatile LAS unsigned* st;
};

__device__ __forceinline__ XcdBarrier xcd_barrier_post(unsigned* bar, volatile LAS unsigned* st) {
    XcdBarrier b; b.bar = bar; b.x = xb_xcc_id(); b.st = st;
    if (threadIdx.x == 0) (void)xb_add(&bar[XB_XCNT(b.x)], 1u);
    return b;
}
__device__ __forceinline__ void xcd_barrier_complete(unsigned* bar, unsigned x, unsigned& nloc, unsigned& nx) {
    const unsigned G = gridDim.x * gridDim.y * gridDim.z;
    unsigned sum, cnt, mine, sp = 0u;
    for (;;) {
        sum = 0u; cnt = 0u; mine = 0u;
#pragma unroll
        for (unsigned j = 0; j < 16; ++j) { const unsigned c = xb_ld(&bar[XB_XCNT(j)]); sum += c; cnt += (c > 0u) ? 1u : 0u; mine = (j == x) ? c : mine; }
        if (sum == G) break;
        __builtin_amdgcn_s_sleep(1);
        if ((++sp & 255u) == 0u) { if (xb_ld(&bar[XB_TMO])) break; if (sp > XB_SPIN_CAP) { atomicAdd(&bar[XB_TMO], 1u); break; } }
    }
    nloc = mine > 0u ? mine : 1u; nx = cnt > 0u ? cnt : 1u;
}

__device__ __forceinline__ void xcd_barrier(const XcdBarrier& b, bool t0  ) {
    asm volatile("s_waitcnt vmcnt(0)" ::: "memory");
    __syncthreads();
    if (t0) {
        unsigned* bar = b.bar;
        __builtin_amdgcn_s_waitcnt(0);
        unsigned nloc = b.st[0], nx = b.st[1];
        if (nloc == 0u) { xcd_barrier_complete(bar, b.x, nloc, nx); b.st[0] = nloc; b.st[1] = nx; }
        const unsigned old = xb_add(&bar[XB_XSUB(b.x)], 1u);
        const unsigned gen = old / nloc;
        if (old + 1u == (gen + 1u) * nloc) {
            __builtin_amdgcn_fence(__ATOMIC_RELEASE, "agent");
            asm volatile("s_waitcnt vmcnt(0)" ::: "memory");
            const unsigned og = xb_add(&bar[XB_TOP], 1u);
            const unsigned tg = og / nx;
            if (og + 1u == (tg + 1u) * nx) xb_add(&bar[XB_TOPGEN], 1u);
            else XB_SPIN(xb_ld(&bar[XB_TOPGEN]) == tg, bar);
            __builtin_amdgcn_fence(__ATOMIC_ACQUIRE, "agent");
            xb_add(&bar[XB_XGEN(b.x)], 1u);
            asm volatile("s_waitcnt vmcnt(0)" ::: "memory");
        } else {
            XB_SPIN(xb_ld(&bar[XB_XGEN(b.x)]) == gen, bar);
            __builtin_amdgcn_fence(__ATOMIC_ACQUIRE, "agent");
            asm volatile("s_waitcnt vmcnt(0)" ::: "memory");
        }
    }
    __syncthreads();
}
#undef LAS
}
#ifndef PROBE_ATT_REPS
#define PROBE_ATT_REPS 1
#endif
#ifndef PROBE_SYNC_REPS
#define PROBE_SYNC_REPS 1
#endif
#ifndef PROBE_THIN_REPS
#define PROBE_THIN_REPS 1
#endif
#ifndef PROBE_PRO_REPS
#define PROBE_PRO_REPS 1
#endif
#ifndef PROBE_GEMM_REPS
#define PROBE_GEMM_REPS 1
#endif
namespace mk {
typedef unsigned short u16;
typedef float f32x4 __attribute__((ext_vector_type(4)));
constexpr int M = 32768, D = 1024, SEQ = 16384;
constexpr float EPS = 1e-6f;
constexpr size_t MB = (size_t)1 << 20;
__host__ __device__ constexpr size_t WT_MLA(int j) { return (size_t)j * 6 * MB; }
__host__ __device__ constexpr size_t WT_LRU(int j) { return 12 * MB + (size_t)j * 8 * MB; }
__host__ __device__ constexpr size_t WT_FFN(int l) { return 28 * MB + (size_t)l * 16 * MB; }
constexpr size_t OFF_UQ = 3 * MB / 2, OFF_UKV = 11 * MB / 4, OFF_WO = 15 * MB / 4, OFF_GT = 4 * MB, OFF_LOUT = 5 * MB, OFF_DOWN = 8 * MB;
constexpr size_t WS_COS = 96 * MB, WS_SIN = 100 * MB, WS_SA = 104 * MB, WS_SB = 105 * MB;
constexpr size_t WS_HN = 112 * MB, WS_Y = 176 * MB, WS_U = 240 * MB, WS_END = 496 * MB;
constexpr size_t U_PROJ = 64 * MB, U_CQ = 112 * MB, U_CKV = 136 * MB, U_KR = 152 * MB, U_Q = 160 * MB, U_O = 64 * MB;
constexpr size_t U_GATE = 0, U_XC = 64 * MB, U_REC = 128 * MB, U_LA = 128 * MB, U_B = 192 * MB;
constexpr size_t WS_XSA = 108 * MB, WS_XSB = 109 * MB;
constexpr size_t WS_RS = 108 * MB;
constexpr int SCAN_L = 128, SCAN_NC = SEQ / SCAN_L;

__device__ __forceinline__ unsigned f2bf(float f) { unsigned u = __float_as_uint(f); return (u + 0x7fffu + ((u >> 16) & 1u)) >> 16; }
__device__ __forceinline__ unsigned pk2(float lo, float hi) { return f2bf(lo) | (f2bf(hi) << 16); }
__device__ __forceinline__ float bflo(unsigned w) { return __uint_as_float(w << 16); }
__device__ __forceinline__ float bfhi(unsigned w) { return __uint_as_float(w & 0xffff0000u); }
__device__ __forceinline__ float bf1(u16 h) { return __uint_as_float(((unsigned)h) << 16); }
__device__ __forceinline__ float wave_sum(float v) {
    v += xor1f(v); v += xor2f(v); v += xor4f(v); v += xor8f(v); v += xor16f(v);
    return sum32f(v);
}
__device__ __forceinline__ void transpose_item(const float* W, int ldw, u16* WT, int ldt, int nblk, float* scr, int item, int lane) {
    const int kb = item / nblk, nb = item % nblk, k0 = 64 * kb, n0 = 32 * nb;
#pragma unroll
    for (int i = 0; i < 8; ++i) { const int kk = 8 * i + (lane >> 3); const f32x4 v = *(const f32x4*)(W + (size_t)(k0 + kk) * ldw + n0 + (lane & 7) * 4);
        float* s = scr + kk * 33 + (lane & 7) * 4; s[0] = v.x; s[1] = v.y; s[2] = v.z; s[3] = v.w; }
    asm volatile("s_waitcnt lgkmcnt(0)" ::: "memory");
    const int c = lane & 7;
#pragma unroll
    for (int j = 0; j < 4; ++j) { const int n = (lane >> 3) + 8 * j; const float* s = scr + (8 * c) * 33 + n;
        uint4 o; o.x = pk2(s[0 * 33], s[1 * 33]); o.y = pk2(s[2 * 33], s[3 * 33]); o.z = pk2(s[4 * 33], s[5 * 33]); o.w = pk2(s[6 * 33], s[7 * 33]);
        *(uint4*)(WT + (size_t)(n0 + n) * ldt + k0 + 8 * c) = o; }
    asm volatile("s_waitcnt lgkmcnt(0)" ::: "memory");
}
struct Params { const float* in[23]; float* out; unsigned char* ws; };
enum { I_X = 0, I_POS, I_MIXPRE, I_MIXPOST, I_FFNPRE, I_FFNPOST, I_MLA_WIN, I_MLA_QN, I_MLA_KVN, I_MLA_WUQ, I_MLA_WUKV, I_MLA_WO,
       I_LRU_WIN, I_LRU_CW, I_LRU_CB, I_LRU_WA, I_LRU_BA, I_LRU_WX, I_LRU_BX, I_LRU_LAM, I_LRU_WOUT, I_FFN_UP, I_FFN_DOWN };

__device__ __forceinline__ void prologue_weights(const __attribute__((address_space(4))) Params& p, float* scr, int gw, int NGW, int lane) {
    u16* wt = (u16*)p.ws;
    constexpr int IT_MLA = 352 + 288 + 256 + 512, IT_LRU = 1024 + 128 + 512, IT_FFN = 4096, TOTAL = 2 * IT_MLA + 2 * IT_LRU + 4 * IT_FFN;
    for (int it = gw; it < TOTAL; it += NGW) {
        int r = it; const float* W; int ldw, ldt, nblk; u16* WT;
        if (r < 2 * IT_MLA) { const int j = r / IT_MLA; r -= j * IT_MLA; u16* base = wt + WT_MLA(j) / 2;
            if (r < 352) { W = p.in[I_MLA_WIN] + (size_t)j * 1024 * 704; ldw = 704; nblk = 22; WT = base; ldt = 1024; }
            else if (r < 640) { r -= 352; W = p.in[I_MLA_WUQ] + (size_t)j * 384 * 1536; ldw = 1536; nblk = 48; WT = base + OFF_UQ / 2; ldt = 384; }
            else if (r < 896) { r -= 640; W = p.in[I_MLA_WUKV] + (size_t)j * 256 * 2048; ldw = 2048; nblk = 64; WT = base + OFF_UKV / 2; ldt = 256; }
            else { r -= 896; W = p.in[I_MLA_WO] + (size_t)j * 1024 * 1024; ldw = 1024; nblk = 32; WT = base + OFF_WO / 2; ldt = 1024; }
        } else if (r < 2 * IT_MLA + 2 * IT_LRU) { r -= 2 * IT_MLA; const int j = r / IT_LRU; r -= j * IT_LRU; u16* base = wt + WT_LRU(j) / 2;
            if (r < 1024) { W = p.in[I_LRU_WIN] + (size_t)j * 1024 * 2048; ldw = 2048; nblk = 64; WT = base; ldt = 1024; }
            else if (r < 1152) { r -= 1024; const int which = r >> 3, gt = which >> 3, n = which & 7; r &= 7;
                W = p.in[gt ? I_LRU_WX : I_LRU_WA] + (size_t)j * 8 * 128 * 128 + (size_t)n * 128 * 128; ldw = 128; nblk = 4;
                WT = base + OFF_GT / 2 + (size_t)(n * 256 + gt * 128) * 256 + 128 * (n & 1); ldt = 256; }
            else { r -= 1152; W = p.in[I_LRU_WOUT] + (size_t)j * 1024 * 1024; ldw = 1024; nblk = 32; WT = base + OFF_LOUT / 2; ldt = 1024; }
        } else { r -= 2 * IT_MLA + 2 * IT_LRU; const int l = r / IT_FFN; r -= l * IT_FFN; u16* base = wt + WT_FFN(l) / 2;
            if (r < 2048) { W = p.in[I_FFN_UP] + (size_t)l * 1024 * 4096; ldw = 4096; nblk = 128; WT = base; ldt = 1024; }
            else { r -= 2048; W = p.in[I_FFN_DOWN] + (size_t)l * 4096 * 1024; ldw = 1024; nblk = 32; WT = base + OFF_DOWN / 2; ldt = 4096; }
        }
        transpose_item(W, ldw, WT, ldt, nblk, scr, r, lane);
    }
}
__device__ __forceinline__ void rowop(const u16* y, const float* xin, float* xout, u16* hn, float* rs, const float* gpost, const float* gpre, int gw, int NGW, int lane) {
    f32x4 gp[4], gq[4];
#pragma unroll
    for (int j = 0; j < 4; ++j) { gp[j] = gpost ? *(const f32x4*)(gpost + j * 256 + lane * 4) : (f32x4){0.f, 0.f, 0.f, 0.f}; gq[j] = gpre ? *(const f32x4*)(gpre + j * 256 + lane * 4) : (f32x4){0.f, 0.f, 0.f, 0.f}; }
    for (int row = gw; row < M; row += NGW) {
        f32x4 xv[4];
#pragma unroll
        for (int j = 0; j < 4; ++j) xv[j] = *(const f32x4*)(xin + (size_t)row * D + j * 256 + lane * 4);
        if (y) {
            f32x4 yv[4]; float ss = 0.f;
#pragma unroll
            for (int j = 0; j < 4; ++j) { const uint2 w = *(const uint2*)(y + (size_t)row * D + j * 256 + lane * 4);
                yv[j] = (f32x4){bflo(w.x), bfhi(w.x), bflo(w.y), bfhi(w.y)}; ss += (yv[j].x * yv[j].x + yv[j].y * yv[j].y) + (yv[j].z * yv[j].z + yv[j].w * yv[j].w); }
            const float r = rsqrtf(wave_sum(ss) * (1.f / D) + EPS);
#pragma unroll
            for (int j = 0; j < 4; ++j) xv[j] = xv[j] + (yv[j] * r) * gp[j];
        }
        if (xout) {
#pragma unroll
        for (int j = 0; j < 4; ++j) *(f32x4*)(xout + (size_t)row * D + j * 256 + lane * 4) = xv[j]; }
        if (gpre) {
            float s2 = 0.f;
#pragma unroll
            for (int j = 0; j < 4; ++j) s2 += (xv[j].x * xv[j].x + xv[j].y * xv[j].y) + (xv[j].z * xv[j].z + xv[j].w * xv[j].w);
            const float tot2 = wave_sum(s2); const float r2 = 1.0f;
            if (rs && lane < 4) rs[(size_t)row * 4 + lane] = lane == 0 ? tot2 : 0.f;
#pragma unroll
            for (int j = 0; j < 4; ++j) { const f32x4 h = (xv[j] * r2) * gq[j]; uint2 w; w.x = pk2(h.x, h.y); w.y = pk2(h.z, h.w);
                *(uint2*)(hn + (size_t)row * D + j * 256 + lane * 4) = w; }
        }
    }
}
__device__ __forceinline__ void qkvnorm(const u16* proj, u16* cq, u16* ckv, u16* kr, const float* qn, const float* kvn, const float* ctab, const float* stab, const float* rss, int gw, int NGW, int lane) {
    float gq[6], gk[4];
#pragma unroll
    for (int j = 0; j < 6; ++j) gq[j] = qn[lane + 64 * j];
#pragma unroll
    for (int j = 0; j < 4; ++j) gk[j] = kvn[lane + 64 * j];
    for (int row = gw; row < M; row += NGW) {
        const u16* pr = proj + (size_t)row * 768;
        const f32x4 pp = *(const f32x4*)(rss + (size_t)row * 4); const float rsc = rsqrtf(((pp[0] + pp[1]) + (pp[2] + pp[3])) * (1.f / D) + EPS);
        float a[6], b[4], s1 = 0.f, s2 = 0.f;
#pragma unroll
        for (int j = 0; j < 6; ++j) { a[j] = bf1(pr[lane + 64 * j]) * rsc; s1 += a[j] * a[j]; }
#pragma unroll
        for (int j = 0; j < 4; ++j) { b[j] = bf1(pr[384 + lane + 64 * j]) * rsc; s2 += b[j] * b[j]; }
        const float x1 = bf1(pr[640 + (lane & 31)]) * rsc, x2 = bf1(pr[672 + (lane & 31)]) * rsc;
        const float r1 = rsqrtf(wave_sum(s1) * (1.f / 384.f) + EPS), r2 = rsqrtf(wave_sum(s2) * (1.f / 256.f) + EPS);
#pragma unroll
        for (int j = 0; j < 6; ++j) cq[(size_t)row * 384 + lane + 64 * j] = (u16)f2bf(a[j] * r1 * gq[j]);
#pragma unroll
        for (int j = 0; j < 4; ++j) ckv[(size_t)row * 256 + lane + 64 * j] = (u16)f2bf(b[j] * r2 * gk[j]);
        const float c = ctab[(size_t)row * 32 + (lane & 31)], s = stab[(size_t)row * 32 + (lane & 31)];
        kr[(size_t)row * 64 + lane] = (u16)f2bf(lane < 32 ? x1 * c - x2 * s : x2 * c + x1 * s);
    }
}
__device__ __forceinline__ void qrope(u16* q, const float* ctab, const float* stab, int gw, int NGW, int lane) {
    for (int row = gw; row < M; row += NGW) {
        u16* qr = q + (size_t)row * 1536; const int i = lane & 31;
        const float c = ctab[(size_t)row * 32 + i], s = stab[(size_t)row * 32 + i];
#pragma unroll
        for (int j = 0; j < 4; ++j) { const int h = 2 * j + (lane >> 5); u16* pp = qr + h * 192 + 128 + i;
            const float x1 = bf1(pp[0]), x2 = bf1(pp[32]);
            pp[0] = (u16)f2bf(x1 * c - x2 * s); pp[32] = (u16)f2bf(x2 * c + x1 * s); }
    }
}
__device__ __forceinline__ void conv_phase(const u16* rec, u16* xc, const float* cw, const float* cb, int gtid, int NGT) {
    for (int idx = gtid; idx < M * 128; idx += NGT) {
        const int row = idx >> 7, c0 = (idx & 127) * 8, s = row & (SEQ - 1);
        float acc[8];
#pragma unroll
        for (int e = 0; e < 8; ++e) acc[e] = cb[c0 + e];
#pragma unroll
        for (int k = 0; k < 4; ++k) { if (s - 3 + k >= 0) {
            const uint4 w = *(const uint4*)(rec + (size_t)(row - 3 + k) * D + c0);
            const float v[8] = {bflo(w.x), bfhi(w.x), bflo(w.y), bfhi(w.y), bflo(w.z), bfhi(w.z), bflo(w.w), bfhi(w.w)};
#pragma unroll
            for (int e = 0; e < 8; ++e) acc[e] += v[e] * cw[k * D + c0 + e]; } }
        uint4 o; o.x = pk2(acc[0], acc[1]); o.y = pk2(acc[2], acc[3]); o.z = pk2(acc[4], acc[5]); o.w = pk2(acc[6], acc[7]);
        *(uint4*)(xc + (size_t)row * D + c0) = o;
    }
}
__device__ __forceinline__ void scanA(const u16* A, const u16* B, float* SA, float* SB, int tid) {
    for (int item = blockIdx.x; item < 2 * SCAN_NC * 2; item += gridDim.x) {
        const int half = item & 1, c = (item >> 1) % SCAN_NC, b = item / (2 * SCAN_NC), ch = half * 512 + tid;
        const size_t base = ((size_t)b * SEQ + (size_t)c * SCAN_L) * D + ch;
        float h = 0.f, P = 1.f;
        for (int t0 = 0; t0 < SCAN_L; t0 += 16) {
            u16 aw[16], bw[16];
#pragma unroll
            for (int u = 0; u < 16; ++u) { aw[u] = A[base + (size_t)(t0 + u) * D]; bw[u] = B[base + (size_t)(t0 + u) * D]; }
#pragma unroll
            for (int u = 0; u < 16; ++u) { const float a = __expf(bf1(aw[u])); h = a * h + bf1(bw[u]); P *= a; }
        }
        SA[((size_t)b * SCAN_NC + c) * D + ch] = P; SB[((size_t)b * SCAN_NC + c) * D + ch] = h;
    }
}
__device__ __forceinline__ void scanC(const u16* A, const u16* B, const float* SA, const float* SB, const u16* gate, u16* hg, int tid) {
    for (int item = blockIdx.x; item < 2 * SCAN_NC * 2; item += gridDim.x) {
        const int half = item & 1, c = (item >> 1) % SCAN_NC, b = item / (2 * SCAN_NC), ch = half * 512 + tid;
        const size_t base = ((size_t)b * SEQ + (size_t)c * SCAN_L) * D + ch;
        float h = 0.f;
        for (int cc = 0; cc < c; ++cc) { const size_t so = ((size_t)b * SCAN_NC + cc) * D + ch; h = SA[so] * h + SB[so]; }
        for (int t0 = 0; t0 < SCAN_L; t0 += 16) {
            u16 aw[16], bw[16], gv[16];
#pragma unroll
            for (int u = 0; u < 16; ++u) { aw[u] = A[base + (size_t)(t0 + u) * D]; bw[u] = B[base + (size_t)(t0 + u) * D]; gv[u] = gate[base + (size_t)(t0 + u) * D]; }
#pragma unroll
            for (int u = 0; u < 16; ++u) { h = __expf(bf1(aw[u])) * h + bf1(bw[u]); hg[base + (size_t)(t0 + u) * D] = (u16)f2bf(bf1(gv[u]) * h); }
        }
    }
}

constexpr int LDS_GEMM = pg8::STAGE_BYTES + 8192, LDS_MAIN = att::LDS_BYTES > LDS_GEMM ? att::LDS_BYTES : LDS_GEMM, LDS_BYTES = LDS_MAIN + 16;
constexpr size_t WS_BAR = 106 * MB;
constexpr size_t WS_CNT1 = WS_BAR + 16384, WS_CNT2 = WS_BAR + 49152, CTL_BYTES = 81920, WS_XS1 = 107 * MB, WS_XS2 = 107 * MB + MB / 2;
constexpr int XL_OFF = 131072;
static_assert(XL_OFF + 8192 <= LDS_MAIN && XCD_BAR_WORDS * 4 <= 16384 && att::LDS_BYTES <= LDS_MAIN && pg8::STAGE_BYTES <= LDS_MAIN && LDS_BYTES <= 160 * 1024, "LDS map");

__global__ void __launch_bounds__(512, 2) fwd_mega(Params p_arg) {
    extern __shared__ __attribute__((aligned(16))) unsigned char lds[];
    cg::grid_group grid = cg::this_grid();
    (void)p_arg;
    volatile __attribute__((address_space(3))) unsigned* bst = (volatile __attribute__((address_space(3))) unsigned*)((__attribute__((address_space(3))) unsigned char*)lds + LDS_MAIN);
    if (threadIdx.x < 4) bst[threadIdx.x] = 0u;
    __syncthreads();
    const int wave_s = __builtin_amdgcn_readfirstlane(threadIdx.x >> 6);
    const unsigned bar_x = xb::xb_xcc_id();
    (void)xb::xcd_barrier_post((unsigned*)(p_arg.ws + WS_BAR), bst);
#define GRID_BAR() do { unsigned bx_ = bar_x; asm volatile("" : "+s"(bx_)); xb::XcdBarrier bb_; bb_.bar = (unsigned*)(ws + WS_BAR); bb_.x = bx_; bb_.st = bst; xb::xcd_barrier(bb_, tid == 0); } while (0)
    typedef const __attribute__((address_space(4))) Params* KParams;
    KParams pp = (KParams)__builtin_amdgcn_kernarg_segment_ptr();
#define FRESH() int tid_ = wave_s * 64 + lane_id_fresh(); asm volatile("" : "+v"(tid_)); asm volatile("" : "+s"(pp)); const __attribute__((address_space(4))) Params& p = *pp; \
    const int tid = tid_, lane = tid & 63, wave = __builtin_amdgcn_readfirstlane(tid >> 6); \
    const int G = gridDim.x, gw = blockIdx.x * 8 + wave, NGW = G * 8, gtid = blockIdx.x * 512 + tid, NGT = G * 512; \
    unsigned char* ws = p.ws; float* x = p.out; u16* hn = (u16*)(ws + WS_HN); u16* ybuf = (u16*)(ws + WS_Y); unsigned char* U = ws + WS_U; \
    float* ctab = (float*)(ws + WS_COS); float* stab = (float*)(ws + WS_SIN); float* SA = (float*)(ws + WS_SA); float* SB = (float*)(ws + WS_SB); \
    (void)lane; (void)wave; (void)gw; (void)NGW; (void)gtid; (void)NGT; (void)x; (void)hn; (void)ybuf; (void)U; (void)ctab; (void)stab; (void)SA; (void)SB;
    {
    FRESH();

    for (int prep = 0; prep < PROBE_PRO_REPS; ++prep) {
    prologue_weights(p, (float*)lds + wave * (64 * 33), gw, NGW, lane);
    for (int i = gtid; i < 2 * 2048 * 16; i += NGT) { const int j = i >> 15, row = (i >> 4) & 2047, chn = i & 15, n = row >> 8;
        *(uint4*)((u16*)(ws + WT_LRU(j) + OFF_GT) + (size_t)row * 256 + 128 * ((n & 1) ^ 1) + chn * 8) = make_uint4(0u, 0u, 0u, 0u); }
    { const int* pos = (const int*)p.in[I_POS];
      for (int i = gtid; i < M * 32; i += NGT) { const int row = i >> 5, f = i & 31;
        const float inv = __builtin_amdgcn_exp2f(-(float)f * (13.287712379549449f / 32.f));
        const float ang = (float)pos[row] * inv;
        double rev = (double)ang * 0.15915494309189535; rev -= __builtin_rint(rev);
        ctab[i] = __builtin_amdgcn_cosf((float)rev); stab[i] = __builtin_amdgcn_sinf((float)rev); } }
    rowop(nullptr, p.in[I_X], nullptr, hn, (float*)(ws + WS_XSB), nullptr, p.in[I_MIXPRE], gw, NGW, lane);
    }
    if (ws == nullptr) grid.sync();
    GRID_BAR();
    }

#pragma nounroll
    for (int layer = 0; layer < 4; ++layer) {
#pragma nounroll
        for (int op = 0; op < 10; ++op) {
            FRESH();
            const int j = layer >> 1; const bool lru = (layer & 1) != 0;
            const u16* wtm = (const u16*)(ws + WT_MLA(j)); const u16* wtl = (const u16*)(ws + WT_LRU(j)); const u16* wtf = (const u16*)(ws + WT_FFN(layer));
            int gk = 0;
            pg8::Gemm g{}; pg8::EpiB E{};
            if (op == 6 || op == 9) continue;
            const float* gprev = p.in[op == 5 ? I_MIXPRE : I_FFNPRE] + layer * D;
            const float* gpost = p.in[op == 5 ? I_MIXPOST : I_FFNPOST] + layer * D;
            const float* gpre = op == 5 ? p.in[I_FFNPRE] + layer * D : (layer < 3 ? p.in[I_MIXPRE] + (layer + 1) * D : nullptr);
            if (op == 7) { gk = 1; g = pg8::Gemm{hn, wtf, M, 4096, 1024, 1024, 1024, 0}; E = pg8::EpiB{(u16*)U, 4096, 0, 0, 1, nullptr}; }
            else if (op == 8) { gk = 3; g = pg8::Gemm{(const u16*)U, wtf + OFF_DOWN / 2, M, 1024, 4096, 4096, 4096, 0}; }
            else if (!lru) {
                u16* proj = (u16*)(U + U_PROJ); u16* cq = (u16*)(U + U_CQ); u16* ckv = (u16*)(U + U_CKV); u16* kr = (u16*)(U + U_KR); u16* q = (u16*)(U + U_Q); u16* o = (u16*)(U + U_O); u16* kv = ybuf;
                if (op == 0) { gk = 1; g = pg8::Gemm{hn, wtm, M, 768, 1024, 1024, 1024, 0}; E = pg8::EpiB{proj, 768, 0, 0, 0, nullptr}; }
                else if (op == 1) for (int rep = 0; rep < PROBE_THIN_REPS; ++rep) qkvnorm(proj, cq, ckv, kr, p.in[I_MLA_QN] + j * 384, p.in[I_MLA_KVN] + j * 256, ctab, stab, (const float*)(ws + WS_XSB), gw, NGW, lane);
                else if (op == 2) { gk = 1; g = pg8::Gemm{cq, wtm + OFF_UQ / 2, M, 1536, 384, 384, 384, 0}; E = pg8::EpiB{q, 1536, 0, 0, 0, nullptr}; }
                else if (op == 3) { gk = 1; g = pg8::Gemm{ckv, wtm + OFF_UKV / 2, M, 2048, 256, 256, 256, 0}; E = pg8::EpiB{kv, 2048, 0, 0, 0, nullptr}; }
                else if (op == 4) { const att::Tensors T{q, kv, kr, o, ctab, stab}; for (int rep = 0; rep < PROBE_ATT_REPS; ++rep) att::attn_phase((char*)lds, T, tid); }
                else { gk = 3; g = pg8::Gemm{o, wtm + OFF_WO / 2, M, 1024, 1024, 1024, 1024, 0}; }
            } else {
                u16* gate = (u16*)(U + U_GATE); u16* xc = (u16*)(U + U_XC); u16* rec = (u16*)(U + U_REC); u16* Bb = (u16*)(U + U_B); u16* Ab = (u16*)(U + U_LA); u16* hg = xc;
                if (op == 0) { gk = 1; g = pg8::Gemm{hn, wtl, M, 2048, 1024, 1024, 1024, 0}; E = pg8::EpiB{gate, 1024, 1024, (size_t)(U_REC - U_GATE) / 2, 2, (const float*)(ws + WS_XSB)}; }
                else if (op == 1) for (int rep = 0; rep < PROBE_THIN_REPS; ++rep) conv_phase(rec, xc, p.in[I_LRU_CW] + j * 4 * D, p.in[I_LRU_CB] + j * D, gtid, NGT);
                else if (op == 2) { gk = 2; g = pg8::Gemm{xc, wtl + OFF_GT / 2, M, 2048, 256, 1024, 256, 512}; }
                else if (op == 3) for (int rep = 0; rep < PROBE_THIN_REPS; ++rep) scanA(Ab, Bb, SA, SB, tid);
                else if (op == 4) for (int rep = 0; rep < PROBE_THIN_REPS; ++rep) scanC(Ab, Bb, SA, SB, gate, hg, tid);
                else { gk = 3; g = pg8::Gemm{hg, wtl + OFF_LOUT / 2, M, 1024, 1024, 1024, 1024, 0}; }
            }
            for (int rep = 0; rep < PROBE_GEMM_REPS; ++rep)
            if (gk == 1) { pg8::StaticOrder S; S.init(g.M, g.N, G, (int)blockIdx.x);
                pg8::gemm_phase<pg8::EpiB, pg8::StaticOrder, true>((PG8_LAS unsigned char*)lds, g, S, E, tid); }
            else if (gk == 2) { pg8::StaticOrder S; S.init(g.M, g.N, G, (int)blockIdx.x);
                const pg8::EpiGate EG{(const u16*)(U + U_XC), (u16*)(U + U_LA), (u16*)(U + U_B), p.in[I_LRU_BA] + j * D, p.in[I_LRU_BX] + j * D, p.in[I_LRU_LAM] + j * D};
                pg8::gemm_phase<pg8::EpiGate, pg8::StaticOrder, true>((PG8_LAS unsigned char*)lds, g, S, EG, tid); }
            else if (gk == 3) { pg8::StaticOrder S; S.init(g.M, g.N, G, (int)blockIdx.x);
                const unsigned target = 32u * (unsigned)(layer * 2 + (op == 8 ? 2 : 1));
                const pg8::RowStats st1{(float*)(ws + WS_XS1), (unsigned*)(ws + WS_CNT1), target};
                const pg8::EpiNormRes EN{hn, (float*)(ws + (op == 8 ? WS_XSB : WS_XSA)), x, gprev, gpost, gpre, st1, (PG8_LAS unsigned char*)lds + XL_OFF, op == 8 ? (const float*)(ws + WS_XSA) : nullptr};
                pg8::gemm_phase<pg8::EpiNormRes, pg8::StaticOrder, true>((PG8_LAS unsigned char*)lds, g, S, EN, tid); }
            if (!(layer == 3 && op == 8) && !(!lru && op == 2)) { for (int rep = 0; rep < PROBE_SYNC_REPS; ++rep) GRID_BAR(); }
        }
    }
}
}

extern "C" void kernel_launch(void* const* d_in, const int* in_sizes, int n_in, void* d_out, int out_size, void* d_ws, size_t ws_size, hipStream_t stream) {
    static int grid = 0;
    if (grid == 0) {
        if (n_in != 23 || in_sizes[0] != mk::M * mk::D || out_size != mk::M * mk::D || ws_size < mk::WS_END) {
            fprintf(stderr, "kernel_launch: unexpected shapes (n_in %d, in0 %d, out %d, ws %zu); nothing launched\n", n_in, n_in > 0 ? in_sizes[0] : -1, out_size, ws_size); grid = -1; return; }
        int dev = 0, cus = 0, per_cu = 0;
        (void)hipGetDevice(&dev); (void)hipDeviceGetAttribute(&cus, hipDeviceAttributeMultiprocessorCount, dev);
        if (hipFuncSetAttribute((const void*)mk::fwd_mega, hipFuncAttributeMaxDynamicSharedMemorySize, mk::LDS_BYTES) != hipSuccess) { fprintf(stderr, "kernel_launch: hipFuncSetAttribute failed\n"); grid = -1; return; }
        if (hipOccupancyMaxActiveBlocksPerMultiprocessor(&per_cu, (const void*)mk::fwd_mega, 512, mk::LDS_BYTES) != hipSuccess || per_cu < 1) { fprintf(stderr, "kernel_launch: occupancy query says %d blocks per CU\n", per_cu); per_cu = 1; }
        (void)hipGetLastError();
        grid = cus > 0 ? cus : 256;
    }
    if (grid < 0) return;
    mk::Params p{};
    for (int i = 0; i < 23; ++i) p.in[i] = (const float*)d_in[i];
    p.out = (float*)d_out; p.ws = (unsigned char*)d_ws;
    if (hipMemsetAsync((char*)d_ws + mk::WS_BAR, 0, mk::CTL_BYTES, stream) != hipSuccess) { fprintf(stderr, "kernel_launch: hipMemsetAsync failed\n"); return; }
    void* args[] = {&p};
    hipError_t e = hipLaunchCooperativeKernel((const void*)mk::fwd_mega, dim3(grid), dim3(512), args, mk::LDS_BYTES, stream);
    if (e != hipSuccess) fprintf(stderr, "kernel_launch: cooperative launch failed: %s (grid %d)\n", hipGetErrorString(e), grid);
}
```

```cpp
#include <hip/hip_runtime.h>
#include <hip/hip_bf16.h>
#include <hip/hip_cooperative_groups.h>
#include <cstdio>
#include <cstdint>
namespace cg = cooperative_groups;

__device__ __forceinline__ float xor1f(float v)  { return __int_as_float(__builtin_amdgcn_mov_dpp(__float_as_int(v), 0xB1, 0xF, 0xF, false)); }
__device__ __forceinline__ float xor2f(float v)  { return __int_as_float(__builtin_amdgcn_mov_dpp(__float_as_int(v), 0x4E, 0xF, 0xF, false)); }
__device__ __forceinline__ float xor4f(float v)  { return __int_as_float(__builtin_amdgcn_ds_swizzle(__float_as_int(v), 0x101F)); }
__device__ __forceinline__ float xor8f(float v)  { return __int_as_float(__builtin_amdgcn_ds_swizzle(__float_as_int(v), 0x201F)); }
__device__ __forceinline__ float xor16f(float v) { return __int_as_float(__builtin_amdgcn_ds_swizzle(__float_as_int(v), 0x401F)); }
__device__ __forceinline__ float sum32f(float v) { auto rr = __builtin_amdgcn_permlane32_swap(__float_as_uint(v), __float_as_uint(v), false, false); return __uint_as_float(rr[0]) + __uint_as_float(rr[1]); }
__device__ __forceinline__ int lane_id_fresh() { int l; asm volatile("v_mbcnt_lo_u32_b32 %0, -1, 0\n\tv_mbcnt_hi_u32_b32 %0, -1, %0" : "=v"(l)); return l; }
namespace pg8 {
#define PG8_LAS __attribute__((address_space(3)))
typedef unsigned short bf16_t;
typedef short bf16x8 __attribute__((ext_vector_type(8)));
typedef float f32x4 __attribute__((ext_vector_type(4)));
typedef unsigned u32x4 __attribute__((ext_vector_type(4)));
constexpr int BM = 256, BK = 64, HALF = 128, HTB = HALF * BK * 2  , STAGE_BYTES = 8 * HTB, NXCD = 8, WGM = 8;

__host__ __device__ __forceinline__ int lds_byte(int r, int c) { const int st = (r >> 4) * 2 + (c >> 5), rr = r & 15, cc = c & 31, ob = rr * 64 + cc * 2; return st * 1024 + (ob ^ (((ob >> 9) & 1) << 5)); }
__host__ __device__ __forceinline__ void stage_rc(int b, int& R, int& C) { const int st = b / 1024, sb = b % 1024, swz = sb ^ (((sb >> 9) & 1) << 5); R = (st >> 1) * 16 + swz / 64; C = (st & 1) * 32 + (swz % 64) / 2; }
__host__ __device__ __forceinline__ int perm32(int rho) { const int n = rho >> 4, i = rho & 15; return 8 * (i >> 2) + 4 * n + (i & 3); }

struct Unit { int pm, pn; };
struct Gemm { const bf16_t* A; const bf16_t* Bt; int M, N, K; int lda, ldb; int apn; };

struct StaticOrder {
    int nM, nN, nwg, G, c;
    __host__ __device__ void init(int M, int N, int G_, int c_) { nM = M / BM; nN = N / BM; nwg = nM * nN; G = G_; c = c_; }
    __host__ __device__ bool next(int i, Unit& u) const {
        const long L = (long)i * G + c; if (L >= nwg) return false;
        int wgid = (int)L; { const int q = nwg / NXCD, r = nwg % NXCD, xcd = wgid % NXCD, off = wgid / NXCD; wgid = (xcd < r ? xcd * (q + 1) : r * (q + 1) + (xcd - r) * q) + off; }
        const int nig = WGM * nN, gid = wgid / nig, fm = gid * WGM, gsz = (nM - fm) < WGM ? (nM - fm) : WGM;
        u.pm = fm + ((wgid % nig) % gsz); u.pn = (wgid % nig) / gsz; return true;
    }
    __device__ __forceinline__ void a_ready(const Unit&) const {}
    __device__ __forceinline__ void done(const Unit&) const {}
};

__device__ __forceinline__ unsigned cvt_pk_bf16(float lo, float hi) { unsigned r; asm volatile("v_cvt_pk_bf16_f32 %0, %1, %2" : "=v"(r) : "v"(lo), "v"(hi)); return r; }
__device__ __forceinline__ float gelu_tanh(float x) {
    const float z = 0.7978845608028654f * (x + 0.044715f * x * x * x);
    const float e = __expf(2.0f * z);
    const float th = 1.0f - 2.0f * __builtin_amdgcn_rcpf(1.0f + e);
    return 0.5f * x * (1.0f + th);
}
struct EpiB {
    static constexpr bool PERM = true, AFTER_DRAIN = false, FUSED = false;
    bf16_t* O; int ldc; int split_cols; size_t split_stride; int mode;
    const float* rss;
    __device__ __forceinline__ void operator()(const f32x4 (&acc)[2][2][4][2], const Unit& u, int wr, int wc, int fr, int fq) const {
        const int row0 = u.pm * BM + wr * 64 + fr; int colt = u.pn * BM; bf16_t* base = O; int t = 0;
        if (split_cols) { t = colt / split_cols; base += (size_t)t * split_stride; colt -= t * split_cols; }
        const int act = (mode == 1) ? 1 : ((mode == 2 && t == 0) ? 2 : 0);
        const int col0 = colt + wc * 32 + 8 * fq;
#pragma unroll
        for (int ai = 0; ai < 2; ++ai)
#pragma unroll
            for (int m = 0; m < 4; ++m) { bf16_t* rowp = base + (size_t)(row0 + ai * HALF + m * 16) * ldc + col0;
                float rsc = 1.0f; if (rss) { const f32x4 pp = *(const f32x4*)(rss + (size_t)(row0 + ai * HALF + m * 16) * 4); rsc = rsqrtf(((pp[0] + pp[1]) + (pp[2] + pp[3])) * (1.0f / 1024.0f) + 1e-6f); }
#pragma unroll
                for (int bj = 0; bj < 2; ++bj) { f32x4 v0 = acc[ai][bj][m][0] * rsc, v1 = acc[ai][bj][m][1] * rsc;
                    if (act == 1) {
#pragma unroll
                        for (int e = 0; e < 4; ++e) { const float a = fmaxf(v0[e], 0.f), b = fmaxf(v1[e], 0.f); v0[e] = a * a; v1[e] = b * b; } }
                    else if (act == 2) {
#pragma unroll
                        for (int e = 0; e < 4; ++e) { v0[e] = gelu_tanh(v0[e]); v1[e] = gelu_tanh(v1[e]); } }
                    u32x4 w; w.x = cvt_pk_bf16(v0[0], v0[1]); w.y = cvt_pk_bf16(v0[2], v0[3]); w.z = cvt_pk_bf16(v1[0], v1[1]); w.w = cvt_pk_bf16(v1[2], v1[3]);
                    *(u32x4*)(rowp + bj * HALF) = w; } }
    }
};
__device__ __forceinline__ float bf2f(unsigned short h) { return __uint_as_float(((unsigned)h) << 16); }
__device__ __forceinline__ float sigmoidf_(float x) { return __builtin_amdgcn_rcpf(1.0f + __expf(-x)); }
__device__ __forceinline__ float one_minus_exp(float t) { const float ser = -t * (1.0f + t * (0.5f + t * (0.16666667f + t * (0.041666668f + t * 0.008333334f)))); return t > -0.25f ? ser : 1.0f - __expf(t); }
struct EpiGate {
    static constexpr bool PERM = false, AFTER_DRAIN = false, FUSED = false;
    const bf16_t* xc; bf16_t* Aout; bf16_t* Bout; const float* b_a; const float* b_x; const float* lam;
    __device__ __forceinline__ void operator()(const f32x4 (&acc)[2][2][4][2], const Unit& u, int wr, int wc, int fr, int fq) const {
#pragma unroll
        for (int n = 0; n < 2; ++n) {
            const int ch0 = 128 * u.pn + 32 * wc + 16 * n + 4 * fq;
            const f32x4 ba = *(const f32x4*)(b_a + ch0), bx = *(const f32x4*)(b_x + ch0), lm = *(const f32x4*)(lam + ch0);
            f32x4 sp;
#pragma unroll
            for (int e = 0; e < 4; ++e) sp[e] = -8.0f * log1pf(__expf(-lm[e]));
#pragma unroll
            for (int ai = 0; ai < 2; ++ai)
#pragma unroll
                for (int m = 0; m < 4; ++m) {
                    const size_t off = (size_t)(u.pm * BM + ai * HALF + wr * 64 + m * 16 + fr) * 1024 + ch0;
                    const uint2 xr = *(const uint2*)(xc + off);
                    float xv[4] = { __uint_as_float(xr.x << 16), __uint_as_float(xr.x & 0xffff0000u), __uint_as_float(xr.y << 16), __uint_as_float(xr.y & 0xffff0000u) };
                    f32x4 av, bv;
#pragma unroll
                    for (int e = 0; e < 4; ++e) {
                        const float r = sigmoidf_(acc[ai][0][m][n][e] + ba[e]);
                        const float ig = sigmoidf_(acc[ai][1][m][n][e] + bx[e]);
                        const float la = sp[e] * r;
                        av[e] = la;
                        bv[e] = __builtin_amdgcn_sqrtf(fmaxf(one_minus_exp(2.0f * la), 0.f)) * (ig * xv[e]);
                    }
                    uint2 wa, wb; wa.x = cvt_pk_bf16(av[0], av[1]); wa.y = cvt_pk_bf16(av[2], av[3]); wb.x = cvt_pk_bf16(bv[0], bv[1]); wb.y = cvt_pk_bf16(bv[2], bv[3]);
                    *(uint2*)(Aout + off) = wa; *(uint2*)(Bout + off) = wb;
                }
        }
    }
};

struct RowStats {
    float* xbuf;
    unsigned* cnt;
    unsigned target;
    __device__ __forceinline__ void run(const f32x4 (&v)[2][2][4][2], const Unit& u, int wr, int wc, int fr, int fq, PG8_LAS unsigned char* xl, int wid, int lane) const {
        PG8_LAS float* P = (PG8_LAS float*)xl;
        PG8_LAS float* S = (PG8_LAS float*)(xl + 4096);
#pragma unroll
        for (int ai = 0; ai < 2; ++ai)
#pragma unroll
            for (int m = 0; m < 4; ++m) {
                float s = 0.f;
#pragma unroll
                for (int bj = 0; bj < 2; ++bj)
#pragma unroll
                    for (int n = 0; n < 2; ++n) { const f32x4 x = v[ai][bj][m][n]; s += (x[0] * x[0] + x[1] * x[1]) + (x[2] * x[2] + x[3] * x[3]); }
                s += xor16f(s); s = sum32f(s);
                if (fq == 0) P[(ai * HALF + wr * 64 + m * 16 + fr) * 4 + wc] = s;
            }
        asm volatile("s_waitcnt lgkmcnt(0)" ::: "memory"); __builtin_amdgcn_s_barrier(); asm volatile("" ::: "memory");
        const int row = wid * 32 + (lane & 31);
        if (lane < 32) { const float t = (P[row * 4 + 0] + P[row * 4 + 1]) + (P[row * 4 + 2] + P[row * 4 + 3]);
            __hip_atomic_store(xbuf + (size_t)(u.pm * BM + row) * 4 + u.pn, t, __ATOMIC_RELAXED, __HIP_MEMORY_SCOPE_AGENT); }
        asm volatile("s_waitcnt vmcnt(0)" ::: "memory");
        if (lane == 0) __hip_atomic_fetch_add(cnt + 64 * u.pm, 1u, __ATOMIC_RELAXED, __HIP_MEMORY_SCOPE_AGENT);
        if (wid == 0) { unsigned sp = 0;
            while ((unsigned)__builtin_amdgcn_readfirstlane(__hip_atomic_load(cnt + 64 * u.pm, __ATOMIC_RELAXED, __HIP_MEMORY_SCOPE_AGENT)) < target) { __builtin_amdgcn_s_sleep(2); if (++sp > (1u << 18)) break; }
            __builtin_amdgcn_fence(__ATOMIC_ACQUIRE, "agent"); }
        asm volatile("s_waitcnt vmcnt(0) lgkmcnt(0)" ::: "memory"); __builtin_amdgcn_s_barrier(); asm volatile("" ::: "memory");
        if (lane < 32) { float* slot = xbuf + (size_t)(u.pm * BM + row) * 4; float t = 0.f;
#pragma unroll
            for (int k = 0; k < 4; ++k) t += __hip_atomic_load(slot + k, __ATOMIC_RELAXED, __HIP_MEMORY_SCOPE_AGENT);
            S[row] = t; }
        asm volatile("s_waitcnt lgkmcnt(0)" ::: "memory"); __builtin_amdgcn_s_barrier(); asm volatile("" ::: "memory");
    }
};
struct EpiNormRes {
    static constexpr bool PERM = false, AFTER_DRAIN = false, FUSED = true;
    bf16_t* hn; float* xs2; float* out; const float* gprev; const float* gpost; const float* gpre; RowStats st1; PG8_LAS unsigned char* xl;
    const float* s_in;
    __device__ __forceinline__ void fused(f32x4 (&acc)[2][2][4][2], const Unit& u, int wr, int wc, int fr, int fq, int wid, int lane) const {
        typedef unsigned u32x2v __attribute__((ext_vector_type(2)));
        PG8_LAS float* P = (PG8_LAS float*)xl;
        const PG8_LAS float* S = (const PG8_LAS float*)(xl + 4096);
        const int col0 = u.pn * BM + wc * 32 + 4 * fq;
        st1.run(acc, u, wr, wc, fr, fq, xl, wid, lane);
#pragma unroll
        for (int ai = 0; ai < 2; ++ai)
#pragma unroll
            for (int m = 0; m < 4; ++m) { const int r = ai * HALF + wr * 64 + m * 16 + fr; float rstd = rsqrtf(S[r] * (1.0f / 1024.0f) + 1e-6f); const size_t off = (size_t)(u.pm * BM + r) * 1024 + col0;
                if (s_in) { const f32x4 pp = *(const f32x4*)(s_in + (size_t)(u.pm * BM + r) * 4); const float s2 = __builtin_amdgcn_rcpf(((pp[0] + pp[1]) + (pp[2] + pp[3])) * (1.0f / 1024.0f) + 1e-6f);
                    rstd = rsqrtf(S[r] * (1.0f / 1024.0f) * s2 * s2 + 1e-6f) * s2; }
#pragma unroll
                for (int bj = 0; bj < 2; ++bj)
#pragma unroll
                    for (int n = 0; n < 2; ++n) { const u32x2v hw = *(const u32x2v*)(hn + off + bj * HALF + n * 16);
                        const f32x4 gp = *(const f32x4*)(gprev + col0 + bj * HALF + n * 16); const f32x4 gv = *(const f32x4*)(gpost + col0 + bj * HALF + n * 16);
                        f32x4 xs; xs[0] = __uint_as_float(hw.x << 16) * __builtin_amdgcn_rcpf(gp[0]); xs[1] = __uint_as_float(hw.x & 0xffff0000u) * __builtin_amdgcn_rcpf(gp[1]);
                        xs[2] = __uint_as_float(hw.y << 16) * __builtin_amdgcn_rcpf(gp[2]); xs[3] = __uint_as_float(hw.y & 0xffff0000u) * __builtin_amdgcn_rcpf(gp[3]);
                        acc[ai][bj][m][n] = xs + (acc[ai][bj][m][n] * rstd) * gv; }
                asm volatile("" : "+v"(acc[ai][0][m][0]), "+v"(acc[ai][0][m][1]), "+v"(acc[ai][1][m][0]), "+v"(acc[ai][1][m][1]));
                if (m & 1) asm volatile("" ::: "memory"); }
        if (gpre) {
#pragma unroll
            for (int ai = 0; ai < 2; ++ai)
#pragma unroll
                for (int m = 0; m < 4; ++m) {
                    float s = 0.f;
#pragma unroll
                    for (int bj = 0; bj < 2; ++bj)
#pragma unroll
                        for (int n = 0; n < 2; ++n) { const f32x4 x = acc[ai][bj][m][n]; s += (x[0] * x[0] + x[1] * x[1]) + (x[2] * x[2] + x[3] * x[3]); }
                    s += xor16f(s); s = sum32f(s);
                    if (fq == 0) P[(ai * HALF + wr * 64 + m * 16 + fr) * 4 + wc] = s;
                }
            asm volatile("s_waitcnt lgkmcnt(0)" ::: "memory"); __builtin_amdgcn_s_barrier(); asm volatile("" ::: "memory");
            { const int row = wid * 32 + (lane & 31);
              if (lane < 32) xs2[(size_t)(u.pm * BM + row) * 4 + u.pn] = (P[row * 4 + 0] + P[row * 4 + 1]) + (P[row * 4 + 2] + P[row * 4 + 3]); }
#pragma unroll
            for (int ai = 0; ai < 2; ++ai)
#pragma unroll
                for (int m = 0; m < 4; ++m) { const int r = ai * HALF + wr * 64 + m * 16 + fr; const size_t off = (size_t)(u.pm * BM + r) * 1024 + col0;
#pragma unroll
                    for (int bj = 0; bj < 2; ++bj)
#pragma unroll
                        for (int n = 0; n < 2; ++n) { const f32x4 gv = *(const f32x4*)(gpre + col0 + bj * HALF + n * 16); const f32x4 o = acc[ai][bj][m][n] * gv;
                            u32x2v w; w.x = cvt_pk_bf16(o[0], o[1]); w.y = cvt_pk_bf16(o[2], o[3]); *(u32x2v*)(hn + off + bj * HALF + n * 16) = w; }
                    asm volatile("" ::: "memory"); }
            asm volatile("s_waitcnt lgkmcnt(0)" ::: "memory"); __builtin_amdgcn_s_barrier(); asm volatile("" ::: "memory");
        } else {
#pragma unroll
            for (int ai = 0; ai < 2; ++ai)
#pragma unroll
                for (int m = 0; m < 4; ++m) { const int r = ai * HALF + wr * 64 + m * 16 + fr; const size_t off = (size_t)(u.pm * BM + r) * 1024 + col0;
#pragma unroll
                    for (int bj = 0; bj < 2; ++bj)
#pragma unroll
                        for (int n = 0; n < 2; ++n) *(f32x4*)(out + off + bj * HALF + n * 16) = acc[ai][bj][m][n]; }
        }
    }
};

template <class Epi, class Sched, bool ALIGN_EPI>
__device__ __forceinline__ void gemm_phase(PG8_LAS unsigned char* lds, const Gemm g, const Sched& S, const Epi& E, int tid0) {
    int tid_ = tid0; asm volatile("" : "+v"(tid_));
    const int tid = tid_, wid = __builtin_amdgcn_readfirstlane(tid >> 6), lane = tid & 63, wr = wid >> 2, wc = wid & 3, fr = lane & 15, fq = lane >> 4;
    const int K = g.K, nt = K / BK;
    unsigned voffA[2], voffB[2];
#pragma unroll
    for (int i = 0; i < 2; ++i) { int R, C; stage_rc(tid * 16 + i * 8192, R, C); const int Rb = Epi::PERM ? ((R & ~31) + perm32(R & 31)) : R;
        voffA[i] = (unsigned)(R * g.lda + C) * 2u; voffB[i] = (unsigned)(Rb * g.ldb + C) * 2u; }
    const size_t kstep = (size_t)(BK * 2);
    const size_t hstepA = (size_t)HALF * g.lda * 2, hstepB = (size_t)HALF * g.ldb * 2;
    const size_t tstepA = 2 * hstepA, tstepB = 2 * hstepB;
    const unsigned ldsw = (unsigned)wid * 1024u;
    const int aoff = lds_byte(wr * 64 + fr, fq * 8), boff = lds_byte(wc * 32 + fr, fq * 8);
#define PG8_SA(b, h) (((b) * 2 + (h)) * HTB)
#define PG8_SB(b, h) ((4 + (b) * 2 + (h)) * HTB)
#define PG8_STAGE(bufoff, gbase, voff) do { _Pragma("unroll") for (int _i = 0; _i < 2; ++_i) \
        __builtin_amdgcn_global_load_lds((const unsigned*)((const char*)(gbase) + (voff)[_i]), (PG8_LAS unsigned*)(lds + (bufoff) + ldsw + _i * 8192), 16, 0, 0); } while (0)
#define PG8_LDA(dst, b, h) do { _Pragma("unroll") for (int m = 0; m < 4; ++m) _Pragma("unroll") for (int k = 0; k < 2; ++k) dst[m][k] = *(const PG8_LAS bf16x8*)(lds + PG8_SA(b, h) + aoff + m * 2048 + k * 1024); } while (0)
#define PG8_LDB(dst, b, h) do { _Pragma("unroll") for (int n = 0; n < 2; ++n) _Pragma("unroll") for (int k = 0; k < 2; ++k) dst[n][k] = *(const PG8_LAS bf16x8*)(lds + PG8_SB(b, h) + boff + n * 2048 + k * 1024); } while (0)
#define PG8_MMA(ai, bj, At, Bt) do { __builtin_amdgcn_s_setprio(1); _Pragma("unroll") for (int m = 0; m < 4; ++m) _Pragma("unroll") for (int n = 0; n < 2; ++n) _Pragma("unroll") for (int k = 0; k < 2; ++k) \
        acc[ai][bj][m][n] = __builtin_amdgcn_mfma_f32_16x16x32_bf16(Bt[n][k], At[m][k], acc[ai][bj][m][n], 0, 0, 0); __builtin_amdgcn_s_setprio(0); } while (0)
#define PG8_WAIT_V(n) asm volatile("s_waitcnt vmcnt(" #n ")" ::: "memory")
#define PG8_WAIT_L(n) asm volatile("s_waitcnt lgkmcnt(" #n ")" ::: "memory")
#define PG8_BAR __builtin_amdgcn_s_barrier()
#define PG8_SCHED __builtin_amdgcn_sched_barrier(0)
    Unit cur, nxt; int ui = 0;
    if (!S.next(0, cur)) return;
    f32x4 acc[2][2][4][2];
#pragma unroll
    for (int a = 0; a < 2; ++a)
#pragma unroll
        for (int b = 0; b < 2; ++b)
#pragma unroll
            for (int m = 0; m < 4; ++m)
#pragma unroll
                for (int n = 0; n < 2; ++n) acc[a][b][m][n] = (f32x4){0.f, 0.f, 0.f, 0.f};
    bf16x8 At[4][2], B0[2][2], B1[2][2];
    const char* cA = (const char*)g.A + (size_t)cur.pm * tstepA + (size_t)(cur.pn >> 1) * (size_t)g.apn; const char* cB = (const char*)g.Bt + (size_t)cur.pn * tstepB;
    S.a_ready(cur);
    PG8_STAGE(PG8_SB(0, 0), cB, voffB); PG8_STAGE(PG8_SB(0, 1), cB + hstepB, voffB); PG8_STAGE(PG8_SA(0, 0), cA, voffA); PG8_STAGE(PG8_SA(0, 1), cA + hstepA, voffA);
    if (wr == 1) PG8_BAR;
    PG8_WAIT_V(2); PG8_BAR;
    PG8_STAGE(PG8_SB(1, 0), cB + kstep, voffB); PG8_STAGE(PG8_SA(1, 0), cA + kstep, voffA); PG8_STAGE(PG8_SB(1, 1), cB + hstepB + kstep, voffB);
    PG8_WAIT_V(6); PG8_BAR;
    for (;;) {
        const bool has_next = S.next(ui + 1, nxt);
        const char* nA = has_next ? (const char*)g.A + (size_t)nxt.pm * tstepA + (size_t)(nxt.pn >> 1) * (size_t)g.apn : cA; const char* nB = has_next ? (const char*)g.Bt + (size_t)nxt.pn * tstepB : cB;
        for (int t = 0; t < nt; t += 2) {
            const bool last = (t == nt - 2);
            const char* a1 = cA + (size_t)(t + 1) * kstep;
            const char* a2 = last ? nA : cA + (size_t)(t + 2) * kstep; const char* b2 = last ? nB : cB + (size_t)(t + 2) * kstep;
            const char* a3 = a2 + kstep; const char* b3 = b2 + kstep;
            if (last && has_next) S.a_ready(nxt);
            PG8_LDB(B0, 0, 0); PG8_LDB(B1, 0, 1); PG8_SCHED; PG8_LDA(At, 0, 0); PG8_STAGE(PG8_SA(1, 1), a1 + hstepA, voffA);
            PG8_WAIT_V(8); PG8_WAIT_L(0); PG8_BAR; PG8_MMA(0, 0, At, B0); PG8_MMA(0, 1, At, B1); PG8_BAR; PG8_SCHED;
            PG8_LDA(At, 0, 1); PG8_STAGE(PG8_SB(0, 0), b2, voffB); PG8_STAGE(PG8_SB(0, 1), b2 + hstepB, voffB); PG8_STAGE(PG8_SA(0, 0), a2, voffA);
            PG8_WAIT_V(8); PG8_WAIT_L(0); PG8_BAR; PG8_MMA(1, 0, At, B0); PG8_MMA(1, 1, At, B1); PG8_BAR; PG8_SCHED;
            PG8_LDB(B0, 1, 0); PG8_LDB(B1, 1, 1); PG8_SCHED; PG8_LDA(At, 1, 0); PG8_STAGE(PG8_SA(0, 1), a2 + hstepA, voffA);
            PG8_WAIT_V(8); PG8_WAIT_L(0); PG8_BAR; PG8_MMA(0, 0, At, B0); PG8_MMA(0, 1, At, B1); PG8_BAR; PG8_SCHED;
            PG8_LDA(At, 1, 1); PG8_STAGE(PG8_SB(1, 0), b3, voffB); PG8_STAGE(PG8_SB(1, 1), b3 + hstepB, voffB); PG8_STAGE(PG8_SA(1, 0), a3, voffA);
            PG8_WAIT_V(8); PG8_WAIT_L(0); PG8_BAR; PG8_MMA(1, 0, At, B0); PG8_MMA(1, 1, At, B1); PG8_BAR; PG8_SCHED;
        }
        if constexpr (ALIGN_EPI) { if (wr == 0) PG8_BAR; }
        if constexpr (Epi::FUSED) E.fused(acc, cur, wr, wc, fr, fq, wid, lane); else E(acc, cur, wr, wc, fr, fq);
        S.done(cur);
        if (!has_next) break;
#pragma unroll
        for (int a = 0; a < 2; ++a)
#pragma unroll
            for (int b = 0; b < 2; ++b)
#pragma unroll
                for (int m = 0; m < 4; ++m)
#pragma unroll
                    for (int n = 0; n < 2; ++n) acc[a][b][m][n] = (f32x4){0.f, 0.f, 0.f, 0.f};
        cur = nxt; cA = nA; cB = nB; ++ui;
        if constexpr (ALIGN_EPI) { if (wr == 1) PG8_BAR; }
    }
    PG8_WAIT_V(0);
    if constexpr (!ALIGN_EPI) { if (wr == 0) PG8_BAR; }
    PG8_BAR;
#undef PG8_SA
#undef PG8_SB
#undef PG8_STAGE
#undef PG8_LDA
#undef PG8_LDB
#undef PG8_MMA
#undef PG8_WAIT_V
#undef PG8_WAIT_L
#undef PG8_BAR
#undef PG8_SCHED
}
}
namespace att {
typedef unsigned short u16;
typedef short bf16x8 __attribute__((ext_vector_type(8)));
typedef short s16x4 __attribute__((ext_vector_type(4)));
typedef float f32x16 __attribute__((ext_vector_type(16)));
typedef float f32x4 __attribute__((ext_vector_type(4)));
typedef unsigned u32x4 __attribute__((ext_vector_type(4)));
constexpr int SEQ = 16384, NW = 8, QBLK = 32, KVBLK = 64, QB = NW * QBLK;
constexpr int LDQ = 1536, LDK = 2048, LDKR = 64, LDO = 1024;
#ifndef ATT_NQREG
#define ATT_NQREG 6
#endif
constexpr int NQREG = ATT_NQREG, NQREG_L = 8 - NQREG;
constexpr int SHM_V = KVBLK * 128 * 2, SHM_K = KVBLK * 128 * 2, SHM_KR = KVBLK * 64 * 2;
constexpr int OFF_V = 0, OFF_K = 2 * SHM_V, OFF_KR = OFF_K + 2 * SHM_K, OFF_WS = OFF_KR + 2 * SHM_KR, OFF_QR = OFF_WS + NW * 64 * 4, QR_WAVE = (NQREG_L + 4) * 1024, LDS_BYTES = OFF_QR + NW * QR_WAVE;
constexpr float SCALE = 0.07216878364870322f;
constexpr float THR = 8.f;

#define KSWZ(row, colB) ((row) * 256 + ((colB) ^ (((row) & 7) << 4)))
#define KRSWZ(row, colB) ((row) * 128 + ((colB) ^ (((row) & 7) << 4)))
#define SBAR() __builtin_amdgcn_sched_barrier(0)
__device__ __forceinline__ int v_st(int k, int c) { const int kk = (k & ~0xC) | ((k & 4) << 1) | ((k & 8) >> 1); return ((kk >> 3) * 4 + (c >> 5)) * 512 + ((kk & 7) * 32 + (c & 31)) * 2; }
__device__ __forceinline__ int v_rd_base(int lane) { return ((lane & 3) << 3) | (((lane >> 2) & 3) << 6) | (((lane >> 4) & 1) << 5) | (((lane >> 5) & 1) << 8); }
constexpr int v_rd_off(int d0, int ks, int half) { return d0 * 512 + ks * 4096 + half * 2048; }
__device__ __forceinline__ int crow(int r, int hi) { return (r & 3) + 8 * (r >> 2) + 4 * hi; }
__device__ __forceinline__ unsigned cvtpk(float lo, float hi) { unsigned r; asm volatile("v_cvt_pk_bf16_f32 %0, %1, %2" : "=v"(r) : "v"(lo), "v"(hi)); return r; }
__device__ __forceinline__ bf16x8 load8(const u16* p) { return *reinterpret_cast<const bf16x8*>(p); }
__device__ __forceinline__ void mask_tile(f32x16& p0, f32x16& p1, int dq, unsigned W) {
    const float NEG = -__builtin_inff();
#pragma unroll
    for (int r = 0; r < 16; ++r) {
        const int c = (r & 3) + 8 * (r >> 2);
        if ((unsigned)(dq - c) >= W) p0[r] = NEG;
        if ((unsigned)(dq - c - 32) >= W) p1[r] = NEG;
    }
}
__device__ __forceinline__ void partialSM(f32x16& p0, f32x16& p1, float& m_reg, float& mn, float& alpha) {
    float pmax = p0[0]; for (int r = 1; r < 16; ++r) pmax = fmaxf(pmax, p0[r]); for (int r = 0; r < 16; ++r) pmax = fmaxf(pmax, p1[r]);
    { auto rr = __builtin_amdgcn_permlane32_swap(__float_as_uint(pmax), __float_as_uint(pmax), false, false);
      pmax = fmaxf(__uint_as_float(rr[0]), __uint_as_float(rr[1])); }
    constexpr float C2 = 1.4426950408889634f * SCALE;
    if (__builtin_expect(__all((pmax - m_reg) * SCALE <= THR), 1)) { mn = m_reg; alpha = 1.f; }
    else { mn = fmaxf(m_reg, pmax); alpha = __builtin_amdgcn_exp2f((m_reg - mn) * C2); m_reg = mn; }
    const float mnL = -mn * C2;
    for (int r = 0; r < 16; ++r) p0[r] = fmaf(p0[r], C2, mnL); for (int r = 0; r < 16; ++r) p1[r] = fmaf(p1[r], C2, mnL);
    for (int r = 0; r < 16; ++r) p0[r] = __builtin_amdgcn_exp2f(p0[r]);
}
__device__ __forceinline__ void finishSM(f32x16& p0, f32x16& p1, float alpha, float& l_reg, bf16x8& pa0, bf16x8& pa1, bf16x8& pa2, bf16x8& pa3) {
    for (int r = 0; r < 16; ++r) p1[r] = __builtin_amdgcn_exp2f(p1[r]);
    float ps = 0; for (int r = 0; r < 16; ++r) ps += p0[r]; for (int r = 0; r < 16; ++r) ps += p1[r];
    { auto rr = __builtin_amdgcn_permlane32_swap(__float_as_uint(ps), __float_as_uint(ps), false, false);
      ps = __uint_as_float(rr[0]) + __uint_as_float(rr[1]); }
    l_reg = l_reg * alpha + ps;
#define PK4(P, B_, OUT) do { unsigned a0 = cvtpk(P[B_+0], P[B_+1]), a1 = cvtpk(P[B_+2], P[B_+3]);                          \
        unsigned b0 = cvtpk(P[B_+4], P[B_+5]), b1 = cvtpk(P[B_+6], P[B_+7]);                                             \
        auto r0 = __builtin_amdgcn_permlane32_swap(a0, b0, false, false); auto r1 = __builtin_amdgcn_permlane32_swap(a1, b1, false, false); \
        u32x4 w = {r0[0], r1[0], r0[1], r1[1]}; OUT = *reinterpret_cast<bf16x8*>(&w); } while (0)
    PK4(p0, 0, pa0); PK4(p0, 8, pa1); PK4(p1, 0, pa2); PK4(p1, 8, pa3);
#undef PK4
}
#ifndef ATT_PF
#define ATT_PF 2
#endif
#define QK_SB() __builtin_amdgcn_sched_barrier(0x406)
#define QK_LOAD(s, SET) do { if ((s) < 8) { const char* a_ = kb[(s) & 3] + ((s) >> 2) * 128; fb0[SET] = *reinterpret_cast<const bf16x8*>(a_); fb1[SET] = *reinterpret_cast<const bf16x8*>(a_ + 32 * 256); \
            if ((s) < NQREG) fq[SET] = qr[(s) < NQREG ? (s) : 0]; else fq[SET] = qrl[((s) - NQREG) * 64]; } \
        else { const char* a_ = krb[((s) - 8) & 3]; fb0[SET] = *reinterpret_cast<const bf16x8*>(a_); fb1[SET] = *reinterpret_cast<const bf16x8*>(a_ + 32 * 128); fq[SET] = qrl[(NQREG_L + (s) - 8) * 64]; } } while (0)
template <int KB>
__device__ __forceinline__ void qkt(f32x16& p0, f32x16& p1, const char* K_lds, const char* KR_lds, const bf16x8* qrl, int r32, int hi, const bf16x8* qr) {
    constexpr int PF = ATT_PF, NS = PF + 1;
    p0 = f32x16{}; p1 = f32x16{};
    const char* kb[4]; const char* krb[4];
#pragma unroll
    for (int dd = 0; dd < 4; ++dd) { kb[dd] = K_lds + KB * SHM_K + KSWZ(r32, (dd * 16 + hi * 8) * 2); krb[dd] = KR_lds + KB * SHM_KR + KRSWZ(r32, (dd * 16 + hi * 8) * 2); }
    bf16x8 fb0[NS], fb1[NS], fq[NS];
#pragma unroll
    for (int s = 0; s < PF; ++s) QK_LOAD(s, s % NS);
#pragma unroll
    for (int s = 0; s < 12; ++s) {
        QK_SB();
        if (s + PF < 12) QK_LOAD(s + PF, (s + PF) % NS);
        QK_SB();
        p0 = __builtin_amdgcn_mfma_f32_32x32x16_bf16(fb0[s % NS], fq[s % NS], p0, 0, 0, 0);
        p1 = __builtin_amdgcn_mfma_f32_32x32x16_bf16(fb1[s % NS], fq[s % NS], p1, 0, 0, 0);
    }
    QK_SB();
}
#undef QK_LOAD
template <int VB>
__device__ __forceinline__ void pv_tile(f32x16* o, int vb0, bf16x8 pa0, bf16x8 pa1, bf16x8 pa2, bf16x8 pa3) {
#define TRRD(dst, off) asm volatile("ds_read_b64_tr_b16 %0, %1 offset:%2" : "=&v"(dst) : "v"(vb0), "i"(off) : "memory")
#define PV_D0(d0) do { s16x4 l0, l1, l2, l3, h0, h1, h2, h3; constexpr int b_ = OFF_V + VB * SHM_V + v_rd_off(d0, 0, 0); \
        TRRD(l0, b_); TRRD(h0, b_ + 2048); TRRD(l1, b_ + 4096); TRRD(h1, b_ + 6144); TRRD(l2, b_ + 8192); TRRD(h2, b_ + 10240); TRRD(l3, b_ + 12288); TRRD(h3, b_ + 14336); \
        asm volatile("s_waitcnt lgkmcnt(0)" ::: "memory"); SBAR();   \
        o[d0] = __builtin_amdgcn_mfma_f32_32x32x16_bf16(pa0, (bf16x8){l0[0], l0[1], l0[2], l0[3], h0[0], h0[1], h0[2], h0[3]}, o[d0], 0, 0, 0);   \
        o[d0] = __builtin_amdgcn_mfma_f32_32x32x16_bf16(pa1, (bf16x8){l1[0], l1[1], l1[2], l1[3], h1[0], h1[1], h1[2], h1[3]}, o[d0], 0, 0, 0);   \
        o[d0] = __builtin_amdgcn_mfma_f32_32x32x16_bf16(pa2, (bf16x8){l2[0], l2[1], l2[2], l2[3], h2[0], h2[1], h2[2], h2[3]}, o[d0], 0, 0, 0);   \
        o[d0] = __builtin_amdgcn_mfma_f32_32x32x16_bf16(pa3, (bf16x8){l3[0], l3[1], l3[2], l3[3], h3[0], h3[1], h3[2], h3[3]}, o[d0], 0, 0, 0); } while (0)
    PV_D0(0); PV_D0(1); PV_D0(2); PV_D0(3);
}
template <int VB>
__device__ __forceinline__ void pv_tile_sm(f32x16* o, int vb0, bf16x8 pa0, bf16x8 pa1, bf16x8 pa2, bf16x8 pa3, f32x16& p0, f32x16& p1, float& m_reg, float& mn, float& alpha) {
    constexpr float C2 = 1.4426950408889634f * SCALE;
    PV_D0(0);
    float pmax = p0[0];
#pragma unroll
    for (int r = 1; r < 16; ++r) pmax = fmaxf(pmax, p0[r]);
#pragma unroll
    for (int r = 0; r < 16; ++r) pmax = fmaxf(pmax, p1[r]);
    PV_D0(1);
    { auto rr = __builtin_amdgcn_permlane32_swap(__float_as_uint(pmax), __float_as_uint(pmax), false, false);
      pmax = fmaxf(__uint_as_float(rr[0]), __uint_as_float(rr[1])); }
    const bool keep = __all((pmax - m_reg) * SCALE <= THR);
    mn = keep ? m_reg : fmaxf(m_reg, pmax);
    alpha = __builtin_amdgcn_exp2f((m_reg - mn) * C2);
    m_reg = mn;
    const float mnL = -mn * C2;
#pragma unroll
    for (int r = 0; r < 16; ++r) p0[r] = fmaf(p0[r], C2, mnL);
    PV_D0(2);
#pragma unroll
    for (int r = 0; r < 16; ++r) p1[r] = fmaf(p1[r], C2, mnL);
#pragma unroll
    for (int r = 0; r < 8; ++r) p0[r] = __builtin_amdgcn_exp2f(p0[r]);
    PV_D0(3);
#pragma unroll
    for (int r = 8; r < 16; ++r) p0[r] = __builtin_amdgcn_exp2f(p0[r]);
}
#undef PV_D0
#undef TRRD

struct BlockRef { const u16* Q; const u16* K; const u16* V; const u16* KR; u16* O; int P0; int row0; };
#define VMW() asm volatile("s_waitcnt vmcnt(0)" ::: "memory")
#define ATT_LAS __attribute__((address_space(3)))
#define KDMA(Kp, KRp, k0, bf) do { \
        __builtin_amdgcn_global_load_lds((const unsigned*)((Kp) + (size_t)((k0) + sr) * LDK + ksc), (ATT_LAS unsigned*)(ldsL + OFF_K + (bf) * SHM_K + wid * 1024), 16, 0, 0); \
        __builtin_amdgcn_global_load_lds((const unsigned*)((Kp) + (size_t)((k0) + 32 + sr) * LDK + ksc), (ATT_LAS unsigned*)(ldsL + OFF_K + (bf) * SHM_K + 8192 + wid * 1024), 16, 0, 0); \
        __builtin_amdgcn_global_load_lds((const unsigned*)((KRp) + (size_t)((k0) + krr) * LDKR + krsc), (ATT_LAS unsigned*)(ldsL + OFF_KR + (bf) * SHM_KR + wid * 1024), 16, 0, 0); } while (0)
#define VDMA(Vp, k0, bf) do { \
        __builtin_amdgcn_global_load_lds((const unsigned*)((Vp) + (size_t)((k0) + vk) * LDK + vc), (ATT_LAS unsigned*)(ldsL + OFF_V + (bf) * SHM_V + wid * 1024), 16, 0, 0); \
        __builtin_amdgcn_global_load_lds((const unsigned*)((Vp) + (size_t)((k0) + 32 + vk) * LDK + vc), (ATT_LAS unsigned*)(ldsL + OFF_V + (bf) * SHM_V + 8192 + wid * 1024), 16, 0, 0); } while (0)
#define ATT_MAPS() const int sr = tid >> 4, ksc = ((tid & 15) ^ (sr & 7)) * 8, krr = tid >> 3, krsc = ((tid & 7) ^ (krr & 7)) * 8; ATT_LAS unsigned char* ldsL = (ATT_LAS unsigned char*)lds; \
    const int vkk_ = ((tid >> 7) << 3) | ((tid >> 2) & 7), vk = (vkk_ & ~0xC) | ((vkk_ & 4) << 1) | ((vkk_ & 8) >> 1), vc = ((tid >> 5) & 3) * 32 + (tid & 3) * 8
__device__ __forceinline__ void attn_prime(const BlockRef& cur, char* lds, int tid0) {
    int tid_ = tid0; asm volatile("" : "+v"(tid_));
    const int tid = tid_, wid = __builtin_amdgcn_readfirstlane(tid >> 6);
    ATT_MAPS();
    KDMA(cur.K, cur.KR, 0, 0); VDMA(cur.V, 0, 0); VMW();
    __syncthreads();
}
__device__ __forceinline__ void attn_block(const BlockRef& cur, const BlockRef& nxt, char* lds, int tid0, const float* ctab, const float* stab) {
    int tid_ = tid0; asm volatile("" : "+v"(tid_));
    const int tid = tid_, wid = __builtin_amdgcn_readfirstlane(tid >> 6), lane = tid & 63, r32 = lane & 31, hi = lane >> 5;
    const unsigned W = 0x40000000u;
    const int NT = (cur.P0 + QB - 1) / KVBLK + 1;
    const int qlo = cur.P0 + wid * QBLK, qm = qlo + r32 - 4 * hi;
    char* K_lds = lds + OFF_K; char* KR_lds = lds + OFF_KR;
    float* ws = (float*)(lds + OFF_WS) + wid * 64; float* li_l = ws, * al_l = ws + 32;
    bf16x8* qrl = (bf16x8*)(lds + OFF_QR + wid * QR_WAVE) + lane;
    float m_reg = -1e30f, l_reg = 0; f32x16 o[4] = {};
    ATT_MAPS();
    const int vb0 = (int)(uintptr_t)lds + v_rd_base(lane);
    const u16* Kh = cur.K; const u16* Vh = cur.V; const u16* KRh = cur.KR;
#define RESC(a) do { if (__any((a) < 1.f)) { if (hi == 0) al_l[r32] = (a); asm volatile("s_waitcnt lgkmcnt(0)" ::: "memory");              \
                     for (int d_ = 0; d_ < 4; ++d_) for (int r = 0; r < 16; ++r) o[d_][r] *= al_l[crow(r, hi)]; } } while (0)
#define KBASE(t) ((t) * KVBLK)
#define MASKT(P0_, P1_, t) do { const int kb_ = KBASE(t); if (kb_ + KVBLK - 1 > qlo) mask_tile(P0_, P1_, qm - kb_, W); } while (0)
    f32x16 pA0, pA1, pB0, pB1; float mnA, mnB, alA, alB; bf16x8 pa0, pa1, pa2, pa3;
    bf16x8 qr[NQREG > 0 ? NQREG : 1];
    { const u16* qp = cur.Q + (size_t)(wid * QBLK + r32) * LDQ + hi * 8;
#pragma unroll
      for (int d = 0; d < NQREG_L; ++d) qrl[d * 64] = load8(qp + (NQREG + d) * 16);
      const size_t trow = (size_t)(cur.row0 + wid * QBLK + r32) * 32 + hi * 8;
#pragma unroll
      for (int pr = 0; pr < 2; ++pr) {
          const bf16x8 x1 = load8(qp + 128 + pr * 16), x2 = load8(qp + 128 + 32 + pr * 16);
          const f32x4 c0 = *(const f32x4*)(ctab + trow + pr * 16), c1 = *(const f32x4*)(ctab + trow + pr * 16 + 4), s0 = *(const f32x4*)(stab + trow + pr * 16), s1 = *(const f32x4*)(stab + trow + pr * 16 + 4);
          float o1[8], o2[8];
#pragma unroll
          for (int e = 0; e < 8; ++e) { const float a = __uint_as_float(((unsigned)(unsigned short)x1[e]) << 16), b = __uint_as_float(((unsigned)(unsigned short)x2[e]) << 16);
              const float cc = e < 4 ? c0[e & 3] : c1[e & 3], ss = e < 4 ? s0[e & 3] : s1[e & 3]; o1[e] = a * cc - b * ss; o2[e] = b * cc + a * ss; }
          u32x4 w1 = {cvtpk(o1[0], o1[1]), cvtpk(o1[2], o1[3]), cvtpk(o1[4], o1[5]), cvtpk(o1[6], o1[7])}, w2 = {cvtpk(o2[0], o2[1]), cvtpk(o2[2], o2[3]), cvtpk(o2[4], o2[5]), cvtpk(o2[6], o2[7])};
          qrl[(NQREG_L + pr) * 64] = *reinterpret_cast<bf16x8*>(&w1); qrl[(NQREG_L + 2 + pr) * 64] = *reinterpret_cast<bf16x8*>(&w2); }
#pragma unroll
      for (int d0 = 0; d0 < NQREG; ++d0) qr[d0] = load8(qp + d0 * 16); }
    SBAR();
    KDMA(Kh, KRh, KBASE(1), 1); VDMA(Vh, KBASE(1), 1);
    SBAR(); qkt<0>(pA0, pA1, K_lds, KR_lds, qrl, r32, hi, qr);
    MASKT(pA0, pA1, 0); partialSM(pA0, pA1, m_reg, mnA, alA);
    VMW(); __syncthreads();
    KDMA(Kh, KRh, KBASE(2), 0);
#define HALF_STEP(PX0, PX1, mnX, alX, PY0, PY1, alY, t, KB, VB) do {                                                          \
        SBAR(); qkt<KB>(PX0, PX1, K_lds, KR_lds, qrl, r32, hi, qr);                                                          \
        finishSM(PY0, PY1, alY, l_reg, pa0, pa1, pa2, pa3); SBAR();                                                           \
        MASKT(PX0, PX1, (t)); SBAR(); pv_tile_sm<VB>(o, vb0, pa0, pa1, pa2, pa3, PX0, PX1, m_reg, mnX, alX);                  \
        VMW(); __syncthreads();                                                                                               \
        if ((t) + 2 < NT) KDMA(Kh, KRh, KBASE((t) + 2), KB);                                                                  \
        if ((t) + 1 < NT) VDMA(Vh, KBASE((t) + 1), VB);                                                                       \
        SBAR(); RESC(alX); } while (0)
    for (int t = 1; t + 1 < NT; t += 2) {
        HALF_STEP(pB0, pB1, mnB, alB, pA0, pA1, alA, t, 1, 0);
        HALF_STEP(pA0, pA1, mnA, alA, pB0, pB1, alB, t + 1, 0, 1);
    }
    SBAR(); qkt<1>(pB0, pB1, K_lds, KR_lds, qrl, r32, hi, qr);
    finishSM(pA0, pA1, alA, l_reg, pa0, pa1, pa2, pa3); SBAR();
    MASKT(pB0, pB1, NT - 1); SBAR(); pv_tile_sm<0>(o, vb0, pa0, pa1, pa2, pa3, pB0, pB1, m_reg, mnB, alB);
    VMW(); __syncthreads();
    KDMA(nxt.K, nxt.KR, 0, 0); VDMA(nxt.V, 0, 0);
    SBAR(); RESC(alB);
    finishSM(pB0, pB1, alB, l_reg, pa0, pa1, pa2, pa3); SBAR(); pv_tile<1>(o, vb0, pa0, pa1, pa2, pa3);
    SBAR();
    if (hi == 0) li_l[r32] = l_reg; asm volatile("s_waitcnt lgkmcnt(0)" ::: "memory");
    float rli[16];
#pragma unroll
    for (int r = 0; r < 16; ++r) rli[r] = __builtin_amdgcn_rcpf(li_l[crow(r, hi)]);
    u16* Ow = cur.O + (size_t)(wid * QBLK) * LDO;
#pragma unroll
    for (int r = 0; r < 16; ++r) { const int orow = crow(r, hi);
#pragma unroll
        for (int d0 = 0; d0 < 4; ++d0) { const float v = o[d0][r] * rli[r];
            const float vn = xor1f(v);
            if ((r32 & 1) == 0) *(unsigned*)(Ow + (size_t)orow * LDO + d0 * 32 + r32) = cvtpk(v, vn); } }
    VMW(); __syncthreads();
#undef RESC
#undef KBASE
#undef MASKT
#undef HALF_STEP
}
struct Tensors { const u16* q; const u16* kv; const u16* kr; u16* o; const float* ctab; const float* stab; };
__device__ __forceinline__ BlockRef make_ref(const Tensors& T, int L, int pass) {
    const int bh = (L & 7) + 8 * (L >> 8), x = (L >> 3) & 31, b = bh >> 3, h = bh & 7, qb = pass ? 63 - x : x;
    BlockRef r; const size_t row0 = (size_t)b * SEQ;
    r.Q = T.q + (row0 + (size_t)qb * QB) * LDQ + h * 192; r.K = T.kv + row0 * LDK + h * 256; r.V = r.K + 128; r.KR = T.kr + row0 * LDKR;
    r.O = T.o + (row0 + (size_t)qb * QB) * LDO + h * 128; r.P0 = qb * QB; r.row0 = b * SEQ + qb * QB;
    return r;
}
__device__ __forceinline__ void attn_phase(char* lds, const Tensors& T, int tid0) {
    const int total = 512, stride = gridDim.x;
    int L = blockIdx.x; if (L >= total) return;
    int pass = 0;
    BlockRef cur = make_ref(T, L, 0);
    attn_prime(cur, lds, tid0);
    for (;;) {
        const bool more_pass = pass == 0, more_item = L + stride < total, last = !more_pass && !more_item;
        int passn = pass + 1, Ln = L;
        if (!more_pass) { passn = 0; Ln = more_item ? L + stride : L; }
        const BlockRef nxt = last ? cur : make_ref(T, Ln, passn);
        attn_block(cur, nxt, lds, tid0, T.ctab, T.stab);
        if (last) break;
        cur = nxt; pass = passn; L = Ln;
    }
}
#undef VMW
#undef KDMA
#undef VDMA
#undef ATT_MAPS
#undef SBAR
}
namespace xb {
#define LAS __attribute__((address_space(3)))
#define XB_TMO      128
#define XB_XCNT(j)  (256  + 64 * (j))
#define XB_XSUB(j)  (1280 + 64 * (j))
#define XB_XGEN(j)  (2304 + 64 * (j))
#define XB_TOP      3328
#define XB_TOPGEN   3392
#define XCD_BAR_WORDS 3456
#define XB_SPIN_CAP (1u << 18)

__device__ __forceinline__ unsigned xb_ld(unsigned* p)              { return __hip_atomic_load(p, __ATOMIC_RELAXED, __HIP_MEMORY_SCOPE_AGENT); }
__device__ __forceinline__ unsigned xb_add(unsigned* p, unsigned v) { return __hip_atomic_fetch_add(p, v, __ATOMIC_RELAXED, __HIP_MEMORY_SCOPE_AGENT); }
__device__ __forceinline__ unsigned xb_xcc_id() { return (unsigned)__builtin_amdgcn_s_getreg((3 << 11) | 20) & 0xFu; }
#define XB_SPIN(cond, bar) do { unsigned _sp = 0; while (cond) { __builtin_amdgcn_s_sleep(1); \
    if ((++_sp & 255u) == 0u) { if (xb_ld(&(bar)[XB_TMO])) break; if (_sp > XB_SPIN_CAP) { atomicAdd(&(bar)[XB_TMO], 1u); break; } } } } while (0)

struct XcdBarrier {
    unsigned* bar; unsigned x;
    volatile LAS unsigned* st;
};

__device__ __forceinline__ XcdBarrier xcd_barrier_post(unsigned* bar, volatile LAS unsigned* st) {
    XcdBarrier b; b.bar = bar; b.x = xb_xcc_id(); b.st = st;
    if (threadIdx.x == 0) (void)xb_add(&bar[XB_XCNT(b.x)], 1u);
    return b;
}
__device__ __forceinline__ void xcd_barrier_complete(unsigned* bar, unsigned x, unsigned& nloc, unsigned& nx) {
    const unsigned G = gridDim.x * gridDim.y * gridDim.z;
    unsigned sum, cnt, mine, sp = 0u;
    for (;;) {
        sum = 0u; cnt = 0u; mine = 0u;
#pragma unroll
        for (unsigned j = 0; j < 16; ++j) { const unsigned c = xb_ld(&bar[XB_XCNT(j)]); sum += c; cnt += (c > 0u) ? 1u : 0u; mine = (j == x) ? c : mine; }
        if (sum == G) break;
        __builtin_amdgcn_s_sleep(1);
        if ((++sp & 255u) == 0u) { if (xb_ld(&bar[XB_TMO])) break; if (sp > XB_SPIN_CAP) { atomicAdd(&bar[XB_TMO], 1u); break; } }
    }
    nloc = mine > 0u ? mine : 1u; nx = cnt > 0u ? cnt : 1u;
}

__device__ __forceinline__ void xcd_barrier(const XcdBarrier& b, bool t0  ) {
    asm volatile("s_waitcnt vmcnt(0)" ::: "memory");
    __syncthreads();
    if (t0) {
        unsigned* bar = b.bar;
        __builtin_amdgcn_s_waitcnt(0);
        unsigned nloc = b.st[0], nx = b.st[1];
        if (nloc == 0u) { xcd_barrier_complete(bar, b.x, nloc, nx); b.st[0] = nloc; b.st[1] = nx; }
        const unsigned old = xb_add(&bar[XB_XSUB(b.x)], 1u);
        const unsigned gen = old / nloc;
        if (old + 1u == (gen + 1u) * nloc) {
            __builtin_amdgcn_fence(__ATOMIC_RELEASE, "agent");
            asm volatile("s_waitcnt vmcnt(0)" ::: "memory");
            const unsigned og = xb_add(&bar[XB_TOP], 1u);
            const unsigned tg = og / nx;
            if (og + 1u == (tg + 1u) * nx) xb_add(&bar[XB_TOPGEN], 1u);
            else XB_SPIN(xb_ld(&bar[XB_TOPGEN]) == tg, bar);
            __builtin_amdgcn_fence(__ATOMIC_ACQUIRE, "agent");
            xb_add(&bar[XB_XGEN(b.x)], 1u);
            asm volatile("s_waitcnt vmcnt(0)" ::: "memory");
        } else {
            XB_SPIN(xb_ld(&bar[XB_XGEN(b.x)]) == gen, bar);
            __builtin_amdgcn_fence(__ATOMIC_ACQUIRE, "agent");
            asm volatile("s_waitcnt vmcnt(0)" ::: "memory");
        }
    }
    __syncthreads();
}
#undef LAS
}
#ifndef PROBE_ATT_REPS
#define PROBE_ATT_REPS 1
#endif
#ifndef PROBE_SYNC_REPS
#define PROBE_SYNC_REPS 1
#endif
#ifndef PROBE_THIN_REPS
#define PROBE_THIN_REPS 1
#endif
#ifndef PROBE_PRO_REPS
#define PROBE_PRO_REPS 1
#endif
#ifndef PROBE_GEMM_REPS
#define PROBE_GEMM_REPS 1
#endif
namespace mk {
typedef unsigned short u16;
typedef float f32x4 __attribute__((ext_vector_type(4)));
constexpr int M = 32768, D = 1024, SEQ = 16384;
constexpr float EPS = 1e-6f;
constexpr size_t MB = (size_t)1 << 20;
__host__ __device__ constexpr size_t WT_MLA(int j) { return (size_t)j * 6 * MB; }
__host__ __device__ constexpr size_t WT_LRU(int j) { return 12 * MB + (size_t)j * 8 * MB; }
__host__ __device__ constexpr size_t WT_FFN(int l) { return 28 * MB + (size_t)l * 16 * MB; }
constexpr size_t OFF_UQ = 3 * MB / 2, OFF_UKV = 11 * MB / 4, OFF_WO = 15 * MB / 4, OFF_GT = 4 * MB, OFF_LOUT = 5 * MB, OFF_DOWN = 8 * MB;
constexpr size_t WS_COS = 96 * MB, WS_SIN = 100 * MB, WS_SA = 104 * MB, WS_SB = 105 * MB;
constexpr size_t WS_HN = 112 * MB, WS_Y = 176 * MB, WS_U = 240 * MB, WS_END = 496 * MB;
constexpr size_t U_PROJ = 64 * MB, U_CQ = 112 * MB, U_CKV = 136 * MB, U_KR = 152 * MB, U_Q = 160 * MB, U_O = 64 * MB;
constexpr size_t U_GATE = 0, U_XC = 64 * MB, U_REC = 128 * MB, U_LA = 128 * MB, U_B = 192 * MB;
constexpr size_t WS_XSA = 108 * MB, WS_XSB = 109 * MB;
constexpr size_t WS_RS = 108 * MB;
constexpr int SCAN_L = 128, SCAN_NC = SEQ / SCAN_L;

__device__ __forceinline__ unsigned f2bf(float f) { unsigned u = __float_as_uint(f); return (u + 0x7fffu + ((u >> 16) & 1u)) >> 16; }
__device__ __forceinline__ unsigned pk2(float lo, float hi) { return f2bf(lo) | (f2bf(hi) << 16); }
__device__ __forceinline__ float bflo(unsigned w) { return __uint_as_float(w << 16); }
__device__ __forceinline__ float bfhi(unsigned w) { return __uint_as_float(w & 0xffff0000u); }
__device__ __forceinline__ float bf1(u16 h) { return __uint_as_float(((unsigned)h) << 16); }
__device__ __forceinline__ float wave_sum(float v) {
    v += xor1f(v); v += xor2f(v); v += xor4f(v); v += xor8f(v); v += xor16f(v);
    return sum32f(v);
}
__device__ __forceinline__ void transpose_item(const float* W, int ldw, u16* WT, int ldt, int nblk, float* scr, int item, int lane) {
    const int kb = item / nblk, nb = item % nblk, k0 = 64 * kb, n0 = 32 * nb;
#pragma unroll
    for (int i = 0; i < 8; ++i) { const int kk = 8 * i + (lane >> 3); const f32x4 v = *(const f32x4*)(W + (size_t)(k0 + kk) * ldw + n0 + (lane & 7) * 4);
        float* s = scr + kk * 33 + (lane & 7) * 4; s[0] = v.x; s[1] = v.y; s[2] = v.z; s[3] = v.w; }
    asm volatile("s_waitcnt lgkmcnt(0)" ::: "memory");
    const int c = lane & 7;
#pragma unroll
    for (int j = 0; j < 4; ++j) { const int n = (lane >> 3) + 8 * j; const float* s = scr + (8 * c) * 33 + n;
        uint4 o; o.x = pk2(s[0 * 33], s[1 * 33]); o.y = pk2(s[2 * 33], s[3 * 33]); o.z = pk2(s[4 * 33], s[5 * 33]); o.w = pk2(s[6 * 33], s[7 * 33]);
        *(uint4*)(WT + (size_t)(n0 + n) * ldt + k0 + 8 * c) = o; }
    asm volatile("s_waitcnt lgkmcnt(0)" ::: "memory");
}
struct Params { const float* in[23]; float* out; unsigned char* ws; };
enum { I_X = 0, I_POS, I_MIXPRE, I_MIXPOST, I_FFNPRE, I_FFNPOST, I_MLA_WIN, I_MLA_QN, I_MLA_KVN, I_MLA_WUQ, I_MLA_WUKV, I_MLA_WO,
       I_LRU_WIN, I_LRU_CW, I_LRU_CB, I_LRU_WA, I_LRU_BA, I_LRU_WX, I_LRU_BX, I_LRU_LAM, I_LRU_WOUT, I_FFN_UP, I_FFN_DOWN };

__device__ __forceinline__ void prologue_weights(const __attribute__((address_space(4))) Params& p, float* scr, int gw, int NGW, int lane) {
    u16* wt = (u16*)p.ws;
    constexpr int IT_MLA = 352 + 288 + 256 + 512, IT_LRU = 1024 + 128 + 512, IT_FFN = 4096, TOTAL = 2 * IT_MLA + 2 * IT_LRU + 4 * IT_FFN;
    for (int it = gw; it < TOTAL; it += NGW) {
        int r = it; const float* W; int ldw, ldt, nblk; u16* WT;
        if (r < 2 * IT_MLA) { const int j = r / IT_MLA; r -= j * IT_MLA; u16* base = wt + WT_MLA(j) / 2;
            if (r < 352) { W = p.in[I_MLA_WIN] + (size_t)j * 1024 * 704; ldw = 704; nblk = 22; WT = base; ldt = 1024; }
            else if (r < 640) { r -= 352; W = p.in[I_MLA_WUQ] + (size_t)j * 384 * 1536; ldw = 1536; nblk = 48; WT = base + OFF_UQ / 2; ldt = 384; }
            else if (r < 896) { r -= 640; W = p.in[I_MLA_WUKV] + (size_t)j * 256 * 2048; ldw = 2048; nblk = 64; WT = base + OFF_UKV / 2; ldt = 256; }
            else { r -= 896; W = p.in[I_MLA_WO] + (size_t)j * 1024 * 1024; ldw = 1024; nblk = 32; WT = base + OFF_WO / 2; ldt = 1024; }
        } else if (r < 2 * IT_MLA + 2 * IT_LRU) { r -= 2 * IT_MLA; const int j = r / IT_LRU; r -= j * IT_LRU; u16* base = wt + WT_LRU(j) / 2;
            if (r < 1024) { W = p.in[I_LRU_WIN] + (size_t)j * 1024 * 2048; ldw = 2048; nblk = 64; WT = base; ldt = 1024; }
            else if (r < 1152) { r -= 1024; const int which = r >> 3, gt = which >> 3, n = which & 7; r &= 7;
                W = p.in[gt ? I_LRU_WX : I_LRU_WA] + (size_t)j * 8 * 128 * 128 + (size_t)n * 128 * 128; ldw = 128; nblk = 4;
                WT = base + OFF_GT / 2 + (size_t)(n * 256 + gt * 128) * 256 + 128 * (n & 1); ldt = 256; }
            else { r -= 1152; W = p.in[I_LRU_WOUT] + (size_t)j * 1024 * 1024; ldw = 1024; nblk = 32; WT = base + OFF_LOUT / 2; ldt = 1024; }
        } else { r -= 2 * IT_MLA + 2 * IT_LRU; const int l = r / IT_FFN; r -= l * IT_FFN; u16* base = wt + WT_FFN(l) / 2;
            if (r < 2048) { W = p.in[I_FFN_UP] + (size_t)l * 1024 * 4096; ldw = 4096; nblk = 128; WT = base; ldt = 1024; }
            else { r -= 2048; W = p.in[I_FFN_DOWN] + (size_t)l * 4096 * 1024; ldw = 1024; nblk = 32; WT = base + OFF_DOWN / 2; ldt = 4096; }
        }
        transpose_item(W, ldw, WT, ldt, nblk, scr, r, lane);
    }
}
__device__ __forceinline__ void rowop(const u16* y, const float* xin, float* xout, u16* hn, float* rs, const float* gpost, const float* gpre, int gw, int NGW, int lane) {
    f32x4 gp[4], gq[4];
#pragma unroll
    for (int j = 0; j < 4; ++j) { gp[j] = gpost ? *(const f32x4*)(gpost + j * 256 + lane * 4) : (f32x4){0.f, 0.f, 0.f, 0.f}; gq[j] = gpre ? *(const f32x4*)(gpre + j * 256 + lane * 4) : (f32x4){0.f, 0.f, 0.f, 0.f}; }
    for (int row = gw; row < M; row += NGW) {
        f32x4 xv[4];
#pragma unroll
        for (int j = 0; j < 4; ++j) xv[j] = *(const f32x4*)(xin + (size_t)row * D + j * 256 + lane * 4);
        if (y) {
            f32x4 yv[4]; float ss = 0.f;
#pragma unroll
            for (int j = 0; j < 4; ++j) { const uint2 w = *(const uint2*)(y + (size_t)row * D + j * 256 + lane * 4);
                yv[j] = (f32x4){bflo(w.x), bfhi(w.x), bflo(w.y), bfhi(w.y)}; ss += (yv[j].x * yv[j].x + yv[j].y * yv[j].y) + (yv[j].z * yv[j].z + yv[j].w * yv[j].w); }
            const float r = rsqrtf(wave_sum(ss) * (1.f / D) + EPS);
#pragma unroll
            for (int j = 0; j < 4; ++j) xv[j] = xv[j] + (yv[j] * r) * gp[j];
        }
        if (xout) {
#pragma unroll
        for (int j = 0; j < 4; ++j) *(f32x4*)(xout + (size_t)row * D + j * 256 + lane * 4) = xv[j]; }
        if (gpre) {
            float s2 = 0.f;
#pragma unroll
            for (int j = 0; j < 4; ++j) s2 += (xv[j].x * xv[j].x + xv[j].y * xv[j].y) + (xv[j].z * xv[j].z + xv[j].w * xv[j].w);
            const float tot2 = wave_sum(s2); const float r2 = 1.0f;
            if (rs && lane < 4) rs[(size_t)row * 4 + lane] = lane == 0 ? tot2 : 0.f;
#pragma unroll
            for (int j = 0; j < 4; ++j) { const f32x4 h = (xv[j] * r2) * gq[j]; uint2 w; w.x = pk2(h.x, h.y); w.y = pk2(h.z, h.w);
                *(uint2*)(hn + (size_t)row * D + j * 256 + lane * 4) = w; }
        }
    }
}
__device__ __forceinline__ void qkvnorm(const u16* proj, u16* cq, u16* ckv, u16* kr, const float* qn, const float* kvn, const float* ctab, const float* stab, const float* rss, int gw, int NGW, int lane) {
    float gq[6], gk[4];
#pragma unroll
    for (int j = 0; j < 6; ++j) gq[j] = qn[lane + 64 * j];
#pragma unroll
    for (int j = 0; j < 4; ++j) gk[j] = kvn[lane + 64 * j];
    for (int row = gw; row < M; row += NGW) {
        const u16* pr = proj + (size_t)row * 768;
        const f32x4 pp = *(const f32x4*)(rss + (size_t)row * 4); const float rsc = rsqrtf(((pp[0] + pp[1]) + (pp[2] + pp[3])) * (1.f / D) + EPS);
        float a[6], b[4], s1 = 0.f, s2 = 0.f;
#pragma unroll
        for (int j = 0; j < 6; ++j) { a[j] = bf1(pr[lane + 64 * j]) * rsc; s1 += a[j] * a[j]; }
#pragma unroll
        for (int j = 0; j < 4; ++j) { b[j] = bf1(pr[384 + lane + 64 * j]) * rsc; s2 += b[j] * b[j]; }
        const float x1 = bf1(pr[640 + (lane & 31)]) * rsc, x2 = bf1(pr[672 + (lane & 31)]) * rsc;
        const float r1 = rsqrtf(wave_sum(s1) * (1.f / 384.f) + EPS), r2 = rsqrtf(wave_sum(s2) * (1.f / 256.f) + EPS);
#pragma unroll
        for (int j = 0; j < 6; ++j) cq[(size_t)row * 384 + lane + 64 * j] = (u16)f2bf(a[j] * r1 * gq[j]);
#pragma unroll
        for (int j = 0; j < 4; ++j) ckv[(size_t)row * 256 + lane + 64 * j] = (u16)f2bf(b[j] * r2 * gk[j]);
        const float c = ctab[(size_t)row * 32 + (lane & 31)], s = stab[(size_t)row * 32 + (lane & 31)];
        kr[(size_t)row * 64 + lane] = (u16)f2bf(lane < 32 ? x1 * c - x2 * s : x2 * c + x1 * s);
    }
}
__device__ __forceinline__ void qrope(u16* q, const float* ctab, const float* stab, int gw, int NGW, int lane) {
    for (int row = gw; row < M; row += NGW) {
        u16* qr = q + (size_t)row * 1536; const int i = lane & 31;
        const float c = ctab[(size_t)row * 32 + i], s = stab[(size_t)row * 32 + i];
#pragma unroll
        for (int j = 0; j < 4; ++j) { const int h = 2 * j + (lane >> 5); u16* pp = qr + h * 192 + 128 + i;
            const float x1 = bf1(pp[0]), x2 = bf1(pp[32]);
            pp[0] = (u16)f2bf(x1 * c - x2 * s); pp[32] = (u16)f2bf(x2 * c + x1 * s); }
    }
}
__device__ __forceinline__ void conv_phase(const u16* rec, u16* xc, const float* cw, const float* cb, int gtid, int NGT) {
    for (int idx = gtid; idx < M * 128; idx += NGT) {
        const int row = idx >> 7, c0 = (idx & 127) * 8, s = row & (SEQ - 1);
        float acc[8];
#pragma unroll
        for (int e = 0; e < 8; ++e) acc[e] = cb[c0 + e];
#pragma unroll
        for (int k = 0; k < 4; ++k) { if (s - 3 + k >= 0) {
            const uint4 w = *(const uint4*)(rec + (size_t)(row - 3 + k) * D + c0);
            const float v[8] = {bflo(w.x), bfhi(w.x), bflo(w.y), bfhi(w.y), bflo(w.z), bfhi(w.z), bflo(w.w), bfhi(w.w)};
#pragma unroll
            for (int e = 0; e < 8; ++e) acc[e] += v[e] * cw[k * D + c0 + e]; } }
        uint4 o; o.x = pk2(acc[0], acc[1]); o.y = pk2(acc[2], acc[3]); o.z = pk2(acc[4], acc[5]); o.w = pk2(acc[6], acc[7]);
        *(uint4*)(xc + (size_t)row * D + c0) = o;
    }
}
__device__ __forceinline__ void scanA(const u16* A, const u16* B, float* SA, float* SB, int tid) {
    for (int item = blockIdx.x; item < 2 * SCAN_NC * 2; item += gridDim.x) {
        const int half = item & 1, c = (item >> 1) % SCAN_NC, b = item / (2 * SCAN_NC), ch = half * 512 + tid;
        const size_t base = ((size_t)b * SEQ + (size_t)c * SCAN_L) * D + ch;
        float h = 0.f, P = 1.f;
        for (int t0 = 0; t0 < SCAN_L; t0 += 16) {
            u16 aw[16], bw[16];
#pragma unroll
            for (int u = 0; u < 16; ++u) { aw[u] = A[base + (size_t)(t0 + u) * D]; bw[u] = B[base + (size_t)(t0 + u) * D]; }
#pragma unroll
            for (int u = 0; u < 16; ++u) { const float a = __expf(bf1(aw[u])); h = a * h + bf1(bw[u]); P *= a; }
        }
        SA[((size_t)b * SCAN_NC + c) * D + ch] = P; SB[((size_t)b * SCAN_NC + c) * D + ch] = h;
    }
}
__device__ __forceinline__ void scanC(const u16* A, const u16* B, const float* SA, const float* SB, const u16* gate, u16* hg, int tid) {
    for (int item = blockIdx.x; item < 2 * SCAN_NC * 2; item += gridDim.x) {
        const int half = item & 1, c = (item >> 1) % SCAN_NC, b = item / (2 * SCAN_NC), ch = half * 512 + tid;
        const size_t base = ((size_t)b * SEQ + (size_t)c * SCAN_L) * D + ch;
        float h = 0.f;
        for (int cc = 0; cc < c; ++cc) { const size_t so = ((size_t)b * SCAN_NC + cc) * D + ch; h = SA[so] * h + SB[so]; }
        for (int t0 = 0; t0 < SCAN_L; t0 += 16) {
            u16 aw[16], bw[16], gv[16];
#pragma unroll
            for (int u = 0; u < 16; ++u) { aw[u] = A[base + (size_t)(t0 + u) * D]; bw[u] = B[base + (size_t)(t0 + u) * D]; gv[u] = gate[base + (size_t)(t0 + u) * D]; }
#pragma unroll
            for (int u = 0; u < 16; ++u) { h = __expf(bf1(aw[u])) * h + bf1(bw[u]); hg[base + (size_t)(t0 + u) * D] = (u16)f2bf(bf1(gv[u]) * h); }
        }
    }
}

constexpr int LDS_GEMM = pg8::STAGE_BYTES + 8192, LDS_MAIN = att::LDS_BYTES > LDS_GEMM ? att::LDS_BYTES : LDS_GEMM, LDS_BYTES = LDS_MAIN + 16;
constexpr size_t WS_BAR = 106 * MB;
constexpr size_t WS_CNT1 = WS_BAR + 16384, WS_CNT2 = WS_BAR + 49152, CTL_BYTES = 81920, WS_XS1 = 107 * MB, WS_XS2 = 107 * MB + MB / 2;
constexpr int XL_OFF = 131072;
static_assert(XL_OFF + 8192 <= LDS_MAIN && XCD_BAR_WORDS * 4 <= 16384 && att::LDS_BYTES <= LDS_MAIN && pg8::STAGE_BYTES <= LDS_MAIN && LDS_BYTES <= 160 * 1024, "LDS map");

__global__ void __launch_bounds__(512, 2) fwd_mega(Params p_arg) {
    extern __shared__ __attribute__((aligned(16))) unsigned char lds[];
    cg::grid_group grid = cg::this_grid();
    (void)p_arg;
    volatile __attribute__((address_space(3))) unsigned* bst = (volatile __attribute__((address_space(3))) unsigned*)((__attribute__((address_space(3))) unsigned char*)lds + LDS_MAIN);
    if (threadIdx.x < 4) bst[threadIdx.x] = 0u;
    __syncthreads();
    const int wave_s = __builtin_amdgcn_readfirstlane(threadIdx.x >> 6);
    const unsigned bar_x = xb::xb_xcc_id();
    (void)xb::xcd_barrier_post((unsigned*)(p_arg.ws + WS_BAR), bst);
#define GRID_BAR() do { unsigned bx_ = bar_x; asm volatile("" : "+s"(bx_)); xb::XcdBarrier bb_; bb_.bar = (unsigned*)(ws + WS_BAR); bb_.x = bx_; bb_.st = bst; xb::xcd_barrier(bb_, tid == 0); } while (0)
    typedef const __attribute__((address_space(4))) Params* KParams;
    KParams pp = (KParams)__builtin_amdgcn_kernarg_segment_ptr();
#define FRESH() int tid_ = wave_s * 64 + lane_id_fresh(); asm volatile("" : "+v"(tid_)); asm volatile("" : "+s"(pp)); const __attribute__((address_space(4))) Params& p = *pp; \
    const int tid = tid_, lane = tid & 63, wave = __builtin_amdgcn_readfirstlane(tid >> 6); \
    const int G = gridDim.x, gw = blockIdx.x * 8 + wave, NGW = G * 8, gtid = blockIdx.x * 512 + tid, NGT = G * 512; \
    unsigned char* ws = p.ws; float* x = p.out; u16* hn = (u16*)(ws + WS_HN); u16* ybuf = (u16*)(ws + WS_Y); unsigned char* U = ws + WS_U; \
    float* ctab = (float*)(ws + WS_COS); float* stab = (float*)(ws + WS_SIN); float* SA = (float*)(ws + WS_SA); float* SB = (float*)(ws + WS_SB); \
    (void)lane; (void)wave; (void)gw; (void)NGW; (void)gtid; (void)NGT; (void)x; (void)hn; (void)ybuf; (void)U; (void)ctab; (void)stab; (void)SA; (void)SB;
    {
    FRESH();

    for (int prep = 0; prep < PROBE_PRO_REPS; ++prep) {
    prologue_weights(p, (float*)lds + wave * (64 * 33), gw, NGW, lane);
    for (int i = gtid; i < 2 * 2048 * 16; i += NGT) { const int j = i >> 15, row = (i >> 4) & 2047, chn = i & 15, n = row >> 8;
        *(uint4*)((u16*)(ws + WT_LRU(j) + OFF_GT) + (size_t)row * 256 + 128 * ((n & 1) ^ 1) + chn * 8) = make_uint4(0u, 0u, 0u, 0u); }
    { const int* pos = (const int*)p.in[I_POS];
      for (int i = gtid; i < M * 32; i += NGT) { const int row = i >> 5, f = i & 31;
        const float inv = __builtin_amdgcn_exp2f(-(float)f * (13.287712379549449f / 32.f));
        const float ang = (float)pos[row] * inv;
        double rev = (double)ang * 0.15915494309189535; rev -= __builtin_rint(rev);
        ctab[i] = __builtin_amdgcn_cosf((float)rev); stab[i] = __builtin_amdgcn_sinf((float)rev); } }
    rowop(nullptr, p.in[I_X], nullptr, hn, (float*)(ws + WS_XSB), nullptr, p.in[I_MIXPRE], gw, NGW, lane);
    }
    if (ws == nullptr) grid.sync();
    GRID_BAR();
    }

#pragma nounroll
    for (int layer = 0; layer < 4; ++layer) {
#pragma nounroll
        for (int op = 0; op < 10; ++op) {
            FRESH();
            const int j = layer >> 1; const bool lru = (layer & 1) != 0;
            const u16* wtm = (const u16*)(ws + WT_MLA(j)); const u16* wtl = (const u16*)(ws + WT_LRU(j)); const u16* wtf = (const u16*)(ws + WT_FFN(layer));
            int gk = 0;
            pg8::Gemm g{}; pg8::EpiB E{};
            if (op == 6 || op == 9) continue;
            const float* gprev = p.in[op == 5 ? I_MIXPRE : I_FFNPRE] + layer * D;
            const float* gpost = p.in[op == 5 ? I_MIXPOST : I_FFNPOST] + layer * D;
            const float* gpre = op == 5 ? p.in[I_FFNPRE] + layer * D : (layer < 3 ? p.in[I_MIXPRE] + (layer + 1) * D : nullptr);
            if (op == 7) { gk = 1; g = pg8::Gemm{hn, wtf, M, 4096, 1024, 1024, 1024, 0}; E = pg8::EpiB{(u16*)U, 4096, 0, 0, 1, nullptr}; }
            else if (op == 8) { gk = 3; g = pg8::Gemm{(const u16*)U, wtf + OFF_DOWN / 2, M, 1024, 4096, 4096, 4096, 0}; }
            else if (!lru) {
                u16* proj = (u16*)(U + U_PROJ); u16* cq = (u16*)(U + U_CQ); u16* ckv = (u16*)(U + U_CKV); u16* kr = (u16*)(U + U_KR); u16* q = (u16*)(U + U_Q); u16* o = (u16*)(U + U_O); u16* kv = ybuf;
                if (op == 0) { gk = 1; g = pg8::Gemm{hn, wtm, M, 768, 1024, 1024, 1024, 0}; E = pg8::EpiB{proj, 768, 0, 0, 0, nullptr}; }
                else if (op == 1) for (int rep = 0; rep < PROBE_THIN_REPS; ++rep) qkvnorm(proj, cq, ckv, kr, p.in[I_MLA_QN] + j * 384, p.in[I_MLA_KVN] + j * 256, ctab, stab, (const float*)(ws + WS_XSB), gw, NGW, lane);
                else if (op == 2) { gk = 1; g = pg8::Gemm{cq, wtm + OFF_UQ / 2, M, 1536, 384, 384, 384, 0}; E = pg8::EpiB{q, 1536, 0, 0, 0, nullptr}; }
                else if (op == 3) { gk = 1; g = pg8::Gemm{ckv, wtm + OFF_UKV / 2, M, 2048, 256, 256, 256, 0}; E = pg8::EpiB{kv, 2048, 0, 0, 0, nullptr}; }
                else if (op == 4) { const att::Tensors T{q, kv, kr, o, ctab, stab}; for (int rep = 0; rep < PROBE_ATT_REPS; ++rep) att::attn_phase((char*)lds, T, tid); }
                else { gk = 3; g = pg8::Gemm{o, wtm + OFF_WO / 2, M, 1024, 1024, 1024, 1024, 0}; }
            } else {
                u16* gate = (u16*)(U + U_GATE); u16* xc = (u16*)(U + U_XC); u16* rec = (u16*)(U + U_REC); u16* Bb = (u16*)(U + U_B); u16* Ab = (u16*)(U + U_LA); u16* hg = xc;
                if (op == 0) { gk = 1; g = pg8::Gemm{hn, wtl, M, 2048, 1024, 1024, 1024, 0}; E = pg8::EpiB{gate, 1024, 1024, (size_t)(U_REC - U_GATE) / 2, 2, (const float*)(ws + WS_XSB)}; }
                else if (op == 1) for (int rep = 0; rep < PROBE_THIN_REPS; ++rep) conv_phase(rec, xc, p.in[I_LRU_CW] + j * 4 * D, p.in[I_LRU_CB] + j * D, gtid, NGT);
                else if (op == 2) { gk = 2; g = pg8::Gemm{xc, wtl + OFF_GT / 2, M, 2048, 256, 1024, 256, 512}; }
                else if (op == 3) for (int rep = 0; rep < PROBE_THIN_REPS; ++rep) scanA(Ab, Bb, SA, SB, tid);
                else if (op == 4) for (int rep = 0; rep < PROBE_THIN_REPS; ++rep) scanC(Ab, Bb, SA, SB, gate, hg, tid);
                else { gk = 3; g = pg8::Gemm{hg, wtl + OFF_LOUT / 2, M, 1024, 1024, 1024, 1024, 0}; }
            }
            for (int rep = 0; rep < PROBE_GEMM_REPS; ++rep)
            if (gk == 1) { pg8::StaticOrder S; S.init(g.M, g.N, G, (int)blockIdx.x);
                pg8::gemm_phase<pg8::EpiB, pg8::StaticOrder, true>((PG8_LAS unsigned char*)lds, g, S, E, tid); }
            else if (gk == 2) { pg8::StaticOrder S; S.init(g.M, g.N, G, (int)blockIdx.x);
                const pg8::EpiGate EG{(const u16*)(U + U_XC), (u16*)(U + U_LA), (u16*)(U + U_B), p.in[I_LRU_BA] + j * D, p.in[I_LRU_BX] + j * D, p.in[I_LRU_LAM] + j * D};
                pg8::gemm_phase<pg8::EpiGate, pg8::StaticOrder, true>((PG8_LAS unsigned char*)lds, g, S, EG, tid); }
            else if (gk == 3) { pg8::StaticOrder S; S.init(g.M, g.N, G, (int)blockIdx.x);
                const unsigned target = 32u * (unsigned)(layer * 2 + (op == 8 ? 2 : 1));
                const pg8::RowStats st1{(float*)(ws + WS_XS1), (unsigned*)(ws + WS_CNT1), target};
                const pg8::EpiNormRes EN{hn, (float*)(ws + (op == 8 ? WS_XSB : WS_XSA)), x, gprev, gpost, gpre, st1, (PG8_LAS unsigned char*)lds + XL_OFF, op == 8 ? (const float*)(ws + WS_XSA) : nullptr};
                pg8::gemm_phase<pg8::EpiNormRes, pg8::StaticOrder, true>((PG8_LAS unsigned char*)lds, g, S, EN, tid); }
            if (!(layer == 3 && op == 8) && !(!lru && op == 2)) { for (int rep = 0; rep < PROBE_SYNC_REPS; ++rep) GRID_BAR(); }
        }
    }
}
}

extern "C" void kernel_launch(void* const* d_in, const int* in_sizes, int n_in, void* d_out, int out_size, void* d_ws, size_t ws_size, hipStream_t stream) {
    static int grid = 0;
    if (grid == 0) {
        if (n_in != 23 || in_sizes[0] != mk::M * mk::D || out_size != mk::M * mk::D || ws_size < mk::WS_END) {
            fprintf(stderr, "kernel_launch: unexpected shapes (n_in %d, in0 %d, out %d, ws %zu); nothing launched\n", n_in, n_in > 0 ? in_sizes[0] : -1, out_size, ws_size); grid = -1; return; }
        int dev = 0, cus = 0, per_cu = 0;
        (void)hipGetDevice(&dev); (void)hipDeviceGetAttribute(&cus, hipDeviceAttributeMultiprocessorCount, dev);
        if (hipFuncSetAttribute((const void*)mk::fwd_mega, hipFuncAttributeMaxDynamicSharedMemorySize, mk::LDS_BYTES) != hipSuccess) { fprintf(stderr, "kernel_launch: hipFuncSetAttribute failed\n"); grid = -1; return; }
        if (hipOccupancyMaxActiveBlocksPerMultiprocessor(&per_cu, (const void*)mk::fwd_mega, 512, mk::LDS_BYTES) != hipSuccess || per_cu < 1) { fprintf(stderr, "kernel_launch: occupancy query says %d blocks per CU\n", per_cu); per_cu = 1; }
        (void)hipGetLastError();
        grid = cus > 0 ? cus : 256;
    }
    if (grid < 0) return;
    mk::Params p{};
    for (int i = 0; i < 23; ++i) p.in[i] = (const float*)d_in[i];
    p.out = (float*)d_out; p.ws = (unsigned char*)d_ws;
    if (hipMemsetAsync((char*)d_ws + mk::WS_BAR, 0, mk::CTL_BYTES, stream) != hipSuccess) { fprintf(stderr, "kernel_launch: hipMemsetAsync failed\n"); return; }
    void* args[] = {&p};
    hipError_t e = hipLaunchCooperativeKernel((const void*)mk::fwd_mega, dim3(grid), dim3(512), args, mk::LDS_BYTES, stream);
    if (e != hipSuccess) fprintf(stderr, "kernel_launch: cooperative launch failed: %s (grid %d)\n", hipGetErrorString(e), grid);
}
```

```cpp
#include <hip/hip_runtime.h>
#include <hip/hip_bf16.h>
#include <hip/hip_cooperative_groups.h>
#include <cstdio>
#include <cstdint>
namespace cg = cooperative_groups;

__device__ __forceinline__ float xor1f(float v)  { return __int_as_float(__builtin_amdgcn_mov_dpp(__float_as_int(v), 0xB1, 0xF, 0xF, false)); }
__device__ __forceinline__ float xor2f(float v)  { return __int_as_float(__builtin_amdgcn_mov_dpp(__float_as_int(v), 0x4E, 0xF, 0xF, false)); }
__device__ __forceinline__ float xor4f(float v)  { return __int_as_float(__builtin_amdgcn_ds_swizzle(__float_as_int(v), 0x101F)); }
__device__ __forceinline__ float xor8f(float v)  { return __int_as_float(__builtin_amdgcn_ds_swizzle(__float_as_int(v), 0x201F)); }
__device__ __forceinline__ float xor16f(float v) { return __int_as_float(__builtin_amdgcn_ds_swizzle(__float_as_int(v), 0x401F)); }
__device__ __forceinline__ float sum32f(float v) { auto rr = __builtin_amdgcn_permlane32_swap(__float_as_uint(v), __float_as_uint(v), false, false); return __uint_as_float(rr[0]) + __uint_as_float(rr[1]); }
__device__ __forceinline__ int lane_id_fresh() { int l; asm volatile("v_mbcnt_lo_u32_b32 %0, -1, 0\n\tv_mbcnt_hi_u32_b32 %0, -1, %0" : "=v"(l)); return l; }
namespace pg8 {
#define PG8_LAS __attribute__((address_space(3)))
typedef unsigned short bf16_t;
typedef short bf16x8 __attribute__((ext_vector_type(8)));
typedef float f32x4 __attribute__((ext_vector_type(4)));
typedef unsigned u32x4 __attribute__((ext_vector_type(4)));
constexpr int BM = 256, BK = 64, HALF = 128, HTB = HALF * BK * 2  , STAGE_BYTES = 8 * HTB, NXCD = 8, WGM = 8;

__host__ __device__ __forceinline__ int lds_byte(int r, int c) { const int st = (r >> 4) * 2 + (c >> 5), rr = r & 15, cc = c & 31, ob = rr * 64 + cc * 2; return st * 1024 + (ob ^ (((ob >> 9) & 1) << 5)); }
__host__ __device__ __forceinline__ void stage_rc(int b, int& R, int& C) { const int st = b / 1024, sb = b % 1024, swz = sb ^ (((sb >> 9) & 1) << 5); R = (st >> 1) * 16 + swz / 64; C = (st & 1) * 32 + (swz % 64) / 2; }
__host__ __device__ __forceinline__ int perm32(int rho) { const int n = rho >> 4, i = rho & 15; return 8 * (i >> 2) + 4 * n + (i & 3); }

struct Unit { int pm, pn; };
struct Gemm { const bf16_t* A; const bf16_t* Bt; int M, N, K; int lda, ldb; int apn; };

struct StaticOrder {
    int nM, nN, nwg, G, c;
    __host__ __device__ void init(int M, int N, int G_, int c_) { nM = M / BM; nN = N / BM; nwg = nM * nN; G = G_; c = c_; }
    __host__ __device__ bool next(int i, Unit& u) const {
        const long L = (long)i * G + c; if (L >= nwg) return false;
        int wgid = (int)L; { const int q = nwg / NXCD, r = nwg % NXCD, xcd = wgid % NXCD, off = wgid / NXCD; wgid = (xcd < r ? xcd * (q + 1) : r * (q + 1) + (xcd - r) * q) + off; }
        const int nig = WGM * nN, gid = wgid / nig, fm = gid * WGM, gsz = (nM - fm) < WGM ? (nM - fm) : WGM;
        u.pm = fm + ((wgid % nig) % gsz); u.pn = (wgid % nig) / gsz; return true;
    }
    __device__ __forceinline__ void a_ready(const Unit&) const {}
    __device__ __forceinline__ void done(const Unit&) const {}
};

__device__ __forceinline__ unsigned cvt_pk_bf16(float lo, float hi) { unsigned r; asm volatile("v_cvt_pk_bf16_f32 %0, %1, %2" : "=v"(r) : "v"(lo), "v"(hi)); return r; }
__device__ __forceinline__ float gelu_tanh(float x) {
    const float z = 0.7978845608028654f * (x + 0.044715f * x * x * x);
    const float e = __expf(2.0f * z);
    const float th = 1.0f - 2.0f * __builtin_amdgcn_rcpf(1.0f + e);
    return 0.5f * x * (1.0f + th);
}
struct EpiB {
    static constexpr bool PERM = true, AFTER_DRAIN = false, FUSED = false;
    bf16_t* O; int ldc; int split_cols; size_t split_stride; int mode;
    const float* rss;
    __device__ __forceinline__ void operator()(const f32x4 (&acc)[2][2][4][2], const Unit& u, int wr, int wc, int fr, int fq) const {
        const int row0 = u.pm * BM + wr * 64 + fr; int colt = u.pn * BM; bf16_t* base = O; int t = 0;
        if (split_cols) { t = colt / split_cols; base += (size_t)t * split_stride; colt -= t * split_cols; }
        const int act = (mode == 1) ? 1 : ((mode == 2 && t == 0) ? 2 : 0);
        const int col0 = colt + wc * 32 + 8 * fq;
#pragma unroll
        for (int ai = 0; ai < 2; ++ai)
#pragma unroll
            for (int m = 0; m < 4; ++m) { bf16_t* rowp = base + (size_t)(row0 + ai * HALF + m * 16) * ldc + col0;
                float rsc = 1.0f; if (rss) { const f32x4 pp = *(const f32x4*)(rss + (size_t)(row0 + ai * HALF + m * 16) * 4); rsc = rsqrtf(((pp[0] + pp[1]) + (pp[2] + pp[3])) * (1.0f / 1024.0f) + 1e-6f); }
#pragma unroll
                for (int bj = 0; bj < 2; ++bj) { f32x4 v0 = acc[ai][bj][m][0] * rsc, v1 = acc[ai][bj][m][1] * rsc;
                    if (act == 1) {
#pragma unroll
                        for (int e = 0; e < 4; ++e) { const float a = fmaxf(v0[e], 0.f), b = fmaxf(v1[e], 0.f); v0[e] = a * a; v1[e] = b * b; } }
                    else if (act == 2) {
#pragma unroll
                        for (int e = 0; e < 4; ++e) { v0[e] = gelu_tanh(v0[e]); v1[e] = gelu_tanh(v1[e]); } }
                    u32x4 w; w.x = cvt_pk_bf16(v0[0], v0[1]); w.y = cvt_pk_bf16(v0[2], v0[3]); w.z = cvt_pk_bf16(v1[0], v1[1]); w.w = cvt_pk_bf16(v1[2], v1[3]);
                    *(u32x4*)(rowp + bj * HALF) = w; } }
    }
};
__device__ __forceinline__ float bf2f(unsigned short h) { return __uint_as_float(((unsigned)h) << 16); }
__device__ __forceinline__ float sigmoidf_(float x) { return __builtin_amdgcn_rcpf(1.0f + __expf(-x)); }
__device__ __forceinline__ float one_minus_exp(float t) { const float ser = -t * (1.0f + t * (0.5f + t * (0.16666667f + t * (0.041666668f + t * 0.008333334f)))); return t > -0.25f ? ser : 1.0f - __expf(t); }
struct EpiGate {
    static constexpr bool PERM = false, AFTER_DRAIN = false, FUSED = false;
    const bf16_t* xc; bf16_t* Aout; bf16_t* Bout; const float* b_a; const float* b_x; const float* lam;
    __device__ __forceinline__ void operator()(const f32x4 (&acc)[2][2][4][2], const Unit& u, int wr, int wc, int fr, int fq) const {
#pragma unroll
        for (int n = 0; n < 2; ++n) {
            const int ch0 = 128 * u.pn + 32 * wc + 16 * n + 4 * fq;
            const f32x4 ba = *(const f32x4*)(b_a + ch0), bx = *(const f32x4*)(b_x + ch0), lm = *(const f32x4*)(lam + ch0);
            f32x4 sp;
#pragma unroll
            for (int e = 0; e < 4; ++e) sp[e] = -8.0f * log1pf(__expf(-lm[e]));
#pragma unroll
            for (int ai = 0; ai < 2; ++ai)
#pragma unroll
                for (int m = 0; m < 4; ++m) {
                    const size_t off = (size_t)(u.pm * BM + ai * HALF + wr * 64 + m * 16 + fr) * 1024 + ch0;
                    const uint2 xr = *(const uint2*)(xc + off);
                    float xv[4] = { __uint_as_float(xr.x << 16), __uint_as_float(xr.x & 0xffff0000u), __uint_as_float(xr.y << 16), __uint_as_float(xr.y & 0xffff0000u) };
                    f32x4 av, bv;
#pragma unroll
                    for (int e = 0; e < 4; ++e) {
                        const float r = sigmoidf_(acc[ai][0][m][n][e] + ba[e]);
                        const float ig = sigmoidf_(acc[ai][1][m][n][e] + bx[e]);
                        const float la = sp[e] * r;
                        av[e] = la;
                        bv[e] = __builtin_amdgcn_sqrtf(fmaxf(one_minus_exp(2.0f * la), 0.f)) * (ig * xv[e]);
                    }
                    uint2 wa, wb; wa.x = cvt_pk_bf16(av[0], av[1]); wa.y = cvt_pk_bf16(av[2], av[3]); wb.x = cvt_pk_bf16(bv[0], bv[1]); wb.y = cvt_pk_bf16(bv[2], bv[3]);
                    *(uint2*)(Aout + off) = wa; *(uint2*)(Bout + off) = wb;
                }
        }
    }
};

struct RowStats {
    float* xbuf;
    unsigned* cnt;
    unsigned target;
    __device__ __forceinline__ void run(const f32x4 (&v)[2][2][4][2], const Unit& u, int wr, int wc, int fr, int fq, PG8_LAS unsigned char* xl, int wid, int lane) const {
        PG8_LAS float* P = (PG8_LAS float*)xl;
        PG8_LAS float* S = (PG8_LAS float*)(xl + 4096);
#pragma unroll
        for (int ai = 0; ai < 2; ++ai)
#pragma unroll
            for (int m = 0; m < 4; ++m) {
                float s = 0.f;
#pragma unroll
                for (int bj = 0; bj < 2; ++bj)
#pragma unroll
                    for (int n = 0; n < 2; ++n) { const f32x4 x = v[ai][bj][m][n]; s += (x[0] * x[0] + x[1] * x[1]) + (x[2] * x[2] + x[3] * x[3]); }
                s += xor16f(s); s = sum32f(s);
                if (fq == 0) P[(ai * HALF + wr * 64 + m * 16 + fr) * 4 + wc] = s;
            }
        asm volatile("s_waitcnt lgkmcnt(0)" ::: "memory"); __builtin_amdgcn_s_barrier(); asm volatile("" ::: "memory");
        const int row = wid * 32 + (lane & 31);
        if (lane < 32) { const float t = (P[row * 4 + 0] + P[row * 4 + 1]) + (P[row * 4 + 2] + P[row * 4 + 3]);
            __hip_atomic_store(xbuf + (size_t)(u.pm * BM + row) * 4 + u.pn, t, __ATOMIC_RELAXED, __HIP_MEMORY_SCOPE_AGENT); }
        asm volatile("s_waitcnt vmcnt(0)" ::: "memory");
        if (lane == 0) __hip_atomic_fetch_add(cnt + 64 * u.pm, 1u, __ATOMIC_RELAXED, __HIP_MEMORY_SCOPE_AGENT);
        if (wid == 0) { unsigned sp = 0;
            while ((unsigned)__builtin_amdgcn_readfirstlane(__hip_atomic_load(cnt + 64 * u.pm, __ATOMIC_RELAXED, __HIP_MEMORY_SCOPE_AGENT)) < target) { __builtin_amdgcn_s_sleep(2); if (++sp > (1u << 18)) break; }
            __builtin_amdgcn_fence(__ATOMIC_ACQUIRE, "agent"); }
        asm volatile("s_waitcnt vmcnt(0) lgkmcnt(0)" ::: "memory"); __builtin_amdgcn_s_barrier(); asm volatile("" ::: "memory");
        if (lane < 32) { float* slot = xbuf + (size_t)(u.pm * BM + row) * 4; float t = 0.f;
#pragma unroll
            for (int k = 0; k < 4; ++k) t += __hip_atomic_load(slot + k, __ATOMIC_RELAXED, __HIP_MEMORY_SCOPE_AGENT);
            S[row] = t; }
        asm volatile("s_waitcnt lgkmcnt(0)" ::: "memory"); __builtin_amdgcn_s_barrier(); asm volatile("" ::: "memory");
    }
};
struct EpiNormRes {
    static constexpr bool PERM = false, AFTER_DRAIN = false, FUSED = true;
    bf16_t* hn; float* xs2; float* out; const float* gprev; const float* gpost; const float* gpre; RowStats st1; PG8_LAS unsigned char* xl;
    const float* s_in;
    __device__ __forceinline__ void fused(f32x4 (&acc)[2][2][4][2], const Unit& u, int wr, int wc, int fr, int fq, int wid, int lane) const {
        typedef unsigned u32x2v __attribute__((ext_vector_type(2)));
        PG8_LAS float* P = (PG8_LAS float*)xl;
        const PG8_LAS float* S = (const PG8_LAS float*)(xl + 4096);
        const int col0 = u.pn * BM + wc * 32 + 4 * fq;
        st1.run(acc, u, wr, wc, fr, fq, xl, wid, lane);
#pragma unroll
        for (int ai = 0; ai < 2; ++ai)
#pragma unroll
            for (int m = 0; m < 4; ++m) { const int r = ai * HALF + wr * 64 + m * 16 + fr; float rstd = rsqrtf(S[r] * (1.0f / 1024.0f) + 1e-6f); const size_t off = (size_t)(u.pm * BM + r) * 1024 + col0;
                if (s_in) { const f32x4 pp = *(const f32x4*)(s_in + (size_t)(u.pm * BM + r) * 4); const float s2 = __builtin_amdgcn_rcpf(((pp[0] + pp[1]) + (pp[2] + pp[3])) * (1.0f / 1024.0f) + 1e-6f);
                    rstd = rsqrtf(S[r] * (1.0f / 1024.0f) * s2 * s2 + 1e-6f) * s2; }
#pragma unroll
                for (int bj = 0; bj < 2; ++bj)
#pragma unroll
                    for (int n = 0; n < 2; ++n) { const u32x2v hw = *(const u32x2v*)(hn + off + bj * HALF + n * 16);
                        const f32x4 gp = *(const f32x4*)(gprev + col0 + bj * HALF + n * 16); const f32x4 gv = *(const f32x4*)(gpost + col0 + bj * HALF + n * 16);
                        f32x4 xs; xs[0] = __uint_as_float(hw.x << 16) * __builtin_amdgcn_rcpf(gp[0]); xs[1] = __uint_as_float(hw.x & 0xffff0000u) * __builtin_amdgcn_rcpf(gp[1]);
                        xs[2] = __uint_as_float(hw.y << 16) * __builtin_amdgcn_rcpf(gp[2]); xs[3] = __uint_as_float(hw.y & 0xffff0000u) * __builtin_amdgcn_rcpf(gp[3]);
                        acc[ai][bj][m][n] = xs + (acc[ai][bj][m][n] * rstd) * gv; }
                asm volatile("" : "+v"(acc[ai][0][m][0]), "+v"(acc[ai][0][m][1]), "+v"(acc[ai][1][m][0]), "+v"(acc[ai][1][m][1]));
                if (m & 1) asm volatile("" ::: "memory"); }
        if (gpre) {
#pragma unroll
            for (int ai = 0; ai < 2; ++ai)
#pragma unroll
                for (int m = 0; m < 4; ++m) {
                    float s = 0.f;
#pragma unroll
                    for (int bj = 0; bj < 2; ++bj)
#pragma unroll
                        for (int n = 0; n < 2; ++n) { const f32x4 x = acc[ai][bj][m][n]; s += (x[0] * x[0] + x[1] * x[1]) + (x[2] * x[2] + x[3] * x[3]); }
                    s += xor16f(s); s = sum32f(s);
                    if (fq == 0) P[(ai * HALF + wr * 64 + m * 16 + fr) * 4 + wc] = s;
                }
            asm volatile("s_waitcnt lgkmcnt(0)" ::: "memory"); __builtin_amdgcn_s_barrier(); asm volatile("" ::: "memory");
            { const int row = wid * 32 + (lane & 31);
              if (lane < 32) xs2[(size_t)(u.pm * BM + row) * 4 + u.pn] = (P[row * 4 + 0] + P[row * 4 + 1]) + (P[row * 4 + 2] + P[row * 4 + 3]); }
#pragma unroll
            for (int ai = 0; ai < 2; ++ai)
#pragma unroll
                for (int m = 0; m < 4; ++m) { const int r = ai * HALF + wr * 64 + m * 16 + fr; const size_t off = (size_t)(u.pm * BM + r) * 1024 + col0;
#pragma unroll
                    for (int bj = 0; bj < 2; ++bj)
#pragma unroll
                        for (int n = 0; n < 2; ++n) { const f32x4 gv = *(const f32x4*)(gpre + col0 + bj * HALF + n * 16); const f32x4 o = acc[ai][bj][m][n] * gv;
                            u32x2v w; w.x = cvt_pk_bf16(o[0], o[1]); w.y = cvt_pk_bf16(o[2], o[3]); *(u32x2v*)(hn + off + bj * HALF + n * 16) = w; }
                    asm volatile("" ::: "memory"); }
            asm volatile("s_waitcnt lgkmcnt(0)" ::: "memory"); __builtin_amdgcn_s_barrier(); asm volatile("" ::: "memory");
        } else {
#pragma unroll
            for (int ai = 0; ai < 2; ++ai)
#pragma unroll
                for (int m = 0; m < 4; ++m) { const int r = ai * HALF + wr * 64 + m * 16 + fr; const size_t off = (size_t)(u.pm * BM + r) * 1024 + col0;
#pragma unroll
                    for (int bj = 0; bj < 2; ++bj)
#pragma unroll
                        for (int n = 0; n < 2; ++n) *(f32x4*)(out + off + bj * HALF + n * 16) = acc[ai][bj][m][n]; }
        }
    }
};

template <class Epi, class Sched, bool ALIGN_EPI>
__device__ __forceinline__ void gemm_phase(PG8_LAS unsigned char* lds, const Gemm g, const Sched& S, const Epi& E, int tid0) {
    int tid_ = tid0; asm volatile("" : "+v"(tid_));
    const int tid = tid_, wid = __builtin_amdgcn_readfirstlane(tid >> 6), lane = tid & 63, wr = wid >> 2, wc = wid & 3, fr = lane & 15, fq = lane >> 4;
    const int K = g.K, nt = K / BK;
    unsigned voffA[2], voffB[2];
#pragma unroll
    for (int i = 0; i < 2; ++i) { int R, C; stage_rc(tid * 16 + i * 8192, R, C); const int Rb = Epi::PERM ? ((R & ~31) + perm32(R & 31)) : R;
        voffA[i] = (unsigned)(R * g.lda + C) * 2u; voffB[i] = (unsigned)(Rb * g.ldb + C) * 2u; }
    const size_t kstep = (size_t)(BK * 2);
    const size_t hstepA = (size_t)HALF * g.lda * 2, hstepB = (size_t)HALF * g.ldb * 2;
    const size_t tstepA = 2 * hstepA, tstepB = 2 * hstepB;
    const unsigned ldsw = (unsigned)wid * 1024u;
    const int aoff = lds_byte(wr * 64 + fr, fq * 8), boff = lds_byte(wc * 32 + fr, fq * 8);
#define PG8_SA(b, h) (((b) * 2 + (h)) * HTB)
#define PG8_SB(b, h) ((4 + (b) * 2 + (h)) * HTB)
#define PG8_STAGE(bufoff, gbase, voff) do { _Pragma("unroll") for (int _i = 0; _i < 2; ++_i) \
        __builtin_amdgcn_global_load_lds((const unsigned*)((const char*)(gbase) + (voff)[_i]), (PG8_LAS unsigned*)(lds + (bufoff) + ldsw + _i * 8192), 16, 0, 0); } while (0)
#define PG8_LDA(dst, b, h) do { _Pragma("unroll") for (int m = 0; m < 4; ++m) _Pragma("unroll") for (int k = 0; k < 2; ++k) dst[m][k] = *(const PG8_LAS bf16x8*)(lds + PG8_SA(b, h) + aoff + m * 2048 + k * 1024); } while (0)
#define PG8_LDB(dst, b, h) do { _Pragma("unroll") for (int n = 0; n < 2; ++n) _Pragma("unroll") for (int k = 0; k < 2; ++k) dst[n][k] = *(const PG8_LAS bf16x8*)(lds + PG8_SB(b, h) + boff + n * 2048 + k * 1024); } while (0)
#define PG8_MMA(ai, bj, At, Bt) do { __builtin_amdgcn_s_setprio(1); _Pragma("unroll") for (int m = 0; m < 4; ++m) _Pragma("unroll") for (int n = 0; n < 2; ++n) _Pragma("unroll") for (int k = 0; k < 2; ++k) \
        acc[ai][bj][m][n] = __builtin_amdgcn_mfma_f32_16x16x32_bf16(Bt[n][k], At[m][k], acc[ai][bj][m][n], 0, 0, 0); __builtin_amdgcn_s_setprio(0); } while (0)
#define PG8_WAIT_V(n) asm volatile("s_waitcnt vmcnt(" #n ")" ::: "memory")
#define PG8_WAIT_L(n) asm volatile("s_waitcnt lgkmcnt(" #n ")" ::: "memory")
#define PG8_BAR __builtin_amdgcn_s_barrier()
#define PG8_SCHED __builtin_amdgcn_sched_barrier(0)
    Unit cur, nxt; int ui = 0;
    if (!S.next(0, cur)) return;
    f32x4 acc[2][2][4][2];
#pragma unroll
    for (int a = 0; a < 2; ++a)
#pragma unroll
        for (int b = 0; b < 2; ++b)
#pragma unroll
            for (int m = 0; m < 4; ++m)
#pragma unroll
                for (int n = 0; n < 2; ++n) acc[a][b][m][n] = (f32x4){0.f, 0.f, 0.f, 0.f};
    bf16x8 At[4][2], B0[2][2], B1[2][2];
    const char* cA = (const char*)g.A + (size_t)cur.pm * tstepA + (size_t)(cur.pn >> 1) * (size_t)g.apn; const char* cB = (const char*)g.Bt + (size_t)cur.pn * tstepB;
    S.a_ready(cur);
    PG8_STAGE(PG8_SB(0, 0), cB, voffB); PG8_STAGE(PG8_SB(0, 1), cB + hstepB, voffB); PG8_STAGE(PG8_SA(0, 0), cA, voffA); PG8_STAGE(PG8_SA(0, 1), cA + hstepA, voffA);
    if (wr == 1) PG8_BAR;
    PG8_WAIT_V(2); PG8_BAR;
    PG8_STAGE(PG8_SB(1, 0), cB + kstep, voffB); PG8_STAGE(PG8_SA(1, 0), cA + kstep, voffA); PG8_STAGE(PG8_SB(1, 1), cB + hstepB + kstep, voffB);
    PG8_WAIT_V(6); PG8_BAR;
    for (;;) {
        const bool has_next = S.next(ui + 1, nxt);
        const char* nA = has_next ? (const char*)g.A + (size_t)nxt.pm * tstepA + (size_t)(nxt.pn >> 1) * (size_t)g.apn : cA; const char* nB = has_next ? (const char*)g.Bt + (size_t)nxt.pn * tstepB : cB;
        for (int t = 0; t < nt; t += 2) {
            const bool last = (t == nt - 2);
            const char* a1 = cA + (size_t)(t + 1) * kstep;
            const char* a2 = last ? nA : cA + (size_t)(t + 2) * kstep; const char* b2 = last ? nB : cB + (size_t)(t + 2) * kstep;
            const char* a3 = a2 + kstep; const char* b3 = b2 + kstep;
            if (last && has_next) S.a_ready(nxt);
            PG8_LDB(B0, 0, 0); PG8_LDB(B1, 0, 1); PG8_SCHED; PG8_LDA(At, 0, 0); PG8_STAGE(PG8_SA(1, 1), a1 + hstepA, voffA);
            PG8_WAIT_V(8); PG8_WAIT_L(0); PG8_BAR; PG8_MMA(0, 0, At, B0); PG8_MMA(0, 1, At, B1); PG8_BAR; PG8_SCHED;
            PG8_LDA(At, 0, 1); PG8_STAGE(PG8_SB(0, 0), b2, voffB); PG8_STAGE(PG8_SB(0, 1), b2 + hstepB, voffB); PG8_STAGE(PG8_SA(0, 0), a2, voffA);
            PG8_WAIT_V(8); PG8_WAIT_L(0); PG8_BAR; PG8_MMA(1, 0, At, B0); PG8_MMA(1, 1, At, B1); PG8_BAR; PG8_SCHED;
            PG8_LDB(B0, 1, 0); PG8_LDB(B1, 1, 1); PG8_SCHED; PG8_LDA(At, 1, 0); PG8_STAGE(PG8_SA(0, 1), a2 + hstepA, voffA);
            PG8_WAIT_V(8); PG8_WAIT_L(0); PG8_BAR; PG8_MMA(0, 0, At, B0); PG8_MMA(0, 1, At, B1); PG8_BAR; PG8_SCHED;
            PG8_LDA(At, 1, 1); PG8_STAGE(PG8_SB(1, 0), b3, voffB); PG8_STAGE(PG8_SB(1, 1), b3 + hstepB, voffB); PG8_STAGE(PG8_SA(1, 0), a3, voffA);
            PG8_WAIT_V(8); PG8_WAIT_L(0); PG8_BAR; PG8_MMA(1, 0, At, B0); PG8_MMA(1, 1, At, B1); PG8_BAR; PG8_SCHED;
        }
        if constexpr (ALIGN_EPI) { if (wr == 0) PG8_BAR; }
        if constexpr (Epi::FUSED) E.fused(acc, cur, wr, wc, fr, fq, wid, lane); else E(acc, cur, wr, wc, fr, fq);
        S.done(cur);
        if (!has_next) break;
#pragma unroll
        for (int a = 0; a < 2; ++a)
#pragma unroll
            for (int b = 0; b < 2; ++b)
#pragma unroll
                for (int m = 0; m < 4; ++m)
#pragma unroll
                    for (int n = 0; n < 2; ++n) acc[a][b][m][n] = (f32x4){0.f, 0.f, 0.f, 0.f};
        cur = nxt; cA = nA; cB = nB; ++ui;
        if constexpr (ALIGN_EPI) { if (wr == 1) PG8_BAR; }
    }
    PG8_WAIT_V(0);
    if constexpr (!ALIGN_EPI) { if (wr == 0) PG8_BAR; }
    PG8_BAR;
#undef PG8_SA
#undef PG8_SB
#undef PG8_STAGE
#undef PG8_LDA
#undef PG8_LDB
#undef PG8_MMA
#undef PG8_WAIT_V
#undef PG8_WAIT_L
#undef PG8_BAR
#undef PG8_SCHED
}
}
namespace att {
typedef unsigned short u16;
typedef short bf16x8 __attribute__((ext_vector_type(8)));
typedef short s16x4 __attribute__((ext_vector_type(4)));
typedef float f32x16 __attribute__((ext_vector_type(16)));
typedef float f32x4 __attribute__((ext_vector_type(4)));
typedef unsigned u32x4 __attribute__((ext_vector_type(4)));
constexpr int SEQ = 16384, NW = 8, QBLK = 32, KVBLK = 64, QB = NW * QBLK;
constexpr int LDQ = 1536, LDK = 2048, LDKR = 64, LDO = 1024;
#ifndef ATT_NQREG
#define ATT_NQREG 6
#endif
constexpr int NQREG = ATT_NQREG, NQREG_L = 8 - NQREG;
constexpr int SHM_V = KVBLK * 128 * 2, SHM_K = KVBLK * 128 * 2, SHM_KR = KVBLK * 64 * 2;
constexpr int OFF_V = 0, OFF_K = 2 * SHM_V, OFF_KR = OFF_K + 2 * SHM_K, OFF_WS = OFF_KR + 2 * SHM_KR, OFF_QR = OFF_WS + NW * 64 * 4, QR_WAVE = (NQREG_L + 4) * 1024, LDS_BYTES = OFF_QR + NW * QR_WAVE;
constexpr float SCALE = 0.07216878364870322f;
constexpr float THR = 8.f;

#define KSWZ(row, colB) ((row) * 256 + ((colB) ^ (((row) & 7) << 4)))
#define KRSWZ(row, colB) ((row) * 128 + ((colB) ^ (((row) & 7) << 4)))
#define SBAR() __builtin_amdgcn_sched_barrier(0)
__device__ __forceinline__ int v_st(int k, int c) { const int kk = (k & ~0xC) | ((k & 4) << 1) | ((k & 8) >> 1); return ((kk >> 3) * 4 + (c >> 5)) * 512 + ((kk & 7) * 32 + (c & 31)) * 2; }
__device__ __forceinline__ int v_rd_base(int lane) { return ((lane & 3) << 3) | (((lane >> 2) & 3) << 6) | (((lane >> 4) & 1) << 5) | (((lane >> 5) & 1) << 8); }
constexpr int v_rd_off(int d0, int ks, int half) { return d0 * 512 + ks * 4096 + half * 2048; }
__device__ __forceinline__ int crow(int r, int hi) { return (r & 3) + 8 * (r >> 2) + 4 * hi; }
__device__ __forceinline__ unsigned cvtpk(float lo, float hi) { unsigned r; asm volatile("v_cvt_pk_bf16_f32 %0, %1, %2" : "=v"(r) : "v"(lo), "v"(hi)); return r; }
__device__ __forceinline__ bf16x8 load8(const u16* p) { return *reinterpret_cast<const bf16x8*>(p); }
__device__ __forceinline__ void mask_tile(f32x16& p0, f32x16& p1, int dq, unsigned W) {
    const float NEG = -__builtin_inff();
#pragma unroll
    for (int r = 0; r < 16; ++r) {
        const int c = (r & 3) + 8 * (r >> 2);
        if ((unsigned)(dq - c) >= W) p0[r] = NEG;
        if ((unsigned)(dq - c - 32) >= W) p1[r] = NEG;
    }
}
__device__ __forceinline__ void partialSM(f32x16& p0, f32x16& p1, float& m_reg, float& mn, float& alpha) {
    float pmax = p0[0]; for (int r = 1; r < 16; ++r) pmax = fmaxf(pmax, p0[r]); for (int r = 0; r < 16; ++r) pmax = fmaxf(pmax, p1[r]);
    { auto rr = __builtin_amdgcn_permlane32_swap(__float_as_uint(pmax), __float_as_uint(pmax), false, false);
      pmax = fmaxf(__uint_as_float(rr[0]), __uint_as_float(rr[1])); }
    constexpr float C2 = 1.4426950408889634f * SCALE;
    if (__builtin_expect(__all((pmax - m_reg) * SCALE <= THR), 1)) { mn = m_reg; alpha = 1.f; }
    else { mn = fmaxf(m_reg, pmax); alpha = __builtin_amdgcn_exp2f((m_reg - mn) * C2); m_reg = mn; }
    const float mnL = -mn * C2;
    for (int r = 0; r < 16; ++r) p0[r] = fmaf(p0[r], C2, mnL); for (int r = 0; r < 16; ++r) p1[r] = fmaf(p1[r], C2, mnL);
    for (int r = 0; r < 16; ++r) p0[r] = __builtin_amdgcn_exp2f(p0[r]);
}
__device__ __forceinline__ void finishSM(f32x16& p0, f32x16& p1, float alpha, float& l_reg, bf16x8& pa0, bf16x8& pa1, bf16x8& pa2, bf16x8& pa3) {
    for (int r = 0; r < 16; ++r) p1[r] = __builtin_amdgcn_exp2f(p1[r]);
    float ps = 0; for (int r = 0; r < 16; ++r) ps += p0[r]; for (int r = 0; r < 16; ++r) ps += p1[r];
    { auto rr = __builtin_amdgcn_permlane32_swap(__float_as_uint(ps), __float_as_uint(ps), false, false);
      ps = __uint_as_float(rr[0]) + __uint_as_float(rr[1]); }
    l_reg = l_reg * alpha + ps;
#define PK4(P, B_, OUT) do { unsigned a0 = cvtpk(P[B_+0], P[B_+1]), a1 = cvtpk(P[B_+2], P[B_+3]);                          \
        unsigned b0 = cvtpk(P[B_+4], P[B_+5]), b1 = cvtpk(P[B_+6], P[B_+7]);                                             \
        auto r0 = __builtin_amdgcn_permlane32_swap(a0, b0, false, false); auto r1 = __builtin_amdgcn_permlane32_swap(a1, b1, false, false); \
        u32x4 w = {r0[0], r1[0], r0[1], r1[1]}; OUT = *reinterpret_cast<bf16x8*>(&w); } while (0)
    PK4(p0, 0, pa0); PK4(p0, 8, pa1); PK4(p1, 0, pa2); PK4(p1, 8, pa3);
#undef PK4
}
#ifndef ATT_PF
#define ATT_PF 2
#endif
#define QK_SB() __builtin_amdgcn_sched_barrier(0x406)
#define QK_LOAD(s, SET) do { if ((s) < 8) { const char* a_ = kb[(s) & 3] + ((s) >> 2) * 128; fb0[SET] = *reinterpret_cast<const bf16x8*>(a_); fb1[SET] = *reinterpret_cast<const bf16x8*>(a_ + 32 * 256); \
            if ((s) < NQREG) fq[SET] = qr[(s) < NQREG ? (s) : 0]; else fq[SET] = qrl[((s) - NQREG) * 64]; } \
        else { const char* a_ = krb[((s) - 8) & 3]; fb0[SET] = *reinterpret_cast<const bf16x8*>(a_); fb1[SET] = *reinterpret_cast<const bf16x8*>(a_ + 32 * 128); fq[SET] = qrl[(NQREG_L + (s) - 8) * 64]; } } while (0)
template <int KB>
__device__ __forceinline__ void qkt(f32x16& p0, f32x16& p1, const char* K_lds, const char* KR_lds, const bf16x8* qrl, int r32, int hi, const bf16x8* qr) {
    constexpr int PF = ATT_PF, NS = PF + 1;
    p0 = f32x16{}; p1 = f32x16{};
    const char* kb[4]; const char* krb[4];
#pragma unroll
    for (int dd = 0; dd < 4; ++dd) { kb[dd] = K_lds + KB * SHM_K + KSWZ(r32, (dd * 16 + hi * 8) * 2); krb[dd] = KR_lds + KB * SHM_KR + KRSWZ(r32, (dd * 16 + hi * 8) * 2); }
    bf16x8 fb0[NS], fb1[NS], fq[NS];
#pragma unroll
    for (int s = 0; s < PF; ++s) QK_LOAD(s, s % NS);
#pragma unroll
    for (int s = 0; s < 12; ++s) {
        QK_SB();
        if (s + PF < 12) QK_LOAD(s + PF, (s + PF) % NS);
        QK_SB();
        p0 = __builtin_amdgcn_mfma_f32_32x32x16_bf16(fb0[s % NS], fq[s % NS], p0, 0, 0, 0);
        p1 = __builtin_amdgcn_mfma_f32_32x32x16_bf16(fb1[s % NS], fq[s % NS], p1, 0, 0, 0);
    }
    QK_SB();
}
#undef QK_LOAD
template <int VB>
__device__ __forceinline__ void pv_tile(f32x16* o, int vb0, bf16x8 pa0, bf16x8 pa1, bf16x8 pa2, bf16x8 pa3) {
#define TRRD(dst, off) asm volatile("ds_read_b64_tr_b16 %0, %1 offset:%2" : "=&v"(dst) : "v"(vb0), "i"(off) : "memory")
#define PV_D0(d0) do { s16x4 l0, l1, l2, l3, h0, h1, h2, h3; constexpr int b_ = OFF_V + VB * SHM_V + v_rd_off(d0, 0, 0); \
        TRRD(l0, b_); TRRD(h0, b_ + 2048); TRRD(l1, b_ + 4096); TRRD(h1, b_ + 6144); TRRD(l2, b_ + 8192); TRRD(h2, b_ + 10240); TRRD(l3, b_ + 12288); TRRD(h3, b_ + 14336); \
        asm volatile("s_waitcnt lgkmcnt(0)" ::: "memory"); SBAR();   \
        o[d0] = __builtin_amdgcn_mfma_f32_32x32x16_bf16(pa0, (bf16x8){l0[0], l0[1], l0[2], l0[3], h0[0], h0[1], h0[2], h0[3]}, o[d0], 0, 0, 0);   \
        o[d0] = __builtin_amdgcn_mfma_f32_32x32x16_bf16(pa1, (bf16x8){l1[0], l1[1], l1[2], l1[3], h1[0], h1[1], h1[2], h1[3]}, o[d0], 0, 0, 0);   \
        o[d0] = __builtin_amdgcn_mfma_f32_32x32x16_bf16(pa2, (bf16x8){l2[0], l2[1], l2[2], l2[3], h2[0], h2[1], h2[2], h2[3]}, o[d0], 0, 0, 0);   \
        o[d0] = __builtin_amdgcn_mfma_f32_32x32x16_bf16(pa3, (bf16x8){l3[0], l3[1], l3[2], l3[3], h3[0], h3[1], h3[2], h3[3]}, o[d0], 0, 0, 0); } while (0)
    PV_D0(0); PV_D0(1); PV_D0(2); PV_D0(3);
}
template <int VB>
__device__ __forceinline__ void pv_tile_sm(f32x16* o, int vb0, bf16x8 pa0, bf16x8 pa1, bf16x8 pa2, bf16x8 pa3, f32x16& p0, f32x16& p1, float& m_reg, float& mn, float& alpha) {
    constexpr float C2 = 1.4426950408889634f * SCALE;
    PV_D0(0);
    float pmax = p0[0];
#pragma unroll
    for (int r = 1; r < 16; ++r) pmax = fmaxf(pmax, p0[r]);
#pragma unroll
    for (int r = 0; r < 16; ++r) pmax = fmaxf(pmax, p1[r]);
    PV_D0(1);
    { auto rr = __builtin_amdgcn_permlane32_swap(__float_as_uint(pmax), __float_as_uint(pmax), false, false);
      pmax = fmaxf(__uint_as_float(rr[0]), __uint_as_float(rr[1])); }
    const bool keep = __all((pmax - m_reg) * SCALE <= THR);
    mn = keep ? m_reg : fmaxf(m_reg, pmax);
    alpha = __builtin_amdgcn_exp2f((m_reg - mn) * C2);
    m_reg = mn;
    const float mnL = -mn * C2;
#pragma unroll
    for (int r = 0; r < 16; ++r) p0[r] = fmaf(p0[r], C2, mnL);
    PV_D0(2);
#pragma unroll
    for (int r = 0; r < 16; ++r) p1[r] = fmaf(p1[r], C2, mnL);
#pragma unroll
    for (int r = 0; r < 8; ++r) p0[r] = __builtin_amdgcn_exp2f(p0[r]);
    PV_D0(3);
#pragma unroll
    for (int r = 8; r < 16; ++r) p0[r] = __builtin_amdgcn_exp2f(p0[r]);
}
#undef PV_D0
#undef TRRD

struct BlockRef { const u16* Q; const u16* K; const u16* V; const u16* KR; u16* O; int P0; int row0; };
#define VMW() asm volatile("s_waitcnt vmcnt(0)" ::: "memory")
#define ATT_LAS __attribute__((address_space(3)))
#define KDMA(Kp, KRp, k0, bf) do { \
        __builtin_amdgcn_global_load_lds((const unsigned*)((Kp) + (size_t)((k0) + sr) * LDK + ksc), (ATT_LAS unsigned*)(ldsL + OFF_K + (bf) * SHM_K + wid * 1024), 16, 0, 0); \
        __builtin_amdgcn_global_load_lds((const unsigned*)((Kp) + (size_t)((k0) + 32 + sr) * LDK + ksc), (ATT_LAS unsigned*)(ldsL + OFF_K + (bf) * SHM_K + 8192 + wid * 1024), 16, 0, 0); \
        __builtin_amdgcn_global_load_lds((const unsigned*)((KRp) + (size_t)((k0) + krr) * LDKR + krsc), (ATT_LAS unsigned*)(ldsL + OFF_KR + (bf) * SHM_KR + wid * 1024), 16, 0, 0); } while (0)
#define VDMA(Vp, k0, bf) do { \
        __builtin_amdgcn_global_load_lds((const unsigned*)((Vp) + (size_t)((k0) + vk) * LDK + vc), (ATT_LAS unsigned*)(ldsL + OFF_V + (bf) * SHM_V + wid * 1024), 16, 0, 0); \
        __builtin_amdgcn_global_load_lds((const unsigned*)((Vp) + (size_t)((k0) + 32 + vk) * LDK + vc), (ATT_LAS unsigned*)(ldsL + OFF_V + (bf) * SHM_V + 8192 + wid * 1024), 16, 0, 0); } while (0)
#define ATT_MAPS() const int sr = tid >> 4, ksc = ((tid & 15) ^ (sr & 7)) * 8, krr = tid >> 3, krsc = ((tid & 7) ^ (krr & 7)) * 8; ATT_LAS unsigned char* ldsL = (ATT_LAS unsigned char*)lds; \
    const int vkk_ = ((tid >> 7) << 3) | ((tid >> 2) & 7), vk = (vkk_ & ~0xC) | ((vkk_ & 4) << 1) | ((vkk_ & 8) >> 1), vc = ((tid >> 5) & 3) * 32 + (tid & 3) * 8
__device__ __forceinline__ void attn_prime(const BlockRef& cur, char* lds, int tid0) {
    int tid_ = tid0; asm volatile("" : "+v"(tid_));
    const int tid = tid_, wid = __builtin_amdgcn_readfirstlane(tid >> 6);
    ATT_MAPS();
    KDMA(cur.K, cur.KR, 0, 0); VDMA(cur.V, 0, 0); VMW();
    __syncthreads();
}
__device__ __forceinline__ void attn_block(const BlockRef& cur, const BlockRef& nxt, char* lds, int tid0, const float* ctab, const float* stab) {
    int tid_ = tid0; asm volatile("" : "+v"(tid_));
    const int tid = tid_, wid = __builtin_amdgcn_readfirstlane(tid >> 6), lane = tid & 63, r32 = lane & 31, hi = lane >> 5;
    const unsigned W = 0x40000000u;
    const int NT = (cur.P0 + QB - 1) / KVBLK + 1;
    const int qlo = cur.P0 + wid * QBLK, qm = qlo + r32 - 4 * hi;
    char* K_lds = lds + OFF_K; char* KR_lds = lds + OFF_KR;
    float* ws = (float*)(lds + OFF_WS) + wid * 64; float* li_l = ws, * al_l = ws + 32;
    bf16x8* qrl = (bf16x8*)(lds + OFF_QR + wid * QR_WAVE) + lane;
    float m_reg = -1e30f, l_reg = 0; f32x16 o[4] = {};
    ATT_MAPS();
    const int vb0 = (int)(uintptr_t)lds + v_rd_base(lane);
    const u16* Kh = cur.K; const u16* Vh = cur.V; const u16* KRh = cur.KR;
#define RESC(a) do { if (__any((a) < 1.f)) { if (hi == 0) al_l[r32] = (a); asm volatile("s_waitcnt lgkmcnt(0)" ::: "memory");              \
                     for (int d_ = 0; d_ < 4; ++d_) for (int r = 0; r < 16; ++r) o[d_][r] *= al_l[crow(r, hi)]; } } while (0)
#define KBASE(t) ((t) * KVBLK)
#define MASKT(P0_, P1_, t) do { const int kb_ = KBASE(t); if (kb_ + KVBLK - 1 > qlo) mask_tile(P0_, P1_, qm - kb_, W); } while (0)
    f32x16 pA0, pA1, pB0, pB1; float mnA, mnB, alA, alB; bf16x8 pa0, pa1, pa2, pa3;
    bf16x8 qr[NQREG > 0 ? NQREG : 1];
    { const u16* qp = cur.Q + (size_t)(wid * QBLK + r32) * LDQ + hi * 8;
#pragma unroll
      for (int d = 0; d < NQREG_L; ++d) qrl[d * 64] = load8(qp + (NQREG + d) * 16);
      const size_t trow = (size_t)(cur.row0 + wid * QBLK + r32) * 32 + hi * 8;
#pragma unroll
      for (int pr = 0; pr < 2; ++pr) {
          const bf16x8 x1 = load8(qp + 128 + pr * 16), x2 = load8(qp + 128 + 32 + pr * 16);
          const f32x4 c0 = *(const f32x4*)(ctab + trow + pr * 16), c1 = *(const f32x4*)(ctab + trow + pr * 16 + 4), s0 = *(const f32x4*)(stab + trow + pr * 16), s1 = *(const f32x4*)(stab + trow + pr * 16 + 4);
          float o1[8], o2[8];
#pragma unroll
          for (int e = 0; e < 8; ++e) { const float a = __uint_as_float(((unsigned)(unsigned short)x1[e]) << 16), b = __uint_as_float(((unsigned)(unsigned short)x2[e]) << 16);
              const float cc = e < 4 ? c0[e & 3] : c1[e & 3], ss = e < 4 ? s0[e & 3] : s1[e & 3]; o1[e] = a * cc - b * ss; o2[e] = b * cc + a * ss; }
          u32x4 w1 = {cvtpk(o1[0], o1[1]), cvtpk(o1[2], o1[3]), cvtpk(o1[4], o1[5]), cvtpk(o1[6], o1[7])}, w2 = {cvtpk(o2[0], o2[1]), cvtpk(o2[2], o2[3]), cvtpk(o2[4], o2[5]), cvtpk(o2[6], o2[7])};
          qrl[(NQREG_L + pr) * 64] = *reinterpret_cast<bf16x8*>(&w1); qrl[(NQREG_L + 2 + pr) * 64] = *reinterpret_cast<bf16x8*>(&w2); }
#pragma unroll
      for (int d0 = 0; d0 < NQREG; ++d0) qr[d0] = load8(qp + d0 * 16); }
    SBAR();
    KDMA(Kh, KRh, KBASE(1), 1); VDMA(Vh, KBASE(1), 1);
    SBAR(); qkt<0>(pA0, pA1, K_lds, KR_lds, qrl, r32, hi, qr);
    MASKT(pA0, pA1, 0); partialSM(pA0, pA1, m_reg, mnA, alA);
    VMW(); __syncthreads();
    KDMA(Kh, KRh, KBASE(2), 0);
#define HALF_STEP(PX0, PX1, mnX, alX, PY0, PY1, alY, t, KB, VB) do {                                                          \
        SBAR(); qkt<KB>(PX0, PX1, K_lds, KR_lds, qrl, r32, hi, qr);                                                          \
        finishSM(PY0, PY1, alY, l_reg, pa0, pa1, pa2, pa3); SBAR();                                                           \
        MASKT(PX0, PX1, (t)); SBAR(); pv_tile_sm<VB>(o, vb0, pa0, pa1, pa2, pa3, PX0, PX1, m_reg, mnX, alX);                  \
        VMW(); __syncthreads();                                                                                               \
        if ((t) + 2 < NT) KDMA(Kh, KRh, KBASE((t) + 2), KB);                                                                  \
        if ((t) + 1 < NT) VDMA(Vh, KBASE((t) + 1), VB);                                                                       \
        SBAR(); RESC(alX); } while (0)
    for (int t = 1; t + 1 < NT; t += 2) {
        HALF_STEP(pB0, pB1, mnB, alB, pA0, pA1, alA, t, 1, 0);
        HALF_STEP(pA0, pA1, mnA, alA, pB0, pB1, alB, t + 1, 0, 1);
    }
    SBAR(); qkt<1>(pB0, pB1, K_lds, KR_lds, qrl, r32, hi, qr);
    finishSM(pA0, pA1, alA, l_reg, pa0, pa1, pa2, pa3); SBAR();
    MASKT(pB0, pB1, NT - 1); SBAR(); pv_tile_sm<0>(o, vb0, pa0, pa1, pa2, pa3, pB0, pB1, m_reg, mnB, alB);
    VMW(); __syncthreads();
    KDMA(nxt.K, nxt.KR, 0, 0); VDMA(nxt.V, 0, 0);
    SBAR(); RESC(alB);
    finishSM(pB0, pB1, alB, l_reg, pa0, pa1, pa2, pa3); SBAR(); pv_tile<1>(o, vb0, pa0, pa1, pa2, pa3);
    SBAR();
    if (hi == 0) li_l[r32] = l_reg; asm volatile("s_waitcnt lgkmcnt(0)" ::: "memory");
    float rli[16];
#pragma unroll
    for (int r = 0; r < 16; ++r) rli[r] = __builtin_amdgcn_rcpf(li_l[crow(r, hi)]);
    u16* Ow = cur.O + (size_t)(wid * QBLK) * LDO;
#pragma unroll
    for (int r = 0; r < 16; ++r) { const int orow = crow(r, hi);
#pragma unroll
        for (int d0 = 0; d0 < 4; ++d0) { const float v = o[d0][r] * rli[r];
            const float vn = xor1f(v);
            if ((r32 & 1) == 0) *(unsigned*)(Ow + (size_t)orow * LDO + d0 * 32 + r32) = cvtpk(v, vn); } }
    VMW(); __syncthreads();
#undef RESC
#undef KBASE
#undef MASKT
#undef HALF_STEP
}
struct Tensors { const u16* q; const u16* kv; const u16* kr; u16* o; const float* ctab; const float* stab; };
__device__ __forceinline__ BlockRef make_ref(const Tensors& T, int L, int pass) {
    const int bh = (L & 7) + 8 * (L >> 8), x = (L >> 3) & 31, b = bh >> 3, h = bh & 7, qb = pass ? 63 - x : x;
    BlockRef r; const size_t row0 = (size_t)b * SEQ;
    r.Q = T.q + (row0 + (size_t)qb * QB) * LDQ + h * 192; r.K = T.kv + row0 * LDK + h * 256; r.V = r.K + 128; r.KR = T.kr + row0 * LDKR;
    r.O = T.o + (row0 + (size_t)qb * QB) * LDO + h * 128; r.P0 = qb * QB; r.row0 = b * SEQ + qb * QB;
    return r;
}
__device__ __forceinline__ void attn_phase(char* lds, const Tensors& T, int tid0) {
    const int total = 512, stride = gridDim.x;
    int L = blockIdx.x; if (L >= total) return;
    int pass = 0;
    BlockRef cur = make_ref(T, L, 0);
    attn_prime(cur, lds, tid0);
    for (;;) {
        const bool more_pass = pass == 0, more_item = L + stride < total, last = !more_pass && !more_item;
        int passn = pass + 1, Ln = L;
        if (!more_pass) { passn = 0; Ln = more_item ? L + stride : L; }
        const BlockRef nxt = last ? cur : make_ref(T, Ln, passn);
        attn_block(cur, nxt, lds, tid0, T.ctab, T.stab);
        if (last) break;
        cur = nxt; pass = passn; L = Ln;
    }
}
#undef VMW
#undef KDMA
#undef VDMA
#undef ATT_MAPS
#undef SBAR
}
namespace xb {
#define LAS __attribute__((address_space(3)))
#define XB_TMO      128
#define XB_XCNT(j)  (256  + 64 * (j))
#define XB_XSUB(j)  (1280 + 64 * (j))
#define XB_XGEN(j)  (2304 + 64 * (j))
#define XB_TOP      3328
#define XB_TOPGEN   3392
#define XCD_BAR_WORDS 3456
#define XB_SPIN_CAP (1u << 18)

__device__ __forceinline__ unsigned xb_ld(unsigned* p)              { return __hip_atomic_load(p, __ATOMIC_RELAXED, __HIP_MEMORY_SCOPE_AGENT); }
__device__ __forceinline__ unsigned xb_add(unsigned* p, unsigned v) { return __hip_atomic_fetch_add(p, v, __ATOMIC_RELAXED, __HIP_MEMORY_SCOPE_AGENT); }
__device__ __forceinline__ unsigned xb_xcc_id() { return (unsigned)__builtin_amdgcn_s_getreg((3 << 11) | 20) & 0xFu; }
#define XB_SPIN(cond, bar) do { unsigned _sp = 0; while (cond) { __builtin_amdgcn_s_sleep(1); \
    if ((++_sp & 255u) == 0u) { if (xb_ld(&(bar)[XB_TMO])) break; if (_sp > XB_SPIN_CAP) { atomicAdd(&(bar)[XB_TMO], 1u); break; } } } } while (0)

struct XcdBarrier {
    unsigned* bar; unsigned x;
    volatile LAS unsigned* st;
};

__device__ __forceinline__ XcdBarrier xcd_barrier_post(unsigned* bar, volatile LAS unsigned* st) {
    XcdBarrier b; b.bar = bar; b.x = xb_xcc_id(); b.st = st;
    if (threadIdx.x == 0) (void)xb_add(&bar[XB_XCNT(b.x)], 1u);
    return b;
}
__device__ __forceinline__ void xcd_barrier_complete(unsigned* bar, unsigned x, unsigned& nloc, unsigned& nx) {
    const unsigned G = gridDim.x * gridDim.y * gridDim.z;
    unsigned sum, cnt, mine, sp = 0u;
    for (;;) {
        sum = 0u; cnt = 0u; mine = 0u;
#pragma unroll
        for (unsigned j = 0; j < 16; ++j) { const unsigned c = xb_ld(&bar[XB_XCNT(j)]); sum += c; cnt += (c > 0u) ? 1u : 0u; mine = (j == x) ? c : mine; }
        if (sum == G) break;
        __builtin_amdgcn_s_sleep(1);
        if ((++sp & 255u) == 0u) { if (xb_ld(&bar[XB_TMO])) break; if (sp > XB_SPIN_CAP) { atomicAdd(&bar[XB_TMO], 1u); break; } }
    }
    nloc = mine > 0u ? mine : 1u; nx = cnt > 0u ? cnt : 1u;
}

__device__ __forceinline__ void xcd_barrier(const XcdBarrier& b, bool t0  ) {
    asm volatile("s_waitcnt vmcnt(0)" ::: "memory");
    __syncthreads();
    if (t0) {
        unsigned* bar = b.bar;
        __builtin_amdgcn_s_waitcnt(0);
        unsigned nloc = b.st[0], nx = b.st[1];
        if (nloc == 0u) { xcd_barrier_complete(bar, b.x, nloc, nx); b.st[0] = nloc; b.st[1] = nx; }
        const unsigned old = xb_add(&bar[XB_XSUB(b.x)], 1u);
        const unsigned gen = old / nloc;
        if (old + 1u == (gen + 1u) * nloc) {
            __builtin_amdgcn_fence(__ATOMIC_RELEASE, "agent");
            asm volatile("s_waitcnt vmcnt(0)" ::: "memory");
            const unsigned og = xb_add(&bar[XB_TOP], 1u);
            const unsigned tg = og / nx;
            if (og + 1u == (tg + 1u) * nx) xb_add(&bar[XB_TOPGEN], 1u);
            else XB_SPIN(xb_ld(&bar[XB_TOPGEN]) == tg, bar);
            __builtin_amdgcn_fence(__ATOMIC_ACQUIRE, "agent");
            xb_add(&bar[XB_XGEN(b.x)], 1u);
            asm volatile("s_waitcnt vmcnt(0)" ::: "memory");
        } else {
            XB_SPIN(xb_ld(&bar[XB_XGEN(b.x)]) == gen, bar);
            __builtin_amdgcn_fence(__ATOMIC_ACQUIRE, "agent");
            asm volatile("s_waitcnt vmcnt(0)" ::: "memory");
        }
    }
    __syncthreads();
}
#undef LAS
}
#ifndef PROBE_ATT_REPS
#define PROBE_ATT_REPS 1
#endif
#ifndef PROBE_SYNC_REPS
#define PROBE_SYNC_REPS 1
#endif
#ifndef PROBE_THIN_REPS
#define PROBE_THIN_REPS 1
#endif
#ifndef PROBE_PRO_REPS
#define PROBE_PRO_REPS 1
#endif
#ifndef PROBE_GEMM_REPS
#define PROBE_GEMM_REPS 1
#endif
namespace mk {
typedef unsigned short u16;
typedef float f32x4 __attribute__((ext_vector_type(4)));
constexpr int M = 32768, D = 1024, SEQ = 16384;
constexpr float EPS = 1e-6f;
constexpr size_t MB = (size_t)1 << 20;
__host__ __device__ constexpr size_t WT_MLA(int j) { return (size_t)j * 6 * MB; }
__host__ __device__ constexpr size_t WT_LRU(int j) { return 12 * MB + (size_t)j * 8 * MB; }
__host__ __device__ constexpr size_t WT_FFN(int l) { return 28 * MB + (size_t)l * 16 * MB; }
constexpr size_t OFF_UQ = 3 * MB / 2, OFF_UKV = 11 * MB / 4, OFF_WO = 15 * MB / 4, OFF_GT = 4 * MB, OFF_LOUT = 5 * MB, OFF_DOWN = 8 * MB;
constexpr size_t WS_COS = 96 * MB, WS_SIN = 100 * MB, WS_SA = 104 * MB, WS_SB = 105 * MB;
constexpr size_t WS_HN = 112 * MB, WS_Y = 176 * MB, WS_U = 240 * MB, WS_END = 496 * MB;
constexpr size_t U_PROJ = 64 * MB, U_CQ = 112 * MB, U_CKV = 136 * MB, U_KR = 152 * MB, U_Q = 160 * MB, U_O = 64 * MB;
constexpr size_t U_GATE = 0, U_XC = 64 * MB, U_REC = 128 * MB, U_LA = 128 * MB, U_B = 192 * MB;
constexpr size_t WS_XSA = 108 * MB, WS_XSB = 109 * MB;
constexpr size_t WS_RS = 108 * MB;
constexpr int SCAN_L = 128, SCAN_NC = SEQ / SCAN_L;

__device__ __forceinline__ unsigned f2bf(float f) { unsigned u = __float_as_uint(f); return (u + 0x7fffu + ((u >> 16) & 1u)) >> 16; }
__device__ __forceinline__ unsigned pk2(float lo, float hi) { return f2bf(lo) | (f2bf(hi) << 16); }
__device__ __forceinline__ float bflo(unsigned w) { return __uint_as_float(w << 16); }
__device__ __forceinline__ float bfhi(unsigned w) { return __uint_as_float(w & 0xffff0000u); }
__device__ __forceinline__ float bf1(u16 h) { return __uint_as_float(((unsigned)h) << 16); }
__device__ __forceinline__ float wave_sum(float v) {
    v += xor1f(v); v += xor2f(v); v += xor4f(v); v += xor8f(v); v += xor16f(v);
    return sum32f(v);
}
__device__ __forceinline__ void transpose_item(const float* W, int ldw, u16* WT, int ldt, int nblk, float* scr, int item, int lane) {
    const int kb = item / nblk, nb = item % nblk, k0 = 64 * kb, n0 = 32 * nb;
#pragma unroll
    for (int i = 0; i < 8; ++i) { const int kk = 8 * i + (lane >> 3); const f32x4 v = *(const f32x4*)(W + (size_t)(k0 + kk) * ldw + n0 + (lane & 7) * 4);
        float* s = scr + kk * 33 + (lane & 7) * 4; s[0] = v.x; s[1] = v.y; s[2] = v.z; s[3] = v.w; }
    asm volatile("s_waitcnt lgkmcnt(0)" ::: "memory");
    const int c = lane & 7;
#pragma unroll
    for (int j = 0; j < 4; ++j) { const int n = (lane >> 3) + 8 * j; const float* s = scr + (8 * c) * 33 + n;
        uint4 o; o.x = pk2(s[0 * 33], s[1 * 33]); o.y = pk2(s[2 * 33], s[3 * 33]); o.z = pk2(s[4 * 33], s[5 * 33]); o.w = pk2(s[6 * 33], s[7 * 33]);
        *(uint4*)(WT + (size_t)(n0 + n) * ldt + k0 + 8 * c) = o; }
    asm volatile("s_waitcnt lgkmcnt(0)" ::: "memory");
}
struct Params { const float* in[23]; float* out; unsigned char* ws; };
enum { I_X = 0, I_POS, I_MIXPRE, I_MIXPOST, I_FFNPRE, I_FFNPOST, I_MLA_WIN, I_MLA_QN, I_MLA_KVN, I_MLA_WUQ, I_MLA_WUKV, I_MLA_WO,
       I_LRU_WIN, I_LRU_CW, I_LRU_CB, I_LRU_WA, I_LRU_BA, I_LRU_WX, I_LRU_BX, I_LRU_LAM, I_LRU_WOUT, I_FFN_UP, I_FFN_DOWN };

__device__ __forceinline__ void prologue_weights(const __attribute__((address_space(4))) Params& p, float* scr, int gw, int NGW, int lane) {
    u16* wt = (u16*)p.ws;
    constexpr int IT_MLA = 352 + 288 + 256 + 512, IT_LRU = 1024 + 128 + 512, IT_FFN = 4096, TOTAL = 2 * IT_MLA + 2 * IT_LRU + 4 * IT_FFN;
    for (int it = gw; it < TOTAL; it += NGW) {
        int r = it; const float* W; int ldw, ldt, nblk; u16* WT;
        if (r < 2 * IT_MLA) { const int j = r / IT_MLA; r -= j * IT_MLA; u16* base = wt + WT_MLA(j) / 2;
            if (r < 352) { W = p.in[I_MLA_WIN] + (size_t)j * 1024 * 704; ldw = 704; nblk = 22; WT = base; ldt = 1024; }
            else if (r < 640) { r -= 352; W = p.in[I_MLA_WUQ] + (size_t)j * 384 * 1536; ldw = 1536; nblk = 48; WT = base + OFF_UQ / 2; ldt = 384; }
            else if (r < 896) { r -= 640; W = p.in[I_MLA_WUKV] + (size_t)j * 256 * 2048; ldw = 2048; nblk = 64; WT = base + OFF_UKV / 2; ldt = 256; }
            else { r -= 896; W = p.in[I_MLA_WO] + (size_t)j * 1024 * 1024; ldw = 1024; nblk = 32; WT = base + OFF_WO / 2; ldt = 1024; }
        } else if (r < 2 * IT_MLA + 2 * IT_LRU) { r -= 2 * IT_MLA; const int j = r / IT_LRU; r -= j * IT_LRU; u16* base = wt + WT_LRU(j) / 2;
            if (r < 1024) { W = p.in[I_LRU_WIN] + (size_t)j * 1024 * 2048; ldw = 2048; nblk = 64; WT = base; ldt = 1024; }
            else if (r < 1152) { r -= 1024; const int which = r >> 3, gt = which >> 3, n = which & 7; r &= 7;
                W = p.in[gt ? I_LRU_WX : I_LRU_WA] + (size_t)j * 8 * 128 * 128 + (size_t)n * 128 * 128; ldw = 128; nblk = 4;
                WT = base + OFF_GT / 2 + (size_t)(n * 256 + gt * 128) * 256 + 128 * (n & 1); ldt = 256; }
            else { r -= 1152; W = p.in[I_LRU_WOUT] + (size_t)j * 1024 * 1024; ldw = 1024; nblk = 32; WT = base + OFF_LOUT / 2; ldt = 1024; }
        } else { r -= 2 * IT_MLA + 2 * IT_LRU; const int l = r / IT_FFN; r -= l * IT_FFN; u16* base = wt + WT_FFN(l) / 2;
            if (r < 2048) { W = p.in[I_FFN_UP] + (size_t)l * 1024 * 4096; ldw = 4096; nblk = 128; WT = base; ldt = 1024; }
            else { r -= 2048; W = p.in[I_FFN_DOWN] + (size_t)l * 4096 * 1024; ldw = 1024; nblk = 32; WT = base + OFF_DOWN / 2; ldt = 4096; }
        }
        transpose_item(W, ldw, WT, ldt, nblk, scr, r, lane);
    }
}
__device__ __forceinline__ void rowop(const u16* y, const float* xin, float* xout, u16* hn, float* rs, const float* gpost, const float* gpre, int gw, int NGW, int lane) {
    f32x4 gp[4], gq[4];
#pragma unroll
    for (int j = 0; j < 4; ++j) { gp[j] = gpost ? *(const f32x4*)(gpost + j * 256 + lane * 4) : (f32x4){0.f, 0.f, 0.f, 0.f}; gq[j] = gpre ? *(const f32x4*)(gpre + j * 256 + lane * 4) : (f32x4){0.f, 0.f, 0.f, 0.f}; }
    for (int row = gw; row < M; row += NGW) {
        f32x4 xv[4];
#pragma unroll
        for (int j = 0; j < 4; ++j) xv[j] = *(const f32x4*)(xin + (size_t)row * D + j * 256 + lane * 4);
        if (y) {
            f32x4 yv[4]; float ss = 0.f;
#pragma unroll
            for (int j = 0; j < 4; ++j) { const uint2 w = *(const uint2*)(y + (size_t)row * D + j * 256 + lane * 4);
                yv[j] = (f32x4){bflo(w.x), bfhi(w.x), bflo(w.y), bfhi(w.y)}; ss += (yv[j].x * yv[j].x + yv[j].y * yv[j].y) + (yv[j].z * yv[j].z + yv[j].w * yv[j].w); }
            const float r = rsqrtf(wave_sum(ss) * (1.f / D) + EPS);
#pragma unroll
            for (int j = 0; j < 4; ++j) xv[j] = xv[j] + (yv[j] * r) * gp[j];
        }
        if (xout) {
#pragma unroll
        for (int j = 0; j < 4; ++j) *(f32x4*)(xout + (size_t)row * D + j * 256 + lane * 4) = xv[j]; }
        if (gpre) {
            float s2 = 0.f;
#pragma unroll
            for (int j = 0; j < 4; ++j) s2 += (xv[j].x * xv[j].x + xv[j].y * xv[j].y) + (xv[j].z * xv[j].z + xv[j].w * xv[j].w);
            const float tot2 = wave_sum(s2); const float r2 = 1.0f;
            if (rs && lane < 4) rs[(size_t)row * 4 + lane] = lane == 0 ? tot2 : 0.f;
#pragma unroll
            for (int j = 0; j < 4; ++j) { const f32x4 h = (xv[j] * r2) * gq[j]; uint2 w; w.x = pk2(h.x, h.y); w.y = pk2(h.z, h.w);
                *(uint2*)(hn + (size_t)row * D + j * 256 + lane * 4) = w; }
        }
    }
}
__device__ __forceinline__ void qkvnorm(const u16* proj, u16* cq, u16* ckv, u16* kr, const float* qn, const float* kvn, const float* ctab, const float* stab, const float* rss, int gw, int NGW, int lane) {
    float gq[6], gk[4];
#pragma unroll
    for (int j = 0; j < 6; ++j) gq[j] = qn[lane + 64 * j];
#pragma unroll
    for (int j = 0; j < 4; ++j) gk[j] = kvn[lane + 64 * j];
    for (int row = gw; row < M; row += NGW) {
        const u16* pr = proj + (size_t)row * 768;
        const f32x4 pp = *(const f32x4*)(rss + (size_t)row * 4); const float rsc = rsqrtf(((pp[0] + pp[1]) + (pp[2] + pp[3])) * (1.f / D) + EPS);
        float a[6], b[4], s1 = 0.f, s2 = 0.f;
#pragma unroll
        for (int j = 0; j < 6; ++j) { a[j] = bf1(pr[lane + 64 * j]) * rsc; s1 += a[j] * a[j]; }
#pragma unroll
        for (int j = 0; j < 4; ++j) { b[j] = bf1(pr[384 + lane + 64 * j]) * rsc; s2 += b[j] * b[j]; }
        const float x1 = bf1(pr[640 + (lane & 31)]) * rsc, x2 = bf1(pr[672 + (lane & 31)]) * rsc;
        const float r1 = rsqrtf(wave_sum(s1) * (1.f / 384.f) + EPS), r2 = rsqrtf(wave_sum(s2) * (1.f / 256.f) + EPS);
#pragma unroll
        for (int j = 0; j < 6; ++j) cq[(size_t)row * 384 + lane + 64 * j] = (u16)f2bf(a[j] * r1 * gq[j]);
#pragma unroll
        for (int j = 0; j < 4; ++j) ckv[(size_t)row * 256 + lane + 64 * j] = (u16)f2bf(b[j] * r2 * gk[j]);
        const float c = ctab[(size_t)row * 32 + (lane & 31)], s = stab[(size_t)row * 32 + (lane & 31)];
        kr[(size_t)row * 64 + lane] = (u16)f2bf(lane < 32 ? x1 * c - x2 * s : x2 * c + x1 * s);
    }
}
__device__ __forceinline__ void qrope(u16* q, const float* ctab, const float* stab, int gw, int NGW, int lane) {
    for (int row = gw; row < M; row += NGW) {
        u16* qr = q + (size_t)row * 1536; const int i = lane & 31;
        const float c = ctab[(size_t)row * 32 + i], s = stab[(size_t)row * 32 + i];
#pragma unroll
        for (int j = 0; j < 4; ++j) { const int h = 2 * j + (lane >> 5); u16* pp = qr + h * 192 + 128 + i;
            const float x1 = bf1(pp[0]), x2 = bf1(pp[32]);
            pp[0] = (u16)f2bf(x1 * c - x2 * s); pp[32] = (u16)f2bf(x2 * c + x1 * s); }
    }
}
__device__ __forceinline__ void conv_phase(const u16* rec, u16* xc, const float* cw, const float* cb, int gtid, int NGT) {
    for (int idx = gtid; idx < (M / 32) * 128; idx += NGT) {
        const int r0 = (idx >> 7) * 32, c0 = (idx & 127) * 8;
        float w[4][8], bias[8], win[3][8];
#pragma unroll
        for (int e = 0; e < 8; ++e) { bias[e] = cb[c0 + e];
#pragma unroll
            for (int k = 0; k < 4; ++k) w[k][e] = cw[k * D + c0 + e]; }
        const bool first = (r0 & (SEQ - 1)) == 0;
#pragma unroll
        for (int k = 0; k < 3; ++k) { uint4 v = make_uint4(0u, 0u, 0u, 0u); if (!first) v = *(const uint4*)(rec + (size_t)(r0 - 3 + k) * D + c0);
            win[k][0] = bflo(v.x); win[k][1] = bfhi(v.x); win[k][2] = bflo(v.y); win[k][3] = bfhi(v.y); win[k][4] = bflo(v.z); win[k][5] = bfhi(v.z); win[k][6] = bflo(v.w); win[k][7] = bfhi(v.w); }
        for (int i0 = 0; i0 < 32; i0 += 8) {
            uint4 in[8];
#pragma unroll
            for (int u = 0; u < 8; ++u) in[u] = *(const uint4*)(rec + (size_t)(r0 + i0 + u) * D + c0);
#pragma unroll
            for (int u = 0; u < 8; ++u) {
                const float x[8] = {bflo(in[u].x), bfhi(in[u].x), bflo(in[u].y), bfhi(in[u].y), bflo(in[u].z), bfhi(in[u].z), bflo(in[u].w), bfhi(in[u].w)};
                float acc[8];
#pragma unroll
                for (int e = 0; e < 8; ++e) { acc[e] = bias[e] + win[0][e] * w[0][e] + win[1][e] * w[1][e] + win[2][e] * w[2][e] + x[e] * w[3][e]; win[0][e] = win[1][e]; win[1][e] = win[2][e]; win[2][e] = x[e]; }
                uint4 o; o.x = pk2(acc[0], acc[1]); o.y = pk2(acc[2], acc[3]); o.z = pk2(acc[4], acc[5]); o.w = pk2(acc[6], acc[7]);
                *(uint4*)(xc + (size_t)(r0 + i0 + u) * D + c0) = o;
            }
        }
    }
}
__device__ __forceinline__ void scanA(const u16* A, const u16* B, float* SA, float* SB, int tid) {
    for (int item = blockIdx.x; item < 2 * SCAN_NC; item += gridDim.x) {
        const int c = item % SCAN_NC, b = item / SCAN_NC, ch = 2 * tid;
        const size_t base = ((size_t)b * SEQ + (size_t)c * SCAN_L) * D + ch;
        float h0 = 0.f, h1 = 0.f, P0 = 1.f, P1 = 1.f;
        for (int t0 = 0; t0 < SCAN_L; t0 += 16) {
            unsigned aw[16], bw[16];
#pragma unroll
            for (int u = 0; u < 16; ++u) { aw[u] = *(const unsigned*)(A + base + (size_t)(t0 + u) * D); bw[u] = *(const unsigned*)(B + base + (size_t)(t0 + u) * D); }
#pragma unroll
            for (int u = 0; u < 16; ++u) { const float a0 = __expf(bflo(aw[u])), a1 = __expf(bfhi(aw[u])); h0 = a0 * h0 + bflo(bw[u]); h1 = a1 * h1 + bfhi(bw[u]); P0 *= a0; P1 *= a1; }
        }
        const size_t so = ((size_t)b * SCAN_NC + c) * D + ch;
        *(float2*)(SA + so) = make_float2(P0, P1); *(float2*)(SB + so) = make_float2(h0, h1);
    }
}
__device__ __forceinline__ void scanC(const u16* A, const u16* B, const float* SA, const float* SB, const u16* gate, u16* hg, int tid) {
    for (int item = blockIdx.x; item < 2 * SCAN_NC; item += gridDim.x) {
        const int c = item % SCAN_NC, b = item / SCAN_NC, ch = 2 * tid;
        const size_t base = ((size_t)b * SEQ + (size_t)c * SCAN_L) * D + ch;
        float h0 = 0.f, h1 = 0.f;
        for (int cc = 0; cc < c; ++cc) { const size_t so = ((size_t)b * SCAN_NC + cc) * D + ch; const float2 pa = *(const float2*)(SA + so), pb = *(const float2*)(SB + so); h0 = pa.x * h0 + pb.x; h1 = pa.y * h1 + pb.y; }
        for (int t0 = 0; t0 < SCAN_L; t0 += 16) {
            unsigned aw[16], bw[16], gv[16];
#pragma unroll
            for (int u = 0; u < 16; ++u) { aw[u] = *(const unsigned*)(A + base + (size_t)(t0 + u) * D); bw[u] = *(const unsigned*)(B + base + (size_t)(t0 + u) * D); gv[u] = *(const unsigned*)(gate + base + (size_t)(t0 + u) * D); }
#pragma unroll
            for (int u = 0; u < 16; ++u) { h0 = __expf(bflo(aw[u])) * h0 + bflo(bw[u]); h1 = __expf(bfhi(aw[u])) * h1 + bfhi(bw[u]);
                *(unsigned*)(hg + base + (size_t)(t0 + u) * D) = pk2(bflo(gv[u]) * h0, bfhi(gv[u]) * h1); }
        }
    }
}

constexpr int LDS_GEMM = pg8::STAGE_BYTES + 8192, LDS_MAIN = att::LDS_BYTES > LDS_GEMM ? att::LDS_BYTES : LDS_GEMM, LDS_BYTES = LDS_MAIN + 16;
constexpr size_t WS_BAR = 106 * MB;
constexpr size_t WS_CNT1 = WS_BAR + 16384, WS_CNT2 = WS_BAR + 49152, CTL_BYTES = 81920, WS_XS1 = 107 * MB, WS_XS2 = 107 * MB + MB / 2;
constexpr int XL_OFF = 131072;
static_assert(XL_OFF + 8192 <= LDS_MAIN && XCD_BAR_WORDS * 4 <= 16384 && att::LDS_BYTES <= LDS_MAIN && pg8::STAGE_BYTES <= LDS_MAIN && LDS_BYTES <= 160 * 1024, "LDS map");

__global__ void __launch_bounds__(512, 2) fwd_mega(Params p_arg) {
    extern __shared__ __attribute__((aligned(16))) unsigned char lds[];
    cg::grid_group grid = cg::this_grid();
    (void)p_arg;
    volatile __attribute__((address_space(3))) unsigned* bst = (volatile __attribute__((address_space(3))) unsigned*)((__attribute__((address_space(3))) unsigned char*)lds + LDS_MAIN);
    if (threadIdx.x < 4) bst[threadIdx.x] = 0u;
    __syncthreads();
    const int wave_s = __builtin_amdgcn_readfirstlane(threadIdx.x >> 6);
    const unsigned bar_x = xb::xb_xcc_id();
    (void)xb::xcd_barrier_post((unsigned*)(p_arg.ws + WS_BAR), bst);
#define GRID_BAR() do { unsigned bx_ = bar_x; asm volatile("" : "+s"(bx_)); xb::XcdBarrier bb_; bb_.bar = (unsigned*)(ws + WS_BAR); bb_.x = bx_; bb_.st = bst; xb::xcd_barrier(bb_, tid == 0); } while (0)
    typedef const __attribute__((address_space(4))) Params* KParams;
    KParams pp = (KParams)__builtin_amdgcn_kernarg_segment_ptr();
#define FRESH() int tid_ = wave_s * 64 + lane_id_fresh(); asm volatile("" : "+v"(tid_)); asm volatile("" : "+s"(pp)); const __attribute__((address_space(4))) Params& p = *pp; \
    const int tid = tid_, lane = tid & 63, wave = __builtin_amdgcn_readfirstlane(tid >> 6); \
    const int G = gridDim.x, gw = blockIdx.x * 8 + wave, NGW = G * 8, gtid = blockIdx.x * 512 + tid, NGT = G * 512; \
    unsigned char* ws = p.ws; float* x = p.out; u16* hn = (u16*)(ws + WS_HN); u16* ybuf = (u16*)(ws + WS_Y); unsigned char* U = ws + WS_U; \
    float* ctab = (float*)(ws + WS_COS); float* stab = (float*)(ws + WS_SIN); float* SA = (float*)(ws + WS_SA); float* SB = (float*)(ws + WS_SB); \
    (void)lane; (void)wave; (void)gw; (void)NGW; (void)gtid; (void)NGT; (void)x; (void)hn; (void)ybuf; (void)U; (void)ctab; (void)stab; (void)SA; (void)SB;
    {
    FRESH();

    for (int prep = 0; prep < PROBE_PRO_REPS; ++prep) {
    prologue_weights(p, (float*)lds + wave * (64 * 33), gw, NGW, lane);
    for (int i = gtid; i < 2 * 2048 * 16; i += NGT) { const int j = i >> 15, row = (i >> 4) & 2047, chn = i & 15, n = row >> 8;
        *(uint4*)((u16*)(ws + WT_LRU(j) + OFF_GT) + (size_t)row * 256 + 128 * ((n & 1) ^ 1) + chn * 8) = make_uint4(0u, 0u, 0u, 0u); }
    { const int* pos = (const int*)p.in[I_POS];
      for (int i = gtid; i < M * 32; i += NGT) { const int row = i >> 5, f = i & 31;
        const float inv = __builtin_amdgcn_exp2f(-(float)f * (13.287712379549449f / 32.f));
        const float ang = (float)pos[row] * inv;
        double rev = (double)ang * 0.15915494309189535; rev -= __builtin_rint(rev);
        ctab[i] = __builtin_amdgcn_cosf((float)rev); stab[i] = __builtin_amdgcn_sinf((float)rev); } }
    rowop(nullptr, p.in[I_X], nullptr, hn, (float*)(ws + WS_XSB), nullptr, p.in[I_MIXPRE], gw, NGW, lane);
    }
    if (ws == nullptr) grid.sync();
    GRID_BAR();
    }

#pragma nounroll
    for (int layer = 0; layer < 4; ++layer) {
#pragma nounroll
        for (int op = 0; op < 10; ++op) {
            FRESH();
            const int j = layer >> 1; const bool lru = (layer & 1) != 0;
            const u16* wtm = (const u16*)(ws + WT_MLA(j)); const u16* wtl = (const u16*)(ws + WT_LRU(j)); const u16* wtf = (const u16*)(ws + WT_FFN(layer));
            int gk = 0;
            pg8::Gemm g{}; pg8::EpiB E{};
            if (op == 6 || op == 9) continue;
            const float* gprev = p.in[op == 5 ? I_MIXPRE : I_FFNPRE] + layer * D;
            const float* gpost = p.in[op == 5 ? I_MIXPOST : I_FFNPOST] + layer * D;
            const float* gpre = op == 5 ? p.in[I_FFNPRE] + layer * D : (layer < 3 ? p.in[I_MIXPRE] + (layer + 1) * D : nullptr);
            if (op == 7) { gk = 1; g = pg8::Gemm{hn, wtf, M, 4096, 1024, 1024, 1024, 0}; E = pg8::EpiB{(u16*)U, 4096, 0, 0, 1, nullptr}; }
            else if (op == 8) { gk = 3; g = pg8::Gemm{(const u16*)U, wtf + OFF_DOWN / 2, M, 1024, 4096, 4096, 4096, 0}; }
            else if (!lru) {
                u16* proj = (u16*)(U + U_PROJ); u16* cq = (u16*)(U + U_CQ); u16* ckv = (u16*)(U + U_CKV); u16* kr = (u16*)(U + U_KR); u16* q = (u16*)(U + U_Q); u16* o = (u16*)(U + U_O); u16* kv = ybuf;
                if (op == 0) { gk = 1; g = pg8::Gemm{hn, wtm, M, 768, 1024, 1024, 1024, 0}; E = pg8::EpiB{proj, 768, 0, 0, 0, nullptr}; }
                else if (op == 1) for (int rep = 0; rep < PROBE_THIN_REPS; ++rep) qkvnorm(proj, cq, ckv, kr, p.in[I_MLA_QN] + j * 384, p.in[I_MLA_KVN] + j * 256, ctab, stab, (const float*)(ws + WS_XSB), gw, NGW, lane);
                else if (op == 2) { gk = 1; g = pg8::Gemm{cq, wtm + OFF_UQ / 2, M, 1536, 384, 384, 384, 0}; E = pg8::EpiB{q, 1536, 0, 0, 0, nullptr}; }
                else if (op == 3) { gk = 1; g = pg8::Gemm{ckv, wtm + OFF_UKV / 2, M, 2048, 256, 256, 256, 0}; E = pg8::EpiB{kv, 2048, 0, 0, 0, nullptr}; }
                else if (op == 4) { const att::Tensors T{q, kv, kr, o, ctab, stab}; for (int rep = 0; rep < PROBE_ATT_REPS; ++rep) att::attn_phase((char*)lds, T, tid); }
                else { gk = 3; g = pg8::Gemm{o, wtm + OFF_WO / 2, M, 1024, 1024, 1024, 1024, 0}; }
            } else {
                u16* gate = (u16*)(U + U_GATE); u16* xc = (u16*)(U + U_XC); u16* rec = (u16*)(U + U_REC); u16* Bb = (u16*)(U + U_B); u16* Ab = (u16*)(U + U_LA); u16* hg = xc;
                if (op == 0) { gk = 1; g = pg8::Gemm{hn, wtl, M, 2048, 1024, 1024, 1024, 0}; E = pg8::EpiB{gate, 1024, 1024, (size_t)(U_REC - U_GATE) / 2, 2, (const float*)(ws + WS_XSB)}; }
                else if (op == 1) for (int rep = 0; rep < PROBE_THIN_REPS; ++rep) conv_phase(rec, xc, p.in[I_LRU_CW] + j * 4 * D, p.in[I_LRU_CB] + j * D, gtid, NGT);
                else if (op == 2) { gk = 2; g = pg8::Gemm{xc, wtl + OFF_GT / 2, M, 2048, 256, 1024, 256, 512}; }
                else if (op == 3) for (int rep = 0; rep < PROBE_THIN_REPS; ++rep) scanA(Ab, Bb, SA, SB, tid);
                else if (op == 4) for (int rep = 0; rep < PROBE_THIN_REPS; ++rep) scanC(Ab, Bb, SA, SB, gate, hg, tid);
                else { gk = 3; g = pg8::Gemm{hg, wtl + OFF_LOUT / 2, M, 1024, 1024, 1024, 1024, 0}; }
            }
            for (int rep = 0; rep < PROBE_GEMM_REPS; ++rep)
            if (gk == 1) { pg8::StaticOrder S; S.init(g.M, g.N, G, (int)blockIdx.x);
                pg8::gemm_phase<pg8::EpiB, pg8::StaticOrder, true>((PG8_LAS unsigned char*)lds, g, S, E, tid); }
            else if (gk == 2) { pg8::StaticOrder S; S.init(g.M, g.N, G, (int)blockIdx.x);
                const pg8::EpiGate EG{(const u16*)(U + U_XC), (u16*)(U + U_LA), (u16*)(U + U_B), p.in[I_LRU_BA] + j * D, p.in[I_LRU_BX] + j * D, p.in[I_LRU_LAM] + j * D};
                pg8::gemm_phase<pg8::EpiGate, pg8::StaticOrder, true>((PG8_LAS unsigned char*)lds, g, S, EG, tid); }
            else if (gk == 3) { pg8::StaticOrder S; S.init(g.M, g.N, G, (int)blockIdx.x);
                const unsigned target = 32u * (unsigned)(layer * 2 + (op == 8 ? 2 : 1));
                const pg8::RowStats st1{(float*)(ws + WS_XS1), (unsigned*)(ws + WS_CNT1), target};
                const pg8::EpiNormRes EN{hn, (float*)(ws + (op == 8 ? WS_XSB : WS_XSA)), x, gprev, gpost, gpre, st1, (PG8_LAS unsigned char*)lds + XL_OFF, op == 8 ? (const float*)(ws + WS_XSA) : nullptr};
                pg8::gemm_phase<pg8::EpiNormRes, pg8::StaticOrder, true>((PG8_LAS unsigned char*)lds, g, S, EN, tid); }
            if (!(layer == 3 && op == 8) && !(!lru && op == 2)) { for (int rep = 0; rep < PROBE_SYNC_REPS; ++rep) GRID_BAR(); }
        }
    }
}
}

extern "C" void kernel_launch(void* const* d_in, const int* in_sizes, int n_in, void* d_out, int out_size, void* d_ws, size_t ws_size, hipStream_t stream) {
    static int grid = 0;
    if (grid == 0) {
        if (n_in != 23 || in_sizes[0] != mk::M * mk::D || out_size != mk::M * mk::D || ws_size < mk::WS_END) {
            fprintf(stderr, "kernel_launch: unexpected shapes (n_in %d, in0 %d, out %d, ws %zu); nothing launched\n", n_in, n_in > 0 ? in_sizes[0] : -1, out_size, ws_size); grid = -1; return; }
        int dev = 0, cus = 0, per_cu = 0;
        (void)hipGetDevice(&dev); (void)hipDeviceGetAttribute(&cus, hipDeviceAttributeMultiprocessorCount, dev);
        if (hipFuncSetAttribute((const void*)mk::fwd_mega, hipFuncAttributeMaxDynamicSharedMemorySize, mk::LDS_BYTES) != hipSuccess) { fprintf(stderr, "kernel_launch: hipFuncSetAttribute failed\n"); grid = -1; return; }
        if (hipOccupancyMaxActiveBlocksPerMultiprocessor(&per_cu, (const void*)mk::fwd_mega, 512, mk::LDS_BYTES) != hipSuccess || per_cu < 1) { fprintf(stderr, "kernel_launch: occupancy query says %d blocks per CU\n", per_cu); per_cu = 1; }
        (void)hipGetLastError();
        grid = cus > 0 ? cus : 256;
    }
    if (grid < 0) return;
    mk::Params p{};
    for (int i = 0; i < 23; ++i) p.in[i] = (const float*)d_in[i];
    p.out = (float*)d_out; p.ws = (unsigned char*)d_ws;
    if (hipMemsetAsync((char*)d_ws + mk::WS_BAR, 0, mk::CTL_BYTES, stream) != hipSuccess) { fprintf(stderr, "kernel_launch: hipMemsetAsync failed\n"); return; }
    void* args[] = {&p};
    hipError_t e = hipLaunchCooperativeKernel((const void*)mk::fwd_mega, dim3(grid), dim3(512), args, mk::LDS_BYTES, stream);
    if (e != hipSuccess) fprintf(stderr, "kernel_launch: cooperative launch failed: %s (grid %d)\n", hipGetErrorString(e), grid);
}
```

```cpp
#include <hip/hip_runtime.h>
#include <hip/hip_bf16.h>
#include <hip/hip_cooperative_groups.h>
#include <cstdio>
#include <cstdint>
namespace cg = cooperative_groups;

__device__ __forceinline__ float xor1f(float v)  { return __int_as_float(__builtin_amdgcn_mov_dpp(__float_as_int(v), 0xB1, 0xF, 0xF, false)); }
__device__ __forceinline__ float xor2f(float v)  { return __int_as_float(__builtin_amdgcn_mov_dpp(__float_as_int(v), 0x4E, 0xF, 0xF, false)); }
__device__ __forceinline__ float xor4f(float v)  { return __int_as_float(__builtin_amdgcn_ds_swizzle(__float_as_int(v), 0x101F)); }
__device__ __forceinline__ float xor8f(float v)  { return __int_as_float(__builtin_amdgcn_ds_swizzle(__float_as_int(v), 0x201F)); }
__device__ __forceinline__ float xor16f(float v) { return __int_as_float(__builtin_amdgcn_ds_swizzle(__float_as_int(v), 0x401F)); }
__device__ __forceinline__ float sum32f(float v) { auto rr = __builtin_amdgcn_permlane32_swap(__float_as_uint(v), __float_as_uint(v), false, false); return __uint_as_float(rr[0]) + __uint_as_float(rr[1]); }
__device__ __forceinline__ int lane_id_fresh() { int l; asm volatile("v_mbcnt_lo_u32_b32 %0, -1, 0\n\tv_mbcnt_hi_u32_b32 %0, -1, %0" : "=v"(l)); return l; }
namespace pg8 {
#define PG8_LAS __attribute__((address_space(3)))
typedef unsigned short bf16_t;
typedef short bf16x8 __attribute__((ext_vector_type(8)));
typedef float f32x4 __attribute__((ext_vector_type(4)));
typedef unsigned u32x4 __attribute__((ext_vector_type(4)));
constexpr int BM = 256, BK = 64, HALF = 128, HTB = HALF * BK * 2  , STAGE_BYTES = 8 * HTB, NXCD = 8, WGM = 8;

__host__ __device__ __forceinline__ int lds_byte(int r, int c) { const int st = (r >> 4) * 2 + (c >> 5), rr = r & 15, cc = c & 31, ob = rr * 64 + cc * 2; return st * 1024 + (ob ^ (((ob >> 9) & 1) << 5)); }
__host__ __device__ __forceinline__ void stage_rc(int b, int& R, int& C) { const int st = b / 1024, sb = b % 1024, swz = sb ^ (((sb >> 9) & 1) << 5); R = (st >> 1) * 16 + swz / 64; C = (st & 1) * 32 + (swz % 64) / 2; }
__host__ __device__ __forceinline__ int perm32(int rho) { const int n = rho >> 4, i = rho & 15; return 8 * (i >> 2) + 4 * n + (i & 3); }

struct Unit { int pm, pn; };
struct Gemm { const bf16_t* A; const bf16_t* Bt; int M, N, K; int lda, ldb; int apn; };

struct StaticOrder {
    int nM, nN, nwg, G, c;
    __host__ __device__ void init(int M, int N, int G_, int c_) { nM = M / BM; nN = N / BM; nwg = nM * nN; G = G_; c = c_; }
    __host__ __device__ bool next(int i, Unit& u) const {
        const long L = (long)i * G + c; if (L >= nwg) return false;
        int wgid = (int)L; { const int q = nwg / NXCD, r = nwg % NXCD, xcd = wgid % NXCD, off = wgid / NXCD; wgid = (xcd < r ? xcd * (q + 1) : r * (q + 1) + (xcd - r) * q) + off; }
        const int nig = WGM * nN, gid = wgid / nig, fm = gid * WGM, gsz = (nM - fm) < WGM ? (nM - fm) : WGM;
        u.pm = fm + ((wgid % nig) % gsz); u.pn = (wgid % nig) / gsz; return true;
    }
    __device__ __forceinline__ void a_ready(const Unit&) const {}
    __device__ __forceinline__ void done(const Unit&) const {}
};

__device__ __forceinline__ unsigned cvt_pk_bf16(float lo, float hi) { unsigned r; asm volatile("v_cvt_pk_bf16_f32 %0, %1, %2" : "=v"(r) : "v"(lo), "v"(hi)); return r; }
__device__ __forceinline__ float gelu_tanh(float x) {
    const float z = 0.7978845608028654f * (x + 0.044715f * x * x * x);
    const float e = __expf(2.0f * z);
    const float th = 1.0f - 2.0f * __builtin_amdgcn_rcpf(1.0f + e);
    return 0.5f * x * (1.0f + th);
}
struct EpiB {
    static constexpr bool PERM = true, AFTER_DRAIN = false, FUSED = false;
    bf16_t* O; int ldc; int split_cols; size_t split_stride; int mode;
    const float* rss;
    __device__ __forceinline__ void operator()(const f32x4 (&acc)[2][2][4][2], const Unit& u, int wr, int wc, int fr, int fq) const {
        const int row0 = u.pm * BM + wr * 64 + fr; int colt = u.pn * BM; bf16_t* base = O; int t = 0;
        if (split_cols) { t = colt / split_cols; base += (size_t)t * split_stride; colt -= t * split_cols; }
        const int act = (mode == 1) ? 1 : ((mode == 2 && t == 0) ? 2 : 0);
        const int col0 = colt + wc * 32 + 8 * fq;
#pragma unroll
        for (int ai = 0; ai < 2; ++ai)
#pragma unroll
            for (int m = 0; m < 4; ++m) { bf16_t* rowp = base + (size_t)(row0 + ai * HALF + m * 16) * ldc + col0;
                float rsc = 1.0f; if (rss) { const f32x4 pp = *(const f32x4*)(rss + (size_t)(row0 + ai * HALF + m * 16) * 4); rsc = rsqrtf(((pp[0] + pp[1]) + (pp[2] + pp[3])) * (1.0f / 1024.0f) + 1e-6f); }
#pragma unroll
                for (int bj = 0; bj < 2; ++bj) { f32x4 v0 = acc[ai][bj][m][0] * rsc, v1 = acc[ai][bj][m][1] * rsc;
                    if (act == 1) {
#pragma unroll
                        for (int e = 0; e < 4; ++e) { const float a = fmaxf(v0[e], 0.f), b = fmaxf(v1[e], 0.f); v0[e] = a * a; v1[e] = b * b; } }
                    else if (act == 2) {
#pragma unroll
                        for (int e = 0; e < 4; ++e) { v0[e] = gelu_tanh(v0[e]); v1[e] = gelu_tanh(v1[e]); } }
                    u32x4 w; w.x = cvt_pk_bf16(v0[0], v0[1]); w.y = cvt_pk_bf16(v0[2], v0[3]); w.z = cvt_pk_bf16(v1[0], v1[1]); w.w = cvt_pk_bf16(v1[2], v1[3]);
                    *(u32x4*)(rowp + bj * HALF) = w; } }
    }
};
__device__ __forceinline__ float bf2f(unsigned short h) { return __uint_as_float(((unsigned)h) << 16); }
__device__ __forceinline__ float sigmoidf_(float x) { return __builtin_amdgcn_rcpf(1.0f + __expf(-x)); }
__device__ __forceinline__ float one_minus_exp(float t) { const float ser = -t * (1.0f + t * (0.5f + t * (0.16666667f + t * (0.041666668f + t * 0.008333334f)))); return t > -0.25f ? ser : 1.0f - __expf(t); }
struct EpiGate {
    static constexpr bool PERM = false, AFTER_DRAIN = false, FUSED = false;
    const bf16_t* xc; bf16_t* Aout; bf16_t* Bout; const float* b_a; const float* b_x; const float* lam;
    __device__ __forceinline__ void operator()(const f32x4 (&acc)[2][2][4][2], const Unit& u, int wr, int wc, int fr, int fq) const {
#pragma unroll
        for (int n = 0; n < 2; ++n) {
            const int ch0 = 128 * u.pn + 32 * wc + 16 * n + 4 * fq;
            const f32x4 ba = *(const f32x4*)(b_a + ch0), bx = *(const f32x4*)(b_x + ch0), lm = *(const f32x4*)(lam + ch0);
            f32x4 sp;
#pragma unroll
            for (int e = 0; e < 4; ++e) sp[e] = -8.0f * log1pf(__expf(-lm[e]));
#pragma unroll
            for (int ai = 0; ai < 2; ++ai)
#pragma unroll
                for (int m = 0; m < 4; ++m) {
                    const size_t off = (size_t)(u.pm * BM + ai * HALF + wr * 64 + m * 16 + fr) * 1024 + ch0;
                    const uint2 xr = *(const uint2*)(xc + off);
                    float xv[4] = { __uint_as_float(xr.x << 16), __uint_as_float(xr.x & 0xffff0000u), __uint_as_float(xr.y << 16), __uint_as_float(xr.y & 0xffff0000u) };
                    f32x4 av, bv;
#pragma unroll
                    for (int e = 0; e < 4; ++e) {
                        const float r = sigmoidf_(acc[ai][0][m][n][e] + ba[e]);
                        const float ig = sigmoidf_(acc[ai][1][m][n][e] + bx[e]);
                        const float la = sp[e] * r;
                        av[e] = la;
                        bv[e] = __builtin_amdgcn_sqrtf(fmaxf(one_minus_exp(2.0f * la), 0.f)) * (ig * xv[e]);
                    }
                    uint2 wa, wb; wa.x = cvt_pk_bf16(av[0], av[1]); wa.y = cvt_pk_bf16(av[2], av[3]); wb.x = cvt_pk_bf16(bv[0], bv[1]); wb.y = cvt_pk_bf16(bv[2], bv[3]);
                    *(uint2*)(Aout + off) = wa; *(uint2*)(Bout + off) = wb;
                }
        }
    }
};

struct RowStats {
    float* xbuf;
    unsigned* cnt;
    unsigned target;
    __device__ __forceinline__ void run(const f32x4 (&v)[2][2][4][2], const Unit& u, int wr, int wc, int fr, int fq, PG8_LAS unsigned char* xl, int wid, int lane) const {
        PG8_LAS float* P = (PG8_LAS float*)xl;
        PG8_LAS float* S = (PG8_LAS float*)(xl + 4096);
#pragma unroll
        for (int ai = 0; ai < 2; ++ai)
#pragma unroll
            for (int m = 0; m < 4; ++m) {
                float s = 0.f;
#pragma unroll
                for (int bj = 0; bj < 2; ++bj)
#pragma unroll
                    for (int n = 0; n < 2; ++n) { const f32x4 x = v[ai][bj][m][n]; s += (x[0] * x[0] + x[1] * x[1]) + (x[2] * x[2] + x[3] * x[3]); }
                s += xor16f(s); s = sum32f(s);
                if (fq == 0) P[(ai * HALF + wr * 64 + m * 16 + fr) * 4 + wc] = s;
            }
        asm volatile("s_waitcnt lgkmcnt(0)" ::: "memory"); __builtin_amdgcn_s_barrier(); asm volatile("" ::: "memory");
        const int row = wid * 32 + (lane & 31);
        if (lane < 32) { const float t = (P[row * 4 + 0] + P[row * 4 + 1]) + (P[row * 4 + 2] + P[row * 4 + 3]);
            __hip_atomic_store(xbuf + (size_t)(u.pm * BM + row) * 4 + u.pn, t, __ATOMIC_RELAXED, __HIP_MEMORY_SCOPE_AGENT); }
        asm volatile("s_waitcnt vmcnt(0)" ::: "memory");
        if (lane == 0) __hip_atomic_fetch_add(cnt + 64 * u.pm, 1u, __ATOMIC_RELAXED, __HIP_MEMORY_SCOPE_AGENT);
        if (wid == 0) { unsigned sp = 0;
            while ((unsigned)__builtin_amdgcn_readfirstlane(__hip_atomic_load(cnt + 64 * u.pm, __ATOMIC_RELAXED, __HIP_MEMORY_SCOPE_AGENT)) < target) { __builtin_amdgcn_s_sleep(2); if (++sp > (1u << 18)) break; }
            __builtin_amdgcn_fence(__ATOMIC_ACQUIRE, "agent"); }
        asm volatile("s_waitcnt vmcnt(0) lgkmcnt(0)" ::: "memory"); __builtin_amdgcn_s_barrier(); asm volatile("" ::: "memory");
        if (lane < 32) { float* slot = xbuf + (size_t)(u.pm * BM + row) * 4; float t = 0.f;
#pragma unroll
            for (int k = 0; k < 4; ++k) t += __hip_atomic_load(slot + k, __ATOMIC_RELAXED, __HIP_MEMORY_SCOPE_AGENT);
            S[row] = t; }
        asm volatile("s_waitcnt lgkmcnt(0)" ::: "memory"); __builtin_amdgcn_s_barrier(); asm volatile("" ::: "memory");
    }
};
struct EpiNormRes {
    static constexpr bool PERM = false, AFTER_DRAIN = false, FUSED = true;
    bf16_t* hn; float* xs2; float* out; const float* gprev; const float* gpost; const float* gpre; RowStats st1; PG8_LAS unsigned char* xl;
    const float* s_in;
    __device__ __forceinline__ void fused(f32x4 (&acc)[2][2][4][2], const Unit& u, int wr, int wc, int fr, int fq, int wid, int lane) const {
        typedef unsigned u32x2v __attribute__((ext_vector_type(2)));
        PG8_LAS float* P = (PG8_LAS float*)xl;
        const PG8_LAS float* S = (const PG8_LAS float*)(xl + 4096);
        const int col0 = u.pn * BM + wc * 32 + 4 * fq;
        st1.run(acc, u, wr, wc, fr, fq, xl, wid, lane);
#pragma unroll
        for (int ai = 0; ai < 2; ++ai)
#pragma unroll
            for (int m = 0; m < 4; ++m) { const int r = ai * HALF + wr * 64 + m * 16 + fr; float rstd = rsqrtf(S[r] * (1.0f / 1024.0f) + 1e-6f); const size_t off = (size_t)(u.pm * BM + r) * 1024 + col0;
                if (s_in) { const f32x4 pp = *(const f32x4*)(s_in + (size_t)(u.pm * BM + r) * 4); const float s2 = __builtin_amdgcn_rcpf(((pp[0] + pp[1]) + (pp[2] + pp[3])) * (1.0f / 1024.0f) + 1e-6f);
                    rstd = rsqrtf(S[r] * (1.0f / 1024.0f) * s2 * s2 + 1e-6f) * s2; }
#pragma unroll
                for (int bj = 0; bj < 2; ++bj)
#pragma unroll
                    for (int n = 0; n < 2; ++n) { const u32x2v hw = *(const u32x2v*)(hn + off + bj * HALF + n * 16);
                        const f32x4 gp = *(const f32x4*)(gprev + col0 + bj * HALF + n * 16); const f32x4 gv = *(const f32x4*)(gpost + col0 + bj * HALF + n * 16);
                        f32x4 xs; xs[0] = __uint_as_float(hw.x << 16) * __builtin_amdgcn_rcpf(gp[0]); xs[1] = __uint_as_float(hw.x & 0xffff0000u) * __builtin_amdgcn_rcpf(gp[1]);
                        xs[2] = __uint_as_float(hw.y << 16) * __builtin_amdgcn_rcpf(gp[2]); xs[3] = __uint_as_float(hw.y & 0xffff0000u) * __builtin_amdgcn_rcpf(gp[3]);
                        acc[ai][bj][m][n] = xs + (acc[ai][bj][m][n] * rstd) * gv; }
                asm volatile("" : "+v"(acc[ai][0][m][0]), "+v"(acc[ai][0][m][1]), "+v"(acc[ai][1][m][0]), "+v"(acc[ai][1][m][1]));
                if (m & 1) asm volatile("" ::: "memory"); }
        if (gpre) {
#pragma unroll
            for (int ai = 0; ai < 2; ++ai)
#pragma unroll
                for (int m = 0; m < 4; ++m) {
                    float s = 0.f;
#pragma unroll
                    for (int bj = 0; bj < 2; ++bj)
#pragma unroll
                        for (int n = 0; n < 2; ++n) { const f32x4 x = acc[ai][bj][m][n]; s += (x[0] * x[0] + x[1] * x[1]) + (x[2] * x[2] + x[3] * x[3]); }
                    s += xor16f(s); s = sum32f(s);
                    if (fq == 0) P[(ai * HALF + wr * 64 + m * 16 + fr) * 4 + wc] = s;
                }
            asm volatile("s_waitcnt lgkmcnt(0)" ::: "memory"); __builtin_amdgcn_s_barrier(); asm volatile("" ::: "memory");
            { const int row = wid * 32 + (lane & 31);
              if (lane < 32) xs2[(size_t)(u.pm * BM + row) * 4 + u.pn] = (P[row * 4 + 0] + P[row * 4 + 1]) + (P[row * 4 + 2] + P[row * 4 + 3]); }
#pragma unroll
            for (int ai = 0; ai < 2; ++ai)
#pragma unroll
                for (int m = 0; m < 4; ++m) { const int r = ai * HALF + wr * 64 + m * 16 + fr; const size_t off = (size_t)(u.pm * BM + r) * 1024 + col0;
#pragma unroll
                    for (int bj = 0; bj < 2; ++bj)
#pragma unroll
                        for (int n = 0; n < 2; ++n) { const f32x4 gv = *(const f32x4*)(gpre + col0 + bj * HALF + n * 16); const f32x4 o = acc[ai][bj][m][n] * gv;
                            u32x2v w; w.x = cvt_pk_bf16(o[0], o[1]); w.y = cvt_pk_bf16(o[2], o[3]); *(u32x2v*)(hn + off + bj * HALF + n * 16) = w; }
                    asm volatile("" ::: "memory"); }
            asm volatile("s_waitcnt lgkmcnt(0)" ::: "memory"); __builtin_amdgcn_s_barrier(); asm volatile("" ::: "memory");
        } else {
#pragma unroll
            for (int ai = 0; ai < 2; ++ai)
#pragma unroll
                for (int m = 0; m < 4; ++m) { const int r = ai * HALF + wr * 64 + m * 16 + fr; const size_t off = (size_t)(u.pm * BM + r) * 1024 + col0;
#pragma unroll
                    for (int bj = 0; bj < 2; ++bj)
#pragma unroll
                        for (int n = 0; n < 2; ++n) *(f32x4*)(out + off + bj * HALF + n * 16) = acc[ai][bj][m][n]; }
        }
    }
};

template <class Epi, class Sched, bool ALIGN_EPI>
__device__ __forceinline__ void gemm_phase(PG8_LAS unsigned char* lds, const Gemm g, const Sched& S, const Epi& E, int tid0) {
    int tid_ = tid0; asm volatile("" : "+v"(tid_));
    const int tid = tid_, wid = __builtin_amdgcn_readfirstlane(tid >> 6), lane = tid & 63, wr = wid >> 2, wc = wid & 3, fr = lane & 15, fq = lane >> 4;
    const int K = g.K, nt = K / BK;
    unsigned voffA[2], voffB[2];
#pragma unroll
    for (int i = 0; i < 2; ++i) { int R, C; stage_rc(tid * 16 + i * 8192, R, C); const int Rb = Epi::PERM ? ((R & ~31) + perm32(R & 31)) : R;
        voffA[i] = (unsigned)(R * g.lda + C) * 2u; voffB[i] = (unsigned)(Rb * g.ldb + C) * 2u; }
    const size_t kstep = (size_t)(BK * 2);
    const size_t hstepA = (size_t)HALF * g.lda * 2, hstepB = (size_t)HALF * g.ldb * 2;
    const size_t tstepA = 2 * hstepA, tstepB = 2 * hstepB;
    const unsigned ldsw = (unsigned)wid * 1024u;
    const int aoff = lds_byte(wr * 64 + fr, fq * 8), boff = lds_byte(wc * 32 + fr, fq * 8);
#define PG8_SA(b, h) (((b) * 2 + (h)) * HTB)
#define PG8_SB(b, h) ((4 + (b) * 2 + (h)) * HTB)
#define PG8_STAGE(bufoff, gbase, voff) do { _Pragma("unroll") for (int _i = 0; _i < 2; ++_i) \
        __builtin_amdgcn_global_load_lds((const unsigned*)((const char*)(gbase) + (voff)[_i]), (PG8_LAS unsigned*)(lds + (bufoff) + ldsw + _i * 8192), 16, 0, 0); } while (0)
#define PG8_LDA(dst, b, h) do { _Pragma("unroll") for (int m = 0; m < 4; ++m) _Pragma("unroll") for (int k = 0; k < 2; ++k) dst[m][k] = *(const PG8_LAS bf16x8*)(lds + PG8_SA(b, h) + aoff + m * 2048 + k * 1024); } while (0)
#define PG8_LDB(dst, b, h) do { _Pragma("unroll") for (int n = 0; n < 2; ++n) _Pragma("unroll") for (int k = 0; k < 2; ++k) dst[n][k] = *(const PG8_LAS bf16x8*)(lds + PG8_SB(b, h) + boff + n * 2048 + k * 1024); } while (0)
#define PG8_MMA(ai, bj, At, Bt) do { __builtin_amdgcn_s_setprio(1); _Pragma("unroll") for (int m = 0; m < 4; ++m) _Pragma("unroll") for (int n = 0; n < 2; ++n) _Pragma("unroll") for (int k = 0; k < 2; ++k) \
        acc[ai][bj][m][n] = __builtin_amdgcn_mfma_f32_16x16x32_bf16(Bt[n][k], At[m][k], acc[ai][bj][m][n], 0, 0, 0); __builtin_amdgcn_s_setprio(0); } while (0)
#define PG8_WAIT_V(n) asm volatile("s_waitcnt vmcnt(" #n ")" ::: "memory")
#define PG8_WAIT_L(n) asm volatile("s_waitcnt lgkmcnt(" #n ")" ::: "memory")
#define PG8_BAR __builtin_amdgcn_s_barrier()
#define PG8_SCHED __builtin_amdgcn_sched_barrier(0)
    Unit cur, nxt; int ui = 0;
    if (!S.next(0, cur)) return;
    f32x4 acc[2][2][4][2];
#pragma unroll
    for (int a = 0; a < 2; ++a)
#pragma unroll
        for (int b = 0; b < 2; ++b)
#pragma unroll
            for (int m = 0; m < 4; ++m)
#pragma unroll
                for (int n = 0; n < 2; ++n) acc[a][b][m][n] = (f32x4){0.f, 0.f, 0.f, 0.f};
    bf16x8 At[4][2], B0[2][2], B1[2][2];
    const char* cA = (const char*)g.A + (size_t)cur.pm * tstepA + (size_t)(cur.pn >> 1) * (size_t)g.apn; const char* cB = (const char*)g.Bt + (size_t)cur.pn * tstepB;
    S.a_ready(cur);
    PG8_STAGE(PG8_SB(0, 0), cB, voffB); PG8_STAGE(PG8_SB(0, 1), cB + hstepB, voffB); PG8_STAGE(PG8_SA(0, 0), cA, voffA); PG8_STAGE(PG8_SA(0, 1), cA + hstepA, voffA);
    if (wr == 1) PG8_BAR;
    PG8_WAIT_V(2); PG8_BAR;
    PG8_STAGE(PG8_SB(1, 0), cB + kstep, voffB); PG8_STAGE(PG8_SA(1, 0), cA + kstep, voffA); PG8_STAGE(PG8_SB(1, 1), cB + hstepB + kstep, voffB);
    PG8_WAIT_V(6); PG8_BAR;
    for (;;) {
        const bool has_next = S.next(ui + 1, nxt);
        const char* nA = has_next ? (const char*)g.A + (size_t)nxt.pm * tstepA + (size_t)(nxt.pn >> 1) * (size_t)g.apn : cA; const char* nB = has_next ? (const char*)g.Bt + (size_t)nxt.pn * tstepB : cB;
        for (int t = 0; t < nt; t += 2) {
            const bool last = (t == nt - 2);
            const char* a1 = cA + (size_t)(t + 1) * kstep;
            const char* a2 = last ? nA : cA + (size_t)(t + 2) * kstep; const char* b2 = last ? nB : cB + (size_t)(t + 2) * kstep;
            const char* a3 = a2 + kstep; const char* b3 = b2 + kstep;
            if (last && has_next) S.a_ready(nxt);
            PG8_LDB(B0, 0, 0); PG8_LDB(B1, 0, 1); PG8_SCHED; PG8_LDA(At, 0, 0); PG8_STAGE(PG8_SA(1, 1), a1 + hstepA, voffA);
            PG8_WAIT_V(8); PG8_WAIT_L(0); PG8_BAR; PG8_MMA(0, 0, At, B0); PG8_MMA(0, 1, At, B1); PG8_BAR; PG8_SCHED;
            PG8_LDA(At, 0, 1); PG8_STAGE(PG8_SB(0, 0), b2, voffB); PG8_STAGE(PG8_SB(0, 1), b2 + hstepB, voffB); PG8_STAGE(PG8_SA(0, 0), a2, voffA);
            PG8_WAIT_V(8); PG8_WAIT_L(0); PG8_BAR; PG8_MMA(1, 0, At, B0); PG8_MMA(1, 1, At, B1); PG8_BAR; PG8_SCHED;
            PG8_LDB(B0, 1, 0); PG8_LDB(B1, 1, 1); PG8_SCHED; PG8_LDA(At, 1, 0); PG8_STAGE(PG8_SA(0, 1), a2 + hstepA, voffA);
            PG8_WAIT_V(8); PG8_WAIT_L(0); PG8_BAR; PG8_MMA(0, 0, At, B0); PG8_MMA(0, 1, At, B1); PG8_BAR; PG8_SCHED;
            PG8_LDA(At, 1, 1); PG8_STAGE(PG8_SB(1, 0), b3, voffB); PG8_STAGE(PG8_SB(1, 1), b3 + hstepB, voffB); PG8_STAGE(PG8_SA(1, 0), a3, voffA);
            PG8_WAIT_V(8); PG8_WAIT_L(0); PG8_BAR; PG8_MMA(1, 0, At, B0); PG8_MMA(1, 1, At, B1); PG8_BAR; PG8_SCHED;
        }
        if constexpr (ALIGN_EPI) { if (wr == 0) PG8_BAR; }
        if constexpr (Epi::FUSED) E.fused(acc, cur, wr, wc, fr, fq, wid, lane); else E(acc, cur, wr, wc, fr, fq);
        S.done(cur);
        if (!has_next) break;
#pragma unroll
        for (int a = 0; a < 2; ++a)
#pragma unroll
            for (int b = 0; b < 2; ++b)
#pragma unroll
                for (int m = 0; m < 4; ++m)
#pragma unroll
                    for (int n = 0; n < 2; ++n) acc[a][b][m][n] = (f32x4){0.f, 0.f, 0.f, 0.f};
        cur = nxt; cA = nA; cB = nB; ++ui;
        if constexpr (ALIGN_EPI) { if (wr == 1) PG8_BAR; }
    }
    PG8_WAIT_V(0);
    if constexpr (!ALIGN_EPI) { if (wr == 0) PG8_BAR; }
    PG8_BAR;
#undef PG8_SA
#undef PG8_SB
#undef PG8_STAGE
#undef PG8_LDA
#undef PG8_LDB
#undef PG8_MMA
#undef PG8_WAIT_V
#undef PG8_WAIT_L
#undef PG8_BAR
#undef PG8_SCHED
}
}
namespace att {
typedef unsigned short u16;
typedef short bf16x8 __attribute__((ext_vector_type(8)));
typedef short s16x4 __attribute__((ext_vector_type(4)));
typedef float f32x16 __attribute__((ext_vector_type(16)));
typedef float f32x4 __attribute__((ext_vector_type(4)));
typedef unsigned u32x4 __attribute__((ext_vector_type(4)));
constexpr int SEQ = 16384, NW = 8, QBLK = 32, KVBLK = 64, QB = NW * QBLK;
constexpr int LDQ = 1536, LDK = 2048, LDKR = 64, LDO = 1024;
#ifndef ATT_NQREG
#define ATT_NQREG 6
#endif
constexpr int NQREG = ATT_NQREG, NQREG_L = 8 - NQREG;
constexpr int SHM_V = KVBLK * 128 * 2, SHM_K = KVBLK * 128 * 2, SHM_KR = KVBLK * 64 * 2;
constexpr int OFF_V = 0, OFF_K = 2 * SHM_V, OFF_KR = OFF_K + 2 * SHM_K, OFF_WS = OFF_KR + 2 * SHM_KR, OFF_QR = OFF_WS + NW * 64 * 4, QR_WAVE = (NQREG_L + 4) * 1024, LDS_BYTES = OFF_QR + NW * QR_WAVE;
constexpr float SCALE = 0.07216878364870322f;
constexpr float THR = 8.f;

#define KSWZ(row, colB) ((row) * 256 + ((colB) ^ (((row) & 7) << 4)))
#define KRSWZ(row, colB) ((row) * 128 + ((colB) ^ (((row) & 7) << 4)))
#define SBAR() __builtin_amdgcn_sched_barrier(0)
__device__ __forceinline__ int v_st(int k, int c) { const int kk = (k & ~0xC) | ((k & 4) << 1) | ((k & 8) >> 1); return ((kk >> 3) * 4 + (c >> 5)) * 512 + ((kk & 7) * 32 + (c & 31)) * 2; }
__device__ __forceinline__ int v_rd_base(int lane) { return ((lane & 3) << 3) | (((lane >> 2) & 3) << 6) | (((lane >> 4) & 1) << 5) | (((lane >> 5) & 1) << 8); }
constexpr int v_rd_off(int d0, int ks, int half) { return d0 * 512 + ks * 4096 + half * 2048; }
__device__ __forceinline__ int crow(int r, int hi) { return (r & 3) + 8 * (r >> 2) + 4 * hi; }
__device__ __forceinline__ unsigned cvtpk(float lo, float hi) { unsigned r; asm volatile("v_cvt_pk_bf16_f32 %0, %1, %2" : "=v"(r) : "v"(lo), "v"(hi)); return r; }
__device__ __forceinline__ bf16x8 load8(const u16* p) { return *reinterpret_cast<const bf16x8*>(p); }
__device__ __forceinline__ void mask_tile(f32x16& p0, f32x16& p1, int dq, unsigned W) {
    const float NEG = -__builtin_inff();
#pragma unroll
    for (int r = 0; r < 16; ++r) {
        const int c = (r & 3) + 8 * (r >> 2);
        if ((unsigned)(dq - c) >= W) p0[r] = NEG;
        if ((unsigned)(dq - c - 32) >= W) p1[r] = NEG;
    }
}
__device__ __forceinline__ void partialSM(f32x16& p0, f32x16& p1, float& m_reg, float& mn, float& alpha) {
    float pmax = p0[0]; for (int r = 1; r < 16; ++r) pmax = fmaxf(pmax, p0[r]); for (int r = 0; r < 16; ++r) pmax = fmaxf(pmax, p1[r]);
    { auto rr = __builtin_amdgcn_permlane32_swap(__float_as_uint(pmax), __float_as_uint(pmax), false, false);
      pmax = fmaxf(__uint_as_float(rr[0]), __uint_as_float(rr[1])); }
    constexpr float C2 = 1.4426950408889634f * SCALE;
    if (__builtin_expect(__all((pmax - m_reg) * SCALE <= THR), 1)) { mn = m_reg; alpha = 1.f; }
    else { mn = fmaxf(m_reg, pmax); alpha = __builtin_amdgcn_exp2f((m_reg - mn) * C2); m_reg = mn; }
    const float mnL = -mn * C2;
    for (int r = 0; r < 16; ++r) p0[r] = fmaf(p0[r], C2, mnL); for (int r = 0; r < 16; ++r) p1[r] = fmaf(p1[r], C2, mnL);
    for (int r = 0; r < 16; ++r) p0[r] = __builtin_amdgcn_exp2f(p0[r]);
}
__device__ __forceinline__ void finishSM(f32x16& p0, f32x16& p1, float alpha, float& l_reg, bf16x8& pa0, bf16x8& pa1, bf16x8& pa2, bf16x8& pa3) {
    for (int r = 0; r < 16; ++r) p1[r] = __builtin_amdgcn_exp2f(p1[r]);
    float ps = 0; for (int r = 0; r < 16; ++r) ps += p0[r]; for (int r = 0; r < 16; ++r) ps += p1[r];
    { auto rr = __builtin_amdgcn_permlane32_swap(__float_as_uint(ps), __float_as_uint(ps), false, false);
      ps = __uint_as_float(rr[0]) + __uint_as_float(rr[1]); }
    l_reg = l_reg * alpha + ps;
#define PK4(P, B_, OUT) do { unsigned a0 = cvtpk(P[B_+0], P[B_+1]), a1 = cvtpk(P[B_+2], P[B_+3]);                          \
        unsigned b0 = cvtpk(P[B_+4], P[B_+5]), b1 = cvtpk(P[B_+6], P[B_+7]);                                             \
        auto r0 = __builtin_amdgcn_permlane32_swap(a0, b0, false, false); auto r1 = __builtin_amdgcn_permlane32_swap(a1, b1, false, false); \
        u32x4 w = {r0[0], r1[0], r0[1], r1[1]}; OUT = *reinterpret_cast<bf16x8*>(&w); } while (0)
    PK4(p0, 0, pa0); PK4(p0, 8, pa1); PK4(p1, 0, pa2); PK4(p1, 8, pa3);
#undef PK4
}
#ifndef ATT_PF
#define ATT_PF 2
#endif
#define QK_SB() __builtin_amdgcn_sched_barrier(0x406)
#define QK_LOAD(s, SET) do { if ((s) < 8) { const char* a_ = kb[(s) & 3] + ((s) >> 2) * 128; fb0[SET] = *reinterpret_cast<const bf16x8*>(a_); fb1[SET] = *reinterpret_cast<const bf16x8*>(a_ + 32 * 256); \
            if ((s) < NQREG) fq[SET] = qr[(s) < NQREG ? (s) : 0]; else fq[SET] = qrl[((s) - NQREG) * 64]; } \
        else { const char* a_ = krb[((s) - 8) & 3]; fb0[SET] = *reinterpret_cast<const bf16x8*>(a_); fb1[SET] = *reinterpret_cast<const bf16x8*>(a_ + 32 * 128); fq[SET] = qrl[(NQREG_L + (s) - 8) * 64]; } } while (0)
template <int KB>
__device__ __forceinline__ void qkt(f32x16& p0, f32x16& p1, const char* K_lds, const char* KR_lds, const bf16x8* qrl, int r32, int hi, const bf16x8* qr) {
    constexpr int PF = ATT_PF, NS = PF + 1;
    p0 = f32x16{}; p1 = f32x16{};
    const char* kb[4]; const char* krb[4];
#pragma unroll
    for (int dd = 0; dd < 4; ++dd) { kb[dd] = K_lds + KB * SHM_K + KSWZ(r32, (dd * 16 + hi * 8) * 2); krb[dd] = KR_lds + KB * SHM_KR + KRSWZ(r32, (dd * 16 + hi * 8) * 2); }
    bf16x8 fb0[NS], fb1[NS], fq[NS];
#pragma unroll
    for (int s = 0; s < PF; ++s) QK_LOAD(s, s % NS);
#pragma unroll
    for (int s = 0; s < 12; ++s) {
        QK_SB();
        if (s + PF < 12) QK_LOAD(s + PF, (s + PF) % NS);
        QK_SB();
        p0 = __builtin_amdgcn_mfma_f32_32x32x16_bf16(fb0[s % NS], fq[s % NS], p0, 0, 0, 0);
        p1 = __builtin_amdgcn_mfma_f32_32x32x16_bf16(fb1[s % NS], fq[s % NS], p1, 0, 0, 0);
    }
    QK_SB();
}
#undef QK_LOAD
template <int VB>
__device__ __forceinline__ void pv_tile(f32x16* o, int vb0, bf16x8 pa0, bf16x8 pa1, bf16x8 pa2, bf16x8 pa3) {
#define TRRD(dst, off) asm volatile("ds_read_b64_tr_b16 %0, %1 offset:%2" : "=&v"(dst) : "v"(vb0), "i"(off) : "memory")
#define PV_D0(d0) do { s16x4 l0, l1, l2, l3, h0, h1, h2, h3; constexpr int b_ = OFF_V + VB * SHM_V + v_rd_off(d0, 0, 0); \
        TRRD(l0, b_); TRRD(h0, b_ + 2048); TRRD(l1, b_ + 4096); TRRD(h1, b_ + 6144); TRRD(l2, b_ + 8192); TRRD(h2, b_ + 10240); TRRD(l3, b_ + 12288); TRRD(h3, b_ + 14336); \
        asm volatile("s_waitcnt lgkmcnt(0)" ::: "memory"); SBAR();   \
        o[d0] = __builtin_amdgcn_mfma_f32_32x32x16_bf16(pa0, (bf16x8){l0[0], l0[1], l0[2], l0[3], h0[0], h0[1], h0[2], h0[3]}, o[d0], 0, 0, 0);   \
        o[d0] = __builtin_amdgcn_mfma_f32_32x32x16_bf16(pa1, (bf16x8){l1[0], l1[1], l1[2], l1[3], h1[0], h1[1], h1[2], h1[3]}, o[d0], 0, 0, 0);   \
        o[d0] = __builtin_amdgcn_mfma_f32_32x32x16_bf16(pa2, (bf16x8){l2[0], l2[1], l2[2], l2[3], h2[0], h2[1], h2[2], h2[3]}, o[d0], 0, 0, 0);   \
        o[d0] = __builtin_amdgcn_mfma_f32_32x32x16_bf16(pa3, (bf16x8){l3[0], l3[1], l3[2], l3[3], h3[0], h3[1], h3[2], h3[3]}, o[d0], 0, 0, 0); } while (0)
    PV_D0(0); PV_D0(1); PV_D0(2); PV_D0(3);
}
template <int VB>
__device__ __forceinline__ void pv_tile_sm(f32x16* o, int vb0, bf16x8 pa0, bf16x8 pa1, bf16x8 pa2, bf16x8 pa3, f32x16& p0, f32x16& p1, float& m_reg, float& mn, float& alpha) {
    constexpr float C2 = 1.4426950408889634f * SCALE;
    PV_D0(0);
    float pmax = p0[0];
#pragma unroll
    for (int r = 1; r < 16; ++r) pmax = fmaxf(pmax, p0[r]);
#pragma unroll
    for (int r = 0; r < 16; ++r) pmax = fmaxf(pmax, p1[r]);
    PV_D0(1);
    { auto rr = __builtin_amdgcn_permlane32_swap(__float_as_uint(pmax), __float_as_uint(pmax), false, false);
      pmax = fmaxf(__uint_as_float(rr[0]), __uint_as_float(rr[1])); }
    const bool keep = __all((pmax - m_reg) * SCALE <= THR);
    mn = keep ? m_reg : fmaxf(m_reg, pmax);
    alpha = __builtin_amdgcn_exp2f((m_reg - mn) * C2);
    m_reg = mn;
    const float mnL = -mn * C2;
#pragma unroll
    for (int r = 0; r < 16; ++r) p0[r] = fmaf(p0[r], C2, mnL);
    PV_D0(2);
#pragma unroll
    for (int r = 0; r < 16; ++r) p1[r] = fmaf(p1[r], C2, mnL);
#pragma unroll
    for (int r = 0; r < 8; ++r) p0[r] = __builtin_amdgcn_exp2f(p0[r]);
    PV_D0(3);
#pragma unroll
    for (int r = 8; r < 16; ++r) p0[r] = __builtin_amdgcn_exp2f(p0[r]);
}
#undef PV_D0
#undef TRRD

struct BlockRef { const u16* Q; const u16* K; const u16* V; const u16* KR; u16* O; int P0; int row0; };
#define VMW() asm volatile("s_waitcnt vmcnt(0)" ::: "memory")
#define ATT_LAS __attribute__((address_space(3)))
#define KDMA(Kp, KRp, k0, bf) do { \
        __builtin_amdgcn_global_load_lds((const unsigned*)((Kp) + (size_t)((k0) + sr) * LDK + ksc), (ATT_LAS unsigned*)(ldsL + OFF_K + (bf) * SHM_K + wid * 1024), 16, 0, 0); \
        __builtin_amdgcn_global_load_lds((const unsigned*)((Kp) + (size_t)((k0) + 32 + sr) * LDK + ksc), (ATT_LAS unsigned*)(ldsL + OFF_K + (bf) * SHM_K + 8192 + wid * 1024), 16, 0, 0); \
        __builtin_amdgcn_global_load_lds((const unsigned*)((KRp) + (size_t)((k0) + krr) * LDKR + krsc), (ATT_LAS unsigned*)(ldsL + OFF_KR + (bf) * SHM_KR + wid * 1024), 16, 0, 0); } while (0)
#define VDMA(Vp, k0, bf) do { \
        __builtin_amdgcn_global_load_lds((const unsigned*)((Vp) + (size_t)((k0) + vk) * LDK + vc), (ATT_LAS unsigned*)(ldsL + OFF_V + (bf) * SHM_V + wid * 1024), 16, 0, 0); \
        __builtin_amdgcn_global_load_lds((const unsigned*)((Vp) + (size_t)((k0) + 32 + vk) * LDK + vc), (ATT_LAS unsigned*)(ldsL + OFF_V + (bf) * SHM_V + 8192 + wid * 1024), 16, 0, 0); } while (0)
#define ATT_MAPS() const int sr = tid >> 4, ksc = ((tid & 15) ^ (sr & 7)) * 8, krr = tid >> 3, krsc = ((tid & 7) ^ (krr & 7)) * 8; ATT_LAS unsigned char* ldsL = (ATT_LAS unsigned char*)lds; \
    const int vkk_ = ((tid >> 7) << 3) | ((tid >> 2) & 7), vk = (vkk_ & ~0xC) | ((vkk_ & 4) << 1) | ((vkk_ & 8) >> 1), vc = ((tid >> 5) & 3) * 32 + (tid & 3) * 8
__device__ __forceinline__ void attn_prime(const BlockRef& cur, char* lds, int tid0) {
    int tid_ = tid0; asm volatile("" : "+v"(tid_));
    const int tid = tid_, wid = __builtin_amdgcn_readfirstlane(tid >> 6);
    ATT_MAPS();
    KDMA(cur.K, cur.KR, 0, 0); VDMA(cur.V, 0, 0); VMW();
    __syncthreads();
}
__device__ __forceinline__ void attn_block(const BlockRef& cur, const BlockRef& nxt, char* lds, int tid0, const float* ctab, const float* stab) {
    int tid_ = tid0; asm volatile("" : "+v"(tid_));
    const int tid = tid_, wid = __builtin_amdgcn_readfirstlane(tid >> 6), lane = tid & 63, r32 = lane & 31, hi = lane >> 5;
    const unsigned W = 0x40000000u;
    const int NT = (cur.P0 + QB - 1) / KVBLK + 1;
    const int qlo = cur.P0 + wid * QBLK, qm = qlo + r32 - 4 * hi;
    char* K_lds = lds + OFF_K; char* KR_lds = lds + OFF_KR;
    float* ws = (float*)(lds + OFF_WS) + wid * 64; float* li_l = ws, * al_l = ws + 32;
    bf16x8* qrl = (bf16x8*)(lds + OFF_QR + wid * QR_WAVE) + lane;
    float m_reg = -1e30f, l_reg = 0; f32x16 o[4] = {};
    ATT_MAPS();
    const int vb0 = (int)(uintptr_t)lds + v_rd_base(lane);
    const u16* Kh = cur.K; const u16* Vh = cur.V; const u16* KRh = cur.KR;
#define RESC(a) do { if (__any((a) < 1.f)) { if (hi == 0) al_l[r32] = (a); asm volatile("s_waitcnt lgkmcnt(0)" ::: "memory");              \
                     for (int d_ = 0; d_ < 4; ++d_) for (int r = 0; r < 16; ++r) o[d_][r] *= al_l[crow(r, hi)]; } } while (0)
#define KBASE(t) ((t) * KVBLK)
#define MASKT(P0_, P1_, t) do { const int kb_ = KBASE(t); if (kb_ + KVBLK - 1 > qlo) mask_tile(P0_, P1_, qm - kb_, W); } while (0)
    f32x16 pA0, pA1, pB0, pB1; float mnA, mnB, alA, alB; bf16x8 pa0, pa1, pa2, pa3;
    bf16x8 qr[NQREG > 0 ? NQREG : 1];
    { const u16* qp = cur.Q + (size_t)(wid * QBLK + r32) * LDQ + hi * 8;
#pragma unroll
      for (int d = 0; d < NQREG_L; ++d) qrl[d * 64] = load8(qp + (NQREG + d) * 16);
      const size_t trow = (size_t)(cur.row0 + wid * QBLK + r32) * 32 + hi * 8;
#pragma unroll
      for (int pr = 0; pr < 2; ++pr) {
          const bf16x8 x1 = load8(qp + 128 + pr * 16), x2 = load8(qp + 128 + 32 + pr * 16);
          const f32x4 c0 = *(const f32x4*)(ctab + trow + pr * 16), c1 = *(const f32x4*)(ctab + trow + pr * 16 + 4), s0 = *(const f32x4*)(stab + trow + pr * 16), s1 = *(const f32x4*)(stab + trow + pr * 16 + 4);
          float o1[8], o2[8];
#pragma unroll
          for (int e = 0; e < 8; ++e) { const float a = __uint_as_float(((unsigned)(unsigned short)x1[e]) << 16), b = __uint_as_float(((unsigned)(unsigned short)x2[e]) << 16);
              const float cc = e < 4 ? c0[e & 3] : c1[e & 3], ss = e < 4 ? s0[e & 3] : s1[e & 3]; o1[e] = a * cc - b * ss; o2[e] = b * cc + a * ss; }
          u32x4 w1 = {cvtpk(o1[0], o1[1]), cvtpk(o1[2], o1[3]), cvtpk(o1[4], o1[5]), cvtpk(o1[6], o1[7])}, w2 = {cvtpk(o2[0], o2[1]), cvtpk(o2[2], o2[3]), cvtpk(o2[4], o2[5]), cvtpk(o2[6], o2[7])};
          qrl[(NQREG_L + pr) * 64] = *reinterpret_cast<bf16x8*>(&w1); qrl[(NQREG_L + 2 + pr) * 64] = *reinterpret_cast<bf16x8*>(&w2); }
#pragma unroll
      for (int d0 = 0; d0 < NQREG; ++d0) qr[d0] = load8(qp + d0 * 16); }
    SBAR();
    KDMA(Kh, KRh, KBASE(1), 1); VDMA(Vh, KBASE(1), 1);
    SBAR(); qkt<0>(pA0, pA1, K_lds, KR_lds, qrl, r32, hi, qr);
    MASKT(pA0, pA1, 0); partialSM(pA0, pA1, m_reg, mnA, alA);
    VMW(); __syncthreads();
    KDMA(Kh, KRh, KBASE(2), 0);
#define HALF_STEP(PX0, PX1, mnX, alX, PY0, PY1, alY, t, KB, VB) do {                                                          \
        SBAR(); qkt<KB>(PX0, PX1, K_lds, KR_lds, qrl, r32, hi, qr);                                                          \
        finishSM(PY0, PY1, alY, l_reg, pa0, pa1, pa2, pa3); SBAR();                                                           \
        MASKT(PX0, PX1, (t)); SBAR(); pv_tile_sm<VB>(o, vb0, pa0, pa1, pa2, pa3, PX0, PX1, m_reg, mnX, alX);                  \
        VMW(); __syncthreads();                                                                                               \
        if ((t) + 2 < NT) KDMA(Kh, KRh, KBASE((t) + 2), KB);                                                                  \
        if ((t) + 1 < NT) VDMA(Vh, KBASE((t) + 1), VB);                                                                       \
        SBAR(); RESC(alX); } while (0)
    for (int t = 1; t + 1 < NT; t += 2) {
        HALF_STEP(pB0, pB1, mnB, alB, pA0, pA1, alA, t, 1, 0);
        HALF_STEP(pA0, pA1, mnA, alA, pB0, pB1, alB, t + 1, 0, 1);
    }
    SBAR(); qkt<1>(pB0, pB1, K_lds, KR_lds, qrl, r32, hi, qr);
    finishSM(pA0, pA1, alA, l_reg, pa0, pa1, pa2, pa3); SBAR();
    MASKT(pB0, pB1, NT - 1); SBAR(); pv_tile_sm<0>(o, vb0, pa0, pa1, pa2, pa3, pB0, pB1, m_reg, mnB, alB);
    VMW(); __syncthreads();
    KDMA(nxt.K, nxt.KR, 0, 0); VDMA(nxt.V, 0, 0);
    SBAR(); RESC(alB);
    finishSM(pB0, pB1, alB, l_reg, pa0, pa1, pa2, pa3); SBAR(); pv_tile<1>(o, vb0, pa0, pa1, pa2, pa3);
    SBAR();
    if (hi == 0) li_l[r32] = l_reg; asm volatile("s_waitcnt lgkmcnt(0)" ::: "memory");
    float rli[16];
#pragma unroll
    for (int r = 0; r < 16; ++r) rli[r] = __builtin_amdgcn_rcpf(li_l[crow(r, hi)]);
    u16* Ow = cur.O + (size_t)(wid * QBLK) * LDO;
#pragma unroll
    for (int r = 0; r < 16; ++r) { const int orow = crow(r, hi);
#pragma unroll
        for (int d0 = 0; d0 < 4; ++d0) { const float v = o[d0][r] * rli[r];
            const float vn = xor1f(v);
            if ((r32 & 1) == 0) *(unsigned*)(Ow + (size_t)orow * LDO + d0 * 32 + r32) = cvtpk(v, vn); } }
    VMW(); __syncthreads();
#undef RESC
#undef KBASE
#undef MASKT
#undef HALF_STEP
}
struct Tensors { const u16* q; const u16* kv; const u16* kr; u16* o; const float* ctab; const float* stab; };
__device__ __forceinline__ BlockRef make_ref(const Tensors& T, int L, int pass) {
    const int bh = (L & 7) + 8 * (L >> 8), x = (L >> 3) & 31, b = bh >> 3, h = bh & 7, qb = pass ? 63 - x : x;
    BlockRef r; const size_t row0 = (size_t)b * SEQ;
    r.Q = T.q + (row0 + (size_t)qb * QB) * LDQ + h * 192; r.K = T.kv + row0 * LDK + h * 256; r.V = r.K + 128; r.KR = T.kr + row0 * LDKR;
    r.O = T.o + (row0 + (size_t)qb * QB) * LDO + h * 128; r.P0 = qb * QB; r.row0 = b * SEQ + qb * QB;
    return r;
}
__device__ __forceinline__ void attn_phase(char* lds, const Tensors& T, int tid0) {
    const int total = 512, stride = gridDim.x;
    int L = blockIdx.x; if (L >= total) return;
    int pass = 0;
    BlockRef cur = make_ref(T, L, 0);
    attn_prime(cur, lds, tid0);
    for (;;) {
        const bool more_pass = pass == 0, more_item = L + stride < total, last = !more_pass && !more_item;
        int passn = pass + 1, Ln = L;
        if (!more_pass) { passn = 0; Ln = more_item ? L + stride : L; }
        const BlockRef nxt = last ? cur : make_ref(T, Ln, passn);
        attn_block(cur, nxt, lds, tid0, T.ctab, T.stab);
        if (last) break;
        cur = nxt; pass = passn; L = Ln;
    }
}
#undef VMW
#undef KDMA
#undef VDMA
#undef ATT_MAPS
#undef SBAR
}
namespace xb {
#define LAS __attribute__((address_space(3)))
#define XB_TMO      128
#define XB_XCNT(j)  (256  + 64 * (j))
#define XB_XSUB(j)  (1280 + 64 * (j))
#define XB_XGEN(j)  (2304 + 64 * (j))
#define XB_TOP      3328
#define XB_TOPGEN   3392
#define XCD_BAR_WORDS 3456
#define XB_SPIN_CAP (1u << 18)

__device__ __forceinline__ unsigned xb_ld(unsigned* p)              { return __hip_atomic_load(p, __ATOMIC_RELAXED, __HIP_MEMORY_SCOPE_AGENT); }
__device__ __forceinline__ unsigned xb_add(unsigned* p, unsigned v) { return __hip_atomic_fetch_add(p, v, __ATOMIC_RELAXED, __HIP_MEMORY_SCOPE_AGENT); }
__device__ __forceinline__ unsigned xb_xcc_id() { return (unsigned)__builtin_amdgcn_s_getreg((3 << 11) | 20) & 0xFu; }
#define XB_SPIN(cond, bar) do { unsigned _sp = 0; while (cond) { __builtin_amdgcn_s_sleep(1); \
    if ((++_sp & 255u) == 0u) { if (xb_ld(&(bar)[XB_TMO])) break; if (_sp > XB_SPIN_CAP) { atomicAdd(&(bar)[XB_TMO], 1u); break; } } } } while (0)

struct XcdBarrier {
    unsigned* bar; unsigned x;
    volatile LAS unsigned* st;
};

__device__ __forceinline__ XcdBarrier xcd_barrier_post(unsigned* bar, volatile LAS unsigned* st) {
    XcdBarrier b; b.bar = bar; b.x = xb_xcc_id(); b.st = st;
    if (threadIdx.x == 0) (void)xb_add(&bar[XB_XCNT(b.x)], 1u);
    return b;
}
__device__ __forceinline__ void xcd_barrier_complete(unsigned* bar, unsigned x, unsigned& nloc, unsigned& nx) {
    const unsigned G = gridDim.x * gridDim.y * gridDim.z;
    unsigned sum, cnt, mine, sp = 0u;
    for (;;) {
        sum = 0u; cnt = 0u; mine = 0u;
#pragma unroll
        for (unsigned j = 0; j < 16; ++j) { const unsigned c = xb_ld(&bar[XB_XCNT(j)]); sum += c; cnt += (c > 0u) ? 1u : 0u; mine = (j == x) ? c : mine; }
        if (sum == G) break;
        __builtin_amdgcn_s_sleep(1);
        if ((++sp & 255u) == 0u) { if (xb_ld(&bar[XB_TMO])) break; if (sp > XB_SPIN_CAP) { atomicAdd(&bar[XB_TMO], 1u); break; } }
    }
    nloc = mine > 0u ? mine : 1u; nx = cnt > 0u ? cnt : 1u;
}

__device__ __forceinline__ void xcd_barrier(const XcdBarrier& b, bool t0  ) {
    asm volatile("s_waitcnt vmcnt(0)" ::: "memory");
    __syncthreads();
    if (t0) {
        unsigned* bar = b.bar;
        __builtin_amdgcn_s_waitcnt(0);
        unsigned nloc = b.st[0], nx = b.st[1];
        if (nloc == 0u) { xcd_barrier_complete(bar, b.x, nloc, nx); b.st[0] = nloc; b.st[1] = nx; }
        const unsigned old = xb_add(&bar[XB_XSUB(b.x)], 1u);
        const unsigned gen = old / nloc;
        if (old + 1u == (gen + 1u) * nloc) {
            __builtin_amdgcn_fence(__ATOMIC_RELEASE, "agent");
            asm volatile("s_waitcnt vmcnt(0)" ::: "memory");
            const unsigned og = xb_add(&bar[XB_TOP], 1u);
            const unsigned tg = og / nx;
            if (og + 1u == (tg + 1u) * nx) xb_add(&bar[XB_TOPGEN], 1u);
            else XB_SPIN(xb_ld(&bar[XB_TOPGEN]) == tg, bar);
            __builtin_amdgcn_fence(__ATOMIC_ACQUIRE, "agent");
            xb_add(&bar[XB_XGEN(b.x)], 1u);
            asm volatile("s_waitcnt vmcnt(0)" ::: "memory");
        } else {
            XB_SPIN(xb_ld(&bar[XB_XGEN(b.x)]) == gen, bar);
            __builtin_amdgcn_fence(__ATOMIC_ACQUIRE, "agent");
            asm volatile("s_waitcnt vmcnt(0)" ::: "memory");
        }
    }
    __syncthreads();
}
#undef LAS
}
#ifndef PROBE_ATT_REPS
#define PROBE_ATT_REPS 1
#endif
#ifndef PROBE_SYNC_REPS
#define PROBE_SYNC_REPS 1
#endif
#ifndef PROBE_THIN_REPS
#define PROBE_THIN_REPS 1
#endif
#ifndef PROBE_PRO_REPS
#define PROBE_PRO_REPS 1
#endif
#ifndef PROBE_GEMM_REPS
#define PROBE_GEMM_REPS 1
#endif
namespace mk {
typedef unsigned short u16;
typedef float f32x4 __attribute__((ext_vector_type(4)));
constexpr int M = 32768, D = 1024, SEQ = 16384;
constexpr float EPS = 1e-6f;
constexpr size_t MB = (size_t)1 << 20;
__host__ __device__ constexpr size_t WT_MLA(int j) { return (size_t)j * 6 * MB; }
__host__ __device__ constexpr size_t WT_LRU(int j) { return 12 * MB + (size_t)j * 8 * MB; }
__host__ __device__ constexpr size_t WT_FFN(int l) { return 28 * MB + (size_t)l * 16 * MB; }
constexpr size_t OFF_UQ = 3 * MB / 2, OFF_UKV = 11 * MB / 4, OFF_WO = 15 * MB / 4, OFF_GT = 4 * MB, OFF_LOUT = 5 * MB, OFF_DOWN = 8 * MB;
constexpr size_t WS_COS = 96 * MB, WS_SIN = 100 * MB, WS_SA = 104 * MB, WS_SB = 105 * MB;
constexpr size_t WS_HN = 112 * MB, WS_Y = 176 * MB, WS_U = 240 * MB, WS_END = 496 * MB;
constexpr size_t U_PROJ = 64 * MB, U_CQ = 112 * MB, U_CKV = 136 * MB, U_KR = 152 * MB, U_Q = 160 * MB, U_O = 64 * MB;
constexpr size_t U_GATE = 0, U_XC = 64 * MB, U_REC = 128 * MB, U_LA = 128 * MB, U_B = 192 * MB;
constexpr size_t WS_XSA = 108 * MB, WS_XSB = 109 * MB;
constexpr size_t WS_RS = 108 * MB;
constexpr int SCAN_L = 128, SCAN_NC = SEQ / SCAN_L;

__device__ __forceinline__ unsigned f2bf(float f) { unsigned u = __float_as_uint(f); return (u + 0x7fffu + ((u >> 16) & 1u)) >> 16; }
__device__ __forceinline__ unsigned pk2(float lo, float hi) { return f2bf(lo) | (f2bf(hi) << 16); }
__device__ __forceinline__ float bflo(unsigned w) { return __uint_as_float(w << 16); }
__device__ __forceinline__ float bfhi(unsigned w) { return __uint_as_float(w & 0xffff0000u); }
__device__ __forceinline__ float bf1(u16 h) { return __uint_as_float(((unsigned)h) << 16); }
__device__ __forceinline__ float wave_sum(float v) {
    v += xor1f(v); v += xor2f(v); v += xor4f(v); v += xor8f(v); v += xor16f(v);
    return sum32f(v);
}
__device__ __forceinline__ void transpose_item(const float* W, int ldw, u16* WT, int ldt, int nblk, float* scr, int item, int lane) {
    const int kb = item / nblk, nb = item % nblk, k0 = 64 * kb, n0 = 32 * nb;
#pragma unroll
    for (int i = 0; i < 8; ++i) { const int kk = 8 * i + (lane >> 3); const f32x4 v = *(const f32x4*)(W + (size_t)(k0 + kk) * ldw + n0 + (lane & 7) * 4);
        float* s = scr + kk * 33 + (lane & 7) * 4; s[0] = v.x; s[1] = v.y; s[2] = v.z; s[3] = v.w; }
    asm volatile("s_waitcnt lgkmcnt(0)" ::: "memory");
    const int c = lane & 7;
#pragma unroll
    for (int j = 0; j < 4; ++j) { const int n = (lane >> 3) + 8 * j; const float* s = scr + (8 * c) * 33 + n;
        uint4 o; o.x = pk2(s[0 * 33], s[1 * 33]); o.y = pk2(s[2 * 33], s[3 * 33]); o.z = pk2(s[4 * 33], s[5 * 33]); o.w = pk2(s[6 * 33], s[7 * 33]);
        *(uint4*)(WT + (size_t)(n0 + n) * ldt + k0 + 8 * c) = o; }
    asm volatile("s_waitcnt lgkmcnt(0)" ::: "memory");
}
struct Params { const float* in[23]; float* out; unsigned char* ws; };
enum { I_X = 0, I_POS, I_MIXPRE, I_MIXPOST, I_FFNPRE, I_FFNPOST, I_MLA_WIN, I_MLA_QN, I_MLA_KVN, I_MLA_WUQ, I_MLA_WUKV, I_MLA_WO,
       I_LRU_WIN, I_LRU_CW, I_LRU_CB, I_LRU_WA, I_LRU_BA, I_LRU_WX, I_LRU_BX, I_LRU_LAM, I_LRU_WOUT, I_FFN_UP, I_FFN_DOWN };

__device__ __forceinline__ void prologue_weights(const __attribute__((address_space(4))) Params& p, float* scr, int gw, int NGW, int lane) {
    u16* wt = (u16*)p.ws;
    constexpr int IT_MLA = 352 + 288 + 256 + 512, IT_LRU = 1024 + 128 + 512, IT_FFN = 4096, TOTAL = 2 * IT_MLA + 2 * IT_LRU + 4 * IT_FFN;
    for (int it = gw; it < TOTAL; it += NGW) {
        int r = it; const float* W; int ldw, ldt, nblk; u16* WT;
        if (r < 2 * IT_MLA) { const int j = r / IT_MLA; r -= j * IT_MLA; u16* base = wt + WT_MLA(j) / 2;
            if (r < 352) { W = p.in[I_MLA_WIN] + (size_t)j * 1024 * 704; ldw = 704; nblk = 22; WT = base; ldt = 1024; }
            else if (r < 640) { r -= 352; W = p.in[I_MLA_WUQ] + (size_t)j * 384 * 1536; ldw = 1536; nblk = 48; WT = base + OFF_UQ / 2; ldt = 384; }
            else if (r < 896) { r -= 640; W = p.in[I_MLA_WUKV] + (size_t)j * 256 * 2048; ldw = 2048; nblk = 64; WT = base + OFF_UKV / 2; ldt = 256; }
            else { r -= 896; W = p.in[I_MLA_WO] + (size_t)j * 1024 * 1024; ldw = 1024; nblk = 32; WT = base + OFF_WO / 2; ldt = 1024; }
        } else if (r < 2 * IT_MLA + 2 * IT_LRU) { r -= 2 * IT_MLA; const int j = r / IT_LRU; r -= j * IT_LRU; u16* base = wt + WT_LRU(j) / 2;
            if (r < 1024) { W = p.in[I_LRU_WIN] + (size_t)j * 1024 * 2048; ldw = 2048; nblk = 64; WT = base; ldt = 1024; }
            else if (r < 1152) { r -= 1024; const int which = r >> 3, gt = which >> 3, n = which & 7; r &= 7;
                W = p.in[gt ? I_LRU_WX : I_LRU_WA] + (size_t)j * 8 * 128 * 128 + (size_t)n * 128 * 128; ldw = 128; nblk = 4;
                WT = base + OFF_GT / 2 + (size_t)(n * 256 + gt * 128) * 256 + 128 * (n & 1); ldt = 256; }
            else { r -= 1152; W = p.in[I_LRU_WOUT] + (size_t)j * 1024 * 1024; ldw = 1024; nblk = 32; WT = base + OFF_LOUT / 2; ldt = 1024; }
        } else { r -= 2 * IT_MLA + 2 * IT_LRU; const int l = r / IT_FFN; r -= l * IT_FFN; u16* base = wt + WT_FFN(l) / 2;
            if (r < 2048) { W = p.in[I_FFN_UP] + (size_t)l * 1024 * 4096; ldw = 4096; nblk = 128; WT = base; ldt = 1024; }
            else { r -= 2048; W = p.in[I_FFN_DOWN] + (size_t)l * 4096 * 1024; ldw = 1024; nblk = 32; WT = base + OFF_DOWN / 2; ldt = 4096; }
        }
        transpose_item(W, ldw, WT, ldt, nblk, scr, r, lane);
    }
}
__device__ __forceinline__ void rowop(const u16* y, const float* xin, float* xout, u16* hn, float* rs, const float* gpost, const float* gpre, int gw, int NGW, int lane) {
    f32x4 gp[4], gq[4];
#pragma unroll
    for (int j = 0; j < 4; ++j) { gp[j] = gpost ? *(const f32x4*)(gpost + j * 256 + lane * 4) : (f32x4){0.f, 0.f, 0.f, 0.f}; gq[j] = gpre ? *(const f32x4*)(gpre + j * 256 + lane * 4) : (f32x4){0.f, 0.f, 0.f, 0.f}; }
    for (int row = gw; row < M; row += NGW) {
        f32x4 xv[4];
#pragma unroll
        for (int j = 0; j < 4; ++j) xv[j] = *(const f32x4*)(xin + (size_t)row * D + j * 256 + lane * 4);
        if (y) {
            f32x4 yv[4]; float ss = 0.f;
#pragma unroll
            for (int j = 0; j < 4; ++j) { const uint2 w = *(const uint2*)(y + (size_t)row * D + j * 256 + lane * 4);
                yv[j] = (f32x4){bflo(w.x), bfhi(w.x), bflo(w.y), bfhi(w.y)}; ss += (yv[j].x * yv[j].x + yv[j].y * yv[j].y) + (yv[j].z * yv[j].z + yv[j].w * yv[j].w); }
            const float r = rsqrtf(wave_sum(ss) * (1.f / D) + EPS);
#pragma unroll
            for (int j = 0; j < 4; ++j) xv[j] = xv[j] + (yv[j] * r) * gp[j];
        }
        if (xout) {
#pragma unroll
        for (int j = 0; j < 4; ++j) *(f32x4*)(xout + (size_t)row * D + j * 256 + lane * 4) = xv[j]; }
        if (gpre) {
            float s2 = 0.f;
#pragma unroll
            for (int j = 0; j < 4; ++j) s2 += (xv[j].x * xv[j].x + xv[j].y * xv[j].y) + (xv[j].z * xv[j].z + xv[j].w * xv[j].w);
            const float tot2 = wave_sum(s2); const float r2 = 1.0f;
            if (rs && lane < 4) rs[(size_t)row * 4 + lane] = lane == 0 ? tot2 : 0.f;
#pragma unroll
            for (int j = 0; j < 4; ++j) { const f32x4 h = (xv[j] * r2) * gq[j]; uint2 w; w.x = pk2(h.x, h.y); w.y = pk2(h.z, h.w);
                *(uint2*)(hn + (size_t)row * D + j * 256 + lane * 4) = w; }
        }
    }
}
__device__ __forceinline__ void qkvnorm(const u16* proj, u16* cq, u16* ckv, u16* kr, const float* qn, const float* kvn, const float* ctab, const float* stab, const float* rss, int gw, int NGW, int lane) {
    float gA[8], gB[8];
    { const float* gp = lane < 48 ? qn + 8 * lane : kvn + (8 * lane - 384); const f32x4 g0 = *(const f32x4*)gp, g1 = *(const f32x4*)(gp + 4);
      gA[0] = g0[0]; gA[1] = g0[1]; gA[2] = g0[2]; gA[3] = g0[3]; gA[4] = g1[0]; gA[5] = g1[1]; gA[6] = g1[2]; gA[7] = g1[3]; }
    { f32x4 g0 = {0.f, 0.f, 0.f, 0.f}, g1 = {0.f, 0.f, 0.f, 0.f}; if (lane < 16) { g0 = *(const f32x4*)(kvn + 128 + 8 * lane); g1 = *(const f32x4*)(kvn + 132 + 8 * lane); }
      gB[0] = g0[0]; gB[1] = g0[1]; gB[2] = g0[2]; gB[3] = g0[3]; gB[4] = g1[0]; gB[5] = g1[1]; gB[6] = g1[2]; gB[7] = g1[3]; }
    const bool ropeL = lane >= 16 && lane < 24; const int rk = (lane & 3) * 8;
    const int cOff = lane < 20 ? 672 + rk : 640 + rk;
    for (int row0 = gw; row0 < M; row0 += 2 * NGW) {
        float A[2][8], B[2][8], C[2][8], rsc[2], sa[2], sb[2];
#pragma unroll
        for (int q = 0; q < 2; ++q) { const int row = row0 + q * NGW; const u16* pr = proj + (size_t)row * 768;
            const f32x4 pp = *(const f32x4*)(rss + (size_t)row * 4); rsc[q] = rsqrtf(((pp[0] + pp[1]) + (pp[2] + pp[3])) * (1.f / D) + EPS);
            const uint4 a = *(const uint4*)(pr + 8 * lane); uint4 b = make_uint4(0u, 0u, 0u, 0u), c = make_uint4(0u, 0u, 0u, 0u);
            if (lane < 24) b = *(const uint4*)(pr + 512 + 8 * lane);
            if (ropeL) c = *(const uint4*)(pr + cOff);
            A[q][0] = bflo(a.x); A[q][1] = bfhi(a.x); A[q][2] = bflo(a.y); A[q][3] = bfhi(a.y); A[q][4] = bflo(a.z); A[q][5] = bfhi(a.z); A[q][6] = bflo(a.w); A[q][7] = bfhi(a.w);
            B[q][0] = bflo(b.x); B[q][1] = bfhi(b.x); B[q][2] = bflo(b.y); B[q][3] = bfhi(b.y); B[q][4] = bflo(b.z); B[q][5] = bfhi(b.z); B[q][6] = bflo(b.w); B[q][7] = bfhi(b.w);
            C[q][0] = bflo(c.x); C[q][1] = bfhi(c.x); C[q][2] = bflo(c.y); C[q][3] = bfhi(c.y); C[q][4] = bflo(c.z); C[q][5] = bfhi(c.z); C[q][6] = bflo(c.w); C[q][7] = bfhi(c.w); }
#pragma unroll
        for (int q = 0; q < 2; ++q) { sa[q] = 0.f; sb[q] = 0.f;
#pragma unroll
            for (int e = 0; e < 8; ++e) { A[q][e] *= rsc[q]; B[q][e] *= rsc[q]; C[q][e] *= rsc[q]; sa[q] += A[q][e] * A[q][e]; sb[q] += B[q][e] * B[q][e]; } }
        float r1[2], r2[2];
#pragma unroll
        for (int q = 0; q < 2; ++q) { const float s1 = wave_sum(lane < 48 ? sa[q] : 0.f), s2 = wave_sum((lane >= 48 ? sa[q] : 0.f) + (lane < 16 ? sb[q] : 0.f));
            r1[q] = rsqrtf(s1 * (1.f / 384.f) + EPS); r2[q] = rsqrtf(s2 * (1.f / 256.f) + EPS); }
#pragma unroll
        for (int q = 0; q < 2; ++q) { const int row = row0 + q * NGW;
            { const float r = lane < 48 ? r1[q] : r2[q]; uint4 o; o.x = pk2(A[q][0] * r * gA[0], A[q][1] * r * gA[1]); o.y = pk2(A[q][2] * r * gA[2], A[q][3] * r * gA[3]);
              o.z = pk2(A[q][4] * r * gA[4], A[q][5] * r * gA[5]); o.w = pk2(A[q][6] * r * gA[6], A[q][7] * r * gA[7]);
              if (lane < 48) *(uint4*)(cq + (size_t)row * 384 + 8 * lane) = o; else *(uint4*)(ckv + (size_t)row * 256 + (8 * lane - 384)) = o; }
            if (lane < 16) { const float r = r2[q]; uint4 o; o.x = pk2(B[q][0] * r * gB[0], B[q][1] * r * gB[1]); o.y = pk2(B[q][2] * r * gB[2], B[q][3] * r * gB[3]);
              o.z = pk2(B[q][4] * r * gB[4], B[q][5] * r * gB[5]); o.w = pk2(B[q][6] * r * gB[6], B[q][7] * r * gB[7]);
              *(uint4*)(ckv + (size_t)row * 256 + 128 + 8 * lane) = o; }
            if (ropeL) { const f32x4 c0 = *(const f32x4*)(ctab + (size_t)row * 32 + rk), c1 = *(const f32x4*)(ctab + (size_t)row * 32 + rk + 4), s0 = *(const f32x4*)(stab + (size_t)row * 32 + rk), s1 = *(const f32x4*)(stab + (size_t)row * 32 + rk + 4);
              float ov[8];
#pragma unroll
              for (int e = 0; e < 8; ++e) { const float cc = e < 4 ? c0[e & 3] : c1[e & 3], ss = e < 4 ? s0[e & 3] : s1[e & 3];
                  ov[e] = lane < 20 ? B[q][e] * cc - C[q][e] * ss
                                    : B[q][e] * cc + C[q][e] * ss; }
              uint4 o; o.x = pk2(ov[0], ov[1]); o.y = pk2(ov[2], ov[3]); o.z = pk2(ov[4], ov[5]); o.w = pk2(ov[6], ov[7]);
              *(uint4*)(kr + (size_t)row * 64 + (lane < 20 ? 0 : 32) + rk) = o; }
        }
    }
}
__device__ __forceinline__ void qrope(u16* q, const float* ctab, const float* stab, int gw, int NGW, int lane) {
    for (int row = gw; row < M; row += NGW) {
        u16* qr = q + (size_t)row * 1536; const int i = lane & 31;
        const float c = ctab[(size_t)row * 32 + i], s = stab[(size_t)row * 32 + i];
#pragma unroll
        for (int j = 0; j < 4; ++j) { const int h = 2 * j + (lane >> 5); u16* pp = qr + h * 192 + 128 + i;
            const float x1 = bf1(pp[0]), x2 = bf1(pp[32]);
            pp[0] = (u16)f2bf(x1 * c - x2 * s); pp[32] = (u16)f2bf(x2 * c + x1 * s); }
    }
}
__device__ __forceinline__ void conv_phase(const u16* rec, u16* xc, const float* cw, const float* cb, int gtid, int NGT) {
    for (int idx = gtid; idx < (M / 32) * 128; idx += NGT) {
        const int r0 = (idx >> 7) * 32, c0 = (idx & 127) * 8;
        float w[4][8], bias[8], win[3][8];
#pragma unroll
        for (int e = 0; e < 8; ++e) { bias[e] = cb[c0 + e];
#pragma unroll
            for (int k = 0; k < 4; ++k) w[k][e] = cw[k * D + c0 + e]; }
        const bool first = (r0 & (SEQ - 1)) == 0;
#pragma unroll
        for (int k = 0; k < 3; ++k) { uint4 v = make_uint4(0u, 0u, 0u, 0u); if (!first) v = *(const uint4*)(rec + (size_t)(r0 - 3 + k) * D + c0);
            win[k][0] = bflo(v.x); win[k][1] = bfhi(v.x); win[k][2] = bflo(v.y); win[k][3] = bfhi(v.y); win[k][4] = bflo(v.z); win[k][5] = bfhi(v.z); win[k][6] = bflo(v.w); win[k][7] = bfhi(v.w); }
        for (int i0 = 0; i0 < 32; i0 += 8) {
            uint4 in[8];
#pragma unroll
            for (int u = 0; u < 8; ++u) in[u] = *(const uint4*)(rec + (size_t)(r0 + i0 + u) * D + c0);
#pragma unroll
            for (int u = 0; u < 8; ++u) {
                const float x[8] = {bflo(in[u].x), bfhi(in[u].x), bflo(in[u].y), bfhi(in[u].y), bflo(in[u].z), bfhi(in[u].z), bflo(in[u].w), bfhi(in[u].w)};
                float acc[8];
#pragma unroll
                for (int e = 0; e < 8; ++e) { acc[e] = bias[e] + win[0][e] * w[0][e] + win[1][e] * w[1][e] + win[2][e] * w[2][e] + x[e] * w[3][e]; win[0][e] = win[1][e]; win[1][e] = win[2][e]; win[2][e] = x[e]; }
                uint4 o; o.x = pk2(acc[0], acc[1]); o.y = pk2(acc[2], acc[3]); o.z = pk2(acc[4], acc[5]); o.w = pk2(acc[6], acc[7]);
                *(uint4*)(xc + (size_t)(r0 + i0 + u) * D + c0) = o;
            }
        }
    }
}
__device__ __forceinline__ void scanA(const u16* A, const u16* B, float* SA, float* SB, int tid) {
    for (int item = blockIdx.x; item < 2 * SCAN_NC; item += gridDim.x) {
        const int c = item % SCAN_NC, b = item / SCAN_NC, ch = 2 * tid;
        const size_t base = ((size_t)b * SEQ + (size_t)c * SCAN_L) * D + ch;
        float h0 = 0.f, h1 = 0.f, P0 = 1.f, P1 = 1.f;
        for (int t0 = 0; t0 < SCAN_L; t0 += 16) {
            unsigned aw[16], bw[16];
#pragma unroll
            for (int u = 0; u < 16; ++u) { aw[u] = *(const unsigned*)(A + base + (size_t)(t0 + u) * D); bw[u] = *(const unsigned*)(B + base + (size_t)(t0 + u) * D); }
#pragma unroll
            for (int u = 0; u < 16; ++u) { const float a0 = __expf(bflo(aw[u])), a1 = __expf(bfhi(aw[u])); h0 = a0 * h0 + bflo(bw[u]); h1 = a1 * h1 + bfhi(bw[u]); P0 *= a0; P1 *= a1; }
        }
        const size_t so = ((size_t)b * SCAN_NC + c) * D + ch;
        *(float2*)(SA + so) = make_float2(P0, P1); *(float2*)(SB + so) = make_float2(h0, h1);
    }
}
__device__ __forceinline__ void scanC(const u16* A, const u16* B, const float* SA, const float* SB, const u16* gate, u16* hg, int tid) {
    for (int item = blockIdx.x; item < 2 * SCAN_NC; item += gridDim.x) {
        const int c = item % SCAN_NC, b = item / SCAN_NC, ch = 2 * tid;
        const size_t base = ((size_t)b * SEQ + (size_t)c * SCAN_L) * D + ch;
        float h0 = 0.f, h1 = 0.f;
        for (int cc = 0; cc < c; ++cc) { const size_t so = ((size_t)b * SCAN_NC + cc) * D + ch; const float2 pa = *(const float2*)(SA + so), pb = *(const float2*)(SB + so); h0 = pa.x * h0 + pb.x; h1 = pa.y * h1 + pb.y; }
        for (int t0 = 0; t0 < SCAN_L; t0 += 16) {
            unsigned aw[16], bw[16], gv[16];
#pragma unroll
            for (int u = 0; u < 16; ++u) { aw[u] = *(const unsigned*)(A + base + (size_t)(t0 + u) * D); bw[u] = *(const unsigned*)(B + base + (size_t)(t0 + u) * D); gv[u] = *(const unsigned*)(gate + base + (size_t)(t0 + u) * D); }
#pragma unroll
            for (int u = 0; u < 16; ++u) { h0 = __expf(bflo(aw[u])) * h0 + bflo(bw[u]); h1 = __expf(bfhi(aw[u])) * h1 + bfhi(bw[u]);
                *(unsigned*)(hg + base + (size_t)(t0 + u) * D) = pk2(bflo(gv[u]) * h0, bfhi(gv[u]) * h1); }
        }
    }
}

constexpr int LDS_GEMM = pg8::STAGE_BYTES + 8192, LDS_MAIN = att::LDS_BYTES > LDS_GEMM ? att::LDS_BYTES : LDS_GEMM, LDS_BYTES = LDS_MAIN + 16;
constexpr size_t WS_BAR = 106 * MB;
constexpr size_t WS_CNT1 = WS_BAR + 16384, WS_CNT2 = WS_BAR + 49152, CTL_BYTES = 81920, WS_XS1 = 107 * MB, WS_XS2 = 107 * MB + MB / 2;
constexpr int XL_OFF = 131072;
static_assert(XL_OFF + 8192 <= LDS_MAIN && XCD_BAR_WORDS * 4 <= 16384 && att::LDS_BYTES <= LDS_MAIN && pg8::STAGE_BYTES <= LDS_MAIN && LDS_BYTES <= 160 * 1024, "LDS map");

__global__ void __launch_bounds__(512, 2) fwd_mega(Params p_arg) {
    extern __shared__ __attribute__((aligned(16))) unsigned char lds[];
    cg::grid_group grid = cg::this_grid();
    (void)p_arg;
    volatile __attribute__((address_space(3))) unsigned* bst = (volatile __attribute__((address_space(3))) unsigned*)((__attribute__((address_space(3))) unsigned char*)lds + LDS_MAIN);
    if (threadIdx.x < 4) bst[threadIdx.x] = 0u;
    __syncthreads();
    const int wave_s = __builtin_amdgcn_readfirstlane(threadIdx.x >> 6);
    const unsigned bar_x = xb::xb_xcc_id();
    (void)xb::xcd_barrier_post((unsigned*)(p_arg.ws + WS_BAR), bst);
#define GRID_BAR() do { unsigned bx_ = bar_x; asm volatile("" : "+s"(bx_)); xb::XcdBarrier bb_; bb_.bar = (unsigned*)(ws + WS_BAR); bb_.x = bx_; bb_.st = bst; xb::xcd_barrier(bb_, tid == 0); } while (0)
    typedef const __attribute__((address_space(4))) Params* KParams;
    KParams pp = (KParams)__builtin_amdgcn_kernarg_segment_ptr();
#define FRESH() int tid_ = wave_s * 64 + lane_id_fresh(); asm volatile("" : "+v"(tid_)); asm volatile("" : "+s"(pp)); const __attribute__((address_space(4))) Params& p = *pp; \
    const int tid = tid_, lane = tid & 63, wave = __builtin_amdgcn_readfirstlane(tid >> 6); \
    const int G = gridDim.x, gw = blockIdx.x * 8 + wave, NGW = G * 8, gtid = blockIdx.x * 512 + tid, NGT = G * 512; \
    unsigned char* ws = p.ws; float* x = p.out; u16* hn = (u16*)(ws + WS_HN); u16* ybuf = (u16*)(ws + WS_Y); unsigned char* U = ws + WS_U; \
    float* ctab = (float*)(ws + WS_COS); float* stab = (float*)(ws + WS_SIN); float* SA = (float*)(ws + WS_SA); float* SB = (float*)(ws + WS_SB); \
    (void)lane; (void)wave; (void)gw; (void)NGW; (void)gtid; (void)NGT; (void)x; (void)hn; (void)ybuf; (void)U; (void)ctab; (void)stab; (void)SA; (void)SB;
    {
    FRESH();

    for (int prep = 0; prep < PROBE_PRO_REPS; ++prep) {
    prologue_weights(p, (float*)lds + wave * (64 * 33), gw, NGW, lane);
    for (int i = gtid; i < 2 * 2048 * 16; i += NGT) { const int j = i >> 15, row = (i >> 4) & 2047, chn = i & 15, n = row >> 8;
        *(uint4*)((u16*)(ws + WT_LRU(j) + OFF_GT) + (size_t)row * 256 + 128 * ((n & 1) ^ 1) + chn * 8) = make_uint4(0u, 0u, 0u, 0u); }
    { const int* pos = (const int*)p.in[I_POS];
      for (int i = gtid; i < M * 32; i += NGT) { const int row = i >> 5, f = i & 31;
        const float inv = __builtin_amdgcn_exp2f(-(float)f * (13.287712379549449f / 32.f));
        const float ang = (float)pos[row] * inv;
        double rev = (double)ang * 0.15915494309189535; rev -= __builtin_rint(rev);
        ctab[i] = __builtin_amdgcn_cosf((float)rev); stab[i] = __builtin_amdgcn_sinf((float)rev); } }
    rowop(nullptr, p.in[I_X], nullptr, hn, (float*)(ws + WS_XSB), nullptr, p.in[I_MIXPRE], gw, NGW, lane);
    }
    if (ws == nullptr) grid.sync();
    GRID_BAR();
    }

#pragma nounroll
    for (int layer = 0; layer < 4; ++layer) {
#pragma nounroll
        for (int op = 0; op < 10; ++op) {
            FRESH();
            const int j = layer >> 1; const bool lru = (layer & 1) != 0;
            const u16* wtm = (const u16*)(ws + WT_MLA(j)); const u16* wtl = (const u16*)(ws + WT_LRU(j)); const u16* wtf = (const u16*)(ws + WT_FFN(layer));
            int gk = 0;
            pg8::Gemm g{}; pg8::EpiB E{};
            if (op == 6 || op == 9) continue;
            const float* gprev = p.in[op == 5 ? I_MIXPRE : I_FFNPRE] + layer * D;
            const float* gpost = p.in[op == 5 ? I_MIXPOST : I_FFNPOST] + layer * D;
            const float* gpre = op == 5 ? p.in[I_FFNPRE] + layer * D : (layer < 3 ? p.in[I_MIXPRE] + (layer + 1) * D : nullptr);
            if (op == 7) { gk = 1; g = pg8::Gemm{hn, wtf, M, 4096, 1024, 1024, 1024, 0}; E = pg8::EpiB{(u16*)U, 4096, 0, 0, 1, nullptr}; }
            else if (op == 8) { gk = 3; g = pg8::Gemm{(const u16*)U, wtf + OFF_DOWN / 2, M, 1024, 4096, 4096, 4096, 0}; }
            else if (!lru) {
                u16* proj = (u16*)(U + U_PROJ); u16* cq = (u16*)(U + U_CQ); u16* ckv = (u16*)(U + U_CKV); u16* kr = (u16*)(U + U_KR); u16* q = (u16*)(U + U_Q); u16* o = (u16*)(U + U_O); u16* kv = ybuf;
                if (op == 0) { gk = 1; g = pg8::Gemm{hn, wtm, M, 768, 1024, 1024, 1024, 0}; E = pg8::EpiB{proj, 768, 0, 0, 0, nullptr}; }
                else if (op == 1) for (int rep = 0; rep < PROBE_THIN_REPS; ++rep) qkvnorm(proj, cq, ckv, kr, p.in[I_MLA_QN] + j * 384, p.in[I_MLA_KVN] + j * 256, ctab, stab, (const float*)(ws + WS_XSB), gw, NGW, lane);
                else if (op == 2) { gk = 1; g = pg8::Gemm{cq, wtm + OFF_UQ / 2, M, 1536, 384, 384, 384, 0}; E = pg8::EpiB{q, 1536, 0, 0, 0, nullptr}; }
                else if (op == 3) { gk = 1; g = pg8::Gemm{ckv, wtm + OFF_UKV / 2, M, 2048, 256, 256, 256, 0}; E = pg8::EpiB{kv, 2048, 0, 0, 0, nullptr}; }
                else if (op == 4) { const att::Tensors T{q, kv, kr, o, ctab, stab}; for (int rep = 0; rep < PROBE_ATT_REPS; ++rep) att::attn_phase((char*)lds, T, tid); }
                else { gk = 3; g = pg8::Gemm{o, wtm + OFF_WO / 2, M, 1024, 1024, 1024, 1024, 0}; }
            } else {
                u16* gate = (u16*)(U + U_GATE); u16* xc = (u16*)(U + U_XC); u16* rec = (u16*)(U + U_REC); u16* Bb = (u16*)(U + U_B); u16* Ab = (u16*)(U + U_LA); u16* hg = xc;
                if (op == 0) { gk = 1; g = pg8::Gemm{hn, wtl, M, 2048, 1024, 1024, 1024, 0}; E = pg8::EpiB{gate, 1024, 1024, (size_t)(U_REC - U_GATE) / 2, 2, (const float*)(ws + WS_XSB)}; }
                else if (op == 1) for (int rep = 0; rep < PROBE_THIN_REPS; ++rep) conv_phase(rec, xc, p.in[I_LRU_CW] + j * 4 * D, p.in[I_LRU_CB] + j * D, gtid, NGT);
                else if (op == 2) { gk = 2; g = pg8::Gemm{xc, wtl + OFF_GT / 2, M, 2048, 256, 1024, 256, 512}; }
                else if (op == 3) for (int rep = 0; rep < PROBE_THIN_REPS; ++rep) scanA(Ab, Bb, SA, SB, tid);
                else if (op == 4) for (int rep = 0; rep < PROBE_THIN_REPS; ++rep) scanC(Ab, Bb, SA, SB, gate, hg, tid);
                else { gk = 3; g = pg8::Gemm{hg, wtl + OFF_LOUT / 2, M, 1024, 1024, 1024, 1024, 0}; }
            }
            for (int rep = 0; rep < PROBE_GEMM_REPS; ++rep)
            if (gk == 1) { pg8::StaticOrder S; S.init(g.M, g.N, G, (int)blockIdx.x);
                pg8::gemm_phase<pg8::EpiB, pg8::StaticOrder, true>((PG8_LAS unsigned char*)lds, g, S, E, tid); }
            else if (gk == 2) { pg8::StaticOrder S; S.init(g.M, g.N, G, (int)blockIdx.x);
                const pg8::EpiGate EG{(const u16*)(U + U_XC), (u16*)(U + U_LA), (u16*)(U + U_B), p.in[I_LRU_BA] + j * D, p.in[I_LRU_BX] + j * D, p.in[I_LRU_LAM] + j * D};
                pg8::gemm_phase<pg8::EpiGate, pg8::StaticOrder, true>((PG8_LAS unsigned char*)lds, g, S, EG, tid); }
            else if (gk == 3) { pg8::StaticOrder S; S.init(g.M, g.N, G, (int)blockIdx.x);
                const unsigned target = 32u * (unsigned)(layer * 2 + (op == 8 ? 2 : 1));
                const pg8::RowStats st1{(float*)(ws + WS_XS1), (unsigned*)(ws + WS_CNT1), target};
                const pg8::EpiNormRes EN{hn, (float*)(ws + (op == 8 ? WS_XSB : WS_XSA)), x, gprev, gpost, gpre, st1, (PG8_LAS unsigned char*)lds + XL_OFF, op == 8 ? (const float*)(ws + WS_XSA) : nullptr};
                pg8::gemm_phase<pg8::EpiNormRes, pg8::StaticOrder, true>((PG8_LAS unsigned char*)lds, g, S, EN, tid); }
            if (!(layer == 3 && op == 8) && !(!lru && op == 2)) { for (int rep = 0; rep < PROBE_SYNC_REPS; ++rep) GRID_BAR(); }
        }
    }
}
}

extern "C" void kernel_launch(void* const* d_in, const int* in_sizes, int n_in, void* d_out, int out_size, void* d_ws, size_t ws_size, hipStream_t stream) {
    static int grid = 0;
    if (grid == 0) {
        if (n_in != 23 || in_sizes[0] != mk::M * mk::D || out_size != mk::M * mk::D || ws_size < mk::WS_END) {
            fprintf(stderr, "kernel_launch: unexpected shapes (n_in %d, in0 %d, out %d, ws %zu); nothing launched\n", n_in, n_in > 0 ? in_sizes[0] : -1, out_size, ws_size); grid = -1; return; }
        int dev = 0, cus = 0, per_cu = 0;
        (void)hipGetDevice(&dev); (void)hipDeviceGetAttribute(&cus, hipDeviceAttributeMultiprocessorCount, dev);
        if (hipFuncSetAttribute((const void*)mk::fwd_mega, hipFuncAttributeMaxDynamicSharedMemorySize, mk::LDS_BYTES) != hipSuccess) { fprintf(stderr, "kernel_launch: hipFuncSetAttribute failed\n"); grid = -1; return; }
        if (hipOccupancyMaxActiveBlocksPerMultiprocessor(&per_cu, (const void*)mk::fwd_mega, 512, mk::LDS_BYTES) != hipSuccess || per_cu < 1) { fprintf(stderr, "kernel_launch: occupancy query says %d blocks per CU\n", per_cu); per_cu = 1; }
        (void)hipGetLastError();
        grid = cus > 0 ? cus : 256;
    }
    if (grid < 0) return;
    mk::Params p{};
    for (int i = 0; i < 23; ++i) p.in[i] = (const float*)d_in[i];
    p.out = (float*)d_out; p.ws = (unsigned char*)d_ws;
    if (hipMemsetAsync((char*)d_ws + mk::WS_BAR, 0, mk::CTL_BYTES, stream) != hipSuccess) { fprintf(stderr, "kernel_launch: hipMemsetAsync failed\n"); return; }
    void* args[] = {&p};
    hipError_t e = hipLaunchCooperativeKernel((const void*)mk::fwd_mega, dim3(grid), dim3(512), args, mk::LDS_BYTES, stream);
    if (e != hipSuccess) fprintf(stderr, "kernel_launch: cooperative launch failed: %s (grid %d)\n", hipGetErrorString(e), grid);
}
```

```cpp
#include <hip/hip_runtime.h>
#include <hip/hip_bf16.h>
#include <hip/hip_cooperative_groups.h>
#include <cstdio>
#include <cstdint>
namespace cg = cooperative_groups;

__device__ __forceinline__ float xor1f(float v)  { return __int_as_float(__builtin_amdgcn_mov_dpp(__float_as_int(v), 0xB1, 0xF, 0xF, false)); }
__device__ __forceinline__ float xor2f(float v)  { return __int_as_float(__builtin_amdgcn_mov_dpp(__float_as_int(v), 0x4E, 0xF, 0xF, false)); }
__device__ __forceinline__ float xor4f(float v)  { return __int_as_float(__builtin_amdgcn_ds_swizzle(__float_as_int(v), 0x101F)); }
__device__ __forceinline__ float xor8f(float v)  { return __int_as_float(__builtin_amdgcn_ds_swizzle(__float_as_int(v), 0x201F)); }
__device__ __forceinline__ float xor16f(float v) { return __int_as_float(__builtin_amdgcn_ds_swizzle(__float_as_int(v), 0x401F)); }
__device__ __forceinline__ float sum32f(float v) { auto rr = __builtin_amdgcn_permlane32_swap(__float_as_uint(v), __float_as_uint(v), false, false); return __uint_as_float(rr[0]) + __uint_as_float(rr[1]); }
__device__ __forceinline__ int lane_id_fresh() { int l; asm volatile("v_mbcnt_lo_u32_b32 %0, -1, 0\n\tv_mbcnt_hi_u32_b32 %0, -1, %0" : "=v"(l)); return l; }
namespace pg8 {
#define PG8_LAS __attribute__((address_space(3)))
typedef unsigned short bf16_t;
typedef short bf16x8 __attribute__((ext_vector_type(8)));
typedef float f32x4 __attribute__((ext_vector_type(4)));
typedef unsigned u32x4 __attribute__((ext_vector_type(4)));
constexpr int BM = 256, BK = 64, HALF = 128, HTB = HALF * BK * 2  , STAGE_BYTES = 8 * HTB, NXCD = 8, WGM = 8;

__host__ __device__ __forceinline__ int lds_byte(int r, int c) { const int st = (r >> 4) * 2 + (c >> 5), rr = r & 15, cc = c & 31, ob = rr * 64 + cc * 2; return st * 1024 + (ob ^ (((ob >> 9) & 1) << 5)); }
__host__ __device__ __forceinline__ void stage_rc(int b, int& R, int& C) { const int st = b / 1024, sb = b % 1024, swz = sb ^ (((sb >> 9) & 1) << 5); R = (st >> 1) * 16 + swz / 64; C = (st & 1) * 32 + (swz % 64) / 2; }
__host__ __device__ __forceinline__ int perm32(int rho) { const int n = rho >> 4, i = rho & 15; return 8 * (i >> 2) + 4 * n + (i & 3); }

struct Unit { int pm, pn; };
struct Gemm { const bf16_t* A; const bf16_t* Bt; int M, N, K; int lda, ldb; int apn; };

struct StaticOrder {
    int nM, nN, nwg, G, c;
    __host__ __device__ void init(int M, int N, int G_, int c_) { nM = M / BM; nN = N / BM; nwg = nM * nN; G = G_; c = c_; }
    __host__ __device__ bool next(int i, Unit& u) const {
        const long L = (long)i * G + c; if (L >= nwg) return false;
        int wgid = (int)L; { const int q = nwg / NXCD, r = nwg % NXCD, xcd = wgid % NXCD, off = wgid / NXCD; wgid = (xcd < r ? xcd * (q + 1) : r * (q + 1) + (xcd - r) * q) + off; }
        const int nig = WGM * nN, gid = wgid / nig, fm = gid * WGM, gsz = (nM - fm) < WGM ? (nM - fm) : WGM;
        u.pm = fm + ((wgid % nig) % gsz); u.pn = (wgid % nig) / gsz; return true;
    }
    __device__ __forceinline__ void a_ready(const Unit&) const {}
    __device__ __forceinline__ void done(const Unit&) const {}
};

__device__ __forceinline__ unsigned cvt_pk_bf16(float lo, float hi) { unsigned r; asm volatile("v_cvt_pk_bf16_f32 %0, %1, %2" : "=v"(r) : "v"(lo), "v"(hi)); return r; }
__device__ __forceinline__ float gelu_tanh(float x) {
    const float z = 0.7978845608028654f * (x + 0.044715f * x * x * x);
    const float e = __expf(2.0f * z);
    const float th = 1.0f - 2.0f * __builtin_amdgcn_rcpf(1.0f + e);
    return 0.5f * x * (1.0f + th);
}
struct EpiB {
    static constexpr bool PERM = true, AFTER_DRAIN = false, FUSED = false;
    bf16_t* O; int ldc; int split_cols; size_t split_stride; int mode;
    const float* rss;
    __device__ __forceinline__ void operator()(const f32x4 (&acc)[2][2][4][2], const Unit& u, int wr, int wc, int fr, int fq) const {
        const int row0 = u.pm * BM + wr * 64 + fr; int colt = u.pn * BM; bf16_t* base = O; int t = 0;
        if (split_cols) { t = colt / split_cols; base += (size_t)t * split_stride; colt -= t * split_cols; }
        const int act = (mode == 1) ? 1 : ((mode == 2 && t == 0) ? 2 : 0);
        const int col0 = colt + wc * 32 + 8 * fq;
#pragma unroll
        for (int ai = 0; ai < 2; ++ai)
#pragma unroll
            for (int m = 0; m < 4; ++m) { bf16_t* rowp = base + (size_t)(row0 + ai * HALF + m * 16) * ldc + col0;
                float rsc = 1.0f; if (rss) { const f32x4 pp = *(const f32x4*)(rss + (size_t)(row0 + ai * HALF + m * 16) * 4); rsc = rsqrtf(((pp[0] + pp[1]) + (pp[2] + pp[3])) * (1.0f / 1024.0f) + 1e-6f); }
#pragma unroll
                for (int bj = 0; bj < 2; ++bj) { f32x4 v0 = acc[ai][bj][m][0] * rsc, v1 = acc[ai][bj][m][1] * rsc;
                    if (act == 1) {
#pragma unroll
                        for (int e = 0; e < 4; ++e) { const float a = fmaxf(v0[e], 0.f), b = fmaxf(v1[e], 0.f); v0[e] = a * a; v1[e] = b * b; } }
                    else if (act == 2) {
#pragma unroll
                        for (int e = 0; e < 4; ++e) { v0[e] = gelu_tanh(v0[e]); v1[e] = gelu_tanh(v1[e]); } }
                    u32x4 w; w.x = cvt_pk_bf16(v0[0], v0[1]); w.y = cvt_pk_bf16(v0[2], v0[3]); w.z = cvt_pk_bf16(v1[0], v1[1]); w.w = cvt_pk_bf16(v1[2], v1[3]);
                    *(u32x4*)(rowp + bj * HALF) = w; } }
    }
};
__device__ __forceinline__ float bf2f(unsigned short h) { return __uint_as_float(((unsigned)h) << 16); }
__device__ __forceinline__ float sigmoidf_(float x) { return __builtin_amdgcn_rcpf(1.0f + __expf(-x)); }
__device__ __forceinline__ float one_minus_exp(float t) { const float ser = -t * (1.0f + t * (0.5f + t * (0.16666667f + t * (0.041666668f + t * 0.008333334f)))); return t > -0.25f ? ser : 1.0f - __expf(t); }
struct EpiGate {
    static constexpr bool PERM = false, AFTER_DRAIN = false, FUSED = false;
    const bf16_t* xc; bf16_t* Aout; bf16_t* Bout; const float* b_a; const float* b_x; const float* lam;
    __device__ __forceinline__ void operator()(const f32x4 (&acc)[2][2][4][2], const Unit& u, int wr, int wc, int fr, int fq) const {
#pragma unroll
        for (int n = 0; n < 2; ++n) {
            const int ch0 = 128 * u.pn + 32 * wc + 16 * n + 4 * fq;
            const f32x4 ba = *(const f32x4*)(b_a + ch0), bx = *(const f32x4*)(b_x + ch0), lm = *(const f32x4*)(lam + ch0);
            f32x4 sp;
#pragma unroll
            for (int e = 0; e < 4; ++e) sp[e] = -8.0f * log1pf(__expf(-lm[e]));
#pragma unroll
            for (int ai = 0; ai < 2; ++ai)
#pragma unroll
                for (int m = 0; m < 4; ++m) {
                    const size_t off = (size_t)(u.pm * BM + ai * HALF + wr * 64 + m * 16 + fr) * 1024 + ch0;
                    const uint2 xr = *(const uint2*)(xc + off);
                    float xv[4] = { __uint_as_float(xr.x << 16), __uint_as_float(xr.x & 0xffff0000u), __uint_as_float(xr.y << 16), __uint_as_float(xr.y & 0xffff0000u) };
                    f32x4 av, bv;
#pragma unroll
                    for (int e = 0; e < 4; ++e) {
                        const float r = sigmoidf_(acc[ai][0][m][n][e] + ba[e]);
                        const float ig = sigmoidf_(acc[ai][1][m][n][e] + bx[e]);
                        const float la = sp[e] * r;
                        av[e] = la;
                        bv[e] = __builtin_amdgcn_sqrtf(fmaxf(one_minus_exp(2.0f * la), 0.f)) * (ig * xv[e]);
                    }
                    uint2 wa, wb; wa.x = cvt_pk_bf16(av[0], av[1]); wa.y = cvt_pk_bf16(av[2], av[3]); wb.x = cvt_pk_bf16(bv[0], bv[1]); wb.y = cvt_pk_bf16(bv[2], bv[3]);
                    *(uint2*)(Aout + off) = wa; *(uint2*)(Bout + off) = wb;
                }
        }
    }
};

struct RowStats {
    float* xbuf;
    unsigned* cnt;
    unsigned target;
    __device__ __forceinline__ void run(const f32x4 (&v)[2][2][4][2], const Unit& u, int wr, int wc, int fr, int fq, PG8_LAS unsigned char* xl, int wid, int lane) const {
        PG8_LAS float* P = (PG8_LAS float*)xl;
        PG8_LAS float* S = (PG8_LAS float*)(xl + 4096);
#pragma unroll
        for (int ai = 0; ai < 2; ++ai)
#pragma unroll
            for (int m = 0; m < 4; ++m) {
                float s = 0.f;
#pragma unroll
                for (int bj = 0; bj < 2; ++bj)
#pragma unroll
                    for (int n = 0; n < 2; ++n) { const f32x4 x = v[ai][bj][m][n]; s += (x[0] * x[0] + x[1] * x[1]) + (x[2] * x[2] + x[3] * x[3]); }
                s += xor16f(s); s = sum32f(s);
                if (fq == 0) P[(ai * HALF + wr * 64 + m * 16 + fr) * 4 + wc] = s;
            }
        asm volatile("s_waitcnt lgkmcnt(0)" ::: "memory"); __builtin_amdgcn_s_barrier(); asm volatile("" ::: "memory");
        const int row = wid * 32 + (lane & 31);
        if (lane < 32) { const float t = (P[row * 4 + 0] + P[row * 4 + 1]) + (P[row * 4 + 2] + P[row * 4 + 3]);
            __hip_atomic_store(xbuf + (size_t)(u.pm * BM + row) * 4 + u.pn, t, __ATOMIC_RELAXED, __HIP_MEMORY_SCOPE_AGENT); }
        asm volatile("s_waitcnt vmcnt(0)" ::: "memory");
        if (lane == 0) __hip_atomic_fetch_add(cnt + 64 * u.pm, 1u, __ATOMIC_RELAXED, __HIP_MEMORY_SCOPE_AGENT);
        if (wid == 0) { unsigned sp = 0;
            while ((unsigned)__builtin_amdgcn_readfirstlane(__hip_atomic_load(cnt + 64 * u.pm, __ATOMIC_RELAXED, __HIP_MEMORY_SCOPE_AGENT)) < target) { __builtin_amdgcn_s_sleep(2); if (++sp > (1u << 18)) break; }
            __builtin_amdgcn_fence(__ATOMIC_ACQUIRE, "agent"); }
        asm volatile("s_waitcnt vmcnt(0) lgkmcnt(0)" ::: "memory"); __builtin_amdgcn_s_barrier(); asm volatile("" ::: "memory");
        if (lane < 32) { float* slot = xbuf + (size_t)(u.pm * BM + row) * 4; float t = 0.f;
#pragma unroll
            for (int k = 0; k < 4; ++k) t += __hip_atomic_load(slot + k, __ATOMIC_RELAXED, __HIP_MEMORY_SCOPE_AGENT);
            S[row] = t; }
        asm volatile("s_waitcnt lgkmcnt(0)" ::: "memory"); __builtin_amdgcn_s_barrier(); asm volatile("" ::: "memory");
    }
};
struct EpiNormRes {
    static constexpr bool PERM = false, AFTER_DRAIN = false, FUSED = true;
    bf16_t* hn; float* xs2; float* out; const float* gprev; const float* gpost; const float* gpre; RowStats st1; PG8_LAS unsigned char* xl;
    const float* s_in;
    __device__ __forceinline__ void fused(f32x4 (&acc)[2][2][4][2], const Unit& u, int wr, int wc, int fr, int fq, int wid, int lane) const {
        typedef unsigned u32x2v __attribute__((ext_vector_type(2)));
        PG8_LAS float* P = (PG8_LAS float*)xl;
        const PG8_LAS float* S = (const PG8_LAS float*)(xl + 4096);
        const int col0 = u.pn * BM + wc * 32 + 4 * fq;
        st1.run(acc, u, wr, wc, fr, fq, xl, wid, lane);
#pragma unroll
        for (int ai = 0; ai < 2; ++ai)
#pragma unroll
            for (int m = 0; m < 4; ++m) { const int r = ai * HALF + wr * 64 + m * 16 + fr; float rstd = rsqrtf(S[r] * (1.0f / 1024.0f) + 1e-6f); const size_t off = (size_t)(u.pm * BM + r) * 1024 + col0;
                if (s_in) { const f32x4 pp = *(const f32x4*)(s_in + (size_t)(u.pm * BM + r) * 4); const float s2 = __builtin_amdgcn_rcpf(((pp[0] + pp[1]) + (pp[2] + pp[3])) * (1.0f / 1024.0f) + 1e-6f);
                    rstd = rsqrtf(S[r] * (1.0f / 1024.0f) * s2 * s2 + 1e-6f) * s2; }
#pragma unroll
                for (int bj = 0; bj < 2; ++bj)
#pragma unroll
                    for (int n = 0; n < 2; ++n) { const u32x2v hw = *(const u32x2v*)(hn + off + bj * HALF + n * 16);
                        const f32x4 gp = *(const f32x4*)(gprev + col0 + bj * HALF + n * 16); const f32x4 gv = *(const f32x4*)(gpost + col0 + bj * HALF + n * 16);
                        f32x4 xs; xs[0] = __uint_as_float(hw.x << 16) * __builtin_amdgcn_rcpf(gp[0]); xs[1] = __uint_as_float(hw.x & 0xffff0000u) * __builtin_amdgcn_rcpf(gp[1]);
                        xs[2] = __uint_as_float(hw.y << 16) * __builtin_amdgcn_rcpf(gp[2]); xs[3] = __uint_as_float(hw.y & 0xffff0000u) * __builtin_amdgcn_rcpf(gp[3]);
                        acc[ai][bj][m][n] = xs + (acc[ai][bj][m][n] * rstd) * gv; }
                asm volatile("" : "+v"(acc[ai][0][m][0]), "+v"(acc[ai][0][m][1]), "+v"(acc[ai][1][m][0]), "+v"(acc[ai][1][m][1]));
                if (m & 1) asm volatile("" ::: "memory"); }
        if (gpre) {
#pragma unroll
            for (int ai = 0; ai < 2; ++ai)
#pragma unroll
                for (int m = 0; m < 4; ++m) {
                    float s = 0.f;
#pragma unroll
                    for (int bj = 0; bj < 2; ++bj)
#pragma unroll
                        for (int n = 0; n < 2; ++n) { const f32x4 x = acc[ai][bj][m][n]; s += (x[0] * x[0] + x[1] * x[1]) + (x[2] * x[2] + x[3] * x[3]); }
                    s += xor16f(s); s = sum32f(s);
                    if (fq == 0) P[(ai * HALF + wr * 64 + m * 16 + fr) * 4 + wc] = s;
                }
            asm volatile("s_waitcnt lgkmcnt(0)" ::: "memory"); __builtin_amdgcn_s_barrier(); asm volatile("" ::: "memory");
            { const int row = wid * 32 + (lane & 31);
              if (lane < 32) xs2[(size_t)(u.pm * BM + row) * 4 + u.pn] = (P[row * 4 + 0] + P[row * 4 + 1]) + (P[row * 4 + 2] + P[row * 4 + 3]); }
#pragma unroll
            for (int ai = 0; ai < 2; ++ai)
#pragma unroll
                for (int m = 0; m < 4; ++m) { const int r = ai * HALF + wr * 64 + m * 16 + fr; const size_t off = (size_t)(u.pm * BM + r) * 1024 + col0;
#pragma unroll
                    for (int bj = 0; bj < 2; ++bj)
#pragma unroll
                        for (int n = 0; n < 2; ++n) { const f32x4 gv = *(const f32x4*)(gpre + col0 + bj * HALF + n * 16); const f32x4 o = acc[ai][bj][m][n] * gv;
                            u32x2v w; w.x = cvt_pk_bf16(o[0], o[1]); w.y = cvt_pk_bf16(o[2], o[3]); *(u32x2v*)(hn + off + bj * HALF + n * 16) = w; }
                    asm volatile("" ::: "memory"); }
            asm volatile("s_waitcnt lgkmcnt(0)" ::: "memory"); __builtin_amdgcn_s_barrier(); asm volatile("" ::: "memory");
        } else {
#pragma unroll
            for (int ai = 0; ai < 2; ++ai)
#pragma unroll
                for (int m = 0; m < 4; ++m) { const int r = ai * HALF + wr * 64 + m * 16 + fr; const size_t off = (size_t)(u.pm * BM + r) * 1024 + col0;
#pragma unroll
                    for (int bj = 0; bj < 2; ++bj)
#pragma unroll
                        for (int n = 0; n < 2; ++n) *(f32x4*)(out + off + bj * HALF + n * 16) = acc[ai][bj][m][n]; }
        }
    }
};

template <class Epi, class Sched, bool ALIGN_EPI>
__device__ __forceinline__ void gemm_phase(PG8_LAS unsigned char* lds, const Gemm g, const Sched& S, const Epi& E, int tid0) {
    int tid_ = tid0; asm volatile("" : "+v"(tid_));
    const int tid = tid_, wid = __builtin_amdgcn_readfirstlane(tid >> 6), lane = tid & 63, wr = wid >> 2, wc = wid & 3, fr = lane & 15, fq = lane >> 4;
    const int K = g.K, nt = K / BK;
    unsigned voffA[2], voffB[2];
#pragma unroll
    for (int i = 0; i < 2; ++i) { int R, C; stage_rc(tid * 16 + i * 8192, R, C); const int Rb = Epi::PERM ? ((R & ~31) + perm32(R & 31)) : R;
        voffA[i] = (unsigned)(R * g.lda + C) * 2u; voffB[i] = (unsigned)(Rb * g.ldb + C) * 2u; }
    const size_t kstep = (size_t)(BK * 2);
    const size_t hstepA = (size_t)HALF * g.lda * 2, hstepB = (size_t)HALF * g.ldb * 2;
    const size_t tstepA = 2 * hstepA, tstepB = 2 * hstepB;
    const unsigned ldsw = (unsigned)wid * 1024u;
    const int aoff = lds_byte(wr * 64 + fr, fq * 8), boff = lds_byte(wc * 32 + fr, fq * 8);
#define PG8_SA(b, h) (((b) * 2 + (h)) * HTB)
#define PG8_SB(b, h) ((4 + (b) * 2 + (h)) * HTB)
#define PG8_STAGE(bufoff, gbase, voff) do { _Pragma("unroll") for (int _i = 0; _i < 2; ++_i) \
        __builtin_amdgcn_global_load_lds((const unsigned*)((const char*)(gbase) + (voff)[_i]), (PG8_LAS unsigned*)(lds + (bufoff) + ldsw + _i * 8192), 16, 0, 0); } while (0)
#define PG8_LDA(dst, b, h) do { _Pragma("unroll") for (int m = 0; m < 4; ++m) _Pragma("unroll") for (int k = 0; k < 2; ++k) dst[m][k] = *(const PG8_LAS bf16x8*)(lds + PG8_SA(b, h) + aoff + m * 2048 + k * 1024); } while (0)
#define PG8_LDB(dst, b, h) do { _Pragma("unroll") for (int n = 0; n < 2; ++n) _Pragma("unroll") for (int k = 0; k < 2; ++k) dst[n][k] = *(const PG8_LAS bf16x8*)(lds + PG8_SB(b, h) + boff + n * 2048 + k * 1024); } while (0)
#define PG8_MMA(ai, bj, At, Bt) do { __builtin_amdgcn_s_setprio(1); _Pragma("unroll") for (int m = 0; m < 4; ++m) _Pragma("unroll") for (int n = 0; n < 2; ++n) _Pragma("unroll") for (int k = 0; k < 2; ++k) \
        acc[ai][bj][m][n] = __builtin_amdgcn_mfma_f32_16x16x32_bf16(Bt[n][k], At[m][k], acc[ai][bj][m][n], 0, 0, 0); __builtin_amdgcn_s_setprio(0); } while (0)
#define PG8_WAIT_V(n) asm volatile("s_waitcnt vmcnt(" #n ")" ::: "memory")
#define PG8_WAIT_L(n) asm volatile("s_waitcnt lgkmcnt(" #n ")" ::: "memory")
#define PG8_BAR __builtin_amdgcn_s_barrier()
#define PG8_SCHED __builtin_amdgcn_sched_barrier(0)
    Unit cur, nxt; int ui = 0;
    if (!S.next(0, cur)) return;
    f32x4 acc[2][2][4][2];
#pragma unroll
    for (int a = 0; a < 2; ++a)
#pragma unroll
        for (int b = 0; b < 2; ++b)
#pragma unroll
            for (int m = 0; m < 4; ++m)
#pragma unroll
                for (int n = 0; n < 2; ++n) acc[a][b][m][n] = (f32x4){0.f, 0.f, 0.f, 0.f};
    bf16x8 At[4][2], B0[2][2], B1[2][2];
    const char* cA = (const char*)g.A + (size_t)cur.pm * tstepA + (size_t)(cur.pn >> 1) * (size_t)g.apn; const char* cB = (const char*)g.Bt + (size_t)cur.pn * tstepB;
    S.a_ready(cur);
    PG8_STAGE(PG8_SB(0, 0), cB, voffB); PG8_STAGE(PG8_SB(0, 1), cB + hstepB, voffB); PG8_STAGE(PG8_SA(0, 0), cA, voffA); PG8_STAGE(PG8_SA(0, 1), cA + hstepA, voffA);
    if (wr == 1) PG8_BAR;
    PG8_WAIT_V(2); PG8_BAR;
    PG8_STAGE(PG8_SB(1, 0), cB + kstep, voffB); PG8_STAGE(PG8_SA(1, 0), cA + kstep, voffA); PG8_STAGE(PG8_SB(1, 1), cB + hstepB + kstep, voffB);
    PG8_WAIT_V(6); PG8_BAR;
    for (;;) {
        const bool has_next = S.next(ui + 1, nxt);
        const char* nA = has_next ? (const char*)g.A + (size_t)nxt.pm * tstepA + (size_t)(nxt.pn >> 1) * (size_t)g.apn : cA; const char* nB = has_next ? (const char*)g.Bt + (size_t)nxt.pn * tstepB : cB;
        for (int t = 0; t < nt; t += 2) {
            const bool last = (t == nt - 2);
            const char* a1 = cA + (size_t)(t + 1) * kstep;
            const char* a2 = last ? nA : cA + (size_t)(t + 2) * kstep; const char* b2 = last ? nB : cB + (size_t)(t + 2) * kstep;
            const char* a3 = a2 + kstep; const char* b3 = b2 + kstep;
            if (last && has_next) S.a_ready(nxt);
            PG8_LDB(B0, 0, 0); PG8_LDB(B1, 0, 1); PG8_SCHED; PG8_LDA(At, 0, 0); PG8_STAGE(PG8_SA(1, 1), a1 + hstepA, voffA);
            PG8_WAIT_V(8); PG8_WAIT_L(0); PG8_BAR; PG8_MMA(0, 0, At, B0); PG8_MMA(0, 1, At, B1); PG8_BAR; PG8_SCHED;
            PG8_LDA(At, 0, 1); PG8_STAGE(PG8_SB(0, 0), b2, voffB); PG8_STAGE(PG8_SB(0, 1), b2 + hstepB, voffB); PG8_STAGE(PG8_SA(0, 0), a2, voffA);
            PG8_WAIT_V(8); PG8_WAIT_L(0); PG8_BAR; PG8_MMA(1, 0, At, B0); PG8_MMA(1, 1, At, B1); PG8_BAR; PG8_SCHED;
            PG8_LDB(B0, 1, 0); PG8_LDB(B1, 1, 1); PG8_SCHED; PG8_LDA(At, 1, 0); PG8_STAGE(PG8_SA(0, 1), a2 + hstepA, voffA);
            PG8_WAIT_V(8); PG8_WAIT_L(0); PG8_BAR; PG8_MMA(0, 0, At, B0); PG8_MMA(0, 1, At, B1); PG8_BAR; PG8_SCHED;
            PG8_LDA(At, 1, 1); PG8_STAGE(PG8_SB(1, 0), b3, voffB); PG8_STAGE(PG8_SB(1, 1), b3 + hstepB, voffB); PG8_STAGE(PG8_SA(1, 0), a3, voffA);
            PG8_WAIT_V(8); PG8_WAIT_L(0); PG8_BAR; PG8_MMA(1, 0, At, B0); PG8_MMA(1, 1, At, B1); PG8_BAR; PG8_SCHED;
        }
        if constexpr (ALIGN_EPI) { if (wr == 0) PG8_BAR; }
        if constexpr (Epi::FUSED) E.fused(acc, cur, wr, wc, fr, fq, wid, lane); else E(acc, cur, wr, wc, fr, fq);
        S.done(cur);
        if (!has_next) break;
#pragma unroll
        for (int a = 0; a < 2; ++a)
#pragma unroll
            for (int b = 0; b < 2; ++b)
#pragma unroll
                for (int m = 0; m < 4; ++m)
#pragma unroll
                    for (int n = 0; n < 2; ++n) acc[a][b][m][n] = (f32x4){0.f, 0.f, 0.f, 0.f};
        cur = nxt; cA = nA; cB = nB; ++ui;
        if constexpr (ALIGN_EPI) { if (wr == 1) PG8_BAR; }
    }
    PG8_WAIT_V(0);
    if constexpr (!ALIGN_EPI) { if (wr == 0) PG8_BAR; }
    PG8_BAR;
#undef PG8_SA
#undef PG8_SB
#undef PG8_STAGE
#undef PG8_LDA
#undef PG8_LDB
#undef PG8_MMA
#undef PG8_WAIT_V
#undef PG8_WAIT_L
#undef PG8_BAR
#undef PG8_SCHED
}
}
namespace att {
typedef unsigned short u16;
typedef short bf16x8 __attribute__((ext_vector_type(8)));
typedef short s16x4 __attribute__((ext_vector_type(4)));
typedef float f32x16 __attribute__((ext_vector_type(16)));
typedef float f32x4 __attribute__((ext_vector_type(4)));
typedef unsigned u32x4 __attribute__((ext_vector_type(4)));
constexpr int SEQ = 16384, NW = 8, QBLK = 32, KVBLK = 64, QB = NW * QBLK;
constexpr int LDQ = 1536, LDK = 2048, LDKR = 64, LDO = 1024;
#ifndef ATT_NQREG
#define ATT_NQREG 8
#endif
constexpr int NQREG = ATT_NQREG, NQREG_L = 8 - NQREG;
constexpr int SHM_V = KVBLK * 128 * 2, SHM_K = KVBLK * 128 * 2, SHM_KR = KVBLK * 64 * 2;
constexpr int OFF_V = 0, OFF_K = 2 * SHM_V, OFF_KR = OFF_K + 2 * SHM_K, OFF_WS = OFF_KR + 2 * SHM_KR, OFF_QR = OFF_WS + NW * 64 * 4, QR_WAVE = (NQREG_L + 4) * 1024, LDS_BYTES = OFF_QR + NW * QR_WAVE;
constexpr float SCALE = 0.07216878364870322f;
constexpr float THR = 8.f;

#define KSWZ(row, colB) ((row) * 256 + ((colB) ^ (((row) & 7) << 4)))
#define KRSWZ(row, colB) ((row) * 128 + ((colB) ^ (((row) & 7) << 4)))
#define SBAR() __builtin_amdgcn_sched_barrier(0)
__device__ __forceinline__ int v_st(int k, int c) { const int kk = (k & ~0xC) | ((k & 4) << 1) | ((k & 8) >> 1); return ((kk >> 3) * 4 + (c >> 5)) * 512 + ((kk & 7) * 32 + (c & 31)) * 2; }
__device__ __forceinline__ int v_rd_base(int lane) { return ((lane & 3) << 3) | (((lane >> 2) & 3) << 6) | (((lane >> 4) & 1) << 5) | (((lane >> 5) & 1) << 8); }
constexpr int v_rd_off(int d0, int ks, int half) { return d0 * 512 + ks * 4096 + half * 2048; }
__device__ __forceinline__ int crow(int r, int hi) { return (r & 3) + 8 * (r >> 2) + 4 * hi; }
__device__ __forceinline__ unsigned cvtpk(float lo, float hi) { unsigned r; asm volatile("v_cvt_pk_bf16_f32 %0, %1, %2" : "=v"(r) : "v"(lo), "v"(hi)); return r; }
__device__ __forceinline__ bf16x8 load8(const u16* p) { return *reinterpret_cast<const bf16x8*>(p); }
__device__ __forceinline__ void mask_tile(f32x16& p0, f32x16& p1, int dq, unsigned W) {
    const float NEG = -__builtin_inff();
#pragma unroll
    for (int r = 0; r < 16; ++r) {
        const int c = (r & 3) + 8 * (r >> 2);
        if ((unsigned)(dq - c) >= W) p0[r] = NEG;
        if ((unsigned)(dq - c - 32) >= W) p1[r] = NEG;
    }
}
__device__ __forceinline__ void partialSM(f32x16& p0, f32x16& p1, float& m_reg, float& mn, float& alpha) {
    float pmax = p0[0]; for (int r = 1; r < 16; ++r) pmax = fmaxf(pmax, p0[r]); for (int r = 0; r < 16; ++r) pmax = fmaxf(pmax, p1[r]);
    { auto rr = __builtin_amdgcn_permlane32_swap(__float_as_uint(pmax), __float_as_uint(pmax), false, false);
      pmax = fmaxf(__uint_as_float(rr[0]), __uint_as_float(rr[1])); }
    constexpr float C2 = 1.4426950408889634f * SCALE;
    if (__builtin_expect(__all((pmax - m_reg) * SCALE <= THR), 1)) { mn = m_reg; alpha = 1.f; }
    else { mn = fmaxf(m_reg, pmax); alpha = __builtin_amdgcn_exp2f((m_reg - mn) * C2); m_reg = mn; }
    const float mnL = -mn * C2;
    for (int r = 0; r < 16; ++r) p0[r] = fmaf(p0[r], C2, mnL); for (int r = 0; r < 16; ++r) p1[r] = fmaf(p1[r], C2, mnL);
    for (int r = 0; r < 16; ++r) p0[r] = __builtin_amdgcn_exp2f(p0[r]);
}
__device__ __forceinline__ void finishSM(f32x16& p0, f32x16& p1, float alpha, float& l_reg, bf16x8& pa0, bf16x8& pa1, bf16x8& pa2, bf16x8& pa3) {
    for (int r = 0; r < 16; ++r) p1[r] = __builtin_amdgcn_exp2f(p1[r]);
    float ps = 0; for (int r = 0; r < 16; ++r) ps += p0[r]; for (int r = 0; r < 16; ++r) ps += p1[r];
    { auto rr = __builtin_amdgcn_permlane32_swap(__float_as_uint(ps), __float_as_uint(ps), false, false);
      ps = __uint_as_float(rr[0]) + __uint_as_float(rr[1]); }
    l_reg = l_reg * alpha + ps;
#define PK4(P, B_, OUT) do { unsigned a0 = cvtpk(P[B_+0], P[B_+1]), a1 = cvtpk(P[B_+2], P[B_+3]);                          \
        unsigned b0 = cvtpk(P[B_+4], P[B_+5]), b1 = cvtpk(P[B_+6], P[B_+7]);                                             \
        auto r0 = __builtin_amdgcn_permlane32_swap(a0, b0, false, false); auto r1 = __builtin_amdgcn_permlane32_swap(a1, b1, false, false); \
        u32x4 w = {r0[0], r1[0], r0[1], r1[1]}; OUT = *reinterpret_cast<bf16x8*>(&w); } while (0)
    PK4(p0, 0, pa0); PK4(p0, 8, pa1); PK4(p1, 0, pa2); PK4(p1, 8, pa3);
#undef PK4
}
#ifndef ATT_PF
#define ATT_PF 2
#endif
#define QK_SB() __builtin_amdgcn_sched_barrier(0x406)
#define QK_LOAD(s, SET) do { if ((s) < 8) { const char* a_ = kb[(s) & 3] + ((s) >> 2) * 128; fb0[SET] = *reinterpret_cast<const bf16x8*>(a_); fb1[SET] = *reinterpret_cast<const bf16x8*>(a_ + 32 * 256); \
            if ((s) < NQREG) fq[SET] = qr[(s) < NQREG ? (s) : 0]; else fq[SET] = qrl[((s) - NQREG) * 64]; } \
        else { const char* a_ = krb[((s) - 8) & 3]; fb0[SET] = *reinterpret_cast<const bf16x8*>(a_); fb1[SET] = *reinterpret_cast<const bf16x8*>(a_ + 32 * 128); fq[SET] = qrl[(NQREG_L + (s) - 8) * 64]; } } while (0)
template <int KB>
__device__ __forceinline__ void qkt(f32x16& p0, f32x16& p1, const char* K_lds, const char* KR_lds, const bf16x8* qrl, int r32, int hi, const bf16x8* qr) {
    constexpr int PF = ATT_PF, NS = PF + 1;
    p0 = f32x16{}; p1 = f32x16{};
    const char* kb[4]; const char* krb[4];
#pragma unroll
    for (int dd = 0; dd < 4; ++dd) { kb[dd] = K_lds + KB * SHM_K + KSWZ(r32, (dd * 16 + hi * 8) * 2); krb[dd] = KR_lds + KB * SHM_KR + KRSWZ(r32, (dd * 16 + hi * 8) * 2); }
    bf16x8 fb0[NS], fb1[NS], fq[NS];
#pragma unroll
    for (int s = 0; s < PF; ++s) QK_LOAD(s, s % NS);
#pragma unroll
    for (int s = 0; s < 12; ++s) {
        QK_SB();
        if (s + PF < 12) QK_LOAD(s + PF, (s + PF) % NS);
        QK_SB();
        p0 = __builtin_amdgcn_mfma_f32_32x32x16_bf16(fb0[s % NS], fq[s % NS], p0, 0, 0, 0);
        p1 = __builtin_amdgcn_mfma_f32_32x32x16_bf16(fb1[s % NS], fq[s % NS], p1, 0, 0, 0);
    }
    QK_SB();
}
#undef QK_LOAD
template <int VB>
__device__ __forceinline__ void pv_tile(f32x16* o, int vb0, bf16x8 pa0, bf16x8 pa1, bf16x8 pa2, bf16x8 pa3) {
#define TRRD(dst, off) asm volatile("ds_read_b64_tr_b16 %0, %1 offset:%2" : "=&v"(dst) : "v"(vb0), "i"(off) : "memory")
#define PV_D0(d0) do { s16x4 l0, l1, l2, l3, h0, h1, h2, h3; constexpr int b_ = OFF_V + VB * SHM_V + v_rd_off(d0, 0, 0); \
        TRRD(l0, b_); TRRD(h0, b_ + 2048); TRRD(l1, b_ + 4096); TRRD(h1, b_ + 6144); TRRD(l2, b_ + 8192); TRRD(h2, b_ + 10240); TRRD(l3, b_ + 12288); TRRD(h3, b_ + 14336); \
        asm volatile("s_waitcnt lgkmcnt(0)" ::: "memory"); SBAR();   \
        o[d0] = __builtin_amdgcn_mfma_f32_32x32x16_bf16(pa0, (bf16x8){l0[0], l0[1], l0[2], l0[3], h0[0], h0[1], h0[2], h0[3]}, o[d0], 0, 0, 0);   \
        o[d0] = __builtin_amdgcn_mfma_f32_32x32x16_bf16(pa1, (bf16x8){l1[0], l1[1], l1[2], l1[3], h1[0], h1[1], h1[2], h1[3]}, o[d0], 0, 0, 0);   \
        o[d0] = __builtin_amdgcn_mfma_f32_32x32x16_bf16(pa2, (bf16x8){l2[0], l2[1], l2[2], l2[3], h2[0], h2[1], h2[2], h2[3]}, o[d0], 0, 0, 0);   \
        o[d0] = __builtin_amdgcn_mfma_f32_32x32x16_bf16(pa3, (bf16x8){l3[0], l3[1], l3[2], l3[3], h3[0], h3[1], h3[2], h3[3]}, o[d0], 0, 0, 0); } while (0)
    PV_D0(0); PV_D0(1); PV_D0(2); PV_D0(3);
}
template <int VB>
__device__ __forceinline__ void pv_tile_sm(f32x16* o, int vb0, bf16x8 pa0, bf16x8 pa1, bf16x8 pa2, bf16x8 pa3, f32x16& p0, f32x16& p1, float& m_reg, float& mn, float& alpha) {
    constexpr float C2 = 1.4426950408889634f * SCALE;
    PV_D0(0);
    float pmax = p0[0];
#pragma unroll
    for (int r = 1; r < 16; ++r) pmax = fmaxf(pmax, p0[r]);
#pragma unroll
    for (int r = 0; r < 16; ++r) pmax = fmaxf(pmax, p1[r]);
    PV_D0(1);
    { auto rr = __builtin_amdgcn_permlane32_swap(__float_as_uint(pmax), __float_as_uint(pmax), false, false);
      pmax = fmaxf(__uint_as_float(rr[0]), __uint_as_float(rr[1])); }
    const bool keep = __all((pmax - m_reg) * SCALE <= THR);
    mn = keep ? m_reg : fmaxf(m_reg, pmax);
    alpha = __builtin_amdgcn_exp2f((m_reg - mn) * C2);
    m_reg = mn;
    const float mnL = -mn * C2;
#pragma unroll
    for (int r = 0; r < 16; ++r) p0[r] = fmaf(p0[r], C2, mnL);
    PV_D0(2);
#pragma unroll
    for (int r = 0; r < 16; ++r) p1[r] = fmaf(p1[r], C2, mnL);
#pragma unroll
    for (int r = 0; r < 8; ++r) p0[r] = __builtin_amdgcn_exp2f(p0[r]);
    PV_D0(3);
#pragma unroll
    for (int r = 8; r < 16; ++r) p0[r] = __builtin_amdgcn_exp2f(p0[r]);
}
#undef PV_D0
#undef TRRD

struct BlockRef { const u16* Q; const u16* K; const u16* V; const u16* KR; u16* O; int P0; int row0; };
#define VMW() asm volatile("s_waitcnt vmcnt(0)" ::: "memory")
#define ATT_LAS __attribute__((address_space(3)))
#define KDMA(Kp, KRp, k0, bf) do { \
        __builtin_amdgcn_global_load_lds((const unsigned*)((Kp) + (size_t)((k0) + sr) * LDK + ksc), (ATT_LAS unsigned*)(ldsL + OFF_K + (bf) * SHM_K + wid * 1024), 16, 0, 0); \
        __builtin_amdgcn_global_load_lds((const unsigned*)((Kp) + (size_t)((k0) + 32 + sr) * LDK + ksc), (ATT_LAS unsigned*)(ldsL + OFF_K + (bf) * SHM_K + 8192 + wid * 1024), 16, 0, 0); \
        __builtin_amdgcn_global_load_lds((const unsigned*)((KRp) + (size_t)((k0) + krr) * LDKR + krsc), (ATT_LAS unsigned*)(ldsL + OFF_KR + (bf) * SHM_KR + wid * 1024), 16, 0, 0); } while (0)
#define VDMA(Vp, k0, bf) do { \
        __builtin_amdgcn_global_load_lds((const unsigned*)((Vp) + (size_t)((k0) + vk) * LDK + vc), (ATT_LAS unsigned*)(ldsL + OFF_V + (bf) * SHM_V + wid * 1024), 16, 0, 0); \
        __builtin_amdgcn_global_load_lds((const unsigned*)((Vp) + (size_t)((k0) + 32 + vk) * LDK + vc), (ATT_LAS unsigned*)(ldsL + OFF_V + (bf) * SHM_V + 8192 + wid * 1024), 16, 0, 0); } while (0)
#define ATT_MAPS() const int sr = tid >> 4, ksc = ((tid & 15) ^ (sr & 7)) * 8, krr = tid >> 3, krsc = ((tid & 7) ^ (krr & 7)) * 8; ATT_LAS unsigned char* ldsL = (ATT_LAS unsigned char*)lds; \
    const int vkk_ = ((tid >> 7) << 3) | ((tid >> 2) & 7), vk = (vkk_ & ~0xC) | ((vkk_ & 4) << 1) | ((vkk_ & 8) >> 1), vc = ((tid >> 5) & 3) * 32 + (tid & 3) * 8
__device__ __forceinline__ void attn_prime(const BlockRef& cur, char* lds, int tid0) {
    int tid_ = tid0; asm volatile("" : "+v"(tid_));
    const int tid = tid_, wid = __builtin_amdgcn_readfirstlane(tid >> 6);
    ATT_MAPS();
    KDMA(cur.K, cur.KR, 0, 0); VDMA(cur.V, 0, 0); VMW();
    __syncthreads();
}
__device__ __forceinline__ void attn_block(const BlockRef& cur, const BlockRef& nxt, char* lds, int tid0, const float* ctab, const float* stab) {
    int tid_ = tid0; asm volatile("" : "+v"(tid_));
    const int tid = tid_, wid = __builtin_amdgcn_readfirstlane(tid >> 6), lane = tid & 63, r32 = lane & 31, hi = lane >> 5;
    const unsigned W = 0x40000000u;
    const int NT = (cur.P0 + QB - 1) / KVBLK + 1;
    const int qlo = cur.P0 + wid * QBLK, qm = qlo + r32 - 4 * hi;
    char* K_lds = lds + OFF_K; char* KR_lds = lds + OFF_KR;
    float* ws = (float*)(lds + OFF_WS) + wid * 64; float* li_l = ws, * al_l = ws + 32;
    bf16x8* qrl = (bf16x8*)(lds + OFF_QR + wid * QR_WAVE) + lane;
    float m_reg = -1e30f, l_reg = 0; f32x16 o[4] = {};
    ATT_MAPS();
    const int vb0 = (int)(uintptr_t)lds + v_rd_base(lane);
    const u16* Kh = cur.K; const u16* Vh = cur.V; const u16* KRh = cur.KR;
#define RESC(a) do { if (__any((a) < 1.f)) { if (hi == 0) al_l[r32] = (a); asm volatile("s_waitcnt lgkmcnt(0)" ::: "memory");              \
                     for (int d_ = 0; d_ < 4; ++d_) for (int r = 0; r < 16; ++r) o[d_][r] *= al_l[crow(r, hi)]; } } while (0)
#define KBASE(t) ((t) * KVBLK)
#define MASKT(P0_, P1_, t) do { const int kb_ = KBASE(t); if (kb_ + KVBLK - 1 > qlo) mask_tile(P0_, P1_, qm - kb_, W); } while (0)
    f32x16 pA0, pA1, pB0, pB1; float mnA, mnB, alA, alB; bf16x8 pa0, pa1, pa2, pa3;
    bf16x8 qr[NQREG > 0 ? NQREG : 1];
    { const u16* qp = cur.Q + (size_t)(wid * QBLK + r32) * LDQ + hi * 8;
#pragma unroll
      for (int d = 0; d < NQREG_L; ++d) qrl[d * 64] = load8(qp + (NQREG + d) * 16);
      const size_t trow = (size_t)(cur.row0 + wid * QBLK + r32) * 32 + hi * 8;
#pragma unroll
      for (int pr = 0; pr < 2; ++pr) {
          const bf16x8 x1 = load8(qp + 128 + pr * 16), x2 = load8(qp + 128 + 32 + pr * 16);
          const f32x4 c0 = *(const f32x4*)(ctab + trow + pr * 16), c1 = *(const f32x4*)(ctab + trow + pr * 16 + 4), s0 = *(const f32x4*)(stab + trow + pr * 16), s1 = *(const f32x4*)(stab + trow + pr * 16 + 4);
          float o1[8], o2[8];
#pragma unroll
          for (int e = 0; e < 8; ++e) { const float a = __uint_as_float(((unsigned)(unsigned short)x1[e]) << 16), b = __uint_as_float(((unsigned)(unsigned short)x2[e]) << 16);
              const float cc = e < 4 ? c0[e & 3] : c1[e & 3], ss = e < 4 ? s0[e & 3] : s1[e & 3]; o1[e] = a * cc - b * ss; o2[e] = b * cc + a * ss; }
          u32x4 w1 = {cvtpk(o1[0], o1[1]), cvtpk(o1[2], o1[3]), cvtpk(o1[4], o1[5]), cvtpk(o1[6], o1[7])}, w2 = {cvtpk(o2[0], o2[1]), cvtpk(o2[2], o2[3]), cvtpk(o2[4], o2[5]), cvtpk(o2[6], o2[7])};
          qrl[(NQREG_L + pr) * 64] = *reinterpret_cast<bf16x8*>(&w1); qrl[(NQREG_L + 2 + pr) * 64] = *reinterpret_cast<bf16x8*>(&w2); }
#pragma unroll
      for (int d0 = 0; d0 < NQREG; ++d0) qr[d0] = load8(qp + d0 * 16); }
    SBAR();
    KDMA(Kh, KRh, KBASE(1), 1); VDMA(Vh, KBASE(1), 1);
    SBAR(); qkt<0>(pA0, pA1, K_lds, KR_lds, qrl, r32, hi, qr);
    MASKT(pA0, pA1, 0); partialSM(pA0, pA1, m_reg, mnA, alA);
    VMW(); __syncthreads();
    KDMA(Kh, KRh, KBASE(2), 0);
#define HALF_STEP(PX0, PX1, mnX, alX, PY0, PY1, alY, t, KB, VB) do {                                                          \
        SBAR(); qkt<KB>(PX0, PX1, K_lds, KR_lds, qrl, r32, hi, qr);                                                          \
        finishSM(PY0, PY1, alY, l_reg, pa0, pa1, pa2, pa3); SBAR();                                                           \
        MASKT(PX0, PX1, (t)); SBAR(); pv_tile_sm<VB>(o, vb0, pa0, pa1, pa2, pa3, PX0, PX1, m_reg, mnX, alX);                  \
        VMW(); __syncthreads();                                                                                               \
        if ((t) + 2 < NT) KDMA(Kh, KRh, KBASE((t) + 2), KB);                                                                  \
        if ((t) + 1 < NT) VDMA(Vh, KBASE((t) + 1), VB);                                                                       \
        SBAR(); RESC(alX); } while (0)
    for (int t = 1; t + 1 < NT; t += 2) {
        HALF_STEP(pB0, pB1, mnB, alB, pA0, pA1, alA, t, 1, 0);
        HALF_STEP(pA0, pA1, mnA, alA, pB0, pB1, alB, t + 1, 0, 1);
    }
    SBAR(); qkt<1>(pB0, pB1, K_lds, KR_lds, qrl, r32, hi, qr);
    finishSM(pA0, pA1, alA, l_reg, pa0, pa1, pa2, pa3); SBAR();
    MASKT(pB0, pB1, NT - 1); SBAR(); pv_tile_sm<0>(o, vb0, pa0, pa1, pa2, pa3, pB0, pB1, m_reg, mnB, alB);
    VMW(); __syncthreads();
    KDMA(nxt.K, nxt.KR, 0, 0); VDMA(nxt.V, 0, 0);
    SBAR(); RESC(alB);
    finishSM(pB0, pB1, alB, l_reg, pa0, pa1, pa2, pa3); SBAR(); pv_tile<1>(o, vb0, pa0, pa1, pa2, pa3);
    SBAR();
    if (hi == 0) li_l[r32] = l_reg; asm volatile("s_waitcnt lgkmcnt(0)" ::: "memory");
    float rli[16];
#pragma unroll
    for (int r = 0; r < 16; ++r) rli[r] = __builtin_amdgcn_rcpf(li_l[crow(r, hi)]);
    u16* Ow = cur.O + (size_t)(wid * QBLK) * LDO;
#pragma unroll
    for (int r = 0; r < 16; ++r) { const int orow = crow(r, hi);
#pragma unroll
        for (int d0 = 0; d0 < 4; ++d0) { const float v = o[d0][r] * rli[r];
            const float vn = xor1f(v);
            if ((r32 & 1) == 0) *(unsigned*)(Ow + (size_t)orow * LDO + d0 * 32 + r32) = cvtpk(v, vn); } }
    VMW(); __syncthreads();
#undef RESC
#undef KBASE
#undef MASKT
#undef HALF_STEP
}
struct Tensors { const u16* q; const u16* kv; const u16* kr; u16* o; const float* ctab; const float* stab; };
__device__ __forceinline__ BlockRef make_ref(const Tensors& T, int L, int pass) {
    const int bh = (L & 7) + 8 * (L >> 8), x = (L >> 3) & 31, b = bh >> 3, h = bh & 7, qb = pass ? 63 - x : x;
    BlockRef r; const size_t row0 = (size_t)b * SEQ;
    r.Q = T.q + (row0 + (size_t)qb * QB) * LDQ + h * 192; r.K = T.kv + row0 * LDK + h * 256; r.V = r.K + 128; r.KR = T.kr + row0 * LDKR;
    r.O = T.o + (row0 + (size_t)qb * QB) * LDO + h * 128; r.P0 = qb * QB; r.row0 = b * SEQ + qb * QB;
    return r;
}
__device__ __forceinline__ void attn_phase(char* lds, const Tensors& T, int tid0) {
    const int total = 512, stride = gridDim.x;
    int L = blockIdx.x; if (L >= total) return;
    int pass = 0;
    BlockRef cur = make_ref(T, L, 0);
    attn_prime(cur, lds, tid0);
    for (;;) {
        const bool more_pass = pass == 0, more_item = L + stride < total, last = !more_pass && !more_item;
        int passn = pass + 1, Ln = L;
        if (!more_pass) { passn = 0; Ln = more_item ? L + stride : L; }
        const BlockRef nxt = last ? cur : make_ref(T, Ln, passn);
        attn_block(cur, nxt, lds, tid0, T.ctab, T.stab);
        if (last) break;
        cur = nxt; pass = passn; L = Ln;
    }
}
#undef VMW
#undef KDMA
#undef VDMA
#undef ATT_MAPS
#undef SBAR
}
namespace xb {
#define LAS __attribute__((address_space(3)))
#define XB_TMO      128
#define XB_XCNT(j)  (256  + 64 * (j))
#define XB_XSUB(j)  (1280 + 64 * (j))
#define XB_XGEN(j)  (2304 + 64 * (j))
#define XB_TOP      3328
#define XB_TOPGEN   3392
#define XCD_BAR_WORDS 3456
#define XB_SPIN_CAP (1u << 18)

__device__ __forceinline__ unsigned xb_ld(unsigned* p)              { return __hip_atomic_load(p, __ATOMIC_RELAXED, __HIP_MEMORY_SCOPE_AGENT); }
__device__ __forceinline__ unsigned xb_add(unsigned* p, unsigned v) { return __hip_atomic_fetch_add(p, v, __ATOMIC_RELAXED, __HIP_MEMORY_SCOPE_AGENT); }
__device__ __forceinline__ unsigned xb_xcc_id() { return (unsigned)__builtin_amdgcn_s_getreg((3 << 11) | 20) & 0xFu; }
#define XB_SPIN(cond, bar) do { unsigned _sp = 0; while (cond) { __builtin_amdgcn_s_sleep(1); \
    if ((++_sp & 255u) == 0u) { if (xb_ld(&(bar)[XB_TMO])) break; if (_sp > XB_SPIN_CAP) { atomicAdd(&(bar)[XB_TMO], 1u); break; } } } } while (0)

struct XcdBarrier {
    unsigned* bar; unsigned x;
    volatile LAS unsigned* st;
};

__device__ __forceinline__ XcdBarrier xcd_barrier_post(unsigned* bar, volatile LAS unsigned* st) {
    XcdBarrier b; b.bar = bar; b.x = xb_xcc_id(); b.st = st;
    if (threadIdx.x == 0) (void)xb_add(&bar[XB_XCNT(b.x)], 1u);
    return b;
}
__device__ __forceinline__ void xcd_barrier_complete(unsigned* bar, unsigned x, unsigned& nloc, unsigned& nx) {
    const unsigned G = gridDim.x * gridDim.y * gridDim.z;
    unsigned sum, cnt, mine, sp = 0u;
    for (;;) {
        sum = 0u; cnt = 0u; mine = 0u;
#pragma unroll
        for (unsigned j = 0; j < 16; ++j) { const unsigned c = xb_ld(&bar[XB_XCNT(j)]); sum += c; cnt += (c > 0u) ? 1u : 0u; mine = (j == x) ? c : mine; }
        if (sum == G) break;
        __builtin_amdgcn_s_sleep(1);
        if ((++sp & 255u) == 0u) { if (xb_ld(&bar[XB_TMO])) break; if (sp > XB_SPIN_CAP) { atomicAdd(&bar[XB_TMO], 1u); break; } }
    }
    nloc = mine > 0u ? mine : 1u; nx = cnt > 0u ? cnt : 1u;
}

__device__ __forceinline__ void xcd_barrier(const XcdBarrier& b, bool t0  ) {
    asm volatile("s_waitcnt vmcnt(0)" ::: "memory");
    __syncthreads();
    if (t0) {
        unsigned* bar = b.bar;
        __builtin_amdgcn_s_waitcnt(0);
        unsigned nloc = b.st[0], nx = b.st[1];
        if (nloc == 0u) { xcd_barrier_complete(bar, b.x, nloc, nx); b.st[0] = nloc; b.st[1] = nx; }
        const unsigned old = xb_add(&bar[XB_XSUB(b.x)], 1u);
        const unsigned gen = old / nloc;
        if (old + 1u == (gen + 1u) * nloc) {
            __builtin_amdgcn_fence(__ATOMIC_RELEASE, "agent");
            asm volatile("s_waitcnt vmcnt(0)" ::: "memory");
            const unsigned og = xb_add(&bar[XB_TOP], 1u);
            const unsigned tg = og / nx;
            if (og + 1u == (tg + 1u) * nx) xb_add(&bar[XB_TOPGEN], 1u);
            else XB_SPIN(xb_ld(&bar[XB_TOPGEN]) == tg, bar);
            __builtin_amdgcn_fence(__ATOMIC_ACQUIRE, "agent");
            xb_add(&bar[XB_XGEN(b.x)], 1u);
            asm volatile("s_waitcnt vmcnt(0)" ::: "memory");
        } else {
            XB_SPIN(xb_ld(&bar[XB_XGEN(b.x)]) == gen, bar);
            __builtin_amdgcn_fence(__ATOMIC_ACQUIRE, "agent");
            asm volatile("s_waitcnt vmcnt(0)" ::: "memory");
        }
    }
    __syncthreads();
}
#undef LAS
}
#ifndef PROBE_ATT_REPS
#define PROBE_ATT_REPS 1
#endif
#ifndef PROBE_SYNC_REPS
#define PROBE_SYNC_REPS 1
#endif
#ifndef PROBE_THIN_REPS
#define PROBE_THIN_REPS 1
#endif
#ifndef PROBE_PRO_REPS
#define PROBE_PRO_REPS 1
#endif
#ifndef PROBE_GEMM_REPS
#define PROBE_GEMM_REPS 1
#endif
namespace mk {
typedef unsigned short u16;
typedef float f32x4 __attribute__((ext_vector_type(4)));
constexpr int M = 32768, D = 1024, SEQ = 16384;
constexpr float EPS = 1e-6f;
constexpr size_t MB = (size_t)1 << 20;
__host__ __device__ constexpr size_t WT_MLA(int j) { return (size_t)j * 6 * MB; }
__host__ __device__ constexpr size_t WT_LRU(int j) { return 12 * MB + (size_t)j * 8 * MB; }
__host__ __device__ constexpr size_t WT_FFN(int l) { return 28 * MB + (size_t)l * 16 * MB; }
constexpr size_t OFF_UQ = 3 * MB / 2, OFF_UKV = 11 * MB / 4, OFF_WO = 15 * MB / 4, OFF_GT = 4 * MB, OFF_LOUT = 5 * MB, OFF_DOWN = 8 * MB;
constexpr size_t WS_COS = 96 * MB, WS_SIN = 100 * MB, WS_SA = 104 * MB, WS_SB = 105 * MB;
constexpr size_t WS_HN = 112 * MB, WS_Y = 176 * MB, WS_U = 240 * MB, WS_END = 496 * MB;
constexpr size_t U_PROJ = 64 * MB, U_CQ = 112 * MB, U_CKV = 136 * MB, U_KR = 152 * MB, U_Q = 160 * MB, U_O = 64 * MB;
constexpr size_t U_GATE = 0, U_XC = 64 * MB, U_REC = 128 * MB, U_LA = 128 * MB, U_B = 192 * MB;
constexpr size_t WS_XSA = 108 * MB, WS_XSB = 109 * MB;
constexpr size_t WS_RS = 108 * MB;
constexpr int SCAN_L = 128, SCAN_NC = SEQ / SCAN_L;

__device__ __forceinline__ unsigned f2bf(float f) { unsigned u = __float_as_uint(f); return (u + 0x7fffu + ((u >> 16) & 1u)) >> 16; }
__device__ __forceinline__ unsigned pk2(float lo, float hi) { return f2bf(lo) | (f2bf(hi) << 16); }
__device__ __forceinline__ float bflo(unsigned w) { return __uint_as_float(w << 16); }
__device__ __forceinline__ float bfhi(unsigned w) { return __uint_as_float(w & 0xffff0000u); }
__device__ __forceinline__ float bf1(u16 h) { return __uint_as_float(((unsigned)h) << 16); }
__device__ __forceinline__ float wave_sum(float v) {
    v += xor1f(v); v += xor2f(v); v += xor4f(v); v += xor8f(v); v += xor16f(v);
    return sum32f(v);
}
__device__ __forceinline__ void transpose_item(const float* W, int ldw, u16* WT, int ldt, int nblk, float* scr, int item, int lane) {
    const int kb = item / nblk, nb = item % nblk, k0 = 64 * kb, n0 = 32 * nb;
#pragma unroll
    for (int i = 0; i < 8; ++i) { const int kk = 8 * i + (lane >> 3); const f32x4 v = *(const f32x4*)(W + (size_t)(k0 + kk) * ldw + n0 + (lane & 7) * 4);
        float* s = scr + kk * 33 + (lane & 7) * 4; s[0] = v.x; s[1] = v.y; s[2] = v.z; s[3] = v.w; }
    asm volatile("s_waitcnt lgkmcnt(0)" ::: "memory");
    const int c = lane & 7;
#pragma unroll
    for (int j = 0; j < 4; ++j) { const int n = (lane >> 3) + 8 * j; const float* s = scr + (8 * c) * 33 + n;
        uint4 o; o.x = pk2(s[0 * 33], s[1 * 33]); o.y = pk2(s[2 * 33], s[3 * 33]); o.z = pk2(s[4 * 33], s[5 * 33]); o.w = pk2(s[6 * 33], s[7 * 33]);
        *(uint4*)(WT + (size_t)(n0 + n) * ldt + k0 + 8 * c) = o; }
    asm volatile("s_waitcnt lgkmcnt(0)" ::: "memory");
}
struct Params { const float* in[23]; float* out; unsigned char* ws; };
enum { I_X = 0, I_POS, I_MIXPRE, I_MIXPOST, I_FFNPRE, I_FFNPOST, I_MLA_WIN, I_MLA_QN, I_MLA_KVN, I_MLA_WUQ, I_MLA_WUKV, I_MLA_WO,
       I_LRU_WIN, I_LRU_CW, I_LRU_CB, I_LRU_WA, I_LRU_BA, I_LRU_WX, I_LRU_BX, I_LRU_LAM, I_LRU_WOUT, I_FFN_UP, I_FFN_DOWN };

__device__ __forceinline__ void prologue_weights(const __attribute__((address_space(4))) Params& p, float* scr, int gw, int NGW, int lane) {
    u16* wt = (u16*)p.ws;
    constexpr int IT_MLA = 352 + 288 + 256 + 512, IT_LRU = 1024 + 128 + 512, IT_FFN = 4096, TOTAL = 2 * IT_MLA + 2 * IT_LRU + 4 * IT_FFN;
    for (int it = gw; it < TOTAL; it += NGW) {
        int r = it; const float* W; int ldw, ldt, nblk; u16* WT;
        if (r < 2 * IT_MLA) { const int j = r / IT_MLA; r -= j * IT_MLA; u16* base = wt + WT_MLA(j) / 2;
            if (r < 352) { W = p.in[I_MLA_WIN] + (size_t)j * 1024 * 704; ldw = 704; nblk = 22; WT = base; ldt = 1024; }
            else if (r < 640) { r -= 352; W = p.in[I_MLA_WUQ] + (size_t)j * 384 * 1536; ldw = 1536; nblk = 48; WT = base + OFF_UQ / 2; ldt = 384; }
            else if (r < 896) { r -= 640; W = p.in[I_MLA_WUKV] + (size_t)j * 256 * 2048; ldw = 2048; nblk = 64; WT = base + OFF_UKV / 2; ldt = 256; }
            else { r -= 896; W = p.in[I_MLA_WO] + (size_t)j * 1024 * 1024; ldw = 1024; nblk = 32; WT = base + OFF_WO / 2; ldt = 1024; }
        } else if (r < 2 * IT_MLA + 2 * IT_LRU) { r -= 2 * IT_MLA; const int j = r / IT_LRU; r -= j * IT_LRU; u16* base = wt + WT_LRU(j) / 2;
            if (r < 1024) { W = p.in[I_LRU_WIN] + (size_t)j * 1024 * 2048; ldw = 2048; nblk = 64; WT = base; ldt = 1024; }
            else if (r < 1152) { r -= 1024; const int which = r >> 3, gt = which >> 3, n = which & 7; r &= 7;
                W = p.in[gt ? I_LRU_WX : I_LRU_WA] + (size_t)j * 8 * 128 * 128 + (size_t)n * 128 * 128; ldw = 128; nblk = 4;
                WT = base + OFF_GT / 2 + (size_t)(n * 256 + gt * 128) * 256 + 128 * (n & 1); ldt = 256; }
            else { r -= 1152; W = p.in[I_LRU_WOUT] + (size_t)j * 1024 * 1024; ldw = 1024; nblk = 32; WT = base + OFF_LOUT / 2; ldt = 1024; }
        } else { r -= 2 * IT_MLA + 2 * IT_LRU; const int l = r / IT_FFN; r -= l * IT_FFN; u16* base = wt + WT_FFN(l) / 2;
            if (r < 2048) { W = p.in[I_FFN_UP] + (size_t)l * 1024 * 4096; ldw = 4096; nblk = 128; WT = base; ldt = 1024; }
            else { r -= 2048; W = p.in[I_FFN_DOWN] + (size_t)l * 4096 * 1024; ldw = 1024; nblk = 32; WT = base + OFF_DOWN / 2; ldt = 4096; }
        }
        transpose_item(W, ldw, WT, ldt, nblk, scr, r, lane);
    }
}
__device__ __forceinline__ void rowop(const u16* y, const float* xin, float* xout, u16* hn, float* rs, const float* gpost, const float* gpre, int gw, int NGW, int lane) {
    f32x4 gp[4], gq[4];
#pragma unroll
    for (int j = 0; j < 4; ++j) { gp[j] = gpost ? *(const f32x4*)(gpost + j * 256 + lane * 4) : (f32x4){0.f, 0.f, 0.f, 0.f}; gq[j] = gpre ? *(const f32x4*)(gpre + j * 256 + lane * 4) : (f32x4){0.f, 0.f, 0.f, 0.f}; }
    for (int row = gw; row < M; row += NGW) {
        f32x4 xv[4];
#pragma unroll
        for (int j = 0; j < 4; ++j) xv[j] = *(const f32x4*)(xin + (size_t)row * D + j * 256 + lane * 4);
        if (y) {
            f32x4 yv[4]; float ss = 0.f;
#pragma unroll
            for (int j = 0; j < 4; ++j) { const uint2 w = *(const uint2*)(y + (size_t)row * D + j * 256 + lane * 4);
                yv[j] = (f32x4){bflo(w.x), bfhi(w.x), bflo(w.y), bfhi(w.y)}; ss += (yv[j].x * yv[j].x + yv[j].y * yv[j].y) + (yv[j].z * yv[j].z + yv[j].w * yv[j].w); }
            const float r = rsqrtf(wave_sum(ss) * (1.f / D) + EPS);
#pragma unroll
            for (int j = 0; j < 4; ++j) xv[j] = xv[j] + (yv[j] * r) * gp[j];
        }
        if (xout) {
#pragma unroll
        for (int j = 0; j < 4; ++j) *(f32x4*)(xout + (size_t)row * D + j * 256 + lane * 4) = xv[j]; }
        if (gpre) {
            float s2 = 0.f;
#pragma unroll
            for (int j = 0; j < 4; ++j) s2 += (xv[j].x * xv[j].x + xv[j].y * xv[j].y) + (xv[j].z * xv[j].z + xv[j].w * xv[j].w);
            const float tot2 = wave_sum(s2); const float r2 = 1.0f;
            if (rs && lane < 4) rs[(size_t)row * 4 + lane] = lane == 0 ? tot2 : 0.f;
#pragma unroll
            for (int j = 0; j < 4; ++j) { const f32x4 h = (xv[j] * r2) * gq[j]; uint2 w; w.x = pk2(h.x, h.y); w.y = pk2(h.z, h.w);
                *(uint2*)(hn + (size_t)row * D + j * 256 + lane * 4) = w; }
        }
    }
}
__device__ __forceinline__ void qkvnorm(const u16* proj, u16* cq, u16* ckv, u16* kr, const float* qn, const float* kvn, const float* ctab, const float* stab, const float* rss, int gw, int NGW, int lane) {
    float gA[8], gB[8];
    { const float* gp = lane < 48 ? qn + 8 * lane : kvn + (8 * lane - 384); const f32x4 g0 = *(const f32x4*)gp, g1 = *(const f32x4*)(gp + 4);
      gA[0] = g0[0]; gA[1] = g0[1]; gA[2] = g0[2]; gA[3] = g0[3]; gA[4] = g1[0]; gA[5] = g1[1]; gA[6] = g1[2]; gA[7] = g1[3]; }
    { f32x4 g0 = {0.f, 0.f, 0.f, 0.f}, g1 = {0.f, 0.f, 0.f, 0.f}; if (lane < 16) { g0 = *(const f32x4*)(kvn + 128 + 8 * lane); g1 = *(const f32x4*)(kvn + 132 + 8 * lane); }
      gB[0] = g0[0]; gB[1] = g0[1]; gB[2] = g0[2]; gB[3] = g0[3]; gB[4] = g1[0]; gB[5] = g1[1]; gB[6] = g1[2]; gB[7] = g1[3]; }
    const bool ropeL = lane >= 16 && lane < 24; const int rk = (lane & 3) * 8;
    const int cOff = lane < 20 ? 672 + rk : 640 + rk;
    for (int row0 = gw; row0 < M; row0 += 2 * NGW) {
        float A[2][8], B[2][8], C[2][8], rsc[2], sa[2], sb[2];
#pragma unroll
        for (int q = 0; q < 2; ++q) { const int row = row0 + q * NGW; const u16* pr = proj + (size_t)row * 768;
            const f32x4 pp = *(const f32x4*)(rss + (size_t)row * 4); rsc[q] = rsqrtf(((pp[0] + pp[1]) + (pp[2] + pp[3])) * (1.f / D) + EPS);
            const uint4 a = *(const uint4*)(pr + 8 * lane); uint4 b = make_uint4(0u, 0u, 0u, 0u), c = make_uint4(0u, 0u, 0u, 0u);
            if (lane < 24) b = *(const uint4*)(pr + 512 + 8 * lane);
            if (ropeL) c = *(const uint4*)(pr + cOff);
            A[q][0] = bflo(a.x); A[q][1] = bfhi(a.x); A[q][2] = bflo(a.y); A[q][3] = bfhi(a.y); A[q][4] = bflo(a.z); A[q][5] = bfhi(a.z); A[q][6] = bflo(a.w); A[q][7] = bfhi(a.w);
            B[q][0] = bflo(b.x); B[q][1] = bfhi(b.x); B[q][2] = bflo(b.y); B[q][3] = bfhi(b.y); B[q][4] = bflo(b.z); B[q][5] = bfhi(b.z); B[q][6] = bflo(b.w); B[q][7] = bfhi(b.w);
            C[q][0] = bflo(c.x); C[q][1] = bfhi(c.x); C[q][2] = bflo(c.y); C[q][3] = bfhi(c.y); C[q][4] = bflo(c.z); C[q][5] = bfhi(c.z); C[q][6] = bflo(c.w); C[q][7] = bfhi(c.w); }
#pragma unroll
        for (int q = 0; q < 2; ++q) { sa[q] = 0.f; sb[q] = 0.f;
#pragma unroll
            for (int e = 0; e < 8; ++e) { A[q][e] *= rsc[q]; B[q][e] *= rsc[q]; C[q][e] *= rsc[q]; sa[q] += A[q][e] * A[q][e]; sb[q] += B[q][e] * B[q][e]; } }
        float r1[2], r2[2];
#pragma unroll
        for (int q = 0; q < 2; ++q) { const float s1 = wave_sum(lane < 48 ? sa[q] : 0.f), s2 = wave_sum((lane >= 48 ? sa[q] : 0.f) + (lane < 16 ? sb[q] : 0.f));
            r1[q] = rsqrtf(s1 * (1.f / 384.f) + EPS); r2[q] = rsqrtf(s2 * (1.f / 256.f) + EPS); }
#pragma unroll
        for (int q = 0; q < 2; ++q) { const int row = row0 + q * NGW;
            { const float r = lane < 48 ? r1[q] : r2[q]; uint4 o; o.x = pk2(A[q][0] * r * gA[0], A[q][1] * r * gA[1]); o.y = pk2(A[q][2] * r * gA[2], A[q][3] * r * gA[3]);
              o.z = pk2(A[q][4] * r * gA[4], A[q][5] * r * gA[5]); o.w = pk2(A[q][6] * r * gA[6], A[q][7] * r * gA[7]);
              if (lane < 48) *(uint4*)(cq + (size_t)row * 384 + 8 * lane) = o; else *(uint4*)(ckv + (size_t)row * 256 + (8 * lane - 384)) = o; }
            if (lane < 16) { const float r = r2[q]; uint4 o; o.x = pk2(B[q][0] * r * gB[0], B[q][1] * r * gB[1]); o.y = pk2(B[q][2] * r * gB[2], B[q][3] * r * gB[3]);
              o.z = pk2(B[q][4] * r * gB[4], B[q][5] * r * gB[5]); o.w = pk2(B[q][6] * r * gB[6], B[q][7] * r * gB[7]);
              *(uint4*)(ckv + (size_t)row * 256 + 128 + 8 * lane) = o; }
            if (ropeL) { const f32x4 c0 = *(const f32x4*)(ctab + (size_t)row * 32 + rk), c1 = *(const f32x4*)(ctab + (size_t)row * 32 + rk + 4), s0 = *(const f32x4*)(stab + (size_t)row * 32 + rk), s1 = *(const f32x4*)(stab + (size_t)row * 32 + rk + 4);
              float ov[8];
#pragma unroll
              for (int e = 0; e < 8; ++e) { const float cc = e < 4 ? c0[e & 3] : c1[e & 3], ss = e < 4 ? s0[e & 3] : s1[e & 3];
                  ov[e] = lane < 20 ? B[q][e] * cc - C[q][e] * ss
                                    : B[q][e] * cc + C[q][e] * ss; }
              uint4 o; o.x = pk2(ov[0], ov[1]); o.y = pk2(ov[2], ov[3]); o.z = pk2(ov[4], ov[5]); o.w = pk2(ov[6], ov[7]);
              *(uint4*)(kr + (size_t)row * 64 + (lane < 20 ? 0 : 32) + rk) = o; }
        }
    }
}
__device__ __forceinline__ void qrope(u16* q, const float* ctab, const float* stab, int gw, int NGW, int lane) {
    for (int row = gw; row < M; row += NGW) {
        u16* qr = q + (size_t)row * 1536; const int i = lane & 31;
        const float c = ctab[(size_t)row * 32 + i], s = stab[(size_t)row * 32 + i];
#pragma unroll
        for (int j = 0; j < 4; ++j) { const int h = 2 * j + (lane >> 5); u16* pp = qr + h * 192 + 128 + i;
            const float x1 = bf1(pp[0]), x2 = bf1(pp[32]);
            pp[0] = (u16)f2bf(x1 * c - x2 * s); pp[32] = (u16)f2bf(x2 * c + x1 * s); }
    }
}
__device__ __forceinline__ void conv_phase(const u16* rec, u16* xc, const float* cw, const float* cb, int gtid, int NGT) {
    for (int idx = gtid; idx < (M / 32) * 128; idx += NGT) {
        const int r0 = (idx >> 7) * 32, c0 = (idx & 127) * 8;
        float w[4][8], bias[8], win[3][8];
#pragma unroll
        for (int e = 0; e < 8; ++e) { bias[e] = cb[c0 + e];
#pragma unroll
            for (int k = 0; k < 4; ++k) w[k][e] = cw[k * D + c0 + e]; }
        const bool first = (r0 & (SEQ - 1)) == 0;
#pragma unroll
        for (int k = 0; k < 3; ++k) { uint4 v = make_uint4(0u, 0u, 0u, 0u); if (!first) v = *(const uint4*)(rec + (size_t)(r0 - 3 + k) * D + c0);
            win[k][0] = bflo(v.x); win[k][1] = bfhi(v.x); win[k][2] = bflo(v.y); win[k][3] = bfhi(v.y); win[k][4] = bflo(v.z); win[k][5] = bfhi(v.z); win[k][6] = bflo(v.w); win[k][7] = bfhi(v.w); }
        for (int i0 = 0; i0 < 32; i0 += 8) {
            uint4 in[8];
#pragma unroll
            for (int u = 0; u < 8; ++u) in[u] = *(const uint4*)(rec + (size_t)(r0 + i0 + u) * D + c0);
#pragma unroll
            for (int u = 0; u < 8; ++u) {
                const float x[8] = {bflo(in[u].x), bfhi(in[u].x), bflo(in[u].y), bfhi(in[u].y), bflo(in[u].z), bfhi(in[u].z), bflo(in[u].w), bfhi(in[u].w)};
                float acc[8];
#pragma unroll
                for (int e = 0; e < 8; ++e) { acc[e] = bias[e] + win[0][e] * w[0][e] + win[1][e] * w[1][e] + win[2][e] * w[2][e] + x[e] * w[3][e]; win[0][e] = win[1][e]; win[1][e] = win[2][e]; win[2][e] = x[e]; }
                uint4 o; o.x = pk2(acc[0], acc[1]); o.y = pk2(acc[2], acc[3]); o.z = pk2(acc[4], acc[5]); o.w = pk2(acc[6], acc[7]);
                *(uint4*)(xc + (size_t)(r0 + i0 + u) * D + c0) = o;
            }
        }
    }
}
__device__ __forceinline__ void scanA(const u16* A, const u16* B, float* SA, float* SB, int tid) {
    for (int item = blockIdx.x; item < 2 * SCAN_NC; item += gridDim.x) {
        const int c = item % SCAN_NC, b = item / SCAN_NC, ch = 2 * tid;
        const size_t base = ((size_t)b * SEQ + (size_t)c * SCAN_L) * D + ch;
        float h0 = 0.f, h1 = 0.f, P0 = 1.f, P1 = 1.f;
        for (int t0 = 0; t0 < SCAN_L; t0 += 32) {
            unsigned aw[32], bw[32];
#pragma unroll
            for (int u = 0; u < 32; ++u) { aw[u] = *(const unsigned*)(A + base + (size_t)(t0 + u) * D); bw[u] = *(const unsigned*)(B + base + (size_t)(t0 + u) * D); }
#pragma unroll
            for (int u = 0; u < 32; ++u) { const float a0 = __expf(bflo(aw[u])), a1 = __expf(bfhi(aw[u])); h0 = a0 * h0 + bflo(bw[u]); h1 = a1 * h1 + bfhi(bw[u]); P0 *= a0; P1 *= a1; }
        }
        const size_t so = ((size_t)b * SCAN_NC + c) * D + ch;
        *(float2*)(SA + so) = make_float2(P0, P1); *(float2*)(SB + so) = make_float2(h0, h1);
    }
}
__device__ __forceinline__ void scanC(const u16* A, const u16* B, const float* SA, const float* SB, const u16* gate, u16* hg, int tid) {
    for (int item = blockIdx.x; item < 2 * SCAN_NC; item += gridDim.x) {
        const int c = item % SCAN_NC, b = item / SCAN_NC, ch = 2 * tid;
        const size_t base = ((size_t)b * SEQ + (size_t)c * SCAN_L) * D + ch;
        float h0 = 0.f, h1 = 0.f;
        for (int cc0 = 0; cc0 < c; cc0 += 16) {
            float2 pa[16], pb[16];
#pragma unroll
            for (int u = 0; u < 16; ++u) { const int cc = cc0 + u < c ? cc0 + u : c - 1; const size_t so = ((size_t)b * SCAN_NC + cc) * D + ch; pa[u] = *(const float2*)(SA + so); pb[u] = *(const float2*)(SB + so); }
#pragma unroll
            for (int u = 0; u < 16; ++u) { const bool in = cc0 + u < c; const float ax = in ? pa[u].x : 1.f, ay = in ? pa[u].y : 1.f, bx = in ? pb[u].x : 0.f, by = in ? pb[u].y : 0.f; h0 = ax * h0 + bx; h1 = ay * h1 + by; }
        }
        for (int t0 = 0; t0 < SCAN_L; t0 += 16) {
            unsigned aw[16], bw[16], gv[16];
#pragma unroll
            for (int u = 0; u < 16; ++u) { aw[u] = *(const unsigned*)(A + base + (size_t)(t0 + u) * D); bw[u] = *(const unsigned*)(B + base + (size_t)(t0 + u) * D); gv[u] = *(const unsigned*)(gate + base + (size_t)(t0 + u) * D); }
#pragma unroll
            for (int u = 0; u < 16; ++u) { h0 = __expf(bflo(aw[u])) * h0 + bflo(bw[u]); h1 = __expf(bfhi(aw[u])) * h1 + bfhi(bw[u]);
                *(unsigned*)(hg + base + (size_t)(t0 + u) * D) = pk2(bflo(gv[u]) * h0, bfhi(gv[u]) * h1); }
        }
    }
}

constexpr int LDS_GEMM = pg8::STAGE_BYTES + 8192, LDS_MAIN = att::LDS_BYTES > LDS_GEMM ? att::LDS_BYTES : LDS_GEMM, LDS_BYTES = LDS_MAIN + 16;
constexpr size_t WS_BAR = 106 * MB;
constexpr size_t WS_CNT1 = WS_BAR + 16384, WS_CNT2 = WS_BAR + 49152, CTL_BYTES = 81920, WS_XS1 = 107 * MB, WS_XS2 = 107 * MB + MB / 2;
constexpr int XL_OFF = 131072;
static_assert(XL_OFF + 8192 <= LDS_MAIN && XCD_BAR_WORDS * 4 <= 16384 && att::LDS_BYTES <= LDS_MAIN && pg8::STAGE_BYTES <= LDS_MAIN && LDS_BYTES <= 160 * 1024, "LDS map");

__global__ void __launch_bounds__(512, 2) fwd_mega(Params p_arg) {
    extern __shared__ __attribute__((aligned(16))) unsigned char lds[];
    cg::grid_group grid = cg::this_grid();
    (void)p_arg;
    volatile __attribute__((address_space(3))) unsigned* bst = (volatile __attribute__((address_space(3))) unsigned*)((__attribute__((address_space(3))) unsigned char*)lds + LDS_MAIN);
    if (threadIdx.x < 4) bst[threadIdx.x] = 0u;
    __syncthreads();
    const int wave_s = __builtin_amdgcn_readfirstlane(threadIdx.x >> 6);
    const unsigned bar_x = xb::xb_xcc_id();
    (void)xb::xcd_barrier_post((unsigned*)(p_arg.ws + WS_BAR), bst);
#define GRID_BAR() do { unsigned bx_ = bar_x; asm volatile("" : "+s"(bx_)); xb::XcdBarrier bb_; bb_.bar = (unsigned*)(ws + WS_BAR); bb_.x = bx_; bb_.st = bst; xb::xcd_barrier(bb_, tid == 0); } while (0)
    typedef const __attribute__((address_space(4))) Params* KParams;
    KParams pp = (KParams)__builtin_amdgcn_kernarg_segment_ptr();
#define FRESH() int tid_ = wave_s * 64 + lane_id_fresh(); asm volatile("" : "+v"(tid_)); asm volatile("" : "+s"(pp)); const __attribute__((address_space(4))) Params& p = *pp; \
    const int tid = tid_, lane = tid & 63, wave = __builtin_amdgcn_readfirstlane(tid >> 6); \
    const int G = gridDim.x, gw = blockIdx.x * 8 + wave, NGW = G * 8, gtid = blockIdx.x * 512 + tid, NGT = G * 512; \
    unsigned char* ws = p.ws; float* x = p.out; u16* hn = (u16*)(ws + WS_HN); u16* ybuf = (u16*)(ws + WS_Y); unsigned char* U = ws + WS_U; \
    float* ctab = (float*)(ws + WS_COS); float* stab = (float*)(ws + WS_SIN); float* SA = (float*)(ws + WS_SA); float* SB = (float*)(ws + WS_SB); \
    (void)lane; (void)wave; (void)gw; (void)NGW; (void)gtid; (void)NGT; (void)x; (void)hn; (void)ybuf; (void)U; (void)ctab; (void)stab; (void)SA; (void)SB;
    {
    FRESH();

    for (int prep = 0; prep < PROBE_PRO_REPS; ++prep) {
    prologue_weights(p, (float*)lds + wave * (64 * 33), gw, NGW, lane);
    for (int i = gtid; i < 2 * 2048 * 16; i += NGT) { const int j = i >> 15, row = (i >> 4) & 2047, chn = i & 15, n = row >> 8;
        *(uint4*)((u16*)(ws + WT_LRU(j) + OFF_GT) + (size_t)row * 256 + 128 * ((n & 1) ^ 1) + chn * 8) = make_uint4(0u, 0u, 0u, 0u); }
    { const int* pos = (const int*)p.in[I_POS];
      for (int i = gtid; i < M * 32; i += NGT) { const int row = i >> 5, f = i & 31;
        const float inv = __builtin_amdgcn_exp2f(-(float)f * (13.287712379549449f / 32.f));
        const float ang = (float)pos[row] * inv;
        double rev = (double)ang * 0.15915494309189535; rev -= __builtin_rint(rev);
        ctab[i] = __builtin_amdgcn_cosf((float)rev); stab[i] = __builtin_amdgcn_sinf((float)rev); } }
    rowop(nullptr, p.in[I_X], nullptr, hn, (float*)(ws + WS_XSB), nullptr, p.in[I_MIXPRE], gw, NGW, lane);
    }
    if (ws == nullptr) grid.sync();
    GRID_BAR();
    }

#pragma nounroll
    for (int layer = 0; layer < 4; ++layer) {
#pragma nounroll
        for (int op = 0; op < 10; ++op) {
            FRESH();
            const int j = layer >> 1; const bool lru = (layer & 1) != 0;
            const u16* wtm = (const u16*)(ws + WT_MLA(j)); const u16* wtl = (const u16*)(ws + WT_LRU(j)); const u16* wtf = (const u16*)(ws + WT_FFN(layer));
            int gk = 0;
            pg8::Gemm g{}; pg8::EpiB E{};
            if (op == 6 || op == 9) continue;
            const float* gprev = p.in[op == 5 ? I_MIXPRE : I_FFNPRE] + layer * D;
            const float* gpost = p.in[op == 5 ? I_MIXPOST : I_FFNPOST] + layer * D;
            const float* gpre = op == 5 ? p.in[I_FFNPRE] + layer * D : (layer < 3 ? p.in[I_MIXPRE] + (layer + 1) * D : nullptr);
            if (op == 7) { gk = 1; g = pg8::Gemm{hn, wtf, M, 4096, 1024, 1024, 1024, 0}; E = pg8::EpiB{(u16*)U, 4096, 0, 0, 1, nullptr}; }
            else if (op == 8) { gk = 3; g = pg8::Gemm{(const u16*)U, wtf + OFF_DOWN / 2, M, 1024, 4096, 4096, 4096, 0}; }
            else if (!lru) {
                u16* proj = (u16*)(U + U_PROJ); u16* cq = (u16*)(U + U_CQ); u16* ckv = (u16*)(U + U_CKV); u16* kr = (u16*)(U + U_KR); u16* q = (u16*)(U + U_Q); u16* o = (u16*)(U + U_O); u16* kv = ybuf;
                if (op == 0) { gk = 1; g = pg8::Gemm{hn, wtm, M, 768, 1024, 1024, 1024, 0}; E = pg8::EpiB{proj, 768, 0, 0, 0, nullptr}; }
                else if (op == 1) for (int rep = 0; rep < PROBE_THIN_REPS; ++rep) qkvnorm(proj, cq, ckv, kr, p.in[I_MLA_QN] + j * 384, p.in[I_MLA_KVN] + j * 256, ctab, stab, (const float*)(ws + WS_XSB), gw, NGW, lane);
                else if (op == 2) { gk = 1; g = pg8::Gemm{cq, wtm + OFF_UQ / 2, M, 1536, 384, 384, 384, 0}; E = pg8::EpiB{q, 1536, 0, 0, 0, nullptr}; }
                else if (op == 3) { gk = 1; g = pg8::Gemm{ckv, wtm + OFF_UKV / 2, M, 2048, 256, 256, 256, 0}; E = pg8::EpiB{kv, 2048, 0, 0, 0, nullptr}; }
                else if (op == 4) { const att::Tensors T{q, kv, kr, o, ctab, stab}; for (int rep = 0; rep < PROBE_ATT_REPS; ++rep) att::attn_phase((char*)lds, T, tid); }
                else { gk = 3; g = pg8::Gemm{o, wtm + OFF_WO / 2, M, 1024, 1024, 1024, 1024, 0}; }
            } else {
                u16* gate = (u16*)(U + U_GATE); u16* xc = (u16*)(U + U_XC); u16* rec = (u16*)(U + U_REC); u16* Bb = (u16*)(U + U_B); u16* Ab = (u16*)(U + U_LA); u16* hg = xc;
                if (op == 0) { gk = 1; g = pg8::Gemm{hn, wtl, M, 2048, 1024, 1024, 1024, 0}; E = pg8::EpiB{gate, 1024, 1024, (size_t)(U_REC - U_GATE) / 2, 2, (const float*)(ws + WS_XSB)}; }
                else if (op == 1) for (int rep = 0; rep < PROBE_THIN_REPS; ++rep) conv_phase(rec, xc, p.in[I_LRU_CW] + j * 4 * D, p.in[I_LRU_CB] + j * D, gtid, NGT);
                else if (op == 2) { gk = 2; g = pg8::Gemm{xc, wtl + OFF_GT / 2, M, 2048, 256, 1024, 256, 512}; }
                else if (op == 3) for (int rep = 0; rep < PROBE_THIN_REPS; ++rep) scanA(Ab, Bb, SA, SB, tid);
                else if (op == 4) for (int rep = 0; rep < PROBE_THIN_REPS; ++rep) scanC(Ab, Bb, SA, SB, gate, hg, tid);
                else { gk = 3; g = pg8::Gemm{hg, wtl + OFF_LOUT / 2, M, 1024, 1024, 1024, 1024, 0}; }
            }
            for (int rep = 0; rep < PROBE_GEMM_REPS; ++rep)
            if (gk == 1) { pg8::StaticOrder S; S.init(g.M, g.N, G, (int)blockIdx.x);
                pg8::gemm_phase<pg8::EpiB, pg8::StaticOrder, true>((PG8_LAS unsigned char*)lds, g, S, E, tid); }
            else if (gk == 2) { pg8::StaticOrder S; S.init(g.M, g.N, G, (int)blockIdx.x);
                const pg8::EpiGate EG{(const u16*)(U + U_XC), (u16*)(U + U_LA), (u16*)(U + U_B), p.in[I_LRU_BA] + j * D, p.in[I_LRU_BX] + j * D, p.in[I_LRU_LAM] + j * D};
                pg8::gemm_phase<pg8::EpiGate, pg8::StaticOrder, true>((PG8_LAS unsigned char*)lds, g, S, EG, tid); }
            else if (gk == 3) { pg8::StaticOrder S; S.init(g.M, g.N, G, (int)blockIdx.x);
                const unsigned target = 32u * (unsigned)(layer * 2 + (op == 8 ? 2 : 1));
                const pg8::RowStats st1{(float*)(ws + WS_XS1), (unsigned*)(ws + WS_CNT1), target};
                const pg8::EpiNormRes EN{hn, (float*)(ws + (op == 8 ? WS_XSB : WS_XSA)), x, gprev, gpost, gpre, st1, (PG8_LAS unsigned char*)lds + XL_OFF, op == 8 ? (const float*)(ws + WS_XSA) : nullptr};
                pg8::gemm_phase<pg8::EpiNormRes, pg8::StaticOrder, true>((PG8_LAS unsigned char*)lds, g, S, EN, tid); }
            if (!(layer == 3 && op == 8) && !(!lru && op == 2)) { for (int rep = 0; rep < PROBE_SYNC_REPS; ++rep) GRID_BAR(); }
        }
    }
}
}

extern "C" void kernel_launch(void* const* d_in, const int* in_sizes, int n_in, void* d_out, int out_size, void* d_ws, size_t ws_size, hipStream_t stream) {
    static int grid = 0;
    if (grid == 0) {
        if (n_in != 23 || in_sizes[0] != mk::M * mk::D || out_size != mk::M * mk::D || ws_size < mk::WS_END) {
            fprintf(stderr, "kernel_launch: unexpected shapes (n_in %d, in0 %d, out %d, ws %zu); nothing launched\n", n_in, n_in > 0 ? in_sizes[0] : -1, out_size, ws_size); grid = -1; return; }
        int dev = 0, cus = 0, per_cu = 0;
        (void)hipGetDevice(&dev); (void)hipDeviceGetAttribute(&cus, hipDeviceAttributeMultiprocessorCount, dev);
        if (hipFuncSetAttribute((const void*)mk::fwd_mega, hipFuncAttributeMaxDynamicSharedMemorySize, mk::LDS_BYTES) != hipSuccess) { fprintf(stderr, "kernel_launch: hipFuncSetAttribute failed\n"); grid = -1; return; }
        if (hipOccupancyMaxActiveBlocksPerMultiprocessor(&per_cu, (const void*)mk::fwd_mega, 512, mk::LDS_BYTES) != hipSuccess || per_cu < 1) { fprintf(stderr, "kernel_launch: occupancy query says %d blocks per CU\n", per_cu); per_cu = 1; }
        (void)hipGetLastError();
        grid = cus > 0 ? cus : 256;
    }
    if (grid < 0) return;
    mk::Params p{};
    for (int i = 0; i < 23; ++i) p.in[i] = (const float*)d_in[i];
    p.out = (float*)d_out; p.ws = (unsigned char*)d_ws;
    if (hipMemsetAsync((char*)d_ws + mk::WS_BAR, 0, mk::CTL_BYTES, stream) != hipSuccess) { fprintf(stderr, "kernel_launch: hipMemsetAsync failed\n"); return; }
    void* args[] = {&p};
    hipError_t e = hipLaunchCooperativeKernel((const void*)mk::fwd_mega, dim3(grid), dim3(512), args, mk::LDS_BYTES, stream);
    if (e != hipSuccess) fprintf(stderr, "kernel_launch: cooperative launch failed: %s (grid %d)\n", hipGetErrorString(e), grid);
}
```

```cpp
#include <hip/hip_runtime.h>
#include <hip/hip_bf16.h>
#include <hip/hip_cooperative_groups.h>
#include <cstdio>
#include <cstdint>
namespace cg = cooperative_groups;

__device__ __forceinline__ float xor1f(float v)  { return __int_as_float(__builtin_amdgcn_mov_dpp(__float_as_int(v), 0xB1, 0xF, 0xF, false)); }
__device__ __forceinline__ float xor2f(float v)  { return __int_as_float(__builtin_amdgcn_mov_dpp(__float_as_int(v), 0x4E, 0xF, 0xF, false)); }
__device__ __forceinline__ float xor4f(float v)  { return __int_as_float(__builtin_amdgcn_ds_swizzle(__float_as_int(v), 0x101F)); }
__device__ __forceinline__ float xor8f(float v)  { return __int_as_float(__builtin_amdgcn_ds_swizzle(__float_as_int(v), 0x201F)); }
__device__ __forceinline__ float xor16f(float v) { return __int_as_float(__builtin_amdgcn_ds_swizzle(__float_as_int(v), 0x401F)); }
__device__ __forceinline__ float sum32f(float v) { auto rr = __builtin_amdgcn_permlane32_swap(__float_as_uint(v), __float_as_uint(v), false, false); return __uint_as_float(rr[0]) + __uint_as_float(rr[1]); }
__device__ __forceinline__ int lane_id_fresh() { int l; asm volatile("v_mbcnt_lo_u32_b32 %0, -1, 0\n\tv_mbcnt_hi_u32_b32 %0, -1, %0" : "=v"(l)); return l; }
namespace pg8 {
#define PG8_LAS __attribute__((address_space(3)))
typedef unsigned short bf16_t;
typedef short bf16x8 __attribute__((ext_vector_type(8)));
typedef float f32x4 __attribute__((ext_vector_type(4)));
typedef unsigned u32x4 __attribute__((ext_vector_type(4)));
constexpr int BM = 256, BK = 64, HALF = 128, HTB = HALF * BK * 2  , STAGE_BYTES = 8 * HTB, NXCD = 8, WGM = 8;

__host__ __device__ __forceinline__ int lds_byte(int r, int c) { const int st = (r >> 4) * 2 + (c >> 5), rr = r & 15, cc = c & 31, ob = rr * 64 + cc * 2; return st * 1024 + (ob ^ (((ob >> 9) & 1) << 5)); }
__host__ __device__ __forceinline__ void stage_rc(int b, int& R, int& C) { const int st = b / 1024, sb = b % 1024, swz = sb ^ (((sb >> 9) & 1) << 5); R = (st >> 1) * 16 + swz / 64; C = (st & 1) * 32 + (swz % 64) / 2; }
__host__ __device__ __forceinline__ int perm32(int rho) { const int n = rho >> 4, i = rho & 15; return 8 * (i >> 2) + 4 * n + (i & 3); }

struct Unit { int pm, pn; };
struct Gemm { const bf16_t* A; const bf16_t* Bt; int M, N, K; int lda, ldb; int apn; };

struct StaticOrder {
    int nM, nN, nwg, G, c;
    __host__ __device__ void init(int M, int N, int G_, int c_) { nM = M / BM; nN = N / BM; nwg = nM * nN; G = G_; c = c_; }
    __host__ __device__ bool next(int i, Unit& u) const {
        const long L = (long)i * G + c; if (L >= nwg) return false;
        int wgid = (int)L; { const int q = nwg / NXCD, r = nwg % NXCD, xcd = wgid % NXCD, off = wgid / NXCD; wgid = (xcd < r ? xcd * (q + 1) : r * (q + 1) + (xcd - r) * q) + off; }
        const int nig = WGM * nN, gid = wgid / nig, fm = gid * WGM, gsz = (nM - fm) < WGM ? (nM - fm) : WGM;
        u.pm = fm + ((wgid % nig) % gsz); u.pn = (wgid % nig) / gsz; return true;
    }
    __device__ __forceinline__ void a_ready(const Unit&) const {}
    __device__ __forceinline__ void done(const Unit&) const {}
};

__device__ __forceinline__ unsigned cvt_pk_bf16(float lo, float hi) { unsigned r; asm volatile("v_cvt_pk_bf16_f32 %0, %1, %2" : "=v"(r) : "v"(lo), "v"(hi)); return r; }
__device__ __forceinline__ float gelu_tanh(float x) {
    const float z = 0.7978845608028654f * (x + 0.044715f * x * x * x);
    const float e = __expf(2.0f * z);
    const float th = 1.0f - 2.0f * __builtin_amdgcn_rcpf(1.0f + e);
    return 0.5f * x * (1.0f + th);
}
struct EpiB {
    static constexpr bool PERM = true, AFTER_DRAIN = false, FUSED = false;
    bf16_t* O; int ldc; int split_cols; size_t split_stride; int mode;
    const float* rss;
    __device__ __forceinline__ void operator()(const f32x4 (&acc)[2][2][4][2], const Unit& u, int wr, int wc, int fr, int fq) const {
        const int row0 = u.pm * BM + wr * 64 + fr; int colt = u.pn * BM; bf16_t* base = O; int t = 0;
        if (split_cols) { t = colt / split_cols; base += (size_t)t * split_stride; colt -= t * split_cols; }
        const int act = (mode == 1) ? 1 : ((mode == 2 && t == 0) ? 2 : 0);
        const int col0 = colt + wc * 32 + 8 * fq;
#pragma unroll
        for (int ai = 0; ai < 2; ++ai)
#pragma unroll
            for (int m = 0; m < 4; ++m) { bf16_t* rowp = base + (size_t)(row0 + ai * HALF + m * 16) * ldc + col0;
                float rsc = 1.0f; if (rss) { const f32x4 pp = *(const f32x4*)(rss + (size_t)(row0 + ai * HALF + m * 16) * 4); rsc = rsqrtf(((pp[0] + pp[1]) + (pp[2] + pp[3])) * (1.0f / 1024.0f) + 1e-6f); }
#pragma unroll
                for (int bj = 0; bj < 2; ++bj) { f32x4 v0 = acc[ai][bj][m][0] * rsc, v1 = acc[ai][bj][m][1] * rsc;
                    if (act == 1) {
#pragma unroll
                        for (int e = 0; e < 4; ++e) { const float a = fmaxf(v0[e], 0.f), b = fmaxf(v1[e], 0.f); v0[e] = a * a; v1[e] = b * b; } }
                    else if (act == 2) {
#pragma unroll
                        for (int e = 0; e < 4; ++e) { v0[e] = gelu_tanh(v0[e]); v1[e] = gelu_tanh(v1[e]); } }
                    u32x4 w; w.x = cvt_pk_bf16(v0[0], v0[1]); w.y = cvt_pk_bf16(v0[2], v0[3]); w.z = cvt_pk_bf16(v1[0], v1[1]); w.w = cvt_pk_bf16(v1[2], v1[3]);
                    *(u32x4*)(rowp + bj * HALF) = w; } }
    }
};
__device__ __forceinline__ float bf2f(unsigned short h) { return __uint_as_float(((unsigned)h) << 16); }
__device__ __forceinline__ float sigmoidf_(float x) { return __builtin_amdgcn_rcpf(1.0f + __expf(-x)); }
__device__ __forceinline__ float one_minus_exp(float t) { const float ser = -t * (1.0f + t * (0.5f + t * (0.16666667f + t * (0.041666668f + t * 0.008333334f)))); return t > -0.25f ? ser : 1.0f - __expf(t); }
struct EpiGate {
    static constexpr bool PERM = false, AFTER_DRAIN = false, FUSED = false;
    const bf16_t* xc; bf16_t* Aout; bf16_t* Bout; const float* b_a; const float* b_x; const float* lam;
    __device__ __forceinline__ void operator()(const f32x4 (&acc)[2][2][4][2], const Unit& u, int wr, int wc, int fr, int fq) const {
#pragma unroll
        for (int n = 0; n < 2; ++n) {
            const int ch0 = 128 * u.pn + 32 * wc + 16 * n + 4 * fq;
            const f32x4 ba = *(const f32x4*)(b_a + ch0), bx = *(const f32x4*)(b_x + ch0), lm = *(const f32x4*)(lam + ch0);
            f32x4 sp;
#pragma unroll
            for (int e = 0; e < 4; ++e) sp[e] = -8.0f * log1pf(__expf(-lm[e]));
#pragma unroll
            for (int ai = 0; ai < 2; ++ai)
#pragma unroll
                for (int m = 0; m < 4; ++m) {
                    const size_t off = (size_t)(u.pm * BM + ai * HALF + wr * 64 + m * 16 + fr) * 1024 + ch0;
                    const uint2 xr = *(const uint2*)(xc + off);
                    float xv[4] = { __uint_as_float(xr.x << 16), __uint_as_float(xr.x & 0xffff0000u), __uint_as_float(xr.y << 16), __uint_as_float(xr.y & 0xffff0000u) };
                    f32x4 av, bv;
#pragma unroll
                    for (int e = 0; e < 4; ++e) {
                        const float r = sigmoidf_(acc[ai][0][m][n][e] + ba[e]);
                        const float ig = sigmoidf_(acc[ai][1][m][n][e] + bx[e]);
                        const float la = sp[e] * r;
                        av[e] = la;
                        bv[e] = __builtin_amdgcn_sqrtf(fmaxf(one_minus_exp(2.0f * la), 0.f)) * (ig * xv[e]);
                    }
                    uint2 wa, wb; wa.x = cvt_pk_bf16(av[0], av[1]); wa.y = cvt_pk_bf16(av[2], av[3]); wb.x = cvt_pk_bf16(bv[0], bv[1]); wb.y = cvt_pk_bf16(bv[2], bv[3]);
                    *(uint2*)(Aout + off) = wa; *(uint2*)(Bout + off) = wb;
                }
        }
    }
};

struct RowStats {
    float* xbuf;
    unsigned* cnt;
    unsigned target;
    __device__ __forceinline__ void run(const f32x4 (&v)[2][2][4][2], const Unit& u, int wr, int wc, int fr, int fq, PG8_LAS unsigned char* xl, int wid, int lane) const {
        PG8_LAS float* P = (PG8_LAS float*)xl;
        PG8_LAS float* S = (PG8_LAS float*)(xl + 4096);
#pragma unroll
        for (int ai = 0; ai < 2; ++ai)
#pragma unroll
            for (int m = 0; m < 4; ++m) {
                float s = 0.f;
#pragma unroll
                for (int bj = 0; bj < 2; ++bj)
#pragma unroll
                    for (int n = 0; n < 2; ++n) { const f32x4 x = v[ai][bj][m][n]; s += (x[0] * x[0] + x[1] * x[1]) + (x[2] * x[2] + x[3] * x[3]); }
                s += xor16f(s); s = sum32f(s);
                if (fq == 0) P[(ai * HALF + wr * 64 + m * 16 + fr) * 4 + wc] = s;
            }
        asm volatile("s_waitcnt lgkmcnt(0)" ::: "memory"); __builtin_amdgcn_s_barrier(); asm volatile("" ::: "memory");
        const int row = wid * 32 + (lane & 31);
        if (lane < 32) { const float t = (P[row * 4 + 0] + P[row * 4 + 1]) + (P[row * 4 + 2] + P[row * 4 + 3]);
            __hip_atomic_store(xbuf + (size_t)(u.pm * BM + row) * 4 + u.pn, t, __ATOMIC_RELAXED, __HIP_MEMORY_SCOPE_AGENT); }
        asm volatile("s_waitcnt vmcnt(0)" ::: "memory");
        if (lane == 0) __hip_atomic_fetch_add(cnt + 64 * u.pm, 1u, __ATOMIC_RELAXED, __HIP_MEMORY_SCOPE_AGENT);
        if (wid == 0) { unsigned sp = 0;
            while ((unsigned)__builtin_amdgcn_readfirstlane(__hip_atomic_load(cnt + 64 * u.pm, __ATOMIC_RELAXED, __HIP_MEMORY_SCOPE_AGENT)) < target) { __builtin_amdgcn_s_sleep(2); if (++sp > (1u << 18)) break; }
            __builtin_amdgcn_fence(__ATOMIC_ACQUIRE, "agent"); }
        asm volatile("s_waitcnt vmcnt(0) lgkmcnt(0)" ::: "memory"); __builtin_amdgcn_s_barrier(); asm volatile("" ::: "memory");
        if (lane < 32) { float* slot = xbuf + (size_t)(u.pm * BM + row) * 4; float t = 0.f;
#pragma unroll
            for (int k = 0; k < 4; ++k) t += __hip_atomic_load(slot + k, __ATOMIC_RELAXED, __HIP_MEMORY_SCOPE_AGENT);
            S[row] = t; }
        asm volatile("s_waitcnt lgkmcnt(0)" ::: "memory"); __builtin_amdgcn_s_barrier(); asm volatile("" ::: "memory");
    }
};
struct EpiNormRes {
    static constexpr bool PERM = false, AFTER_DRAIN = false, FUSED = true;
    bf16_t* hn; float* xs2; float* out; const float* gprev; const float* gpost; const float* gpre; RowStats st1; PG8_LAS unsigned char* xl;
    const float* s_in;
    __device__ __forceinline__ void fused(f32x4 (&acc)[2][2][4][2], const Unit& u, int wr, int wc, int fr, int fq, int wid, int lane) const {
        typedef unsigned u32x2v __attribute__((ext_vector_type(2)));
        PG8_LAS float* P = (PG8_LAS float*)xl;
        const PG8_LAS float* S = (const PG8_LAS float*)(xl + 4096);
        const int col0 = u.pn * BM + wc * 32 + 4 * fq;
        st1.run(acc, u, wr, wc, fr, fq, xl, wid, lane);
#pragma unroll
        for (int ai = 0; ai < 2; ++ai)
#pragma unroll
            for (int m = 0; m < 4; ++m) { const int r = ai * HALF + wr * 64 + m * 16 + fr; float rstd = rsqrtf(S[r] * (1.0f / 1024.0f) + 1e-6f); const size_t off = (size_t)(u.pm * BM + r) * 1024 + col0;
                if (s_in) { const f32x4 pp = *(const f32x4*)(s_in + (size_t)(u.pm * BM + r) * 4); const float s2 = __builtin_amdgcn_rcpf(((pp[0] + pp[1]) + (pp[2] + pp[3])) * (1.0f / 1024.0f) + 1e-6f);
                    rstd = rsqrtf(S[r] * (1.0f / 1024.0f) * s2 * s2 + 1e-6f) * s2; }
#pragma unroll
                for (int bj = 0; bj < 2; ++bj)
#pragma unroll
                    for (int n = 0; n < 2; ++n) { const u32x2v hw = *(const u32x2v*)(hn + off + bj * HALF + n * 16);
                        const f32x4 gp = *(const f32x4*)(gprev + col0 + bj * HALF + n * 16); const f32x4 gv = *(const f32x4*)(gpost + col0 + bj * HALF + n * 16);
                        f32x4 xs; xs[0] = __uint_as_float(hw.x << 16) * __builtin_amdgcn_rcpf(gp[0]); xs[1] = __uint_as_float(hw.x & 0xffff0000u) * __builtin_amdgcn_rcpf(gp[1]);
                        xs[2] = __uint_as_float(hw.y << 16) * __builtin_amdgcn_rcpf(gp[2]); xs[3] = __uint_as_float(hw.y & 0xffff0000u) * __builtin_amdgcn_rcpf(gp[3]);
                        acc[ai][bj][m][n] = xs + (acc[ai][bj][m][n] * rstd) * gv; }
                asm volatile("" : "+v"(acc[ai][0][m][0]), "+v"(acc[ai][0][m][1]), "+v"(acc[ai][1][m][0]), "+v"(acc[ai][1][m][1]));
                if (m & 1) asm volatile("" ::: "memory"); }
        if (gpre) {
#pragma unroll
            for (int ai = 0; ai < 2; ++ai)
#pragma unroll
                for (int m = 0; m < 4; ++m) {
                    float s = 0.f;
#pragma unroll
                    for (int bj = 0; bj < 2; ++bj)
#pragma unroll
                        for (int n = 0; n < 2; ++n) { const f32x4 x = acc[ai][bj][m][n]; s += (x[0] * x[0] + x[1] * x[1]) + (x[2] * x[2] + x[3] * x[3]); }
                    s += xor16f(s); s = sum32f(s);
                    if (fq == 0) P[(ai * HALF + wr * 64 + m * 16 + fr) * 4 + wc] = s;
                }
            asm volatile("s_waitcnt lgkmcnt(0)" ::: "memory"); __builtin_amdgcn_s_barrier(); asm volatile("" ::: "memory");
            { const int row = wid * 32 + (lane & 31);
              if (lane < 32) xs2[(size_t)(u.pm * BM + row) * 4 + u.pn] = (P[row * 4 + 0] + P[row * 4 + 1]) + (P[row * 4 + 2] + P[row * 4 + 3]); }
#pragma unroll
            for (int ai = 0; ai < 2; ++ai)
#pragma unroll
                for (int m = 0; m < 4; ++m) { const int r = ai * HALF + wr * 64 + m * 16 + fr; const size_t off = (size_t)(u.pm * BM + r) * 1024 + col0;
#pragma unroll
                    for (int bj = 0; bj < 2; ++bj)
#pragma unroll
                        for (int n = 0; n < 2; ++n) { const f32x4 gv = *(const f32x4*)(gpre + col0 + bj * HALF + n * 16); const f32x4 o = acc[ai][bj][m][n] * gv;
                            u32x2v w; w.x = cvt_pk_bf16(o[0], o[1]); w.y = cvt_pk_bf16(o[2], o[3]); *(u32x2v*)(hn + off + bj * HALF + n * 16) = w; }
                    asm volatile("" ::: "memory"); }
            asm volatile("s_waitcnt lgkmcnt(0)" ::: "memory"); __builtin_amdgcn_s_barrier(); asm volatile("" ::: "memory");
        } else {
#pragma unroll
            for (int ai = 0; ai < 2; ++ai)
#pragma unroll
                for (int m = 0; m < 4; ++m) { const int r = ai * HALF + wr * 64 + m * 16 + fr; const size_t off = (size_t)(u.pm * BM + r) * 1024 + col0;
#pragma unroll
                    for (int bj = 0; bj < 2; ++bj)
#pragma unroll
                        for (int n = 0; n < 2; ++n) *(f32x4*)(out + off + bj * HALF + n * 16) = acc[ai][bj][m][n]; }
        }
    }
};

template <class Epi, class Sched, bool ALIGN_EPI>
__device__ __forceinline__ void gemm_phase(PG8_LAS unsigned char* lds, const Gemm g, const Sched& S, const Epi& E, int tid0) {
    int tid_ = tid0; asm volatile("" : "+v"(tid_));
    const int tid = tid_, wid = __builtin_amdgcn_readfirstlane(tid >> 6), lane = tid & 63, wr = wid >> 2, wc = wid & 3, fr = lane & 15, fq = lane >> 4;
    const int K = g.K, nt = K / BK;
    unsigned voffA[2], voffB[2];
#pragma unroll
    for (int i = 0; i < 2; ++i) { int R, C; stage_rc(tid * 16 + i * 8192, R, C); const int Rb = Epi::PERM ? ((R & ~31) + perm32(R & 31)) : R;
        voffA[i] = (unsigned)(R * g.lda + C) * 2u; voffB[i] = (unsigned)(Rb * g.ldb + C) * 2u; }
    const size_t kstep = (size_t)(BK * 2);
    const size_t hstepA = (size_t)HALF * g.lda * 2, hstepB = (size_t)HALF * g.ldb * 2;
    const size_t tstepA = 2 * hstepA, tstepB = 2 * hstepB;
    const unsigned ldsw = (unsigned)wid * 1024u;
    const int aoff = lds_byte(wr * 64 + fr, fq * 8), boff = lds_byte(wc * 32 + fr, fq * 8);
#define PG8_SA(b, h) (((b) * 2 + (h)) * HTB)
#define PG8_SB(b, h) ((4 + (b) * 2 + (h)) * HTB)
#define PG8_STAGE(bufoff, gbase, voff) do { _Pragma("unroll") for (int _i = 0; _i < 2; ++_i) \
        __builtin_amdgcn_global_load_lds((const unsigned*)((const char*)(gbase) + (voff)[_i]), (PG8_LAS unsigned*)(lds + (bufoff) + ldsw + _i * 8192), 16, 0, 0); } while (0)
#define PG8_LDA(dst, b, h) do { _Pragma("unroll") for (int m = 0; m < 4; ++m) _Pragma("unroll") for (int k = 0; k < 2; ++k) dst[m][k] = *(const PG8_LAS bf16x8*)(lds + PG8_SA(b, h) + aoff + m * 2048 + k * 1024); } while (0)
#define PG8_LDB(dst, b, h) do { _Pragma("unroll") for (int n = 0; n < 2; ++n) _Pragma("unroll") for (int k = 0; k < 2; ++k) dst[n][k] = *(const PG8_LAS bf16x8*)(lds + PG8_SB(b, h) + boff + n * 2048 + k * 1024); } while (0)
#define PG8_MMA(ai, bj, At, Bt) do { __builtin_amdgcn_s_setprio(1); _Pragma("unroll") for (int m = 0; m < 4; ++m) _Pragma("unroll") for (int n = 0; n < 2; ++n) _Pragma("unroll") for (int k = 0; k < 2; ++k) \
        acc[ai][bj][m][n] = __builtin_amdgcn_mfma_f32_16x16x32_bf16(Bt[n][k], At[m][k], acc[ai][bj][m][n], 0, 0, 0); __builtin_amdgcn_s_setprio(0); } while (0)
#define PG8_WAIT_V(n) asm volatile("s_waitcnt vmcnt(" #n ")" ::: "memory")
#define PG8_WAIT_L(n) asm volatile("s_waitcnt lgkmcnt(" #n ")" ::: "memory")
#define PG8_BAR __builtin_amdgcn_s_barrier()
#define PG8_SCHED __builtin_amdgcn_sched_barrier(0)
    Unit cur, nxt; int ui = 0;
    if (!S.next(0, cur)) return;
    f32x4 acc[2][2][4][2];
#pragma unroll
    for (int a = 0; a < 2; ++a)
#pragma unroll
        for (int b = 0; b < 2; ++b)
#pragma unroll
            for (int m = 0; m < 4; ++m)
#pragma unroll
                for (int n = 0; n < 2; ++n) acc[a][b][m][n] = (f32x4){0.f, 0.f, 0.f, 0.f};
    bf16x8 At[4][2], B0[2][2], B1[2][2];
    const char* cA = (const char*)g.A + (size_t)cur.pm * tstepA + (size_t)(cur.pn >> 1) * (size_t)g.apn; const char* cB = (const char*)g.Bt + (size_t)cur.pn * tstepB;
    S.a_ready(cur);
    PG8_STAGE(PG8_SB(0, 0), cB, voffB); PG8_STAGE(PG8_SB(0, 1), cB + hstepB, voffB); PG8_STAGE(PG8_SA(0, 0), cA, voffA); PG8_STAGE(PG8_SA(0, 1), cA + hstepA, voffA);
    if (wr == 1) PG8_BAR;
    PG8_WAIT_V(2); PG8_BAR;
    PG8_STAGE(PG8_SB(1, 0), cB + kstep, voffB); PG8_STAGE(PG8_SA(1, 0), cA + kstep, voffA); PG8_STAGE(PG8_SB(1, 1), cB + hstepB + kstep, voffB);
    PG8_WAIT_V(6); PG8_BAR;
    for (;;) {
        const bool has_next = S.next(ui + 1, nxt);
        const char* nA = has_next ? (const char*)g.A + (size_t)nxt.pm * tstepA + (size_t)(nxt.pn >> 1) * (size_t)g.apn : cA; const char* nB = has_next ? (const char*)g.Bt + (size_t)nxt.pn * tstepB : cB;
        for (int t = 0; t < nt; t += 2) {
            const bool last = (t == nt - 2);
            const char* a1 = cA + (size_t)(t + 1) * kstep;
            const char* a2 = last ? nA : cA + (size_t)(t + 2) * kstep; const char* b2 = last ? nB : cB + (size_t)(t + 2) * kstep;
            const char* a3 = a2 + kstep; const char* b3 = b2 + kstep;
            if (last && has_next) S.a_ready(nxt);
            PG8_LDB(B0, 0, 0); PG8_LDB(B1, 0, 1); PG8_SCHED; PG8_LDA(At, 0, 0); PG8_STAGE(PG8_SA(1, 1), a1 + hstepA, voffA);
            PG8_WAIT_V(8); PG8_WAIT_L(0); PG8_BAR; PG8_MMA(0, 0, At, B0); PG8_MMA(0, 1, At, B1); PG8_BAR; PG8_SCHED;
            PG8_LDA(At, 0, 1); PG8_STAGE(PG8_SB(0, 0), b2, voffB); PG8_STAGE(PG8_SB(0, 1), b2 + hstepB, voffB); PG8_STAGE(PG8_SA(0, 0), a2, voffA);
            PG8_WAIT_V(8); PG8_WAIT_L(0); PG8_BAR; PG8_MMA(1, 0, At, B0); PG8_MMA(1, 1, At, B1); PG8_BAR; PG8_SCHED;
            PG8_LDB(B0, 1, 0); PG8_LDB(B1, 1, 1); PG8_SCHED; PG8_LDA(At, 1, 0); PG8_STAGE(PG8_SA(0, 1), a2 + hstepA, voffA);
            PG8_WAIT_V(8); PG8_WAIT_L(0); PG8_BAR; PG8_MMA(0, 0, At, B0); PG8_MMA(0, 1, At, B1); PG8_BAR; PG8_SCHED;
            PG8_LDA(At, 1, 1); PG8_STAGE(PG8_SB(1, 0), b3, voffB); PG8_STAGE(PG8_SB(1, 1), b3 + hstepB, voffB); PG8_STAGE(PG8_SA(1, 0), a3, voffA);
            PG8_WAIT_V(8); PG8_WAIT_L(0); PG8_BAR; PG8_MMA(1, 0, At, B0); PG8_MMA(1, 1, At, B1); PG8_BAR; PG8_SCHED;
        }
        if constexpr (ALIGN_EPI) { if (wr == 0) PG8_BAR; }
        if constexpr (Epi::FUSED) E.fused(acc, cur, wr, wc, fr, fq, wid, lane); else E(acc, cur, wr, wc, fr, fq);
        S.done(cur);
        if (!has_next) break;
#pragma unroll
        for (int a = 0; a < 2; ++a)
#pragma unroll
            for (int b = 0; b < 2; ++b)
#pragma unroll
                for (int m = 0; m < 4; ++m)
#pragma unroll
                    for (int n = 0; n < 2; ++n) acc[a][b][m][n] = (f32x4){0.f, 0.f, 0.f, 0.f};
        cur = nxt; cA = nA; cB = nB; ++ui;
        if constexpr (ALIGN_EPI) { if (wr == 1) PG8_BAR; }
    }
    PG8_WAIT_V(0);
    if constexpr (!ALIGN_EPI) { if (wr == 0) PG8_BAR; }
    PG8_BAR;
#undef PG8_SA
#undef PG8_SB
#undef PG8_STAGE
#undef PG8_LDA
#undef PG8_LDB
#undef PG8_MMA
#undef PG8_WAIT_V
#undef PG8_WAIT_L
#undef PG8_BAR
#undef PG8_SCHED
}
}
namespace att {
typedef unsigned short u16;
typedef short bf16x8 __attribute__((ext_vector_type(8)));
typedef short s16x4 __attribute__((ext_vector_type(4)));
typedef float f32x16 __attribute__((ext_vector_type(16)));
typedef float f32x4 __attribute__((ext_vector_type(4)));
typedef unsigned u32x4 __attribute__((ext_vector_type(4)));
constexpr int SEQ = 16384, NW = 8, QBLK = 32, KVBLK = 64, QB = NW * QBLK;
constexpr int LDQ = 1536, LDK = 2048, LDKR = 64, LDO = 1024;
#ifndef ATT_NQREG
#define ATT_NQREG 6
#endif
constexpr int NQREG = ATT_NQREG, NQREG_L = 8 - NQREG;
constexpr int SHM_V = KVBLK * 128 * 2, SHM_K = KVBLK * 128 * 2, SHM_KR = KVBLK * 64 * 2;
constexpr int OFF_V = 0, OFF_K = 2 * SHM_V, OFF_KR = OFF_K + 2 * SHM_K, OFF_WS = OFF_KR + 2 * SHM_KR, OFF_QR = OFF_WS + NW * 64 * 4, QR_WAVE = (NQREG_L + 4) * 1024, LDS_BYTES = OFF_QR + NW * QR_WAVE;
constexpr float SCALE = 0.07216878364870322f;
constexpr float THR = 8.f;

#define KSWZ(row, colB) ((row) * 256 + ((colB) ^ (((row) & 7) << 4)))
#define KRSWZ(row, colB) ((row) * 128 + ((colB) ^ (((row) & 7) << 4)))
#define SBAR() __builtin_amdgcn_sched_barrier(0)
__device__ __forceinline__ int v_st(int k, int c) { const int kk = (k & ~0xC) | ((k & 4) << 1) | ((k & 8) >> 1); return ((kk >> 3) * 4 + (c >> 5)) * 512 + ((kk & 7) * 32 + (c & 31)) * 2; }
__device__ __forceinline__ int v_rd_base(int lane) { return ((lane & 3) << 3) | (((lane >> 2) & 3) << 6) | (((lane >> 4) & 1) << 5) | (((lane >> 5) & 1) << 8); }
constexpr int v_rd_off(int d0, int ks, int half) { return d0 * 512 + ks * 4096 + half * 2048; }
__device__ __forceinline__ int crow(int r, int hi) { return (r & 3) + 8 * (r >> 2) + 4 * hi; }
__device__ __forceinline__ unsigned cvtpk(float lo, float hi) { unsigned r; asm volatile("v_cvt_pk_bf16_f32 %0, %1, %2" : "=v"(r) : "v"(lo), "v"(hi)); return r; }
__device__ __forceinline__ bf16x8 load8(const u16* p) { return *reinterpret_cast<const bf16x8*>(p); }
__device__ __forceinline__ void mask_tile(f32x16& p0, f32x16& p1, int dq, unsigned W) {
    const float NEG = -__builtin_inff();
#pragma unroll
    for (int r = 0; r < 16; ++r) {
        const int c = (r & 3) + 8 * (r >> 2);
        if ((unsigned)(dq - c) >= W) p0[r] = NEG;
        if ((unsigned)(dq - c - 32) >= W) p1[r] = NEG;
    }
}
__device__ __forceinline__ void partialSM(f32x16& p0, f32x16& p1, float& m_reg, float& mn, float& alpha) {
    float pmax = p0[0]; for (int r = 1; r < 16; ++r) pmax = fmaxf(pmax, p0[r]); for (int r = 0; r < 16; ++r) pmax = fmaxf(pmax, p1[r]);
    { auto rr = __builtin_amdgcn_permlane32_swap(__float_as_uint(pmax), __float_as_uint(pmax), false, false);
      pmax = fmaxf(__uint_as_float(rr[0]), __uint_as_float(rr[1])); }
    constexpr float C2 = 1.4426950408889634f * SCALE;
    if (__builtin_expect(__all((pmax - m_reg) * SCALE <= THR), 1)) { mn = m_reg; alpha = 1.f; }
    else { mn = fmaxf(m_reg, pmax); alpha = __builtin_amdgcn_exp2f((m_reg - mn) * C2); m_reg = mn; }
    const float mnL = -mn * C2;
    for (int r = 0; r < 16; ++r) p0[r] = fmaf(p0[r], C2, mnL); for (int r = 0; r < 16; ++r) p1[r] = fmaf(p1[r], C2, mnL);
}
__device__ __forceinline__ void finishSM(f32x16& p0, f32x16& p1, float alpha, float& l_reg, bf16x8& pa0, bf16x8& pa1, bf16x8& pa2, bf16x8& pa3) {
    for (int r = 0; r < 16; ++r) p0[r] = __builtin_amdgcn_exp2f(p0[r]);
    for (int r = 0; r < 16; ++r) p1[r] = __builtin_amdgcn_exp2f(p1[r]);
    float ps = 0; for (int r = 0; r < 16; ++r) ps += p0[r]; for (int r = 0; r < 16; ++r) ps += p1[r];
    { auto rr = __builtin_amdgcn_permlane32_swap(__float_as_uint(ps), __float_as_uint(ps), false, false);
      ps = __uint_as_float(rr[0]) + __uint_as_float(rr[1]); }
    l_reg = l_reg * alpha + ps;
#define PK4(P, B_, OUT) do { unsigned a0 = cvtpk(P[B_+0], P[B_+1]), a1 = cvtpk(P[B_+2], P[B_+3]);                          \
        unsigned b0 = cvtpk(P[B_+4], P[B_+5]), b1 = cvtpk(P[B_+6], P[B_+7]);                                             \
        auto r0 = __builtin_amdgcn_permlane32_swap(a0, b0, false, false); auto r1 = __builtin_amdgcn_permlane32_swap(a1, b1, false, false); \
        u32x4 w = {r0[0], r1[0], r0[1], r1[1]}; OUT = *reinterpret_cast<bf16x8*>(&w); } while (0)
    PK4(p0, 0, pa0); PK4(p0, 8, pa1); PK4(p1, 0, pa2); PK4(p1, 8, pa3);
#undef PK4
}
#ifndef ATT_PF
#define ATT_PF 2
#endif
#define QK_SB() __builtin_amdgcn_sched_barrier(0x406)
#define QK_LOAD(s, SET) do { if ((s) < 8) { const char* a_ = kb[(s) & 3] + ((s) >> 2) * 128; fb0[SET] = *reinterpret_cast<const bf16x8*>(a_); fb1[SET] = *reinterpret_cast<const bf16x8*>(a_ + 32 * 256); \
            if ((s) < NQREG) fq[SET] = qr[(s) < NQREG ? (s) : 0]; else fq[SET] = qrl[((s) - NQREG) * 64]; } \
        else { const char* a_ = krb[((s) - 8) & 3]; fb0[SET] = *reinterpret_cast<const bf16x8*>(a_); fb1[SET] = *reinterpret_cast<const bf16x8*>(a_ + 32 * 128); fq[SET] = qrl[(NQREG_L + (s) - 8) * 64]; } } while (0)
template <int KB>
__device__ __forceinline__ void qkt(f32x16& p0, f32x16& p1, const char* K_lds, const char* KR_lds, const bf16x8* qrl, int r32, int hi, const bf16x8* qr) {
    constexpr int PF = ATT_PF, NS = PF + 1;
    p0 = f32x16{}; p1 = f32x16{};
    const char* kb[4]; const char* krb[4];
#pragma unroll
    for (int dd = 0; dd < 4; ++dd) { kb[dd] = K_lds + KB * SHM_K + KSWZ(r32, (dd * 16 + hi * 8) * 2); krb[dd] = KR_lds + KB * SHM_KR + KRSWZ(r32, (dd * 16 + hi * 8) * 2); }
    bf16x8 fb0[NS], fb1[NS], fq[NS];
#pragma unroll
    for (int s = 0; s < PF; ++s) QK_LOAD(s, s % NS);
#pragma unroll
    for (int s = 0; s < 12; ++s) {
        QK_SB();
        if (s + PF < 12) QK_LOAD(s + PF, (s + PF) % NS);
        QK_SB();
        p0 = __builtin_amdgcn_mfma_f32_32x32x16_bf16(fb0[s % NS], fq[s % NS], p0, 0, 0, 0);
        p1 = __builtin_amdgcn_mfma_f32_32x32x16_bf16(fb1[s % NS], fq[s % NS], p1, 0, 0, 0);
    }
    QK_SB();
}
#define FSM_E(j) do { if ((j) < 16) { y0[(j) & 15] = __builtin_amdgcn_exp2f(y0[(j) & 15]); acc += y0[(j) & 15]; } else { y1[(j) & 15] = __builtin_amdgcn_exp2f(y1[(j) & 15]); acc += y1[(j) & 15]; } } while (0)
#define FSM_CVT(P, B_) do { ca0 = cvtpk(P[(B_) + 0], P[(B_) + 1]); ca1 = cvtpk(P[(B_) + 2], P[(B_) + 3]); cb0 = cvtpk(P[(B_) + 4], P[(B_) + 5]); cb1 = cvtpk(P[(B_) + 6], P[(B_) + 7]); } while (0)
#define FSM_SWP(OUT) do { auto r0_ = __builtin_amdgcn_permlane32_swap(ca0, cb0, false, false); auto r1_ = __builtin_amdgcn_permlane32_swap(ca1, cb1, false, false); \
        u32x4 w_ = {r0_[0], r1_[0], r0_[1], r1_[1]}; OUT = *reinterpret_cast<bf16x8*>(&w_); } while (0)
#define FSM_CHUNK(c) do { if ((c) < 12) { FSM_E(2 * (c)); FSM_E(2 * (c) + 1); } else if ((c) < 20) { FSM_E(24 + (c) - 12); } \
        if ((c) == 12) FSM_CVT(y0, 0); if ((c) == 13) FSM_SWP(pa0); if ((c) == 14) FSM_CVT(y0, 8); if ((c) == 15) FSM_SWP(pa1); \
        if ((c) == 16) FSM_CVT(y1, 0); if ((c) == 17) FSM_SWP(pa2); if ((c) == 20) FSM_CVT(y1, 8); if ((c) == 21) FSM_SWP(pa3); \
        if ((c) == 22) { auto rr_ = __builtin_amdgcn_permlane32_swap(__float_as_uint(acc), __float_as_uint(acc), false, false); acc = __uint_as_float(rr_[0]) + __uint_as_float(rr_[1]); } \
        if ((c) == 23) l_reg = l_reg * alpha + acc; } while (0)
#define SB0() __builtin_amdgcn_sched_barrier(0)
template <int KB>
__device__ __forceinline__ void qkt_fsm(f32x16& p0, f32x16& p1, const char* K_lds, const char* KR_lds, const bf16x8* qrl, int r32, int hi, const bf16x8* qr,
                                        f32x16& y0, f32x16& y1, float alpha, float& l_reg, bf16x8& pa0, bf16x8& pa1, bf16x8& pa2, bf16x8& pa3) {
    constexpr int PF = ATT_PF, NS = PF + 1;
    p0 = f32x16{}; p1 = f32x16{};
    const char* kb[4]; const char* krb[4];
#pragma unroll
    for (int dd = 0; dd < 4; ++dd) { kb[dd] = K_lds + KB * SHM_K + KSWZ(r32, (dd * 16 + hi * 8) * 2); krb[dd] = KR_lds + KB * SHM_KR + KRSWZ(r32, (dd * 16 + hi * 8) * 2); }
    bf16x8 fb0[NS], fb1[NS], fq[NS];
    float acc = 0.f; unsigned ca0 = 0, ca1 = 0, cb0 = 0, cb1 = 0;
#pragma unroll
    for (int s = 0; s < PF; ++s) QK_LOAD(s, s % NS);
#pragma unroll
    for (int s = 0; s < 12; ++s) {
        SB0();
        if (s + PF < 12) QK_LOAD(s + PF, (s + PF) % NS);
        SB0();
        p0 = __builtin_amdgcn_mfma_f32_32x32x16_bf16(fb0[s % NS], fq[s % NS], p0, 0, 0, 0);
        SB0(); FSM_CHUNK(2 * s); SB0();
        p1 = __builtin_amdgcn_mfma_f32_32x32x16_bf16(fb1[s % NS], fq[s % NS], p1, 0, 0, 0);
        SB0(); FSM_CHUNK(2 * s + 1);
    }
    SB0();
}
#undef FSM_E
#undef FSM_CVT
#undef FSM_SWP
#undef FSM_CHUNK
#undef QK_LOAD
template <int VB>
__device__ __forceinline__ void pv_tile(f32x16* o, int vb0, bf16x8 pa0, bf16x8 pa1, bf16x8 pa2, bf16x8 pa3) {
#define TRRD(dst, off) asm volatile("ds_read_b64_tr_b16 %0, %1 offset:%2" : "=&v"(dst) : "v"(vb0), "i"(off) : "memory")
#define PV_D0(d0) do { s16x4 l0, l1, l2, l3, h0, h1, h2, h3; constexpr int b_ = OFF_V + VB * SHM_V + v_rd_off(d0, 0, 0); \
        TRRD(l0, b_); TRRD(h0, b_ + 2048); TRRD(l1, b_ + 4096); TRRD(h1, b_ + 6144); TRRD(l2, b_ + 8192); TRRD(h2, b_ + 10240); TRRD(l3, b_ + 12288); TRRD(h3, b_ + 14336); \
        asm volatile("s_waitcnt lgkmcnt(0)" ::: "memory"); SBAR();   \
        o[d0] = __builtin_amdgcn_mfma_f32_32x32x16_bf16(pa0, (bf16x8){l0[0], l0[1], l0[2], l0[3], h0[0], h0[1], h0[2], h0[3]}, o[d0], 0, 0, 0);   \
        o[d0] = __builtin_amdgcn_mfma_f32_32x32x16_bf16(pa1, (bf16x8){l1[0], l1[1], l1[2], l1[3], h1[0], h1[1], h1[2], h1[3]}, o[d0], 0, 0, 0);   \
        o[d0] = __builtin_amdgcn_mfma_f32_32x32x16_bf16(pa2, (bf16x8){l2[0], l2[1], l2[2], l2[3], h2[0], h2[1], h2[2], h2[3]}, o[d0], 0, 0, 0);   \
        o[d0] = __builtin_amdgcn_mfma_f32_32x32x16_bf16(pa3, (bf16x8){l3[0], l3[1], l3[2], l3[3], h3[0], h3[1], h3[2], h3[3]}, o[d0], 0, 0, 0); } while (0)
    PV_D0(0); PV_D0(1); PV_D0(2); PV_D0(3);
}
template <int VB>
__device__ __forceinline__ void pv_tile_sm(f32x16* o, int vb0, bf16x8 pa0, bf16x8 pa1, bf16x8 pa2, bf16x8 pa3, f32x16& p0, f32x16& p1, float& m_reg, float& mn, float& alpha) {
    constexpr float C2 = 1.4426950408889634f * SCALE;
    PV_D0(0);
    float pmax = p0[0];
#pragma unroll
    for (int r = 1; r < 16; ++r) pmax = fmaxf(pmax, p0[r]);
#pragma unroll
    for (int r = 0; r < 16; ++r) pmax = fmaxf(pmax, p1[r]);
    PV_D0(1);
    { auto rr = __builtin_amdgcn_permlane32_swap(__float_as_uint(pmax), __float_as_uint(pmax), false, false);
      pmax = fmaxf(__uint_as_float(rr[0]), __uint_as_float(rr[1])); }
    const bool keep = __all((pmax - m_reg) * SCALE <= THR);
    mn = keep ? m_reg : fmaxf(m_reg, pmax);
    alpha = __builtin_amdgcn_exp2f((m_reg - mn) * C2);
    m_reg = mn;
    const float mnL = -mn * C2;
#pragma unroll
    for (int r = 0; r < 16; ++r) p0[r] = fmaf(p0[r], C2, mnL);
    PV_D0(2);
#pragma unroll
    for (int r = 0; r < 16; ++r) p1[r] = fmaf(p1[r], C2, mnL);
    PV_D0(3);
}
#undef PV_D0
#undef TRRD

struct BlockRef { const u16* Q; const u16* K; const u16* V; const u16* KR; u16* O; int P0; int row0; };
#define VMW() asm volatile("s_waitcnt vmcnt(0)" ::: "memory")
#define ATT_LAS __attribute__((address_space(3)))
#define KDMA(Kp, KRp, k0, bf) do { \
        __builtin_amdgcn_global_load_lds((const unsigned*)((Kp) + (size_t)((k0) + sr) * LDK + ksc), (ATT_LAS unsigned*)(ldsL + OFF_K + (bf) * SHM_K + wid * 1024), 16, 0, 0); \
        __builtin_amdgcn_global_load_lds((const unsigned*)((Kp) + (size_t)((k0) + 32 + sr) * LDK + ksc), (ATT_LAS unsigned*)(ldsL + OFF_K + (bf) * SHM_K + 8192 + wid * 1024), 16, 0, 0); \
        __builtin_amdgcn_global_load_lds((const unsigned*)((KRp) + (size_t)((k0) + krr) * LDKR + krsc), (ATT_LAS unsigned*)(ldsL + OFF_KR + (bf) * SHM_KR + wid * 1024), 16, 0, 0); } while (0)
#define VDMA(Vp, k0, bf) do { \
        __builtin_amdgcn_global_load_lds((const unsigned*)((Vp) + (size_t)((k0) + vk) * LDK + vc), (ATT_LAS unsigned*)(ldsL + OFF_V + (bf) * SHM_V + wid * 1024), 16, 0, 0); \
        __builtin_amdgcn_global_load_lds((const unsigned*)((Vp) + (size_t)((k0) + 32 + vk) * LDK + vc), (ATT_LAS unsigned*)(ldsL + OFF_V + (bf) * SHM_V + 8192 + wid * 1024), 16, 0, 0); } while (0)
#define ATT_MAPS() const int sr = tid >> 4, ksc = ((tid & 15) ^ (sr & 7)) * 8, krr = tid >> 3, krsc = ((tid & 7) ^ (krr & 7)) * 8; ATT_LAS unsigned char* ldsL = (ATT_LAS unsigned char*)lds; \
    const int vkk_ = ((tid >> 7) << 3) | ((tid >> 2) & 7), vk = (vkk_ & ~0xC) | ((vkk_ & 4) << 1) | ((vkk_ & 8) >> 1), vc = ((tid >> 5) & 3) * 32 + (tid & 3) * 8
__device__ __forceinline__ void attn_prime(const BlockRef& cur, char* lds, int tid0) {
    int tid_ = tid0; asm volatile("" : "+v"(tid_));
    const int tid = tid_, wid = __builtin_amdgcn_readfirstlane(tid >> 6);
    ATT_MAPS();
    KDMA(cur.K, cur.KR, 0, 0); VDMA(cur.V, 0, 0); VMW();
    __syncthreads();
}
__device__ __forceinline__ void attn_block(const BlockRef& cur, const BlockRef& nxt, char* lds, int tid0, const float* ctab, const float* stab) {
    int tid_ = tid0; asm volatile("" : "+v"(tid_));
    const int tid = tid_, wid = __builtin_amdgcn_readfirstlane(tid >> 6), lane = tid & 63, r32 = lane & 31, hi = lane >> 5;
    const unsigned W = 0x40000000u;
    const int NT = (cur.P0 + QB - 1) / KVBLK + 1;
    const int qlo = cur.P0 + wid * QBLK, qm = qlo + r32 - 4 * hi;
    char* K_lds = lds + OFF_K; char* KR_lds = lds + OFF_KR;
    float* ws = (float*)(lds + OFF_WS) + wid * 64; float* li_l = ws, * al_l = ws + 32;
    bf16x8* qrl = (bf16x8*)(lds + OFF_QR + wid * QR_WAVE) + lane;
    float m_reg = -1e30f, l_reg = 0; f32x16 o[4] = {};
    ATT_MAPS();
    const int vb0 = (int)(uintptr_t)lds + v_rd_base(lane);
    const u16* Kh = cur.K; const u16* Vh = cur.V; const u16* KRh = cur.KR;
#define RESC(a) do { if (__any((a) < 1.f)) { if (hi == 0) al_l[r32] = (a); asm volatile("s_waitcnt lgkmcnt(0)" ::: "memory");              \
                     for (int d_ = 0; d_ < 4; ++d_) for (int r = 0; r < 16; ++r) o[d_][r] *= al_l[crow(r, hi)]; } } while (0)
#define KBASE(t) ((t) * KVBLK)
#define MASKT(P0_, P1_, t) do { const int kb_ = KBASE(t); if (kb_ + KVBLK - 1 > qlo) mask_tile(P0_, P1_, qm - kb_, W); } while (0)
    f32x16 pA0, pA1, pB0, pB1; float mnA, mnB, alA, alB; bf16x8 pa0, pa1, pa2, pa3;
    bf16x8 qr[NQREG > 0 ? NQREG : 1];
    { const u16* qp = cur.Q + (size_t)(wid * QBLK + r32) * LDQ + hi * 8;
#pragma unroll
      for (int d = 0; d < NQREG_L; ++d) qrl[d * 64] = load8(qp + (NQREG + d) * 16);
      const size_t trow = (size_t)(cur.row0 + wid * QBLK + r32) * 32 + hi * 8;
#pragma unroll
      for (int pr = 0; pr < 2; ++pr) {
          const bf16x8 x1 = load8(qp + 128 + pr * 16), x2 = load8(qp + 128 + 32 + pr * 16);
          const f32x4 c0 = *(const f32x4*)(ctab + trow + pr * 16), c1 = *(const f32x4*)(ctab + trow + pr * 16 + 4), s0 = *(const f32x4*)(stab + trow + pr * 16), s1 = *(const f32x4*)(stab + trow + pr * 16 + 4);
          float o1[8], o2[8];
#pragma unroll
          for (int e = 0; e < 8; ++e) { const float a = __uint_as_float(((unsigned)(unsigned short)x1[e]) << 16), b = __uint_as_float(((unsigned)(unsigned short)x2[e]) << 16);
              const float cc = e < 4 ? c0[e & 3] : c1[e & 3], ss = e < 4 ? s0[e & 3] : s1[e & 3]; o1[e] = a * cc - b * ss; o2[e] = b * cc + a * ss; }
          u32x4 w1 = {cvtpk(o1[0], o1[1]), cvtpk(o1[2], o1[3]), cvtpk(o1[4], o1[5]), cvtpk(o1[6], o1[7])}, w2 = {cvtpk(o2[0], o2[1]), cvtpk(o2[2], o2[3]), cvtpk(o2[4], o2[5]), cvtpk(o2[6], o2[7])};
          qrl[(NQREG_L + pr) * 64] = *reinterpret_cast<bf16x8*>(&w1); qrl[(NQREG_L + 2 + pr) * 64] = *reinterpret_cast<bf16x8*>(&w2); }
#pragma unroll
      for (int d0 = 0; d0 < NQREG; ++d0) qr[d0] = load8(qp + d0 * 16); }
    SBAR();
    KDMA(Kh, KRh, KBASE(1), 1); VDMA(Vh, KBASE(1), 1);
    SBAR(); qkt<0>(pA0, pA1, K_lds, KR_lds, qrl, r32, hi, qr);
    MASKT(pA0, pA1, 0); partialSM(pA0, pA1, m_reg, mnA, alA);
    VMW(); __syncthreads();
    KDMA(Kh, KRh, KBASE(2), 0);
#define HALF_STEP(PX0, PX1, mnX, alX, PY0, PY1, alY, t, KB, VB) do {                                                          \
        SBAR(); qkt_fsm<KB>(PX0, PX1, K_lds, KR_lds, qrl, r32, hi, qr, PY0, PY1, alY, l_reg, pa0, pa1, pa2, pa3); SBAR();               \
        MASKT(PX0, PX1, (t)); SBAR(); pv_tile_sm<VB>(o, vb0, pa0, pa1, pa2, pa3, PX0, PX1, m_reg, mnX, alX);                  \
        VMW(); __syncthreads();                                                                                               \
        if ((t) + 2 < NT) KDMA(Kh, KRh, KBASE((t) + 2), KB);                                                                  \
        if ((t) + 1 < NT) VDMA(Vh, KBASE((t) + 1), VB);                                                                       \
        SBAR(); RESC(alX); } while (0)
    for (int t = 1; t + 1 < NT; t += 2) {
        HALF_STEP(pB0, pB1, mnB, alB, pA0, pA1, alA, t, 1, 0);
        HALF_STEP(pA0, pA1, mnA, alA, pB0, pB1, alB, t + 1, 0, 1);
    }
    SBAR(); qkt_fsm<1>(pB0, pB1, K_lds, KR_lds, qrl, r32, hi, qr, pA0, pA1, alA, l_reg, pa0, pa1, pa2, pa3); SBAR();
    MASKT(pB0, pB1, NT - 1); SBAR(); pv_tile_sm<0>(o, vb0, pa0, pa1, pa2, pa3, pB0, pB1, m_reg, mnB, alB);
    VMW(); __syncthreads();
    KDMA(nxt.K, nxt.KR, 0, 0); VDMA(nxt.V, 0, 0);
    SBAR(); RESC(alB);
    finishSM(pB0, pB1, alB, l_reg, pa0, pa1, pa2, pa3); SBAR(); pv_tile<1>(o, vb0, pa0, pa1, pa2, pa3);
    SBAR();
    if (hi == 0) li_l[r32] = l_reg; asm volatile("s_waitcnt lgkmcnt(0)" ::: "memory");
    float rli[16];
#pragma unroll
    for (int r = 0; r < 16; ++r) rli[r] = __builtin_amdgcn_rcpf(li_l[crow(r, hi)]);
    u16* Ow = cur.O + (size_t)(wid * QBLK) * LDO;
#pragma unroll
    for (int r = 0; r < 16; ++r) { const int orow = crow(r, hi);
#pragma unroll
        for (int d0 = 0; d0 < 4; ++d0) { const float v = o[d0][r] * rli[r];
            const float vn = xor1f(v);
            if ((r32 & 1) == 0) *(unsigned*)(Ow + (size_t)orow * LDO + d0 * 32 + r32) = cvtpk(v, vn); } }
    VMW(); __syncthreads();
#undef RESC
#undef KBASE
#undef MASKT
#undef HALF_STEP
}
struct Tensors { const u16* q; const u16* kv; const u16* kr; u16* o; const float* ctab; const float* stab; };
__device__ __forceinline__ BlockRef make_ref(const Tensors& T, int L, int pass) {
    const int bh = (L & 7) + 8 * (L >> 8), x = (L >> 3) & 31, b = bh >> 3, h = bh & 7, qb = pass ? 63 - x : x;
    BlockRef r; const size_t row0 = (size_t)b * SEQ;
    r.Q = T.q + (row0 + (size_t)qb * QB) * LDQ + h * 192; r.K = T.kv + row0 * LDK + h * 256; r.V = r.K + 128; r.KR = T.kr + row0 * LDKR;
    r.O = T.o + (row0 + (size_t)qb * QB) * LDO + h * 128; r.P0 = qb * QB; r.row0 = b * SEQ + qb * QB;
    return r;
}
__device__ __forceinline__ void attn_phase(char* lds, const Tensors& T, int tid0) {
    const int total = 512, stride = gridDim.x;
    int L = blockIdx.x; if (L >= total) return;
    int pass = 0;
    BlockRef cur = make_ref(T, L, 0);
    attn_prime(cur, lds, tid0);
    for (;;) {
        const bool more_pass = pass == 0, more_item = L + stride < total, last = !more_pass && !more_item;
        int passn = pass + 1, Ln = L;
        if (!more_pass) { passn = 0; Ln = more_item ? L + stride : L; }
        const BlockRef nxt = last ? cur : make_ref(T, Ln, passn);
        attn_block(cur, nxt, lds, tid0, T.ctab, T.stab);
        if (last) break;
        cur = nxt; pass = passn; L = Ln;
    }
}
#undef VMW
#undef KDMA
#undef VDMA
#undef ATT_MAPS
#undef SBAR
}
namespace xb {
#define LAS __attribute__((address_space(3)))
#define XB_TMO      128
#define XB_XCNT(j)  (256  + 64 * (j))
#define XB_XSUB(j)  (1280 + 64 * (j))
#define XB_XGEN(j)  (2304 + 64 * (j))
#define XB_TOP      3328
#define XB_TOPGEN   3392
#define XCD_BAR_WORDS 3456
#define XB_SPIN_CAP (1u << 18)

__device__ __forceinline__ unsigned xb_ld(unsigned* p)              { return __hip_atomic_load(p, __ATOMIC_RELAXED, __HIP_MEMORY_SCOPE_AGENT); }
__device__ __forceinline__ unsigned xb_add(unsigned* p, unsigned v) { return __hip_atomic_fetch_add(p, v, __ATOMIC_RELAXED, __HIP_MEMORY_SCOPE_AGENT); }
__device__ __forceinline__ unsigned xb_xcc_id() { return (unsigned)__builtin_amdgcn_s_getreg((3 << 11) | 20) & 0xFu; }
#define XB_SPIN(cond, bar) do { unsigned _sp = 0; while (cond) { __builtin_amdgcn_s_sleep(1); \
    if ((++_sp & 255u) == 0u) { if (xb_ld(&(bar)[XB_TMO])) break; if (_sp > XB_SPIN_CAP) { atomicAdd(&(bar)[XB_TMO], 1u); break; } } } } while (0)

struct XcdBarrier {
    unsigned* bar; unsigned x;
    volatile LAS unsigned* st;
};

__device__ __forceinline__ XcdBarrier xcd_barrier_post(unsigned* bar, volatile LAS unsigned* st) {
    XcdBarrier b; b.bar = bar; b.x = xb_xcc_id(); b.st = st;
    if (threadIdx.x == 0) (void)xb_add(&bar[XB_XCNT(b.x)], 1u);
    return b;
}
__device__ __forceinline__ void xcd_barrier_complete(unsigned* bar, unsigned x, unsigned& nloc, unsigned& nx) {
    const unsigned G = gridDim.x * gridDim.y * gridDim.z;
    unsigned sum, cnt, mine, sp = 0u;
    for (;;) {
        sum = 0u; cnt = 0u; mine = 0u;
#pragma unroll
        for (unsigned j = 0; j < 16; ++j) { const unsigned c = xb_ld(&bar[XB_XCNT(j)]); sum += c; cnt += (c > 0u) ? 1u : 0u; mine = (j == x) ? c : mine; }
        if (sum == G) break;
        __builtin_amdgcn_s_sleep(1);
        if ((++sp & 255u) == 0u) { if (xb_ld(&bar[XB_TMO])) break; if (sp > XB_SPIN_CAP) { atomicAdd(&bar[XB_TMO], 1u); break; } }
    }
    nloc = mine > 0u ? mine : 1u; nx = cnt > 0u ? cnt : 1u;
}

__device__ __forceinline__ void xcd_barrier(const XcdBarrier& b, bool t0  ) {
    asm volatile("s_waitcnt vmcnt(0)" ::: "memory");
    __syncthreads();
    if (t0) {
        unsigned* bar = b.bar;
        __builtin_amdgcn_s_waitcnt(0);
        unsigned nloc = b.st[0], nx = b.st[1];
        if (nloc == 0u) { xcd_barrier_complete(bar, b.x, nloc, nx); b.st[0] = nloc; b.st[1] = nx; }
        const unsigned old = xb_add(&bar[XB_XSUB(b.x)], 1u);
        const unsigned gen = old / nloc;
        if (old + 1u == (gen + 1u) * nloc) {
            __builtin_amdgcn_fence(__ATOMIC_RELEASE, "agent");
            asm volatile("s_waitcnt vmcnt(0)" ::: "memory");
            const unsigned og = xb_add(&bar[XB_TOP], 1u);
            const unsigned tg = og / nx;
            if (og + 1u == (tg + 1u) * nx) xb_add(&bar[XB_TOPGEN], 1u);
            else XB_SPIN(xb_ld(&bar[XB_TOPGEN]) == tg, bar);
            __builtin_amdgcn_fence(__ATOMIC_ACQUIRE, "agent");
            xb_add(&bar[XB_XGEN(b.x)], 1u);
            asm volatile("s_waitcnt vmcnt(0)" ::: "memory");
        } else {
            XB_SPIN(xb_ld(&bar[XB_XGEN(b.x)]) == gen, bar);
            __builtin_amdgcn_fence(__ATOMIC_ACQUIRE, "agent");
            asm volatile("s_waitcnt vmcnt(0)" ::: "memory");
        }
    }
    __syncthreads();
}
#undef LAS
}
#ifndef PROBE_ATT_REPS
#define PROBE_ATT_REPS 1
#endif
#ifndef PROBE_SYNC_REPS
#define PROBE_SYNC_REPS 1
#endif
#ifndef PROBE_THIN_REPS
#define PROBE_THIN_REPS 1
#endif
#ifndef PROBE_PRO_REPS
#define PROBE_PRO_REPS 1
#endif
#ifndef STAGGER_TICKS
#define STAGGER_TICKS 0
#endif
#ifndef PROBE_GEMM_OP
#define PROBE_GEMM_OP -1
#endif
#ifndef PROBE_GEMM_REPS
#define PROBE_GEMM_REPS 1
#endif
namespace mk {
typedef unsigned short u16;
typedef float f32x4 __attribute__((ext_vector_type(4)));
constexpr int M = 32768, D = 1024, SEQ = 16384;
constexpr float EPS = 1e-6f;
constexpr size_t MB = (size_t)1 << 20;
__host__ __device__ constexpr size_t WT_MLA(int j) { return (size_t)j * 6 * MB; }
__host__ __device__ constexpr size_t WT_LRU(int j) { return 12 * MB + (size_t)j * 8 * MB; }
__host__ __device__ constexpr size_t WT_FFN(int l) { return 28 * MB + (size_t)l * 16 * MB; }
constexpr size_t OFF_UQ = 3 * MB / 2, OFF_UKV = 11 * MB / 4, OFF_WO = 15 * MB / 4, OFF_GT = 4 * MB, OFF_LOUT = 5 * MB, OFF_DOWN = 8 * MB;
constexpr size_t WS_COS = 96 * MB, WS_SIN = 100 * MB, WS_SA = 104 * MB, WS_SB = 105 * MB;
constexpr size_t WS_HN = 112 * MB, WS_Y = 176 * MB, WS_U = 240 * MB, WS_END = 496 * MB;
constexpr size_t U_PROJ = 64 * MB, U_CQ = 112 * MB, U_CKV = 136 * MB, U_KR = 152 * MB, U_Q = 160 * MB, U_O = 64 * MB;
constexpr size_t U_GATE = 0, U_XC = 64 * MB, U_REC = 128 * MB, U_LA = 128 * MB, U_B = 192 * MB;
constexpr size_t WS_XSA = 108 * MB, WS_XSB = 109 * MB;
constexpr size_t WS_RS = 108 * MB;
constexpr int SCAN_L = 128, SCAN_NC = SEQ / SCAN_L;

__device__ __forceinline__ unsigned f2bf(float f) { unsigned u = __float_as_uint(f); return (u + 0x7fffu + ((u >> 16) & 1u)) >> 16; }
__device__ __forceinline__ unsigned pk2(float lo, float hi) { return f2bf(lo) | (f2bf(hi) << 16); }
__device__ __forceinline__ float bflo(unsigned w) { return __uint_as_float(w << 16); }
__device__ __forceinline__ float bfhi(unsigned w) { return __uint_as_float(w & 0xffff0000u); }
__device__ __forceinline__ float bf1(u16 h) { return __uint_as_float(((unsigned)h) << 16); }
__device__ __forceinline__ float wave_sum(float v) {
    v += xor1f(v); v += xor2f(v); v += xor4f(v); v += xor8f(v); v += xor16f(v);
    return sum32f(v);
}
__device__ __forceinline__ void transpose_item(const float* W, int ldw, u16* WT, int ldt, int nblk, float* scr, int item, int lane) {
    const int kb = item / nblk, nb = item % nblk, k0 = 64 * kb, n0 = 32 * nb;
#pragma unroll
    for (int i = 0; i < 8; ++i) { const int kk = 8 * i + (lane >> 3); const f32x4 v = *(const f32x4*)(W + (size_t)(k0 + kk) * ldw + n0 + (lane & 7) * 4);
        float* s = scr + kk * 33 + (lane & 7) * 4; s[0] = v.x; s[1] = v.y; s[2] = v.z; s[3] = v.w; }
    asm volatile("s_waitcnt lgkmcnt(0)" ::: "memory");
    const int c = lane & 7;
#pragma unroll
    for (int j = 0; j < 4; ++j) { const int n = (lane >> 3) + 8 * j; const float* s = scr + (8 * c) * 33 + n;
        uint4 o; o.x = pk2(s[0 * 33], s[1 * 33]); o.y = pk2(s[2 * 33], s[3 * 33]); o.z = pk2(s[4 * 33], s[5 * 33]); o.w = pk2(s[6 * 33], s[7 * 33]);
        *(uint4*)(WT + (size_t)(n0 + n) * ldt + k0 + 8 * c) = o; }
    asm volatile("s_waitcnt lgkmcnt(0)" ::: "memory");
}
struct Params { const float* in[23]; float* out; unsigned char* ws; };
enum { I_X = 0, I_POS, I_MIXPRE, I_MIXPOST, I_FFNPRE, I_FFNPOST, I_MLA_WIN, I_MLA_QN, I_MLA_KVN, I_MLA_WUQ, I_MLA_WUKV, I_MLA_WO,
       I_LRU_WIN, I_LRU_CW, I_LRU_CB, I_LRU_WA, I_LRU_BA, I_LRU_WX, I_LRU_BX, I_LRU_LAM, I_LRU_WOUT, I_FFN_UP, I_FFN_DOWN };

__device__ __forceinline__ void prologue_weights(const __attribute__((address_space(4))) Params& p, float* scr, int gw, int NGW, int lane) {
    u16* wt = (u16*)p.ws;
    constexpr int IT_MLA = 352 + 288 + 256 + 512, IT_LRU = 1024 + 128 + 512, IT_FFN = 4096, TOTAL = 2 * IT_MLA + 2 * IT_LRU + 4 * IT_FFN;
    for (int it = gw; it < TOTAL; it += NGW) {
        int r = it; const float* W; int ldw, ldt, nblk; u16* WT;
        if (r < 2 * IT_MLA) { const int j = r / IT_MLA; r -= j * IT_MLA; u16* base = wt + WT_MLA(j) / 2;
            if (r < 352) { W = p.in[I_MLA_WIN] + (size_t)j * 1024 * 704; ldw = 704; nblk = 22; WT = base; ldt = 1024; }
            else if (r < 640) { r -= 352; W = p.in[I_MLA_WUQ] + (size_t)j * 384 * 1536; ldw = 1536; nblk = 48; WT = base + OFF_UQ / 2; ldt = 384; }
            else if (r < 896) { r -= 640; W = p.in[I_MLA_WUKV] + (size_t)j * 256 * 2048; ldw = 2048; nblk = 64; WT = base + OFF_UKV / 2; ldt = 256; }
            else { r -= 896; W = p.in[I_MLA_WO] + (size_t)j * 1024 * 1024; ldw = 1024; nblk = 32; WT = base + OFF_WO / 2; ldt = 1024; }
        } else if (r < 2 * IT_MLA + 2 * IT_LRU) { r -= 2 * IT_MLA; const int j = r / IT_LRU; r -= j * IT_LRU; u16* base = wt + WT_LRU(j) / 2;
            if (r < 1024) { W = p.in[I_LRU_WIN] + (size_t)j * 1024 * 2048; ldw = 2048; nblk = 64; WT = base; ldt = 1024; }
            else if (r < 1152) { r -= 1024; const int which = r >> 3, gt = which >> 3, n = which & 7; r &= 7;
                W = p.in[gt ? I_LRU_WX : I_LRU_WA] + (size_t)j * 8 * 128 * 128 + (size_t)n * 128 * 128; ldw = 128; nblk = 4;
                WT = base + OFF_GT / 2 + (size_t)(n * 256 + gt * 128) * 256 + 128 * (n & 1); ldt = 256; }
            else { r -= 1152; W = p.in[I_LRU_WOUT] + (size_t)j * 1024 * 1024; ldw = 1024; nblk = 32; WT = base + OFF_LOUT / 2; ldt = 1024; }
        } else { r -= 2 * IT_MLA + 2 * IT_LRU; const int l = r / IT_FFN; r -= l * IT_FFN; u16* base = wt + WT_FFN(l) / 2;
            if (r < 2048) { W = p.in[I_FFN_UP] + (size_t)l * 1024 * 4096; ldw = 4096; nblk = 128; WT = base; ldt = 1024; }
            else { r -= 2048; W = p.in[I_FFN_DOWN] + (size_t)l * 4096 * 1024; ldw = 1024; nblk = 32; WT = base + OFF_DOWN / 2; ldt = 4096; }
        }
        transpose_item(W, ldw, WT, ldt, nblk, scr, r, lane);
    }
}
__device__ __forceinline__ void rowop(const u16* y, const float* xin, float* xout, u16* hn, float* rs, const float* gpost, const float* gpre, int gw, int NGW, int lane) {
    f32x4 gp[4], gq[4];
#pragma unroll
    for (int j = 0; j < 4; ++j) { gp[j] = gpost ? *(const f32x4*)(gpost + j * 256 + lane * 4) : (f32x4){0.f, 0.f, 0.f, 0.f}; gq[j] = gpre ? *(const f32x4*)(gpre + j * 256 + lane * 4) : (f32x4){0.f, 0.f, 0.f, 0.f}; }
    for (int row = gw; row < M; row += NGW) {
        f32x4 xv[4];
#pragma unroll
        for (int j = 0; j < 4; ++j) xv[j] = *(const f32x4*)(xin + (size_t)row * D + j * 256 + lane * 4);
        if (y) {
            f32x4 yv[4]; float ss = 0.f;
#pragma unroll
            for (int j = 0; j < 4; ++j) { const uint2 w = *(const uint2*)(y + (size_t)row * D + j * 256 + lane * 4);
                yv[j] = (f32x4){bflo(w.x), bfhi(w.x), bflo(w.y), bfhi(w.y)}; ss += (yv[j].x * yv[j].x + yv[j].y * yv[j].y) + (yv[j].z * yv[j].z + yv[j].w * yv[j].w); }
            const float r = rsqrtf(wave_sum(ss) * (1.f / D) + EPS);
#pragma unroll
            for (int j = 0; j < 4; ++j) xv[j] = xv[j] + (yv[j] * r) * gp[j];
        }
        if (xout) {
#pragma unroll
        for (int j = 0; j < 4; ++j) *(f32x4*)(xout + (size_t)row * D + j * 256 + lane * 4) = xv[j]; }
        if (gpre) {
            float s2 = 0.f;
#pragma unroll
            for (int j = 0; j < 4; ++j) s2 += (xv[j].x * xv[j].x + xv[j].y * xv[j].y) + (xv[j].z * xv[j].z + xv[j].w * xv[j].w);
            const float tot2 = wave_sum(s2); const float r2 = 1.0f;
            if (rs && lane < 4) rs[(size_t)row * 4 + lane] = lane == 0 ? tot2 : 0.f;
#pragma unroll
            for (int j = 0; j < 4; ++j) { const f32x4 h = (xv[j] * r2) * gq[j]; uint2 w; w.x = pk2(h.x, h.y); w.y = pk2(h.z, h.w);
                *(uint2*)(hn + (size_t)row * D + j * 256 + lane * 4) = w; }
        }
    }
}
__device__ __forceinline__ void qkvnorm(const u16* proj, u16* cq, u16* ckv, u16* kr, const float* qn, const float* kvn, const float* ctab, const float* stab, const float* rss, int gw, int NGW, int lane) {
    float gA[8], gB[8];
    { const float* gp = lane < 48 ? qn + 8 * lane : kvn + (8 * lane - 384); const f32x4 g0 = *(const f32x4*)gp, g1 = *(const f32x4*)(gp + 4);
      gA[0] = g0[0]; gA[1] = g0[1]; gA[2] = g0[2]; gA[3] = g0[3]; gA[4] = g1[0]; gA[5] = g1[1]; gA[6] = g1[2]; gA[7] = g1[3]; }
    { f32x4 g0 = {0.f, 0.f, 0.f, 0.f}, g1 = {0.f, 0.f, 0.f, 0.f}; if (lane < 16) { g0 = *(const f32x4*)(kvn + 128 + 8 * lane); g1 = *(const f32x4*)(kvn + 132 + 8 * lane); }
      gB[0] = g0[0]; gB[1] = g0[1]; gB[2] = g0[2]; gB[3] = g0[3]; gB[4] = g1[0]; gB[5] = g1[1]; gB[6] = g1[2]; gB[7] = g1[3]; }
    const bool ropeL = lane >= 16 && lane < 24; const int rk = (lane & 3) * 8;
    const int cOff = lane < 20 ? 672 + rk : 640 + rk;
    for (int row0 = gw; row0 < M; row0 += 2 * NGW) {
        float A[2][8], B[2][8], C[2][8], rsc[2], sa[2], sb[2];
#pragma unroll
        for (int q = 0; q < 2; ++q) { const int row = row0 + q * NGW; const u16* pr = proj + (size_t)row * 768;
            const f32x4 pp = *(const f32x4*)(rss + (size_t)row * 4); rsc[q] = rsqrtf(((pp[0] + pp[1]) + (pp[2] + pp[3])) * (1.f / D) + EPS);
            const uint4 a = *(const uint4*)(pr + 8 * lane); uint4 b = make_uint4(0u, 0u, 0u, 0u), c = make_uint4(0u, 0u, 0u, 0u);
            if (lane < 24) b = *(const uint4*)(pr + 512 + 8 * lane);
            if (ropeL) c = *(const uint4*)(pr + cOff);
            A[q][0] = bflo(a.x); A[q][1] = bfhi(a.x); A[q][2] = bflo(a.y); A[q][3] = bfhi(a.y); A[q][4] = bflo(a.z); A[q][5] = bfhi(a.z); A[q][6] = bflo(a.w); A[q][7] = bfhi(a.w);
            B[q][0] = bflo(b.x); B[q][1] = bfhi(b.x); B[q][2] = bflo(b.y); B[q][3] = bfhi(b.y); B[q][4] = bflo(b.z); B[q][5] = bfhi(b.z); B[q][6] = bflo(b.w); B[q][7] = bfhi(b.w);
            C[q][0] = bflo(c.x); C[q][1] = bfhi(c.x); C[q][2] = bflo(c.y); C[q][3] = bfhi(c.y); C[q][4] = bflo(c.z); C[q][5] = bfhi(c.z); C[q][6] = bflo(c.w); C[q][7] = bfhi(c.w); }
#pragma unroll
        for (int q = 0; q < 2; ++q) { sa[q] = 0.f; sb[q] = 0.f;
#pragma unroll
            for (int e = 0; e < 8; ++e) { A[q][e] *= rsc[q]; B[q][e] *= rsc[q]; C[q][e] *= rsc[q]; sa[q] += A[q][e] * A[q][e]; sb[q] += B[q][e] * B[q][e]; } }
        float r1[2], r2[2];
#pragma unroll
        for (int q = 0; q < 2; ++q) { const float s1 = wave_sum(lane < 48 ? sa[q] : 0.f), s2 = wave_sum((lane >= 48 ? sa[q] : 0.f) + (lane < 16 ? sb[q] : 0.f));
            r1[q] = rsqrtf(s1 * (1.f / 384.f) + EPS); r2[q] = rsqrtf(s2 * (1.f / 256.f) + EPS); }
#pragma unroll
        for (int q = 0; q < 2; ++q) { const int row = row0 + q * NGW;
            { const float r = lane < 48 ? r1[q] : r2[q]; uint4 o; o.x = pk2(A[q][0] * r * gA[0], A[q][1] * r * gA[1]); o.y = pk2(A[q][2] * r * gA[2], A[q][3] * r * gA[3]);
              o.z = pk2(A[q][4] * r * gA[4], A[q][5] * r * gA[5]); o.w = pk2(A[q][6] * r * gA[6], A[q][7] * r * gA[7]);
              if (lane < 48) *(uint4*)(cq + (size_t)row * 384 + 8 * lane) = o; else *(uint4*)(ckv + (size_t)row * 256 + (8 * lane - 384)) = o; }
            if (lane < 16) { const float r = r2[q]; uint4 o; o.x = pk2(B[q][0] * r * gB[0], B[q][1] * r * gB[1]); o.y = pk2(B[q][2] * r * gB[2], B[q][3] * r * gB[3]);
              o.z = pk2(B[q][4] * r * gB[4], B[q][5] * r * gB[5]); o.w = pk2(B[q][6] * r * gB[6], B[q][7] * r * gB[7]);
              *(uint4*)(ckv + (size_t)row * 256 + 128 + 8 * lane) = o; }
            if (ropeL) { const f32x4 c0 = *(const f32x4*)(ctab + (size_t)row * 32 + rk), c1 = *(const f32x4*)(ctab + (size_t)row * 32 + rk + 4), s0 = *(const f32x4*)(stab + (size_t)row * 32 + rk), s1 = *(const f32x4*)(stab + (size_t)row * 32 + rk + 4);
              float ov[8];
#pragma unroll
              for (int e = 0; e < 8; ++e) { const float cc = e < 4 ? c0[e & 3] : c1[e & 3], ss = e < 4 ? s0[e & 3] : s1[e & 3];
                  ov[e] = lane < 20 ? B[q][e] * cc - C[q][e] * ss
                                    : B[q][e] * cc + C[q][e] * ss; }
              uint4 o; o.x = pk2(ov[0], ov[1]); o.y = pk2(ov[2], ov[3]); o.z = pk2(ov[4], ov[5]); o.w = pk2(ov[6], ov[7]);
              *(uint4*)(kr + (size_t)row * 64 + (lane < 20 ? 0 : 32) + rk) = o; }
        }
    }
}
__device__ __forceinline__ void qrope(u16* q, const float* ctab, const float* stab, int gw, int NGW, int lane) {
    for (int row = gw; row < M; row += NGW) {
        u16* qr = q + (size_t)row * 1536; const int i = lane & 31;
        const float c = ctab[(size_t)row * 32 + i], s = stab[(size_t)row * 32 + i];
#pragma unroll
        for (int j = 0; j < 4; ++j) { const int h = 2 * j + (lane >> 5); u16* pp = qr + h * 192 + 128 + i;
            const float x1 = bf1(pp[0]), x2 = bf1(pp[32]);
            pp[0] = (u16)f2bf(x1 * c - x2 * s); pp[32] = (u16)f2bf(x2 * c + x1 * s); }
    }
}
__device__ __forceinline__ void conv_phase(const u16* rec, u16* xc, const float* cw, const float* cb, int gtid, int NGT) {
    for (int idx = gtid; idx < (M / 32) * 128; idx += NGT) {
        const int r0 = (idx >> 7) * 32, c0 = (idx & 127) * 8;
        float w[4][8], bias[8], win[3][8];
#pragma unroll
        for (int e = 0; e < 8; ++e) { bias[e] = cb[c0 + e];
#pragma unroll
            for (int k = 0; k < 4; ++k) w[k][e] = cw[k * D + c0 + e]; }
        const bool first = (r0 & (SEQ - 1)) == 0;
#pragma unroll
        for (int k = 0; k < 3; ++k) { uint4 v = make_uint4(0u, 0u, 0u, 0u); if (!first) v = *(const uint4*)(rec + (size_t)(r0 - 3 + k) * D + c0);
            win[k][0] = bflo(v.x); win[k][1] = bfhi(v.x); win[k][2] = bflo(v.y); win[k][3] = bfhi(v.y); win[k][4] = bflo(v.z); win[k][5] = bfhi(v.z); win[k][6] = bflo(v.w); win[k][7] = bfhi(v.w); }
        for (int i0 = 0; i0 < 32; i0 += 8) {
            uint4 in[8];
#pragma unroll
            for (int u = 0; u < 8; ++u) in[u] = *(const uint4*)(rec + (size_t)(r0 + i0 + u) * D + c0);
#pragma unroll
            for (int u = 0; u < 8; ++u) {
                const float x[8] = {bflo(in[u].x), bfhi(in[u].x), bflo(in[u].y), bfhi(in[u].y), bflo(in[u].z), bfhi(in[u].z), bflo(in[u].w), bfhi(in[u].w)};
                float acc[8];
#pragma unroll
                for (int e = 0; e < 8; ++e) { acc[e] = bias[e] + win[0][e] * w[0][e] + win[1][e] * w[1][e] + win[2][e] * w[2][e] + x[e] * w[3][e]; win[0][e] = win[1][e]; win[1][e] = win[2][e]; win[2][e] = x[e]; }
                uint4 o; o.x = pk2(acc[0], acc[1]); o.y = pk2(acc[2], acc[3]); o.z = pk2(acc[4], acc[5]); o.w = pk2(acc[6], acc[7]);
                *(uint4*)(xc + (size_t)(r0 + i0 + u) * D + c0) = o;
            }
        }
    }
}
__device__ __forceinline__ void scanA(const u16* A, const u16* B, float* SA, float* SB, int tid) {
    for (int item = blockIdx.x; item < 2 * SCAN_NC; item += gridDim.x) {
        const int c = item % SCAN_NC, b = item / SCAN_NC, ch = 2 * tid;
        const size_t base = ((size_t)b * SEQ + (size_t)c * SCAN_L) * D + ch;
        float h0 = 0.f, h1 = 0.f, P0 = 1.f, P1 = 1.f;
        for (int t0 = 0; t0 < SCAN_L; t0 += 32) {
            unsigned aw[32], bw[32];
#pragma unroll
            for (int u = 0; u < 32; ++u) { aw[u] = *(const unsigned*)(A + base + (size_t)(t0 + u) * D); bw[u] = *(const unsigned*)(B + base + (size_t)(t0 + u) * D); }
#pragma unroll
            for (int u = 0; u < 32; ++u) { const float a0 = __expf(bflo(aw[u])), a1 = __expf(bfhi(aw[u])); h0 = a0 * h0 + bflo(bw[u]); h1 = a1 * h1 + bfhi(bw[u]); P0 *= a0; P1 *= a1; }
        }
        const size_t so = ((size_t)b * SCAN_NC + c) * D + ch;
        *(float2*)(SA + so) = make_float2(P0, P1); *(float2*)(SB + so) = make_float2(h0, h1);
    }
}
__device__ __forceinline__ void scanC(const u16* A, const u16* B, const float* SA, const float* SB, const u16* gate, u16* hg, int tid) {
    for (int item = blockIdx.x; item < 2 * SCAN_NC; item += gridDim.x) {
        const int c = item % SCAN_NC, b = item / SCAN_NC, ch = 2 * tid;
        const size_t base = ((size_t)b * SEQ + (size_t)c * SCAN_L) * D + ch;
        float h0 = 0.f, h1 = 0.f;
        for (int cc0 = 0; cc0 < c; cc0 += 16) {
            float2 pa[16], pb[16];
#pragma unroll
            for (int u = 0; u < 16; ++u) { const int cc = cc0 + u < c ? cc0 + u : c - 1; const size_t so = ((size_t)b * SCAN_NC + cc) * D + ch; pa[u] = *(const float2*)(SA + so); pb[u] = *(const float2*)(SB + so); }
#pragma unroll
            for (int u = 0; u < 16; ++u) { const bool in = cc0 + u < c; const float ax = in ? pa[u].x : 1.f, ay = in ? pa[u].y : 1.f, bx = in ? pb[u].x : 0.f, by = in ? pb[u].y : 0.f; h0 = ax * h0 + bx; h1 = ay * h1 + by; }
        }
        for (int t0 = 0; t0 < SCAN_L; t0 += 16) {
            unsigned aw[16], bw[16], gv[16];
#pragma unroll
            for (int u = 0; u < 16; ++u) { aw[u] = *(const unsigned*)(A + base + (size_t)(t0 + u) * D); bw[u] = *(const unsigned*)(B + base + (size_t)(t0 + u) * D); gv[u] = *(const unsigned*)(gate + base + (size_t)(t0 + u) * D); }
#pragma unroll
            for (int u = 0; u < 16; ++u) { h0 = __expf(bflo(aw[u])) * h0 + bflo(bw[u]); h1 = __expf(bfhi(aw[u])) * h1 + bfhi(bw[u]);
                *(unsigned*)(hg + base + (size_t)(t0 + u) * D) = pk2(bflo(gv[u]) * h0, bfhi(gv[u]) * h1); }
        }
    }
}

constexpr int LDS_GEMM = pg8::STAGE_BYTES + 8192, LDS_MAIN = att::LDS_BYTES > LDS_GEMM ? att::LDS_BYTES : LDS_GEMM, LDS_BYTES = LDS_MAIN + 16;
constexpr size_t WS_BAR = 106 * MB;
constexpr size_t WS_CNT1 = WS_BAR + 16384, WS_CNT2 = WS_BAR + 49152, CTL_BYTES = 81920, WS_XS1 = 107 * MB, WS_XS2 = 107 * MB + MB / 2;
constexpr int XL_OFF = 131072;
static_assert(XL_OFF + 8192 <= LDS_MAIN && XCD_BAR_WORDS * 4 <= 16384 && att::LDS_BYTES <= LDS_MAIN && pg8::STAGE_BYTES <= LDS_MAIN && LDS_BYTES <= 160 * 1024, "LDS map");

__global__ void __launch_bounds__(512, 2) fwd_mega(Params p_arg) {
    extern __shared__ __attribute__((aligned(16))) unsigned char lds[];
    cg::grid_group grid = cg::this_grid();
    (void)p_arg;
    volatile __attribute__((address_space(3))) unsigned* bst = (volatile __attribute__((address_space(3))) unsigned*)((__attribute__((address_space(3))) unsigned char*)lds + LDS_MAIN);
    if (threadIdx.x < 4) bst[threadIdx.x] = 0u;
    __syncthreads();
    const int wave_s = __builtin_amdgcn_readfirstlane(threadIdx.x >> 6);
    const unsigned bar_x = xb::xb_xcc_id();
    (void)xb::xcd_barrier_post((unsigned*)(p_arg.ws + WS_BAR), bst);
#define GRID_BAR() do { unsigned bx_ = bar_x; asm volatile("" : "+s"(bx_)); xb::XcdBarrier bb_; bb_.bar = (unsigned*)(ws + WS_BAR); bb_.x = bx_; bb_.st = bst; xb::xcd_barrier(bb_, tid == 0); } while (0)
    typedef const __attribute__((address_space(4))) Params* KParams;
    KParams pp = (KParams)__builtin_amdgcn_kernarg_segment_ptr();
#define FRESH() int tid_ = wave_s * 64 + lane_id_fresh(); asm volatile("" : "+v"(tid_)); asm volatile("" : "+s"(pp)); const __attribute__((address_space(4))) Params& p = *pp; \
    const int tid = tid_, lane = tid & 63, wave = __builtin_amdgcn_readfirstlane(tid >> 6); \
    const int G = gridDim.x, gw = blockIdx.x * 8 + wave, NGW = G * 8, gtid = blockIdx.x * 512 + tid, NGT = G * 512; \
    unsigned char* ws = p.ws; float* x = p.out; u16* hn = (u16*)(ws + WS_HN); u16* ybuf = (u16*)(ws + WS_Y); unsigned char* U = ws + WS_U; \
    float* ctab = (float*)(ws + WS_COS); float* stab = (float*)(ws + WS_SIN); float* SA = (float*)(ws + WS_SA); float* SB = (float*)(ws + WS_SB); \
    (void)lane; (void)wave; (void)gw; (void)NGW; (void)gtid; (void)NGT; (void)x; (void)hn; (void)ybuf; (void)U; (void)ctab; (void)stab; (void)SA; (void)SB;
    {
    FRESH();

    for (int prep = 0; prep < PROBE_PRO_REPS; ++prep) {
    prologue_weights(p, (float*)lds + wave * (64 * 33), gw, NGW, lane);
    for (int i = gtid; i < 2 * 2048 * 16; i += NGT) { const int j = i >> 15, row = (i >> 4) & 2047, chn = i & 15, n = row >> 8;
        *(uint4*)((u16*)(ws + WT_LRU(j) + OFF_GT) + (size_t)row * 256 + 128 * ((n & 1) ^ 1) + chn * 8) = make_uint4(0u, 0u, 0u, 0u); }
    { const int* pos = (const int*)p.in[I_POS];
      for (int i = gtid; i < M * 32; i += NGT) { const int row = i >> 5, f = i & 31;
        const float inv = __builtin_amdgcn_exp2f(-(float)f * (13.287712379549449f / 32.f));
        const float ang = (float)pos[row] * inv;
        double rev = (double)ang * 0.15915494309189535; rev -= __builtin_rint(rev);
        ctab[i] = __builtin_amdgcn_cosf((float)rev); stab[i] = __builtin_amdgcn_sinf((float)rev); } }
    rowop(nullptr, p.in[I_X], nullptr, hn, (float*)(ws + WS_XSB), nullptr, p.in[I_MIXPRE], gw, NGW, lane);
    }
    if (ws == nullptr) grid.sync();
    GRID_BAR();
    }

#pragma nounroll
    for (int layer = 0; layer < 4; ++layer) {
#pragma nounroll
        for (int op = 0; op < 10; ++op) {
            FRESH();
            const int j = layer >> 1; const bool lru = (layer & 1) != 0;
            const u16* wtm = (const u16*)(ws + WT_MLA(j)); const u16* wtl = (const u16*)(ws + WT_LRU(j)); const u16* wtf = (const u16*)(ws + WT_FFN(layer));
            int gk = 0;
            pg8::Gemm g{}; pg8::EpiB E{};
            if (op == 6 || op == 9) continue;
            const float* gprev = p.in[op == 5 ? I_MIXPRE : I_FFNPRE] + layer * D;
            const float* gpost = p.in[op == 5 ? I_MIXPOST : I_FFNPOST] + layer * D;
            const float* gpre = op == 5 ? p.in[I_FFNPRE] + layer * D : (layer < 3 ? p.in[I_MIXPRE] + (layer + 1) * D : nullptr);
            if (op == 7) { gk = 1; g = pg8::Gemm{hn, wtf, M, 4096, 1024, 1024, 1024, 0}; E = pg8::EpiB{(u16*)U, 4096, 0, 0, 1, nullptr}; }
            else if (op == 8) { gk = 3; g = pg8::Gemm{(const u16*)U, wtf + OFF_DOWN / 2, M, 1024, 4096, 4096, 4096, 0}; }
            else if (!lru) {
                u16* proj = (u16*)(U + U_PROJ); u16* cq = (u16*)(U + U_CQ); u16* ckv = (u16*)(U + U_CKV); u16* kr = (u16*)(U + U_KR); u16* q = (u16*)(U + U_Q); u16* o = (u16*)(U + U_O); u16* kv = ybuf;
                if (op == 0) { gk = 1; g = pg8::Gemm{hn, wtm, M, 768, 1024, 1024, 1024, 0}; E = pg8::EpiB{proj, 768, 0, 0, 0, nullptr}; }
                else if (op == 1) for (int rep = 0; rep < PROBE_THIN_REPS; ++rep) qkvnorm(proj, cq, ckv, kr, p.in[I_MLA_QN] + j * 384, p.in[I_MLA_KVN] + j * 256, ctab, stab, (const float*)(ws + WS_XSB), gw, NGW, lane);
                else if (op == 2) { gk = 1; g = pg8::Gemm{cq, wtm + OFF_UQ / 2, M, 1536, 384, 384, 384, 0}; E = pg8::EpiB{q, 1536, 0, 0, 0, nullptr}; }
                else if (op == 3) { gk = 1; g = pg8::Gemm{ckv, wtm + OFF_UKV / 2, M, 2048, 256, 256, 256, 0}; E = pg8::EpiB{kv, 2048, 0, 0, 0, nullptr}; }
                else if (op == 4) { const att::Tensors T{q, kv, kr, o, ctab, stab}; for (int rep = 0; rep < PROBE_ATT_REPS; ++rep) att::attn_phase((char*)lds, T, tid); }
                else { gk = 3; g = pg8::Gemm{o, wtm + OFF_WO / 2, M, 1024, 1024, 1024, 1024, 0}; }
            } else {
                u16* gate = (u16*)(U + U_GATE); u16* xc = (u16*)(U + U_XC); u16* rec = (u16*)(U + U_REC); u16* Bb = (u16*)(U + U_B); u16* Ab = (u16*)(U + U_LA); u16* hg = xc;
                if (op == 0) { gk = 1; g = pg8::Gemm{hn, wtl, M, 2048, 1024, 1024, 1024, 0}; E = pg8::EpiB{gate, 1024, 1024, (size_t)(U_REC - U_GATE) / 2, 2, (const float*)(ws + WS_XSB)}; }
                else if (op == 1) for (int rep = 0; rep < PROBE_THIN_REPS; ++rep) conv_phase(rec, xc, p.in[I_LRU_CW] + j * 4 * D, p.in[I_LRU_CB] + j * D, gtid, NGT);
                else if (op == 2) { gk = 2; g = pg8::Gemm{xc, wtl + OFF_GT / 2, M, 2048, 256, 1024, 256, 512}; }
                else if (op == 3) for (int rep = 0; rep < PROBE_THIN_REPS; ++rep) scanA(Ab, Bb, SA, SB, tid);
                else if (op == 4) for (int rep = 0; rep < PROBE_THIN_REPS; ++rep) scanC(Ab, Bb, SA, SB, gate, hg, tid);
                else { gk = 3; g = pg8::Gemm{hg, wtl + OFF_LOUT / 2, M, 1024, 1024, 1024, 1024, 0}; }
            }
            if (STAGGER_TICKS > 0 && op == 7) {
                unsigned bx_ = bar_x; asm volatile("" : "+s"(bx_));
                const unsigned long long t0_ = __builtin_amdgcn_s_memrealtime(), want_ = (unsigned long long)(bx_ & 7u) * STAGGER_TICKS;
                while (__builtin_amdgcn_s_memrealtime() - t0_ < want_) __builtin_amdgcn_s_sleep(8); }
            for (int rep = 0; rep < ((gk != 3 && (PROBE_GEMM_OP == -1 || op == PROBE_GEMM_OP || (PROBE_GEMM_OP == -2 && op != 7))) ? PROBE_GEMM_REPS : 1); ++rep)
            if (gk == 1) { pg8::StaticOrder S; S.init(g.M, g.N, G, (int)blockIdx.x);
                pg8::gemm_phase<pg8::EpiB, pg8::StaticOrder, true>((PG8_LAS unsigned char*)lds, g, S, E, tid); }
            else if (gk == 2) { pg8::StaticOrder S; S.init(g.M, g.N, G, (int)blockIdx.x);
                const pg8::EpiGate EG{(const u16*)(U + U_XC), (u16*)(U + U_LA), (u16*)(U + U_B), p.in[I_LRU_BA] + j * D, p.in[I_LRU_BX] + j * D, p.in[I_LRU_LAM] + j * D};
                pg8::gemm_phase<pg8::EpiGate, pg8::StaticOrder, true>((PG8_LAS unsigned char*)lds, g, S, EG, tid); }
            else if (gk == 3) { pg8::StaticOrder S; S.init(g.M, g.N, G, (int)blockIdx.x);
                const unsigned target = 32u * (unsigned)(layer * 2 + (op == 8 ? 2 : 1));
                const pg8::RowStats st1{(float*)(ws + WS_XS1), (unsigned*)(ws + WS_CNT1), target};
                const pg8::EpiNormRes EN{hn, (float*)(ws + (op == 8 ? WS_XSB : WS_XSA)), x, gprev, gpost, gpre, st1, (PG8_LAS unsigned char*)lds + XL_OFF, op == 8 ? (const float*)(ws + WS_XSA) : nullptr};
                pg8::gemm_phase<pg8::EpiNormRes, pg8::StaticOrder, true>((PG8_LAS unsigned char*)lds, g, S, EN, tid); }
            if (!(layer == 3 && op == 8) && !(!lru && op == 2)) { for (int rep = 0; rep < PROBE_SYNC_REPS; ++rep) GRID_BAR(); }
        }
    }
}
}

extern "C" void kernel_launch(void* const* d_in, const int* in_sizes, int n_in, void* d_out, int out_size, void* d_ws, size_t ws_size, hipStream_t stream) {
    static int grid = 0;
    if (grid == 0) {
        if (n_in != 23 || in_sizes[0] != mk::M * mk::D || out_size != mk::M * mk::D || ws_size < mk::WS_END) {
            fprintf(stderr, "kernel_launch: unexpected shapes (n_in %d, in0 %d, out %d, ws %zu); nothing launched\n", n_in, n_in > 0 ? in_sizes[0] : -1, out_size, ws_size); grid = -1; return; }
        int dev = 0, cus = 0, per_cu = 0;
        (void)hipGetDevice(&dev); (void)hipDeviceGetAttribute(&cus, hipDeviceAttributeMultiprocessorCount, dev);
        if (hipFuncSetAttribute((const void*)mk::fwd_mega, hipFuncAttributeMaxDynamicSharedMemorySize, mk::LDS_BYTES) != hipSuccess) { fprintf(stderr, "kernel_launch: hipFuncSetAttribute failed\n"); grid = -1; return; }
        if (hipOccupancyMaxActiveBlocksPerMultiprocessor(&per_cu, (const void*)mk::fwd_mega, 512, mk::LDS_BYTES) != hipSuccess || per_cu < 1) { fprintf(stderr, "kernel_launch: occupancy query says %d blocks per CU\n", per_cu); per_cu = 1; }
        (void)hipGetLastError();
        grid = cus > 0 ? cus : 256;
    }
    if (grid < 0) return;
    mk::Params p{};
    for (int i = 0; i < 23; ++i) p.in[i] = (const float*)d_in[i];
    p.out = (float*)d_out; p.ws = (unsigned char*)d_ws;
    if (hipMemsetAsync((char*)d_ws + mk::WS_BAR, 0, mk::CTL_BYTES, stream) != hipSuccess) { fprintf(stderr, "kernel_launch: hipMemsetAsync failed\n"); return; }
    void* args[] = {&p};
    hipError_t e = hipLaunchCooperativeKernel((const void*)mk::fwd_mega, dim3(grid), dim3(512), args, mk::LDS_BYTES, stream);
    if (e != hipSuccess) fprintf(stderr, "kernel_launch: cooperative launch failed: %s (grid %d)\n", hipGetErrorString(e), grid);
}
```

```cpp
#include <hip/hip_runtime.h>
#include <hip/hip_bf16.h>
#include <hip/hip_cooperative_groups.h>
#include <cstdio>
#include <cstdint>
namespace cg = cooperative_groups;

__device__ __forceinline__ float xor1f(float v)  { return __int_as_float(__builtin_amdgcn_mov_dpp(__float_as_int(v), 0xB1, 0xF, 0xF, false)); }
__device__ __forceinline__ float xor2f(float v)  { return __int_as_float(__builtin_amdgcn_mov_dpp(__float_as_int(v), 0x4E, 0xF, 0xF, false)); }
__device__ __forceinline__ float xor4f(float v)  { return __int_as_float(__builtin_amdgcn_ds_swizzle(__float_as_int(v), 0x101F)); }
__device__ __forceinline__ float xor8f(float v)  { return __int_as_float(__builtin_amdgcn_ds_swizzle(__float_as_int(v), 0x201F)); }
__device__ __forceinline__ float xor16f(float v) { return __int_as_float(__builtin_amdgcn_ds_swizzle(__float_as_int(v), 0x401F)); }
__device__ __forceinline__ float sum32f(float v) { auto rr = __builtin_amdgcn_permlane32_swap(__float_as_uint(v), __float_as_uint(v), false, false); return __uint_as_float(rr[0]) + __uint_as_float(rr[1]); }
__device__ __forceinline__ int lane_id_fresh() { int l; asm volatile("v_mbcnt_lo_u32_b32 %0, -1, 0\n\tv_mbcnt_hi_u32_b32 %0, -1, %0" : "=v"(l)); return l; }
namespace pg8 {
#define PG8_LAS __attribute__((address_space(3)))
typedef unsigned short bf16_t;
typedef short bf16x8 __attribute__((ext_vector_type(8)));
typedef float f32x4 __attribute__((ext_vector_type(4)));
typedef unsigned u32x4 __attribute__((ext_vector_type(4)));
constexpr int BM = 256, BK = 64, HALF = 128, HTB = HALF * BK * 2  , STAGE_BYTES = 8 * HTB, NXCD = 8, WGM = 8;

__host__ __device__ __forceinline__ int lds_byte(int r, int c) { const int st = (r >> 4) * 2 + (c >> 5), rr = r & 15, cc = c & 31, ob = rr * 64 + cc * 2; return st * 1024 + (ob ^ (((ob >> 9) & 1) << 5)); }
__host__ __device__ __forceinline__ void stage_rc(int b, int& R, int& C) { const int st = b / 1024, sb = b % 1024, swz = sb ^ (((sb >> 9) & 1) << 5); R = (st >> 1) * 16 + swz / 64; C = (st & 1) * 32 + (swz % 64) / 2; }
__host__ __device__ __forceinline__ int perm32(int rho) { const int n = rho >> 4, i = rho & 15; return 8 * (i >> 2) + 4 * n + (i & 3); }

struct Unit { int pm, pn; };
struct Gemm { const bf16_t* A; const bf16_t* Bt; int M, N, K; int lda, ldb; int apn; };

struct StaticOrder {
    int nM, nN, nwg, G, c;
    __host__ __device__ void init(int M, int N, int G_, int c_) { nM = M / BM; nN = N / BM; nwg = nM * nN; G = G_; c = c_; }
    __host__ __device__ bool next(int i, Unit& u) const {
        const long L = (long)i * G + c; if (L >= nwg) return false;
        int wgid = (int)L; { const int q = nwg / NXCD, r = nwg % NXCD, xcd = wgid % NXCD, off = wgid / NXCD; wgid = (xcd < r ? xcd * (q + 1) : r * (q + 1) + (xcd - r) * q) + off; }
        const int nig = WGM * nN, gid = wgid / nig, fm = gid * WGM, gsz = (nM - fm) < WGM ? (nM - fm) : WGM;
        u.pm = fm + ((wgid % nig) % gsz); u.pn = (wgid % nig) / gsz; return true;
    }
    __device__ __forceinline__ void a_ready(const Unit&) const {}
    __device__ __forceinline__ void done(const Unit&) const {}
};

__device__ __forceinline__ unsigned cvt_pk_bf16(float lo, float hi) { unsigned r; asm volatile("v_cvt_pk_bf16_f32 %0, %1, %2" : "=v"(r) : "v"(lo), "v"(hi)); return r; }
__device__ __forceinline__ float gelu_tanh(float x) {
    const float z = 0.7978845608028654f * (x + 0.044715f * x * x * x);
    const float e = __expf(2.0f * z);
    const float th = 1.0f - 2.0f * __builtin_amdgcn_rcpf(1.0f + e);
    return 0.5f * x * (1.0f + th);
}
struct EpiB {
    static constexpr bool PERM = true, AFTER_DRAIN = false, FUSED = false;
    bf16_t* O; int ldc; int split_cols; size_t split_stride; int mode;
    const float* rss;
    __device__ __forceinline__ void operator()(const f32x4 (&acc)[2][2][4][2], const Unit& u, int wr, int wc, int fr, int fq) const {
        const int row0 = u.pm * BM + wr * 64 + fr; int colt = u.pn * BM; bf16_t* base = O; int t = 0;
        if (split_cols) { t = colt / split_cols; base += (size_t)t * split_stride; colt -= t * split_cols; }
        const int act = (mode == 1) ? 1 : ((mode == 2 && t == 0) ? 2 : 0);
        const int col0 = colt + wc * 32 + 8 * fq;
#pragma unroll
        for (int ai = 0; ai < 2; ++ai)
#pragma unroll
            for (int m = 0; m < 4; ++m) { bf16_t* rowp = base + (size_t)(row0 + ai * HALF + m * 16) * ldc + col0;
                float rsc = 1.0f; if (rss) { const f32x4 pp = *(const f32x4*)(rss + (size_t)(row0 + ai * HALF + m * 16) * 4); rsc = rsqrtf(((pp[0] + pp[1]) + (pp[2] + pp[3])) * (1.0f / 1024.0f) + 1e-6f); }
#pragma unroll
                for (int bj = 0; bj < 2; ++bj) { f32x4 v0 = acc[ai][bj][m][0] * rsc, v1 = acc[ai][bj][m][1] * rsc;
                    if (act == 1) {
#pragma unroll
                        for (int e = 0; e < 4; ++e) { const float a = fmaxf(v0[e], 0.f), b = fmaxf(v1[e], 0.f); v0[e] = a * a; v1[e] = b * b; } }
                    else if (act == 2) {
#pragma unroll
                        for (int e = 0; e < 4; ++e) { v0[e] = gelu_tanh(v0[e]); v1[e] = gelu_tanh(v1[e]); } }
                    u32x4 w; w.x = cvt_pk_bf16(v0[0], v0[1]); w.y = cvt_pk_bf16(v0[2], v0[3]); w.z = cvt_pk_bf16(v1[0], v1[1]); w.w = cvt_pk_bf16(v1[2], v1[3]);
                    *(u32x4*)(rowp + bj * HALF) = w; } }
    }
};
__device__ __forceinline__ float bf2f(unsigned short h) { return __uint_as_float(((unsigned)h) << 16); }
__device__ __forceinline__ float sigmoidf_(float x) { return __builtin_amdgcn_rcpf(1.0f + __expf(-x)); }
__device__ __forceinline__ float one_minus_exp(float t) { const float ser = -t * (1.0f + t * (0.5f + t * (0.16666667f + t * (0.041666668f + t * 0.008333334f)))); return t > -0.25f ? ser : 1.0f - __expf(t); }
struct EpiGate {
    static constexpr bool PERM = false, AFTER_DRAIN = false, FUSED = false;
    const bf16_t* xc; bf16_t* Aout; bf16_t* Bout; const float* b_a; const float* b_x; const float* lam;
    __device__ __forceinline__ void operator()(const f32x4 (&acc)[2][2][4][2], const Unit& u, int wr, int wc, int fr, int fq) const {
#pragma unroll
        for (int n = 0; n < 2; ++n) {
            const int ch0 = 128 * u.pn + 32 * wc + 16 * n + 4 * fq;
            const f32x4 ba = *(const f32x4*)(b_a + ch0), bx = *(const f32x4*)(b_x + ch0), lm = *(const f32x4*)(lam + ch0);
            f32x4 sp;
#pragma unroll
            for (int e = 0; e < 4; ++e) sp[e] = -8.0f * log1pf(__expf(-lm[e]));
#pragma unroll
            for (int ai = 0; ai < 2; ++ai)
#pragma unroll
                for (int m = 0; m < 4; ++m) {
                    const size_t off = (size_t)(u.pm * BM + ai * HALF + wr * 64 + m * 16 + fr) * 1024 + ch0;
                    const uint2 xr = *(const uint2*)(xc + off);
                    float xv[4] = { __uint_as_float(xr.x << 16), __uint_as_float(xr.x & 0xffff0000u), __uint_as_float(xr.y << 16), __uint_as_float(xr.y & 0xffff0000u) };
                    f32x4 av, bv;
#pragma unroll
                    for (int e = 0; e < 4; ++e) {
                        const float r = sigmoidf_(acc[ai][0][m][n][e] + ba[e]);
                        const float ig = sigmoidf_(acc[ai][1][m][n][e] + bx[e]);
                        const float la = sp[e] * r;
                        av[e] = la;
                        bv[e] = __builtin_amdgcn_sqrtf(fmaxf(one_minus_exp(2.0f * la), 0.f)) * (ig * xv[e]);
                    }
                    uint2 wa, wb; wa.x = cvt_pk_bf16(av[0], av[1]); wa.y = cvt_pk_bf16(av[2], av[3]); wb.x = cvt_pk_bf16(bv[0], bv[1]); wb.y = cvt_pk_bf16(bv[2], bv[3]);
                    *(uint2*)(Aout + off) = wa; *(uint2*)(Bout + off) = wb;
                }
        }
    }
};

struct RowStats {
    float* xbuf;
    unsigned* cnt;
    unsigned target;
    __device__ __forceinline__ void run(const f32x4 (&v)[2][2][4][2], const Unit& u, int wr, int wc, int fr, int fq, PG8_LAS unsigned char* xl, int wid, int lane) const {
        PG8_LAS float* P = (PG8_LAS float*)xl;
        PG8_LAS float* S = (PG8_LAS float*)(xl + 4096);
#pragma unroll
        for (int ai = 0; ai < 2; ++ai)
#pragma unroll
            for (int m = 0; m < 4; ++m) {
                float s = 0.f;
#pragma unroll
                for (int bj = 0; bj < 2; ++bj)
#pragma unroll
                    for (int n = 0; n < 2; ++n) { const f32x4 x = v[ai][bj][m][n]; s += (x[0] * x[0] + x[1] * x[1]) + (x[2] * x[2] + x[3] * x[3]); }
                s += xor16f(s); s = sum32f(s);
                if (fq == 0) P[(ai * HALF + wr * 64 + m * 16 + fr) * 4 + wc] = s;
            }
        asm volatile("s_waitcnt lgkmcnt(0)" ::: "memory"); __builtin_amdgcn_s_barrier(); asm volatile("" ::: "memory");
        const int row = wid * 32 + (lane & 31);
        if (lane < 32) { const float t = (P[row * 4 + 0] + P[row * 4 + 1]) + (P[row * 4 + 2] + P[row * 4 + 3]);
            __hip_atomic_store(xbuf + (size_t)(u.pm * BM + row) * 4 + u.pn, t, __ATOMIC_RELAXED, __HIP_MEMORY_SCOPE_AGENT); }
        asm volatile("s_waitcnt vmcnt(0)" ::: "memory");
        if (lane == 0) __hip_atomic_fetch_add(cnt + 64 * u.pm, 1u, __ATOMIC_RELAXED, __HIP_MEMORY_SCOPE_AGENT);
        if (wid == 0) { unsigned sp = 0;
            while ((unsigned)__builtin_amdgcn_readfirstlane(__hip_atomic_load(cnt + 64 * u.pm, __ATOMIC_RELAXED, __HIP_MEMORY_SCOPE_AGENT)) < target) { __builtin_amdgcn_s_sleep(2); if (++sp > (1u << 18)) break; }
            __builtin_amdgcn_fence(__ATOMIC_ACQUIRE, "agent"); }
        asm volatile("s_waitcnt vmcnt(0) lgkmcnt(0)" ::: "memory"); __builtin_amdgcn_s_barrier(); asm volatile("" ::: "memory");
        if (lane < 32) { float* slot = xbuf + (size_t)(u.pm * BM + row) * 4; float t = 0.f;
#pragma unroll
            for (int k = 0; k < 4; ++k) t += __hip_atomic_load(slot + k, __ATOMIC_RELAXED, __HIP_MEMORY_SCOPE_AGENT);
            S[row] = t; }
        asm volatile("s_waitcnt lgkmcnt(0)" ::: "memory"); __builtin_amdgcn_s_barrier(); asm volatile("" ::: "memory");
    }
};
struct EpiNormRes {
    static constexpr bool PERM = false, AFTER_DRAIN = false, FUSED = true;
    bf16_t* hn; float* xs2; float* out; const float* gprev; const float* gpost; const float* gpre; RowStats st1; PG8_LAS unsigned char* xl;
    const float* s_in;
    __device__ __forceinline__ void fused(f32x4 (&acc)[2][2][4][2], const Unit& u, int wr, int wc, int fr, int fq, int wid, int lane) const {
        typedef unsigned u32x2v __attribute__((ext_vector_type(2)));
        PG8_LAS float* P = (PG8_LAS float*)xl;
        const PG8_LAS float* S = (const PG8_LAS float*)(xl + 4096);
        const int col0 = u.pn * BM + wc * 32 + 4 * fq;
        st1.run(acc, u, wr, wc, fr, fq, xl, wid, lane);
#pragma unroll
        for (int ai = 0; ai < 2; ++ai)
#pragma unroll
            for (int m = 0; m < 4; ++m) { const int r = ai * HALF + wr * 64 + m * 16 + fr; float rstd = rsqrtf(S[r] * (1.0f / 1024.0f) + 1e-6f); const size_t off = (size_t)(u.pm * BM + r) * 1024 + col0;
                if (s_in) { const f32x4 pp = *(const f32x4*)(s_in + (size_t)(u.pm * BM + r) * 4); const float s2 = __builtin_amdgcn_rcpf(((pp[0] + pp[1]) + (pp[2] + pp[3])) * (1.0f / 1024.0f) + 1e-6f);
                    rstd = rsqrtf(S[r] * (1.0f / 1024.0f) * s2 * s2 + 1e-6f) * s2; }
#pragma unroll
                for (int bj = 0; bj < 2; ++bj)
#pragma unroll
                    for (int n = 0; n < 2; ++n) { const u32x2v hw = *(const u32x2v*)(hn + off + bj * HALF + n * 16);
                        const f32x4 gp = *(const f32x4*)(gprev + col0 + bj * HALF + n * 16); const f32x4 gv = *(const f32x4*)(gpost + col0 + bj * HALF + n * 16);
                        f32x4 xs; xs[0] = __uint_as_float(hw.x << 16) * __builtin_amdgcn_rcpf(gp[0]); xs[1] = __uint_as_float(hw.x & 0xffff0000u) * __builtin_amdgcn_rcpf(gp[1]);
                        xs[2] = __uint_as_float(hw.y << 16) * __builtin_amdgcn_rcpf(gp[2]); xs[3] = __uint_as_float(hw.y & 0xffff0000u) * __builtin_amdgcn_rcpf(gp[3]);
                        acc[ai][bj][m][n] = xs + (acc[ai][bj][m][n] * rstd) * gv; }
                asm volatile("" : "+v"(acc[ai][0][m][0]), "+v"(acc[ai][0][m][1]), "+v"(acc[ai][1][m][0]), "+v"(acc[ai][1][m][1]));
                if (m & 1) asm volatile("" ::: "memory"); }
        if (gpre) {
#pragma unroll
            for (int ai = 0; ai < 2; ++ai)
#pragma unroll
                for (int m = 0; m < 4; ++m) {
                    float s = 0.f;
#pragma unroll
                    for (int bj = 0; bj < 2; ++bj)
#pragma unroll
                        for (int n = 0; n < 2; ++n) { const f32x4 x = acc[ai][bj][m][n]; s += (x[0] * x[0] + x[1] * x[1]) + (x[2] * x[2] + x[3] * x[3]); }
                    s += xor16f(s); s = sum32f(s);
                    if (fq == 0) P[(ai * HALF + wr * 64 + m * 16 + fr) * 4 + wc] = s;
                }
            asm volatile("s_waitcnt lgkmcnt(0)" ::: "memory"); __builtin_amdgcn_s_barrier(); asm volatile("" ::: "memory");
            { const int row = wid * 32 + (lane & 31);
              if (lane < 32) xs2[(size_t)(u.pm * BM + row) * 4 + u.pn] = (P[row * 4 + 0] + P[row * 4 + 1]) + (P[row * 4 + 2] + P[row * 4 + 3]); }
#pragma unroll
            for (int ai = 0; ai < 2; ++ai)
#pragma unroll
                for (int m = 0; m < 4; ++m) { const int r = ai * HALF + wr * 64 + m * 16 + fr; const size_t off = (size_t)(u.pm * BM + r) * 1024 + col0;
#pragma unroll
                    for (int bj = 0; bj < 2; ++bj)
#pragma unroll
                        for (int n = 0; n < 2; ++n) { const f32x4 gv = *(const f32x4*)(gpre + col0 + bj * HALF + n * 16); const f32x4 o = acc[ai][bj][m][n] * gv;
                            u32x2v w; w.x = cvt_pk_bf16(o[0], o[1]); w.y = cvt_pk_bf16(o[2], o[3]); *(u32x2v*)(hn + off + bj * HALF + n * 16) = w; }
                    asm volatile("" ::: "memory"); }
            asm volatile("s_waitcnt lgkmcnt(0)" ::: "memory"); __builtin_amdgcn_s_barrier(); asm volatile("" ::: "memory");
        } else {
#pragma unroll
            for (int ai = 0; ai < 2; ++ai)
#pragma unroll
                for (int m = 0; m < 4; ++m) { const int r = ai * HALF + wr * 64 + m * 16 + fr; const size_t off = (size_t)(u.pm * BM + r) * 1024 + col0;
#pragma unroll
                    for (int bj = 0; bj < 2; ++bj)
#pragma unroll
                        for (int n = 0; n < 2; ++n) *(f32x4*)(out + off + bj * HALF + n * 16) = acc[ai][bj][m][n]; }
        }
    }
};

template <class Epi, class Sched, bool ALIGN_EPI>
__device__ __forceinline__ void gemm_phase(PG8_LAS unsigned char* lds, const Gemm g, const Sched& S, const Epi& E, int tid0) {
    int tid_ = tid0; asm volatile("" : "+v"(tid_));
    const int tid = tid_, wid = __builtin_amdgcn_readfirstlane(tid >> 6), lane = tid & 63, wr = wid >> 2, wc = wid & 3, fr = lane & 15, fq = lane >> 4;
    const int K = g.K, nt = K / BK;
    unsigned voffA[2], voffB[2];
#pragma unroll
    for (int i = 0; i < 2; ++i) { int R, C; stage_rc(tid * 16 + i * 8192, R, C); const int Rb = Epi::PERM ? ((R & ~31) + perm32(R & 31)) : R;
        voffA[i] = (unsigned)(R * g.lda + C) * 2u; voffB[i] = (unsigned)(Rb * g.ldb + C) * 2u; }
    const size_t kstep = (size_t)(BK * 2);
    const size_t hstepA = (size_t)HALF * g.lda * 2, hstepB = (size_t)HALF * g.ldb * 2;
    const size_t tstepA = 2 * hstepA, tstepB = 2 * hstepB;
    const unsigned ldsw = (unsigned)wid * 1024u;
    const int aoff = lds_byte(wr * 64 + fr, fq * 8), boff = lds_byte(wc * 32 + fr, fq * 8);
#define PG8_SA(b, h) (((b) * 2 + (h)) * HTB)
#define PG8_SB(b, h) ((4 + (b) * 2 + (h)) * HTB)
#define PG8_STAGE(bufoff, gbase, voff) do { _Pragma("unroll") for (int _i = 0; _i < 2; ++_i) \
        __builtin_amdgcn_global_load_lds((const unsigned*)((const char*)(gbase) + (voff)[_i]), (PG8_LAS unsigned*)(lds + (bufoff) + ldsw + _i * 8192), 16, 0, 0); } while (0)
#define PG8_LDA(dst, b, h) do { _Pragma("unroll") for (int m = 0; m < 4; ++m) _Pragma("unroll") for (int k = 0; k < 2; ++k) dst[m][k] = *(const PG8_LAS bf16x8*)(lds + PG8_SA(b, h) + aoff + m * 2048 + k * 1024); } while (0)
#define PG8_LDB(dst, b, h) do { _Pragma("unroll") for (int n = 0; n < 2; ++n) _Pragma("unroll") for (int k = 0; k < 2; ++k) dst[n][k] = *(const PG8_LAS bf16x8*)(lds + PG8_SB(b, h) + boff + n * 2048 + k * 1024); } while (0)
#define PG8_MMA(ai, bj, At, Bt) do { __builtin_amdgcn_s_setprio(1); _Pragma("unroll") for (int m = 0; m < 4; ++m) _Pragma("unroll") for (int n = 0; n < 2; ++n) _Pragma("unroll") for (int k = 0; k < 2; ++k) \
        acc[ai][bj][m][n] = __builtin_amdgcn_mfma_f32_16x16x32_bf16(Bt[n][k], At[m][k], acc[ai][bj][m][n], 0, 0, 0); __builtin_amdgcn_s_setprio(0); } while (0)
#define PG8_WAIT_V(n) asm volatile("s_waitcnt vmcnt(" #n ")" ::: "memory")
#define PG8_WAIT_L(n) asm volatile("s_waitcnt lgkmcnt(" #n ")" ::: "memory")
#define PG8_BAR __builtin_amdgcn_s_barrier()
#define PG8_SCHED __builtin_amdgcn_sched_barrier(0)
    Unit cur, nxt; int ui = 0;
    if (!S.next(0, cur)) return;
    f32x4 acc[2][2][4][2];
#pragma unroll
    for (int a = 0; a < 2; ++a)
#pragma unroll
        for (int b = 0; b < 2; ++b)
#pragma unroll
            for (int m = 0; m < 4; ++m)
#pragma unroll
                for (int n = 0; n < 2; ++n) acc[a][b][m][n] = (f32x4){0.f, 0.f, 0.f, 0.f};
    bf16x8 At[4][2], B0[2][2], B1[2][2];
    const char* cA = (const char*)g.A + (size_t)cur.pm * tstepA + (size_t)(cur.pn >> 1) * (size_t)g.apn; const char* cB = (const char*)g.Bt + (size_t)cur.pn * tstepB;
    S.a_ready(cur);
    PG8_STAGE(PG8_SB(0, 0), cB, voffB); PG8_STAGE(PG8_SB(0, 1), cB + hstepB, voffB); PG8_STAGE(PG8_SA(0, 0), cA, voffA); PG8_STAGE(PG8_SA(0, 1), cA + hstepA, voffA);
    if (wr == 1) PG8_BAR;
    PG8_WAIT_V(2); PG8_BAR;
    PG8_STAGE(PG8_SB(1, 0), cB + kstep, voffB); PG8_STAGE(PG8_SA(1, 0), cA + kstep, voffA); PG8_STAGE(PG8_SB(1, 1), cB + hstepB + kstep, voffB);
    PG8_WAIT_V(6); PG8_BAR;
    for (;;) {
        const bool has_next = S.next(ui + 1, nxt);
        const char* nA = has_next ? (const char*)g.A + (size_t)nxt.pm * tstepA + (size_t)(nxt.pn >> 1) * (size_t)g.apn : cA; const char* nB = has_next ? (const char*)g.Bt + (size_t)nxt.pn * tstepB : cB;
        for (int t = 0; t < nt; t += 2) {
            const bool last = (t == nt - 2);
            const char* a1 = cA + (size_t)(t + 1) * kstep;
            const char* a2 = last ? nA : cA + (size_t)(t + 2) * kstep; const char* b2 = last ? nB : cB + (size_t)(t + 2) * kstep;
            const char* a3 = a2 + kstep; const char* b3 = b2 + kstep;
            if (last && has_next) S.a_ready(nxt);
            PG8_LDB(B0, 0, 0); PG8_LDB(B1, 0, 1); PG8_SCHED; PG8_LDA(At, 0, 0); PG8_STAGE(PG8_SA(1, 1), a1 + hstepA, voffA);
            PG8_WAIT_V(8); PG8_WAIT_L(0); PG8_BAR; PG8_MMA(0, 0, At, B0); PG8_MMA(0, 1, At, B1); PG8_BAR; PG8_SCHED;
            PG8_LDA(At, 0, 1); PG8_STAGE(PG8_SB(0, 0), b2, voffB); PG8_STAGE(PG8_SB(0, 1), b2 + hstepB, voffB); PG8_STAGE(PG8_SA(0, 0), a2, voffA);
            PG8_WAIT_V(8); PG8_WAIT_L(0); PG8_BAR; PG8_MMA(1, 0, At, B0); PG8_MMA(1, 1, At, B1); PG8_BAR; PG8_SCHED;
            PG8_LDB(B0, 1, 0); PG8_LDB(B1, 1, 1); PG8_SCHED; PG8_LDA(At, 1, 0); PG8_STAGE(PG8_SA(0, 1), a2 + hstepA, voffA);
            PG8_WAIT_V(8); PG8_WAIT_L(0); PG8_BAR; PG8_MMA(0, 0, At, B0); PG8_MMA(0, 1, At, B1); PG8_BAR; PG8_SCHED;
            PG8_LDA(At, 1, 1); PG8_STAGE(PG8_SB(1, 0), b3, voffB); PG8_STAGE(PG8_SB(1, 1), b3 + hstepB, voffB); PG8_STAGE(PG8_SA(1, 0), a3, voffA);
            PG8_WAIT_V(8); PG8_WAIT_L(0); PG8_BAR; PG8_MMA(1, 0, At, B0); PG8_MMA(1, 1, At, B1); PG8_BAR; PG8_SCHED;
        }
        if constexpr (ALIGN_EPI) { if (wr == 0) PG8_BAR; }
        if constexpr (Epi::FUSED) E.fused(acc, cur, wr, wc, fr, fq, wid, lane); else E(acc, cur, wr, wc, fr, fq);
        S.done(cur);
        if (!has_next) break;
#pragma unroll
        for (int a = 0; a < 2; ++a)
#pragma unroll
            for (int b = 0; b < 2; ++b)
#pragma unroll
                for (int m = 0; m < 4; ++m)
#pragma unroll
                    for (int n = 0; n < 2; ++n) acc[a][b][m][n] = (f32x4){0.f, 0.f, 0.f, 0.f};
        cur = nxt; cA = nA; cB = nB; ++ui;
        if constexpr (ALIGN_EPI) { if (wr == 1) PG8_BAR; }
    }
    PG8_WAIT_V(0);
    if constexpr (!ALIGN_EPI) { if (wr == 0) PG8_BAR; }
    PG8_BAR;
#undef PG8_SA
#undef PG8_SB
#undef PG8_STAGE
#undef PG8_LDA
#undef PG8_LDB
#undef PG8_MMA
#undef PG8_WAIT_V
#undef PG8_WAIT_L
#undef PG8_BAR
#undef PG8_SCHED
}
}
namespace att {
typedef unsigned short u16;
typedef short bf16x8 __attribute__((ext_vector_type(8)));
typedef short s16x4 __attribute__((ext_vector_type(4)));
typedef float f32x16 __attribute__((ext_vector_type(16)));
typedef float f32x4 __attribute__((ext_vector_type(4)));
typedef unsigned u32x4 __attribute__((ext_vector_type(4)));
constexpr int SEQ = 16384, NW = 8, QBLK = 32, KVBLK = 64, QB = NW * QBLK;
constexpr int LDQ = 1536, LDK = 2048, LDKR = 64, LDO = 1024;
#ifndef ATT_NQREG
#define ATT_NQREG 8
#endif
constexpr int NQREG = ATT_NQREG, NQREG_L = 8 - NQREG;
constexpr int SHM_V = KVBLK * 128 * 2, SHM_K = KVBLK * 128 * 2, SHM_KR = KVBLK * 64 * 2;
constexpr int OFF_V = 0, OFF_K = 2 * SHM_V, OFF_KR = OFF_K + 2 * SHM_K, OFF_WS = OFF_KR + 2 * SHM_KR, OFF_QR = OFF_WS + NW * 64 * 4, QR_WAVE = (NQREG_L + 4) * 1024, LDS_BYTES = OFF_QR + NW * QR_WAVE;
constexpr float SCALE = 0.07216878364870322f;
constexpr float THR = 8.f;

#define KSWZ(row, colB) ((row) * 256 + ((colB) ^ (((row) & 7) << 4)))
#define KRSWZ(row, colB) ((row) * 128 + ((colB) ^ (((row) & 7) << 4)))
#define SBAR() __builtin_amdgcn_sched_barrier(0)
__device__ __forceinline__ int v_st(int k, int c) { const int kk = (k & ~0xC) | ((k & 4) << 1) | ((k & 8) >> 1); return ((kk >> 3) * 4 + (c >> 5)) * 512 + ((kk & 7) * 32 + (c & 31)) * 2; }
__device__ __forceinline__ int v_rd_base(int lane) { return ((lane & 3) << 3) | (((lane >> 2) & 3) << 6) | (((lane >> 4) & 1) << 5) | (((lane >> 5) & 1) << 8); }
constexpr int v_rd_off(int d0, int ks, int half) { return d0 * 512 + ks * 4096 + half * 2048; }
__device__ __forceinline__ int crow(int r, int hi) { return (r & 3) + 8 * (r >> 2) + 4 * hi; }
__device__ __forceinline__ unsigned cvtpk(float lo, float hi) { unsigned r; asm volatile("v_cvt_pk_bf16_f32 %0, %1, %2" : "=v"(r) : "v"(lo), "v"(hi)); return r; }
__device__ __forceinline__ bf16x8 load8(const u16* p) { return *reinterpret_cast<const bf16x8*>(p); }
__device__ __forceinline__ void mask_tile(f32x16& p0, f32x16& p1, int dq, unsigned W) {
    const float NEG = -__builtin_inff();
#pragma unroll
    for (int r = 0; r < 16; ++r) {
        const int c = (r & 3) + 8 * (r >> 2);
        if ((unsigned)(dq - c) >= W) p0[r] = NEG;
        if ((unsigned)(dq - c - 32) >= W) p1[r] = NEG;
    }
}
__device__ __forceinline__ void partialSM(f32x16& p0, f32x16& p1, float& m_reg, float& mn, float& alpha) {
    float pmax = p0[0]; for (int r = 1; r < 16; ++r) pmax = fmaxf(pmax, p0[r]); for (int r = 0; r < 16; ++r) pmax = fmaxf(pmax, p1[r]);
    { auto rr = __builtin_amdgcn_permlane32_swap(__float_as_uint(pmax), __float_as_uint(pmax), false, false);
      pmax = fmaxf(__uint_as_float(rr[0]), __uint_as_float(rr[1])); }
    constexpr float C2 = 1.4426950408889634f * SCALE;
    if (__builtin_expect(__all((pmax - m_reg) * SCALE <= THR), 1)) { mn = m_reg; alpha = 1.f; }
    else { mn = fmaxf(m_reg, pmax); alpha = __builtin_amdgcn_exp2f((m_reg - mn) * C2); m_reg = mn; }
    const float mnL = -mn * C2;
    for (int r = 0; r < 16; ++r) p0[r] = fmaf(p0[r], C2, mnL); for (int r = 0; r < 16; ++r) p1[r] = fmaf(p1[r], C2, mnL);
}
__device__ __forceinline__ void finishSM(f32x16& p0, f32x16& p1, float alpha, float& l_reg, bf16x8& pa0, bf16x8& pa1, bf16x8& pa2, bf16x8& pa3) {
    for (int r = 0; r < 16; ++r) p0[r] = __builtin_amdgcn_exp2f(p0[r]);
    for (int r = 0; r < 16; ++r) p1[r] = __builtin_amdgcn_exp2f(p1[r]);
    float ps = 0; for (int r = 0; r < 16; ++r) ps += p0[r]; for (int r = 0; r < 16; ++r) ps += p1[r];
    { auto rr = __builtin_amdgcn_permlane32_swap(__float_as_uint(ps), __float_as_uint(ps), false, false);
      ps = __uint_as_float(rr[0]) + __uint_as_float(rr[1]); }
    l_reg = l_reg * alpha + ps;
#define PK4(P, B_, OUT) do { unsigned a0 = cvtpk(P[B_+0], P[B_+1]), a1 = cvtpk(P[B_+2], P[B_+3]);                          \
        unsigned b0 = cvtpk(P[B_+4], P[B_+5]), b1 = cvtpk(P[B_+6], P[B_+7]);                                             \
        auto r0 = __builtin_amdgcn_permlane32_swap(a0, b0, false, false); auto r1 = __builtin_amdgcn_permlane32_swap(a1, b1, false, false); \
        u32x4 w = {r0[0], r1[0], r0[1], r1[1]}; OUT = *reinterpret_cast<bf16x8*>(&w); } while (0)
    PK4(p0, 0, pa0); PK4(p0, 8, pa1); PK4(p1, 0, pa2); PK4(p1, 8, pa3);
#undef PK4
}
#ifndef ATT_PF
#define ATT_PF 1
#endif
#define QK_SB() __builtin_amdgcn_sched_barrier(0x406)
#define QK_LOAD(s, SET) do { if ((s) < 8) { const char* a_ = kb[(s) & 3] + ((s) >> 2) * 128; fb0[SET] = *reinterpret_cast<const bf16x8*>(a_); fb1[SET] = *reinterpret_cast<const bf16x8*>(a_ + 32 * 256); \
            if ((s) < NQREG) fq[SET] = qr[(s) < NQREG ? (s) : 0]; else fq[SET] = qrl[((s) - NQREG) * 64]; } \
        else { const char* a_ = krb[((s) - 8) & 3]; fb0[SET] = *reinterpret_cast<const bf16x8*>(a_); fb1[SET] = *reinterpret_cast<const bf16x8*>(a_ + 32 * 128); fq[SET] = qrl[(NQREG_L + (s) - 8) * 64]; } } while (0)
template <int KB>
__device__ __forceinline__ void qkt(f32x16& p0, f32x16& p1, const char* K_lds, const char* KR_lds, const bf16x8* qrl, int r32, int hi, const bf16x8* qr) {
    constexpr int PF = ATT_PF, NS = PF + 1;
    p0 = f32x16{}; p1 = f32x16{};
    const char* kb[4]; const char* krb[4];
#pragma unroll
    for (int dd = 0; dd < 4; ++dd) { kb[dd] = K_lds + KB * SHM_K + KSWZ(r32, (dd * 16 + hi * 8) * 2); krb[dd] = KR_lds + KB * SHM_KR + KRSWZ(r32, (dd * 16 + hi * 8) * 2); }
    bf16x8 fb0[NS], fb1[NS], fq[NS];
#pragma unroll
    for (int s = 0; s < PF; ++s) QK_LOAD(s, s % NS);
#pragma unroll
    for (int s = 0; s < 12; ++s) {
        QK_SB();
        if (s + PF < 12) QK_LOAD(s + PF, (s + PF) % NS);
        QK_SB();
        p0 = __builtin_amdgcn_mfma_f32_32x32x16_bf16(fb0[s % NS], fq[s % NS], p0, 0, 0, 0);
        p1 = __builtin_amdgcn_mfma_f32_32x32x16_bf16(fb1[s % NS], fq[s % NS], p1, 0, 0, 0);
    }
    QK_SB();
}
#define FSM_E(j) do { if ((j) < 16) { y0[(j) & 15] = __builtin_amdgcn_exp2f(y0[(j) & 15]); acc += y0[(j) & 15]; } else { y1[(j) & 15] = __builtin_amdgcn_exp2f(y1[(j) & 15]); acc += y1[(j) & 15]; } } while (0)
#define FSM_CVT(P, B_) do { ca0 = cvtpk(P[(B_) + 0], P[(B_) + 1]); ca1 = cvtpk(P[(B_) + 2], P[(B_) + 3]); cb0 = cvtpk(P[(B_) + 4], P[(B_) + 5]); cb1 = cvtpk(P[(B_) + 6], P[(B_) + 7]); } while (0)
#define FSM_SWP(OUT) do { auto r0_ = __builtin_amdgcn_permlane32_swap(ca0, cb0, false, false); auto r1_ = __builtin_amdgcn_permlane32_swap(ca1, cb1, false, false); \
        u32x4 w_ = {r0_[0], r1_[0], r0_[1], r1_[1]}; OUT = *reinterpret_cast<bf16x8*>(&w_); } while (0)
#define FSM_CHUNK(c) do { if ((c) < 12) { FSM_E(2 * (c)); FSM_E(2 * (c) + 1); } else if ((c) < 20) { FSM_E(24 + (c) - 12); } \
        if ((c) == 12) FSM_CVT(y0, 0); if ((c) == 13) FSM_SWP(pa0); if ((c) == 14) FSM_CVT(y0, 8); if ((c) == 15) FSM_SWP(pa1); \
        if ((c) == 16) FSM_CVT(y1, 0); if ((c) == 17) FSM_SWP(pa2); if ((c) == 20) FSM_CVT(y1, 8); if ((c) == 21) FSM_SWP(pa3); \
        if ((c) == 22) { auto rr_ = __builtin_amdgcn_permlane32_swap(__float_as_uint(acc), __float_as_uint(acc), false, false); acc = __uint_as_float(rr_[0]) + __uint_as_float(rr_[1]); } \
        if ((c) == 23) l_reg = l_reg * alpha + acc; } while (0)
#define SB0() __builtin_amdgcn_sched_barrier(0)
template <int KB>
__device__ __forceinline__ void qkt_fsm(f32x16& p0, f32x16& p1, const char* K_lds, const char* KR_lds, const bf16x8* qrl, int r32, int hi, const bf16x8* qr,
                                        f32x16& y0, f32x16& y1, float alpha, float& l_reg, bf16x8& pa0, bf16x8& pa1, bf16x8& pa2, bf16x8& pa3) {
    constexpr int PF = ATT_PF, NS = PF + 1;
    p0 = f32x16{}; p1 = f32x16{};
    const char* kb[4]; const char* krb[4];
#pragma unroll
    for (int dd = 0; dd < 4; ++dd) { kb[dd] = K_lds + KB * SHM_K + KSWZ(r32, (dd * 16 + hi * 8) * 2); krb[dd] = KR_lds + KB * SHM_KR + KRSWZ(r32, (dd * 16 + hi * 8) * 2); }
    bf16x8 fb0[NS], fb1[NS], fq[NS];
    float acc = 0.f; unsigned ca0 = 0, ca1 = 0, cb0 = 0, cb1 = 0;
#pragma unroll
    for (int s = 0; s < PF; ++s) QK_LOAD(s, s % NS);
#pragma unroll
    for (int s = 0; s < 12; ++s) {
        SB0();
        if (s + PF < 12) QK_LOAD(s + PF, (s + PF) % NS);
        SB0();
        p0 = __builtin_amdgcn_mfma_f32_32x32x16_bf16(fb0[s % NS], fq[s % NS], p0, 0, 0, 0);
        SB0(); FSM_CHUNK(2 * s); SB0();
        p1 = __builtin_amdgcn_mfma_f32_32x32x16_bf16(fb1[s % NS], fq[s % NS], p1, 0, 0, 0);
        SB0(); FSM_CHUNK(2 * s + 1);
    }
    SB0();
}
#undef FSM_E
#undef FSM_CVT
#undef FSM_SWP
#undef FSM_CHUNK
#undef QK_LOAD
template <int VB>
__device__ __forceinline__ void pv_tile(f32x16* o, int vb0, bf16x8 pa0, bf16x8 pa1, bf16x8 pa2, bf16x8 pa3) {
#define TRRD(dst, off) asm volatile("ds_read_b64_tr_b16 %0, %1 offset:%2" : "=&v"(dst) : "v"(vb0), "i"(off) : "memory")
#define PV_D0(d0) do { s16x4 l0, l1, l2, l3, h0, h1, h2, h3; constexpr int b_ = OFF_V + VB * SHM_V + v_rd_off(d0, 0, 0); \
        TRRD(l0, b_); TRRD(h0, b_ + 2048); TRRD(l1, b_ + 4096); TRRD(h1, b_ + 6144); TRRD(l2, b_ + 8192); TRRD(h2, b_ + 10240); TRRD(l3, b_ + 12288); TRRD(h3, b_ + 14336); \
        asm volatile("s_waitcnt lgkmcnt(0)" ::: "memory"); SBAR();   \
        o[d0] = __builtin_amdgcn_mfma_f32_32x32x16_bf16(pa0, (bf16x8){l0[0], l0[1], l0[2], l0[3], h0[0], h0[1], h0[2], h0[3]}, o[d0], 0, 0, 0);   \
        o[d0] = __builtin_amdgcn_mfma_f32_32x32x16_bf16(pa1, (bf16x8){l1[0], l1[1], l1[2], l1[3], h1[0], h1[1], h1[2], h1[3]}, o[d0], 0, 0, 0);   \
        o[d0] = __builtin_amdgcn_mfma_f32_32x32x16_bf16(pa2, (bf16x8){l2[0], l2[1], l2[2], l2[3], h2[0], h2[1], h2[2], h2[3]}, o[d0], 0, 0, 0);   \
        o[d0] = __builtin_amdgcn_mfma_f32_32x32x16_bf16(pa3, (bf16x8){l3[0], l3[1], l3[2], l3[3], h3[0], h3[1], h3[2], h3[3]}, o[d0], 0, 0, 0); } while (0)
    PV_D0(0); PV_D0(1); PV_D0(2); PV_D0(3);
}
template <int VB>
__device__ __forceinline__ void pv_tile_sm(f32x16* o, int vb0, bf16x8 pa0, bf16x8 pa1, bf16x8 pa2, bf16x8 pa3, f32x16& p0, f32x16& p1, float& m_reg, float& mn, float& alpha) {
    constexpr float C2 = 1.4426950408889634f * SCALE;
    PV_D0(0);
    float pmax = p0[0];
#pragma unroll
    for (int r = 1; r < 16; ++r) pmax = fmaxf(pmax, p0[r]);
#pragma unroll
    for (int r = 0; r < 16; ++r) pmax = fmaxf(pmax, p1[r]);
    PV_D0(1);
    { auto rr = __builtin_amdgcn_permlane32_swap(__float_as_uint(pmax), __float_as_uint(pmax), false, false);
      pmax = fmaxf(__uint_as_float(rr[0]), __uint_as_float(rr[1])); }
    const bool keep = __all((pmax - m_reg) * SCALE <= THR);
    mn = keep ? m_reg : fmaxf(m_reg, pmax);
    alpha = __builtin_amdgcn_exp2f((m_reg - mn) * C2);
    m_reg = mn;
    const float mnL = -mn * C2;
#pragma unroll
    for (int r = 0; r < 16; ++r) p0[r] = fmaf(p0[r], C2, mnL);
    PV_D0(2);
#pragma unroll
    for (int r = 0; r < 16; ++r) p1[r] = fmaf(p1[r], C2, mnL);
    PV_D0(3);
}
#undef PV_D0
#undef TRRD

struct BlockRef { const u16* Q; const u16* K; const u16* V; const u16* KR; u16* O; int P0; int row0; };
#define VMW() asm volatile("s_waitcnt vmcnt(0)" ::: "memory")
#define ATT_LAS __attribute__((address_space(3)))
#define KDMA(Kp, KRp, k0, bf) do { \
        __builtin_amdgcn_global_load_lds((const unsigned*)((Kp) + (size_t)((k0) + sr) * LDK + ksc), (ATT_LAS unsigned*)(ldsL + OFF_K + (bf) * SHM_K + wid * 1024), 16, 0, 0); \
        __builtin_amdgcn_global_load_lds((const unsigned*)((Kp) + (size_t)((k0) + 32 + sr) * LDK + ksc), (ATT_LAS unsigned*)(ldsL + OFF_K + (bf) * SHM_K + 8192 + wid * 1024), 16, 0, 0); \
        __builtin_amdgcn_global_load_lds((const unsigned*)((KRp) + (size_t)((k0) + krr) * LDKR + krsc), (ATT_LAS unsigned*)(ldsL + OFF_KR + (bf) * SHM_KR + wid * 1024), 16, 0, 0); } while (0)
#define VDMA(Vp, k0, bf) do { \
        __builtin_amdgcn_global_load_lds((const unsigned*)((Vp) + (size_t)((k0) + vk) * LDK + vc), (ATT_LAS unsigned*)(ldsL + OFF_V + (bf) * SHM_V + wid * 1024), 16, 0, 0); \
        __builtin_amdgcn_global_load_lds((const unsigned*)((Vp) + (size_t)((k0) + 32 + vk) * LDK + vc), (ATT_LAS unsigned*)(ldsL + OFF_V + (bf) * SHM_V + 8192 + wid * 1024), 16, 0, 0); } while (0)
#define ATT_MAPS() const int sr = tid >> 4, ksc = ((tid & 15) ^ (sr & 7)) * 8, krr = tid >> 3, krsc = ((tid & 7) ^ (krr & 7)) * 8; ATT_LAS unsigned char* ldsL = (ATT_LAS unsigned char*)lds; \
    const int vkk_ = ((tid >> 7) << 3) | ((tid >> 2) & 7), vk = (vkk_ & ~0xC) | ((vkk_ & 4) << 1) | ((vkk_ & 8) >> 1), vc = ((tid >> 5) & 3) * 32 + (tid & 3) * 8
__device__ __forceinline__ void attn_prime(const BlockRef& cur, char* lds, int tid0) {
    int tid_ = tid0; asm volatile("" : "+v"(tid_));
    const int tid = tid_, wid = __builtin_amdgcn_readfirstlane(tid >> 6);
    ATT_MAPS();
    KDMA(cur.K, cur.KR, 0, 0); VDMA(cur.V, 0, 0); VMW();
    __syncthreads();
}
__device__ __forceinline__ void attn_block(const BlockRef& cur, const BlockRef& nxt, char* lds, int tid0, const float* ctab, const float* stab) {
    int tid_ = tid0; asm volatile("" : "+v"(tid_));
    const int tid = tid_, wid = __builtin_amdgcn_readfirstlane(tid >> 6), lane = tid & 63, r32 = lane & 31, hi = lane >> 5;
    const unsigned W = 0x40000000u;
    const int NT = (cur.P0 + QB - 1) / KVBLK + 1;
    const int qlo = cur.P0 + wid * QBLK, qm = qlo + r32 - 4 * hi;
    char* K_lds = lds + OFF_K; char* KR_lds = lds + OFF_KR;
    float* ws = (float*)(lds + OFF_WS) + wid * 64; float* li_l = ws, * al_l = ws + 32;
    bf16x8* qrl = (bf16x8*)(lds + OFF_QR + wid * QR_WAVE) + lane;
    float m_reg = -1e30f, l_reg = 0; f32x16 o[4] = {};
    ATT_MAPS();
    const int vb0 = (int)(uintptr_t)lds + v_rd_base(lane);
    const u16* Kh = cur.K; const u16* Vh = cur.V; const u16* KRh = cur.KR;
#define RESC(a) do { if (__any((a) < 1.f)) { if (hi == 0) al_l[r32] = (a); asm volatile("s_waitcnt lgkmcnt(0)" ::: "memory");              \
                     for (int d_ = 0; d_ < 4; ++d_) for (int r = 0; r < 16; ++r) o[d_][r] *= al_l[crow(r, hi)]; } } while (0)
#define KBASE(t) ((t) * KVBLK)
#define MASKT(P0_, P1_, t) do { const int kb_ = KBASE(t); if (kb_ + KVBLK - 1 > qlo) mask_tile(P0_, P1_, qm - kb_, W); } while (0)
    f32x16 pA0, pA1, pB0, pB1; float mnA, mnB, alA, alB; bf16x8 pa0, pa1, pa2, pa3;
    bf16x8 qr[NQREG > 0 ? NQREG : 1];
    { const u16* qp = cur.Q + (size_t)(wid * QBLK + r32) * LDQ + hi * 8;
#pragma unroll
      for (int d = 0; d < NQREG_L; ++d) qrl[d * 64] = load8(qp + (NQREG + d) * 16);
      const size_t trow = (size_t)(cur.row0 + wid * QBLK + r32) * 32 + hi * 8;
#pragma unroll
      for (int pr = 0; pr < 2; ++pr) {
          const bf16x8 x1 = load8(qp + 128 + pr * 16), x2 = load8(qp + 128 + 32 + pr * 16);
          const f32x4 c0 = *(const f32x4*)(ctab + trow + pr * 16), c1 = *(const f32x4*)(ctab + trow + pr * 16 + 4), s0 = *(const f32x4*)(stab + trow + pr * 16), s1 = *(const f32x4*)(stab + trow + pr * 16 + 4);
          float o1[8], o2[8];
#pragma unroll
          for (int e = 0; e < 8; ++e) { const float a = __uint_as_float(((unsigned)(unsigned short)x1[e]) << 16), b = __uint_as_float(((unsigned)(unsigned short)x2[e]) << 16);
              const float cc = e < 4 ? c0[e & 3] : c1[e & 3], ss = e < 4 ? s0[e & 3] : s1[e & 3]; o1[e] = a * cc - b * ss; o2[e] = b * cc + a * ss; }
          u32x4 w1 = {cvtpk(o1[0], o1[1]), cvtpk(o1[2], o1[3]), cvtpk(o1[4], o1[5]), cvtpk(o1[6], o1[7])}, w2 = {cvtpk(o2[0], o2[1]), cvtpk(o2[2], o2[3]), cvtpk(o2[4], o2[5]), cvtpk(o2[6], o2[7])};
          qrl[(NQREG_L + pr) * 64] = *reinterpret_cast<bf16x8*>(&w1); qrl[(NQREG_L + 2 + pr) * 64] = *reinterpret_cast<bf16x8*>(&w2); }
#pragma unroll
      for (int d0 = 0; d0 < NQREG; ++d0) qr[d0] = load8(qp + d0 * 16); }
    SBAR();
    KDMA(Kh, KRh, KBASE(1), 1); VDMA(Vh, KBASE(1), 1);
    SBAR(); qkt<0>(pA0, pA1, K_lds, KR_lds, qrl, r32, hi, qr);
    MASKT(pA0, pA1, 0); partialSM(pA0, pA1, m_reg, mnA, alA);
    VMW(); __syncthreads();
    KDMA(Kh, KRh, KBASE(2), 0);
#define HALF_STEP(PX0, PX1, mnX, alX, PY0, PY1, alY, t, KB, VB) do {                                                          \
        SBAR(); qkt_fsm<KB>(PX0, PX1, K_lds, KR_lds, qrl, r32, hi, qr, PY0, PY1, alY, l_reg, pa0, pa1, pa2, pa3); SBAR();               \
        MASKT(PX0, PX1, (t)); SBAR(); pv_tile_sm<VB>(o, vb0, pa0, pa1, pa2, pa3, PX0, PX1, m_reg, mnX, alX);                  \
        VMW(); __syncthreads();                                                                                               \
        if ((t) + 2 < NT) KDMA(Kh, KRh, KBASE((t) + 2), KB);                                                                  \
        if ((t) + 1 < NT) VDMA(Vh, KBASE((t) + 1), VB);                                                                       \
        SBAR(); RESC(alX); } while (0)
    for (int t = 1; t + 1 < NT; t += 2) {
        HALF_STEP(pB0, pB1, mnB, alB, pA0, pA1, alA, t, 1, 0);
        HALF_STEP(pA0, pA1, mnA, alA, pB0, pB1, alB, t + 1, 0, 1);
    }
    SBAR(); qkt_fsm<1>(pB0, pB1, K_lds, KR_lds, qrl, r32, hi, qr, pA0, pA1, alA, l_reg, pa0, pa1, pa2, pa3); SBAR();
    MASKT(pB0, pB1, NT - 1); SBAR(); pv_tile_sm<0>(o, vb0, pa0, pa1, pa2, pa3, pB0, pB1, m_reg, mnB, alB);
    VMW(); __syncthreads();
    KDMA(nxt.K, nxt.KR, 0, 0); VDMA(nxt.V, 0, 0);
    SBAR(); RESC(alB);
    finishSM(pB0, pB1, alB, l_reg, pa0, pa1, pa2, pa3); SBAR(); pv_tile<1>(o, vb0, pa0, pa1, pa2, pa3);
    SBAR();
    if (hi == 0) li_l[r32] = l_reg; asm volatile("s_waitcnt lgkmcnt(0)" ::: "memory");
    float rli[16];
#pragma unroll
    for (int r = 0; r < 16; ++r) rli[r] = __builtin_amdgcn_rcpf(li_l[crow(r, hi)]);
    u16* Ow = cur.O + (size_t)(wid * QBLK) * LDO;
#pragma unroll
    for (int r = 0; r < 16; ++r) { const int orow = crow(r, hi);
#pragma unroll
        for (int d0 = 0; d0 < 4; ++d0) { const float v = o[d0][r] * rli[r];
            const float vn = xor1f(v);
            if ((r32 & 1) == 0) *(unsigned*)(Ow + (size_t)orow * LDO + d0 * 32 + r32) = cvtpk(v, vn); } }
    VMW(); __syncthreads();
#undef RESC
#undef KBASE
#undef MASKT
#undef HALF_STEP
}
struct Tensors { const u16* q; const u16* kv; const u16* kr; u16* o; const float* ctab; const float* stab; };
__device__ __forceinline__ BlockRef make_ref(const Tensors& T, int L, int pass) {
    const int bh = (L & 7) + 8 * (L >> 8), x = (L >> 3) & 31, b = bh >> 3, h = bh & 7, qb = pass ? 63 - x : x;
    BlockRef r; const size_t row0 = (size_t)b * SEQ;
    r.Q = T.q + (row0 + (size_t)qb * QB) * LDQ + h * 192; r.K = T.kv + row0 * LDK + h * 256; r.V = r.K + 128; r.KR = T.kr + row0 * LDKR;
    r.O = T.o + (row0 + (size_t)qb * QB) * LDO + h * 128; r.P0 = qb * QB; r.row0 = b * SEQ + qb * QB;
    return r;
}
__device__ __forceinline__ void attn_phase(char* lds, const Tensors& T, int tid0) {
    const int total = 512, stride = gridDim.x;
    int L = blockIdx.x; if (L >= total) return;
    int pass = 0;
    BlockRef cur = make_ref(T, L, 0);
    attn_prime(cur, lds, tid0);
    for (;;) {
        const bool more_pass = pass == 0, more_item = L + stride < total, last = !more_pass && !more_item;
        int passn = pass + 1, Ln = L;
        if (!more_pass) { passn = 0; Ln = more_item ? L + stride : L; }
        const BlockRef nxt = last ? cur : make_ref(T, Ln, passn);
        attn_block(cur, nxt, lds, tid0, T.ctab, T.stab);
        if (last) break;
        cur = nxt; pass = passn; L = Ln;
    }
}
#undef VMW
#undef KDMA
#undef VDMA
#undef ATT_MAPS
#undef SBAR
}
namespace xb {
#define LAS __attribute__((address_space(3)))
#define XB_TMO      128
#define XB_XCNT(j)  (256  + 64 * (j))
#define XB_XSUB(j)  (1280 + 64 * (j))
#define XB_XGEN(j)  (2304 + 64 * (j))
#define XB_TOP      3328
#define XB_TOPGEN   3392
#define XCD_BAR_WORDS 3456
#define XB_SPIN_CAP (1u << 18)

__device__ __forceinline__ unsigned xb_ld(unsigned* p)              { return __hip_atomic_load(p, __ATOMIC_RELAXED, __HIP_MEMORY_SCOPE_AGENT); }
__device__ __forceinline__ unsigned xb_add(unsigned* p, unsigned v) { return __hip_atomic_fetch_add(p, v, __ATOMIC_RELAXED, __HIP_MEMORY_SCOPE_AGENT); }
__device__ __forceinline__ unsigned xb_xcc_id() { return (unsigned)__builtin_amdgcn_s_getreg((3 << 11) | 20) & 0xFu; }
#define XB_SPIN(cond, bar) do { unsigned _sp = 0; while (cond) { __builtin_amdgcn_s_sleep(1); \
    if ((++_sp & 255u) == 0u) { if (xb_ld(&(bar)[XB_TMO])) break; if (_sp > XB_SPIN_CAP) { atomicAdd(&(bar)[XB_TMO], 1u); break; } } } } while (0)

struct XcdBarrier {
    unsigned* bar; unsigned x;
    volatile LAS unsigned* st;
};

__device__ __forceinline__ XcdBarrier xcd_barrier_post(unsigned* bar, volatile LAS unsigned* st) {
    XcdBarrier b; b.bar = bar; b.x = xb_xcc_id(); b.st = st;
    if (threadIdx.x == 0) (void)xb_add(&bar[XB_XCNT(b.x)], 1u);
    return b;
}
__device__ __forceinline__ void xcd_barrier_complete(unsigned* bar, unsigned x, unsigned& nloc, unsigned& nx) {
    const unsigned G = gridDim.x * gridDim.y * gridDim.z;
    unsigned sum, cnt, mine, sp = 0u;
    for (;;) {
        sum = 0u; cnt = 0u; mine = 0u;
#pragma unroll
        for (unsigned j = 0; j < 16; ++j) { const unsigned c = xb_ld(&bar[XB_XCNT(j)]); sum += c; cnt += (c > 0u) ? 1u : 0u; mine = (j == x) ? c : mine; }
        if (sum == G) break;
        __builtin_amdgcn_s_sleep(1);
        if ((++sp & 255u) == 0u) { if (xb_ld(&bar[XB_TMO])) break; if (sp > XB_SPIN_CAP) { atomicAdd(&bar[XB_TMO], 1u); break; } }
    }
    nloc = mine > 0u ? mine : 1u; nx = cnt > 0u ? cnt : 1u;
}

__device__ __forceinline__ void xcd_barrier(const XcdBarrier& b, bool t0  ) {
    asm volatile("s_waitcnt vmcnt(0)" ::: "memory");
    __syncthreads();
    if (t0) {
        unsigned* bar = b.bar;
        __builtin_amdgcn_s_waitcnt(0);
        unsigned nloc = b.st[0], nx = b.st[1];
        if (nloc == 0u) { xcd_barrier_complete(bar, b.x, nloc, nx); b.st[0] = nloc; b.st[1] = nx; }
        const unsigned old = xb_add(&bar[XB_XSUB(b.x)], 1u);
        const unsigned gen = old / nloc;
        if (old + 1u == (gen + 1u) * nloc) {
            __builtin_amdgcn_fence(__ATOMIC_RELEASE, "agent");
            asm volatile("s_waitcnt vmcnt(0)" ::: "memory");
            const unsigned og = xb_add(&bar[XB_TOP], 1u);
            const unsigned tg = og / nx;
            if (og + 1u == (tg + 1u) * nx) xb_add(&bar[XB_TOPGEN], 1u);
            else XB_SPIN(xb_ld(&bar[XB_TOPGEN]) == tg, bar);
            __builtin_amdgcn_fence(__ATOMIC_ACQUIRE, "agent");
            xb_add(&bar[XB_XGEN(b.x)], 1u);
            asm volatile("s_waitcnt vmcnt(0)" ::: "memory");
        } else {
            XB_SPIN(xb_ld(&bar[XB_XGEN(b.x)]) == gen, bar);
            __builtin_amdgcn_fence(__ATOMIC_ACQUIRE, "agent");
            asm volatile("s_waitcnt vmcnt(0)" ::: "memory");
        }
    }
    __syncthreads();
}
#undef LAS
}
#ifndef PROBE_ATT_REPS
#define PROBE_ATT_REPS 1
#endif
#ifndef PROBE_SYNC_REPS
#define PROBE_SYNC_REPS 1
#endif
#ifndef PROBE_THIN_REPS
#define PROBE_THIN_REPS 1
#endif
#ifndef PROBE_PRO_REPS
#define PROBE_PRO_REPS 1
#endif
#ifndef STAGGER_TICKS
#define STAGGER_TICKS 0
#endif
#ifndef PROBE_GEMM_OP
#define PROBE_GEMM_OP -1
#endif
#ifndef PROBE_GEMM_REPS
#define PROBE_GEMM_REPS 1
#endif
namespace mk {
typedef unsigned short u16;
typedef float f32x4 __attribute__((ext_vector_type(4)));
constexpr int M = 32768, D = 1024, SEQ = 16384;
constexpr float EPS = 1e-6f;
constexpr size_t MB = (size_t)1 << 20;
__host__ __device__ constexpr size_t WT_MLA(int j) { return (size_t)j * 6 * MB; }
__host__ __device__ constexpr size_t WT_LRU(int j) { return 12 * MB + (size_t)j * 8 * MB; }
__host__ __device__ constexpr size_t WT_FFN(int l) { return 28 * MB + (size_t)l * 16 * MB; }
constexpr size_t OFF_UQ = 3 * MB / 2, OFF_UKV = 11 * MB / 4, OFF_WO = 15 * MB / 4, OFF_GT = 4 * MB, OFF_LOUT = 5 * MB, OFF_DOWN = 8 * MB;
constexpr size_t WS_COS = 96 * MB, WS_SIN = 100 * MB, WS_SA = 104 * MB, WS_SB = 105 * MB;
constexpr size_t WS_HN = 112 * MB, WS_Y = 176 * MB, WS_U = 240 * MB, WS_END = 496 * MB;
constexpr size_t U_PROJ = 64 * MB, U_CQ = 112 * MB, U_CKV = 136 * MB, U_KR = 152 * MB, U_Q = 160 * MB, U_O = 64 * MB;
constexpr size_t U_GATE = 0, U_XC = 64 * MB, U_REC = 128 * MB, U_LA = 128 * MB, U_B = 192 * MB;
constexpr size_t WS_XSA = 108 * MB, WS_XSB = 109 * MB;
constexpr size_t WS_RS = 108 * MB;
constexpr int SCAN_L = 128, SCAN_NC = SEQ / SCAN_L;

__device__ __forceinline__ unsigned f2bf(float f) { unsigned u = __float_as_uint(f); return (u + 0x7fffu + ((u >> 16) & 1u)) >> 16; }
__device__ __forceinline__ unsigned pk2(float lo, float hi) { return f2bf(lo) | (f2bf(hi) << 16); }
__device__ __forceinline__ float bflo(unsigned w) { return __uint_as_float(w << 16); }
__device__ __forceinline__ float bfhi(unsigned w) { return __uint_as_float(w & 0xffff0000u); }
__device__ __forceinline__ float bf1(u16 h) { return __uint_as_float(((unsigned)h) << 16); }
__device__ __forceinline__ float wave_sum(float v) {
    v += xor1f(v); v += xor2f(v); v += xor4f(v); v += xor8f(v); v += xor16f(v);
    return sum32f(v);
}
__device__ __forceinline__ void transpose_item(const float* W, int ldw, u16* WT, int ldt, int nblk, float* scr, int item, int lane) {
    const int kb = item / nblk, nb = item % nblk, k0 = 64 * kb, n0 = 32 * nb;
#pragma unroll
    for (int i = 0; i < 8; ++i) { const int kk = 8 * i + (lane >> 3); const f32x4 v = *(const f32x4*)(W + (size_t)(k0 + kk) * ldw + n0 + (lane & 7) * 4);
        float* s = scr + kk * 33 + (lane & 7) * 4; s[0] = v.x; s[1] = v.y; s[2] = v.z; s[3] = v.w; }
    asm volatile("s_waitcnt lgkmcnt(0)" ::: "memory");
    const int c = lane & 7;
#pragma unroll
    for (int j = 0; j < 4; ++j) { const int n = (lane >> 3) + 8 * j; const float* s = scr + (8 * c) * 33 + n;
        uint4 o; o.x = pk2(s[0 * 33], s[1 * 33]); o.y = pk2(s[2 * 33], s[3 * 33]); o.z = pk2(s[4 * 33], s[5 * 33]); o.w = pk2(s[6 * 33], s[7 * 33]);
        *(uint4*)(WT + (size_t)(n0 + n) * ldt + k0 + 8 * c) = o; }
    asm volatile("s_waitcnt lgkmcnt(0)" ::: "memory");
}
struct Params { const float* in[23]; float* out; unsigned char* ws; };
enum { I_X = 0, I_POS, I_MIXPRE, I_MIXPOST, I_FFNPRE, I_FFNPOST, I_MLA_WIN, I_MLA_QN, I_MLA_KVN, I_MLA_WUQ, I_MLA_WUKV, I_MLA_WO,
       I_LRU_WIN, I_LRU_CW, I_LRU_CB, I_LRU_WA, I_LRU_BA, I_LRU_WX, I_LRU_BX, I_LRU_LAM, I_LRU_WOUT, I_FFN_UP, I_FFN_DOWN };

__device__ __forceinline__ void prologue_weights(const __attribute__((address_space(4))) Params& p, float* scr, int gw, int NGW, int lane) {
    u16* wt = (u16*)p.ws;
    constexpr int IT_MLA = 352 + 288 + 256 + 512, IT_LRU = 1024 + 128 + 512, IT_FFN = 4096, TOTAL = 2 * IT_MLA + 2 * IT_LRU + 4 * IT_FFN;
    for (int it = gw; it < TOTAL; it += NGW) {
        int r = it; const float* W; int ldw, ldt, nblk; u16* WT;
        if (r < 2 * IT_MLA) { const int j = r / IT_MLA; r -= j * IT_MLA; u16* base = wt + WT_MLA(j) / 2;
            if (r < 352) { W = p.in[I_MLA_WIN] + (size_t)j * 1024 * 704; ldw = 704; nblk = 22; WT = base; ldt = 1024; }
            else if (r < 640) { r -= 352; W = p.in[I_MLA_WUQ] + (size_t)j * 384 * 1536; ldw = 1536; nblk = 48; WT = base + OFF_UQ / 2; ldt = 384; }
            else if (r < 896) { r -= 640; W = p.in[I_MLA_WUKV] + (size_t)j * 256 * 2048; ldw = 2048; nblk = 64; WT = base + OFF_UKV / 2; ldt = 256; }
            else { r -= 896; W = p.in[I_MLA_WO] + (size_t)j * 1024 * 1024; ldw = 1024; nblk = 32; WT = base + OFF_WO / 2; ldt = 1024; }
        } else if (r < 2 * IT_MLA + 2 * IT_LRU) { r -= 2 * IT_MLA; const int j = r / IT_LRU; r -= j * IT_LRU; u16* base = wt + WT_LRU(j) / 2;
            if (r < 1024) { W = p.in[I_LRU_WIN] + (size_t)j * 1024 * 2048; ldw = 2048; nblk = 64; WT = base; ldt = 1024; }
            else if (r < 1152) { r -= 1024; const int which = r >> 3, gt = which >> 3, n = which & 7; r &= 7;
                W = p.in[gt ? I_LRU_WX : I_LRU_WA] + (size_t)j * 8 * 128 * 128 + (size_t)n * 128 * 128; ldw = 128; nblk = 4;
                WT = base + OFF_GT / 2 + (size_t)(n * 256 + gt * 128) * 256 + 128 * (n & 1); ldt = 256; }
            else { r -= 1152; W = p.in[I_LRU_WOUT] + (size_t)j * 1024 * 1024; ldw = 1024; nblk = 32; WT = base + OFF_LOUT / 2; ldt = 1024; }
        } else { r -= 2 * IT_MLA + 2 * IT_LRU; const int l = r / IT_FFN; r -= l * IT_FFN; u16* base = wt + WT_FFN(l) / 2;
            if (r < 2048) { W = p.in[I_FFN_UP] + (size_t)l * 1024 * 4096; ldw = 4096; nblk = 128; WT = base; ldt = 1024; }
            else { r -= 2048; W = p.in[I_FFN_DOWN] + (size_t)l * 4096 * 1024; ldw = 1024; nblk = 32; WT = base + OFF_DOWN / 2; ldt = 4096; }
        }
        transpose_item(W, ldw, WT, ldt, nblk, scr, r, lane);
    }
}
__device__ __forceinline__ void rowop(const u16* y, const float* xin, float* xout, u16* hn, float* rs, const float* gpost, const float* gpre, int gw, int NGW, int lane) {
    f32x4 gp[4], gq[4];
#pragma unroll
    for (int j = 0; j < 4; ++j) { gp[j] = gpost ? *(const f32x4*)(gpost + j * 256 + lane * 4) : (f32x4){0.f, 0.f, 0.f, 0.f}; gq[j] = gpre ? *(const f32x4*)(gpre + j * 256 + lane * 4) : (f32x4){0.f, 0.f, 0.f, 0.f}; }
    for (int row = gw; row < M; row += NGW) {
        f32x4 xv[4];
#pragma unroll
        for (int j = 0; j < 4; ++j) xv[j] = *(const f32x4*)(xin + (size_t)row * D + j * 256 + lane * 4);
        if (y) {
            f32x4 yv[4]; float ss = 0.f;
#pragma unroll
            for (int j = 0; j < 4; ++j) { const uint2 w = *(const uint2*)(y + (size_t)row * D + j * 256 + lane * 4);
                yv[j] = (f32x4){bflo(w.x), bfhi(w.x), bflo(w.y), bfhi(w.y)}; ss += (yv[j].x * yv[j].x + yv[j].y * yv[j].y) + (yv[j].z * yv[j].z + yv[j].w * yv[j].w); }
            const float r = rsqrtf(wave_sum(ss) * (1.f / D) + EPS);
#pragma unroll
            for (int j = 0; j < 4; ++j) xv[j] = xv[j] + (yv[j] * r) * gp[j];
        }
        if (xout) {
#pragma unroll
        for (int j = 0; j < 4; ++j) *(f32x4*)(xout + (size_t)row * D + j * 256 + lane * 4) = xv[j]; }
        if (gpre) {
            float s2 = 0.f;
#pragma unroll
            for (int j = 0; j < 4; ++j) s2 += (xv[j].x * xv[j].x + xv[j].y * xv[j].y) + (xv[j].z * xv[j].z + xv[j].w * xv[j].w);
            const float tot2 = wave_sum(s2); const float r2 = 1.0f;
            if (rs && lane < 4) rs[(size_t)row * 4 + lane] = lane == 0 ? tot2 : 0.f;
#pragma unroll
            for (int j = 0; j < 4; ++j) { const f32x4 h = (xv[j] * r2) * gq[j]; uint2 w; w.x = pk2(h.x, h.y); w.y = pk2(h.z, h.w);
                *(uint2*)(hn + (size_t)row * D + j * 256 + lane * 4) = w; }
        }
    }
}
__device__ __forceinline__ void qkvnorm(const u16* proj, u16* cq, u16* ckv, u16* kr, const float* qn, const float* kvn, const float* ctab, const float* stab, const float* rss, int gw, int NGW, int lane) {
    float gA[8], gB[8];
    { const float* gp = lane < 48 ? qn + 8 * lane : kvn + (8 * lane - 384); const f32x4 g0 = *(const f32x4*)gp, g1 = *(const f32x4*)(gp + 4);
      gA[0] = g0[0]; gA[1] = g0[1]; gA[2] = g0[2]; gA[3] = g0[3]; gA[4] = g1[0]; gA[5] = g1[1]; gA[6] = g1[2]; gA[7] = g1[3]; }
    { f32x4 g0 = {0.f, 0.f, 0.f, 0.f}, g1 = {0.f, 0.f, 0.f, 0.f}; if (lane < 16) { g0 = *(const f32x4*)(kvn + 128 + 8 * lane); g1 = *(const f32x4*)(kvn + 132 + 8 * lane); }
      gB[0] = g0[0]; gB[1] = g0[1]; gB[2] = g0[2]; gB[3] = g0[3]; gB[4] = g1[0]; gB[5] = g1[1]; gB[6] = g1[2]; gB[7] = g1[3]; }
    const bool ropeL = lane >= 16 && lane < 24; const int rk = (lane & 3) * 8;
    const int cOff = lane < 20 ? 672 + rk : 640 + rk;
    for (int row0 = gw; row0 < M; row0 += 2 * NGW) {
        float A[2][8], B[2][8], C[2][8], rsc[2], sa[2], sb[2];
#pragma unroll
        for (int q = 0; q < 2; ++q) { const int row = row0 + q * NGW; const u16* pr = proj + (size_t)row * 768;
            const f32x4 pp = *(const f32x4*)(rss + (size_t)row * 4); rsc[q] = rsqrtf(((pp[0] + pp[1]) + (pp[2] + pp[3])) * (1.f / D) + EPS);
            const uint4 a = *(const uint4*)(pr + 8 * lane); uint4 b = make_uint4(0u, 0u, 0u, 0u), c = make_uint4(0u, 0u, 0u, 0u);
            if (lane < 24) b = *(const uint4*)(pr + 512 + 8 * lane);
            if (ropeL) c = *(const uint4*)(pr + cOff);
            A[q][0] = bflo(a.x); A[q][1] = bfhi(a.x); A[q][2] = bflo(a.y); A[q][3] = bfhi(a.y); A[q][4] = bflo(a.z); A[q][5] = bfhi(a.z); A[q][6] = bflo(a.w); A[q][7] = bfhi(a.w);
            B[q][0] = bflo(b.x); B[q][1] = bfhi(b.x); B[q][2] = bflo(b.y); B[q][3] = bfhi(b.y); B[q][4] = bflo(b.z); B[q][5] = bfhi(b.z); B[q][6] = bflo(b.w); B[q][7] = bfhi(b.w);
            C[q][0] = bflo(c.x); C[q][1] = bfhi(c.x); C[q][2] = bflo(c.y); C[q][3] = bfhi(c.y); C[q][4] = bflo(c.z); C[q][5] = bfhi(c.z); C[q][6] = bflo(c.w); C[q][7] = bfhi(c.w); }
#pragma unroll
        for (int q = 0; q < 2; ++q) { sa[q] = 0.f; sb[q] = 0.f;
#pragma unroll
            for (int e = 0; e < 8; ++e) { A[q][e] *= rsc[q]; B[q][e] *= rsc[q]; C[q][e] *= rsc[q]; sa[q] += A[q][e] * A[q][e]; sb[q] += B[q][e] * B[q][e]; } }
        float r1[2], r2[2];
#pragma unroll
        for (int q = 0; q < 2; ++q) { const float s1 = wave_sum(lane < 48 ? sa[q] : 0.f), s2 = wave_sum((lane >= 48 ? sa[q] : 0.f) + (lane < 16 ? sb[q] : 0.f));
            r1[q] = rsqrtf(s1 * (1.f / 384.f) + EPS); r2[q] = rsqrtf(s2 * (1.f / 256.f) + EPS); }
#pragma unroll
        for (int q = 0; q < 2; ++q) { const int row = row0 + q * NGW;
            { const float r = lane < 48 ? r1[q] : r2[q]; uint4 o; o.x = pk2(A[q][0] * r * gA[0], A[q][1] * r * gA[1]); o.y = pk2(A[q][2] * r * gA[2], A[q][3] * r * gA[3]);
              o.z = pk2(A[q][4] * r * gA[4], A[q][5] * r * gA[5]); o.w = pk2(A[q][6] * r * gA[6], A[q][7] * r * gA[7]);
              if (lane < 48) *(uint4*)(cq + (size_t)row * 384 + 8 * lane) = o; else *(uint4*)(ckv + (size_t)row * 256 + (8 * lane - 384)) = o; }
            if (lane < 16) { const float r = r2[q]; uint4 o; o.x = pk2(B[q][0] * r * gB[0], B[q][1] * r * gB[1]); o.y = pk2(B[q][2] * r * gB[2], B[q][3] * r * gB[3]);
              o.z = pk2(B[q][4] * r * gB[4], B[q][5] * r * gB[5]); o.w = pk2(B[q][6] * r * gB[6], B[q][7] * r * gB[7]);
              *(uint4*)(ckv + (size_t)row * 256 + 128 + 8 * lane) = o; }
            if (ropeL) { const f32x4 c0 = *(const f32x4*)(ctab + (size_t)row * 32 + rk), c1 = *(const f32x4*)(ctab + (size_t)row * 32 + rk + 4), s0 = *(const f32x4*)(stab + (size_t)row * 32 + rk), s1 = *(const f32x4*)(stab + (size_t)row * 32 + rk + 4);
              float ov[8];
#pragma unroll
              for (int e = 0; e < 8; ++e) { const float cc = e < 4 ? c0[e & 3] : c1[e & 3], ss = e < 4 ? s0[e & 3] : s1[e & 3];
                  ov[e] = lane < 20 ? B[q][e] * cc - C[q][e] * ss
                                    : B[q][e] * cc + C[q][e] * ss; }
              uint4 o; o.x = pk2(ov[0], ov[1]); o.y = pk2(ov[2], ov[3]); o.z = pk2(ov[4], ov[5]); o.w = pk2(ov[6], ov[7]);
              *(uint4*)(kr + (size_t)row * 64 + (lane < 20 ? 0 : 32) + rk) = o; }
        }
    }
}
__device__ __forceinline__ void qrope(u16* q, const float* ctab, const float* stab, int gw, int NGW, int lane) {
    for (int row = gw; row < M; row += NGW) {
        u16* qr = q + (size_t)row * 1536; const int i = lane & 31;
        const float c = ctab[(size_t)row * 32 + i], s = stab[(size_t)row * 32 + i];
#pragma unroll
        for (int j = 0; j < 4; ++j) { const int h = 2 * j + (lane >> 5); u16* pp = qr + h * 192 + 128 + i;
            const float x1 = bf1(pp[0]), x2 = bf1(pp[32]);
            pp[0] = (u16)f2bf(x1 * c - x2 * s); pp[32] = (u16)f2bf(x2 * c + x1 * s); }
    }
}
__device__ __forceinline__ void conv_phase(const u16* rec, u16* xc, const float* cw, const float* cb, int gtid, int NGT) {
    for (int idx = gtid; idx < (M / 32) * 128; idx += NGT) {
        const int r0 = (idx >> 7) * 32, c0 = (idx & 127) * 8;
        float w[4][8], bias[8], win[3][8];
#pragma unroll
        for (int e = 0; e < 8; ++e) { bias[e] = cb[c0 + e];
#pragma unroll
            for (int k = 0; k < 4; ++k) w[k][e] = cw[k * D + c0 + e]; }
        const bool first = (r0 & (SEQ - 1)) == 0;
#pragma unroll
        for (int k = 0; k < 3; ++k) { uint4 v = make_uint4(0u, 0u, 0u, 0u); if (!first) v = *(const uint4*)(rec + (size_t)(r0 - 3 + k) * D + c0);
            win[k][0] = bflo(v.x); win[k][1] = bfhi(v.x); win[k][2] = bflo(v.y); win[k][3] = bfhi(v.y); win[k][4] = bflo(v.z); win[k][5] = bfhi(v.z); win[k][6] = bflo(v.w); win[k][7] = bfhi(v.w); }
        for (int i0 = 0; i0 < 32; i0 += 8) {
            uint4 in[8];
#pragma unroll
            for (int u = 0; u < 8; ++u) in[u] = *(const uint4*)(rec + (size_t)(r0 + i0 + u) * D + c0);
#pragma unroll
            for (int u = 0; u < 8; ++u) {
                const float x[8] = {bflo(in[u].x), bfhi(in[u].x), bflo(in[u].y), bfhi(in[u].y), bflo(in[u].z), bfhi(in[u].z), bflo(in[u].w), bfhi(in[u].w)};
                float acc[8];
#pragma unroll
                for (int e = 0; e < 8; ++e) { acc[e] = bias[e] + win[0][e] * w[0][e] + win[1][e] * w[1][e] + win[2][e] * w[2][e] + x[e] * w[3][e]; win[0][e] = win[1][e]; win[1][e] = win[2][e]; win[2][e] = x[e]; }
                uint4 o; o.x = pk2(acc[0], acc[1]); o.y = pk2(acc[2], acc[3]); o.z = pk2(acc[4], acc[5]); o.w = pk2(acc[6], acc[7]);
                *(uint4*)(xc + (size_t)(r0 + i0 + u) * D + c0) = o;
            }
        }
    }
}
__device__ __forceinline__ void scanA(const u16* A, const u16* B, float* SA, float* SB, int tid) {
    for (int item = blockIdx.x; item < 2 * SCAN_NC; item += gridDim.x) {
        const int c = item % SCAN_NC, b = item / SCAN_NC, ch = 2 * tid;
        const size_t base = ((size_t)b * SEQ + (size_t)c * SCAN_L) * D + ch;
        float h0 = 0.f, h1 = 0.f, P0 = 1.f, P1 = 1.f;
        for (int t0 = 0; t0 < SCAN_L; t0 += 32) {
            unsigned aw[32], bw[32];
#pragma unroll
            for (int u = 0; u < 32; ++u) { aw[u] = *(const unsigned*)(A + base + (size_t)(t0 + u) * D); bw[u] = *(const unsigned*)(B + base + (size_t)(t0 + u) * D); }
#pragma unroll
            for (int u = 0; u < 32; ++u) { const float a0 = __expf(bflo(aw[u])), a1 = __expf(bfhi(aw[u])); h0 = a0 * h0 + bflo(bw[u]); h1 = a1 * h1 + bfhi(bw[u]); P0 *= a0; P1 *= a1; }
        }
        const size_t so = ((size_t)b * SCAN_NC + c) * D + ch;
        *(float2*)(SA + so) = make_float2(P0, P1); *(float2*)(SB + so) = make_float2(h0, h1);
    }
}
__device__ __forceinline__ void scanC(const u16* A, const u16* B, const float* SA, const float* SB, const u16* gate, u16* hg, int tid) {
    for (int item = blockIdx.x; item < 2 * SCAN_NC; item += gridDim.x) {
        const int c = item % SCAN_NC, b = item / SCAN_NC, ch = 2 * tid;
        const size_t base = ((size_t)b * SEQ + (size_t)c * SCAN_L) * D + ch;
        float h0 = 0.f, h1 = 0.f;
        for (int cc0 = 0; cc0 < c; cc0 += 16) {
            float2 pa[16], pb[16];
#pragma unroll
            for (int u = 0; u < 16; ++u) { const int cc = cc0 + u < c ? cc0 + u : c - 1; const size_t so = ((size_t)b * SCAN_NC + cc) * D + ch; pa[u] = *(const float2*)(SA + so); pb[u] = *(const float2*)(SB + so); }
#pragma unroll
            for (int u = 0; u < 16; ++u) { const bool in = cc0 + u < c; const float ax = in ? pa[u].x : 1.f, ay = in ? pa[u].y : 1.f, bx = in ? pb[u].x : 0.f, by = in ? pb[u].y : 0.f; h0 = ax * h0 + bx; h1 = ay * h1 + by; }
        }
        for (int t0 = 0; t0 < SCAN_L; t0 += 16) {
            unsigned aw[16], bw[16], gv[16];
#pragma unroll
            for (int u = 0; u < 16; ++u) { aw[u] = *(const unsigned*)(A + base + (size_t)(t0 + u) * D); bw[u] = *(const unsigned*)(B + base + (size_t)(t0 + u) * D); gv[u] = *(const unsigned*)(gate + base + (size_t)(t0 + u) * D); }
#pragma unroll
            for (int u = 0; u < 16; ++u) { h0 = __expf(bflo(aw[u])) * h0 + bflo(bw[u]); h1 = __expf(bfhi(aw[u])) * h1 + bfhi(bw[u]);
                *(unsigned*)(hg + base + (size_t)(t0 + u) * D) = pk2(bflo(gv[u]) * h0, bfhi(gv[u]) * h1); }
        }
    }
}

constexpr int LDS_GEMM = pg8::STAGE_BYTES + 8192, LDS_MAIN = att::LDS_BYTES > LDS_GEMM ? att::LDS_BYTES : LDS_GEMM, LDS_BYTES = LDS_MAIN + 16;
constexpr size_t WS_BAR = 106 * MB;
constexpr size_t WS_CNT1 = WS_BAR + 16384, WS_CNT2 = WS_BAR + 49152, CTL_BYTES = 81920, WS_XS1 = 107 * MB, WS_XS2 = 107 * MB + MB / 2;
constexpr int XL_OFF = 131072;
static_assert(XL_OFF + 8192 <= LDS_MAIN && XCD_BAR_WORDS * 4 <= 16384 && att::LDS_BYTES <= LDS_MAIN && pg8::STAGE_BYTES <= LDS_MAIN && LDS_BYTES <= 160 * 1024, "LDS map");

__global__ void __launch_bounds__(512, 2) fwd_mega(Params p_arg) {
    extern __shared__ __attribute__((aligned(16))) unsigned char lds[];
    cg::grid_group grid = cg::this_grid();
    (void)p_arg;
    volatile __attribute__((address_space(3))) unsigned* bst = (volatile __attribute__((address_space(3))) unsigned*)((__attribute__((address_space(3))) unsigned char*)lds + LDS_MAIN);
    if (threadIdx.x < 4) bst[threadIdx.x] = 0u;
    __syncthreads();
    const int wave_s = __builtin_amdgcn_readfirstlane(threadIdx.x >> 6);
    const unsigned bar_x = xb::xb_xcc_id();
    (void)xb::xcd_barrier_post((unsigned*)(p_arg.ws + WS_BAR), bst);
#define GRID_BAR() do { unsigned bx_ = bar_x; asm volatile("" : "+s"(bx_)); xb::XcdBarrier bb_; bb_.bar = (unsigned*)(ws + WS_BAR); bb_.x = bx_; bb_.st = bst; xb::xcd_barrier(bb_, tid == 0); } while (0)
    typedef const __attribute__((address_space(4))) Params* KParams;
    KParams pp = (KParams)__builtin_amdgcn_kernarg_segment_ptr();
#define FRESH() int tid_ = wave_s * 64 + lane_id_fresh(); asm volatile("" : "+v"(tid_)); asm volatile("" : "+s"(pp)); const __attribute__((address_space(4))) Params& p = *pp; \
    const int tid = tid_, lane = tid & 63, wave = __builtin_amdgcn_readfirstlane(tid >> 6); \
    const int G = gridDim.x, gw = blockIdx.x * 8 + wave, NGW = G * 8, gtid = blockIdx.x * 512 + tid, NGT = G * 512; \
    unsigned char* ws = p.ws; float* x = p.out; u16* hn = (u16*)(ws + WS_HN); u16* ybuf = (u16*)(ws + WS_Y); unsigned char* U = ws + WS_U; \
    float* ctab = (float*)(ws + WS_COS); float* stab = (float*)(ws + WS_SIN); float* SA = (float*)(ws + WS_SA); float* SB = (float*)(ws + WS_SB); \
    (void)lane; (void)wave; (void)gw; (void)NGW; (void)gtid; (void)NGT; (void)x; (void)hn; (void)ybuf; (void)U; (void)ctab; (void)stab; (void)SA; (void)SB;
    {
    FRESH();

    for (int prep = 0; prep < PROBE_PRO_REPS; ++prep) {
    prologue_weights(p, (float*)lds + wave * (64 * 33), gw, NGW, lane);
    for (int i = gtid; i < 2 * 2048 * 16; i += NGT) { const int j = i >> 15, row = (i >> 4) & 2047, chn = i & 15, n = row >> 8;
        *(uint4*)((u16*)(ws + WT_LRU(j) + OFF_GT) + (size_t)row * 256 + 128 * ((n & 1) ^ 1) + chn * 8) = make_uint4(0u, 0u, 0u, 0u); }
    { const int* pos = (const int*)p.in[I_POS];
      for (int i = gtid; i < M * 32; i += NGT) { const int row = i >> 5, f = i & 31;
        const float inv = __builtin_amdgcn_exp2f(-(float)f * (13.287712379549449f / 32.f));
        const float ang = (float)pos[row] * inv;
        double rev = (double)ang * 0.15915494309189535; rev -= __builtin_rint(rev);
        ctab[i] = __builtin_amdgcn_cosf((float)rev); stab[i] = __builtin_amdgcn_sinf((float)rev); } }
    rowop(nullptr, p.in[I_X], nullptr, hn, (float*)(ws + WS_XSB), nullptr, p.in[I_MIXPRE], gw, NGW, lane);
    }
    if (ws == nullptr) grid.sync();
    GRID_BAR();
    }

#pragma nounroll
    for (int layer = 0; layer < 4; ++layer) {
#pragma nounroll
        for (int op = 0; op < 10; ++op) {
            FRESH();
            const int j = layer >> 1; const bool lru = (layer & 1) != 0;
            const u16* wtm = (const u16*)(ws + WT_MLA(j)); const u16* wtl = (const u16*)(ws + WT_LRU(j)); const u16* wtf = (const u16*)(ws + WT_FFN(layer));
            int gk = 0;
            pg8::Gemm g{}; pg8::EpiB E{};
            if (op == 6 || op == 9) continue;
            const float* gprev = p.in[op == 5 ? I_MIXPRE : I_FFNPRE] + layer * D;
            const float* gpost = p.in[op == 5 ? I_MIXPOST : I_FFNPOST] + layer * D;
            const float* gpre = op == 5 ? p.in[I_FFNPRE] + layer * D : (layer < 3 ? p.in[I_MIXPRE] + (layer + 1) * D : nullptr);
            if (op == 7) { gk = 1; g = pg8::Gemm{hn, wtf, M, 4096, 1024, 1024, 1024, 0}; E = pg8::EpiB{(u16*)U, 4096, 0, 0, 1, nullptr}; }
            else if (op == 8) { gk = 3; g = pg8::Gemm{(const u16*)U, wtf + OFF_DOWN / 2, M, 1024, 4096, 4096, 4096, 0}; }
            else if (!lru) {
                u16* proj = (u16*)(U + U_PROJ); u16* cq = (u16*)(U + U_CQ); u16* ckv = (u16*)(U + U_CKV); u16* kr = (u16*)(U + U_KR); u16* q = (u16*)(U + U_Q); u16* o = (u16*)(U + U_O); u16* kv = ybuf;
                if (op == 0) { gk = 1; g = pg8::Gemm{hn, wtm, M, 768, 1024, 1024, 1024, 0}; E = pg8::EpiB{proj, 768, 0, 0, 0, nullptr}; }
                else if (op == 1) for (int rep = 0; rep < PROBE_THIN_REPS; ++rep) qkvnorm(proj, cq, ckv, kr, p.in[I_MLA_QN] + j * 384, p.in[I_MLA_KVN] + j * 256, ctab, stab, (const float*)(ws + WS_XSB), gw, NGW, lane);
                else if (op == 2) { gk = 1; g = pg8::Gemm{cq, wtm + OFF_UQ / 2, M, 1536, 384, 384, 384, 0}; E = pg8::EpiB{q, 1536, 0, 0, 0, nullptr}; }
                else if (op == 3) { gk = 1; g = pg8::Gemm{ckv, wtm + OFF_UKV / 2, M, 2048, 256, 256, 256, 0}; E = pg8::EpiB{kv, 2048, 0, 0, 0, nullptr}; }
                else if (op == 4) { const att::Tensors T{q, kv, kr, o, ctab, stab}; for (int rep = 0; rep < PROBE_ATT_REPS; ++rep) att::attn_phase((char*)lds, T, tid); }
                else { gk = 3; g = pg8::Gemm{o, wtm + OFF_WO / 2, M, 1024, 1024, 1024, 1024, 0}; }
            } else {
                u16* gate = (u16*)(U + U_GATE); u16* xc = (u16*)(U + U_XC); u16* rec = (u16*)(U + U_REC); u16* Bb = (u16*)(U + U_B); u16* Ab = (u16*)(U + U_LA); u16* hg = xc;
                if (op == 0) { gk = 1; g = pg8::Gemm{hn, wtl, M, 2048, 1024, 1024, 1024, 0}; E = pg8::EpiB{gate, 1024, 1024, (size_t)(U_REC - U_GATE) / 2, 2, (const float*)(ws + WS_XSB)}; }
                else if (op == 1) for (int rep = 0; rep < PROBE_THIN_REPS; ++rep) conv_phase(rec, xc, p.in[I_LRU_CW] + j * 4 * D, p.in[I_LRU_CB] + j * D, gtid, NGT);
                else if (op == 2) { gk = 2; g = pg8::Gemm{xc, wtl + OFF_GT / 2, M, 2048, 256, 1024, 256, 512}; }
                else if (op == 3) for (int rep = 0; rep < PROBE_THIN_REPS; ++rep) scanA(Ab, Bb, SA, SB, tid);
                else if (op == 4) for (int rep = 0; rep < PROBE_THIN_REPS; ++rep) scanC(Ab, Bb, SA, SB, gate, hg, tid);
                else { gk = 3; g = pg8::Gemm{hg, wtl + OFF_LOUT / 2, M, 1024, 1024, 1024, 1024, 0}; }
            }
            if (STAGGER_TICKS > 0 && op == 7) {
                unsigned bx_ = bar_x; asm volatile("" : "+s"(bx_));
                const unsigned long long t0_ = __builtin_amdgcn_s_memrealtime(), want_ = (unsigned long long)(bx_ & 7u) * STAGGER_TICKS;
                while (__builtin_amdgcn_s_memrealtime() - t0_ < want_) __builtin_amdgcn_s_sleep(8); }
            for (int rep = 0; rep < ((gk != 3 && (PROBE_GEMM_OP == -1 || op == PROBE_GEMM_OP || (PROBE_GEMM_OP == -2 && op != 7))) ? PROBE_GEMM_REPS : 1); ++rep)
            if (gk == 1) { pg8::StaticOrder S; S.init(g.M, g.N, G, (int)blockIdx.x);
                pg8::gemm_phase<pg8::EpiB, pg8::StaticOrder, true>((PG8_LAS unsigned char*)lds, g, S, E, tid); }
            else if (gk == 2) { pg8::StaticOrder S; S.init(g.M, g.N, G, (int)blockIdx.x);
                const pg8::EpiGate EG{(const u16*)(U + U_XC), (u16*)(U + U_LA), (u16*)(U + U_B), p.in[I_LRU_BA] + j * D, p.in[I_LRU_BX] + j * D, p.in[I_LRU_LAM] + j * D};
                pg8::gemm_phase<pg8::EpiGate, pg8::StaticOrder, true>((PG8_LAS unsigned char*)lds, g, S, EG, tid); }
            else if (gk == 3) { pg8::StaticOrder S; S.init(g.M, g.N, G, (int)blockIdx.x);
                const unsigned target = 32u * (unsigned)(layer * 2 + (op == 8 ? 2 : 1));
                const pg8::RowStats st1{(float*)(ws + WS_XS1), (unsigned*)(ws + WS_CNT1), target};
                const pg8::EpiNormRes EN{hn, (float*)(ws + (op == 8 ? WS_XSB : WS_XSA)), x, gprev, gpost, gpre, st1, (PG8_LAS unsigned char*)lds + XL_OFF, op == 8 ? (const float*)(ws + WS_XSA) : nullptr};
                pg8::gemm_phase<pg8::EpiNormRes, pg8::StaticOrder, true>((PG8_LAS unsigned char*)lds, g, S, EN, tid); }
            if (!(layer == 3 && op == 8) && !(!lru && op == 2)) { for (int rep = 0; rep < PROBE_SYNC_REPS; ++rep) GRID_BAR(); }
        }
    }
}
}

extern "C" void kernel_launch(void* const* d_in, const int* in_sizes, int n_in, void* d_out, int out_size, void* d_ws, size_t ws_size, hipStream_t stream) {
    static int grid = 0;
    if (grid == 0) {
        if (n_in != 23 || in_sizes[0] != mk::M * mk::D || out_size != mk::M * mk::D || ws_size < mk::WS_END) {
            fprintf(stderr, "kernel_launch: unexpected shapes (n_in %d, in0 %d, out %d, ws %zu); nothing launched\n", n_in, n_in > 0 ? in_sizes[0] : -1, out_size, ws_size); grid = -1; return; }
        int dev = 0, cus = 0, per_cu = 0;
        (void)hipGetDevice(&dev); (void)hipDeviceGetAttribute(&cus, hipDeviceAttributeMultiprocessorCount, dev);
        if (hipFuncSetAttribute((const void*)mk::fwd_mega, hipFuncAttributeMaxDynamicSharedMemorySize, mk::LDS_BYTES) != hipSuccess) { fprintf(stderr, "kernel_launch: hipFuncSetAttribute failed\n"); grid = -1; return; }
        if (hipOccupancyMaxActiveBlocksPerMultiprocessor(&per_cu, (const void*)mk::fwd_mega, 512, mk::LDS_BYTES) != hipSuccess || per_cu < 1) { fprintf(stderr, "kernel_launch: occupancy query says %d blocks per CU\n", per_cu); per_cu = 1; }
        (void)hipGetLastError();
        grid = cus > 0 ? cus : 256;
    }
    if (grid < 0) return;
    mk::Params p{};
    for (int i = 0; i < 23; ++i) p.in[i] = (const float*)d_in[i];
    p.out = (float*)d_out; p.ws = (unsigned char*)d_ws;
    if (hipMemsetAsync((char*)d_ws + mk::WS_BAR, 0, mk::CTL_BYTES, stream) != hipSuccess) { fprintf(stderr, "kernel_launch: hipMemsetAsync failed\n"); return; }
    void* args[] = {&p};
    hipError_t e = hipLaunchCooperativeKernel((const void*)mk::fwd_mega, dim3(grid), dim3(512), args, mk::LDS_BYTES, stream);
    if (e != hipSuccess) fprintf(stderr, "kernel_launch: cooperative launch failed: %s (grid %d)\n", hipGetErrorString(e), grid);
}
```

```cpp
#include <hip/hip_runtime.h>
#include <hip/hip_bf16.h>
#include <hip/hip_cooperative_groups.h>
#include <cstdio>
#include <cstdint>
namespace cg = cooperative_groups;

__device__ __forceinline__ float xor1f(float v)  { return __int_as_float(__builtin_amdgcn_mov_dpp(__float_as_int(v), 0xB1, 0xF, 0xF, false)); }
__device__ __forceinline__ float xor2f(float v)  { return __int_as_float(__builtin_amdgcn_mov_dpp(__float_as_int(v), 0x4E, 0xF, 0xF, false)); }
__device__ __forceinline__ float xor4f(float v)  { return __int_as_float(__builtin_amdgcn_ds_swizzle(__float_as_int(v), 0x101F)); }
__device__ __forceinline__ float xor8f(float v)  { return __int_as_float(__builtin_amdgcn_ds_swizzle(__float_as_int(v), 0x201F)); }
__device__ __forceinline__ float xor16f(float v) { return __int_as_float(__builtin_amdgcn_ds_swizzle(__float_as_int(v), 0x401F)); }
__device__ __forceinline__ float sum32f(float v) { auto rr = __builtin_amdgcn_permlane32_swap(__float_as_uint(v), __float_as_uint(v), false, false); return __uint_as_float(rr[0]) + __uint_as_float(rr[1]); }
__device__ __forceinline__ int lane_id_fresh() { int l; asm volatile("v_mbcnt_lo_u32_b32 %0, -1, 0\n\tv_mbcnt_hi_u32_b32 %0, -1, %0" : "=v"(l)); return l; }
namespace pg8 {
#define PG8_LAS __attribute__((address_space(3)))
typedef unsigned short bf16_t;
typedef short bf16x8 __attribute__((ext_vector_type(8)));
typedef float f32x4 __attribute__((ext_vector_type(4)));
typedef unsigned u32x4 __attribute__((ext_vector_type(4)));
constexpr int BM = 256, BK = 64, HALF = 128, HTB = HALF * BK * 2  , STAGE_BYTES = 8 * HTB, NXCD = 8, WGM = 8;

__host__ __device__ __forceinline__ int lds_byte(int r, int c) { const int st = (r >> 4) * 2 + (c >> 5), rr = r & 15, cc = c & 31, ob = rr * 64 + cc * 2; return st * 1024 + (ob ^ (((ob >> 9) & 1) << 5)); }
__host__ __device__ __forceinline__ void stage_rc(int b, int& R, int& C) { const int st = b / 1024, sb = b % 1024, swz = sb ^ (((sb >> 9) & 1) << 5); R = (st >> 1) * 16 + swz / 64; C = (st & 1) * 32 + (swz % 64) / 2; }
__host__ __device__ __forceinline__ int perm32(int rho) { const int n = rho >> 4, i = rho & 15; return 8 * (i >> 2) + 4 * n + (i & 3); }

struct Unit { int pm, pn; };
struct Gemm { const bf16_t* A; const bf16_t* Bt; int M, N, K; int lda, ldb; int apn; };

struct StaticOrder {
    int nM, nN, nwg, G, c;
    __host__ __device__ void init(int M, int N, int G_, int c_) { nM = M / BM; nN = N / BM; nwg = nM * nN; G = G_; c = c_; }
    __host__ __device__ bool next(int i, Unit& u) const {
        const long L = (long)i * G + c; if (L >= nwg) return false;
        int wgid = (int)L; { const int q = nwg / NXCD, r = nwg % NXCD, xcd = wgid % NXCD, off = wgid / NXCD; wgid = (xcd < r ? xcd * (q + 1) : r * (q + 1) + (xcd - r) * q) + off; }
        const int nig = WGM * nN, gid = wgid / nig, fm = gid * WGM, gsz = (nM - fm) < WGM ? (nM - fm) : WGM;
        u.pm = fm + ((wgid % nig) % gsz); u.pn = (wgid % nig) / gsz; return true;
    }
    __device__ __forceinline__ void a_ready(const Unit&) const {}
    __device__ __forceinline__ void done(const Unit&) const {}
};

__device__ __forceinline__ unsigned cvt_pk_bf16(float lo, float hi) { unsigned r; asm volatile("v_cvt_pk_bf16_f32 %0, %1, %2" : "=v"(r) : "v"(lo), "v"(hi)); return r; }
__device__ __forceinline__ float gelu_tanh(float x) {
    const float z = 0.7978845608028654f * (x + 0.044715f * x * x * x);
    const float e = __expf(2.0f * z);
    const float th = 1.0f - 2.0f * __builtin_amdgcn_rcpf(1.0f + e);
    return 0.5f * x * (1.0f + th);
}
struct EpiB {
    static constexpr bool PERM = true, AFTER_DRAIN = false, FUSED = false;
    bf16_t* O; int ldc; int split_cols; size_t split_stride; int mode;
    const float* rss;
    __device__ __forceinline__ void operator()(const f32x4 (&acc)[2][2][4][2], const Unit& u, int wr, int wc, int fr, int fq) const {
        const int row0 = u.pm * BM + wr * 64 + fr; int colt = u.pn * BM; bf16_t* base = O; int t = 0;
        if (split_cols) { t = colt / split_cols; base += (size_t)t * split_stride; colt -= t * split_cols; }
        const int act = (mode == 1) ? 1 : ((mode == 2 && t == 0) ? 2 : 0);
        const int col0 = colt + wc * 32 + 8 * fq;
#pragma unroll
        for (int ai = 0; ai < 2; ++ai)
#pragma unroll
            for (int m = 0; m < 4; ++m) { bf16_t* rowp = base + (size_t)(row0 + ai * HALF + m * 16) * ldc + col0;
                float rsc = 1.0f; if (rss) { const f32x4 pp = *(const f32x4*)(rss + (size_t)(row0 + ai * HALF + m * 16) * 4); rsc = rsqrtf(((pp[0] + pp[1]) + (pp[2] + pp[3])) * (1.0f / 1024.0f) + 1e-6f); }
#pragma unroll
                for (int bj = 0; bj < 2; ++bj) { f32x4 v0 = acc[ai][bj][m][0] * rsc, v1 = acc[ai][bj][m][1] * rsc;
                    if (act == 1) {
#pragma unroll
                        for (int e = 0; e < 4; ++e) { const float a = fmaxf(v0[e], 0.f), b = fmaxf(v1[e], 0.f); v0[e] = a * a; v1[e] = b * b; } }
                    else if (act == 2) {
#pragma unroll
                        for (int e = 0; e < 4; ++e) { v0[e] = gelu_tanh(v0[e]); v1[e] = gelu_tanh(v1[e]); } }
                    u32x4 w; w.x = cvt_pk_bf16(v0[0], v0[1]); w.y = cvt_pk_bf16(v0[2], v0[3]); w.z = cvt_pk_bf16(v1[0], v1[1]); w.w = cvt_pk_bf16(v1[2], v1[3]);
                    *(u32x4*)(rowp + bj * HALF) = w; } }
    }
};
__device__ __forceinline__ float bf2f(unsigned short h) { return __uint_as_float(((unsigned)h) << 16); }
__device__ __forceinline__ float sigmoidf_(float x) { return __builtin_amdgcn_rcpf(1.0f + __expf(-x)); }
__device__ __forceinline__ float one_minus_exp(float t) { const float ser = -t * (1.0f + t * (0.5f + t * (0.16666667f + t * (0.041666668f + t * 0.008333334f)))); return t > -0.25f ? ser : 1.0f - __expf(t); }
struct EpiGate {
    static constexpr bool PERM = false, AFTER_DRAIN = false, FUSED = false;
    const bf16_t* xc; bf16_t* Aout; bf16_t* Bout; const float* b_a; const float* b_x; const float* lam;
    __device__ __forceinline__ void operator()(const f32x4 (&acc)[2][2][4][2], const Unit& u, int wr, int wc, int fr, int fq) const {
#pragma unroll
        for (int n = 0; n < 2; ++n) {
            const int ch0 = 128 * u.pn + 32 * wc + 16 * n + 4 * fq;
            const f32x4 ba = *(const f32x4*)(b_a + ch0), bx = *(const f32x4*)(b_x + ch0), lm = *(const f32x4*)(lam + ch0);
            f32x4 sp;
#pragma unroll
            for (int e = 0; e < 4; ++e) sp[e] = -8.0f * log1pf(__expf(-lm[e]));
#pragma unroll
            for (int ai = 0; ai < 2; ++ai)
#pragma unroll
                for (int m = 0; m < 4; ++m) {
                    const size_t off = (size_t)(u.pm * BM + ai * HALF + wr * 64 + m * 16 + fr) * 1024 + ch0;
                    const uint2 xr = *(const uint2*)(xc + off);
                    float xv[4] = { __uint_as_float(xr.x << 16), __uint_as_float(xr.x & 0xffff0000u), __uint_as_float(xr.y << 16), __uint_as_float(xr.y & 0xffff0000u) };
                    f32x4 av, bv;
#pragma unroll
                    for (int e = 0; e < 4; ++e) {
                        const float r = sigmoidf_(acc[ai][0][m][n][e] + ba[e]);
                        const float ig = sigmoidf_(acc[ai][1][m][n][e] + bx[e]);
                        const float la = sp[e] * r;
                        av[e] = la;
                        bv[e] = __builtin_amdgcn_sqrtf(fmaxf(one_minus_exp(2.0f * la), 0.f)) * (ig * xv[e]);
                    }
                    uint2 wa, wb; wa.x = cvt_pk_bf16(av[0], av[1]); wa.y = cvt_pk_bf16(av[2], av[3]); wb.x = cvt_pk_bf16(bv[0], bv[1]); wb.y = cvt_pk_bf16(bv[2], bv[3]);
                    *(uint2*)(Aout + off) = wa; *(uint2*)(Bout + off) = wb;
                }
        }
    }
};

struct RowStats {
    float* xbuf;
    unsigned* cnt;
    unsigned target;
    __device__ __forceinline__ void run(const f32x4 (&v)[2][2][4][2], const Unit& u, int wr, int wc, int fr, int fq, PG8_LAS unsigned char* xl, int wid, int lane) const {
        PG8_LAS float* P = (PG8_LAS float*)xl;
        PG8_LAS float* S = (PG8_LAS float*)(xl + 4096);
#pragma unroll
        for (int ai = 0; ai < 2; ++ai)
#pragma unroll
            for (int m = 0; m < 4; ++m) {
                float s = 0.f;
#pragma unroll
                for (int bj = 0; bj < 2; ++bj)
#pragma unroll
                    for (int n = 0; n < 2; ++n) { const f32x4 x = v[ai][bj][m][n]; s += (x[0] * x[0] + x[1] * x[1]) + (x[2] * x[2] + x[3] * x[3]); }
                s += xor16f(s); s = sum32f(s);
                if (fq == 0) P[(ai * HALF + wr * 64 + m * 16 + fr) * 4 + wc] = s;
            }
        asm volatile("s_waitcnt lgkmcnt(0)" ::: "memory"); __builtin_amdgcn_s_barrier(); asm volatile("" ::: "memory");
        const int row = wid * 32 + (lane & 31);
        if (lane < 32) { const float t = (P[row * 4 + 0] + P[row * 4 + 1]) + (P[row * 4 + 2] + P[row * 4 + 3]);
            __hip_atomic_store(xbuf + (size_t)(u.pm * BM + row) * 4 + u.pn, t, __ATOMIC_RELAXED, __HIP_MEMORY_SCOPE_AGENT); }
        asm volatile("s_waitcnt vmcnt(0)" ::: "memory");
        if (lane == 0) __hip_atomic_fetch_add(cnt + 64 * u.pm, 1u, __ATOMIC_RELAXED, __HIP_MEMORY_SCOPE_AGENT);
        if (wid == 0) { unsigned sp = 0;
            while ((unsigned)__builtin_amdgcn_readfirstlane(__hip_atomic_load(cnt + 64 * u.pm, __ATOMIC_RELAXED, __HIP_MEMORY_SCOPE_AGENT)) < target) { __builtin_amdgcn_s_sleep(2); if (++sp > (1u << 18)) break; }
            __builtin_amdgcn_fence(__ATOMIC_ACQUIRE, "agent"); }
        asm volatile("s_waitcnt vmcnt(0) lgkmcnt(0)" ::: "memory"); __builtin_amdgcn_s_barrier(); asm volatile("" ::: "memory");
        if (lane < 32) { float* slot = xbuf + (size_t)(u.pm * BM + row) * 4; float t = 0.f;
#pragma unroll
            for (int k = 0; k < 4; ++k) t += __hip_atomic_load(slot + k, __ATOMIC_RELAXED, __HIP_MEMORY_SCOPE_AGENT);
            S[row] = t; }
        asm volatile("s_waitcnt lgkmcnt(0)" ::: "memory"); __builtin_amdgcn_s_barrier(); asm volatile("" ::: "memory");
    }
};
struct EpiNormRes {
    static constexpr bool PERM = false, AFTER_DRAIN = false, FUSED = true;
    bf16_t* hn; float* xs2; float* out; const float* gprev; const float* gpost; const float* gpre; RowStats st1; PG8_LAS unsigned char* xl;
    const float* s_in;
    __device__ __forceinline__ void fused(f32x4 (&acc)[2][2][4][2], const Unit& u, int wr, int wc, int fr, int fq, int wid, int lane) const {
        typedef unsigned u32x2v __attribute__((ext_vector_type(2)));
        PG8_LAS float* P = (PG8_LAS float*)xl;
        const PG8_LAS float* S = (const PG8_LAS float*)(xl + 4096);
        const int col0 = u.pn * BM + wc * 32 + 4 * fq;
        st1.run(acc, u, wr, wc, fr, fq, xl, wid, lane);
#pragma unroll
        for (int ai = 0; ai < 2; ++ai)
#pragma unroll
            for (int m = 0; m < 4; ++m) { const int r = ai * HALF + wr * 64 + m * 16 + fr; float rstd = rsqrtf(S[r] * (1.0f / 1024.0f) + 1e-6f); const size_t off = (size_t)(u.pm * BM + r) * 1024 + col0;
                if (s_in) { const f32x4 pp = *(const f32x4*)(s_in + (size_t)(u.pm * BM + r) * 4); const float s2 = __builtin_amdgcn_rcpf(((pp[0] + pp[1]) + (pp[2] + pp[3])) * (1.0f / 1024.0f) + 1e-6f);
                    rstd = rsqrtf(S[r] * (1.0f / 1024.0f) * s2 * s2 + 1e-6f) * s2; }
#pragma unroll
                for (int bj = 0; bj < 2; ++bj)
#pragma unroll
                    for (int n = 0; n < 2; ++n) { const u32x2v hw = *(const u32x2v*)(hn + off + bj * HALF + n * 16);
                        const f32x4 gp = *(const f32x4*)(gprev + col0 + bj * HALF + n * 16); const f32x4 gv = *(const f32x4*)(gpost + col0 + bj * HALF + n * 16);
                        f32x4 xs; xs[0] = __uint_as_float(hw.x << 16) * __builtin_amdgcn_rcpf(gp[0]); xs[1] = __uint_as_float(hw.x & 0xffff0000u) * __builtin_amdgcn_rcpf(gp[1]);
                        xs[2] = __uint_as_float(hw.y << 16) * __builtin_amdgcn_rcpf(gp[2]); xs[3] = __uint_as_float(hw.y & 0xffff0000u) * __builtin_amdgcn_rcpf(gp[3]);
                        acc[ai][bj][m][n] = xs + (acc[ai][bj][m][n] * rstd) * gv; }
                asm volatile("" : "+v"(acc[ai][0][m][0]), "+v"(acc[ai][0][m][1]), "+v"(acc[ai][1][m][0]), "+v"(acc[ai][1][m][1]));
                if (m & 1) asm volatile("" ::: "memory"); }
        if (gpre) {
#pragma unroll
            for (int ai = 0; ai < 2; ++ai)
#pragma unroll
                for (int m = 0; m < 4; ++m) {
                    float s = 0.f;
#pragma unroll
                    for (int bj = 0; bj < 2; ++bj)
#pragma unroll
                        for (int n = 0; n < 2; ++n) { const f32x4 x = acc[ai][bj][m][n]; s += (x[0] * x[0] + x[1] * x[1]) + (x[2] * x[2] + x[3] * x[3]); }
                    s += xor16f(s); s = sum32f(s);
                    if (fq == 0) P[(ai * HALF + wr * 64 + m * 16 + fr) * 4 + wc] = s;
                }
            asm volatile("s_waitcnt lgkmcnt(0)" ::: "memory"); __builtin_amdgcn_s_barrier(); asm volatile("" ::: "memory");
            { const int row = wid * 32 + (lane & 31);
              if (lane < 32) xs2[(size_t)(u.pm * BM + row) * 4 + u.pn] = (P[row * 4 + 0] + P[row * 4 + 1]) + (P[row * 4 + 2] + P[row * 4 + 3]); }
#pragma unroll
            for (int ai = 0; ai < 2; ++ai)
#pragma unroll
                for (int m = 0; m < 4; ++m) { const int r = ai * HALF + wr * 64 + m * 16 + fr; const size_t off = (size_t)(u.pm * BM + r) * 1024 + col0;
#pragma unroll
                    for (int bj = 0; bj < 2; ++bj)
#pragma unroll
                        for (int n = 0; n < 2; ++n) { const f32x4 gv = *(const f32x4*)(gpre + col0 + bj * HALF + n * 16); const f32x4 o = acc[ai][bj][m][n] * gv;
                            u32x2v w; w.x = cvt_pk_bf16(o[0], o[1]); w.y = cvt_pk_bf16(o[2], o[3]); *(u32x2v*)(hn + off + bj * HALF + n * 16) = w; }
                    asm volatile("" ::: "memory"); }
            asm volatile("s_waitcnt lgkmcnt(0)" ::: "memory"); __builtin_amdgcn_s_barrier(); asm volatile("" ::: "memory");
        } else {
#pragma unroll
            for (int ai = 0; ai < 2; ++ai)
#pragma unroll
                for (int m = 0; m < 4; ++m) { const int r = ai * HALF + wr * 64 + m * 16 + fr; const size_t off = (size_t)(u.pm * BM + r) * 1024 + col0;
#pragma unroll
                    for (int bj = 0; bj < 2; ++bj)
#pragma unroll
                        for (int n = 0; n < 2; ++n) *(f32x4*)(out + off + bj * HALF + n * 16) = acc[ai][bj][m][n]; }
        }
    }
};

template <class Epi, class Sched, bool ALIGN_EPI>
__device__ __forceinline__ void gemm_phase(PG8_LAS unsigned char* lds, const Gemm g, const Sched& S, const Epi& E, int tid0) {
    int tid_ = tid0; asm volatile("" : "+v"(tid_));
    const int tid = tid_, wid = __builtin_amdgcn_readfirstlane(tid >> 6), lane = tid & 63, wr = wid >> 2, wc = wid & 3, fr = lane & 15, fq = lane >> 4;
    const int K = g.K, nt = K / BK;
    unsigned voffA[2], voffB[2];
#pragma unroll
    for (int i = 0; i < 2; ++i) { int R, C; stage_rc(tid * 16 + i * 8192, R, C); const int Rb = Epi::PERM ? ((R & ~31) + perm32(R & 31)) : R;
        voffA[i] = (unsigned)(R * g.lda + C) * 2u; voffB[i] = (unsigned)(Rb * g.ldb + C) * 2u; }
    const size_t kstep = (size_t)(BK * 2);
    const size_t hstepA = (size_t)HALF * g.lda * 2, hstepB = (size_t)HALF * g.ldb * 2;
    const size_t tstepA = 2 * hstepA, tstepB = 2 * hstepB;
    const unsigned ldsw = (unsigned)wid * 1024u;
    const int aoff = lds_byte(wr * 64 + fr, fq * 8), boff = lds_byte(wc * 32 + fr, fq * 8);
#define PG8_SA(b, h) (((b) * 2 + (h)) * HTB)
#define PG8_SB(b, h) ((4 + (b) * 2 + (h)) * HTB)
#define PG8_STAGE(bufoff, gbase, voff) do { _Pragma("unroll") for (int _i = 0; _i < 2; ++_i) \
        __builtin_amdgcn_global_load_lds((const unsigned*)((const char*)(gbase) + (voff)[_i]), (PG8_LAS unsigned*)(lds + (bufoff) + ldsw + _i * 8192), 16, 0, 0); } while (0)
#define PG8_LDA(dst, b, h) do { _Pragma("unroll") for (int m = 0; m < 4; ++m) _Pragma("unroll") for (int k = 0; k < 2; ++k) dst[m][k] = *(const PG8_LAS bf16x8*)(lds + PG8_SA(b, h) + aoff + m * 2048 + k * 1024); } while (0)
#define PG8_LDB(dst, b, h) do { _Pragma("unroll") for (int n = 0; n < 2; ++n) _Pragma("unroll") for (int k = 0; k < 2; ++k) dst[n][k] = *(const PG8_LAS bf16x8*)(lds + PG8_SB(b, h) + boff + n * 2048 + k * 1024); } while (0)
#define PG8_MMA(ai, bj, At, Bt) do { __builtin_amdgcn_s_setprio(1); _Pragma("unroll") for (int m = 0; m < 4; ++m) _Pragma("unroll") for (int n = 0; n < 2; ++n) _Pragma("unroll") for (int k = 0; k < 2; ++k) \
        acc[ai][bj][m][n] = __builtin_amdgcn_mfma_f32_16x16x32_bf16(Bt[n][k], At[m][k], acc[ai][bj][m][n], 0, 0, 0); __builtin_amdgcn_s_setprio(0); } while (0)
#define PG8_WAIT_V(n) asm volatile("s_waitcnt vmcnt(" #n ")" ::: "memory")
#define PG8_WAIT_L(n) asm volatile("s_waitcnt lgkmcnt(" #n ")" ::: "memory")
#define PG8_BAR __builtin_amdgcn_s_barrier()
#define PG8_SCHED __builtin_amdgcn_sched_barrier(0)
    Unit cur, nxt; int ui = 0;
    if (!S.next(0, cur)) return;
    f32x4 acc[2][2][4][2];
#pragma unroll
    for (int a = 0; a < 2; ++a)
#pragma unroll
        for (int b = 0; b < 2; ++b)
#pragma unroll
            for (int m = 0; m < 4; ++m)
#pragma unroll
                for (int n = 0; n < 2; ++n) acc[a][b][m][n] = (f32x4){0.f, 0.f, 0.f, 0.f};
    bf16x8 At[4][2], B0[2][2], B1[2][2];
    const char* cA = (const char*)g.A + (size_t)cur.pm * tstepA + (size_t)(cur.pn >> 1) * (size_t)g.apn; const char* cB = (const char*)g.Bt + (size_t)cur.pn * tstepB;
    S.a_ready(cur);
    PG8_STAGE(PG8_SB(0, 0), cB, voffB); PG8_STAGE(PG8_SB(0, 1), cB + hstepB, voffB); PG8_STAGE(PG8_SA(0, 0), cA, voffA); PG8_STAGE(PG8_SA(0, 1), cA + hstepA, voffA);
    if (wr == 1) PG8_BAR;
    PG8_WAIT_V(2); PG8_BAR;
    PG8_STAGE(PG8_SB(1, 0), cB + kstep, voffB); PG8_STAGE(PG8_SA(1, 0), cA + kstep, voffA); PG8_STAGE(PG8_SB(1, 1), cB + hstepB + kstep, voffB);
    PG8_WAIT_V(6); PG8_BAR;
    for (;;) {
        const bool has_next = S.next(ui + 1, nxt);
        const char* nA = has_next ? (const char*)g.A + (size_t)nxt.pm * tstepA + (size_t)(nxt.pn >> 1) * (size_t)g.apn : cA; const char* nB = has_next ? (const char*)g.Bt + (size_t)nxt.pn * tstepB : cB;
        for (int t = 0; t < nt; t += 2) {
            const bool last = (t == nt - 2);
            const char* a1 = cA + (size_t)(t + 1) * kstep;
            const char* a2 = last ? nA : cA + (size_t)(t + 2) * kstep; const char* b2 = last ? nB : cB + (size_t)(t + 2) * kstep;
            const char* a3 = a2 + kstep; const char* b3 = b2 + kstep;
            if (last && has_next) S.a_ready(nxt);
            PG8_LDB(B0, 0, 0); PG8_LDB(B1, 0, 1); PG8_SCHED; PG8_LDA(At, 0, 0); PG8_STAGE(PG8_SA(1, 1), a1 + hstepA, voffA);
            PG8_WAIT_V(8); PG8_WAIT_L(0); PG8_BAR; PG8_MMA(0, 0, At, B0); PG8_MMA(0, 1, At, B1); PG8_BAR; PG8_SCHED;
            PG8_LDA(At, 0, 1); PG8_STAGE(PG8_SB(0, 0), b2, voffB); PG8_STAGE(PG8_SB(0, 1), b2 + hstepB, voffB); PG8_STAGE(PG8_SA(0, 0), a2, voffA);
            PG8_WAIT_V(8); PG8_WAIT_L(0); PG8_BAR; PG8_MMA(1, 0, At, B0); PG8_MMA(1, 1, At, B1); PG8_BAR; PG8_SCHED;
            PG8_LDB(B0, 1, 0); PG8_LDB(B1, 1, 1); PG8_SCHED; PG8_LDA(At, 1, 0); PG8_STAGE(PG8_SA(0, 1), a2 + hstepA, voffA);
            PG8_WAIT_V(8); PG8_WAIT_L(0); PG8_BAR; PG8_MMA(0, 0, At, B0); PG8_MMA(0, 1, At, B1); PG8_BAR; PG8_SCHED;
            PG8_LDA(At, 1, 1); PG8_STAGE(PG8_SB(1, 0), b3, voffB); PG8_STAGE(PG8_SB(1, 1), b3 + hstepB, voffB); PG8_STAGE(PG8_SA(1, 0), a3, voffA);
            PG8_WAIT_V(8); PG8_WAIT_L(0); PG8_BAR; PG8_MMA(1, 0, At, B0); PG8_MMA(1, 1, At, B1); PG8_BAR; PG8_SCHED;
        }
        if constexpr (ALIGN_EPI) { if (wr == 0) PG8_BAR; }
        if constexpr (Epi::FUSED) E.fused(acc, cur, wr, wc, fr, fq, wid, lane); else E(acc, cur, wr, wc, fr, fq);
        S.done(cur);
        if (!has_next) break;
#pragma unroll
        for (int a = 0; a < 2; ++a)
#pragma unroll
            for (int b = 0; b < 2; ++b)
#pragma unroll
                for (int m = 0; m < 4; ++m)
#pragma unroll
                    for (int n = 0; n < 2; ++n) acc[a][b][m][n] = (f32x4){0.f, 0.f, 0.f, 0.f};
        cur = nxt; cA = nA; cB = nB; ++ui;
        if constexpr (ALIGN_EPI) { if (wr == 1) PG8_BAR; }
    }
    PG8_WAIT_V(0);
    if constexpr (!ALIGN_EPI) { if (wr == 0) PG8_BAR; }
    PG8_BAR;
#undef PG8_SA
#undef PG8_SB
#undef PG8_STAGE
#undef PG8_LDA
#undef PG8_LDB
#undef PG8_MMA
#undef PG8_WAIT_V
#undef PG8_WAIT_L
#undef PG8_BAR
#undef PG8_SCHED
}
}
namespace att {
typedef unsigned short u16;
typedef short bf16x8 __attribute__((ext_vector_type(8)));
typedef short s16x4 __attribute__((ext_vector_type(4)));
typedef float f32x16 __attribute__((ext_vector_type(16)));
typedef float f32x4 __attribute__((ext_vector_type(4)));
typedef unsigned u32x4 __attribute__((ext_vector_type(4)));
constexpr int SEQ = 16384, NW = 8, QBLK = 32, KVBLK = 64, QB = NW * QBLK;
constexpr int LDQ = 1536, LDK = 2048, LDKR = 64, LDO = 1024;
#ifndef ATT_NQREG
#define ATT_NQREG 8
#endif
constexpr int NQREG = ATT_NQREG, NQREG_L = 8 - NQREG;
constexpr int SHM_V = KVBLK * 128 * 2, SHM_K = KVBLK * 128 * 2, SHM_KR = KVBLK * 64 * 2;
constexpr int OFF_V = 0, OFF_K = 2 * SHM_V, OFF_KR = OFF_K + 2 * SHM_K, OFF_WS = OFF_KR + 2 * SHM_KR, OFF_QR = OFF_WS + NW * 64 * 4, QR_WAVE = (NQREG_L + 4) * 1024, LDS_BYTES = OFF_QR + NW * QR_WAVE;
constexpr float SCALE = 0.07216878364870322f;
constexpr float THR = 8.f;

#define KSWZ(row, colB) ((row) * 256 + ((colB) ^ (((row) & 7) << 4)))
#define KRSWZ(row, colB) ((row) * 128 + ((colB) ^ (((row) & 7) << 4)))
#define SBAR() __builtin_amdgcn_sched_barrier(0)
__device__ __forceinline__ int v_st(int k, int c) { const int kk = (k & ~0xC) | ((k & 4) << 1) | ((k & 8) >> 1); return ((kk >> 3) * 4 + (c >> 5)) * 512 + ((kk & 7) * 32 + (c & 31)) * 2; }
__device__ __forceinline__ int v_rd_base(int lane) { return ((lane & 3) << 3) | (((lane >> 2) & 3) << 6) | (((lane >> 4) & 1) << 5) | (((lane >> 5) & 1) << 8); }
constexpr int v_rd_off(int d0, int ks, int half) { return d0 * 512 + ks * 4096 + half * 2048; }
__device__ __forceinline__ int crow(int r, int hi) { return (r & 3) + 8 * (r >> 2) + 4 * hi; }
__device__ __forceinline__ unsigned cvtpk(float lo, float hi) { unsigned r; asm volatile("v_cvt_pk_bf16_f32 %0, %1, %2" : "=v"(r) : "v"(lo), "v"(hi)); return r; }
__device__ __forceinline__ bf16x8 load8(const u16* p) { return *reinterpret_cast<const bf16x8*>(p); }
__device__ __forceinline__ void mask_tile(f32x16& p0, f32x16& p1, int dq, unsigned W) {
    const float NEG = -__builtin_inff();
#pragma unroll
    for (int r = 0; r < 16; ++r) {
        const int c = (r & 3) + 8 * (r >> 2);
        if ((unsigned)(dq - c) >= W) p0[r] = NEG;
        if ((unsigned)(dq - c - 32) >= W) p1[r] = NEG;
    }
}
__device__ __forceinline__ void partialSM(f32x16& p0, f32x16& p1, float& m_reg, float& mn, float& alpha) {
    float pmax = p0[0]; for (int r = 1; r < 16; ++r) pmax = fmaxf(pmax, p0[r]); for (int r = 0; r < 16; ++r) pmax = fmaxf(pmax, p1[r]);
    { auto rr = __builtin_amdgcn_permlane32_swap(__float_as_uint(pmax), __float_as_uint(pmax), false, false);
      pmax = fmaxf(__uint_as_float(rr[0]), __uint_as_float(rr[1])); }
    constexpr float C2 = 1.4426950408889634f * SCALE;
    if (__builtin_expect(__all((pmax - m_reg) * SCALE <= THR), 1)) { mn = m_reg; alpha = 1.f; }
    else { mn = fmaxf(m_reg, pmax); alpha = __builtin_amdgcn_exp2f((m_reg - mn) * C2); m_reg = mn; }
    const float mnL = -mn * C2;
    for (int r = 0; r < 16; ++r) p0[r] = fmaf(p0[r], C2, mnL); for (int r = 0; r < 16; ++r) p1[r] = fmaf(p1[r], C2, mnL);
}
__device__ __forceinline__ void finishSM(f32x16& p0, f32x16& p1, float alpha, float& l_reg, bf16x8& pa0, bf16x8& pa1, bf16x8& pa2, bf16x8& pa3) {
    for (int r = 0; r < 16; ++r) p0[r] = __builtin_amdgcn_exp2f(p0[r]);
    for (int r = 0; r < 16; ++r) p1[r] = __builtin_amdgcn_exp2f(p1[r]);
    float ps = 0; for (int r = 0; r < 16; ++r) ps += p0[r]; for (int r = 0; r < 16; ++r) ps += p1[r];
    { auto rr = __builtin_amdgcn_permlane32_swap(__float_as_uint(ps), __float_as_uint(ps), false, false);
      ps = __uint_as_float(rr[0]) + __uint_as_float(rr[1]); }
    l_reg = l_reg * alpha + ps;
#define PK4(P, B_, OUT) do { unsigned a0 = cvtpk(P[B_+0], P[B_+1]), a1 = cvtpk(P[B_+2], P[B_+3]);                          \
        unsigned b0 = cvtpk(P[B_+4], P[B_+5]), b1 = cvtpk(P[B_+6], P[B_+7]);                                             \
        auto r0 = __builtin_amdgcn_permlane32_swap(a0, b0, false, false); auto r1 = __builtin_amdgcn_permlane32_swap(a1, b1, false, false); \
        u32x4 w = {r0[0], r1[0], r0[1], r1[1]}; OUT = *reinterpret_cast<bf16x8*>(&w); } while (0)
    PK4(p0, 0, pa0); PK4(p0, 8, pa1); PK4(p1, 0, pa2); PK4(p1, 8, pa3);
#undef PK4
}
#ifndef ATT_PF
#define ATT_PF 1
#endif
#define QK_SB() __builtin_amdgcn_sched_barrier(0x406)
#define QK_LOAD(s, SET) do { if ((s) < 8) { const char* a_ = kb[(s) & 3] + ((s) >> 2) * 128; fb0[SET] = *reinterpret_cast<const bf16x8*>(a_); fb1[SET] = *reinterpret_cast<const bf16x8*>(a_ + 32 * 256); \
            if ((s) < NQREG) fq[SET] = qr[(s) < NQREG ? (s) : 0]; else fq[SET] = qrl[((s) - NQREG) * 64]; } \
        else { const char* a_ = krb[((s) - 8) & 3]; fb0[SET] = *reinterpret_cast<const bf16x8*>(a_); fb1[SET] = *reinterpret_cast<const bf16x8*>(a_ + 32 * 128); fq[SET] = qrl[(NQREG_L + (s) - 8) * 64]; } } while (0)
template <int KB>
__device__ __forceinline__ void qkt(f32x16& p0, f32x16& p1, const char* K_lds, const char* KR_lds, const bf16x8* qrl, int r32, int hi, const bf16x8* qr) {
    constexpr int PF = ATT_PF, NS = PF + 1;
    p0 = f32x16{}; p1 = f32x16{};
    const char* kb[4]; const char* krb[4];
#pragma unroll
    for (int dd = 0; dd < 4; ++dd) { kb[dd] = K_lds + KB * SHM_K + KSWZ(r32, (dd * 16 + hi * 8) * 2); krb[dd] = KR_lds + KB * SHM_KR + KRSWZ(r32, (dd * 16 + hi * 8) * 2); }
    bf16x8 fb0[NS], fb1[NS], fq[NS];
#pragma unroll
    for (int s = 0; s < PF; ++s) QK_LOAD(s, s % NS);
#pragma unroll
    for (int s = 0; s < 12; ++s) {
        QK_SB();
        if (s + PF < 12) QK_LOAD(s + PF, (s + PF) % NS);
        QK_SB();
        p0 = __builtin_amdgcn_mfma_f32_32x32x16_bf16(fb0[s % NS], fq[s % NS], p0, 0, 0, 0);
        p1 = __builtin_amdgcn_mfma_f32_32x32x16_bf16(fb1[s % NS], fq[s % NS], p1, 0, 0, 0);
    }
    QK_SB();
}
#define FSM_E(j) do { if ((j) < 16) { y0[(j) & 15] = __builtin_amdgcn_exp2f(y0[(j) & 15]); acc += y0[(j) & 15]; } else { y1[(j) & 15] = __builtin_amdgcn_exp2f(y1[(j) & 15]); acc += y1[(j) & 15]; } } while (0)
#define FSM_CVT(P, B_) do { ca0 = cvtpk(P[(B_) + 0], P[(B_) + 1]); ca1 = cvtpk(P[(B_) + 2], P[(B_) + 3]); cb0 = cvtpk(P[(B_) + 4], P[(B_) + 5]); cb1 = cvtpk(P[(B_) + 6], P[(B_) + 7]); } while (0)
#define FSM_SWP(OUT) do { auto r0_ = __builtin_amdgcn_permlane32_swap(ca0, cb0, false, false); auto r1_ = __builtin_amdgcn_permlane32_swap(ca1, cb1, false, false); \
        u32x4 w_ = {r0_[0], r1_[0], r0_[1], r1_[1]}; OUT = *reinterpret_cast<bf16x8*>(&w_); } while (0)
#define FSM_CHUNK(c) do { if ((c) < 12) { FSM_E(2 * (c)); FSM_E(2 * (c) + 1); } else if ((c) < 20) { FSM_E(24 + (c) - 12); } \
        if ((c) == 12) FSM_CVT(y0, 0); if ((c) == 13) FSM_SWP(pa0); if ((c) == 14) FSM_CVT(y0, 8); if ((c) == 15) FSM_SWP(pa1); \
        if ((c) == 16) FSM_CVT(y1, 0); if ((c) == 17) FSM_SWP(pa2); if ((c) == 20) FSM_CVT(y1, 8); if ((c) == 21) FSM_SWP(pa3); \
        if ((c) == 22) { auto rr_ = __builtin_amdgcn_permlane32_swap(__float_as_uint(acc), __float_as_uint(acc), false, false); acc = __uint_as_float(rr_[0]) + __uint_as_float(rr_[1]); } \
        if ((c) == 23) l_reg = l_reg * alpha + acc; } while (0)
#define SB0() __builtin_amdgcn_sched_barrier(0)
#define QKN(j) ((j) >= 12 ? 0 : ((j) < NQREG ? 2 : 3))
#define DSR128(dst, addr, off) asm volatile("ds_read_b128 %0, %1 offset:%2" : "=v"(dst) : "v"(addr), "i"(off) : "memory")
#define QKA_LOAD(s, SET) do { if ((s) < 8) { DSR128(fb0[SET], ka[(s) & 3], KB * SHM_K + ((s) >> 2) * 128); DSR128(fb1[SET], ka[(s) & 3], KB * SHM_K + ((s) >> 2) * 128 + 32 * 256); \
            if ((s) >= NQREG) DSR128(fq[SET], qa, (((s) - NQREG) & 15) * 1024); } \
        else if ((s) < 12) { DSR128(fb0[SET], kra[((s) - 8) & 3], KB * SHM_KR); DSR128(fb1[SET], kra[((s) - 8) & 3], KB * SHM_KR + 32 * 128); DSR128(fq[SET], qa, ((NQREG_L + (s) - 8) & 15) * 1024); } } while (0)
#define QKQ(s) ((s) < NQREG ? qr[(s) < NQREG ? (s) : 0] : fq[(s) % 3])
#define QKA_STEP(s) do { SB0(); QKA_LOAD((s) + 2, ((s) + 2) % 3); SB0(); \
        asm volatile("s_waitcnt lgkmcnt(%0)" :: "i"(QKN((s) + 1) + QKN((s) + 2)) : "memory"); SB0(); \
        p0 = __builtin_amdgcn_mfma_f32_32x32x16_bf16(fb0[(s) % 3], QKQ(s), p0, 0, 0, 0); SB0(); FSM_CHUNK(2 * (s)); SB0(); \
        p1 = __builtin_amdgcn_mfma_f32_32x32x16_bf16(fb1[(s) % 3], QKQ(s), p1, 0, 0, 0); SB0(); FSM_CHUNK(2 * (s) + 1); } while (0)
template <int KB>
__device__ __forceinline__ void qkt_fsm(f32x16& p0, f32x16& p1, const char* K_lds, const char* KR_lds, const bf16x8* qrl, int r32, int hi, const bf16x8* qr,
                                        f32x16& y0, f32x16& y1, float alpha, float& l_reg, bf16x8& pa0, bf16x8& pa1, bf16x8& pa2, bf16x8& pa3) {
    p0 = f32x16{}; p1 = f32x16{};
    int ka[4], kra[4]; const int qa = (int)(uintptr_t)qrl;
#pragma unroll
    for (int dd = 0; dd < 4; ++dd) { ka[dd] = (int)(uintptr_t)K_lds + KSWZ(r32, (dd * 16 + hi * 8) * 2); kra[dd] = (int)(uintptr_t)KR_lds + KRSWZ(r32, (dd * 16 + hi * 8) * 2); }
    bf16x8 fb0[3], fb1[3], fq[3];
    float acc = 0.f; unsigned ca0 = 0, ca1 = 0, cb0 = 0, cb1 = 0;
    SB0(); QKA_LOAD(0, 0); QKA_LOAD(1, 1);
    QKA_STEP(0); QKA_STEP(1); QKA_STEP(2); QKA_STEP(3); QKA_STEP(4); QKA_STEP(5); QKA_STEP(6); QKA_STEP(7); QKA_STEP(8); QKA_STEP(9); QKA_STEP(10); QKA_STEP(11);
    SB0();
}
#undef QKN
#undef DSR128
#undef QKA_LOAD
#undef QKQ
#undef QKA_STEP
#undef FSM_E
#undef FSM_CVT
#undef FSM_SWP
#undef FSM_CHUNK
#undef QK_LOAD
template <int VB>
__device__ __forceinline__ void pv_tile(f32x16* o, int vb0, bf16x8 pa0, bf16x8 pa1, bf16x8 pa2, bf16x8 pa3) {
#define TRRD(dst, off) asm volatile("ds_read_b64_tr_b16 %0, %1 offset:%2" : "=&v"(dst) : "v"(vb0), "i"(off) : "memory")
#define PV_D0(d0) do { s16x4 l0, l1, l2, l3, h0, h1, h2, h3; constexpr int b_ = OFF_V + VB * SHM_V + v_rd_off(d0, 0, 0); \
        TRRD(l0, b_); TRRD(h0, b_ + 2048); TRRD(l1, b_ + 4096); TRRD(h1, b_ + 6144); TRRD(l2, b_ + 8192); TRRD(h2, b_ + 10240); TRRD(l3, b_ + 12288); TRRD(h3, b_ + 14336); \
        asm volatile("s_waitcnt lgkmcnt(0)" ::: "memory"); SBAR();   \
        o[d0] = __builtin_amdgcn_mfma_f32_32x32x16_bf16(pa0, (bf16x8){l0[0], l0[1], l0[2], l0[3], h0[0], h0[1], h0[2], h0[3]}, o[d0], 0, 0, 0);   \
        o[d0] = __builtin_amdgcn_mfma_f32_32x32x16_bf16(pa1, (bf16x8){l1[0], l1[1], l1[2], l1[3], h1[0], h1[1], h1[2], h1[3]}, o[d0], 0, 0, 0);   \
        o[d0] = __builtin_amdgcn_mfma_f32_32x32x16_bf16(pa2, (bf16x8){l2[0], l2[1], l2[2], l2[3], h2[0], h2[1], h2[2], h2[3]}, o[d0], 0, 0, 0);   \
        o[d0] = __builtin_amdgcn_mfma_f32_32x32x16_bf16(pa3, (bf16x8){l3[0], l3[1], l3[2], l3[3], h3[0], h3[1], h3[2], h3[3]}, o[d0], 0, 0, 0); } while (0)
    PV_D0(0); PV_D0(1); PV_D0(2); PV_D0(3);
}
template <int VB>
__device__ __forceinline__ void pv_tile_sm(f32x16* o, int vb0, bf16x8 pa0, bf16x8 pa1, bf16x8 pa2, bf16x8 pa3, f32x16& p0, f32x16& p1, float& m_reg, float& mn, float& alpha) {
    constexpr float C2 = 1.4426950408889634f * SCALE;
    PV_D0(0);
    float pmax = p0[0];
#pragma unroll
    for (int r = 1; r < 16; ++r) pmax = fmaxf(pmax, p0[r]);
#pragma unroll
    for (int r = 0; r < 16; ++r) pmax = fmaxf(pmax, p1[r]);
    PV_D0(1);
    { auto rr = __builtin_amdgcn_permlane32_swap(__float_as_uint(pmax), __float_as_uint(pmax), false, false);
      pmax = fmaxf(__uint_as_float(rr[0]), __uint_as_float(rr[1])); }
    const bool keep = __all((pmax - m_reg) * SCALE <= THR);
    mn = keep ? m_reg : fmaxf(m_reg, pmax);
    alpha = __builtin_amdgcn_exp2f((m_reg - mn) * C2);
    m_reg = mn;
    const float mnL = -mn * C2;
#pragma unroll
    for (int r = 0; r < 16; ++r) p0[r] = fmaf(p0[r], C2, mnL);
    PV_D0(2);
#pragma unroll
    for (int r = 0; r < 16; ++r) p1[r] = fmaf(p1[r], C2, mnL);
    PV_D0(3);
}
#undef PV_D0
#undef TRRD

struct BlockRef { const u16* Q; const u16* K; const u16* V; const u16* KR; u16* O; int P0; int row0; };
#define VMW() asm volatile("s_waitcnt vmcnt(0)" ::: "memory")
#define ATT_LAS __attribute__((address_space(3)))
#define KDMA(Kp, KRp, k0, bf) do { \
        __builtin_amdgcn_global_load_lds((const unsigned*)((Kp) + (size_t)((k0) + sr) * LDK + ksc), (ATT_LAS unsigned*)(ldsL + OFF_K + (bf) * SHM_K + wid * 1024), 16, 0, 0); \
        __builtin_amdgcn_global_load_lds((const unsigned*)((Kp) + (size_t)((k0) + 32 + sr) * LDK + ksc), (ATT_LAS unsigned*)(ldsL + OFF_K + (bf) * SHM_K + 8192 + wid * 1024), 16, 0, 0); \
        __builtin_amdgcn_global_load_lds((const unsigned*)((KRp) + (size_t)((k0) + krr) * LDKR + krsc), (ATT_LAS unsigned*)(ldsL + OFF_KR + (bf) * SHM_KR + wid * 1024), 16, 0, 0); } while (0)
#define VDMA(Vp, k0, bf) do { \
        __builtin_amdgcn_global_load_lds((const unsigned*)((Vp) + (size_t)((k0) + vk) * LDK + vc), (ATT_LAS unsigned*)(ldsL + OFF_V + (bf) * SHM_V + wid * 1024), 16, 0, 0); \
        __builtin_amdgcn_global_load_lds((const unsigned*)((Vp) + (size_t)((k0) + 32 + vk) * LDK + vc), (ATT_LAS unsigned*)(ldsL + OFF_V + (bf) * SHM_V + 8192 + wid * 1024), 16, 0, 0); } while (0)
#define ATT_MAPS() const int sr = tid >> 4, ksc = ((tid & 15) ^ (sr & 7)) * 8, krr = tid >> 3, krsc = ((tid & 7) ^ (krr & 7)) * 8; ATT_LAS unsigned char* ldsL = (ATT_LAS unsigned char*)lds; \
    const int vkk_ = ((tid >> 7) << 3) | ((tid >> 2) & 7), vk = (vkk_ & ~0xC) | ((vkk_ & 4) << 1) | ((vkk_ & 8) >> 1), vc = ((tid >> 5) & 3) * 32 + (tid & 3) * 8
__device__ __forceinline__ void attn_prime(const BlockRef& cur, char* lds, int tid0) {
    int tid_ = tid0; asm volatile("" : "+v"(tid_));
    const int tid = tid_, wid = __builtin_amdgcn_readfirstlane(tid >> 6);
    ATT_MAPS();
    KDMA(cur.K, cur.KR, 0, 0); VDMA(cur.V, 0, 0); VMW();
    __syncthreads();
}
__device__ __forceinline__ void attn_block(const BlockRef& cur, const BlockRef& nxt, char* lds, int tid0, const float* ctab, const float* stab) {
    int tid_ = tid0; asm volatile("" : "+v"(tid_));
    const int tid = tid_, wid = __builtin_amdgcn_readfirstlane(tid >> 6), lane = tid & 63, r32 = lane & 31, hi = lane >> 5;
    const unsigned W = 0x40000000u;
    const int NT = (cur.P0 + QB - 1) / KVBLK + 1;
    const int qlo = cur.P0 + wid * QBLK, qm = qlo + r32 - 4 * hi;
    char* K_lds = lds + OFF_K; char* KR_lds = lds + OFF_KR;
    float* ws = (float*)(lds + OFF_WS) + wid * 64; float* li_l = ws, * al_l = ws + 32;
    bf16x8* qrl = (bf16x8*)(lds + OFF_QR + wid * QR_WAVE) + lane;
    float m_reg = -1e30f, l_reg = 0; f32x16 o[4] = {};
    ATT_MAPS();
    const int vb0 = (int)(uintptr_t)lds + v_rd_base(lane);
    const u16* Kh = cur.K; const u16* Vh = cur.V; const u16* KRh = cur.KR;
#define RESC(a) do { if (__any((a) < 1.f)) { if (hi == 0) al_l[r32] = (a); asm volatile("s_waitcnt lgkmcnt(0)" ::: "memory");              \
                     for (int d_ = 0; d_ < 4; ++d_) for (int r = 0; r < 16; ++r) o[d_][r] *= al_l[crow(r, hi)]; } } while (0)
#define KBASE(t) ((t) * KVBLK)
#define MASKT(P0_, P1_, t) do { const int kb_ = KBASE(t); if (kb_ + KVBLK - 1 > qlo) mask_tile(P0_, P1_, qm - kb_, W); } while (0)
    f32x16 pA0, pA1, pB0, pB1; float mnA, mnB, alA, alB; bf16x8 pa0, pa1, pa2, pa3;
    bf16x8 qr[NQREG > 0 ? NQREG : 1];
    { const u16* qp = cur.Q + (size_t)(wid * QBLK + r32) * LDQ + hi * 8;
#pragma unroll
      for (int d = 0; d < NQREG_L; ++d) qrl[d * 64] = load8(qp + (NQREG + d) * 16);
      const size_t trow = (size_t)(cur.row0 + wid * QBLK + r32) * 32 + hi * 8;
#pragma unroll
      for (int pr = 0; pr < 2; ++pr) {
          const bf16x8 x1 = load8(qp + 128 + pr * 16), x2 = load8(qp + 128 + 32 + pr * 16);
          const f32x4 c0 = *(const f32x4*)(ctab + trow + pr * 16), c1 = *(const f32x4*)(ctab + trow + pr * 16 + 4), s0 = *(const f32x4*)(stab + trow + pr * 16), s1 = *(const f32x4*)(stab + trow + pr * 16 + 4);
          float o1[8], o2[8];
#pragma unroll
          for (int e = 0; e < 8; ++e) { const float a = __uint_as_float(((unsigned)(unsigned short)x1[e]) << 16), b = __uint_as_float(((unsigned)(unsigned short)x2[e]) << 16);
              const float cc = e < 4 ? c0[e & 3] : c1[e & 3], ss = e < 4 ? s0[e & 3] : s1[e & 3]; o1[e] = a * cc - b * ss; o2[e] = b * cc + a * ss; }
          u32x4 w1 = {cvtpk(o1[0], o1[1]), cvtpk(o1[2], o1[3]), cvtpk(o1[4], o1[5]), cvtpk(o1[6], o1[7])}, w2 = {cvtpk(o2[0], o2[1]), cvtpk(o2[2], o2[3]), cvtpk(o2[4], o2[5]), cvtpk(o2[6], o2[7])};
          qrl[(NQREG_L + pr) * 64] = *reinterpret_cast<bf16x8*>(&w1); qrl[(NQREG_L + 2 + pr) * 64] = *reinterpret_cast<bf16x8*>(&w2); }
#pragma unroll
      for (int d0 = 0; d0 < NQREG; ++d0) qr[d0] = load8(qp + d0 * 16); }
    SBAR();
    KDMA(Kh, KRh, KBASE(1), 1); VDMA(Vh, KBASE(1), 1);
    SBAR(); qkt<0>(pA0, pA1, K_lds, KR_lds, qrl, r32, hi, qr);
    MASKT(pA0, pA1, 0); partialSM(pA0, pA1, m_reg, mnA, alA);
    VMW(); __syncthreads();
    KDMA(Kh, KRh, KBASE(2), 0);
#define HALF_STEP(PX0, PX1, mnX, alX, PY0, PY1, alY, t, KB, VB) do {                                                          \
        SBAR(); qkt_fsm<KB>(PX0, PX1, K_lds, KR_lds, qrl, r32, hi, qr, PY0, PY1, alY, l_reg, pa0, pa1, pa2, pa3); SBAR();               \
        MASKT(PX0, PX1, (t)); SBAR(); pv_tile_sm<VB>(o, vb0, pa0, pa1, pa2, pa3, PX0, PX1, m_reg, mnX, alX);                  \
        VMW(); __syncthreads();                                                                                               \
        if ((t) + 2 < NT) KDMA(Kh, KRh, KBASE((t) + 2), KB);                                                                  \
        if ((t) + 1 < NT) VDMA(Vh, KBASE((t) + 1), VB);                                                                       \
        SBAR(); RESC(alX); } while (0)
    for (int t = 1; t + 1 < NT; t += 2) {
        HALF_STEP(pB0, pB1, mnB, alB, pA0, pA1, alA, t, 1, 0);
        HALF_STEP(pA0, pA1, mnA, alA, pB0, pB1, alB, t + 1, 0, 1);
    }
    SBAR(); qkt_fsm<1>(pB0, pB1, K_lds, KR_lds, qrl, r32, hi, qr, pA0, pA1, alA, l_reg, pa0, pa1, pa2, pa3); SBAR();
    MASKT(pB0, pB1, NT - 1); SBAR(); pv_tile_sm<0>(o, vb0, pa0, pa1, pa2, pa3, pB0, pB1, m_reg, mnB, alB);
    VMW(); __syncthreads();
    KDMA(nxt.K, nxt.KR, 0, 0); VDMA(nxt.V, 0, 0);
    SBAR(); RESC(alB);
    finishSM(pB0, pB1, alB, l_reg, pa0, pa1, pa2, pa3); SBAR(); pv_tile<1>(o, vb0, pa0, pa1, pa2, pa3);
    SBAR();
    if (hi == 0) li_l[r32] = l_reg; asm volatile("s_waitcnt lgkmcnt(0)" ::: "memory");
    float rli[16];
#pragma unroll
    for (int r = 0; r < 16; ++r) rli[r] = __builtin_amdgcn_rcpf(li_l[crow(r, hi)]);
    u16* Ow = cur.O + (size_t)(wid * QBLK) * LDO;
#pragma unroll
    for (int r = 0; r < 16; ++r) { const int orow = crow(r, hi);
#pragma unroll
        for (int d0 = 0; d0 < 4; ++d0) { const float v = o[d0][r] * rli[r];
            const float vn = xor1f(v);
            if ((r32 & 1) == 0) *(unsigned*)(Ow + (size_t)orow * LDO + d0 * 32 + r32) = cvtpk(v, vn); } }
    VMW(); __syncthreads();
#undef RESC
#undef KBASE
#undef MASKT
#undef HALF_STEP
}
struct Tensors { const u16* q; const u16* kv; const u16* kr; u16* o; const float* ctab; const float* stab; };
__device__ __forceinline__ BlockRef make_ref(const Tensors& T, int L, int pass) {
    const int bh = (L & 7) + 8 * (L >> 8), x = (L >> 3) & 31, b = bh >> 3, h = bh & 7, qb = pass ? 63 - x : x;
    BlockRef r; const size_t row0 = (size_t)b * SEQ;
    r.Q = T.q + (row0 + (size_t)qb * QB) * LDQ + h * 192; r.K = T.kv + row0 * LDK + h * 256; r.V = r.K + 128; r.KR = T.kr + row0 * LDKR;
    r.O = T.o + (row0 + (size_t)qb * QB) * LDO + h * 128; r.P0 = qb * QB; r.row0 = b * SEQ + qb * QB;
    return r;
}
__device__ __forceinline__ void attn_phase(char* lds, const Tensors& T, int tid0) {
    const int total = 512, stride = gridDim.x;
    int L = blockIdx.x; if (L >= total) return;
    int pass = 0;
    BlockRef cur = make_ref(T, L, 0);
    attn_prime(cur, lds, tid0);
    for (;;) {
        const bool more_pass = pass == 0, more_item = L + stride < total, last = !more_pass && !more_item;
        int passn = pass + 1, Ln = L;
        if (!more_pass) { passn = 0; Ln = more_item ? L + stride : L; }
        const BlockRef nxt = last ? cur : make_ref(T, Ln, passn);
        attn_block(cur, nxt, lds, tid0, T.ctab, T.stab);
        if (last) break;
        cur = nxt; pass = passn; L = Ln;
    }
}
#undef VMW
#undef KDMA
#undef VDMA
#undef ATT_MAPS
#undef SBAR
}
namespace xb {
#define LAS __attribute__((address_space(3)))
#define XB_TMO      128
#define XB_XCNT(j)  (256  + 64 * (j))
#define XB_XSUB(j)  (1280 + 64 * (j))
#define XB_XGEN(j)  (2304 + 64 * (j))
#define XB_TOP      3328
#define XB_TOPGEN   3392
#define XCD_BAR_WORDS 3456
#define XB_SPIN_CAP (1u << 18)

__device__ __forceinline__ unsigned xb_ld(unsigned* p)              { return __hip_atomic_load(p, __ATOMIC_RELAXED, __HIP_MEMORY_SCOPE_AGENT); }
__device__ __forceinline__ unsigned xb_add(unsigned* p, unsigned v) { return __hip_atomic_fetch_add(p, v, __ATOMIC_RELAXED, __HIP_MEMORY_SCOPE_AGENT); }
__device__ __forceinline__ unsigned xb_xcc_id() { return (unsigned)__builtin_amdgcn_s_getreg((3 << 11) | 20) & 0xFu; }
#define XB_SPIN(cond, bar) do { unsigned _sp = 0; while (cond) { __builtin_amdgcn_s_sleep(1); \
    if ((++_sp & 255u) == 0u) { if (xb_ld(&(bar)[XB_TMO])) break; if (_sp > XB_SPIN_CAP) { atomicAdd(&(bar)[XB_TMO], 1u); break; } } } } while (0)

struct XcdBarrier {
    unsigned* bar; unsigned x;
    volatile LAS unsigned* st;
};

__device__ __forceinline__ XcdBarrier xcd_barrier_post(unsigned* bar, volatile LAS unsigned* st) {
    XcdBarrier b; b.bar = bar; b.x = xb_xcc_id(); b.st = st;
    if (threadIdx.x == 0) (void)xb_add(&bar[XB_XCNT(b.x)], 1u);
    return b;
}
__device__ __forceinline__ void xcd_barrier_complete(unsigned* bar, unsigned x, unsigned& nloc, unsigned& nx) {
    const unsigned G = gridDim.x * gridDim.y * gridDim.z;
    unsigned sum, cnt, mine, sp = 0u;
    for (;;) {
        sum = 0u; cnt = 0u; mine = 0u;
#pragma unroll
        for (unsigned j = 0; j < 16; ++j) { const unsigned c = xb_ld(&bar[XB_XCNT(j)]); sum += c; cnt += (c > 0u) ? 1u : 0u; mine = (j == x) ? c : mine; }
        if (sum == G) break;
        __builtin_amdgcn_s_sleep(1);
        if ((++sp & 255u) == 0u) { if (xb_ld(&bar[XB_TMO])) break; if (sp > XB_SPIN_CAP) { atomicAdd(&bar[XB_TMO], 1u); break; } }
    }
    nloc = mine > 0u ? mine : 1u; nx = cnt > 0u ? cnt : 1u;
}

__device__ __forceinline__ void xcd_barrier(const XcdBarrier& b, bool t0  ) {
    asm volatile("s_waitcnt vmcnt(0)" ::: "memory");
    __syncthreads();
    if (t0) {
        unsigned* bar = b.bar;
        __builtin_amdgcn_s_waitcnt(0);
        unsigned nloc = b.st[0], nx = b.st[1];
        if (nloc == 0u) { xcd_barrier_complete(bar, b.x, nloc, nx); b.st[0] = nloc; b.st[1] = nx; }
        const unsigned old = xb_add(&bar[XB_XSUB(b.x)], 1u);
        const unsigned gen = old / nloc;
        if (old + 1u == (gen + 1u) * nloc) {
            __builtin_amdgcn_fence(__ATOMIC_RELEASE, "agent");
            asm volatile("s_waitcnt vmcnt(0)" ::: "memory");
            const unsigned og = xb_add(&bar[XB_TOP], 1u);
            const unsigned tg = og / nx;
            if (og + 1u == (tg + 1u) * nx) xb_add(&bar[XB_TOPGEN], 1u);
            else XB_SPIN(xb_ld(&bar[XB_TOPGEN]) == tg, bar);
            __builtin_amdgcn_fence(__ATOMIC_ACQUIRE, "agent");
            xb_add(&bar[XB_XGEN(b.x)], 1u);
            asm volatile("s_waitcnt vmcnt(0)" ::: "memory");
        } else {
            XB_SPIN(xb_ld(&bar[XB_XGEN(b.x)]) == gen, bar);
            __builtin_amdgcn_fence(__ATOMIC_ACQUIRE, "agent");
            asm volatile("s_waitcnt vmcnt(0)" ::: "memory");
        }
    }
    __syncthreads();
}
#undef LAS
}
#ifndef PROBE_ATT_REPS
#define PROBE_ATT_REPS 1
#endif
#ifndef PROBE_SYNC_REPS
#define PROBE_SYNC_REPS 1
#endif
#ifndef PROBE_THIN_REPS
#define PROBE_THIN_REPS 1
#endif
#ifndef PROBE_PRO_REPS
#define PROBE_PRO_REPS 1
#endif
#ifndef STAGGER_TICKS
#define STAGGER_TICKS 0
#endif
#ifndef PROBE_GEMM_OP
#define PROBE_GEMM_OP -1
#endif
#ifndef PROBE_GEMM_REPS
#define PROBE_GEMM_REPS 1
#endif
namespace mk {
typedef unsigned short u16;
typedef float f32x4 __attribute__((ext_vector_type(4)));
constexpr int M = 32768, D = 1024, SEQ = 16384;
constexpr float EPS = 1e-6f;
constexpr size_t MB = (size_t)1 << 20;
__host__ __device__ constexpr size_t WT_MLA(int j) { return (size_t)j * 6 * MB; }
__host__ __device__ constexpr size_t WT_LRU(int j) { return 12 * MB + (size_t)j * 8 * MB; }
__host__ __device__ constexpr size_t WT_FFN(int l) { return 28 * MB + (size_t)l * 16 * MB; }
constexpr size_t OFF_UQ = 3 * MB / 2, OFF_UKV = 11 * MB / 4, OFF_WO = 15 * MB / 4, OFF_GT = 4 * MB, OFF_LOUT = 5 * MB, OFF_DOWN = 8 * MB;
constexpr size_t WS_COS = 96 * MB, WS_SIN = 100 * MB, WS_SA = 104 * MB, WS_SB = 105 * MB;
constexpr size_t WS_HN = 112 * MB, WS_Y = 176 * MB, WS_U = 240 * MB, WS_END = 496 * MB;
constexpr size_t U_PROJ = 64 * MB, U_CQ = 112 * MB, U_CKV = 136 * MB, U_KR = 152 * MB, U_Q = 160 * MB, U_O = 64 * MB;
constexpr size_t U_GATE = 0, U_XC = 64 * MB, U_REC = 128 * MB, U_LA = 128 * MB, U_B = 192 * MB;
constexpr size_t WS_XSA = 108 * MB, WS_XSB = 109 * MB;
constexpr size_t WS_RS = 108 * MB;
constexpr int SCAN_L = 128, SCAN_NC = SEQ / SCAN_L;

__device__ __forceinline__ unsigned f2bf(float f) { unsigned u = __float_as_uint(f); return (u + 0x7fffu + ((u >> 16) & 1u)) >> 16; }
__device__ __forceinline__ unsigned pk2(float lo, float hi) { return f2bf(lo) | (f2bf(hi) << 16); }
__device__ __forceinline__ float bflo(unsigned w) { return __uint_as_float(w << 16); }
__device__ __forceinline__ float bfhi(unsigned w) { return __uint_as_float(w & 0xffff0000u); }
__device__ __forceinline__ float bf1(u16 h) { return __uint_as_float(((unsigned)h) << 16); }
__device__ __forceinline__ float wave_sum(float v) {
    v += xor1f(v); v += xor2f(v); v += xor4f(v); v += xor8f(v); v += xor16f(v);
    return sum32f(v);
}
__device__ __forceinline__ void transpose_item(const float* W, int ldw, u16* WT, int ldt, int nblk, float* scr, int item, int lane) {
    const int kb = item / nblk, nb = item % nblk, k0 = 64 * kb, n0 = 32 * nb;
#pragma unroll
    for (int i = 0; i < 8; ++i) { const int kk = 8 * i + (lane >> 3); const f32x4 v = *(const f32x4*)(W + (size_t)(k0 + kk) * ldw + n0 + (lane & 7) * 4);
        float* s = scr + kk * 33 + (lane & 7) * 4; s[0] = v.x; s[1] = v.y; s[2] = v.z; s[3] = v.w; }
    asm volatile("s_waitcnt lgkmcnt(0)" ::: "memory");
    const int c = lane & 7;
#pragma unroll
    for (int j = 0; j < 4; ++j) { const int n = (lane >> 3) + 8 * j; const float* s = scr + (8 * c) * 33 + n;
        uint4 o; o.x = pk2(s[0 * 33], s[1 * 33]); o.y = pk2(s[2 * 33], s[3 * 33]); o.z = pk2(s[4 * 33], s[5 * 33]); o.w = pk2(s[6 * 33], s[7 * 33]);
        *(uint4*)(WT + (size_t)(n0 + n) * ldt + k0 + 8 * c) = o; }
    asm volatile("s_waitcnt lgkmcnt(0)" ::: "memory");
}
struct Params { const float* in[23]; float* out; unsigned char* ws; };
enum { I_X = 0, I_POS, I_MIXPRE, I_MIXPOST, I_FFNPRE, I_FFNPOST, I_MLA_WIN, I_MLA_QN, I_MLA_KVN, I_MLA_WUQ, I_MLA_WUKV, I_MLA_WO,
       I_LRU_WIN, I_LRU_CW, I_LRU_CB, I_LRU_WA, I_LRU_BA, I_LRU_WX, I_LRU_BX, I_LRU_LAM, I_LRU_WOUT, I_FFN_UP, I_FFN_DOWN };

__device__ __forceinline__ void prologue_weights(const __attribute__((address_space(4))) Params& p, float* scr, int gw, int NGW, int lane) {
    u16* wt = (u16*)p.ws;
    constexpr int IT_MLA = 352 + 288 + 256 + 512, IT_LRU = 1024 + 128 + 512, IT_FFN = 4096, TOTAL = 2 * IT_MLA + 2 * IT_LRU + 4 * IT_FFN;
    for (int it = gw; it < TOTAL; it += NGW) {
        int r = it; const float* W; int ldw, ldt, nblk; u16* WT;
        if (r < 2 * IT_MLA) { const int j = r / IT_MLA; r -= j * IT_MLA; u16* base = wt + WT_MLA(j) / 2;
            if (r < 352) { W = p.in[I_MLA_WIN] + (size_t)j * 1024 * 704; ldw = 704; nblk = 22; WT = base; ldt = 1024; }
            else if (r < 640) { r -= 352; W = p.in[I_MLA_WUQ] + (size_t)j * 384 * 1536; ldw = 1536; nblk = 48; WT = base + OFF_UQ / 2; ldt = 384; }
            else if (r < 896) { r -= 640; W = p.in[I_MLA_WUKV] + (size_t)j * 256 * 2048; ldw = 2048; nblk = 64; WT = base + OFF_UKV / 2; ldt = 256; }
            else { r -= 896; W = p.in[I_MLA_WO] + (size_t)j * 1024 * 1024; ldw = 1024; nblk = 32; WT = base + OFF_WO / 2; ldt = 1024; }
        } else if (r < 2 * IT_MLA + 2 * IT_LRU) { r -= 2 * IT_MLA; const int j = r / IT_LRU; r -= j * IT_LRU; u16* base = wt + WT_LRU(j) / 2;
            if (r < 1024) { W = p.in[I_LRU_WIN] + (size_t)j * 1024 * 2048; ldw = 2048; nblk = 64; WT = base; ldt = 1024; }
            else if (r < 1152) { r -= 1024; const int which = r >> 3, gt = which >> 3, n = which & 7; r &= 7;
                W = p.in[gt ? I_LRU_WX : I_LRU_WA] + (size_t)j * 8 * 128 * 128 + (size_t)n * 128 * 128; ldw = 128; nblk = 4;
                WT = base + OFF_GT / 2 + (size_t)(n * 256 + gt * 128) * 256 + 128 * (n & 1); ldt = 256; }
            else { r -= 1152; W = p.in[I_LRU_WOUT] + (size_t)j * 1024 * 1024; ldw = 1024; nblk = 32; WT = base + OFF_LOUT / 2; ldt = 1024; }
        } else { r -= 2 * IT_MLA + 2 * IT_LRU; const int l = r / IT_FFN; r -= l * IT_FFN; u16* base = wt + WT_FFN(l) / 2;
            if (r < 2048) { W = p.in[I_FFN_UP] + (size_t)l * 1024 * 4096; ldw = 4096; nblk = 128; WT = base; ldt = 1024; }
            else { r -= 2048; W = p.in[I_FFN_DOWN] + (size_t)l * 4096 * 1024; ldw = 1024; nblk = 32; WT = base + OFF_DOWN / 2; ldt = 4096; }
        }
        transpose_item(W, ldw, WT, ldt, nblk, scr, r, lane);
    }
}
__device__ __forceinline__ void rowop(const u16* y, const float* xin, float* xout, u16* hn, float* rs, const float* gpost, const float* gpre, int gw, int NGW, int lane) {
    f32x4 gp[4], gq[4];
#pragma unroll
    for (int j = 0; j < 4; ++j) { gp[j] = gpost ? *(const f32x4*)(gpost + j * 256 + lane * 4) : (f32x4){0.f, 0.f, 0.f, 0.f}; gq[j] = gpre ? *(const f32x4*)(gpre + j * 256 + lane * 4) : (f32x4){0.f, 0.f, 0.f, 0.f}; }
    for (int row = gw; row < M; row += NGW) {
        f32x4 xv[4];
#pragma unroll
        for (int j = 0; j < 4; ++j) xv[j] = *(const f32x4*)(xin + (size_t)row * D + j * 256 + lane * 4);
        if (y) {
            f32x4 yv[4]; float ss = 0.f;
#pragma unroll
            for (int j = 0; j < 4; ++j) { const uint2 w = *(const uint2*)(y + (size_t)row * D + j * 256 + lane * 4);
                yv[j] = (f32x4){bflo(w.x), bfhi(w.x), bflo(w.y), bfhi(w.y)}; ss += (yv[j].x * yv[j].x + yv[j].y * yv[j].y) + (yv[j].z * yv[j].z + yv[j].w * yv[j].w); }
            const float r = rsqrtf(wave_sum(ss) * (1.f / D) + EPS);
#pragma unroll
            for (int j = 0; j < 4; ++j) xv[j] = xv[j] + (yv[j] * r) * gp[j];
        }
        if (xout) {
#pragma unroll
        for (int j = 0; j < 4; ++j) *(f32x4*)(xout + (size_t)row * D + j * 256 + lane * 4) = xv[j]; }
        if (gpre) {
            float s2 = 0.f;
#pragma unroll
            for (int j = 0; j < 4; ++j) s2 += (xv[j].x * xv[j].x + xv[j].y * xv[j].y) + (xv[j].z * xv[j].z + xv[j].w * xv[j].w);
            const float tot2 = wave_sum(s2); const float r2 = 1.0f;
            if (rs && lane < 4) rs[(size_t)row * 4 + lane] = lane == 0 ? tot2 : 0.f;
#pragma unroll
            for (int j = 0; j < 4; ++j) { const f32x4 h = (xv[j] * r2) * gq[j]; uint2 w; w.x = pk2(h.x, h.y); w.y = pk2(h.z, h.w);
                *(uint2*)(hn + (size_t)row * D + j * 256 + lane * 4) = w; }
        }
    }
}
__device__ __forceinline__ void qkvnorm(const u16* proj, u16* cq, u16* ckv, u16* kr, const float* qn, const float* kvn, const float* ctab, const float* stab, const float* rss, int gw, int NGW, int lane) {
    float gA[8], gB[8];
    { const float* gp = lane < 48 ? qn + 8 * lane : kvn + (8 * lane - 384); const f32x4 g0 = *(const f32x4*)gp, g1 = *(const f32x4*)(gp + 4);
      gA[0] = g0[0]; gA[1] = g0[1]; gA[2] = g0[2]; gA[3] = g0[3]; gA[4] = g1[0]; gA[5] = g1[1]; gA[6] = g1[2]; gA[7] = g1[3]; }
    { f32x4 g0 = {0.f, 0.f, 0.f, 0.f}, g1 = {0.f, 0.f, 0.f, 0.f}; if (lane < 16) { g0 = *(const f32x4*)(kvn + 128 + 8 * lane); g1 = *(const f32x4*)(kvn + 132 + 8 * lane); }
      gB[0] = g0[0]; gB[1] = g0[1]; gB[2] = g0[2]; gB[3] = g0[3]; gB[4] = g1[0]; gB[5] = g1[1]; gB[6] = g1[2]; gB[7] = g1[3]; }
    const bool ropeL = lane >= 16 && lane < 24; const int rk = (lane & 3) * 8;
    const int cOff = lane < 20 ? 672 + rk : 640 + rk;
    for (int row0 = gw; row0 < M; row0 += 2 * NGW) {
        float A[2][8], B[2][8], C[2][8], rsc[2], sa[2], sb[2];
#pragma unroll
        for (int q = 0; q < 2; ++q) { const int row = row0 + q * NGW; const u16* pr = proj + (size_t)row * 768;
            const f32x4 pp = *(const f32x4*)(rss + (size_t)row * 4); rsc[q] = rsqrtf(((pp[0] + pp[1]) + (pp[2] + pp[3])) * (1.f / D) + EPS);
            const uint4 a = *(const uint4*)(pr + 8 * lane); uint4 b = make_uint4(0u, 0u, 0u, 0u), c = make_uint4(0u, 0u, 0u, 0u);
            if (lane < 24) b = *(const uint4*)(pr + 512 + 8 * lane);
            if (ropeL) c = *(const uint4*)(pr + cOff);
            A[q][0] = bflo(a.x); A[q][1] = bfhi(a.x); A[q][2] = bflo(a.y); A[q][3] = bfhi(a.y); A[q][4] = bflo(a.z); A[q][5] = bfhi(a.z); A[q][6] = bflo(a.w); A[q][7] = bfhi(a.w);
            B[q][0] = bflo(b.x); B[q][1] = bfhi(b.x); B[q][2] = bflo(b.y); B[q][3] = bfhi(b.y); B[q][4] = bflo(b.z); B[q][5] = bfhi(b.z); B[q][6] = bflo(b.w); B[q][7] = bfhi(b.w);
            C[q][0] = bflo(c.x); C[q][1] = bfhi(c.x); C[q][2] = bflo(c.y); C[q][3] = bfhi(c.y); C[q][4] = bflo(c.z); C[q][5] = bfhi(c.z); C[q][6] = bflo(c.w); C[q][7] = bfhi(c.w); }
#pragma unroll
        for (int q = 0; q < 2; ++q) { sa[q] = 0.f; sb[q] = 0.f;
#pragma unroll
            for (int e = 0; e < 8; ++e) { A[q][e] *= rsc[q]; B[q][e] *= rsc[q]; C[q][e] *= rsc[q]; sa[q] += A[q][e] * A[q][e]; sb[q] += B[q][e] * B[q][e]; } }
        float r1[2], r2[2];
#pragma unroll
        for (int q = 0; q < 2; ++q) { const float s1 = wave_sum(lane < 48 ? sa[q] : 0.f), s2 = wave_sum((lane >= 48 ? sa[q] : 0.f) + (lane < 16 ? sb[q] : 0.f));
            r1[q] = rsqrtf(s1 * (1.f / 384.f) + EPS); r2[q] = rsqrtf(s2 * (1.f / 256.f) + EPS); }
#pragma unroll
        for (int q = 0; q < 2; ++q) { const int row = row0 + q * NGW;
            { const float r = lane < 48 ? r1[q] : r2[q]; uint4 o; o.x = pk2(A[q][0] * r * gA[0], A[q][1] * r * gA[1]); o.y = pk2(A[q][2] * r * gA[2], A[q][3] * r * gA[3]);
              o.z = pk2(A[q][4] * r * gA[4], A[q][5] * r * gA[5]); o.w = pk2(A[q][6] * r * gA[6], A[q][7] * r * gA[7]);
              if (lane < 48) *(uint4*)(cq + (size_t)row * 384 + 8 * lane) = o; else *(uint4*)(ckv + (size_t)row * 256 + (8 * lane - 384)) = o; }
            if (lane < 16) { const float r = r2[q]; uint4 o; o.x = pk2(B[q][0] * r * gB[0], B[q][1] * r * gB[1]); o.y = pk2(B[q][2] * r * gB[2], B[q][3] * r * gB[3]);
              o.z = pk2(B[q][4] * r * gB[4], B[q][5] * r * gB[5]); o.w = pk2(B[q][6] * r * gB[6], B[q][7] * r * gB[7]);
              *(uint4*)(ckv + (size_t)row * 256 + 128 + 8 * lane) = o; }
            if (ropeL) { const f32x4 c0 = *(const f32x4*)(ctab + (size_t)row * 32 + rk), c1 = *(const f32x4*)(ctab + (size_t)row * 32 + rk + 4), s0 = *(const f32x4*)(stab + (size_t)row * 32 + rk), s1 = *(const f32x4*)(stab + (size_t)row * 32 + rk + 4);
              float ov[8];
#pragma unroll
              for (int e = 0; e < 8; ++e) { const float cc = e < 4 ? c0[e & 3] : c1[e & 3], ss = e < 4 ? s0[e & 3] : s1[e & 3];
                  ov[e] = lane < 20 ? B[q][e] * cc - C[q][e] * ss
                                    : B[q][e] * cc + C[q][e] * ss; }
              uint4 o; o.x = pk2(ov[0], ov[1]); o.y = pk2(ov[2], ov[3]); o.z = pk2(ov[4], ov[5]); o.w = pk2(ov[6], ov[7]);
              *(uint4*)(kr + (size_t)row * 64 + (lane < 20 ? 0 : 32) + rk) = o; }
        }
    }
}
__device__ __forceinline__ void qrope(u16* q, const float* ctab, const float* stab, int gw, int NGW, int lane) {
    for (int row = gw; row < M; row += NGW) {
        u16* qr = q + (size_t)row * 1536; const int i = lane & 31;
        const float c = ctab[(size_t)row * 32 + i], s = stab[(size_t)row * 32 + i];
#pragma unroll
        for (int j = 0; j < 4; ++j) { const int h = 2 * j + (lane >> 5); u16* pp = qr + h * 192 + 128 + i;
            const float x1 = bf1(pp[0]), x2 = bf1(pp[32]);
            pp[0] = (u16)f2bf(x1 * c - x2 * s); pp[32] = (u16)f2bf(x2 * c + x1 * s); }
    }
}
__device__ __forceinline__ void conv_phase(const u16* rec, u16* xc, const float* cw, const float* cb, int gtid, int NGT) {
    for (int idx = gtid; idx < (M / 32) * 128; idx += NGT) {
        const int r0 = (idx >> 7) * 32, c0 = (idx & 127) * 8;
        float w[4][8], bias[8], win[3][8];
#pragma unroll
        for (int e = 0; e < 8; ++e) { bias[e] = cb[c0 + e];
#pragma unroll
            for (int k = 0; k < 4; ++k) w[k][e] = cw[k * D + c0 + e]; }
        const bool first = (r0 & (SEQ - 1)) == 0;
#pragma unroll
        for (int k = 0; k < 3; ++k) { uint4 v = make_uint4(0u, 0u, 0u, 0u); if (!first) v = *(const uint4*)(rec + (size_t)(r0 - 3 + k) * D + c0);
            win[k][0] = bflo(v.x); win[k][1] = bfhi(v.x); win[k][2] = bflo(v.y); win[k][3] = bfhi(v.y); win[k][4] = bflo(v.z); win[k][5] = bfhi(v.z); win[k][6] = bflo(v.w); win[k][7] = bfhi(v.w); }
        for (int i0 = 0; i0 < 32; i0 += 8) {
            uint4 in[8];
#pragma unroll
            for (int u = 0; u < 8; ++u) in[u] = *(const uint4*)(rec + (size_t)(r0 + i0 + u) * D + c0);
#pragma unroll
            for (int u = 0; u < 8; ++u) {
                const float x[8] = {bflo(in[u].x), bfhi(in[u].x), bflo(in[u].y), bfhi(in[u].y), bflo(in[u].z), bfhi(in[u].z), bflo(in[u].w), bfhi(in[u].w)};
                float acc[8];
#pragma unroll
                for (int e = 0; e < 8; ++e) { acc[e] = bias[e] + win[0][e] * w[0][e] + win[1][e] * w[1][e] + win[2][e] * w[2][e] + x[e] * w[3][e]; win[0][e] = win[1][e]; win[1][e] = win[2][e]; win[2][e] = x[e]; }
                uint4 o; o.x = pk2(acc[0], acc[1]); o.y = pk2(acc[2], acc[3]); o.z = pk2(acc[4], acc[5]); o.w = pk2(acc[6], acc[7]);
                *(uint4*)(xc + (size_t)(r0 + i0 + u) * D + c0) = o;
            }
        }
    }
}
__device__ __forceinline__ void scanA(const u16* A, const u16* B, float* SA, float* SB, int tid) {
    for (int item = blockIdx.x; item < 2 * SCAN_NC; item += gridDim.x) {
        const int c = item % SCAN_NC, b = item / SCAN_NC, ch = 2 * tid;
        const size_t base = ((size_t)b * SEQ + (size_t)c * SCAN_L) * D + ch;
        float h0 = 0.f, h1 = 0.f, P0 = 1.f, P1 = 1.f;
        for (int t0 = 0; t0 < SCAN_L; t0 += 32) {
            unsigned aw[32], bw[32];
#pragma unroll
            for (int u = 0; u < 32; ++u) { aw[u] = *(const unsigned*)(A + base + (size_t)(t0 + u) * D); bw[u] = *(const unsigned*)(B + base + (size_t)(t0 + u) * D); }
#pragma unroll
            for (int u = 0; u < 32; ++u) { const float a0 = __expf(bflo(aw[u])), a1 = __expf(bfhi(aw[u])); h0 = a0 * h0 + bflo(bw[u]); h1 = a1 * h1 + bfhi(bw[u]); P0 *= a0; P1 *= a1; }
        }
        const size_t so = ((size_t)b * SCAN_NC + c) * D + ch;
        *(float2*)(SA + so) = make_float2(P0, P1); *(float2*)(SB + so) = make_float2(h0, h1);
    }
}
__device__ __forceinline__ void scanC(const u16* A, const u16* B, const float* SA, const float* SB, const u16* gate, u16* hg, int tid) {
    for (int item = blockIdx.x; item < 2 * SCAN_NC; item += gridDim.x) {
        const int c = item % SCAN_NC, b = item / SCAN_NC, ch = 2 * tid;
        const size_t base = ((size_t)b * SEQ + (size_t)c * SCAN_L) * D + ch;
        float h0 = 0.f, h1 = 0.f;
        for (int cc0 = 0; cc0 < c; cc0 += 16) {
            float2 pa[16], pb[16];
#pragma unroll
            for (int u = 0; u < 16; ++u) { const int cc = cc0 + u < c ? cc0 + u : c - 1; const size_t so = ((size_t)b * SCAN_NC + cc) * D + ch; pa[u] = *(const float2*)(SA + so); pb[u] = *(const float2*)(SB + so); }
#pragma unroll
            for (int u = 0; u < 16; ++u) { const bool in = cc0 + u < c; const float ax = in ? pa[u].x : 1.f, ay = in ? pa[u].y : 1.f, bx = in ? pb[u].x : 0.f, by = in ? pb[u].y : 0.f; h0 = ax * h0 + bx; h1 = ay * h1 + by; }
        }
        for (int t0 = 0; t0 < SCAN_L; t0 += 16) {
            unsigned aw[16], bw[16], gv[16];
#pragma unroll
            for (int u = 0; u < 16; ++u) { aw[u] = *(const unsigned*)(A + base + (size_t)(t0 + u) * D); bw[u] = *(const unsigned*)(B + base + (size_t)(t0 + u) * D); gv[u] = *(const unsigned*)(gate + base + (size_t)(t0 + u) * D); }
#pragma unroll
            for (int u = 0; u < 16; ++u) { h0 = __expf(bflo(aw[u])) * h0 + bflo(bw[u]); h1 = __expf(bfhi(aw[u])) * h1 + bfhi(bw[u]);
                *(unsigned*)(hg + base + (size_t)(t0 + u) * D) = pk2(bflo(gv[u]) * h0, bfhi(gv[u]) * h1); }
        }
    }
}

constexpr int LDS_GEMM = pg8::STAGE_BYTES + 8192, LDS_MAIN = att::LDS_BYTES > LDS_GEMM ? att::LDS_BYTES : LDS_GEMM, LDS_BYTES = LDS_MAIN + 16;
constexpr size_t WS_BAR = 106 * MB;
constexpr size_t WS_CNT1 = WS_BAR + 16384, WS_CNT2 = WS_BAR + 49152, CTL_BYTES = 81920, WS_XS1 = 107 * MB, WS_XS2 = 107 * MB + MB / 2;
constexpr int XL_OFF = 131072;
static_assert(XL_OFF + 8192 <= LDS_MAIN && XCD_BAR_WORDS * 4 <= 16384 && att::LDS_BYTES <= LDS_MAIN && pg8::STAGE_BYTES <= LDS_MAIN && LDS_BYTES <= 160 * 1024, "LDS map");

__global__ void __launch_bounds__(512, 2) fwd_mega(Params p_arg) {
    extern __shared__ __attribute__((aligned(16))) unsigned char lds[];
    cg::grid_group grid = cg::this_grid();
    (void)p_arg;
    volatile __attribute__((address_space(3))) unsigned* bst = (volatile __attribute__((address_space(3))) unsigned*)((__attribute__((address_space(3))) unsigned char*)lds + LDS_MAIN);
    if (threadIdx.x < 4) bst[threadIdx.x] = 0u;
    __syncthreads();
    const int wave_s = __builtin_amdgcn_readfirstlane(threadIdx.x >> 6);
    const unsigned bar_x = xb::xb_xcc_id();
    (void)xb::xcd_barrier_post((unsigned*)(p_arg.ws + WS_BAR), bst);
#define GRID_BAR() do { unsigned bx_ = bar_x; asm volatile("" : "+s"(bx_)); xb::XcdBarrier bb_; bb_.bar = (unsigned*)(ws + WS_BAR); bb_.x = bx_; bb_.st = bst; xb::xcd_barrier(bb_, tid == 0); } while (0)
    typedef const __attribute__((address_space(4))) Params* KParams;
    KParams pp = (KParams)__builtin_amdgcn_kernarg_segment_ptr();
#define FRESH() int tid_ = wave_s * 64 + lane_id_fresh(); asm volatile("" : "+v"(tid_)); asm volatile("" : "+s"(pp)); const __attribute__((address_space(4))) Params& p = *pp; \
    const int tid = tid_, lane = tid & 63, wave = __builtin_amdgcn_readfirstlane(tid >> 6); \
    const int G = gridDim.x, gw = blockIdx.x * 8 + wave, NGW = G * 8, gtid = blockIdx.x * 512 + tid, NGT = G * 512; \
    unsigned char* ws = p.ws; float* x = p.out; u16* hn = (u16*)(ws + WS_HN); u16* ybuf = (u16*)(ws + WS_Y); unsigned char* U = ws + WS_U; \
    float* ctab = (float*)(ws + WS_COS); float* stab = (float*)(ws + WS_SIN); float* SA = (float*)(ws + WS_SA); float* SB = (float*)(ws + WS_SB); \
    (void)lane; (void)wave; (void)gw; (void)NGW; (void)gtid; (void)NGT; (void)x; (void)hn; (void)ybuf; (void)U; (void)ctab; (void)stab; (void)SA; (void)SB;
    {
    FRESH();

    for (int prep = 0; prep < PROBE_PRO_REPS; ++prep) {
    prologue_weights(p, (float*)lds + wave * (64 * 33), gw, NGW, lane);
    for (int i = gtid; i < 2 * 2048 * 16; i += NGT) { const int j = i >> 15, row = (i >> 4) & 2047, chn = i & 15, n = row >> 8;
        *(uint4*)((u16*)(ws + WT_LRU(j) + OFF_GT) + (size_t)row * 256 + 128 * ((n & 1) ^ 1) + chn * 8) = make_uint4(0u, 0u, 0u, 0u); }
    { const int* pos = (const int*)p.in[I_POS];
      for (int i = gtid; i < M * 32; i += NGT) { const int row = i >> 5, f = i & 31;
        const float inv = __builtin_amdgcn_exp2f(-(float)f * (13.287712379549449f / 32.f));
        const float ang = (float)pos[row] * inv;
        double rev = (double)ang * 0.15915494309189535; rev -= __builtin_rint(rev);
        ctab[i] = __builtin_amdgcn_cosf((float)rev); stab[i] = __builtin_amdgcn_sinf((float)rev); } }
    rowop(nullptr, p.in[I_X], nullptr, hn, (float*)(ws + WS_XSB), nullptr, p.in[I_MIXPRE], gw, NGW, lane);
    }
    if (ws == nullptr) grid.sync();
    GRID_BAR();
    }

#pragma nounroll
    for (int layer = 0; layer < 4; ++layer) {
#pragma nounroll
        for (int op = 0; op < 10; ++op) {
            FRESH();
            const int j = layer >> 1; const bool lru = (layer & 1) != 0;
            const u16* wtm = (const u16*)(ws + WT_MLA(j)); const u16* wtl = (const u16*)(ws + WT_LRU(j)); const u16* wtf = (const u16*)(ws + WT_FFN(layer));
            int gk = 0;
            pg8::Gemm g{}; pg8::EpiB E{};
            if (op == 6 || op == 9) continue;
            const float* gprev = p.in[op == 5 ? I_MIXPRE : I_FFNPRE] + layer * D;
            const float* gpost = p.in[op == 5 ? I_MIXPOST : I_FFNPOST] + layer * D;
            const float* gpre = op == 5 ? p.in[I_FFNPRE] + layer * D : (layer < 3 ? p.in[I_MIXPRE] + (layer + 1) * D : nullptr);
            if (op == 7) { gk = 1; g = pg8::Gemm{hn, wtf, M, 4096, 1024, 1024, 1024, 0}; E = pg8::EpiB{(u16*)U, 4096, 0, 0, 1, nullptr}; }
            else if (op == 8) { gk = 3; g = pg8::Gemm{(const u16*)U, wtf + OFF_DOWN / 2, M, 1024, 4096, 4096, 4096, 0}; }
            else if (!lru) {
                u16* proj = (u16*)(U + U_PROJ); u16* cq = (u16*)(U + U_CQ); u16* ckv = (u16*)(U + U_CKV); u16* kr = (u16*)(U + U_KR); u16* q = (u16*)(U + U_Q); u16* o = (u16*)(U + U_O); u16* kv = ybuf;
                if (op == 0) { gk = 1; g = pg8::Gemm{hn, wtm, M, 768, 1024, 1024, 1024, 0}; E = pg8::EpiB{proj, 768, 0, 0, 0, nullptr}; }
                else if (op == 1) for (int rep = 0; rep < PROBE_THIN_REPS; ++rep) qkvnorm(proj, cq, ckv, kr, p.in[I_MLA_QN] + j * 384, p.in[I_MLA_KVN] + j * 256, ctab, stab, (const float*)(ws + WS_XSB), gw, NGW, lane);
                else if (op == 2) { gk = 1; g = pg8::Gemm{cq, wtm + OFF_UQ / 2, M, 1536, 384, 384, 384, 0}; E = pg8::EpiB{q, 1536, 0, 0, 0, nullptr}; }
                else if (op == 3) { gk = 1; g = pg8::Gemm{ckv, wtm + OFF_UKV / 2, M, 2048, 256, 256, 256, 0}; E = pg8::EpiB{kv, 2048, 0, 0, 0, nullptr}; }
                else if (op == 4) { const att::Tensors T{q, kv, kr, o, ctab, stab}; for (int rep = 0; rep < PROBE_ATT_REPS; ++rep) att::attn_phase((char*)lds, T, tid); }
                else { gk = 3; g = pg8::Gemm{o, wtm + OFF_WO / 2, M, 1024, 1024, 1024, 1024, 0}; }
            } else {
                u16* gate = (u16*)(U + U_GATE); u16* xc = (u16*)(U + U_XC); u16* rec = (u16*)(U + U_REC); u16* Bb = (u16*)(U + U_B); u16* Ab = (u16*)(U + U_LA); u16* hg = xc;
                if (op == 0) { gk = 1; g = pg8::Gemm{hn, wtl, M, 2048, 1024, 1024, 1024, 0}; E = pg8::EpiB{gate, 1024, 1024, (size_t)(U_REC - U_GATE) / 2, 2, (const float*)(ws + WS_XSB)}; }
                else if (op == 1) for (int rep = 0; rep < PROBE_THIN_REPS; ++rep) conv_phase(rec, xc, p.in[I_LRU_CW] + j * 4 * D, p.in[I_LRU_CB] + j * D, gtid, NGT);
                else if (op == 2) { gk = 2; g = pg8::Gemm{xc, wtl + OFF_GT / 2, M, 2048, 256, 1024, 256, 512}; }
                else if (op == 3) for (int rep = 0; rep < PROBE_THIN_REPS; ++rep) scanA(Ab, Bb, SA, SB, tid);
                else if (op == 4) for (int rep = 0; rep < PROBE_THIN_REPS; ++rep) scanC(Ab, Bb, SA, SB, gate, hg, tid);
                else { gk = 3; g = pg8::Gemm{hg, wtl + OFF_LOUT / 2, M, 1024, 1024, 1024, 1024, 0}; }
            }
            if (STAGGER_TICKS > 0 && op == 7) {
                unsigned bx_ = bar_x; asm volatile("" : "+s"(bx_));
                const unsigned long long t0_ = __builtin_amdgcn_s_memrealtime(), want_ = (unsigned long long)(bx_ & 7u) * STAGGER_TICKS;
                while (__builtin_amdgcn_s_memrealtime() - t0_ < want_) __builtin_amdgcn_s_sleep(8); }
            for (int rep = 0; rep < ((gk != 3 && (PROBE_GEMM_OP == -1 || op == PROBE_GEMM_OP || (PROBE_GEMM_OP == -2 && op != 7))) ? PROBE_GEMM_REPS : 1); ++rep)
            if (gk == 1) { pg8::StaticOrder S; S.init(g.M, g.N, G, (int)blockIdx.x);
                pg8::gemm_phase<pg8::EpiB, pg8::StaticOrder, true>((PG8_LAS unsigned char*)lds, g, S, E, tid); }
            else if (gk == 2) { pg8::StaticOrder S; S.init(g.M, g.N, G, (int)blockIdx.x);
                const pg8::EpiGate EG{(const u16*)(U + U_XC), (u16*)(U + U_LA), (u16*)(U + U_B), p.in[I_LRU_BA] + j * D, p.in[I_LRU_BX] + j * D, p.in[I_LRU_LAM] + j * D};
                pg8::gemm_phase<pg8::EpiGate, pg8::StaticOrder, true>((PG8_LAS unsigned char*)lds, g, S, EG, tid); }
            else if (gk == 3) { pg8::StaticOrder S; S.init(g.M, g.N, G, (int)blockIdx.x);
                const unsigned target = 32u * (unsigned)(layer * 2 + (op == 8 ? 2 : 1));
                const pg8::RowStats st1{(float*)(ws + WS_XS1), (unsigned*)(ws + WS_CNT1), target};
                const pg8::EpiNormRes EN{hn, (float*)(ws + (op == 8 ? WS_XSB : WS_XSA)), x, gprev, gpost, gpre, st1, (PG8_LAS unsigned char*)lds + XL_OFF, op == 8 ? (const float*)(ws + WS_XSA) : nullptr};
                pg8::gemm_phase<pg8::EpiNormRes, pg8::StaticOrder, true>((PG8_LAS unsigned char*)lds, g, S, EN, tid); }
            if (!(layer == 3 && op == 8) && !(!lru && op == 2)) { for (int rep = 0; rep < PROBE_SYNC_REPS; ++rep) GRID_BAR(); }
        }
    }
}
}

extern "C" void kernel_launch(void* const* d_in, const int* in_sizes, int n_in, void* d_out, int out_size, void* d_ws, size_t ws_size, hipStream_t stream) {
    static int grid = 0;
    if (grid == 0) {
        if (n_in != 23 || in_sizes[0] != mk::M * mk::D || out_size != mk::M * mk::D || ws_size < mk::WS_END) {
            fprintf(stderr, "kernel_launch: unexpected shapes (n_in %d, in0 %d, out %d, ws %zu); nothing launched\n", n_in, n_in > 0 ? in_sizes[0] : -1, out_size, ws_size); grid = -1; return; }
        int dev = 0, cus = 0, per_cu = 0;
        (void)hipGetDevice(&dev); (void)hipDeviceGetAttribute(&cus, hipDeviceAttributeMultiprocessorCount, dev);
        if (hipFuncSetAttribute((const void*)mk::fwd_mega, hipFuncAttributeMaxDynamicSharedMemorySize, mk::LDS_BYTES) != hipSuccess) { fprintf(stderr, "kernel_launch: hipFuncSetAttribute failed\n"); grid = -1; return; }
        if (hipOccupancyMaxActiveBlocksPerMultiprocessor(&per_cu, (const void*)mk::fwd_mega, 512, mk::LDS_BYTES) != hipSuccess || per_cu < 1) { fprintf(stderr, "kernel_launch: occupancy query says %d blocks per CU\n", per_cu); per_cu = 1; }
        (void)hipGetLastError();
        grid = cus > 0 ? cus : 256;
    }
    if (grid < 0) return;
    mk::Params p{};
    for (int i = 0; i < 23; ++i) p.in[i] = (const float*)d_in[i];
    p.out = (float*)d_out; p.ws = (unsigned char*)d_ws;
    if (hipMemsetAsync((char*)d_ws + mk::WS_BAR, 0, mk::CTL_BYTES, stream) != hipSuccess) { fprintf(stderr, "kernel_launch: hipMemsetAsync failed\n"); return; }
    void* args[] = {&p};
    hipError_t e = hipLaunchCooperativeKernel((const void*)mk::fwd_mega, dim3(grid), dim3(512), args, mk::LDS_BYTES, stream);
    if (e != hipSuccess) fprintf(stderr, "kernel_launch: cooperative launch failed: %s (grid %d)\n", hipGetErrorString(e), grid);
}
```

```cpp
#include <hip/hip_runtime.h>
#include <hip/hip_bf16.h>
#include <hip/hip_cooperative_groups.h>
#include <cstdio>
#include <cstdint>
namespace cg = cooperative_groups;

__device__ __forceinline__ float xor1f(float v)  { return __int_as_float(__builtin_amdgcn_mov_dpp(__float_as_int(v), 0xB1, 0xF, 0xF, false)); }
__device__ __forceinline__ float xor2f(float v)  { return __int_as_float(__builtin_amdgcn_mov_dpp(__float_as_int(v), 0x4E, 0xF, 0xF, false)); }
__device__ __forceinline__ float xor4f(float v)  { return __int_as_float(__builtin_amdgcn_ds_swizzle(__float_as_int(v), 0x101F)); }
__device__ __forceinline__ float xor8f(float v)  { return __int_as_float(__builtin_amdgcn_ds_swizzle(__float_as_int(v), 0x201F)); }
__device__ __forceinline__ float xor16f(float v) { return __int_as_float(__builtin_amdgcn_ds_swizzle(__float_as_int(v), 0x401F)); }
__device__ __forceinline__ float sum32f(float v) { auto rr = __builtin_amdgcn_permlane32_swap(__float_as_uint(v), __float_as_uint(v), false, false); return __uint_as_float(rr[0]) + __uint_as_float(rr[1]); }
__device__ __forceinline__ int lane_id_fresh() { int l; asm volatile("v_mbcnt_lo_u32_b32 %0, -1, 0\n\tv_mbcnt_hi_u32_b32 %0, -1, %0" : "=v"(l)); return l; }
namespace pg8 {
#define PG8_LAS __attribute__((address_space(3)))
typedef unsigned short bf16_t;
typedef short bf16x8 __attribute__((ext_vector_type(8)));
typedef float f32x4 __attribute__((ext_vector_type(4)));
typedef unsigned u32x4 __attribute__((ext_vector_type(4)));
constexpr int BM = 256, BK = 64, HALF = 128, HTB = HALF * BK * 2  , STAGE_BYTES = 8 * HTB, NXCD = 8, WGM = 8;

__host__ __device__ __forceinline__ int lds_byte(int r, int c) { const int st = (r >> 4) * 2 + (c >> 5), rr = r & 15, cc = c & 31, ob = rr * 64 + cc * 2; return st * 1024 + (ob ^ (((ob >> 9) & 1) << 5)); }
__host__ __device__ __forceinline__ void stage_rc(int b, int& R, int& C) { const int st = b / 1024, sb = b % 1024, swz = sb ^ (((sb >> 9) & 1) << 5); R = (st >> 1) * 16 + swz / 64; C = (st & 1) * 32 + (swz % 64) / 2; }
__host__ __device__ __forceinline__ int perm32(int rho) { const int n = rho >> 4, i = rho & 15; return 8 * (i >> 2) + 4 * n + (i & 3); }

struct Unit { int pm, pn; };
struct Gemm { const bf16_t* A; const bf16_t* Bt; int M, N, K; int lda, ldb; int apn; };

struct StaticOrder {
    int nM, nN, nwg, G, c;
    __host__ __device__ void init(int M, int N, int G_, int c_) { nM = M / BM; nN = N / BM; nwg = nM * nN; G = G_; c = c_; }
    __host__ __device__ bool next(int i, Unit& u) const {
        const long L = (long)i * G + c; if (L >= nwg) return false;
        int wgid = (int)L; { const int q = nwg / NXCD, r = nwg % NXCD, xcd = wgid % NXCD, off = wgid / NXCD; wgid = (xcd < r ? xcd * (q + 1) : r * (q + 1) + (xcd - r) * q) + off; }
        const int nig = WGM * nN, gid = wgid / nig, fm = gid * WGM, gsz = (nM - fm) < WGM ? (nM - fm) : WGM;
        u.pm = fm + ((wgid % nig) % gsz); u.pn = (wgid % nig) / gsz; return true;
    }
    __device__ __forceinline__ void a_ready(const Unit&) const {}
    __device__ __forceinline__ void done(const Unit&) const {}
};

__device__ __forceinline__ unsigned cvt_pk_bf16(float lo, float hi) { unsigned r; asm volatile("v_cvt_pk_bf16_f32 %0, %1, %2" : "=v"(r) : "v"(lo), "v"(hi)); return r; }
__device__ __forceinline__ float gelu_tanh(float x) {
    const float z = 0.7978845608028654f * (x + 0.044715f * x * x * x);
    const float e = __expf(2.0f * z);
    const float th = 1.0f - 2.0f * __builtin_amdgcn_rcpf(1.0f + e);
    return 0.5f * x * (1.0f + th);
}
struct EpiB {
    static constexpr bool PERM = true, AFTER_DRAIN = false, FUSED = false;
    bf16_t* O; int ldc; int split_cols; size_t split_stride; int mode;
    const float* rss;
    __device__ __forceinline__ void operator()(const f32x4 (&acc)[2][2][4][2], const Unit& u, int wr, int wc, int fr, int fq) const {
        const int row0 = u.pm * BM + wr * 64 + fr; int colt = u.pn * BM; bf16_t* base = O; int t = 0;
        if (split_cols) { t = colt / split_cols; base += (size_t)t * split_stride; colt -= t * split_cols; }
        const int act = (mode == 1) ? 1 : ((mode == 2 && t == 0) ? 2 : 0);
        const int col0 = colt + wc * 32 + 8 * fq;
#pragma unroll
        for (int ai = 0; ai < 2; ++ai)
#pragma unroll
            for (int m = 0; m < 4; ++m) { bf16_t* rowp = base + (size_t)(row0 + ai * HALF + m * 16) * ldc + col0;
                float rsc = 1.0f; if (rss) { const f32x4 pp = *(const f32x4*)(rss + (size_t)(row0 + ai * HALF + m * 16) * 4); rsc = rsqrtf(((pp[0] + pp[1]) + (pp[2] + pp[3])) * (1.0f / 1024.0f) + 1e-6f); }
#pragma unroll
                for (int bj = 0; bj < 2; ++bj) { f32x4 v0 = acc[ai][bj][m][0] * rsc, v1 = acc[ai][bj][m][1] * rsc;
                    if (act == 1) {
#pragma unroll
                        for (int e = 0; e < 4; ++e) { const float a = fmaxf(v0[e], 0.f), b = fmaxf(v1[e], 0.f); v0[e] = a * a; v1[e] = b * b; } }
                    else if (act == 2) {
#pragma unroll
                        for (int e = 0; e < 4; ++e) { v0[e] = gelu_tanh(v0[e]); v1[e] = gelu_tanh(v1[e]); } }
                    u32x4 w; w.x = cvt_pk_bf16(v0[0], v0[1]); w.y = cvt_pk_bf16(v0[2], v0[3]); w.z = cvt_pk_bf16(v1[0], v1[1]); w.w = cvt_pk_bf16(v1[2], v1[3]);
                    *(u32x4*)(rowp + bj * HALF) = w; } }
    }
};
__device__ __forceinline__ float bf2f(unsigned short h) { return __uint_as_float(((unsigned)h) << 16); }
__device__ __forceinline__ float sigmoidf_(float x) { return __builtin_amdgcn_rcpf(1.0f + __expf(-x)); }
__device__ __forceinline__ float one_minus_exp(float t) { const float ser = -t * (1.0f + t * (0.5f + t * (0.16666667f + t * (0.041666668f + t * 0.008333334f)))); return t > -0.25f ? ser : 1.0f - __expf(t); }
struct EpiGate {
    static constexpr bool PERM = false, AFTER_DRAIN = false, FUSED = false;
    const bf16_t* xc; bf16_t* Aout; bf16_t* Bout; const float* b_a; const float* b_x; const float* lam;
    __device__ __forceinline__ void operator()(const f32x4 (&acc)[2][2][4][2], const Unit& u, int wr, int wc, int fr, int fq) const {
#pragma unroll
        for (int n = 0; n < 2; ++n) {
            const int ch0 = 128 * u.pn + 32 * wc + 16 * n + 4 * fq;
            const f32x4 ba = *(const f32x4*)(b_a + ch0), bx = *(const f32x4*)(b_x + ch0), lm = *(const f32x4*)(lam + ch0);
            f32x4 sp;
#pragma unroll
            for (int e = 0; e < 4; ++e) sp[e] = -8.0f * log1pf(__expf(-lm[e]));
#pragma unroll
            for (int ai = 0; ai < 2; ++ai)
#pragma unroll
                for (int m = 0; m < 4; ++m) {
                    const size_t off = (size_t)(u.pm * BM + ai * HALF + wr * 64 + m * 16 + fr) * 1024 + ch0;
                    const uint2 xr = *(const uint2*)(xc + off);
                    float xv[4] = { __uint_as_float(xr.x << 16), __uint_as_float(xr.x & 0xffff0000u), __uint_as_float(xr.y << 16), __uint_as_float(xr.y & 0xffff0000u) };
                    f32x4 av, bv;
#pragma unroll
                    for (int e = 0; e < 4; ++e) {
                        const float r = sigmoidf_(acc[ai][0][m][n][e] + ba[e]);
                        const float ig = sigmoidf_(acc[ai][1][m][n][e] + bx[e]);
                        const float la = sp[e] * r;
                        av[e] = la;
                        bv[e] = __builtin_amdgcn_sqrtf(fmaxf(one_minus_exp(2.0f * la), 0.f)) * (ig * xv[e]);
                    }
                    uint2 wa, wb; wa.x = cvt_pk_bf16(av[0], av[1]); wa.y = cvt_pk_bf16(av[2], av[3]); wb.x = cvt_pk_bf16(bv[0], bv[1]); wb.y = cvt_pk_bf16(bv[2], bv[3]);
                    *(uint2*)(Aout + off) = wa; *(uint2*)(Bout + off) = wb;
                }
        }
    }
};

struct RowStats {
    float* xbuf;
    unsigned* cnt;
    unsigned target;
    __device__ __forceinline__ void run(const f32x4 (&v)[2][2][4][2], const Unit& u, int wr, int wc, int fr, int fq, PG8_LAS unsigned char* xl, int wid, int lane) const {
        PG8_LAS float* P = (PG8_LAS float*)xl;
        PG8_LAS float* S = (PG8_LAS float*)(xl + 4096);
#pragma unroll
        for (int ai = 0; ai < 2; ++ai)
#pragma unroll
            for (int m = 0; m < 4; ++m) {
                float s = 0.f;
#pragma unroll
                for (int bj = 0; bj < 2; ++bj)
#pragma unroll
                    for (int n = 0; n < 2; ++n) { const f32x4 x = v[ai][bj][m][n]; s += (x[0] * x[0] + x[1] * x[1]) + (x[2] * x[2] + x[3] * x[3]); }
                s += xor16f(s); s = sum32f(s);
                if (fq == 0) P[(ai * HALF + wr * 64 + m * 16 + fr) * 4 + wc] = s;
            }
        asm volatile("s_waitcnt lgkmcnt(0)" ::: "memory"); __builtin_amdgcn_s_barrier(); asm volatile("" ::: "memory");
        const int row = wid * 32 + (lane & 31);
        if (lane < 32) { const float t = (P[row * 4 + 0] + P[row * 4 + 1]) + (P[row * 4 + 2] + P[row * 4 + 3]);
            __hip_atomic_store(xbuf + (size_t)(u.pm * BM + row) * 4 + u.pn, t, __ATOMIC_RELAXED, __HIP_MEMORY_SCOPE_AGENT); }
        asm volatile("s_waitcnt vmcnt(0)" ::: "memory");
        if (lane == 0) __hip_atomic_fetch_add(cnt + 64 * u.pm, 1u, __ATOMIC_RELAXED, __HIP_MEMORY_SCOPE_AGENT);
        if (wid == 0) { unsigned sp = 0;
            while ((unsigned)__builtin_amdgcn_readfirstlane(__hip_atomic_load(cnt + 64 * u.pm, __ATOMIC_RELAXED, __HIP_MEMORY_SCOPE_AGENT)) < target) { __builtin_amdgcn_s_sleep(2); if (++sp > (1u << 18)) break; }
            __builtin_amdgcn_fence(__ATOMIC_ACQUIRE, "agent"); }
        asm volatile("s_waitcnt vmcnt(0) lgkmcnt(0)" ::: "memory"); __builtin_amdgcn_s_barrier(); asm volatile("" ::: "memory");
        if (lane < 32) { float* slot = xbuf + (size_t)(u.pm * BM + row) * 4; float t = 0.f;
#pragma unroll
            for (int k = 0; k < 4; ++k) t += __hip_atomic_load(slot + k, __ATOMIC_RELAXED, __HIP_MEMORY_SCOPE_AGENT);
            S[row] = t; }
        asm volatile("s_waitcnt lgkmcnt(0)" ::: "memory"); __builtin_amdgcn_s_barrier(); asm volatile("" ::: "memory");
    }
};
struct EpiNormRes {
    static constexpr bool PERM = false, AFTER_DRAIN = false, FUSED = true;
    bf16_t* hn; float* xs2; float* out; const float* gprev; const float* gpost; const float* gpre; RowStats st1; PG8_LAS unsigned char* xl;
    const float* s_in;
    __device__ __forceinline__ void fused(f32x4 (&acc)[2][2][4][2], const Unit& u, int wr, int wc, int fr, int fq, int wid, int lane) const {
        typedef unsigned u32x2v __attribute__((ext_vector_type(2)));
        PG8_LAS float* P = (PG8_LAS float*)xl;
        const PG8_LAS float* S = (const PG8_LAS float*)(xl + 4096);
        const int col0 = u.pn * BM + wc * 32 + 4 * fq;
        st1.run(acc, u, wr, wc, fr, fq, xl, wid, lane);
#pragma unroll
        for (int ai = 0; ai < 2; ++ai)
#pragma unroll
            for (int m = 0; m < 4; ++m) { const int r = ai * HALF + wr * 64 + m * 16 + fr; float rstd = rsqrtf(S[r] * (1.0f / 1024.0f) + 1e-6f); const size_t off = (size_t)(u.pm * BM + r) * 1024 + col0;
                if (s_in) { const f32x4 pp = *(const f32x4*)(s_in + (size_t)(u.pm * BM + r) * 4); const float s2 = __builtin_amdgcn_rcpf(((pp[0] + pp[1]) + (pp[2] + pp[3])) * (1.0f / 1024.0f) + 1e-6f);
                    rstd = rsqrtf(S[r] * (1.0f / 1024.0f) * s2 * s2 + 1e-6f) * s2; }
#pragma unroll
                for (int bj = 0; bj < 2; ++bj)
#pragma unroll
                    for (int n = 0; n < 2; ++n) { const u32x2v hw = *(const u32x2v*)(hn + off + bj * HALF + n * 16);
                        const f32x4 gp = *(const f32x4*)(gprev + col0 + bj * HALF + n * 16); const f32x4 gv = *(const f32x4*)(gpost + col0 + bj * HALF + n * 16);
                        f32x4 xs; xs[0] = __uint_as_float(hw.x << 16) * __builtin_amdgcn_rcpf(gp[0]); xs[1] = __uint_as_float(hw.x & 0xffff0000u) * __builtin_amdgcn_rcpf(gp[1]);
                        xs[2] = __uint_as_float(hw.y << 16) * __builtin_amdgcn_rcpf(gp[2]); xs[3] = __uint_as_float(hw.y & 0xffff0000u) * __builtin_amdgcn_rcpf(gp[3]);
                        acc[ai][bj][m][n] = xs + (acc[ai][bj][m][n] * rstd) * gv; }
                asm volatile("" : "+v"(acc[ai][0][m][0]), "+v"(acc[ai][0][m][1]), "+v"(acc[ai][1][m][0]), "+v"(acc[ai][1][m][1]));
                if (m & 1) asm volatile("" ::: "memory"); }
        if (gpre) {
#pragma unroll
            for (int ai = 0; ai < 2; ++ai)
#pragma unroll
                for (int m = 0; m < 4; ++m) {
                    float s = 0.f;
#pragma unroll
                    for (int bj = 0; bj < 2; ++bj)
#pragma unroll
                        for (int n = 0; n < 2; ++n) { const f32x4 x = acc[ai][bj][m][n]; s += (x[0] * x[0] + x[1] * x[1]) + (x[2] * x[2] + x[3] * x[3]); }
                    s += xor16f(s); s = sum32f(s);
                    if (fq == 0) P[(ai * HALF + wr * 64 + m * 16 + fr) * 4 + wc] = s;
                }
            asm volatile("s_waitcnt lgkmcnt(0)" ::: "memory"); __builtin_amdgcn_s_barrier(); asm volatile("" ::: "memory");
            { const int row = wid * 32 + (lane & 31);
              if (lane < 32) xs2[(size_t)(u.pm * BM + row) * 4 + u.pn] = (P[row * 4 + 0] + P[row * 4 + 1]) + (P[row * 4 + 2] + P[row * 4 + 3]); }
#pragma unroll
            for (int ai = 0; ai < 2; ++ai)
#pragma unroll
                for (int m = 0; m < 4; ++m) { const int r = ai * HALF + wr * 64 + m * 16 + fr; const size_t off = (size_t)(u.pm * BM + r) * 1024 + col0;
#pragma unroll
                    for (int bj = 0; bj < 2; ++bj)
#pragma unroll
                        for (int n = 0; n < 2; ++n) { const f32x4 gv = *(const f32x4*)(gpre + col0 + bj * HALF + n * 16); const f32x4 o = acc[ai][bj][m][n] * gv;
                            u32x2v w; w.x = cvt_pk_bf16(o[0], o[1]); w.y = cvt_pk_bf16(o[2], o[3]); *(u32x2v*)(hn + off + bj * HALF + n * 16) = w; }
                    asm volatile("" ::: "memory"); }
            asm volatile("s_waitcnt lgkmcnt(0)" ::: "memory"); __builtin_amdgcn_s_barrier(); asm volatile("" ::: "memory");
        } else {
#pragma unroll
            for (int ai = 0; ai < 2; ++ai)
#pragma unroll
                for (int m = 0; m < 4; ++m) { const int r = ai * HALF + wr * 64 + m * 16 + fr; const size_t off = (size_t)(u.pm * BM + r) * 1024 + col0;
#pragma unroll
                    for (int bj = 0; bj < 2; ++bj)
#pragma unroll
                        for (int n = 0; n < 2; ++n) *(f32x4*)(out + off + bj * HALF + n * 16) = acc[ai][bj][m][n]; }
        }
    }
};

template <class Epi, class Sched, bool ALIGN_EPI>
__device__ __forceinline__ void gemm_phase(PG8_LAS unsigned char* lds, const Gemm g, const Sched& S, const Epi& E, int tid0) {
    int tid_ = tid0; asm volatile("" : "+v"(tid_));
    const int tid = tid_, wid = __builtin_amdgcn_readfirstlane(tid >> 6), lane = tid & 63, wr = wid >> 2, wc = wid & 3, fr = lane & 15, fq = lane >> 4;
    const int K = g.K, nt = K / BK;
    unsigned voffA[2], voffB[2];
#pragma unroll
    for (int i = 0; i < 2; ++i) { int R, C; stage_rc(tid * 16 + i * 8192, R, C); const int Rb = Epi::PERM ? ((R & ~31) + perm32(R & 31)) : R;
        voffA[i] = (unsigned)(R * g.lda + C) * 2u; voffB[i] = (unsigned)(Rb * g.ldb + C) * 2u; }
    const size_t kstep = (size_t)(BK * 2);
    const size_t hstepA = (size_t)HALF * g.lda * 2, hstepB = (size_t)HALF * g.ldb * 2;
    const size_t tstepA = 2 * hstepA, tstepB = 2 * hstepB;
    const unsigned ldsw = (unsigned)wid * 1024u;
    const int aoff = lds_byte(wr * 64 + fr, fq * 8), boff = lds_byte(wc * 32 + fr, fq * 8);
#define PG8_SA(b, h) (((b) * 2 + (h)) * HTB)
#define PG8_SB(b, h) ((4 + (b) * 2 + (h)) * HTB)
#define PG8_STAGE(bufoff, gbase, voff) do { _Pragma("unroll") for (int _i = 0; _i < 2; ++_i) \
        __builtin_amdgcn_global_load_lds((const unsigned*)((const char*)(gbase) + (voff)[_i]), (PG8_LAS unsigned*)(lds + (bufoff) + ldsw + _i * 8192), 16, 0, 0); } while (0)
#define PG8_LDA(dst, b, h) do { _Pragma("unroll") for (int m = 0; m < 4; ++m) _Pragma("unroll") for (int k = 0; k < 2; ++k) dst[m][k] = *(const PG8_LAS bf16x8*)(lds + PG8_SA(b, h) + aoff + m * 2048 + k * 1024); } while (0)
#define PG8_LDB(dst, b, h) do { _Pragma("unroll") for (int n = 0; n < 2; ++n) _Pragma("unroll") for (int k = 0; k < 2; ++k) dst[n][k] = *(const PG8_LAS bf16x8*)(lds + PG8_SB(b, h) + boff + n * 2048 + k * 1024); } while (0)
#define PG8_MMA(ai, bj, At, Bt) do { __builtin_amdgcn_s_setprio(1); _Pragma("unroll") for (int m = 0; m < 4; ++m) _Pragma("unroll") for (int n = 0; n < 2; ++n) _Pragma("unroll") for (int k = 0; k < 2; ++k) \
        acc[ai][bj][m][n] = __builtin_amdgcn_mfma_f32_16x16x32_bf16(Bt[n][k], At[m][k], acc[ai][bj][m][n], 0, 0, 0); __builtin_amdgcn_s_setprio(0); } while (0)
#define PG8_WAIT_V(n) asm volatile("s_waitcnt vmcnt(" #n ")" ::: "memory")
#define PG8_WAIT_L(n) asm volatile("s_waitcnt lgkmcnt(" #n ")" ::: "memory")
#define PG8_BAR __builtin_amdgcn_s_barrier()
#define PG8_SCHED __builtin_amdgcn_sched_barrier(0)
    Unit cur, nxt; int ui = 0;
    if (!S.next(0, cur)) return;
    f32x4 acc[2][2][4][2];
#pragma unroll
    for (int a = 0; a < 2; ++a)
#pragma unroll
        for (int b = 0; b < 2; ++b)
#pragma unroll
            for (int m = 0; m < 4; ++m)
#pragma unroll
                for (int n = 0; n < 2; ++n) acc[a][b][m][n] = (f32x4){0.f, 0.f, 0.f, 0.f};
    bf16x8 At[4][2], B0[2][2], B1[2][2];
    const char* cA = (const char*)g.A + (size_t)cur.pm * tstepA + (size_t)(cur.pn >> 1) * (size_t)g.apn; const char* cB = (const char*)g.Bt + (size_t)cur.pn * tstepB;
    S.a_ready(cur);
    PG8_STAGE(PG8_SB(0, 0), cB, voffB); PG8_STAGE(PG8_SB(0, 1), cB + hstepB, voffB); PG8_STAGE(PG8_SA(0, 0), cA, voffA); PG8_STAGE(PG8_SA(0, 1), cA + hstepA, voffA);
    if (wr == 1) PG8_BAR;
    PG8_WAIT_V(2); PG8_BAR;
    PG8_STAGE(PG8_SB(1, 0), cB + kstep, voffB); PG8_STAGE(PG8_SA(1, 0), cA + kstep, voffA); PG8_STAGE(PG8_SB(1, 1), cB + hstepB + kstep, voffB);
    PG8_WAIT_V(6); PG8_BAR;
    for (;;) {
        const bool has_next = S.next(ui + 1, nxt);
        const char* nA = has_next ? (const char*)g.A + (size_t)nxt.pm * tstepA + (size_t)(nxt.pn >> 1) * (size_t)g.apn : cA; const char* nB = has_next ? (const char*)g.Bt + (size_t)nxt.pn * tstepB : cB;
        for (int t = 0; t < nt; t += 2) {
            const bool last = (t == nt - 2);
            const char* a1 = cA + (size_t)(t + 1) * kstep;
            const char* a2 = last ? nA : cA + (size_t)(t + 2) * kstep; const char* b2 = last ? nB : cB + (size_t)(t + 2) * kstep;
            const char* a3 = a2 + kstep; const char* b3 = b2 + kstep;
            if (last && has_next) S.a_ready(nxt);
            PG8_LDB(B0, 0, 0); PG8_LDB(B1, 0, 1); PG8_SCHED; PG8_LDA(At, 0, 0); PG8_STAGE(PG8_SA(1, 1), a1 + hstepA, voffA);
            PG8_WAIT_V(8); PG8_WAIT_L(0); PG8_BAR; PG8_MMA(0, 0, At, B0); PG8_MMA(0, 1, At, B1); PG8_BAR; PG8_SCHED;
            PG8_LDA(At, 0, 1); PG8_STAGE(PG8_SB(0, 0), b2, voffB); PG8_STAGE(PG8_SB(0, 1), b2 + hstepB, voffB); PG8_STAGE(PG8_SA(0, 0), a2, voffA);
            PG8_WAIT_V(8); PG8_WAIT_L(0); PG8_BAR; PG8_MMA(1, 0, At, B0); PG8_MMA(1, 1, At, B1); PG8_BAR; PG8_SCHED;
            PG8_LDB(B0, 1, 0); PG8_LDB(B1, 1, 1); PG8_SCHED; PG8_LDA(At, 1, 0); PG8_STAGE(PG8_SA(0, 1), a2 + hstepA, voffA);
            PG8_WAIT_V(8); PG8_WAIT_L(0); PG8_BAR; PG8_MMA(0, 0, At, B0); PG8_MMA(0, 1, At, B1); PG8_BAR; PG8_SCHED;
            PG8_LDA(At, 1, 1); PG8_STAGE(PG8_SB(1, 0), b3, voffB); PG8_STAGE(PG8_SB(1, 1), b3 + hstepB, voffB); PG8_STAGE(PG8_SA(1, 0), a3, voffA);
            PG8_WAIT_V(8); PG8_WAIT_L(0); PG8_BAR; PG8_MMA(1, 0, At, B0); PG8_MMA(1, 1, At, B1); PG8_BAR; PG8_SCHED;
        }
        if constexpr (ALIGN_EPI) { if (wr == 0) PG8_BAR; }
        if constexpr (Epi::FUSED) E.fused(acc, cur, wr, wc, fr, fq, wid, lane); else E(acc, cur, wr, wc, fr, fq);
        S.done(cur);
        if (!has_next) break;
#pragma unroll
        for (int a = 0; a < 2; ++a)
#pragma unroll
            for (int b = 0; b < 2; ++b)
#pragma unroll
                for (int m = 0; m < 4; ++m)
#pragma unroll
                    for (int n = 0; n < 2; ++n) acc[a][b][m][n] = (f32x4){0.f, 0.f, 0.f, 0.f};
        cur = nxt; cA = nA; cB = nB; ++ui;
        if constexpr (ALIGN_EPI) { if (wr == 1) PG8_BAR; }
    }
    PG8_WAIT_V(0);
    if constexpr (!ALIGN_EPI) { if (wr == 0) PG8_BAR; }
    PG8_BAR;
#undef PG8_SA
#undef PG8_SB
#undef PG8_STAGE
#undef PG8_LDA
#undef PG8_LDB
#undef PG8_MMA
#undef PG8_WAIT_V
#undef PG8_WAIT_L
#undef PG8_BAR
#undef PG8_SCHED
}
}
namespace att {
typedef unsigned short u16;
typedef short bf16x8 __attribute__((ext_vector_type(8)));
typedef short s16x4 __attribute__((ext_vector_type(4)));
typedef float f32x16 __attribute__((ext_vector_type(16)));
typedef float f32x4 __attribute__((ext_vector_type(4)));
typedef unsigned u32x4 __attribute__((ext_vector_type(4)));
constexpr int SEQ = 16384, NW = 8, QBLK = 32, KVBLK = 64, QB = NW * QBLK;
constexpr int LDQ = 1536, LDK = 2048, LDKR = 64, LDO = 1024;
#ifndef ATT_NQREG
#define ATT_NQREG 8
#endif
constexpr int NQREG = ATT_NQREG, NQREG_L = 8 - NQREG;
constexpr int SHM_V = KVBLK * 128 * 2, SHM_K = KVBLK * 128 * 2, SHM_KR = KVBLK * 64 * 2;
constexpr int OFF_V = 0, OFF_K = 2 * SHM_V, OFF_KR = OFF_K + 2 * SHM_K, OFF_WS = OFF_KR + 2 * SHM_KR, OFF_QR = OFF_WS + NW * 64 * 4, QR_WAVE = (NQREG_L + 4) * 1024, LDS_BYTES = OFF_QR + NW * QR_WAVE;
constexpr float SCALE = 0.07216878364870322f;
constexpr float THR = 8.f;

#define KSWZ(row, colB) ((row) * 256 + ((colB) ^ (((row) & 7) << 4)))
#define KRSWZ(row, colB) ((row) * 128 + ((colB) ^ (((row) & 7) << 4)))
#define SBAR() __builtin_amdgcn_sched_barrier(0)
__device__ __forceinline__ int v_st(int k, int c) { const int kk = (k & ~0xC) | ((k & 4) << 1) | ((k & 8) >> 1); return ((kk >> 3) * 4 + (c >> 5)) * 512 + ((kk & 7) * 32 + (c & 31)) * 2; }
__device__ __forceinline__ int v_rd_base(int lane) { return ((lane & 3) << 3) | (((lane >> 2) & 3) << 6) | (((lane >> 4) & 1) << 5) | (((lane >> 5) & 1) << 8); }
constexpr int v_rd_off(int d0, int ks, int half) { return d0 * 512 + ks * 4096 + half * 2048; }
__device__ __forceinline__ int crow(int r, int hi) { return (r & 3) + 8 * (r >> 2) + 4 * hi; }
__device__ __forceinline__ unsigned cvtpk(float lo, float hi) { unsigned r; asm volatile("v_cvt_pk_bf16_f32 %0, %1, %2" : "=v"(r) : "v"(lo), "v"(hi)); return r; }
__device__ __forceinline__ bf16x8 load8(const u16* p) { return *reinterpret_cast<const bf16x8*>(p); }
__device__ __forceinline__ void mask_tile(f32x16& p0, f32x16& p1, int dq, unsigned W) {
    const float NEG = -__builtin_inff();
#pragma unroll
    for (int r = 0; r < 16; ++r) {
        const int c = (r & 3) + 8 * (r >> 2);
        if ((unsigned)(dq - c) >= W) p0[r] = NEG;
        if ((unsigned)(dq - c - 32) >= W) p1[r] = NEG;
    }
}
__device__ __forceinline__ void partialSM(f32x16& p0, f32x16& p1, float& m_reg, float& mn, float& alpha) {
    float pmax = p0[0]; for (int r = 1; r < 16; ++r) pmax = fmaxf(pmax, p0[r]); for (int r = 0; r < 16; ++r) pmax = fmaxf(pmax, p1[r]);
    { auto rr = __builtin_amdgcn_permlane32_swap(__float_as_uint(pmax), __float_as_uint(pmax), false, false);
      pmax = fmaxf(__uint_as_float(rr[0]), __uint_as_float(rr[1])); }
    constexpr float C2 = 1.4426950408889634f * SCALE;
    if (__builtin_expect(__all((pmax - m_reg) * SCALE <= THR), 1)) { mn = m_reg; alpha = 1.f; }
    else { mn = fmaxf(m_reg, pmax); alpha = __builtin_amdgcn_exp2f((m_reg - mn) * C2); m_reg = mn; }
    const float mnL = -mn * C2;
    for (int r = 0; r < 16; ++r) p0[r] = fmaf(p0[r], C2, mnL); for (int r = 0; r < 16; ++r) p1[r] = fmaf(p1[r], C2, mnL);
}
__device__ __forceinline__ void finishSM(f32x16& p0, f32x16& p1, float alpha, float& l_reg, bf16x8& pa0, bf16x8& pa1, bf16x8& pa2, bf16x8& pa3) {
    for (int r = 0; r < 16; ++r) p0[r] = __builtin_amdgcn_exp2f(p0[r]);
    for (int r = 0; r < 16; ++r) p1[r] = __builtin_amdgcn_exp2f(p1[r]);
    float ps = 0; for (int r = 0; r < 16; ++r) ps += p0[r]; for (int r = 0; r < 16; ++r) ps += p1[r];
    { auto rr = __builtin_amdgcn_permlane32_swap(__float_as_uint(ps), __float_as_uint(ps), false, false);
      ps = __uint_as_float(rr[0]) + __uint_as_float(rr[1]); }
    l_reg = l_reg * alpha + ps;
#define PK4(P, B_, OUT) do { unsigned a0 = cvtpk(P[B_+0], P[B_+1]), a1 = cvtpk(P[B_+2], P[B_+3]);                          \
        unsigned b0 = cvtpk(P[B_+4], P[B_+5]), b1 = cvtpk(P[B_+6], P[B_+7]);                                             \
        auto r0 = __builtin_amdgcn_permlane32_swap(a0, b0, false, false); auto r1 = __builtin_amdgcn_permlane32_swap(a1, b1, false, false); \
        u32x4 w = {r0[0], r1[0], r0[1], r1[1]}; OUT = *reinterpret_cast<bf16x8*>(&w); } while (0)
    PK4(p0, 0, pa0); PK4(p0, 8, pa1); PK4(p1, 0, pa2); PK4(p1, 8, pa3);
#undef PK4
}
#ifndef ATT_PF
#define ATT_PF 1
#endif
#define QK_SB() __builtin_amdgcn_sched_barrier(0x406)
#define QK_LOAD(s, SET) do { if ((s) < 8) { const char* a_ = kb[(s) & 3] + ((s) >> 2) * 128; fb0[SET] = *reinterpret_cast<const bf16x8*>(a_); fb1[SET] = *reinterpret_cast<const bf16x8*>(a_ + 32 * 256); \
            if ((s) < NQREG) fq[SET] = qr[(s) < NQREG ? (s) : 0]; else fq[SET] = qrl[((s) - NQREG) * 64]; } \
        else { const char* a_ = krb[((s) - 8) & 3]; fb0[SET] = *reinterpret_cast<const bf16x8*>(a_); fb1[SET] = *reinterpret_cast<const bf16x8*>(a_ + 32 * 128); fq[SET] = qrl[(NQREG_L + (s) - 8) * 64]; } } while (0)
template <int KB>
__device__ __forceinline__ void qkt(f32x16& p0, f32x16& p1, const char* K_lds, const char* KR_lds, const bf16x8* qrl, int r32, int hi, const bf16x8* qr) {
    constexpr int PF = ATT_PF, NS = PF + 1;
    p0 = f32x16{}; p1 = f32x16{};
    const char* kb[4]; const char* krb[4];
#pragma unroll
    for (int dd = 0; dd < 4; ++dd) { kb[dd] = K_lds + KB * SHM_K + KSWZ(r32, (dd * 16 + hi * 8) * 2); krb[dd] = KR_lds + KB * SHM_KR + KRSWZ(r32, (dd * 16 + hi * 8) * 2); }
    bf16x8 fb0[NS], fb1[NS], fq[NS];
#pragma unroll
    for (int s = 0; s < PF; ++s) QK_LOAD(s, s % NS);
#pragma unroll
    for (int s = 0; s < 12; ++s) {
        QK_SB();
        if (s + PF < 12) QK_LOAD(s + PF, (s + PF) % NS);
        QK_SB();
        p0 = __builtin_amdgcn_mfma_f32_32x32x16_bf16(fb0[s % NS], fq[s % NS], p0, 0, 0, 0);
        p1 = __builtin_amdgcn_mfma_f32_32x32x16_bf16(fb1[s % NS], fq[s % NS], p1, 0, 0, 0);
    }
    QK_SB();
}
#define FSM_E(j) do { if ((j) < 16) { y0[(j) & 15] = __builtin_amdgcn_exp2f(y0[(j) & 15]); acc += y0[(j) & 15]; } else { y1[(j) & 15] = __builtin_amdgcn_exp2f(y1[(j) & 15]); acc += y1[(j) & 15]; } } while (0)
#define FSM_CVT(P, B_) do { ca0 = cvtpk(P[(B_) + 0], P[(B_) + 1]); ca1 = cvtpk(P[(B_) + 2], P[(B_) + 3]); cb0 = cvtpk(P[(B_) + 4], P[(B_) + 5]); cb1 = cvtpk(P[(B_) + 6], P[(B_) + 7]); } while (0)
#define FSM_SWP(OUT) do { auto r0_ = __builtin_amdgcn_permlane32_swap(ca0, cb0, false, false); auto r1_ = __builtin_amdgcn_permlane32_swap(ca1, cb1, false, false); \
        u32x4 w_ = {r0_[0], r1_[0], r0_[1], r1_[1]}; OUT = *reinterpret_cast<bf16x8*>(&w_); } while (0)
#define FSM_CHUNK(c) do { if ((c) < 12) { FSM_E(2 * (c)); FSM_E(2 * (c) + 1); } else if ((c) < 20) { FSM_E(24 + (c) - 12); } \
        if ((c) == 12) FSM_CVT(y0, 0); if ((c) == 13) FSM_SWP(pa0); if ((c) == 14) FSM_CVT(y0, 8); if ((c) == 15) FSM_SWP(pa1); \
        if ((c) == 16) FSM_CVT(y1, 0); if ((c) == 17) FSM_SWP(pa2); if ((c) == 20) FSM_CVT(y1, 8); if ((c) == 21) FSM_SWP(pa3); \
        if ((c) == 22) { auto rr_ = __builtin_amdgcn_permlane32_swap(__float_as_uint(acc), __float_as_uint(acc), false, false); acc = __uint_as_float(rr_[0]) + __uint_as_float(rr_[1]); } \
        if ((c) == 23) l_reg = l_reg * alpha + acc; } while (0)
#define SB0() __builtin_amdgcn_sched_barrier(0)
#define QKN(j) ((j) >= 12 ? 0 : ((j) < NQREG ? 2 : 3))
#define DSR128(dst, addr, off) asm volatile("ds_read_b128 %0, %1 offset:%2" : "=v"(dst) : "v"(addr), "i"(off) : "memory")
#define QKA_LOAD(s, SET) do { if ((s) < 8) { DSR128(fb0[SET], ka[(s) & 3], KB * SHM_K + ((s) >> 2) * 128); DSR128(fb1[SET], ka[(s) & 3], KB * SHM_K + ((s) >> 2) * 128 + 32 * 256); \
            if ((s) >= NQREG) DSR128(fq[SET], qa, (((s) - NQREG) & 15) * 1024); } \
        else if ((s) < 12) { DSR128(fb0[SET], kra[((s) - 8) & 3], KB * SHM_KR); DSR128(fb1[SET], kra[((s) - 8) & 3], KB * SHM_KR + 32 * 128); DSR128(fq[SET], qa, ((NQREG_L + (s) - 8) & 15) * 1024); } } while (0)
#define QKQ(s) ((s) < NQREG ? qr[(s) < NQREG ? (s) : 0] : fq[(s) % 3])
#define QKA_STEP(s) do { SB0(); QKA_LOAD((s) + 2, ((s) + 2) % 3); SB0(); \
        asm volatile("s_waitcnt lgkmcnt(%0)" :: "i"(QKN((s) + 1) + QKN((s) + 2)) : "memory"); SB0(); \
        p0 = __builtin_amdgcn_mfma_f32_32x32x16_bf16(fb0[(s) % 3], QKQ(s), p0, 0, 0, 0); SB0(); FSM_CHUNK(2 * (s)); SB0(); \
        p1 = __builtin_amdgcn_mfma_f32_32x32x16_bf16(fb1[(s) % 3], QKQ(s), p1, 0, 0, 0); SB0(); FSM_CHUNK(2 * (s) + 1); } while (0)
template <int KB>
__device__ __forceinline__ void qkt_fsm(f32x16& p0, f32x16& p1, const int (&ka)[4], const int (&kra)[4], int qa, bf16x8 (&fb0)[3], bf16x8 (&fb1)[3], bf16x8 (&fq)[3], const bf16x8* qr,
                                        f32x16& y0, f32x16& y1, float alpha, float& l_reg, bf16x8& pa0, bf16x8& pa1, bf16x8& pa2, bf16x8& pa3) {
    p0 = f32x16{}; p1 = f32x16{};
    float acc = 0.f; unsigned ca0 = 0, ca1 = 0, cb0 = 0, cb1 = 0;
    QKA_STEP(0); QKA_STEP(1); QKA_STEP(2); QKA_STEP(3); QKA_STEP(4); QKA_STEP(5); QKA_STEP(6); QKA_STEP(7); QKA_STEP(8); QKA_STEP(9); QKA_STEP(10); QKA_STEP(11);
    SB0();
}
#undef QKN
#undef QKQ
#undef QKA_STEP
#undef FSM_E
#undef FSM_CVT
#undef FSM_SWP
#undef FSM_CHUNK
#undef QK_LOAD
template <int VB>
__device__ __forceinline__ void pv_tile(f32x16* o, int vb0, bf16x8 pa0, bf16x8 pa1, bf16x8 pa2, bf16x8 pa3) {
#define TRRD(dst, off) asm volatile("ds_read_b64_tr_b16 %0, %1 offset:%2" : "=&v"(dst) : "v"(vb0), "i"(off) : "memory")
#define PV_D0(d0) do { s16x4 l0, l1, l2, l3, h0, h1, h2, h3; constexpr int b_ = OFF_V + VB * SHM_V + v_rd_off(d0, 0, 0); \
        TRRD(l0, b_); TRRD(h0, b_ + 2048); TRRD(l1, b_ + 4096); TRRD(h1, b_ + 6144); TRRD(l2, b_ + 8192); TRRD(h2, b_ + 10240); TRRD(l3, b_ + 12288); TRRD(h3, b_ + 14336); \
        asm volatile("s_waitcnt lgkmcnt(0)" ::: "memory"); SBAR();   \
        o[d0] = __builtin_amdgcn_mfma_f32_32x32x16_bf16(pa0, (bf16x8){l0[0], l0[1], l0[2], l0[3], h0[0], h0[1], h0[2], h0[3]}, o[d0], 0, 0, 0);   \
        o[d0] = __builtin_amdgcn_mfma_f32_32x32x16_bf16(pa1, (bf16x8){l1[0], l1[1], l1[2], l1[3], h1[0], h1[1], h1[2], h1[3]}, o[d0], 0, 0, 0);   \
        o[d0] = __builtin_amdgcn_mfma_f32_32x32x16_bf16(pa2, (bf16x8){l2[0], l2[1], l2[2], l2[3], h2[0], h2[1], h2[2], h2[3]}, o[d0], 0, 0, 0);   \
        o[d0] = __builtin_amdgcn_mfma_f32_32x32x16_bf16(pa3, (bf16x8){l3[0], l3[1], l3[2], l3[3], h3[0], h3[1], h3[2], h3[3]}, o[d0], 0, 0, 0); } while (0)
    PV_D0(0); PV_D0(1); PV_D0(2); PV_D0(3);
}
template <int VB>
__device__ __forceinline__ void pv_tile_sm(f32x16* o, int vb0, bf16x8 pa0, bf16x8 pa1, bf16x8 pa2, bf16x8 pa3, f32x16& p0, f32x16& p1, float& m_reg, float& mn, float& alpha) {
    constexpr float C2 = 1.4426950408889634f * SCALE;
    PV_D0(0);
    float pmax = p0[0];
#pragma unroll
    for (int r = 1; r < 16; ++r) pmax = fmaxf(pmax, p0[r]);
#pragma unroll
    for (int r = 0; r < 16; ++r) pmax = fmaxf(pmax, p1[r]);
    PV_D0(1);
    { auto rr = __builtin_amdgcn_permlane32_swap(__float_as_uint(pmax), __float_as_uint(pmax), false, false);
      pmax = fmaxf(__uint_as_float(rr[0]), __uint_as_float(rr[1])); }
    const bool keep = __all((pmax - m_reg) * SCALE <= THR);
    mn = keep ? m_reg : fmaxf(m_reg, pmax);
    alpha = __builtin_amdgcn_exp2f((m_reg - mn) * C2);
    m_reg = mn;
    const float mnL = -mn * C2;
#pragma unroll
    for (int r = 0; r < 16; ++r) p0[r] = fmaf(p0[r], C2, mnL);
    PV_D0(2);
#pragma unroll
    for (int r = 0; r < 16; ++r) p1[r] = fmaf(p1[r], C2, mnL);
    PV_D0(3);
}
#undef PV_D0
#undef TRRD

struct BlockRef { const u16* Q; const u16* K; const u16* V; const u16* KR; u16* O; int P0; int row0; };
#define VMW() asm volatile("s_waitcnt vmcnt(0)" ::: "memory")
#define ATT_LAS __attribute__((address_space(3)))
#define KDMA(Kp, KRp, k0, bf) do { \
        __builtin_amdgcn_global_load_lds((const unsigned*)((Kp) + (size_t)((k0) + sr) * LDK + ksc), (ATT_LAS unsigned*)(ldsL + OFF_K + (bf) * SHM_K + wid * 1024), 16, 0, 0); \
        __builtin_amdgcn_global_load_lds((const unsigned*)((Kp) + (size_t)((k0) + 32 + sr) * LDK + ksc), (ATT_LAS unsigned*)(ldsL + OFF_K + (bf) * SHM_K + 8192 + wid * 1024), 16, 0, 0); \
        __builtin_amdgcn_global_load_lds((const unsigned*)((KRp) + (size_t)((k0) + krr) * LDKR + krsc), (ATT_LAS unsigned*)(ldsL + OFF_KR + (bf) * SHM_KR + wid * 1024), 16, 0, 0); } while (0)
#define VDMA(Vp, k0, bf) do { \
        __builtin_amdgcn_global_load_lds((const unsigned*)((Vp) + (size_t)((k0) + vk) * LDK + vc), (ATT_LAS unsigned*)(ldsL + OFF_V + (bf) * SHM_V + wid * 1024), 16, 0, 0); \
        __builtin_amdgcn_global_load_lds((const unsigned*)((Vp) + (size_t)((k0) + 32 + vk) * LDK + vc), (ATT_LAS unsigned*)(ldsL + OFF_V + (bf) * SHM_V + 8192 + wid * 1024), 16, 0, 0); } while (0)
#define ATT_MAPS() const int sr = tid >> 4, ksc = ((tid & 15) ^ (sr & 7)) * 8, krr = tid >> 3, krsc = ((tid & 7) ^ (krr & 7)) * 8; ATT_LAS unsigned char* ldsL = (ATT_LAS unsigned char*)lds; \
    const int vkk_ = ((tid >> 7) << 3) | ((tid >> 2) & 7), vk = (vkk_ & ~0xC) | ((vkk_ & 4) << 1) | ((vkk_ & 8) >> 1), vc = ((tid >> 5) & 3) * 32 + (tid & 3) * 8
__device__ __forceinline__ void attn_prime(const BlockRef& cur, char* lds, int tid0) {
    int tid_ = tid0; asm volatile("" : "+v"(tid_));
    const int tid = tid_, wid = __builtin_amdgcn_readfirstlane(tid >> 6);
    ATT_MAPS();
    KDMA(cur.K, cur.KR, 0, 0); VDMA(cur.V, 0, 0); VMW();
    __syncthreads();
}
__device__ __forceinline__ void attn_block(const BlockRef& cur, const BlockRef& nxt, char* lds, int tid0, const float* ctab, const float* stab) {
    int tid_ = tid0; asm volatile("" : "+v"(tid_));
    const int tid = tid_, wid = __builtin_amdgcn_readfirstlane(tid >> 6), lane = tid & 63, r32 = lane & 31, hi = lane >> 5;
    const unsigned W = 0x40000000u;
    const int NT = (cur.P0 + QB - 1) / KVBLK + 1;
    const int qlo = cur.P0 + wid * QBLK, qm = qlo + r32 - 4 * hi;
    char* K_lds = lds + OFF_K; char* KR_lds = lds + OFF_KR;
    float* ws = (float*)(lds + OFF_WS) + wid * 64; float* li_l = ws, * al_l = ws + 32;
    bf16x8* qrl = (bf16x8*)(lds + OFF_QR + wid * QR_WAVE) + lane;
    float m_reg = -1e30f, l_reg = 0; f32x16 o[4] = {};
    ATT_MAPS();
    const int vb0 = (int)(uintptr_t)lds + v_rd_base(lane);
    const u16* Kh = cur.K; const u16* Vh = cur.V; const u16* KRh = cur.KR;
#define RESC(a) do { if (__any((a) < 1.f)) { if (hi == 0) al_l[r32] = (a); asm volatile("s_waitcnt lgkmcnt(0)" ::: "memory");              \
                     for (int d_ = 0; d_ < 4; ++d_) for (int r = 0; r < 16; ++r) o[d_][r] *= al_l[crow(r, hi)]; } } while (0)
#define KBASE(t) ((t) * KVBLK)
#define MASKT(P0_, P1_, t) do { const int kb_ = KBASE(t); if (kb_ + KVBLK - 1 > qlo) mask_tile(P0_, P1_, qm - kb_, W); } while (0)
    f32x16 pA0, pA1, pB0, pB1; float mnA, mnB, alA, alB; bf16x8 pa0, pa1, pa2, pa3;
    int ka[4], kra[4]; const int qa = (int)(uintptr_t)qrl; bf16x8 fb0[3], fb1[3], fq[3];
#pragma unroll
    for (int dd = 0; dd < 4; ++dd) { ka[dd] = (int)(uintptr_t)K_lds + KSWZ(r32, (dd * 16 + hi * 8) * 2); kra[dd] = (int)(uintptr_t)KR_lds + KRSWZ(r32, (dd * 16 + hi * 8) * 2); }
#define QK_PREFETCH(KBN) do { constexpr int KB = (KBN); SB0(); QKA_LOAD(0, 0); QKA_LOAD(1, 1); SB0(); } while (0)
    bf16x8 qr[NQREG > 0 ? NQREG : 1];
    { const u16* qp = cur.Q + (size_t)(wid * QBLK + r32) * LDQ + hi * 8;
#pragma unroll
      for (int d = 0; d < NQREG_L; ++d) qrl[d * 64] = load8(qp + (NQREG + d) * 16);
      const size_t trow = (size_t)(cur.row0 + wid * QBLK + r32) * 32 + hi * 8;
#pragma unroll
      for (int pr = 0; pr < 2; ++pr) {
          const bf16x8 x1 = load8(qp + 128 + pr * 16), x2 = load8(qp + 128 + 32 + pr * 16);
          const f32x4 c0 = *(const f32x4*)(ctab + trow + pr * 16), c1 = *(const f32x4*)(ctab + trow + pr * 16 + 4), s0 = *(const f32x4*)(stab + trow + pr * 16), s1 = *(const f32x4*)(stab + trow + pr * 16 + 4);
          float o1[8], o2[8];
#pragma unroll
          for (int e = 0; e < 8; ++e) { const float a = __uint_as_float(((unsigned)(unsigned short)x1[e]) << 16), b = __uint_as_float(((unsigned)(unsigned short)x2[e]) << 16);
              const float cc = e < 4 ? c0[e & 3] : c1[e & 3], ss = e < 4 ? s0[e & 3] : s1[e & 3]; o1[e] = a * cc - b * ss; o2[e] = b * cc + a * ss; }
          u32x4 w1 = {cvtpk(o1[0], o1[1]), cvtpk(o1[2], o1[3]), cvtpk(o1[4], o1[5]), cvtpk(o1[6], o1[7])}, w2 = {cvtpk(o2[0], o2[1]), cvtpk(o2[2], o2[3]), cvtpk(o2[4], o2[5]), cvtpk(o2[6], o2[7])};
          qrl[(NQREG_L + pr) * 64] = *reinterpret_cast<bf16x8*>(&w1); qrl[(NQREG_L + 2 + pr) * 64] = *reinterpret_cast<bf16x8*>(&w2); }
#pragma unroll
      for (int d0 = 0; d0 < NQREG; ++d0) qr[d0] = load8(qp + d0 * 16); }
    SBAR();
    KDMA(Kh, KRh, KBASE(1), 1); VDMA(Vh, KBASE(1), 1);
    SBAR(); qkt<0>(pA0, pA1, K_lds, KR_lds, qrl, r32, hi, qr);
    MASKT(pA0, pA1, 0); partialSM(pA0, pA1, m_reg, mnA, alA);
    VMW(); __syncthreads();
    QK_PREFETCH(1);
    KDMA(Kh, KRh, KBASE(2), 0);
#define HALF_STEP(PX0, PX1, mnX, alX, PY0, PY1, alY, t, KB, VB) do {                                                          \
        SBAR(); qkt_fsm<KB>(PX0, PX1, ka, kra, qa, fb0, fb1, fq, qr, PY0, PY1, alY, l_reg, pa0, pa1, pa2, pa3); SBAR();                       \
        MASKT(PX0, PX1, (t)); SBAR(); pv_tile_sm<VB>(o, vb0, pa0, pa1, pa2, pa3, PX0, PX1, m_reg, mnX, alX);                  \
        VMW(); __syncthreads();                                                                                               \
        QK_PREFETCH(1 - (KB));                             \
        if ((t) + 2 < NT) KDMA(Kh, KRh, KBASE((t) + 2), KB);                                                                  \
        if ((t) + 1 < NT) VDMA(Vh, KBASE((t) + 1), VB);                                                                       \
        SBAR(); RESC(alX); } while (0)
    for (int t = 1; t + 1 < NT; t += 2) {
        HALF_STEP(pB0, pB1, mnB, alB, pA0, pA1, alA, t, 1, 0);
        HALF_STEP(pA0, pA1, mnA, alA, pB0, pB1, alB, t + 1, 0, 1);
    }
    SBAR(); qkt_fsm<1>(pB0, pB1, ka, kra, qa, fb0, fb1, fq, qr, pA0, pA1, alA, l_reg, pa0, pa1, pa2, pa3); SBAR();
    MASKT(pB0, pB1, NT - 1); SBAR(); pv_tile_sm<0>(o, vb0, pa0, pa1, pa2, pa3, pB0, pB1, m_reg, mnB, alB);
    VMW(); __syncthreads();
    KDMA(nxt.K, nxt.KR, 0, 0); VDMA(nxt.V, 0, 0);
    SBAR(); RESC(alB);
    finishSM(pB0, pB1, alB, l_reg, pa0, pa1, pa2, pa3); SBAR(); pv_tile<1>(o, vb0, pa0, pa1, pa2, pa3);
    SBAR();
    if (hi == 0) li_l[r32] = l_reg; asm volatile("s_waitcnt lgkmcnt(0)" ::: "memory");
    float rli[16];
#pragma unroll
    for (int r = 0; r < 16; ++r) rli[r] = __builtin_amdgcn_rcpf(li_l[crow(r, hi)]);
    u16* Ow = cur.O + (size_t)(wid * QBLK) * LDO;
#pragma unroll
    for (int r = 0; r < 16; ++r) { const int orow = crow(r, hi);
#pragma unroll
        for (int d0 = 0; d0 < 4; ++d0) { const float v = o[d0][r] * rli[r];
            const float vn = xor1f(v);
            if ((r32 & 1) == 0) *(unsigned*)(Ow + (size_t)orow * LDO + d0 * 32 + r32) = cvtpk(v, vn); } }
    VMW(); __syncthreads();
#undef RESC
#undef KBASE
#undef MASKT
#undef HALF_STEP
#undef QK_PREFETCH
}
struct Tensors { const u16* q; const u16* kv; const u16* kr; u16* o; const float* ctab; const float* stab; };
__device__ __forceinline__ BlockRef make_ref(const Tensors& T, int L, int pass) {
    const int bh = (L & 7) + 8 * (L >> 8), x = (L >> 3) & 31, b = bh >> 3, h = bh & 7, qb = pass ? 63 - x : x;
    BlockRef r; const size_t row0 = (size_t)b * SEQ;
    r.Q = T.q + (row0 + (size_t)qb * QB) * LDQ + h * 192; r.K = T.kv + row0 * LDK + h * 256; r.V = r.K + 128; r.KR = T.kr + row0 * LDKR;
    r.O = T.o + (row0 + (size_t)qb * QB) * LDO + h * 128; r.P0 = qb * QB; r.row0 = b * SEQ + qb * QB;
    return r;
}
__device__ __forceinline__ void attn_phase(char* lds, const Tensors& T, int tid0) {
    const int total = 512, stride = gridDim.x;
    int L = blockIdx.x; if (L >= total) return;
    int pass = 0;
    BlockRef cur = make_ref(T, L, 0);
    attn_prime(cur, lds, tid0);
    for (;;) {
        const bool more_pass = pass == 0, more_item = L + stride < total, last = !more_pass && !more_item;
        int passn = pass + 1, Ln = L;
        if (!more_pass) { passn = 0; Ln = more_item ? L + stride : L; }
        const BlockRef nxt = last ? cur : make_ref(T, Ln, passn);
        attn_block(cur, nxt, lds, tid0, T.ctab, T.stab);
        if (last) break;
        cur = nxt; pass = passn; L = Ln;
    }
}
#undef VMW
#undef KDMA
#undef VDMA
#undef ATT_MAPS
#undef SBAR
}
namespace xb {
#define LAS __attribute__((address_space(3)))
#define XB_TMO      128
#define XB_XCNT(j)  (256  + 64 * (j))
#define XB_XSUB(j)  (1280 + 64 * (j))
#define XB_XGEN(j)  (2304 + 64 * (j))
#define XB_TOP      3328
#define XB_TOPGEN   3392
#define XCD_BAR_WORDS 3456
#define XB_SPIN_CAP (1u << 18)

__device__ __forceinline__ unsigned xb_ld(unsigned* p)              { return __hip_atomic_load(p, __ATOMIC_RELAXED, __HIP_MEMORY_SCOPE_AGENT); }
__device__ __forceinline__ unsigned xb_add(unsigned* p, unsigned v) { return __hip_atomic_fetch_add(p, v, __ATOMIC_RELAXED, __HIP_MEMORY_SCOPE_AGENT); }
__device__ __forceinline__ unsigned xb_xcc_id() { return (unsigned)__builtin_amdgcn_s_getreg((3 << 11) | 20) & 0xFu; }
#define XB_SPIN(cond, bar) do { unsigned _sp = 0; while (cond) { __builtin_amdgcn_s_sleep(1); \
    if ((++_sp & 255u) == 0u) { if (xb_ld(&(bar)[XB_TMO])) break; if (_sp > XB_SPIN_CAP) { atomicAdd(&(bar)[XB_TMO], 1u); break; } } } } while (0)

struct XcdBarrier {
    unsigned* bar; unsigned x;
    volatile LAS unsigned* st;
};

__device__ __forceinline__ XcdBarrier xcd_barrier_post(unsigned* bar, volatile LAS unsigned* st) {
    XcdBarrier b; b.bar = bar; b.x = xb_xcc_id(); b.st = st;
    if (threadIdx.x == 0) (void)xb_add(&bar[XB_XCNT(b.x)], 1u);
    return b;
}
__device__ __forceinline__ void xcd_barrier_complete(unsigned* bar, unsigned x, unsigned& nloc, unsigned& nx) {
    const unsigned G = gridDim.x * gridDim.y * gridDim.z;
    unsigned sum, cnt, mine, sp = 0u;
    for (;;) {
        sum = 0u; cnt = 0u; mine = 0u;
#pragma unroll
        for (unsigned j = 0; j < 16; ++j) { const unsigned c = xb_ld(&bar[XB_XCNT(j)]); sum += c; cnt += (c > 0u) ? 1u : 0u; mine = (j == x) ? c : mine; }
        if (sum == G) break;
        __builtin_amdgcn_s_sleep(1);
        if ((++sp & 255u) == 0u) { if (xb_ld(&bar[XB_TMO])) break; if (sp > XB_SPIN_CAP) { atomicAdd(&bar[XB_TMO], 1u); break; } }
    }
    nloc = mine > 0u ? mine : 1u; nx = cnt > 0u ? cnt : 1u;
}

__device__ __forceinline__ void xcd_barrier(const XcdBarrier& b, bool t0  ) {
    asm volatile("s_waitcnt vmcnt(0)" ::: "memory");
    __syncthreads();
    if (t0) {
        unsigned* bar = b.bar;
        __builtin_amdgcn_s_waitcnt(0);
        unsigned nloc = b.st[0], nx = b.st[1];
        if (nloc == 0u) { xcd_barrier_complete(bar, b.x, nloc, nx); b.st[0] = nloc; b.st[1] = nx; }
        const unsigned old = xb_add(&bar[XB_XSUB(b.x)], 1u);
        const unsigned gen = old / nloc;
        if (old + 1u == (gen + 1u) * nloc) {
            __builtin_amdgcn_fence(__ATOMIC_RELEASE, "agent");
            asm volatile("s_waitcnt vmcnt(0)" ::: "memory");
            const unsigned og = xb_add(&bar[XB_TOP], 1u);
            const unsigned tg = og / nx;
            if (og + 1u == (tg + 1u) * nx) xb_add(&bar[XB_TOPGEN], 1u);
            else XB_SPIN(xb_ld(&bar[XB_TOPGEN]) == tg, bar);
            __builtin_amdgcn_fence(__ATOMIC_ACQUIRE, "agent");
            xb_add(&bar[XB_XGEN(b.x)], 1u);
            asm volatile("s_waitcnt vmcnt(0)" ::: "memory");
        } else {
            XB_SPIN(xb_ld(&bar[XB_XGEN(b.x)]) == gen, bar);
            __builtin_amdgcn_fence(__ATOMIC_ACQUIRE, "agent");
            asm volatile("s_waitcnt vmcnt(0)" ::: "memory");
        }
    }
    __syncthreads();
}
#undef LAS
}
#ifndef PROBE_ATT_REPS
#define PROBE_ATT_REPS 1
#endif
#ifndef PROBE_SYNC_REPS
#define PROBE_SYNC_REPS 1
#endif
#ifndef PROBE_THIN_REPS
#define PROBE_THIN_REPS 1
#endif
#ifndef PROBE_PRO_REPS
#define PROBE_PRO_REPS 1
#endif
#ifndef STAGGER_TICKS
#define STAGGER_TICKS 0
#endif
#ifndef PROBE_GEMM_OP
#define PROBE_GEMM_OP -1
#endif
#ifndef PROBE_GEMM_REPS
#define PROBE_GEMM_REPS 1
#endif
namespace mk {
typedef unsigned short u16;
typedef float f32x4 __attribute__((ext_vector_type(4)));
constexpr int M = 32768, D = 1024, SEQ = 16384;
constexpr float EPS = 1e-6f;
constexpr size_t MB = (size_t)1 << 20;
__host__ __device__ constexpr size_t WT_MLA(int j) { return (size_t)j * 6 * MB; }
__host__ __device__ constexpr size_t WT_LRU(int j) { return 12 * MB + (size_t)j * 8 * MB; }
__host__ __device__ constexpr size_t WT_FFN(int l) { return 28 * MB + (size_t)l * 16 * MB; }
constexpr size_t OFF_UQ = 3 * MB / 2, OFF_UKV = 11 * MB / 4, OFF_WO = 15 * MB / 4, OFF_GT = 4 * MB, OFF_LOUT = 5 * MB, OFF_DOWN = 8 * MB;
constexpr size_t WS_COS = 96 * MB, WS_SIN = 100 * MB, WS_SA = 104 * MB, WS_SB = 105 * MB;
constexpr size_t WS_HN = 112 * MB, WS_Y = 176 * MB, WS_U = 240 * MB, WS_END = 496 * MB;
constexpr size_t U_PROJ = 64 * MB, U_CQ = 112 * MB, U_CKV = 136 * MB, U_KR = 152 * MB, U_Q = 160 * MB, U_O = 64 * MB;
constexpr size_t U_GATE = 0, U_XC = 64 * MB, U_REC = 128 * MB, U_LA = 128 * MB, U_B = 192 * MB;
constexpr size_t WS_XSA = 108 * MB, WS_XSB = 109 * MB;
constexpr size_t WS_RS = 108 * MB;
constexpr int SCAN_L = 128, SCAN_NC = SEQ / SCAN_L;

__device__ __forceinline__ unsigned f2bf(float f) { unsigned u = __float_as_uint(f); return (u + 0x7fffu + ((u >> 16) & 1u)) >> 16; }
__device__ __forceinline__ unsigned pk2(float lo, float hi) { return f2bf(lo) | (f2bf(hi) << 16); }
__device__ __forceinline__ float bflo(unsigned w) { return __uint_as_float(w << 16); }
__device__ __forceinline__ float bfhi(unsigned w) { return __uint_as_float(w & 0xffff0000u); }
__device__ __forceinline__ float bf1(u16 h) { return __uint_as_float(((unsigned)h) << 16); }
__device__ __forceinline__ float wave_sum(float v) {
    v += xor1f(v); v += xor2f(v); v += xor4f(v); v += xor8f(v); v += xor16f(v);
    return sum32f(v);
}
__device__ __forceinline__ void transpose_item(const float* W, int ldw, u16* WT, int ldt, int nblk, float* scr, int item, int lane) {
    const int kb = item / nblk, nb = item % nblk, k0 = 64 * kb, n0 = 32 * nb;
#pragma unroll
    for (int i = 0; i < 8; ++i) { const int kk = 8 * i + (lane >> 3); const f32x4 v = *(const f32x4*)(W + (size_t)(k0 + kk) * ldw + n0 + (lane & 7) * 4);
        float* s = scr + kk * 33 + (lane & 7) * 4; s[0] = v.x; s[1] = v.y; s[2] = v.z; s[3] = v.w; }
    asm volatile("s_waitcnt lgkmcnt(0)" ::: "memory");
    const int c = lane & 7;
#pragma unroll
    for (int j = 0; j < 4; ++j) { const int n = (lane >> 3) + 8 * j; const float* s = scr + (8 * c) * 33 + n;
        uint4 o; o.x = pk2(s[0 * 33], s[1 * 33]); o.y = pk2(s[2 * 33], s[3 * 33]); o.z = pk2(s[4 * 33], s[5 * 33]); o.w = pk2(s[6 * 33], s[7 * 33]);
        *(uint4*)(WT + (size_t)(n0 + n) * ldt + k0 + 8 * c) = o; }
    asm volatile("s_waitcnt lgkmcnt(0)" ::: "memory");
}
struct Params { const float* in[23]; float* out; unsigned char* ws; };
enum { I_X = 0, I_POS, I_MIXPRE, I_MIXPOST, I_FFNPRE, I_FFNPOST, I_MLA_WIN, I_MLA_QN, I_MLA_KVN, I_MLA_WUQ, I_MLA_WUKV, I_MLA_WO,
       I_LRU_WIN, I_LRU_CW, I_LRU_CB, I_LRU_WA, I_LRU_BA, I_LRU_WX, I_LRU_BX, I_LRU_LAM, I_LRU_WOUT, I_FFN_UP, I_FFN_DOWN };

__device__ __forceinline__ void prologue_weights(const __attribute__((address_space(4))) Params& p, float* scr, int gw, int NGW, int lane) {
    u16* wt = (u16*)p.ws;
    constexpr int IT_MLA = 352 + 288 + 256 + 512, IT_LRU = 1024 + 128 + 512, IT_FFN = 4096, TOTAL = 2 * IT_MLA + 2 * IT_LRU + 4 * IT_FFN;
    for (int it = gw; it < TOTAL; it += NGW) {
        int r = it; const float* W; int ldw, ldt, nblk; u16* WT;
        if (r < 2 * IT_MLA) { const int j = r / IT_MLA; r -= j * IT_MLA; u16* base = wt + WT_MLA(j) / 2;
            if (r < 352) { W = p.in[I_MLA_WIN] + (size_t)j * 1024 * 704; ldw = 704; nblk = 22; WT = base; ldt = 1024; }
            else if (r < 640) { r -= 352; W = p.in[I_MLA_WUQ] + (size_t)j * 384 * 1536; ldw = 1536; nblk = 48; WT = base + OFF_UQ / 2; ldt = 384; }
            else if (r < 896) { r -= 640; W = p.in[I_MLA_WUKV] + (size_t)j * 256 * 2048; ldw = 2048; nblk = 64; WT = base + OFF_UKV / 2; ldt = 256; }
            else { r -= 896; W = p.in[I_MLA_WO] + (size_t)j * 1024 * 1024; ldw = 1024; nblk = 32; WT = base + OFF_WO / 2; ldt = 1024; }
        } else if (r < 2 * IT_MLA + 2 * IT_LRU) { r -= 2 * IT_MLA; const int j = r / IT_LRU; r -= j * IT_LRU; u16* base = wt + WT_LRU(j) / 2;
            if (r < 1024) { W = p.in[I_LRU_WIN] + (size_t)j * 1024 * 2048; ldw = 2048; nblk = 64; WT = base; ldt = 1024; }
            else if (r < 1152) { r -= 1024; const int which = r >> 3, gt = which >> 3, n = which & 7; r &= 7;
                W = p.in[gt ? I_LRU_WX : I_LRU_WA] + (size_t)j * 8 * 128 * 128 + (size_t)n * 128 * 128; ldw = 128; nblk = 4;
                WT = base + OFF_GT / 2 + (size_t)(n * 256 + gt * 128) * 256 + 128 * (n & 1); ldt = 256; }
            else { r -= 1152; W = p.in[I_LRU_WOUT] + (size_t)j * 1024 * 1024; ldw = 1024; nblk = 32; WT = base + OFF_LOUT / 2; ldt = 1024; }
        } else { r -= 2 * IT_MLA + 2 * IT_LRU; const int l = r / IT_FFN; r -= l * IT_FFN; u16* base = wt + WT_FFN(l) / 2;
            if (r < 2048) { W = p.in[I_FFN_UP] + (size_t)l * 1024 * 4096; ldw = 4096; nblk = 128; WT = base; ldt = 1024; }
            else { r -= 2048; W = p.in[I_FFN_DOWN] + (size_t)l * 4096 * 1024; ldw = 1024; nblk = 32; WT = base + OFF_DOWN / 2; ldt = 4096; }
        }
        transpose_item(W, ldw, WT, ldt, nblk, scr, r, lane);
    }
}
__device__ __forceinline__ void rowop(const u16* y, const float* xin, float* xout, u16* hn, float* rs, const float* gpost, const float* gpre, int gw, int NGW, int lane) {
    f32x4 gp[4], gq[4];
#pragma unroll
    for (int j = 0; j < 4; ++j) { gp[j] = gpost ? *(const f32x4*)(gpost + j * 256 + lane * 4) : (f32x4){0.f, 0.f, 0.f, 0.f}; gq[j] = gpre ? *(const f32x4*)(gpre + j * 256 + lane * 4) : (f32x4){0.f, 0.f, 0.f, 0.f}; }
    for (int row = gw; row < M; row += NGW) {
        f32x4 xv[4];
#pragma unroll
        for (int j = 0; j < 4; ++j) xv[j] = *(const f32x4*)(xin + (size_t)row * D + j * 256 + lane * 4);
        if (y) {
            f32x4 yv[4]; float ss = 0.f;
#pragma unroll
            for (int j = 0; j < 4; ++j) { const uint2 w = *(const uint2*)(y + (size_t)row * D + j * 256 + lane * 4);
                yv[j] = (f32x4){bflo(w.x), bfhi(w.x), bflo(w.y), bfhi(w.y)}; ss += (yv[j].x * yv[j].x + yv[j].y * yv[j].y) + (yv[j].z * yv[j].z + yv[j].w * yv[j].w); }
            const float r = rsqrtf(wave_sum(ss) * (1.f / D) + EPS);
#pragma unroll
            for (int j = 0; j < 4; ++j) xv[j] = xv[j] + (yv[j] * r) * gp[j];
        }
        if (xout) {
#pragma unroll
        for (int j = 0; j < 4; ++j) *(f32x4*)(xout + (size_t)row * D + j * 256 + lane * 4) = xv[j]; }
        if (gpre) {
            float s2 = 0.f;
#pragma unroll
            for (int j = 0; j < 4; ++j) s2 += (xv[j].x * xv[j].x + xv[j].y * xv[j].y) + (xv[j].z * xv[j].z + xv[j].w * xv[j].w);
            const float tot2 = wave_sum(s2); const float r2 = 1.0f;
            if (rs && lane < 4) rs[(size_t)row * 4 + lane] = lane == 0 ? tot2 : 0.f;
#pragma unroll
            for (int j = 0; j < 4; ++j) { const f32x4 h = (xv[j] * r2) * gq[j]; uint2 w; w.x = pk2(h.x, h.y); w.y = pk2(h.z, h.w);
                *(uint2*)(hn + (size_t)row * D + j * 256 + lane * 4) = w; }
        }
    }
}
__device__ __forceinline__ void qkvnorm(const u16* proj, u16* cq, u16* ckv, u16* kr, const float* qn, const float* kvn, const float* ctab, const float* stab, const float* rss, int gw, int NGW, int lane) {
    float gA[8], gB[8];
    { const float* gp = lane < 48 ? qn + 8 * lane : kvn + (8 * lane - 384); const f32x4 g0 = *(const f32x4*)gp, g1 = *(const f32x4*)(gp + 4);
      gA[0] = g0[0]; gA[1] = g0[1]; gA[2] = g0[2]; gA[3] = g0[3]; gA[4] = g1[0]; gA[5] = g1[1]; gA[6] = g1[2]; gA[7] = g1[3]; }
    { f32x4 g0 = {0.f, 0.f, 0.f, 0.f}, g1 = {0.f, 0.f, 0.f, 0.f}; if (lane < 16) { g0 = *(const f32x4*)(kvn + 128 + 8 * lane); g1 = *(const f32x4*)(kvn + 132 + 8 * lane); }
      gB[0] = g0[0]; gB[1] = g0[1]; gB[2] = g0[2]; gB[3] = g0[3]; gB[4] = g1[0]; gB[5] = g1[1]; gB[6] = g1[2]; gB[7] = g1[3]; }
    const bool ropeL = lane >= 16 && lane < 24; const int rk = (lane & 3) * 8;
    const int cOff = lane < 20 ? 672 + rk : 640 + rk;
    for (int row0 = gw; row0 < M; row0 += 2 * NGW) {
        float A[2][8], B[2][8], C[2][8], rsc[2], sa[2], sb[2];
#pragma unroll
        for (int q = 0; q < 2; ++q) { const int row = row0 + q * NGW; const u16* pr = proj + (size_t)row * 768;
            const f32x4 pp = *(const f32x4*)(rss + (size_t)row * 4); rsc[q] = rsqrtf(((pp[0] + pp[1]) + (pp[2] + pp[3])) * (1.f / D) + EPS);
            const uint4 a = *(const uint4*)(pr + 8 * lane); uint4 b = make_uint4(0u, 0u, 0u, 0u), c = make_uint4(0u, 0u, 0u, 0u);
            if (lane < 24) b = *(const uint4*)(pr + 512 + 8 * lane);
            if (ropeL) c = *(const uint4*)(pr + cOff);
            A[q][0] = bflo(a.x); A[q][1] = bfhi(a.x); A[q][2] = bflo(a.y); A[q][3] = bfhi(a.y); A[q][4] = bflo(a.z); A[q][5] = bfhi(a.z); A[q][6] = bflo(a.w); A[q][7] = bfhi(a.w);
            B[q][0] = bflo(b.x); B[q][1] = bfhi(b.x); B[q][2] = bflo(b.y); B[q][3] = bfhi(b.y); B[q][4] = bflo(b.z); B[q][5] = bfhi(b.z); B[q][6] = bflo(b.w); B[q][7] = bfhi(b.w);
            C[q][0] = bflo(c.x); C[q][1] = bfhi(c.x); C[q][2] = bflo(c.y); C[q][3] = bfhi(c.y); C[q][4] = bflo(c.z); C[q][5] = bfhi(c.z); C[q][6] = bflo(c.w); C[q][7] = bfhi(c.w); }
#pragma unroll
        for (int q = 0; q < 2; ++q) { sa[q] = 0.f; sb[q] = 0.f;
#pragma unroll
            for (int e = 0; e < 8; ++e) { A[q][e] *= rsc[q]; B[q][e] *= rsc[q]; C[q][e] *= rsc[q]; sa[q] += A[q][e] * A[q][e]; sb[q] += B[q][e] * B[q][e]; } }
        float r1[2], r2[2];
#pragma unroll
        for (int q = 0; q < 2; ++q) { const float s1 = wave_sum(lane < 48 ? sa[q] : 0.f), s2 = wave_sum((lane >= 48 ? sa[q] : 0.f) + (lane < 16 ? sb[q] : 0.f));
            r1[q] = rsqrtf(s1 * (1.f / 384.f) + EPS); r2[q] = rsqrtf(s2 * (1.f / 256.f) + EPS); }
#pragma unroll
        for (int q = 0; q < 2; ++q) { const int row = row0 + q * NGW;
            { const float r = lane < 48 ? r1[q] : r2[q]; uint4 o; o.x = pk2(A[q][0] * r * gA[0], A[q][1] * r * gA[1]); o.y = pk2(A[q][2] * r * gA[2], A[q][3] * r * gA[3]);
              o.z = pk2(A[q][4] * r * gA[4], A[q][5] * r * gA[5]); o.w = pk2(A[q][6] * r * gA[6], A[q][7] * r * gA[7]);
              if (lane < 48) *(uint4*)(cq + (size_t)row * 384 + 8 * lane) = o; else *(uint4*)(ckv + (size_t)row * 256 + (8 * lane - 384)) = o; }
            if (lane < 16) { const float r = r2[q]; uint4 o; o.x = pk2(B[q][0] * r * gB[0], B[q][1] * r * gB[1]); o.y = pk2(B[q][2] * r * gB[2], B[q][3] * r * gB[3]);
              o.z = pk2(B[q][4] * r * gB[4], B[q][5] * r * gB[5]); o.w = pk2(B[q][6] * r * gB[6], B[q][7] * r * gB[7]);
              *(uint4*)(ckv + (size_t)row * 256 + 128 + 8 * lane) = o; }
            if (ropeL) { const f32x4 c0 = *(const f32x4*)(ctab + (size_t)row * 32 + rk), c1 = *(const f32x4*)(ctab + (size_t)row * 32 + rk + 4), s0 = *(const f32x4*)(stab + (size_t)row * 32 + rk), s1 = *(const f32x4*)(stab + (size_t)row * 32 + rk + 4);
              float ov[8];
#pragma unroll
              for (int e = 0; e < 8; ++e) { const float cc = e < 4 ? c0[e & 3] : c1[e & 3], ss = e < 4 ? s0[e & 3] : s1[e & 3];
                  ov[e] = lane < 20 ? B[q][e] * cc - C[q][e] * ss
                                    : B[q][e] * cc + C[q][e] * ss; }
              uint4 o; o.x = pk2(ov[0], ov[1]); o.y = pk2(ov[2], ov[3]); o.z = pk2(ov[4], ov[5]); o.w = pk2(ov[6], ov[7]);
              *(uint4*)(kr + (size_t)row * 64 + (lane < 20 ? 0 : 32) + rk) = o; }
        }
    }
}
__device__ __forceinline__ void qrope(u16* q, const float* ctab, const float* stab, int gw, int NGW, int lane) {
    for (int row = gw; row < M; row += NGW) {
        u16* qr = q + (size_t)row * 1536; const int i = lane & 31;
        const float c = ctab[(size_t)row * 32 + i], s = stab[(size_t)row * 32 + i];
#pragma unroll
        for (int j = 0; j < 4; ++j) { const int h = 2 * j + (lane >> 5); u16* pp = qr + h * 192 + 128 + i;
            const float x1 = bf1(pp[0]), x2 = bf1(pp[32]);
            pp[0] = (u16)f2bf(x1 * c - x2 * s); pp[32] = (u16)f2bf(x2 * c + x1 * s); }
    }
}
__device__ __forceinline__ void conv_phase(const u16* rec, u16* xc, const float* cw, const float* cb, int gtid, int NGT) {
    for (int idx = gtid; idx < (M / 32) * 128; idx += NGT) {
        const int r0 = (idx >> 7) * 32, c0 = (idx & 127) * 8;
        float w[4][8], bias[8], win[3][8];
#pragma unroll
        for (int e = 0; e < 8; ++e) { bias[e] = cb[c0 + e];
#pragma unroll
            for (int k = 0; k < 4; ++k) w[k][e] = cw[k * D + c0 + e]; }
        const bool first = (r0 & (SEQ - 1)) == 0;
#pragma unroll
        for (int k = 0; k < 3; ++k) { uint4 v = make_uint4(0u, 0u, 0u, 0u); if (!first) v = *(const uint4*)(rec + (size_t)(r0 - 3 + k) * D + c0);
            win[k][0] = bflo(v.x); win[k][1] = bfhi(v.x); win[k][2] = bflo(v.y); win[k][3] = bfhi(v.y); win[k][4] = bflo(v.z); win[k][5] = bfhi(v.z); win[k][6] = bflo(v.w); win[k][7] = bfhi(v.w); }
        for (int i0 = 0; i0 < 32; i0 += 8) {
            uint4 in[8];
#pragma unroll
            for (int u = 0; u < 8; ++u) in[u] = *(const uint4*)(rec + (size_t)(r0 + i0 + u) * D + c0);
#pragma unroll
            for (int u = 0; u < 8; ++u) {
                const float x[8] = {bflo(in[u].x), bfhi(in[u].x), bflo(in[u].y), bfhi(in[u].y), bflo(in[u].z), bfhi(in[u].z), bflo(in[u].w), bfhi(in[u].w)};
                float acc[8];
#pragma unroll
                for (int e = 0; e < 8; ++e) { acc[e] = bias[e] + win[0][e] * w[0][e] + win[1][e] * w[1][e] + win[2][e] * w[2][e] + x[e] * w[3][e]; win[0][e] = win[1][e]; win[1][e] = win[2][e]; win[2][e] = x[e]; }
                uint4 o; o.x = pk2(acc[0], acc[1]); o.y = pk2(acc[2], acc[3]); o.z = pk2(acc[4], acc[5]); o.w = pk2(acc[6], acc[7]);
                *(uint4*)(xc + (size_t)(r0 + i0 + u) * D + c0) = o;
            }
        }
    }
}
__device__ __forceinline__ void scanA(const u16* A, const u16* B, float* SA, float* SB, int tid) {
    for (int item = blockIdx.x; item < 2 * SCAN_NC; item += gridDim.x) {
        const int c = item % SCAN_NC, b = item / SCAN_NC, ch = 2 * tid;
        const size_t base = ((size_t)b * SEQ + (size_t)c * SCAN_L) * D + ch;
        float h0 = 0.f, h1 = 0.f, P0 = 1.f, P1 = 1.f;
        for (int t0 = 0; t0 < SCAN_L; t0 += 32) {
            unsigned aw[32], bw[32];
#pragma unroll
            for (int u = 0; u < 32; ++u) { aw[u] = *(const unsigned*)(A + base + (size_t)(t0 + u) * D); bw[u] = *(const unsigned*)(B + base + (size_t)(t0 + u) * D); }
#pragma unroll
            for (int u = 0; u < 32; ++u) { const float a0 = __expf(bflo(aw[u])), a1 = __expf(bfhi(aw[u])); h0 = a0 * h0 + bflo(bw[u]); h1 = a1 * h1 + bfhi(bw[u]); P0 *= a0; P1 *= a1; }
        }
        const size_t so = ((size_t)b * SCAN_NC + c) * D + ch;
        *(float2*)(SA + so) = make_float2(P0, P1); *(float2*)(SB + so) = make_float2(h0, h1);
    }
}
__device__ __forceinline__ void scanC(const u16* A, const u16* B, const float* SA, const float* SB, const u16* gate, u16* hg, int tid) {
    for (int item = blockIdx.x; item < 2 * SCAN_NC; item += gridDim.x) {
        const int c = item % SCAN_NC, b = item / SCAN_NC, ch = 2 * tid;
        const size_t base = ((size_t)b * SEQ + (size_t)c * SCAN_L) * D + ch;
        float h0 = 0.f, h1 = 0.f;
        for (int cc0 = 0; cc0 < c; cc0 += 16) {
            float2 pa[16], pb[16];
#pragma unroll
            for (int u = 0; u < 16; ++u) { const int cc = cc0 + u < c ? cc0 + u : c - 1; const size_t so = ((size_t)b * SCAN_NC + cc) * D + ch; pa[u] = *(const float2*)(SA + so); pb[u] = *(const float2*)(SB + so); }
#pragma unroll
            for (int u = 0; u < 16; ++u) { const bool in = cc0 + u < c; const float ax = in ? pa[u].x : 1.f, ay = in ? pa[u].y : 1.f, bx = in ? pb[u].x : 0.f, by = in ? pb[u].y : 0.f; h0 = ax * h0 + bx; h1 = ay * h1 + by; }
        }
        for (int t0 = 0; t0 < SCAN_L; t0 += 16) {
            unsigned aw[16], bw[16], gv[16];
#pragma unroll
            for (int u = 0; u < 16; ++u) { aw[u] = *(const unsigned*)(A + base + (size_t)(t0 + u) * D); bw[u] = *(const unsigned*)(B + base + (size_t)(t0 + u) * D); gv[u] = *(const unsigned*)(gate + base + (size_t)(t0 + u) * D); }
#pragma unroll
            for (int u = 0; u < 16; ++u) { h0 = __expf(bflo(aw[u])) * h0 + bflo(bw[u]); h1 = __expf(bfhi(aw[u])) * h1 + bfhi(bw[u]);
                *(unsigned*)(hg + base + (size_t)(t0 + u) * D) = pk2(bflo(gv[u]) * h0, bfhi(gv[u]) * h1); }
        }
    }
}

constexpr int LDS_GEMM = pg8::STAGE_BYTES + 8192, LDS_MAIN = att::LDS_BYTES > LDS_GEMM ? att::LDS_BYTES : LDS_GEMM, LDS_BYTES = LDS_MAIN + 16;
constexpr size_t WS_BAR = 106 * MB;
constexpr size_t WS_CNT1 = WS_BAR + 16384, WS_CNT2 = WS_BAR + 49152, CTL_BYTES = 81920, WS_XS1 = 107 * MB, WS_XS2 = 107 * MB + MB / 2;
constexpr int XL_OFF = 131072;
static_assert(XL_OFF + 8192 <= LDS_MAIN && XCD_BAR_WORDS * 4 <= 16384 && att::LDS_BYTES <= LDS_MAIN && pg8::STAGE_BYTES <= LDS_MAIN && LDS_BYTES <= 160 * 1024, "LDS map");

__global__ void __launch_bounds__(512, 2) fwd_mega(Params p_arg) {
    extern __shared__ __attribute__((aligned(16))) unsigned char lds[];
    cg::grid_group grid = cg::this_grid();
    (void)p_arg;
    volatile __attribute__((address_space(3))) unsigned* bst = (volatile __attribute__((address_space(3))) unsigned*)((__attribute__((address_space(3))) unsigned char*)lds + LDS_MAIN);
    if (threadIdx.x < 4) bst[threadIdx.x] = 0u;
    __syncthreads();
    const int wave_s = __builtin_amdgcn_readfirstlane(threadIdx.x >> 6);
    const unsigned bar_x = xb::xb_xcc_id();
    (void)xb::xcd_barrier_post((unsigned*)(p_arg.ws + WS_BAR), bst);
#define GRID_BAR() do { unsigned bx_ = bar_x; asm volatile("" : "+s"(bx_)); xb::XcdBarrier bb_; bb_.bar = (unsigned*)(ws + WS_BAR); bb_.x = bx_; bb_.st = bst; xb::xcd_barrier(bb_, tid == 0); } while (0)
    typedef const __attribute__((address_space(4))) Params* KParams;
    KParams pp = (KParams)__builtin_amdgcn_kernarg_segment_ptr();
#define FRESH() int tid_ = wave_s * 64 + lane_id_fresh(); asm volatile("" : "+v"(tid_)); asm volatile("" : "+s"(pp)); const __attribute__((address_space(4))) Params& p = *pp; \
    const int tid = tid_, lane = tid & 63, wave = __builtin_amdgcn_readfirstlane(tid >> 6); \
    const int G = gridDim.x, gw = blockIdx.x * 8 + wave, NGW = G * 8, gtid = blockIdx.x * 512 + tid, NGT = G * 512; \
    unsigned char* ws = p.ws; float* x = p.out; u16* hn = (u16*)(ws + WS_HN); u16* ybuf = (u16*)(ws + WS_Y); unsigned char* U = ws + WS_U; \
    float* ctab = (float*)(ws + WS_COS); float* stab = (float*)(ws + WS_SIN); float* SA = (float*)(ws + WS_SA); float* SB = (float*)(ws + WS_SB); \
    (void)lane; (void)wave; (void)gw; (void)NGW; (void)gtid; (void)NGT; (void)x; (void)hn; (void)ybuf; (void)U; (void)ctab; (void)stab; (void)SA; (void)SB;
    {
    FRESH();

    for (int prep = 0; prep < PROBE_PRO_REPS; ++prep) {
    prologue_weights(p, (float*)lds + wave * (64 * 33), gw, NGW, lane);
    for (int i = gtid; i < 2 * 2048 * 16; i += NGT) { const int j = i >> 15, row = (i >> 4) & 2047, chn = i & 15, n = row >> 8;
        *(uint4*)((u16*)(ws + WT_LRU(j) + OFF_GT) + (size_t)row * 256 + 128 * ((n & 1) ^ 1) + chn * 8) = make_uint4(0u, 0u, 0u, 0u); }
    { const int* pos = (const int*)p.in[I_POS];
      for (int i = gtid; i < M * 32; i += NGT) { const int row = i >> 5, f = i & 31;
        const float inv = __builtin_amdgcn_exp2f(-(float)f * (13.287712379549449f / 32.f));
        const float ang = (float)pos[row] * inv;
        double rev = (double)ang * 0.15915494309189535; rev -= __builtin_rint(rev);
        ctab[i] = __builtin_amdgcn_cosf((float)rev); stab[i] = __builtin_amdgcn_sinf((float)rev); } }
    rowop(nullptr, p.in[I_X], nullptr, hn, (float*)(ws + WS_XSB), nullptr, p.in[I_MIXPRE], gw, NGW, lane);
    }
    if (ws == nullptr) grid.sync();
    GRID_BAR();
    }

#pragma nounroll
    for (int layer = 0; layer < 4; ++layer) {
#pragma nounroll
        for (int op = 0; op < 10; ++op) {
            FRESH();
            const int j = layer >> 1; const bool lru = (layer & 1) != 0;
            const u16* wtm = (const u16*)(ws + WT_MLA(j)); const u16* wtl = (const u16*)(ws + WT_LRU(j)); const u16* wtf = (const u16*)(ws + WT_FFN(layer));
            int gk = 0;
            pg8::Gemm g{}; pg8::EpiB E{};
            if (op == 6 || op == 9) continue;
            const float* gprev = p.in[op == 5 ? I_MIXPRE : I_FFNPRE] + layer * D;
            const float* gpost = p.in[op == 5 ? I_MIXPOST : I_FFNPOST] + layer * D;
            const float* gpre = op == 5 ? p.in[I_FFNPRE] + layer * D : (layer < 3 ? p.in[I_MIXPRE] + (layer + 1) * D : nullptr);
            if (op == 7) { gk = 1; g = pg8::Gemm{hn, wtf, M, 4096, 1024, 1024, 1024, 0}; E = pg8::EpiB{(u16*)U, 4096, 0, 0, 1, nullptr}; }
            else if (op == 8) { gk = 3; g = pg8::Gemm{(const u16*)U, wtf + OFF_DOWN / 2, M, 1024, 4096, 4096, 4096, 0}; }
            else if (!lru) {
                u16* proj = (u16*)(U + U_PROJ); u16* cq = (u16*)(U + U_CQ); u16* ckv = (u16*)(U + U_CKV); u16* kr = (u16*)(U + U_KR); u16* q = (u16*)(U + U_Q); u16* o = (u16*)(U + U_O); u16* kv = ybuf;
                if (op == 0) { gk = 1; g = pg8::Gemm{hn, wtm, M, 768, 1024, 1024, 1024, 0}; E = pg8::EpiB{proj, 768, 0, 0, 0, nullptr}; }
                else if (op == 1) for (int rep = 0; rep < PROBE_THIN_REPS; ++rep) qkvnorm(proj, cq, ckv, kr, p.in[I_MLA_QN] + j * 384, p.in[I_MLA_KVN] + j * 256, ctab, stab, (const float*)(ws + WS_XSB), gw, NGW, lane);
                else if (op == 2) { gk = 1; g = pg8::Gemm{cq, wtm + OFF_UQ / 2, M, 1536, 384, 384, 384, 0}; E = pg8::EpiB{q, 1536, 0, 0, 0, nullptr}; }
                else if (op == 3) { gk = 1; g = pg8::Gemm{ckv, wtm + OFF_UKV / 2, M, 2048, 256, 256, 256, 0}; E = pg8::EpiB{kv, 2048, 0, 0, 0, nullptr}; }
                else if (op == 4) { const att::Tensors T{q, kv, kr, o, ctab, stab}; for (int rep = 0; rep < PROBE_ATT_REPS; ++rep) att::attn_phase((char*)lds, T, tid); }
                else { gk = 3; g = pg8::Gemm{o, wtm + OFF_WO / 2, M, 1024, 1024, 1024, 1024, 0}; }
            } else {
                u16* gate = (u16*)(U + U_GATE); u16* xc = (u16*)(U + U_XC); u16* rec = (u16*)(U + U_REC); u16* Bb = (u16*)(U + U_B); u16* Ab = (u16*)(U + U_LA); u16* hg = xc;
                if (op == 0) { gk = 1; g = pg8::Gemm{hn, wtl, M, 2048, 1024, 1024, 1024, 0}; E = pg8::EpiB{gate, 1024, 1024, (size_t)(U_REC - U_GATE) / 2, 2, (const float*)(ws + WS_XSB)}; }
                else if (op == 1) for (int rep = 0; rep < PROBE_THIN_REPS; ++rep) conv_phase(rec, xc, p.in[I_LRU_CW] + j * 4 * D, p.in[I_LRU_CB] + j * D, gtid, NGT);
                else if (op == 2) { gk = 2; g = pg8::Gemm{xc, wtl + OFF_GT / 2, M, 2048, 256, 1024, 256, 512}; }
                else if (op == 3) for (int rep = 0; rep < PROBE_THIN_REPS; ++rep) scanA(Ab, Bb, SA, SB, tid);
                else if (op == 4) for (int rep = 0; rep < PROBE_THIN_REPS; ++rep) scanC(Ab, Bb, SA, SB, gate, hg, tid);
                else { gk = 3; g = pg8::Gemm{hg, wtl + OFF_LOUT / 2, M, 1024, 1024, 1024, 1024, 0}; }
            }
            if (STAGGER_TICKS > 0 && op == 7) {
                unsigned bx_ = bar_x; asm volatile("" : "+s"(bx_));
                const unsigned long long t0_ = __builtin_amdgcn_s_memrealtime(), want_ = (unsigned long long)(bx_ & 7u) * STAGGER_TICKS;
                while (__builtin_amdgcn_s_memrealtime() - t0_ < want_) __builtin_amdgcn_s_sleep(8); }
            for (int rep = 0; rep < ((gk != 3 && (PROBE_GEMM_OP == -1 || op == PROBE_GEMM_OP || (PROBE_GEMM_OP == -2 && op != 7))) ? PROBE_GEMM_REPS : 1); ++rep)
            if (gk == 1) { pg8::StaticOrder S; S.init(g.M, g.N, G, (int)blockIdx.x);
                pg8::gemm_phase<pg8::EpiB, pg8::StaticOrder, true>((PG8_LAS unsigned char*)lds, g, S, E, tid); }
            else if (gk == 2) { pg8::StaticOrder S; S.init(g.M, g.N, G, (int)blockIdx.x);
                const pg8::EpiGate EG{(const u16*)(U + U_XC), (u16*)(U + U_LA), (u16*)(U + U_B), p.in[I_LRU_BA] + j * D, p.in[I_LRU_BX] + j * D, p.in[I_LRU_LAM] + j * D};
                pg8::gemm_phase<pg8::EpiGate, pg8::StaticOrder, true>((PG8_LAS unsigned char*)lds, g, S, EG, tid); }
            else if (gk == 3) { pg8::StaticOrder S; S.init(g.M, g.N, G, (int)blockIdx.x);
                const unsigned target = 32u * (unsigned)(layer * 2 + (op == 8 ? 2 : 1));
                const pg8::RowStats st1{(float*)(ws + WS_XS1), (unsigned*)(ws + WS_CNT1), target};
                const pg8::EpiNormRes EN{hn, (float*)(ws + (op == 8 ? WS_XSB : WS_XSA)), x, gprev, gpost, gpre, st1, (PG8_LAS unsigned char*)lds + XL_OFF, op == 8 ? (const float*)(ws + WS_XSA) : nullptr};
                pg8::gemm_phase<pg8::EpiNormRes, pg8::StaticOrder, true>((PG8_LAS unsigned char*)lds, g, S, EN, tid); }
            if (!(layer == 3 && op == 8) && !(!lru && op == 2)) { for (int rep = 0; rep < PROBE_SYNC_REPS; ++rep) GRID_BAR(); }
        }
    }
}
}

extern "C" void kernel_launch(void* const* d_in, const int* in_sizes, int n_in, void* d_out, int out_size, void* d_ws, size_t ws_size, hipStream_t stream) {
    static int grid = 0;
    if (grid == 0) {
        if (n_in != 23 || in_sizes[0] != mk::M * mk::D || out_size != mk::M * mk::D || ws_size < mk::WS_END) {
            fprintf(stderr, "kernel_launch: unexpected shapes (n_in %d, in0 %d, out %d, ws %zu); nothing launched\n", n_in, n_in > 0 ? in_sizes[0] : -1, out_size, ws_size); grid = -1; return; }
        int dev = 0, cus = 0, per_cu = 0;
        (void)hipGetDevice(&dev); (void)hipDeviceGetAttribute(&cus, hipDeviceAttributeMultiprocessorCount, dev);
        if (hipFuncSetAttribute((const void*)mk::fwd_mega, hipFuncAttributeMaxDynamicSharedMemorySize, mk::LDS_BYTES) != hipSuccess) { fprintf(stderr, "kernel_launch: hipFuncSetAttribute failed\n"); grid = -1; return; }
        if (hipOccupancyMaxActiveBlocksPerMultiprocessor(&per_cu, (const void*)mk::fwd_mega, 512, mk::LDS_BYTES) != hipSuccess || per_cu < 1) { fprintf(stderr, "kernel_launch: occupancy query says %d blocks per CU\n", per_cu); per_cu = 1; }
        (void)hipGetLastError();
        grid = cus > 0 ? cus : 256;
    }
    if (grid < 0) return;
    mk::Params p{};
    for (int i = 0; i < 23; ++i) p.in[i] = (const float*)d_in[i];
    p.out = (float*)d_out; p.ws = (unsigned char*)d_ws;
    if (hipMemsetAsync((char*)d_ws + mk::WS_BAR, 0, mk::CTL_BYTES, stream) != hipSuccess) { fprintf(stderr, "kernel_launch: hipMemsetAsync failed\n"); return; }
    void* args[] = {&p};
    hipError_t e = hipLaunchCooperativeKernel((const void*)mk::fwd_mega, dim3(grid), dim3(512), args, mk::LDS_BYTES, stream);
    if (e != hipSuccess) fprintf(stderr, "kernel_launch: cooperative launch failed: %s (grid %d)\n", hipGetErrorString(e), grid);
}
```

```cpp
#include <hip/hip_runtime.h>
#include <hip/hip_bf16.h>
#include <hip/hip_cooperative_groups.h>
#include <cstdio>
#include <cstdint>
namespace cg = cooperative_groups;

__device__ __forceinline__ float xor1f(float v)  { return __int_as_float(__builtin_amdgcn_mov_dpp(__float_as_int(v), 0xB1, 0xF, 0xF, false)); }
__device__ __forceinline__ float xor2f(float v)  { return __int_as_float(__builtin_amdgcn_mov_dpp(__float_as_int(v), 0x4E, 0xF, 0xF, false)); }
__device__ __forceinline__ float xor4f(float v)  { return __int_as_float(__builtin_amdgcn_ds_swizzle(__float_as_int(v), 0x101F)); }
__device__ __forceinline__ float xor8f(float v)  { return __int_as_float(__builtin_amdgcn_ds_swizzle(__float_as_int(v), 0x201F)); }
__device__ __forceinline__ float xor16f(float v) { return __int_as_float(__builtin_amdgcn_ds_swizzle(__float_as_int(v), 0x401F)); }
__device__ __forceinline__ float sum32f(float v) { auto rr = __builtin_amdgcn_permlane32_swap(__float_as_uint(v), __float_as_uint(v), false, false); return __uint_as_float(rr[0]) + __uint_as_float(rr[1]); }
__device__ __forceinline__ int lane_id_fresh() { int l; asm volatile("v_mbcnt_lo_u32_b32 %0, -1, 0\n\tv_mbcnt_hi_u32_b32 %0, -1, %0" : "=v"(l)); return l; }
namespace pg8 {
#define PG8_LAS __attribute__((address_space(3)))
typedef unsigned short bf16_t;
typedef short bf16x8 __attribute__((ext_vector_type(8)));
typedef float f32x4 __attribute__((ext_vector_type(4)));
typedef unsigned u32x4 __attribute__((ext_vector_type(4)));
constexpr int BM = 256, BK = 64, HALF = 128, HTB = HALF * BK * 2  , STAGE_BYTES = 8 * HTB, NXCD = 8, WGM = 8;

__host__ __device__ __forceinline__ int lds_byte(int r, int c) { const int st = (r >> 4) * 2 + (c >> 5), rr = r & 15, cc = c & 31, ob = rr * 64 + cc * 2; return st * 1024 + (ob ^ (((ob >> 9) & 1) << 5)); }
__host__ __device__ __forceinline__ void stage_rc(int b, int& R, int& C) { const int st = b / 1024, sb = b % 1024, swz = sb ^ (((sb >> 9) & 1) << 5); R = (st >> 1) * 16 + swz / 64; C = (st & 1) * 32 + (swz % 64) / 2; }
__host__ __device__ __forceinline__ int perm32(int rho) { const int n = rho >> 4, i = rho & 15; return 8 * (i >> 2) + 4 * n + (i & 3); }

struct Unit { int pm, pn; };
struct Gemm { const bf16_t* A; const bf16_t* Bt; int M, N, K; int lda, ldb; int apn; };

struct StaticOrder {
    int nM, nN, nwg, G, c;
    __host__ __device__ void init(int M, int N, int G_, int c_) { nM = M / BM; nN = N / BM; nwg = nM * nN; G = G_; c = c_; }
    __host__ __device__ bool next(int i, Unit& u) const {
        const long L = (long)i * G + c; if (L >= nwg) return false;
        int wgid = (int)L; { const int q = nwg / NXCD, r = nwg % NXCD, xcd = wgid % NXCD, off = wgid / NXCD; wgid = (xcd < r ? xcd * (q + 1) : r * (q + 1) + (xcd - r) * q) + off; }
        const int nig = WGM * nN, gid = wgid / nig, fm = gid * WGM, gsz = (nM - fm) < WGM ? (nM - fm) : WGM;
        u.pm = fm + ((wgid % nig) % gsz); u.pn = (wgid % nig) / gsz; return true;
    }
    __device__ __forceinline__ void a_ready(const Unit&) const {}
    __device__ __forceinline__ void done(const Unit&) const {}
};

__device__ __forceinline__ unsigned cvt_pk_bf16(float lo, float hi) { unsigned r; asm volatile("v_cvt_pk_bf16_f32 %0, %1, %2" : "=v"(r) : "v"(lo), "v"(hi)); return r; }
__device__ __forceinline__ float gelu_tanh(float x) {
    const float z = 0.7978845608028654f * (x + 0.044715f * x * x * x);
    const float e = __expf(2.0f * z);
    const float th = 1.0f - 2.0f * __builtin_amdgcn_rcpf(1.0f + e);
    return 0.5f * x * (1.0f + th);
}
struct EpiB {
    static constexpr bool PERM = true, AFTER_DRAIN = false, FUSED = false;
    bf16_t* O; int ldc; int split_cols; size_t split_stride; int mode;
    const float* rss;
    __device__ __forceinline__ void operator()(const f32x4 (&acc)[2][2][4][2], const Unit& u, int wr, int wc, int fr, int fq) const {
        const int row0 = u.pm * BM + wr * 64 + fr; int colt = u.pn * BM; bf16_t* base = O; int t = 0;
        if (split_cols) { t = colt / split_cols; base += (size_t)t * split_stride; colt -= t * split_cols; }
        const int act = (mode == 1) ? 1 : ((mode == 2 && t == 0) ? 2 : 0);
        const int col0 = colt + wc * 32 + 8 * fq;
#pragma unroll
        for (int ai = 0; ai < 2; ++ai)
#pragma unroll
            for (int m = 0; m < 4; ++m) { bf16_t* rowp = base + (size_t)(row0 + ai * HALF + m * 16) * ldc + col0;
                float rsc = 1.0f; if (rss) { const f32x4 pp = *(const f32x4*)(rss + (size_t)(row0 + ai * HALF + m * 16) * 4); rsc = rsqrtf(((pp[0] + pp[1]) + (pp[2] + pp[3])) * (1.0f / 1024.0f) + 1e-6f); }
#pragma unroll
                for (int bj = 0; bj < 2; ++bj) { f32x4 v0 = acc[ai][bj][m][0] * rsc, v1 = acc[ai][bj][m][1] * rsc;
                    if (act == 1) {
#pragma unroll
                        for (int e = 0; e < 4; ++e) { const float a = fmaxf(v0[e], 0.f), b = fmaxf(v1[e], 0.f); v0[e] = a * a; v1[e] = b * b; } }
                    else if (act == 2) {
#pragma unroll
                        for (int e = 0; e < 4; ++e) { v0[e] = gelu_tanh(v0[e]); v1[e] = gelu_tanh(v1[e]); } }
                    u32x4 w; w.x = cvt_pk_bf16(v0[0], v0[1]); w.y = cvt_pk_bf16(v0[2], v0[3]); w.z = cvt_pk_bf16(v1[0], v1[1]); w.w = cvt_pk_bf16(v1[2], v1[3]);
                    *(u32x4*)(rowp + bj * HALF) = w; } }
    }
};
__device__ __forceinline__ float bf2f(unsigned short h) { return __uint_as_float(((unsigned)h) << 16); }
__device__ __forceinline__ float sigmoidf_(float x) { return __builtin_amdgcn_rcpf(1.0f + __expf(-x)); }
__device__ __forceinline__ float one_minus_exp(float t) { const float ser = -t * (1.0f + t * (0.5f + t * (0.16666667f + t * (0.041666668f + t * 0.008333334f)))); return t > -0.25f ? ser : 1.0f - __expf(t); }
struct EpiGate {
    static constexpr bool PERM = false, AFTER_DRAIN = false, FUSED = false;
    const bf16_t* xc; bf16_t* Aout; bf16_t* Bout; const float* b_a; const float* b_x; const float* lam;
    __device__ __forceinline__ void operator()(const f32x4 (&acc)[2][2][4][2], const Unit& u, int wr, int wc, int fr, int fq) const {
#pragma unroll
        for (int n = 0; n < 2; ++n) {
            const int ch0 = 128 * u.pn + 32 * wc + 16 * n + 4 * fq;
            const f32x4 ba = *(const f32x4*)(b_a + ch0), bx = *(const f32x4*)(b_x + ch0), lm = *(const f32x4*)(lam + ch0);
            f32x4 sp;
#pragma unroll
            for (int e = 0; e < 4; ++e) sp[e] = -8.0f * log1pf(__expf(-lm[e]));
#pragma unroll
            for (int ai = 0; ai < 2; ++ai)
#pragma unroll
                for (int m = 0; m < 4; ++m) {
                    const size_t off = (size_t)(u.pm * BM + ai * HALF + wr * 64 + m * 16 + fr) * 1024 + ch0;
                    const uint2 xr = *(const uint2*)(xc + off);
                    float xv[4] = { __uint_as_float(xr.x << 16), __uint_as_float(xr.x & 0xffff0000u), __uint_as_float(xr.y << 16), __uint_as_float(xr.y & 0xffff0000u) };
                    f32x4 av, bv;
#pragma unroll
                    for (int e = 0; e < 4; ++e) {
                        const float r = sigmoidf_(acc[ai][0][m][n][e] + ba[e]);
                        const float ig = sigmoidf_(acc[ai][1][m][n][e] + bx[e]);
                        const float la = sp[e] * r;
                        av[e] = la;
                        bv[e] = __builtin_amdgcn_sqrtf(fmaxf(one_minus_exp(2.0f * la), 0.f)) * (ig * xv[e]);
                    }
                    uint2 wa, wb; wa.x = cvt_pk_bf16(av[0], av[1]); wa.y = cvt_pk_bf16(av[2], av[3]); wb.x = cvt_pk_bf16(bv[0], bv[1]); wb.y = cvt_pk_bf16(bv[2], bv[3]);
                    *(uint2*)(Aout + off) = wa; *(uint2*)(Bout + off) = wb;
                }
        }
    }
};

struct RowStats {
    float* xbuf;
    unsigned* cnt;
    unsigned target;
    __device__ __forceinline__ void run(const f32x4 (&v)[2][2][4][2], const Unit& u, int wr, int wc, int fr, int fq, PG8_LAS unsigned char* xl, int wid, int lane) const {
        PG8_LAS float* P = (PG8_LAS float*)xl;
        PG8_LAS float* S = (PG8_LAS float*)(xl + 4096);
#pragma unroll
        for (int ai = 0; ai < 2; ++ai)
#pragma unroll
            for (int m = 0; m < 4; ++m) {
                float s = 0.f;
#pragma unroll
                for (int bj = 0; bj < 2; ++bj)
#pragma unroll
                    for (int n = 0; n < 2; ++n) { const f32x4 x = v[ai][bj][m][n]; s += (x[0] * x[0] + x[1] * x[1]) + (x[2] * x[2] + x[3] * x[3]); }
                s += xor16f(s); s = sum32f(s);
                if (fq == 0) P[(ai * HALF + wr * 64 + m * 16 + fr) * 4 + wc] = s;
            }
        asm volatile("s_waitcnt lgkmcnt(0)" ::: "memory"); __builtin_amdgcn_s_barrier(); asm volatile("" ::: "memory");
        const int row = wid * 32 + (lane & 31);
        if (lane < 32) { const float t = (P[row * 4 + 0] + P[row * 4 + 1]) + (P[row * 4 + 2] + P[row * 4 + 3]);
            __hip_atomic_store(xbuf + (size_t)(u.pm * BM + row) * 4 + u.pn, t, __ATOMIC_RELAXED, __HIP_MEMORY_SCOPE_AGENT); }
        asm volatile("s_waitcnt vmcnt(0)" ::: "memory");
        if (lane == 0) __hip_atomic_fetch_add(cnt + 64 * u.pm, 1u, __ATOMIC_RELAXED, __HIP_MEMORY_SCOPE_AGENT);
        if (wid == 0) { unsigned sp = 0;
            while ((unsigned)__builtin_amdgcn_readfirstlane(__hip_atomic_load(cnt + 64 * u.pm, __ATOMIC_RELAXED, __HIP_MEMORY_SCOPE_AGENT)) < target) { __builtin_amdgcn_s_sleep(2); if (++sp > (1u << 18)) break; }
            __builtin_amdgcn_fence(__ATOMIC_ACQUIRE, "agent"); }
        asm volatile("s_waitcnt vmcnt(0) lgkmcnt(0)" ::: "memory"); __builtin_amdgcn_s_barrier(); asm volatile("" ::: "memory");
        if (lane < 32) { float* slot = xbuf + (size_t)(u.pm * BM + row) * 4; float t = 0.f;
#pragma unroll
            for (int k = 0; k < 4; ++k) t += __hip_atomic_load(slot + k, __ATOMIC_RELAXED, __HIP_MEMORY_SCOPE_AGENT);
            S[row] = t; }
        asm volatile("s_waitcnt lgkmcnt(0)" ::: "memory"); __builtin_amdgcn_s_barrier(); asm volatile("" ::: "memory");
    }
};
struct EpiNormRes {
    static constexpr bool PERM = false, AFTER_DRAIN = false, FUSED = true;
    bf16_t* hn; float* xs2; float* out; const float* gprev; const float* gpost; const float* gpre; RowStats st1; PG8_LAS unsigned char* xl;
    const float* s_in;
    __device__ __forceinline__ void fused(f32x4 (&acc)[2][2][4][2], const Unit& u, int wr, int wc, int fr, int fq, int wid, int lane) const {
        typedef unsigned u32x2v __attribute__((ext_vector_type(2)));
        PG8_LAS float* P = (PG8_LAS float*)xl;
        const PG8_LAS float* S = (const PG8_LAS float*)(xl + 4096);
        const int col0 = u.pn * BM + wc * 32 + 4 * fq;
        st1.run(acc, u, wr, wc, fr, fq, xl, wid, lane);
#pragma unroll
        for (int ai = 0; ai < 2; ++ai)
#pragma unroll
            for (int m = 0; m < 4; ++m) { const int r = ai * HALF + wr * 64 + m * 16 + fr; float rstd = rsqrtf(S[r] * (1.0f / 1024.0f) + 1e-6f); const size_t off = (size_t)(u.pm * BM + r) * 1024 + col0;
                if (s_in) { const f32x4 pp = *(const f32x4*)(s_in + (size_t)(u.pm * BM + r) * 4); const float s2 = __builtin_amdgcn_rcpf(((pp[0] + pp[1]) + (pp[2] + pp[3])) * (1.0f / 1024.0f) + 1e-6f);
                    rstd = rsqrtf(S[r] * (1.0f / 1024.0f) * s2 * s2 + 1e-6f) * s2; }
#pragma unroll
                for (int bj = 0; bj < 2; ++bj)
#pragma unroll
                    for (int n = 0; n < 2; ++n) { const u32x2v hw = *(const u32x2v*)(hn + off + bj * HALF + n * 16);
                        const f32x4 gp = *(const f32x4*)(gprev + col0 + bj * HALF + n * 16); const f32x4 gv = *(const f32x4*)(gpost + col0 + bj * HALF + n * 16);
                        f32x4 xs; xs[0] = __uint_as_float(hw.x << 16) * __builtin_amdgcn_rcpf(gp[0]); xs[1] = __uint_as_float(hw.x & 0xffff0000u) * __builtin_amdgcn_rcpf(gp[1]);
                        xs[2] = __uint_as_float(hw.y << 16) * __builtin_amdgcn_rcpf(gp[2]); xs[3] = __uint_as_float(hw.y & 0xffff0000u) * __builtin_amdgcn_rcpf(gp[3]);
                        acc[ai][bj][m][n] = xs + (acc[ai][bj][m][n] * rstd) * gv; }
                asm volatile("" : "+v"(acc[ai][0][m][0]), "+v"(acc[ai][0][m][1]), "+v"(acc[ai][1][m][0]), "+v"(acc[ai][1][m][1]));
                if (m & 1) asm volatile("" ::: "memory"); }
        if (gpre) {
#pragma unroll
            for (int ai = 0; ai < 2; ++ai)
#pragma unroll
                for (int m = 0; m < 4; ++m) {
                    float s = 0.f;
#pragma unroll
                    for (int bj = 0; bj < 2; ++bj)
#pragma unroll
                        for (int n = 0; n < 2; ++n) { const f32x4 x = acc[ai][bj][m][n]; s += (x[0] * x[0] + x[1] * x[1]) + (x[2] * x[2] + x[3] * x[3]); }
                    s += xor16f(s); s = sum32f(s);
                    if (fq == 0) P[(ai * HALF + wr * 64 + m * 16 + fr) * 4 + wc] = s;
                }
            asm volatile("s_waitcnt lgkmcnt(0)" ::: "memory"); __builtin_amdgcn_s_barrier(); asm volatile("" ::: "memory");
            { const int row = wid * 32 + (lane & 31);
              if (lane < 32) xs2[(size_t)(u.pm * BM + row) * 4 + u.pn] = (P[row * 4 + 0] + P[row * 4 + 1]) + (P[row * 4 + 2] + P[row * 4 + 3]); }
#pragma unroll
            for (int ai = 0; ai < 2; ++ai)
#pragma unroll
                for (int m = 0; m < 4; ++m) { const int r = ai * HALF + wr * 64 + m * 16 + fr; const size_t off = (size_t)(u.pm * BM + r) * 1024 + col0;
#pragma unroll
                    for (int bj = 0; bj < 2; ++bj)
#pragma unroll
                        for (int n = 0; n < 2; ++n) { const f32x4 gv = *(const f32x4*)(gpre + col0 + bj * HALF + n * 16); const f32x4 o = acc[ai][bj][m][n] * gv;
                            u32x2v w; w.x = cvt_pk_bf16(o[0], o[1]); w.y = cvt_pk_bf16(o[2], o[3]); *(u32x2v*)(hn + off + bj * HALF + n * 16) = w; }
                    asm volatile("" ::: "memory"); }
            asm volatile("s_waitcnt lgkmcnt(0)" ::: "memory"); __builtin_amdgcn_s_barrier(); asm volatile("" ::: "memory");
        } else {
#pragma unroll
            for (int ai = 0; ai < 2; ++ai)
#pragma unroll
                for (int m = 0; m < 4; ++m) { const int r = ai * HALF + wr * 64 + m * 16 + fr; const size_t off = (size_t)(u.pm * BM + r) * 1024 + col0;
#pragma unroll
                    for (int bj = 0; bj < 2; ++bj)
#pragma unroll
                        for (int n = 0; n < 2; ++n) *(f32x4*)(out + off + bj * HALF + n * 16) = acc[ai][bj][m][n]; }
        }
    }
};

template <class Epi, class Sched, bool ALIGN_EPI>
__device__ __forceinline__ void gemm_phase(PG8_LAS unsigned char* lds, const Gemm g, const Sched& S, const Epi& E, int tid0) {
    int tid_ = tid0; asm volatile("" : "+v"(tid_));
    const int tid = tid_, wid = __builtin_amdgcn_readfirstlane(tid >> 6), lane = tid & 63, wr = wid >> 2, wc = wid & 3, fr = lane & 15, fq = lane >> 4;
    const int K = g.K, nt = K / BK;
    unsigned voffA[2], voffB[2];
#pragma unroll
    for (int i = 0; i < 2; ++i) { int R, C; stage_rc(tid * 16 + i * 8192, R, C); const int Rb = Epi::PERM ? ((R & ~31) + perm32(R & 31)) : R;
        voffA[i] = (unsigned)(R * g.lda + C) * 2u; voffB[i] = (unsigned)(Rb * g.ldb + C) * 2u; }
    const size_t kstep = (size_t)(BK * 2);
    const size_t hstepA = (size_t)HALF * g.lda * 2, hstepB = (size_t)HALF * g.ldb * 2;
    const size_t tstepA = 2 * hstepA, tstepB = 2 * hstepB;
    const unsigned ldsw = (unsigned)wid * 1024u;
    const int aoff = lds_byte(wr * 64 + fr, fq * 8), boff = lds_byte(wc * 32 + fr, fq * 8);
#define PG8_SA(b, h) (((b) * 2 + (h)) * HTB)
#define PG8_SB(b, h) ((4 + (b) * 2 + (h)) * HTB)
#define PG8_STAGE(bufoff, gbase, voff) do { _Pragma("unroll") for (int _i = 0; _i < 2; ++_i) \
        __builtin_amdgcn_global_load_lds((const unsigned*)((const char*)(gbase) + (voff)[_i]), (PG8_LAS unsigned*)(lds + (bufoff) + ldsw + _i * 8192), 16, 0, 0); } while (0)
#define PG8_LDA(dst, b, h) do { _Pragma("unroll") for (int m = 0; m < 4; ++m) _Pragma("unroll") for (int k = 0; k < 2; ++k) dst[m][k] = *(const PG8_LAS bf16x8*)(lds + PG8_SA(b, h) + aoff + m * 2048 + k * 1024); } while (0)
#define PG8_LDB(dst, b, h) do { _Pragma("unroll") for (int n = 0; n < 2; ++n) _Pragma("unroll") for (int k = 0; k < 2; ++k) dst[n][k] = *(const PG8_LAS bf16x8*)(lds + PG8_SB(b, h) + boff + n * 2048 + k * 1024); } while (0)
#define PG8_MMA(ai, bj, At, Bt) do { __builtin_amdgcn_s_setprio(1); _Pragma("unroll") for (int m = 0; m < 4; ++m) _Pragma("unroll") for (int n = 0; n < 2; ++n) _Pragma("unroll") for (int k = 0; k < 2; ++k) \
        acc[ai][bj][m][n] = __builtin_amdgcn_mfma_f32_16x16x32_bf16(Bt[n][k], At[m][k], acc[ai][bj][m][n], 0, 0, 0); __builtin_amdgcn_s_setprio(0); } while (0)
#define PG8_WAIT_V(n) asm volatile("s_waitcnt vmcnt(" #n ")" ::: "memory")
#define PG8_WAIT_L(n) asm volatile("s_waitcnt lgkmcnt(" #n ")" ::: "memory")
#define PG8_BAR __builtin_amdgcn_s_barrier()
#define PG8_SCHED __builtin_amdgcn_sched_barrier(0)
    Unit cur, nxt; int ui = 0;
    if (!S.next(0, cur)) return;
    f32x4 acc[2][2][4][2];
#pragma unroll
    for (int a = 0; a < 2; ++a)
#pragma unroll
        for (int b = 0; b < 2; ++b)
#pragma unroll
            for (int m = 0; m < 4; ++m)
#pragma unroll
                for (int n = 0; n < 2; ++n) acc[a][b][m][n] = (f32x4){0.f, 0.f, 0.f, 0.f};
    bf16x8 At[4][2], B0[2][2], B1[2][2];
    const char* cA = (const char*)g.A + (size_t)cur.pm * tstepA + (size_t)(cur.pn >> 1) * (size_t)g.apn; const char* cB = (const char*)g.Bt + (size_t)cur.pn * tstepB;
    S.a_ready(cur);
    PG8_STAGE(PG8_SB(0, 0), cB, voffB); PG8_STAGE(PG8_SB(0, 1), cB + hstepB, voffB); PG8_STAGE(PG8_SA(0, 0), cA, voffA); PG8_STAGE(PG8_SA(0, 1), cA + hstepA, voffA);
    if (wr == 1) PG8_BAR;
    PG8_WAIT_V(2); PG8_BAR;
    PG8_STAGE(PG8_SB(1, 0), cB + kstep, voffB); PG8_STAGE(PG8_SA(1, 0), cA + kstep, voffA); PG8_STAGE(PG8_SB(1, 1), cB + hstepB + kstep, voffB);
    PG8_WAIT_V(6); PG8_BAR;
    for (;;) {
        const bool has_next = S.next(ui + 1, nxt);
        const char* nA = has_next ? (const char*)g.A + (size_t)nxt.pm * tstepA + (size_t)(nxt.pn >> 1) * (size_t)g.apn : cA; const char* nB = has_next ? (const char*)g.Bt + (size_t)nxt.pn * tstepB : cB;
        for (int t = 0; t < nt; t += 2) {
            const bool last = (t == nt - 2);
            const char* a1 = cA + (size_t)(t + 1) * kstep;
            const char* a2 = last ? nA : cA + (size_t)(t + 2) * kstep; const char* b2 = last ? nB : cB + (size_t)(t + 2) * kstep;
            const char* a3 = a2 + kstep; const char* b3 = b2 + kstep;
            if (last && has_next) S.a_ready(nxt);
            PG8_LDB(B0, 0, 0); PG8_LDB(B1, 0, 1); PG8_SCHED; PG8_LDA(At, 0, 0); PG8_STAGE(PG8_SA(1, 1), a1 + hstepA, voffA);
            PG8_WAIT_V(8); PG8_WAIT_L(0); PG8_BAR; PG8_MMA(0, 0, At, B0); PG8_MMA(0, 1, At, B1); PG8_BAR; PG8_SCHED;
            PG8_LDA(At, 0, 1); PG8_STAGE(PG8_SB(0, 0), b2, voffB); PG8_STAGE(PG8_SB(0, 1), b2 + hstepB, voffB); PG8_STAGE(PG8_SA(0, 0), a2, voffA);
            PG8_WAIT_V(8); PG8_WAIT_L(0); PG8_BAR; PG8_MMA(1, 0, At, B0); PG8_MMA(1, 1, At, B1); PG8_BAR; PG8_SCHED;
            PG8_LDB(B0, 1, 0); PG8_LDB(B1, 1, 1); PG8_SCHED; PG8_LDA(At, 1, 0); PG8_STAGE(PG8_SA(0, 1), a2 + hstepA, voffA);
            PG8_WAIT_V(8); PG8_WAIT_L(0); PG8_BAR; PG8_MMA(0, 0, At, B0); PG8_MMA(0, 1, At, B1); PG8_BAR; PG8_SCHED;
            PG8_LDA(At, 1, 1); PG8_STAGE(PG8_SB(1, 0), b3, voffB); PG8_STAGE(PG8_SB(1, 1), b3 + hstepB, voffB); PG8_STAGE(PG8_SA(1, 0), a3, voffA);
            PG8_WAIT_V(8); PG8_WAIT_L(0); PG8_BAR; PG8_MMA(1, 0, At, B0); PG8_MMA(1, 1, At, B1); PG8_BAR; PG8_SCHED;
        }
        if constexpr (ALIGN_EPI) { if (wr == 0) PG8_BAR; }
        if constexpr (Epi::FUSED) E.fused(acc, cur, wr, wc, fr, fq, wid, lane); else E(acc, cur, wr, wc, fr, fq);
        S.done(cur);
        if (!has_next) break;
#pragma unroll
        for (int a = 0; a < 2; ++a)
#pragma unroll
            for (int b = 0; b < 2; ++b)
#pragma unroll
                for (int m = 0; m < 4; ++m)
#pragma unroll
                    for (int n = 0; n < 2; ++n) acc[a][b][m][n] = (f32x4){0.f, 0.f, 0.f, 0.f};
        cur = nxt; cA = nA; cB = nB; ++ui;
        if constexpr (ALIGN_EPI) { if (wr == 1) PG8_BAR; }
    }
    PG8_WAIT_V(0);
    if constexpr (!ALIGN_EPI) { if (wr == 0) PG8_BAR; }
    PG8_BAR;
#undef PG8_SA
#undef PG8_SB
#undef PG8_STAGE
#undef PG8_LDA
#undef PG8_LDB
#undef PG8_MMA
#undef PG8_WAIT_V
#undef PG8_WAIT_L
#undef PG8_BAR
#undef PG8_SCHED
}
}
namespace att {
typedef unsigned short u16;
typedef short bf16x8 __attribute__((ext_vector_type(8)));
typedef short s16x4 __attribute__((ext_vector_type(4)));
typedef float f32x16 __attribute__((ext_vector_type(16)));
typedef float f32x4 __attribute__((ext_vector_type(4)));
typedef unsigned u32x4 __attribute__((ext_vector_type(4)));
constexpr int SEQ = 16384, NW = 8, QBLK = 32, KVBLK = 64, QB = NW * QBLK;
constexpr int LDQ = 1536, LDK = 2048, LDKR = 64, LDO = 1024;
#ifndef ATT_NQREG
#define ATT_NQREG 8
#endif
constexpr int NQREG = ATT_NQREG, NQREG_L = 8 - NQREG;
constexpr int SHM_V = KVBLK * 128 * 2, SHM_K = KVBLK * 128 * 2, SHM_KR = KVBLK * 64 * 2;
constexpr int OFF_V = 0, OFF_K = 2 * SHM_V, OFF_KR = OFF_K + 2 * SHM_K, OFF_WS = OFF_KR + 2 * SHM_KR, OFF_QR = OFF_WS + NW * 64 * 4, QR_WAVE = (NQREG_L + 4) * 1024, LDS_BYTES = OFF_QR + NW * QR_WAVE;
constexpr float SCALE = 0.07216878364870322f;
constexpr float THR = 8.f;

#define KSWZ(row, colB) ((row) * 256 + ((colB) ^ (((row) & 7) << 4)))
#define KRSWZ(row, colB) ((row) * 128 + ((colB) ^ (((row) & 7) << 4)))
#define SBAR() __builtin_amdgcn_sched_barrier(0)
__device__ __forceinline__ int v_st(int k, int c) { const int kk = (k & ~0xC) | ((k & 4) << 1) | ((k & 8) >> 1); return ((kk >> 3) * 4 + (c >> 5)) * 512 + ((kk & 7) * 32 + (c & 31)) * 2; }
__device__ __forceinline__ int v_rd_base(int lane) { return ((lane & 3) << 3) | (((lane >> 2) & 3) << 6) | (((lane >> 4) & 1) << 5) | (((lane >> 5) & 1) << 8); }
constexpr int v_rd_off(int d0, int ks, int half) { return d0 * 512 + ks * 4096 + half * 2048; }
__device__ __forceinline__ int crow(int r, int hi) { return (r & 3) + 8 * (r >> 2) + 4 * hi; }
__device__ __forceinline__ unsigned cvtpk(float lo, float hi) { unsigned r; asm volatile("v_cvt_pk_bf16_f32 %0, %1, %2" : "=v"(r) : "v"(lo), "v"(hi)); return r; }
__device__ __forceinline__ bf16x8 load8(const u16* p) { return *reinterpret_cast<const bf16x8*>(p); }
__device__ __forceinline__ void mask_tile(f32x16& p0, f32x16& p1, int dq, unsigned W) {
    const float NEG = -__builtin_inff();
#pragma unroll
    for (int r = 0; r < 16; ++r) {
        const int c = (r & 3) + 8 * (r >> 2);
        if ((unsigned)(dq - c) >= W) p0[r] = NEG;
        if ((unsigned)(dq - c - 32) >= W) p1[r] = NEG;
    }
}
__device__ __forceinline__ void partialSM(f32x16& p0, f32x16& p1, float& m_reg, float& mn, float& alpha) {
    float pmax = p0[0]; for (int r = 1; r < 16; ++r) pmax = fmaxf(pmax, p0[r]); for (int r = 0; r < 16; ++r) pmax = fmaxf(pmax, p1[r]);
    { auto rr = __builtin_amdgcn_permlane32_swap(__float_as_uint(pmax), __float_as_uint(pmax), false, false);
      pmax = fmaxf(__uint_as_float(rr[0]), __uint_as_float(rr[1])); }
    constexpr float C2 = 1.4426950408889634f * SCALE;
    if (__builtin_expect(__all((pmax - m_reg) * SCALE <= THR), 1)) { mn = m_reg; alpha = 1.f; }
    else { mn = fmaxf(m_reg, pmax); alpha = __builtin_amdgcn_exp2f((m_reg - mn) * C2); m_reg = mn; }
    const float mnL = -mn * C2;
    for (int r = 0; r < 16; ++r) p0[r] = fmaf(p0[r], C2, mnL); for (int r = 0; r < 16; ++r) p1[r] = fmaf(p1[r], C2, mnL);
}
__device__ __forceinline__ void finishSM(f32x16& p0, f32x16& p1, float alpha, float& l_reg, bf16x8& pa0, bf16x8& pa1, bf16x8& pa2, bf16x8& pa3) {
    for (int r = 0; r < 16; ++r) p0[r] = __builtin_amdgcn_exp2f(p0[r]);
    for (int r = 0; r < 16; ++r) p1[r] = __builtin_amdgcn_exp2f(p1[r]);
    float ps = 0; for (int r = 0; r < 16; ++r) ps += p0[r]; for (int r = 0; r < 16; ++r) ps += p1[r];
    { auto rr = __builtin_amdgcn_permlane32_swap(__float_as_uint(ps), __float_as_uint(ps), false, false);
      ps = __uint_as_float(rr[0]) + __uint_as_float(rr[1]); }
    l_reg = l_reg * alpha + ps;
#define PK4(P, B_, OUT) do { unsigned a0 = cvtpk(P[B_+0], P[B_+1]), a1 = cvtpk(P[B_+2], P[B_+3]);                          \
        unsigned b0 = cvtpk(P[B_+4], P[B_+5]), b1 = cvtpk(P[B_+6], P[B_+7]);                                             \
        auto r0 = __builtin_amdgcn_permlane32_swap(a0, b0, false, false); auto r1 = __builtin_amdgcn_permlane32_swap(a1, b1, false, false); \
        u32x4 w = {r0[0], r1[0], r0[1], r1[1]}; OUT = *reinterpret_cast<bf16x8*>(&w); } while (0)
    PK4(p0, 0, pa0); PK4(p0, 8, pa1); PK4(p1, 0, pa2); PK4(p1, 8, pa3);
#undef PK4
}
#ifndef ATT_PF
#define ATT_PF 1
#endif
#define QK_SB() __builtin_amdgcn_sched_barrier(0x406)
#define QK_LOAD(s, SET) do { if ((s) < 8) { const char* a_ = kb[(s) & 3] + ((s) >> 2) * 128; fb0[SET] = *reinterpret_cast<const bf16x8*>(a_); fb1[SET] = *reinterpret_cast<const bf16x8*>(a_ + 32 * 256); \
            if ((s) < NQREG) fq[SET] = qr[(s) < NQREG ? (s) : 0]; else fq[SET] = qrl[((s) - NQREG) * 64]; } \
        else { const char* a_ = krb[((s) - 8) & 3]; fb0[SET] = *reinterpret_cast<const bf16x8*>(a_); fb1[SET] = *reinterpret_cast<const bf16x8*>(a_ + 32 * 128); fq[SET] = qrl[(NQREG_L + (s) - 8) * 64]; } } while (0)
template <int KB>
__device__ __forceinline__ void qkt(f32x16& p0, f32x16& p1, const char* K_lds, const char* KR_lds, const bf16x8* qrl, int r32, int hi, const bf16x8* qr) {
    constexpr int PF = ATT_PF, NS = PF + 1;
    p0 = f32x16{}; p1 = f32x16{};
    const char* kb[4]; const char* krb[4];
#pragma unroll
    for (int dd = 0; dd < 4; ++dd) { kb[dd] = K_lds + KB * SHM_K + KSWZ(r32, (dd * 16 + hi * 8) * 2); krb[dd] = KR_lds + KB * SHM_KR + KRSWZ(r32, (dd * 16 + hi * 8) * 2); }
    bf16x8 fb0[NS], fb1[NS], fq[NS];
#pragma unroll
    for (int s = 0; s < PF; ++s) QK_LOAD(s, s % NS);
#pragma unroll
    for (int s = 0; s < 12; ++s) {
        QK_SB();
        if (s + PF < 12) QK_LOAD(s + PF, (s + PF) % NS);
        QK_SB();
        p0 = __builtin_amdgcn_mfma_f32_32x32x16_bf16(fb0[s % NS], fq[s % NS], p0, 0, 0, 0);
        p1 = __builtin_amdgcn_mfma_f32_32x32x16_bf16(fb1[s % NS], fq[s % NS], p1, 0, 0, 0);
    }
    QK_SB();
}
#define FSM_E(j) do { if ((j) < 16) { y0[(j) & 15] = __builtin_amdgcn_exp2f(y0[(j) & 15]); acc += y0[(j) & 15]; } else { y1[(j) & 15] = __builtin_amdgcn_exp2f(y1[(j) & 15]); acc += y1[(j) & 15]; } } while (0)
#define FSM_CVT(P, B_) do { ca0 = cvtpk(P[(B_) + 0], P[(B_) + 1]); ca1 = cvtpk(P[(B_) + 2], P[(B_) + 3]); cb0 = cvtpk(P[(B_) + 4], P[(B_) + 5]); cb1 = cvtpk(P[(B_) + 6], P[(B_) + 7]); } while (0)
#define FSM_SWP(OUT) do { auto r0_ = __builtin_amdgcn_permlane32_swap(ca0, cb0, false, false); auto r1_ = __builtin_amdgcn_permlane32_swap(ca1, cb1, false, false); \
        u32x4 w_ = {r0_[0], r1_[0], r0_[1], r1_[1]}; OUT = *reinterpret_cast<bf16x8*>(&w_); } while (0)
#define FSM_CHUNK(c) do { if ((c) < 12) { FSM_E(2 * (c)); FSM_E(2 * (c) + 1); } else if ((c) < 20) { FSM_E(24 + (c) - 12); } \
        if ((c) == 12) FSM_CVT(y0, 0); if ((c) == 13) FSM_SWP(pa0); if ((c) == 14) FSM_CVT(y0, 8); if ((c) == 15) FSM_SWP(pa1); \
        if ((c) == 16) FSM_CVT(y1, 0); if ((c) == 17) FSM_SWP(pa2); if ((c) == 20) FSM_CVT(y1, 8); if ((c) == 21) FSM_SWP(pa3); \
        if ((c) == 22) { auto rr_ = __builtin_amdgcn_permlane32_swap(__float_as_uint(acc), __float_as_uint(acc), false, false); acc = __uint_as_float(rr_[0]) + __uint_as_float(rr_[1]); } \
        if ((c) == 23) l_reg = l_reg * alpha + acc; } while (0)
#define SB0() __builtin_amdgcn_sched_barrier(0)
#define QKN(j) ((j) >= 12 ? 0 : ((j) < NQREG ? 2 : 3))
#define DSR128(dst, addr, off) asm volatile("ds_read_b128 %0, %1 offset:%2" : "=v"(dst) : "v"(addr), "i"(off) : "memory")
#define QKA_LOAD(s, SET) do { if ((s) < 8) { DSR128(fb0[SET], ka[(s) & 3], KB * SHM_K + ((s) >> 2) * 128); DSR128(fb1[SET], ka[(s) & 3], KB * SHM_K + ((s) >> 2) * 128 + 32 * 256); \
            if ((s) >= NQREG) DSR128(fq[SET], qa, (((s) - NQREG) & 15) * 1024); } \
        else if ((s) < 12) { DSR128(fb0[SET], kra[((s) - 8) & 3], KB * SHM_KR); DSR128(fb1[SET], kra[((s) - 8) & 3], KB * SHM_KR + 32 * 128); DSR128(fq[SET], qa, ((NQREG_L + (s) - 8) & 15) * 1024); } } while (0)
#define QKQ(s) ((s) < NQREG ? qr[(s) < NQREG ? (s) : 0] : fq[(s) % 3])
#define QKA_STEP(s) do { SB0(); QKA_LOAD((s) + 2, ((s) + 2) % 3); SB0(); \
        asm volatile("s_waitcnt lgkmcnt(%0)" :: "i"(QKN((s) + 1) + QKN((s) + 2)) : "memory"); SB0(); \
        p0 = __builtin_amdgcn_mfma_f32_32x32x16_bf16(fb0[(s) % 3], QKQ(s), p0, 0, 0, 0); SB0(); FSM_CHUNK(2 * (s)); SB0(); \
        p1 = __builtin_amdgcn_mfma_f32_32x32x16_bf16(fb1[(s) % 3], QKQ(s), p1, 0, 0, 0); SB0(); FSM_CHUNK(2 * (s) + 1); } while (0)
template <int KB>
__device__ __forceinline__ void qkt_fsm(f32x16& p0, f32x16& p1, const int (&ka)[4], const int (&kra)[4], int qa, bf16x8 (&fb0)[3], bf16x8 (&fb1)[3], bf16x8 (&fq)[3], const bf16x8* qr,
                                        f32x16& y0, f32x16& y1, float alpha, float& l_reg, bf16x8& pa0, bf16x8& pa1, bf16x8& pa2, bf16x8& pa3) {
    p0 = f32x16{}; p1 = f32x16{};
    float acc = 0.f; unsigned ca0 = 0, ca1 = 0, cb0 = 0, cb1 = 0;
    QKA_STEP(0); QKA_STEP(1); QKA_STEP(2); QKA_STEP(3); QKA_STEP(4); QKA_STEP(5); QKA_STEP(6); QKA_STEP(7); QKA_STEP(8); QKA_STEP(9); QKA_STEP(10); QKA_STEP(11);
    SB0();
}
#undef QKN
#undef QKQ
#undef QKA_STEP
#undef FSM_E
#undef FSM_CVT
#undef FSM_SWP
#undef FSM_CHUNK
#undef QK_LOAD
template <int VB>
__device__ __forceinline__ void pv_tile(f32x16* o, int vb0, bf16x8 pa0, bf16x8 pa1, bf16x8 pa2, bf16x8 pa3) {
#define TRRD(dst, off) asm volatile("ds_read_b64_tr_b16 %0, %1 offset:%2" : "=&v"(dst) : "v"(vb0), "i"(off) : "memory")
#define PV_D0(d0) do { s16x4 l0, l1, l2, l3, h0, h1, h2, h3; constexpr int b_ = OFF_V + VB * SHM_V + v_rd_off(d0, 0, 0); \
        TRRD(l0, b_); TRRD(h0, b_ + 2048); TRRD(l1, b_ + 4096); TRRD(h1, b_ + 6144); TRRD(l2, b_ + 8192); TRRD(h2, b_ + 10240); TRRD(l3, b_ + 12288); TRRD(h3, b_ + 14336); \
        asm volatile("s_waitcnt lgkmcnt(0)" ::: "memory"); SBAR();   \
        o[d0] = __builtin_amdgcn_mfma_f32_32x32x16_bf16(pa0, (bf16x8){l0[0], l0[1], l0[2], l0[3], h0[0], h0[1], h0[2], h0[3]}, o[d0], 0, 0, 0);   \
        o[d0] = __builtin_amdgcn_mfma_f32_32x32x16_bf16(pa1, (bf16x8){l1[0], l1[1], l1[2], l1[3], h1[0], h1[1], h1[2], h1[3]}, o[d0], 0, 0, 0);   \
        o[d0] = __builtin_amdgcn_mfma_f32_32x32x16_bf16(pa2, (bf16x8){l2[0], l2[1], l2[2], l2[3], h2[0], h2[1], h2[2], h2[3]}, o[d0], 0, 0, 0);   \
        o[d0] = __builtin_amdgcn_mfma_f32_32x32x16_bf16(pa3, (bf16x8){l3[0], l3[1], l3[2], l3[3], h3[0], h3[1], h3[2], h3[3]}, o[d0], 0, 0, 0); } while (0)
    PV_D0(0); PV_D0(1); PV_D0(2); PV_D0(3);
}
template <int VB>
__device__ __forceinline__ void pv_tile_sm(f32x16* o, int vb0, bf16x8 pa0, bf16x8 pa1, bf16x8 pa2, bf16x8 pa3, f32x16& p0, f32x16& p1, float& m_reg, float& mn, float& alpha) {
    constexpr float C2 = 1.4426950408889634f * SCALE;
    PV_D0(0);
    float pmax = p0[0];
#pragma unroll
    for (int r = 1; r < 16; ++r) pmax = fmaxf(pmax, p0[r]);
#pragma unroll
    for (int r = 0; r < 16; ++r) pmax = fmaxf(pmax, p1[r]);
    PV_D0(1);
    { auto rr = __builtin_amdgcn_permlane32_swap(__float_as_uint(pmax), __float_as_uint(pmax), false, false);
      pmax = fmaxf(__uint_as_float(rr[0]), __uint_as_float(rr[1])); }
    const bool keep = __all((pmax - m_reg) * SCALE <= THR);
    mn = keep ? m_reg : fmaxf(m_reg, pmax);
    alpha = __builtin_amdgcn_exp2f((m_reg - mn) * C2);
    m_reg = mn;
    const float mnL = -mn * C2;
#pragma unroll
    for (int r = 0; r < 16; ++r) p0[r] = fmaf(p0[r], C2, mnL);
    PV_D0(2);
#pragma unroll
    for (int r = 0; r < 16; ++r) p1[r] = fmaf(p1[r], C2, mnL);
    PV_D0(3);
}
#undef PV_D0
#undef TRRD

struct BlockRef { const u16* Q; const u16* K; const u16* V; const u16* KR; u16* O; int P0; int row0; };
#define VMW() asm volatile("s_waitcnt vmcnt(0)" ::: "memory")
#define ATT_LAS __attribute__((address_space(3)))
#define KDMA(Kp, KRp, k0, bf) do { \
        __builtin_amdgcn_global_load_lds((const unsigned*)((Kp) + (size_t)((k0) + sr) * LDK + ksc), (ATT_LAS unsigned*)(ldsL + OFF_K + (bf) * SHM_K + wid * 1024), 16, 0, 0); \
        __builtin_amdgcn_global_load_lds((const unsigned*)((Kp) + (size_t)((k0) + 32 + sr) * LDK + ksc), (ATT_LAS unsigned*)(ldsL + OFF_K + (bf) * SHM_K + 8192 + wid * 1024), 16, 0, 0); \
        __builtin_amdgcn_global_load_lds((const unsigned*)((KRp) + (size_t)((k0) + krr) * LDKR + krsc), (ATT_LAS unsigned*)(ldsL + OFF_KR + (bf) * SHM_KR + wid * 1024), 16, 0, 0); } while (0)
#define VDMA(Vp, k0, bf) do { \
        __builtin_amdgcn_global_load_lds((const unsigned*)((Vp) + (size_t)((k0) + vk) * LDK + vc), (ATT_LAS unsigned*)(ldsL + OFF_V + (bf) * SHM_V + wid * 1024), 16, 0, 0); \
        __builtin_amdgcn_global_load_lds((const unsigned*)((Vp) + (size_t)((k0) + 32 + vk) * LDK + vc), (ATT_LAS unsigned*)(ldsL + OFF_V + (bf) * SHM_V + 8192 + wid * 1024), 16, 0, 0); } while (0)
#define ATT_MAPS() const int sr = tid >> 4, ksc = ((tid & 15) ^ (sr & 7)) * 8, krr = tid >> 3, krsc = ((tid & 7) ^ (krr & 7)) * 8; ATT_LAS unsigned char* ldsL = (ATT_LAS unsigned char*)lds; \
    const int vkk_ = ((tid >> 7) << 3) | ((tid >> 2) & 7), vk = (vkk_ & ~0xC) | ((vkk_ & 4) << 1) | ((vkk_ & 8) >> 1), vc = ((tid >> 5) & 3) * 32 + (tid & 3) * 8
__device__ __forceinline__ void attn_prime(const BlockRef& cur, char* lds, int tid0) {
    int tid_ = tid0; asm volatile("" : "+v"(tid_));
    const int tid = tid_, wid = __builtin_amdgcn_readfirstlane(tid >> 6);
    ATT_MAPS();
    KDMA(cur.K, cur.KR, 0, 0); VDMA(cur.V, 0, 0); VMW();
    __syncthreads();
}
__device__ __forceinline__ void attn_block(const BlockRef& cur, const BlockRef& nxt, char* lds, int tid0, const float* ctab, const float* stab) {
    int tid_ = tid0; asm volatile("" : "+v"(tid_));
    const int tid = tid_, wid = __builtin_amdgcn_readfirstlane(tid >> 6), lane = tid & 63, r32 = lane & 31, hi = lane >> 5;
    const unsigned W = 0x40000000u;
    const int NT = (cur.P0 + QB - 1) / KVBLK + 1;
    const int qlo = cur.P0 + wid * QBLK, qm = qlo + r32 - 4 * hi;
    char* K_lds = lds + OFF_K; char* KR_lds = lds + OFF_KR;
    float* ws = (float*)(lds + OFF_WS) + wid * 64; float* li_l = ws, * al_l = ws + 32;
    bf16x8* qrl = (bf16x8*)(lds + OFF_QR + wid * QR_WAVE) + lane;
    float m_reg = -1e30f, l_reg = 0; f32x16 o[4] = {};
    ATT_MAPS();
    const int vb0 = (int)(uintptr_t)lds + v_rd_base(lane);
    const u16* Kh = cur.K; const u16* Vh = cur.V; const u16* KRh = cur.KR;
#define RESC(a) do { if (__any((a) < 1.f)) { if (hi == 0) al_l[r32] = (a); asm volatile("s_waitcnt lgkmcnt(0)" ::: "memory");              \
                     for (int d_ = 0; d_ < 4; ++d_) for (int r = 0; r < 16; ++r) o[d_][r] *= al_l[crow(r, hi)]; } } while (0)
#define KBASE(t) ((t) * KVBLK)
#define MASKT(P0_, P1_, t) do { const int kb_ = KBASE(t); if (kb_ + KVBLK - 1 > qlo) mask_tile(P0_, P1_, qm - kb_, W); } while (0)
    f32x16 pA0, pA1, pB0, pB1; float mnA, mnB, alA, alB; bf16x8 pa0, pa1, pa2, pa3;
    int ka[4], kra[4]; const int qa = (int)(uintptr_t)qrl; bf16x8 fb0[3], fb1[3], fq[3];
#pragma unroll
    for (int dd = 0; dd < 4; ++dd) { ka[dd] = (int)(uintptr_t)K_lds + KSWZ(r32, (dd * 16 + hi * 8) * 2); kra[dd] = (int)(uintptr_t)KR_lds + KRSWZ(r32, (dd * 16 + hi * 8) * 2); }
#define QK_PREFETCH(KBN) do { constexpr int KB = (KBN); SB0(); QKA_LOAD(0, 0); QKA_LOAD(1, 1); SB0(); } while (0)
    bf16x8 qr[NQREG > 0 ? NQREG : 1];
    { const u16* qp = cur.Q + (size_t)(wid * QBLK + r32) * LDQ + hi * 8;
#pragma unroll
      for (int d = 0; d < NQREG_L; ++d) qrl[d * 64] = load8(qp + (NQREG + d) * 16);
      const size_t trow = (size_t)(cur.row0 + wid * QBLK + r32) * 32 + hi * 8;
#pragma unroll
      for (int pr = 0; pr < 2; ++pr) {
          const bf16x8 x1 = load8(qp + 128 + pr * 16), x2 = load8(qp + 128 + 32 + pr * 16);
          const f32x4 c0 = *(const f32x4*)(ctab + trow + pr * 16), c1 = *(const f32x4*)(ctab + trow + pr * 16 + 4), s0 = *(const f32x4*)(stab + trow + pr * 16), s1 = *(const f32x4*)(stab + trow + pr * 16 + 4);
          float o1[8], o2[8];
#pragma unroll
          for (int e = 0; e < 8; ++e) { const float a = __uint_as_float(((unsigned)(unsigned short)x1[e]) << 16), b = __uint_as_float(((unsigned)(unsigned short)x2[e]) << 16);
              const float cc = e < 4 ? c0[e & 3] : c1[e & 3], ss = e < 4 ? s0[e & 3] : s1[e & 3]; o1[e] = a * cc - b * ss; o2[e] = b * cc + a * ss; }
          u32x4 w1 = {cvtpk(o1[0], o1[1]), cvtpk(o1[2], o1[3]), cvtpk(o1[4], o1[5]), cvtpk(o1[6], o1[7])}, w2 = {cvtpk(o2[0], o2[1]), cvtpk(o2[2], o2[3]), cvtpk(o2[4], o2[5]), cvtpk(o2[6], o2[7])};
          qrl[(NQREG_L + pr) * 64] = *reinterpret_cast<bf16x8*>(&w1); qrl[(NQREG_L + 2 + pr) * 64] = *reinterpret_cast<bf16x8*>(&w2); }
#pragma unroll
      for (int d0 = 0; d0 < NQREG; ++d0) qr[d0] = load8(qp + d0 * 16); }
    SBAR();
    KDMA(Kh, KRh, KBASE(1), 1); VDMA(Vh, KBASE(1), 1);
    SBAR(); qkt<0>(pA0, pA1, K_lds, KR_lds, qrl, r32, hi, qr);
    MASKT(pA0, pA1, 0); partialSM(pA0, pA1, m_reg, mnA, alA);
    VMW(); __syncthreads();
    QK_PREFETCH(1);
    KDMA(Kh, KRh, KBASE(2), 0);
#define HALF_STEP(PX0, PX1, mnX, alX, PY0, PY1, alY, t, KB, VB) do {                                                          \
        SBAR(); qkt_fsm<KB>(PX0, PX1, ka, kra, qa, fb0, fb1, fq, qr, PY0, PY1, alY, l_reg, pa0, pa1, pa2, pa3); SBAR();                       \
        MASKT(PX0, PX1, (t)); SBAR(); pv_tile_sm<VB>(o, vb0, pa0, pa1, pa2, pa3, PX0, PX1, m_reg, mnX, alX);                  \
        VMW(); __syncthreads();                                                                                               \
        QK_PREFETCH(1 - (KB));                             \
        if ((t) + 2 < NT) KDMA(Kh, KRh, KBASE((t) + 2), KB);                                                                  \
        if ((t) + 1 < NT) VDMA(Vh, KBASE((t) + 1), VB);                                                                       \
        SBAR(); RESC(alX); } while (0)
    for (int t = 1; t + 1 < NT; t += 2) {
        HALF_STEP(pB0, pB1, mnB, alB, pA0, pA1, alA, t, 1, 0);
        HALF_STEP(pA0, pA1, mnA, alA, pB0, pB1, alB, t + 1, 0, 1);
    }
    SBAR(); qkt_fsm<1>(pB0, pB1, ka, kra, qa, fb0, fb1, fq, qr, pA0, pA1, alA, l_reg, pa0, pa1, pa2, pa3); SBAR();
    MASKT(pB0, pB1, NT - 1); SBAR(); pv_tile_sm<0>(o, vb0, pa0, pa1, pa2, pa3, pB0, pB1, m_reg, mnB, alB);
    VMW(); __syncthreads();
    KDMA(nxt.K, nxt.KR, 0, 0); VDMA(nxt.V, 0, 0);
    SBAR(); RESC(alB);
    finishSM(pB0, pB1, alB, l_reg, pa0, pa1, pa2, pa3); SBAR(); pv_tile<1>(o, vb0, pa0, pa1, pa2, pa3);
    SBAR();
    if (hi == 0) li_l[r32] = l_reg; asm volatile("s_waitcnt lgkmcnt(0)" ::: "memory");
    float rli[16];
#pragma unroll
    for (int r = 0; r < 16; ++r) rli[r] = __builtin_amdgcn_rcpf(li_l[crow(r, hi)]);
    u16* Ow = cur.O + (size_t)(wid * QBLK) * LDO;
#pragma unroll
    for (int r = 0; r < 16; ++r) { const int orow = crow(r, hi);
#pragma unroll
        for (int d0 = 0; d0 < 4; ++d0) { const float v = o[d0][r] * rli[r];
            const float vn = xor1f(v);
            if ((r32 & 1) == 0) *(unsigned*)(Ow + (size_t)orow * LDO + d0 * 32 + r32) = cvtpk(v, vn); } }
    VMW(); __syncthreads();
#undef RESC
#undef KBASE
#undef MASKT
#undef HALF_STEP
#undef QK_PREFETCH
}
struct Tensors { const u16* q; const u16* kv; const u16* kr; u16* o; const float* ctab; const float* stab; };
__device__ __forceinline__ BlockRef make_ref(const Tensors& T, int L, int pass) {
    const int bh = (L & 7) + 8 * (L >> 8), x = (L >> 3) & 31, b = bh >> 3, h = bh & 7, qb = pass ? x : 63 - x;
    BlockRef r; const size_t row0 = (size_t)b * SEQ;
    r.Q = T.q + (row0 + (size_t)qb * QB) * LDQ + h * 192; r.K = T.kv + row0 * LDK + h * 256; r.V = r.K + 128; r.KR = T.kr + row0 * LDKR;
    r.O = T.o + (row0 + (size_t)qb * QB) * LDO + h * 128; r.P0 = qb * QB; r.row0 = b * SEQ + qb * QB;
    return r;
}
__device__ __forceinline__ void attn_phase(char* lds, const Tensors& T, int tid0) {
    const int total = 512, stride = gridDim.x;
    int L = blockIdx.x; if (L >= total) return;
    int pass = 0;
    BlockRef cur = make_ref(T, L, 0);
    attn_prime(cur, lds, tid0);
    for (;;) {
        const bool more_pass = pass == 0, more_item = L + stride < total, last = !more_pass && !more_item;
        int passn = pass + 1, Ln = L;
        if (!more_pass) { passn = 0; Ln = more_item ? L + stride : L; }
        const BlockRef nxt = last ? cur : make_ref(T, Ln, passn);
        attn_block(cur, nxt, lds, tid0, T.ctab, T.stab);
        if (last) break;
        cur = nxt; pass = passn; L = Ln;
    }
}
#undef VMW
#undef KDMA
#undef VDMA
#undef ATT_MAPS
#undef SBAR
}
namespace xb {
#define LAS __attribute__((address_space(3)))
#define XB_TMO      128
#define XB_XCNT(j)  (256  + 64 * (j))
#define XB_XSUB(j)  (1280 + 64 * (j))
#define XB_XGEN(j)  (2304 + 64 * (j))
#define XB_TOP      3328
#define XB_TOPGEN   3392
#define XCD_BAR_WORDS 3456
#define XB_SPIN_CAP (1u << 18)

__device__ __forceinline__ unsigned xb_ld(unsigned* p)              { return __hip_atomic_load(p, __ATOMIC_RELAXED, __HIP_MEMORY_SCOPE_AGENT); }
__device__ __forceinline__ unsigned xb_add(unsigned* p, unsigned v) { return __hip_atomic_fetch_add(p, v, __ATOMIC_RELAXED, __HIP_MEMORY_SCOPE_AGENT); }
__device__ __forceinline__ unsigned xb_xcc_id() { return (unsigned)__builtin_amdgcn_s_getreg((3 << 11) | 20) & 0xFu; }
#define XB_SPIN(cond, bar) do { unsigned _sp = 0; while (cond) { __builtin_amdgcn_s_sleep(1); \
    if ((++_sp & 255u) == 0u) { if (xb_ld(&(bar)[XB_TMO])) break; if (_sp > XB_SPIN_CAP) { atomicAdd(&(bar)[XB_TMO], 1u); break; } } } } while (0)

struct XcdBarrier {
    unsigned* bar; unsigned x;
    volatile LAS unsigned* st;
};

__device__ __forceinline__ XcdBarrier xcd_barrier_post(unsigned* bar, volatile LAS unsigned* st) {
    XcdBarrier b; b.bar = bar; b.x = xb_xcc_id(); b.st = st;
    if (threadIdx.x == 0) (void)xb_add(&bar[XB_XCNT(b.x)], 1u);
    return b;
}
__device__ __forceinline__ void xcd_barrier_complete(unsigned* bar, unsigned x, unsigned& nloc, unsigned& nx) {
    const unsigned G = gridDim.x * gridDim.y * gridDim.z;
    unsigned sum, cnt, mine, sp = 0u;
    for (;;) {
        sum = 0u; cnt = 0u; mine = 0u;
#pragma unroll
        for (unsigned j = 0; j < 16; ++j) { const unsigned c = xb_ld(&bar[XB_XCNT(j)]); sum += c; cnt += (c > 0u) ? 1u : 0u; mine = (j == x) ? c : mine; }
        if (sum == G) break;
        __builtin_amdgcn_s_sleep(1);
        if ((++sp & 255u) == 0u) { if (xb_ld(&bar[XB_TMO])) break; if (sp > XB_SPIN_CAP) { atomicAdd(&bar[XB_TMO], 1u); break; } }
    }
    nloc = mine > 0u ? mine : 1u; nx = cnt > 0u ? cnt : 1u;
}

__device__ __forceinline__ void xcd_barrier(const XcdBarrier& b, bool t0  ) {
    asm volatile("s_waitcnt vmcnt(0)" ::: "memory");
    __syncthreads();
    if (t0) {
        unsigned* bar = b.bar;
        __builtin_amdgcn_s_waitcnt(0);
        unsigned nloc = b.st[0], nx = b.st[1];
        if (nloc == 0u) { xcd_barrier_complete(bar, b.x, nloc, nx); b.st[0] = nloc; b.st[1] = nx; }
        const unsigned old = xb_add(&bar[XB_XSUB(b.x)], 1u);
        const unsigned gen = old / nloc;
        if (old + 1u == (gen + 1u) * nloc) {
            __builtin_amdgcn_fence(__ATOMIC_RELEASE, "agent");
            asm volatile("s_waitcnt vmcnt(0)" ::: "memory");
            const unsigned og = xb_add(&bar[XB_TOP], 1u);
            const unsigned tg = og / nx;
            if (og + 1u == (tg + 1u) * nx) xb_add(&bar[XB_TOPGEN], 1u);
            else XB_SPIN(xb_ld(&bar[XB_TOPGEN]) == tg, bar);
            __builtin_amdgcn_fence(__ATOMIC_ACQUIRE, "agent");
            xb_add(&bar[XB_XGEN(b.x)], 1u);
            asm volatile("s_waitcnt vmcnt(0)" ::: "memory");
        } else {
            XB_SPIN(xb_ld(&bar[XB_XGEN(b.x)]) == gen, bar);
            __builtin_amdgcn_fence(__ATOMIC_ACQUIRE, "agent");
            asm volatile("s_waitcnt vmcnt(0)" ::: "memory");
        }
    }
    __syncthreads();
}
#undef LAS
}
#ifndef PROBE_ATT_REPS
#define PROBE_ATT_REPS 1
#endif
#ifndef PROBE_SYNC_REPS
#define PROBE_SYNC_REPS 1
#endif
#ifndef PROBE_THIN_REPS
#define PROBE_THIN_REPS 1
#endif
#ifndef PROBE_PRO_REPS
#define PROBE_PRO_REPS 1
#endif
#ifndef STAGGER_TICKS
#define STAGGER_TICKS 0
#endif
#ifndef PROBE_GEMM_OP
#define PROBE_GEMM_OP -1
#endif
#ifndef PROBE_GEMM_REPS
#define PROBE_GEMM_REPS 1
#endif
namespace mk {
typedef unsigned short u16;
typedef float f32x4 __attribute__((ext_vector_type(4)));
constexpr int M = 32768, D = 1024, SEQ = 16384;
constexpr float EPS = 1e-6f;
constexpr size_t MB = (size_t)1 << 20;
__host__ __device__ constexpr size_t WT_MLA(int j) { return (size_t)j * 6 * MB; }
__host__ __device__ constexpr size_t WT_LRU(int j) { return 12 * MB + (size_t)j * 8 * MB; }
__host__ __device__ constexpr size_t WT_FFN(int l) { return 28 * MB + (size_t)l * 16 * MB; }
constexpr size_t OFF_UQ = 3 * MB / 2, OFF_UKV = 11 * MB / 4, OFF_WO = 15 * MB / 4, OFF_GT = 4 * MB, OFF_LOUT = 5 * MB, OFF_DOWN = 8 * MB;
constexpr size_t WS_COS = 96 * MB, WS_SIN = 100 * MB, WS_SA = 104 * MB, WS_SB = 105 * MB;
constexpr size_t WS_HN = 112 * MB, WS_Y = 176 * MB, WS_U = 240 * MB, WS_END = 496 * MB;
constexpr size_t U_PROJ = 64 * MB, U_CQ = 112 * MB, U_CKV = 136 * MB, U_KR = 152 * MB, U_Q = 160 * MB, U_O = 64 * MB;
constexpr size_t U_GATE = 0, U_XC = 64 * MB, U_REC = 128 * MB, U_LA = 128 * MB, U_B = 192 * MB;
constexpr size_t WS_XSA = 108 * MB, WS_XSB = 109 * MB;
constexpr size_t WS_RS = 108 * MB;
constexpr int SCAN_L = 128, SCAN_NC = SEQ / SCAN_L;

__device__ __forceinline__ unsigned f2bf(float f) { unsigned u = __float_as_uint(f); return (u + 0x7fffu + ((u >> 16) & 1u)) >> 16; }
__device__ __forceinline__ unsigned pk2(float lo, float hi) { return f2bf(lo) | (f2bf(hi) << 16); }
__device__ __forceinline__ float bflo(unsigned w) { return __uint_as_float(w << 16); }
__device__ __forceinline__ float bfhi(unsigned w) { return __uint_as_float(w & 0xffff0000u); }
__device__ __forceinline__ float bf1(u16 h) { return __uint_as_float(((unsigned)h) << 16); }
__device__ __forceinline__ float wave_sum(float v) {
    v += xor1f(v); v += xor2f(v); v += xor4f(v); v += xor8f(v); v += xor16f(v);
    return sum32f(v);
}
__device__ __forceinline__ void transpose_item(const float* W, int ldw, u16* WT, int ldt, int nblk, float* scr, int item, int lane) {
    const int kb = item / nblk, nb = item % nblk, k0 = 64 * kb, n0 = 32 * nb;
#pragma unroll
    for (int i = 0; i < 8; ++i) { const int kk = 8 * i + (lane >> 3); const f32x4 v = *(const f32x4*)(W + (size_t)(k0 + kk) * ldw + n0 + (lane & 7) * 4);
        float* s = scr + kk * 33 + (lane & 7) * 4; s[0] = v.x; s[1] = v.y; s[2] = v.z; s[3] = v.w; }
    asm volatile("s_waitcnt lgkmcnt(0)" ::: "memory");
    const int c = lane & 7;
#pragma unroll
    for (int j = 0; j < 4; ++j) { const int n = (lane >> 3) + 8 * j; const float* s = scr + (8 * c) * 33 + n;
        uint4 o; o.x = pk2(s[0 * 33], s[1 * 33]); o.y = pk2(s[2 * 33], s[3 * 33]); o.z = pk2(s[4 * 33], s[5 * 33]); o.w = pk2(s[6 * 33], s[7 * 33]);
        *(uint4*)(WT + (size_t)(n0 + n) * ldt + k0 + 8 * c) = o; }
    asm volatile("s_waitcnt lgkmcnt(0)" ::: "memory");
}
struct Params { const float* in[23]; float* out; unsigned char* ws; };
enum { I_X = 0, I_POS, I_MIXPRE, I_MIXPOST, I_FFNPRE, I_FFNPOST, I_MLA_WIN, I_MLA_QN, I_MLA_KVN, I_MLA_WUQ, I_MLA_WUKV, I_MLA_WO,
       I_LRU_WIN, I_LRU_CW, I_LRU_CB, I_LRU_WA, I_LRU_BA, I_LRU_WX, I_LRU_BX, I_LRU_LAM, I_LRU_WOUT, I_FFN_UP, I_FFN_DOWN };

__device__ __forceinline__ void prologue_weights(const __attribute__((address_space(4))) Params& p, float* scr, int gw, int NGW, int lane) {
    u16* wt = (u16*)p.ws;
    constexpr int IT_MLA = 352 + 288 + 256 + 512, IT_LRU = 1024 + 128 + 512, IT_FFN = 4096, TOTAL = 2 * IT_MLA + 2 * IT_LRU + 4 * IT_FFN;
    for (int it = gw; it < TOTAL; it += NGW) {
        int r = it; const float* W; int ldw, ldt, nblk; u16* WT;
        if (r < 2 * IT_MLA) { const int j = r / IT_MLA; r -= j * IT_MLA; u16* base = wt + WT_MLA(j) / 2;
            if (r < 352) { W = p.in[I_MLA_WIN] + (size_t)j * 1024 * 704; ldw = 704; nblk = 22; WT = base; ldt = 1024; }
            else if (r < 640) { r -= 352; W = p.in[I_MLA_WUQ] + (size_t)j * 384 * 1536; ldw = 1536; nblk = 48; WT = base + OFF_UQ / 2; ldt = 384; }
            else if (r < 896) { r -= 640; W = p.in[I_MLA_WUKV] + (size_t)j * 256 * 2048; ldw = 2048; nblk = 64; WT = base + OFF_UKV / 2; ldt = 256; }
            else { r -= 896; W = p.in[I_MLA_WO] + (size_t)j * 1024 * 1024; ldw = 1024; nblk = 32; WT = base + OFF_WO / 2; ldt = 1024; }
        } else if (r < 2 * IT_MLA + 2 * IT_LRU) { r -= 2 * IT_MLA; const int j = r / IT_LRU; r -= j * IT_LRU; u16* base = wt + WT_LRU(j) / 2;
            if (r < 1024) { W = p.in[I_LRU_WIN] + (size_t)j * 1024 * 2048; ldw = 2048; nblk = 64; WT = base; ldt = 1024; }
            else if (r < 1152) { r -= 1024; const int which = r >> 3, gt = which >> 3, n = which & 7; r &= 7;
                W = p.in[gt ? I_LRU_WX : I_LRU_WA] + (size_t)j * 8 * 128 * 128 + (size_t)n * 128 * 128; ldw = 128; nblk = 4;
                WT = base + OFF_GT / 2 + (size_t)(n * 256 + gt * 128) * 256 + 128 * (n & 1); ldt = 256; }
            else { r -= 1152; W = p.in[I_LRU_WOUT] + (size_t)j * 1024 * 1024; ldw = 1024; nblk = 32; WT = base + OFF_LOUT / 2; ldt = 1024; }
        } else { r -= 2 * IT_MLA + 2 * IT_LRU; const int l = r / IT_FFN; r -= l * IT_FFN; u16* base = wt + WT_FFN(l) / 2;
            if (r < 2048) { W = p.in[I_FFN_UP] + (size_t)l * 1024 * 4096; ldw = 4096; nblk = 128; WT = base; ldt = 1024; }
            else { r -= 2048; W = p.in[I_FFN_DOWN] + (size_t)l * 4096 * 1024; ldw = 1024; nblk = 32; WT = base + OFF_DOWN / 2; ldt = 4096; }
        }
        transpose_item(W, ldw, WT, ldt, nblk, scr, r, lane);
    }
}
__device__ __forceinline__ void rowop(const u16* y, const float* xin, float* xout, u16* hn, float* rs, const float* gpost, const float* gpre, int gw, int NGW, int lane) {
    f32x4 gp[4], gq[4];
#pragma unroll
    for (int j = 0; j < 4; ++j) { gp[j] = gpost ? *(const f32x4*)(gpost + j * 256 + lane * 4) : (f32x4){0.f, 0.f, 0.f, 0.f}; gq[j] = gpre ? *(const f32x4*)(gpre + j * 256 + lane * 4) : (f32x4){0.f, 0.f, 0.f, 0.f}; }
    for (int row = gw; row < M; row += NGW) {
        f32x4 xv[4];
#pragma unroll
        for (int j = 0; j < 4; ++j) xv[j] = *(const f32x4*)(xin + (size_t)row * D + j * 256 + lane * 4);
        if (y) {
            f32x4 yv[4]; float ss = 0.f;
#pragma unroll
            for (int j = 0; j < 4; ++j) { const uint2 w = *(const uint2*)(y + (size_t)row * D + j * 256 + lane * 4);
                yv[j] = (f32x4){bflo(w.x), bfhi(w.x), bflo(w.y), bfhi(w.y)}; ss += (yv[j].x * yv[j].x + yv[j].y * yv[j].y) + (yv[j].z * yv[j].z + yv[j].w * yv[j].w); }
            const float r = rsqrtf(wave_sum(ss) * (1.f / D) + EPS);
#pragma unroll
            for (int j = 0; j < 4; ++j) xv[j] = xv[j] + (yv[j] * r) * gp[j];
        }
        if (xout) {
#pragma unroll
        for (int j = 0; j < 4; ++j) *(f32x4*)(xout + (size_t)row * D + j * 256 + lane * 4) = xv[j]; }
        if (gpre) {
            float s2 = 0.f;
#pragma unroll
            for (int j = 0; j < 4; ++j) s2 += (xv[j].x * xv[j].x + xv[j].y * xv[j].y) + (xv[j].z * xv[j].z + xv[j].w * xv[j].w);
            const float tot2 = wave_sum(s2); const float r2 = 1.0f;
            if (rs && lane < 4) rs[(size_t)row * 4 + lane] = lane == 0 ? tot2 : 0.f;
#pragma unroll
            for (int j = 0; j < 4; ++j) { const f32x4 h = (xv[j] * r2) * gq[j]; uint2 w; w.x = pk2(h.x, h.y); w.y = pk2(h.z, h.w);
                *(uint2*)(hn + (size_t)row * D + j * 256 + lane * 4) = w; }
        }
    }
}
__device__ __forceinline__ void qkvnorm(const u16* proj, u16* cq, u16* ckv, u16* kr, const float* qn, const float* kvn, const float* ctab, const float* stab, const float* rss, int gw, int NGW, int lane) {
    float gA[8], gB[8];
    { const float* gp = lane < 48 ? qn + 8 * lane : kvn + (8 * lane - 384); const f32x4 g0 = *(const f32x4*)gp, g1 = *(const f32x4*)(gp + 4);
      gA[0] = g0[0]; gA[1] = g0[1]; gA[2] = g0[2]; gA[3] = g0[3]; gA[4] = g1[0]; gA[5] = g1[1]; gA[6] = g1[2]; gA[7] = g1[3]; }
    { f32x4 g0 = {0.f, 0.f, 0.f, 0.f}, g1 = {0.f, 0.f, 0.f, 0.f}; if (lane < 16) { g0 = *(const f32x4*)(kvn + 128 + 8 * lane); g1 = *(const f32x4*)(kvn + 132 + 8 * lane); }
      gB[0] = g0[0]; gB[1] = g0[1]; gB[2] = g0[2]; gB[3] = g0[3]; gB[4] = g1[0]; gB[5] = g1[1]; gB[6] = g1[2]; gB[7] = g1[3]; }
    const bool ropeL = lane >= 16 && lane < 24; const int rk = (lane & 3) * 8;
    const int cOff = lane < 20 ? 672 + rk : 640 + rk;
    for (int row0 = gw; row0 < M; row0 += 2 * NGW) {
        float A[2][8], B[2][8], C[2][8], rsc[2], sa[2], sb[2];
#pragma unroll
        for (int q = 0; q < 2; ++q) { const int row = row0 + q * NGW; const u16* pr = proj + (size_t)row * 768;
            const f32x4 pp = *(const f32x4*)(rss + (size_t)row * 4); rsc[q] = rsqrtf(((pp[0] + pp[1]) + (pp[2] + pp[3])) * (1.f / D) + EPS);
            const uint4 a = *(const uint4*)(pr + 8 * lane); uint4 b = make_uint4(0u, 0u, 0u, 0u), c = make_uint4(0u, 0u, 0u, 0u);
            if (lane < 24) b = *(const uint4*)(pr + 512 + 8 * lane);
            if (ropeL) c = *(const uint4*)(pr + cOff);
            A[q][0] = bflo(a.x); A[q][1] = bfhi(a.x); A[q][2] = bflo(a.y); A[q][3] = bfhi(a.y); A[q][4] = bflo(a.z); A[q][5] = bfhi(a.z); A[q][6] = bflo(a.w); A[q][7] = bfhi(a.w);
            B[q][0] = bflo(b.x); B[q][1] = bfhi(b.x); B[q][2] = bflo(b.y); B[q][3] = bfhi(b.y); B[q][4] = bflo(b.z); B[q][5] = bfhi(b.z); B[q][6] = bflo(b.w); B[q][7] = bfhi(b.w);
            C[q][0] = bflo(c.x); C[q][1] = bfhi(c.x); C[q][2] = bflo(c.y); C[q][3] = bfhi(c.y); C[q][4] = bflo(c.z); C[q][5] = bfhi(c.z); C[q][6] = bflo(c.w); C[q][7] = bfhi(c.w); }
#pragma unroll
        for (int q = 0; q < 2; ++q) { sa[q] = 0.f; sb[q] = 0.f;
#pragma unroll
            for (int e = 0; e < 8; ++e) { A[q][e] *= rsc[q]; B[q][e] *= rsc[q]; C[q][e] *= rsc[q]; sa[q] += A[q][e] * A[q][e]; sb[q] += B[q][e] * B[q][e]; } }
        float r1[2], r2[2];
#pragma unroll
        for (int q = 0; q < 2; ++q) { const float s1 = wave_sum(lane < 48 ? sa[q] : 0.f), s2 = wave_sum((lane >= 48 ? sa[q] : 0.f) + (lane < 16 ? sb[q] : 0.f));
            r1[q] = rsqrtf(s1 * (1.f / 384.f) + EPS); r2[q] = rsqrtf(s2 * (1.f / 256.f) + EPS); }
#pragma unroll
        for (int q = 0; q < 2; ++q) { const int row = row0 + q * NGW;
            { const float r = lane < 48 ? r1[q] : r2[q]; uint4 o; o.x = pk2(A[q][0] * r * gA[0], A[q][1] * r * gA[1]); o.y = pk2(A[q][2] * r * gA[2], A[q][3] * r * gA[3]);
              o.z = pk2(A[q][4] * r * gA[4], A[q][5] * r * gA[5]); o.w = pk2(A[q][6] * r * gA[6], A[q][7] * r * gA[7]);
              if (lane < 48) *(uint4*)(cq + (size_t)row * 384 + 8 * lane) = o; else *(uint4*)(ckv + (size_t)row * 256 + (8 * lane - 384)) = o; }
            if (lane < 16) { const float r = r2[q]; uint4 o; o.x = pk2(B[q][0] * r * gB[0], B[q][1] * r * gB[1]); o.y = pk2(B[q][2] * r * gB[2], B[q][3] * r * gB[3]);
              o.z = pk2(B[q][4] * r * gB[4], B[q][5] * r * gB[5]); o.w = pk2(B[q][6] * r * gB[6], B[q][7] * r * gB[7]);
              *(uint4*)(ckv + (size_t)row * 256 + 128 + 8 * lane) = o; }
            if (ropeL) { const f32x4 c0 = *(const f32x4*)(ctab + (size_t)row * 32 + rk), c1 = *(const f32x4*)(ctab + (size_t)row * 32 + rk + 4), s0 = *(const f32x4*)(stab + (size_t)row * 32 + rk), s1 = *(const f32x4*)(stab + (size_t)row * 32 + rk + 4);
              float ov[8];
#pragma unroll
              for (int e = 0; e < 8; ++e) { const float cc = e < 4 ? c0[e & 3] : c1[e & 3], ss = e < 4 ? s0[e & 3] : s1[e & 3];
                  ov[e] = lane < 20 ? B[q][e] * cc - C[q][e] * ss
                                    : B[q][e] * cc + C[q][e] * ss; }
              uint4 o; o.x = pk2(ov[0], ov[1]); o.y = pk2(ov[2], ov[3]); o.z = pk2(ov[4], ov[5]); o.w = pk2(ov[6], ov[7]);
              *(uint4*)(kr + (size_t)row * 64 + (lane < 20 ? 0 : 32) + rk) = o; }
        }
    }
}
__device__ __forceinline__ void qrope(u16* q, const float* ctab, const float* stab, int gw, int NGW, int lane) {
    for (int row = gw; row < M; row += NGW) {
        u16* qr = q + (size_t)row * 1536; const int i = lane & 31;
        const float c = ctab[(size_t)row * 32 + i], s = stab[(size_t)row * 32 + i];
#pragma unroll
        for (int j = 0; j < 4; ++j) { const int h = 2 * j + (lane >> 5); u16* pp = qr + h * 192 + 128 + i;
            const float x1 = bf1(pp[0]), x2 = bf1(pp[32]);
            pp[0] = (u16)f2bf(x1 * c - x2 * s); pp[32] = (u16)f2bf(x2 * c + x1 * s); }
    }
}
__device__ __forceinline__ void conv_phase(const u16* rec, u16* xc, const float* cw, const float* cb, int gtid, int NGT) {
    for (int idx = gtid; idx < (M / 32) * 128; idx += NGT) {
        const int r0 = (idx >> 7) * 32, c0 = (idx & 127) * 8;
        float w[4][8], bias[8], win[3][8];
#pragma unroll
        for (int e = 0; e < 8; ++e) { bias[e] = cb[c0 + e];
#pragma unroll
            for (int k = 0; k < 4; ++k) w[k][e] = cw[k * D + c0 + e]; }
        const bool first = (r0 & (SEQ - 1)) == 0;
#pragma unroll
        for (int k = 0; k < 3; ++k) { uint4 v = make_uint4(0u, 0u, 0u, 0u); if (!first) v = *(const uint4*)(rec + (size_t)(r0 - 3 + k) * D + c0);
            win[k][0] = bflo(v.x); win[k][1] = bfhi(v.x); win[k][2] = bflo(v.y); win[k][3] = bfhi(v.y); win[k][4] = bflo(v.z); win[k][5] = bfhi(v.z); win[k][6] = bflo(v.w); win[k][7] = bfhi(v.w); }
        for (int i0 = 0; i0 < 32; i0 += 8) {
            uint4 in[8];
#pragma unroll
            for (int u = 0; u < 8; ++u) in[u] = *(const uint4*)(rec + (size_t)(r0 + i0 + u) * D + c0);
#pragma unroll
            for (int u = 0; u < 8; ++u) {
                const float x[8] = {bflo(in[u].x), bfhi(in[u].x), bflo(in[u].y), bfhi(in[u].y), bflo(in[u].z), bfhi(in[u].z), bflo(in[u].w), bfhi(in[u].w)};
                float acc[8];
#pragma unroll
                for (int e = 0; e < 8; ++e) { acc[e] = bias[e] + win[0][e] * w[0][e] + win[1][e] * w[1][e] + win[2][e] * w[2][e] + x[e] * w[3][e]; win[0][e] = win[1][e]; win[1][e] = win[2][e]; win[2][e] = x[e]; }
                uint4 o; o.x = pk2(acc[0], acc[1]); o.y = pk2(acc[2], acc[3]); o.z = pk2(acc[4], acc[5]); o.w = pk2(acc[6], acc[7]);
                *(uint4*)(xc + (size_t)(r0 + i0 + u) * D + c0) = o;
            }
        }
    }
}
__device__ __forceinline__ void scanA(const u16* A, const u16* B, float* SA, float* SB, int tid) {
    for (int item = blockIdx.x; item < 2 * SCAN_NC; item += gridDim.x) {
        const int c = item % SCAN_NC, b = item / SCAN_NC, ch = 2 * tid;
        const size_t base = ((size_t)b * SEQ + (size_t)c * SCAN_L) * D + ch;
        float h0 = 0.f, h1 = 0.f, P0 = 1.f, P1 = 1.f;
        for (int t0 = 0; t0 < SCAN_L; t0 += 32) {
            unsigned aw[32], bw[32];
#pragma unroll
            for (int u = 0; u < 32; ++u) { aw[u] = *(const unsigned*)(A + base + (size_t)(t0 + u) * D); bw[u] = *(const unsigned*)(B + base + (size_t)(t0 + u) * D); }
#pragma unroll
            for (int u = 0; u < 32; ++u) { const float a0 = __expf(bflo(aw[u])), a1 = __expf(bfhi(aw[u])); h0 = a0 * h0 + bflo(bw[u]); h1 = a1 * h1 + bfhi(bw[u]); P0 *= a0; P1 *= a1; }
        }
        const size_t so = ((size_t)b * SCAN_NC + c) * D + ch;
        *(float2*)(SA + so) = make_float2(P0, P1); *(float2*)(SB + so) = make_float2(h0, h1);
    }
}
__device__ __forceinline__ void scanC(const u16* A, const u16* B, const float* SA, const float* SB, const u16* gate, u16* hg, int tid) {
    for (int item = blockIdx.x; item < 2 * SCAN_NC; item += gridDim.x) {
        const int c = item % SCAN_NC, b = item / SCAN_NC, ch = 2 * tid;
        const size_t base = ((size_t)b * SEQ + (size_t)c * SCAN_L) * D + ch;
        float h0 = 0.f, h1 = 0.f;
        for (int cc0 = 0; cc0 < c; cc0 += 16) {
            float2 pa[16], pb[16];
#pragma unroll
            for (int u = 0; u < 16; ++u) { const int cc = cc0 + u < c ? cc0 + u : c - 1; const size_t so = ((size_t)b * SCAN_NC + cc) * D + ch; pa[u] = *(const float2*)(SA + so); pb[u] = *(const float2*)(SB + so); }
#pragma unroll
            for (int u = 0; u < 16; ++u) { const bool in = cc0 + u < c; const float ax = in ? pa[u].x : 1.f, ay = in ? pa[u].y : 1.f, bx = in ? pb[u].x : 0.f, by = in ? pb[u].y : 0.f; h0 = ax * h0 + bx; h1 = ay * h1 + by; }
        }
        for (int t0 = 0; t0 < SCAN_L; t0 += 16) {
            unsigned aw[16], bw[16], gv[16];
#pragma unroll
            for (int u = 0; u < 16; ++u) { aw[u] = *(const unsigned*)(A + base + (size_t)(t0 + u) * D); bw[u] = *(const unsigned*)(B + base + (size_t)(t0 + u) * D); gv[u] = *(const unsigned*)(gate + base + (size_t)(t0 + u) * D); }
#pragma unroll
            for (int u = 0; u < 16; ++u) { h0 = __expf(bflo(aw[u])) * h0 + bflo(bw[u]); h1 = __expf(bfhi(aw[u])) * h1 + bfhi(bw[u]);
                *(unsigned*)(hg + base + (size_t)(t0 + u) * D) = pk2(bflo(gv[u]) * h0, bfhi(gv[u]) * h1); }
        }
    }
}

constexpr int LDS_GEMM = pg8::STAGE_BYTES + 8192, LDS_MAIN = att::LDS_BYTES > LDS_GEMM ? att::LDS_BYTES : LDS_GEMM, LDS_BYTES = LDS_MAIN + 16;
constexpr size_t WS_BAR = 106 * MB;
constexpr size_t WS_CNT1 = WS_BAR + 16384, WS_CNT2 = WS_BAR + 49152, CTL_BYTES = 81920, WS_XS1 = 107 * MB, WS_XS2 = 107 * MB + MB / 2;
constexpr int XL_OFF = 131072;
static_assert(XL_OFF + 8192 <= LDS_MAIN && XCD_BAR_WORDS * 4 <= 16384 && att::LDS_BYTES <= LDS_MAIN && pg8::STAGE_BYTES <= LDS_MAIN && LDS_BYTES <= 160 * 1024, "LDS map");

__global__ void __launch_bounds__(512, 2) fwd_mega(Params p_arg) {
    extern __shared__ __attribute__((aligned(16))) unsigned char lds[];
    cg::grid_group grid = cg::this_grid();
    (void)p_arg;
    volatile __attribute__((address_space(3))) unsigned* bst = (volatile __attribute__((address_space(3))) unsigned*)((__attribute__((address_space(3))) unsigned char*)lds + LDS_MAIN);
    if (threadIdx.x < 4) bst[threadIdx.x] = 0u;
    __syncthreads();
    const int wave_s = __builtin_amdgcn_readfirstlane(threadIdx.x >> 6);
    const unsigned bar_x = xb::xb_xcc_id();
    (void)xb::xcd_barrier_post((unsigned*)(p_arg.ws + WS_BAR), bst);
#define GRID_BAR() do { unsigned bx_ = bar_x; asm volatile("" : "+s"(bx_)); xb::XcdBarrier bb_; bb_.bar = (unsigned*)(ws + WS_BAR); bb_.x = bx_; bb_.st = bst; xb::xcd_barrier(bb_, tid == 0); } while (0)
    typedef const __attribute__((address_space(4))) Params* KParams;
    KParams pp = (KParams)__builtin_amdgcn_kernarg_segment_ptr();
#define FRESH() int tid_ = wave_s * 64 + lane_id_fresh(); asm volatile("" : "+v"(tid_)); asm volatile("" : "+s"(pp)); const __attribute__((address_space(4))) Params& p = *pp; \
    const int tid = tid_, lane = tid & 63, wave = __builtin_amdgcn_readfirstlane(tid >> 6); \
    const int G = gridDim.x, gw = blockIdx.x * 8 + wave, NGW = G * 8, gtid = blockIdx.x * 512 + tid, NGT = G * 512; \
    unsigned char* ws = p.ws; float* x = p.out; u16* hn = (u16*)(ws + WS_HN); u16* ybuf = (u16*)(ws + WS_Y); unsigned char* U = ws + WS_U; \
    float* ctab = (float*)(ws + WS_COS); float* stab = (float*)(ws + WS_SIN); float* SA = (float*)(ws + WS_SA); float* SB = (float*)(ws + WS_SB); \
    (void)lane; (void)wave; (void)gw; (void)NGW; (void)gtid; (void)NGT; (void)x; (void)hn; (void)ybuf; (void)U; (void)ctab; (void)stab; (void)SA; (void)SB;
    {
    FRESH();

    for (int prep = 0; prep < PROBE_PRO_REPS; ++prep) {
    prologue_weights(p, (float*)lds + wave * (64 * 33), gw, NGW, lane);
    for (int i = gtid; i < 2 * 2048 * 16; i += NGT) { const int j = i >> 15, row = (i >> 4) & 2047, chn = i & 15, n = row >> 8;
        *(uint4*)((u16*)(ws + WT_LRU(j) + OFF_GT) + (size_t)row * 256 + 128 * ((n & 1) ^ 1) + chn * 8) = make_uint4(0u, 0u, 0u, 0u); }
    { const int* pos = (const int*)p.in[I_POS];
      for (int i = gtid; i < M * 32; i += NGT) { const int row = i >> 5, f = i & 31;
        const float inv = __builtin_amdgcn_exp2f(-(float)f * (13.287712379549449f / 32.f));
        const float ang = (float)pos[row] * inv;
        double rev = (double)ang * 0.15915494309189535; rev -= __builtin_rint(rev);
        ctab[i] = __builtin_amdgcn_cosf((float)rev); stab[i] = __builtin_amdgcn_sinf((float)rev); } }
    rowop(nullptr, p.in[I_X], nullptr, hn, (float*)(ws + WS_XSB), nullptr, p.in[I_MIXPRE], gw, NGW, lane);
    }
    if (ws == nullptr) grid.sync();
    GRID_BAR();
    }

#pragma nounroll
    for (int layer = 0; layer < 4; ++layer) {
#pragma nounroll
        for (int op = 0; op < 10; ++op) {
            FRESH();
            const int j = layer >> 1; const bool lru = (layer & 1) != 0;
            const u16* wtm = (const u16*)(ws + WT_MLA(j)); const u16* wtl = (const u16*)(ws + WT_LRU(j)); const u16* wtf = (const u16*)(ws + WT_FFN(layer));
            int gk = 0;
            pg8::Gemm g{}; pg8::EpiB E{};
            if (op == 6 || op == 9) continue;
            const float* gprev = p.in[op == 5 ? I_MIXPRE : I_FFNPRE] + layer * D;
            const float* gpost = p.in[op == 5 ? I_MIXPOST : I_FFNPOST] + layer * D;
            const float* gpre = op == 5 ? p.in[I_FFNPRE] + layer * D : (layer < 3 ? p.in[I_MIXPRE] + (layer + 1) * D : nullptr);
            if (op == 7) { gk = 1; g = pg8::Gemm{hn, wtf, M, 4096, 1024, 1024, 1024, 0}; E = pg8::EpiB{(u16*)U, 4096, 0, 0, 1, nullptr}; }
            else if (op == 8) { gk = 3; g = pg8::Gemm{(const u16*)U, wtf + OFF_DOWN / 2, M, 1024, 4096, 4096, 4096, 0}; }
            else if (!lru) {
                u16* proj = (u16*)(U + U_PROJ); u16* cq = (u16*)(U + U_CQ); u16* ckv = (u16*)(U + U_CKV); u16* kr = (u16*)(U + U_KR); u16* q = (u16*)(U + U_Q); u16* o = (u16*)(U + U_O); u16* kv = ybuf;
                if (op == 0) { gk = 1; g = pg8::Gemm{hn, wtm, M, 768, 1024, 1024, 1024, 0}; E = pg8::EpiB{proj, 768, 0, 0, 0, nullptr}; }
                else if (op == 1) for (int rep = 0; rep < PROBE_THIN_REPS; ++rep) qkvnorm(proj, cq, ckv, kr, p.in[I_MLA_QN] + j * 384, p.in[I_MLA_KVN] + j * 256, ctab, stab, (const float*)(ws + WS_XSB), gw, NGW, lane);
                else if (op == 2) { gk = 1; g = pg8::Gemm{cq, wtm + OFF_UQ / 2, M, 1536, 384, 384, 384, 0}; E = pg8::EpiB{q, 1536, 0, 0, 0, nullptr}; }
                else if (op == 3) { gk = 1; g = pg8::Gemm{ckv, wtm + OFF_UKV / 2, M, 2048, 256, 256, 256, 0}; E = pg8::EpiB{kv, 2048, 0, 0, 0, nullptr}; }
                else if (op == 4) { const att::Tensors T{q, kv, kr, o, ctab, stab}; for (int rep = 0; rep < PROBE_ATT_REPS; ++rep) att::attn_phase((char*)lds, T, tid); }
                else { gk = 3; g = pg8::Gemm{o, wtm + OFF_WO / 2, M, 1024, 1024, 1024, 1024, 0}; }
            } else {
                u16* gate = (u16*)(U + U_GATE); u16* xc = (u16*)(U + U_XC); u16* rec = (u16*)(U + U_REC); u16* Bb = (u16*)(U + U_B); u16* Ab = (u16*)(U + U_LA); u16* hg = xc;
                if (op == 0) { gk = 1; g = pg8::Gemm{hn, wtl, M, 2048, 1024, 1024, 1024, 0}; E = pg8::EpiB{gate, 1024, 1024, (size_t)(U_REC - U_GATE) / 2, 2, (const float*)(ws + WS_XSB)}; }
                else if (op == 1) for (int rep = 0; rep < PROBE_THIN_REPS; ++rep) conv_phase(rec, xc, p.in[I_LRU_CW] + j * 4 * D, p.in[I_LRU_CB] + j * D, gtid, NGT);
                else if (op == 2) { gk = 2; g = pg8::Gemm{xc, wtl + OFF_GT / 2, M, 2048, 256, 1024, 256, 512}; }
                else if (op == 3) for (int rep = 0; rep < PROBE_THIN_REPS; ++rep) scanA(Ab, Bb, SA, SB, tid);
                else if (op == 4) for (int rep = 0; rep < PROBE_THIN_REPS; ++rep) scanC(Ab, Bb, SA, SB, gate, hg, tid);
                else { gk = 3; g = pg8::Gemm{hg, wtl + OFF_LOUT / 2, M, 1024, 1024, 1024, 1024, 0}; }
            }
            if (STAGGER_TICKS > 0 && op == 7) {
                unsigned bx_ = bar_x; asm volatile("" : "+s"(bx_));
                const unsigned long long t0_ = __builtin_amdgcn_s_memrealtime(), want_ = (unsigned long long)(bx_ & 7u) * STAGGER_TICKS;
                while (__builtin_amdgcn_s_memrealtime() - t0_ < want_) __builtin_amdgcn_s_sleep(8); }
            for (int rep = 0; rep < ((gk != 3 && (PROBE_GEMM_OP == -1 || op == PROBE_GEMM_OP || (PROBE_GEMM_OP == -2 && op != 7))) ? PROBE_GEMM_REPS : 1); ++rep)
            if (gk == 1) { pg8::StaticOrder S; S.init(g.M, g.N, G, (int)blockIdx.x);
                pg8::gemm_phase<pg8::EpiB, pg8::StaticOrder, true>((PG8_LAS unsigned char*)lds, g, S, E, tid); }
            else if (gk == 2) { pg8::StaticOrder S; S.init(g.M, g.N, G, (int)blockIdx.x);
                const pg8::EpiGate EG{(const u16*)(U + U_XC), (u16*)(U + U_LA), (u16*)(U + U_B), p.in[I_LRU_BA] + j * D, p.in[I_LRU_BX] + j * D, p.in[I_LRU_LAM] + j * D};
                pg8::gemm_phase<pg8::EpiGate, pg8::StaticOrder, true>((PG8_LAS unsigned char*)lds, g, S, EG, tid); }
            else if (gk == 3) { pg8::StaticOrder S; S.init(g.M, g.N, G, (int)blockIdx.x);
                const unsigned target = 32u * (unsigned)(layer * 2 + (op == 8 ? 2 : 1));
                const pg8::RowStats st1{(float*)(ws + WS_XS1), (unsigned*)(ws + WS_CNT1), target};
                const pg8::EpiNormRes EN{hn, (float*)(ws + (op == 8 ? WS_XSB : WS_XSA)), x, gprev, gpost, gpre, st1, (PG8_LAS unsigned char*)lds + XL_OFF, op == 8 ? (const float*)(ws + WS_XSA) : nullptr};
                pg8::gemm_phase<pg8::EpiNormRes, pg8::StaticOrder, true>((PG8_LAS unsigned char*)lds, g, S, EN, tid); }
            if (!(layer == 3 && op == 8) && !(!lru && op == 2)) { for (int rep = 0; rep < PROBE_SYNC_REPS; ++rep) GRID_BAR(); }
        }
    }
}
}

extern "C" void kernel_launch(void* const* d_in, const int* in_sizes, int n_in, void* d_out, int out_size, void* d_ws, size_t ws_size, hipStream_t stream) {
    static int grid = 0;
    if (grid == 0) {
        if (n_in != 23 || in_sizes[0] != mk::M * mk::D || out_size != mk::M * mk::D || ws_size < mk::WS_END) {
            fprintf(stderr, "kernel_launch: unexpected shapes (n_in %d, in0 %d, out %d, ws %zu); nothing launched\n", n_in, n_in > 0 ? in_sizes[0] : -1, out_size, ws_size); grid = -1; return; }
        int dev = 0, cus = 0, per_cu = 0;
        (void)hipGetDevice(&dev); (void)hipDeviceGetAttribute(&cus, hipDeviceAttributeMultiprocessorCount, dev);
        if (hipFuncSetAttribute((const void*)mk::fwd_mega, hipFuncAttributeMaxDynamicSharedMemorySize, mk::LDS_BYTES) != hipSuccess) { fprintf(stderr, "kernel_launch: hipFuncSetAttribute failed\n"); grid = -1; return; }
        if (hipOccupancyMaxActiveBlocksPerMultiprocessor(&per_cu, (const void*)mk::fwd_mega, 512, mk::LDS_BYTES) != hipSuccess || per_cu < 1) { fprintf(stderr, "kernel_launch: occupancy query says %d blocks per CU\n", per_cu); per_cu = 1; }
        (void)hipGetLastError();
        grid = cus > 0 ? cus : 256;
    }
    if (grid < 0) return;
    mk::Params p{};
    for (int i = 0; i < 23; ++i) p.in[i] = (const float*)d_in[i];
    p.out = (float*)d_out; p.ws = (unsigned char*)d_ws;
    if (hipMemsetAsync((char*)d_ws + mk::WS_BAR, 0, mk::CTL_BYTES, stream) != hipSuccess) { fprintf(stderr, "kernel_launch: hipMemsetAsync failed\n"); return; }
    void* args[] = {&p};
    hipError_t e = hipLaunchCooperativeKernel((const void*)mk::fwd_mega, dim3(grid), dim3(512), args, mk::LDS_BYTES, stream);
    if (e != hipSuccess) fprintf(stderr, "kernel_launch: cooperative launch failed: %s (grid %d)\n", hipGetErrorString(e), grid);
}
```

```cpp
#include <hip/hip_runtime.h>
#include <hip/hip_bf16.h>
#include <hip/hip_cooperative_groups.h>
#include <cstdio>
#include <cstdint>
namespace cg = cooperative_groups;

__device__ __forceinline__ float xor1f(float v)  { return __int_as_float(__builtin_amdgcn_mov_dpp(__float_as_int(v), 0xB1, 0xF, 0xF, false)); }
__device__ __forceinline__ float xor2f(float v)  { return __int_as_float(__builtin_amdgcn_mov_dpp(__float_as_int(v), 0x4E, 0xF, 0xF, false)); }
__device__ __forceinline__ float xor4f(float v)  { return __int_as_float(__builtin_amdgcn_ds_swizzle(__float_as_int(v), 0x101F)); }
__device__ __forceinline__ float xor8f(float v)  { return __int_as_float(__builtin_amdgcn_ds_swizzle(__float_as_int(v), 0x201F)); }
__device__ __forceinline__ float xor16f(float v) { return __int_as_float(__builtin_amdgcn_ds_swizzle(__float_as_int(v), 0x401F)); }
__device__ __forceinline__ float sum32f(float v) { auto rr = __builtin_amdgcn_permlane32_swap(__float_as_uint(v), __float_as_uint(v), false, false); return __uint_as_float(rr[0]) + __uint_as_float(rr[1]); }
__device__ __forceinline__ int lane_id_fresh() { int l; asm volatile("v_mbcnt_lo_u32_b32 %0, -1, 0\n\tv_mbcnt_hi_u32_b32 %0, -1, %0" : "=v"(l)); return l; }
namespace pg8 {
#define PG8_LAS __attribute__((address_space(3)))
typedef unsigned short bf16_t;
typedef short bf16x8 __attribute__((ext_vector_type(8)));
typedef float f32x4 __attribute__((ext_vector_type(4)));
typedef unsigned u32x4 __attribute__((ext_vector_type(4)));
constexpr int BM = 256, BK = 64, HALF = 128, HTB = HALF * BK * 2  , STAGE_BYTES = 8 * HTB, NXCD = 8, WGM = 8;

__host__ __device__ __forceinline__ int lds_byte(int r, int c) { const int st = (r >> 4) * 2 + (c >> 5), rr = r & 15, cc = c & 31, ob = rr * 64 + cc * 2; return st * 1024 + (ob ^ (((ob >> 9) & 1) << 5)); }
__host__ __device__ __forceinline__ void stage_rc(int b, int& R, int& C) { const int st = b / 1024, sb = b % 1024, swz = sb ^ (((sb >> 9) & 1) << 5); R = (st >> 1) * 16 + swz / 64; C = (st & 1) * 32 + (swz % 64) / 2; }
__host__ __device__ __forceinline__ int perm32(int rho) { const int n = rho >> 4, i = rho & 15; return 8 * (i >> 2) + 4 * n + (i & 3); }

struct Unit { int pm, pn; };
struct Gemm { const bf16_t* A; const bf16_t* Bt; int M, N, K; int lda, ldb; int apn; };

struct StaticOrder {
    int nM, nN, nwg, G, c;
    __host__ __device__ void init(int M, int N, int G_, int c_) { nM = M / BM; nN = N / BM; nwg = nM * nN; G = G_; c = c_; }
    __host__ __device__ bool next(int i, Unit& u) const {
        const long L = (long)i * G + c; if (L >= nwg) return false;
        int wgid = (int)L; { const int q = nwg / NXCD, r = nwg % NXCD, xcd = wgid % NXCD, off = wgid / NXCD; wgid = (xcd < r ? xcd * (q + 1) : r * (q + 1) + (xcd - r) * q) + off; }
        const int nig = WGM * nN, gid = wgid / nig, fm = gid * WGM, gsz = (nM - fm) < WGM ? (nM - fm) : WGM;
        u.pm = fm + ((wgid % nig) % gsz); u.pn = (wgid % nig) / gsz; return true;
    }
    __device__ __forceinline__ void a_ready(const Unit&) const {}
    __device__ __forceinline__ void done(const Unit&) const {}
};

__device__ __forceinline__ unsigned cvt_pk_bf16(float lo, float hi) { unsigned r; asm volatile("v_cvt_pk_bf16_f32 %0, %1, %2" : "=v"(r) : "v"(lo), "v"(hi)); return r; }
__device__ __forceinline__ float gelu_tanh(float x) {
    const float z = 0.7978845608028654f * (x + 0.044715f * x * x * x);
    const float e = __expf(2.0f * z);
    const float th = 1.0f - 2.0f * __builtin_amdgcn_rcpf(1.0f + e);
    return 0.5f * x * (1.0f + th);
}
struct EpiB {
    static constexpr bool PERM = true, AFTER_DRAIN = false, FUSED = false;
    bf16_t* O; int ldc; int split_cols; size_t split_stride; int mode;
    const float* rss;
    __device__ __forceinline__ void operator()(const f32x4 (&acc)[2][2][4][2], const Unit& u, int wr, int wc, int fr, int fq) const {
        const int row0 = u.pm * BM + wr * 64 + fr; int colt = u.pn * BM; bf16_t* base = O; int t = 0;
        if (split_cols) { t = colt / split_cols; base += (size_t)t * split_stride; colt -= t * split_cols; }
        const int act = (mode == 1) ? 1 : ((mode == 2 && t == 0) ? 2 : 0);
        const int col0 = colt + wc * 32 + 8 * fq;
#pragma unroll
        for (int ai = 0; ai < 2; ++ai)
#pragma unroll
            for (int m = 0; m < 4; ++m) { bf16_t* rowp = base + (size_t)(row0 + ai * HALF + m * 16) * ldc + col0;
                float rsc = 1.0f; if (rss) { const f32x4 pp = *(const f32x4*)(rss + (size_t)(row0 + ai * HALF + m * 16) * 4); rsc = rsqrtf(((pp[0] + pp[1]) + (pp[2] + pp[3])) * (1.0f / 1024.0f) + 1e-6f); }
#pragma unroll
                for (int bj = 0; bj < 2; ++bj) { f32x4 v0 = acc[ai][bj][m][0] * rsc, v1 = acc[ai][bj][m][1] * rsc;
                    if (act == 1) {
#pragma unroll
                        for (int e = 0; e < 4; ++e) { const float a = fmaxf(v0[e], 0.f), b = fmaxf(v1[e], 0.f); v0[e] = a * a; v1[e] = b * b; } }
                    else if (act == 2) {
#pragma unroll
                        for (int e = 0; e < 4; ++e) { v0[e] = gelu_tanh(v0[e]); v1[e] = gelu_tanh(v1[e]); } }
                    u32x4 w; w.x = cvt_pk_bf16(v0[0], v0[1]); w.y = cvt_pk_bf16(v0[2], v0[3]); w.z = cvt_pk_bf16(v1[0], v1[1]); w.w = cvt_pk_bf16(v1[2], v1[3]);
                    *(u32x4*)(rowp + bj * HALF) = w; } }
    }
};
__device__ __forceinline__ float bf2f(unsigned short h) { return __uint_as_float(((unsigned)h) << 16); }
__device__ __forceinline__ float sigmoidf_(float x) { return __builtin_amdgcn_rcpf(1.0f + __expf(-x)); }
__device__ __forceinline__ float one_minus_exp(float t) { const float ser = -t * (1.0f + t * (0.5f + t * (0.16666667f + t * (0.041666668f + t * 0.008333334f)))); return t > -0.25f ? ser : 1.0f - __expf(t); }
struct EpiGate {
    static constexpr bool PERM = false, AFTER_DRAIN = false, FUSED = false;
    const bf16_t* xc; bf16_t* Aout; bf16_t* Bout; const float* b_a; const float* b_x; const float* lam;
    __device__ __forceinline__ void operator()(const f32x4 (&acc)[2][2][4][2], const Unit& u, int wr, int wc, int fr, int fq) const {
#pragma unroll
        for (int n = 0; n < 2; ++n) {
            const int ch0 = 128 * u.pn + 32 * wc + 16 * n + 4 * fq;
            const f32x4 ba = *(const f32x4*)(b_a + ch0), bx = *(const f32x4*)(b_x + ch0), lm = *(const f32x4*)(lam + ch0);
            f32x4 sp;
#pragma unroll
            for (int e = 0; e < 4; ++e) sp[e] = -8.0f * log1pf(__expf(-lm[e]));
#pragma unroll
            for (int ai = 0; ai < 2; ++ai)
#pragma unroll
                for (int m = 0; m < 4; ++m) {
                    const size_t off = (size_t)(u.pm * BM + ai * HALF + wr * 64 + m * 16 + fr) * 1024 + ch0;
                    const uint2 xr = *(const uint2*)(xc + off);
                    float xv[4] = { __uint_as_float(xr.x << 16), __uint_as_float(xr.x & 0xffff0000u), __uint_as_float(xr.y << 16), __uint_as_float(xr.y & 0xffff0000u) };
                    f32x4 av, bv;
#pragma unroll
                    for (int e = 0; e < 4; ++e) {
                        const float r = sigmoidf_(acc[ai][0][m][n][e] + ba[e]);
                        const float ig = sigmoidf_(acc[ai][1][m][n][e] + bx[e]);
                        const float la = sp[e] * r;
                        av[e] = la;
                        bv[e] = __builtin_amdgcn_sqrtf(fmaxf(one_minus_exp(2.0f * la), 0.f)) * (ig * xv[e]);
                    }
                    uint2 wa, wb; wa.x = cvt_pk_bf16(av[0], av[1]); wa.y = cvt_pk_bf16(av[2], av[3]); wb.x = cvt_pk_bf16(bv[0], bv[1]); wb.y = cvt_pk_bf16(bv[2], bv[3]);
                    *(uint2*)(Aout + off) = wa; *(uint2*)(Bout + off) = wb;
                }
        }
    }
};

struct RowStats {
    float* xbuf;
    unsigned* cnt;
    unsigned target;
    __device__ __forceinline__ void run(const f32x4 (&v)[2][2][4][2], const Unit& u, int wr, int wc, int fr, int fq, PG8_LAS unsigned char* xl, int wid, int lane) const {
        PG8_LAS float* P = (PG8_LAS float*)xl;
        PG8_LAS float* S = (PG8_LAS float*)(xl + 4096);
#pragma unroll
        for (int ai = 0; ai < 2; ++ai)
#pragma unroll
            for (int m = 0; m < 4; ++m) {
                float s = 0.f;
#pragma unroll
                for (int bj = 0; bj < 2; ++bj)
#pragma unroll
                    for (int n = 0; n < 2; ++n) { const f32x4 x = v[ai][bj][m][n]; s += (x[0] * x[0] + x[1] * x[1]) + (x[2] * x[2] + x[3] * x[3]); }
                s += xor16f(s); s = sum32f(s);
                if (fq == 0) P[(ai * HALF + wr * 64 + m * 16 + fr) * 4 + wc] = s;
            }
        asm volatile("s_waitcnt lgkmcnt(0)" ::: "memory"); __builtin_amdgcn_s_barrier(); asm volatile("" ::: "memory");
        const int row = wid * 32 + (lane & 31);
        if (lane < 32) { const float t = (P[row * 4 + 0] + P[row * 4 + 1]) + (P[row * 4 + 2] + P[row * 4 + 3]);
            __hip_atomic_store(xbuf + (size_t)(u.pm * BM + row) * 4 + u.pn, t, __ATOMIC_RELAXED, __HIP_MEMORY_SCOPE_AGENT); }
        asm volatile("s_waitcnt vmcnt(0)" ::: "memory");
        if (lane == 0) __hip_atomic_fetch_add(cnt + 64 * u.pm, 1u, __ATOMIC_RELAXED, __HIP_MEMORY_SCOPE_AGENT);
        if (wid == 0) { unsigned sp = 0;
            while ((unsigned)__builtin_amdgcn_readfirstlane(__hip_atomic_load(cnt + 64 * u.pm, __ATOMIC_RELAXED, __HIP_MEMORY_SCOPE_AGENT)) < target) { __builtin_amdgcn_s_sleep(2); if (++sp > (1u << 18)) break; }
            __builtin_amdgcn_fence(__ATOMIC_ACQUIRE, "agent"); }
        asm volatile("s_waitcnt vmcnt(0) lgkmcnt(0)" ::: "memory"); __builtin_amdgcn_s_barrier(); asm volatile("" ::: "memory");
        if (lane < 32) { float* slot = xbuf + (size_t)(u.pm * BM + row) * 4; float t = 0.f;
#pragma unroll
            for (int k = 0; k < 4; ++k) t += __hip_atomic_load(slot + k, __ATOMIC_RELAXED, __HIP_MEMORY_SCOPE_AGENT);
            S[row] = t; }
        asm volatile("s_waitcnt lgkmcnt(0)" ::: "memory"); __builtin_amdgcn_s_barrier(); asm volatile("" ::: "memory");
    }
};
struct EpiNormRes {
    static constexpr bool PERM = false, AFTER_DRAIN = false, FUSED = true;
    bf16_t* hn; float* xs2; float* out; const float* gprev; const float* gpost; const float* gpre; RowStats st1; PG8_LAS unsigned char* xl;
    const float* s_in;
    __device__ __forceinline__ void fused(f32x4 (&acc)[2][2][4][2], const Unit& u, int wr, int wc, int fr, int fq, int wid, int lane) const {
        typedef unsigned u32x2v __attribute__((ext_vector_type(2)));
        PG8_LAS float* P = (PG8_LAS float*)xl;
        const PG8_LAS float* S = (const PG8_LAS float*)(xl + 4096);
        const int col0 = u.pn * BM + wc * 32 + 4 * fq;
        st1.run(acc, u, wr, wc, fr, fq, xl, wid, lane);
#pragma unroll
        for (int ai = 0; ai < 2; ++ai)
#pragma unroll
            for (int m = 0; m < 4; ++m) { const int r = ai * HALF + wr * 64 + m * 16 + fr; float rstd = rsqrtf(S[r] * (1.0f / 1024.0f) + 1e-6f); const size_t off = (size_t)(u.pm * BM + r) * 1024 + col0;
                if (s_in) { const f32x4 pp = *(const f32x4*)(s_in + (size_t)(u.pm * BM + r) * 4); const float s2 = __builtin_amdgcn_rcpf(((pp[0] + pp[1]) + (pp[2] + pp[3])) * (1.0f / 1024.0f) + 1e-6f);
                    rstd = rsqrtf(S[r] * (1.0f / 1024.0f) * s2 * s2 + 1e-6f) * s2; }
#pragma unroll
                for (int bj = 0; bj < 2; ++bj)
#pragma unroll
                    for (int n = 0; n < 2; ++n) { const u32x2v hw = *(const u32x2v*)(hn + off + bj * HALF + n * 16);
                        const f32x4 gp = *(const f32x4*)(gprev + col0 + bj * HALF + n * 16); const f32x4 gv = *(const f32x4*)(gpost + col0 + bj * HALF + n * 16);
                        f32x4 xs; xs[0] = __uint_as_float(hw.x << 16) * __builtin_amdgcn_rcpf(gp[0]); xs[1] = __uint_as_float(hw.x & 0xffff0000u) * __builtin_amdgcn_rcpf(gp[1]);
                        xs[2] = __uint_as_float(hw.y << 16) * __builtin_amdgcn_rcpf(gp[2]); xs[3] = __uint_as_float(hw.y & 0xffff0000u) * __builtin_amdgcn_rcpf(gp[3]);
                        acc[ai][bj][m][n] = xs + (acc[ai][bj][m][n] * rstd) * gv; }
                asm volatile("" : "+v"(acc[ai][0][m][0]), "+v"(acc[ai][0][m][1]), "+v"(acc[ai][1][m][0]), "+v"(acc[ai][1][m][1]));
                if (m & 1) asm volatile("" ::: "memory"); }
        if (gpre) {
#pragma unroll
            for (int ai = 0; ai < 2; ++ai)
#pragma unroll
                for (int m = 0; m < 4; ++m) {
                    float s = 0.f;
#pragma unroll
                    for (int bj = 0; bj < 2; ++bj)
#pragma unroll
                        for (int n = 0; n < 2; ++n) { const f32x4 x = acc[ai][bj][m][n]; s += (x[0] * x[0] + x[1] * x[1]) + (x[2] * x[2] + x[3] * x[3]); }
                    s += xor16f(s); s = sum32f(s);
                    if (fq == 0) P[(ai * HALF + wr * 64 + m * 16 + fr) * 4 + wc] = s;
                }
            asm volatile("s_waitcnt lgkmcnt(0)" ::: "memory"); __builtin_amdgcn_s_barrier(); asm volatile("" ::: "memory");
            { const int row = wid * 32 + (lane & 31);
              if (lane < 32) xs2[(size_t)(u.pm * BM + row) * 4 + u.pn] = (P[row * 4 + 0] + P[row * 4 + 1]) + (P[row * 4 + 2] + P[row * 4 + 3]); }
#pragma unroll
            for (int ai = 0; ai < 2; ++ai)
#pragma unroll
                for (int m = 0; m < 4; ++m) { const int r = ai * HALF + wr * 64 + m * 16 + fr; const size_t off = (size_t)(u.pm * BM + r) * 1024 + col0;
#pragma unroll
                    for (int bj = 0; bj < 2; ++bj)
#pragma unroll
                        for (int n = 0; n < 2; ++n) { const f32x4 gv = *(const f32x4*)(gpre + col0 + bj * HALF + n * 16); const f32x4 o = acc[ai][bj][m][n] * gv;
                            u32x2v w; w.x = cvt_pk_bf16(o[0], o[1]); w.y = cvt_pk_bf16(o[2], o[3]); *(u32x2v*)(hn + off + bj * HALF + n * 16) = w; }
                    asm volatile("" ::: "memory"); }
            asm volatile("s_waitcnt lgkmcnt(0)" ::: "memory"); __builtin_amdgcn_s_barrier(); asm volatile("" ::: "memory");
        } else {
#pragma unroll
            for (int ai = 0; ai < 2; ++ai)
#pragma unroll
                for (int m = 0; m < 4; ++m) { const int r = ai * HALF + wr * 64 + m * 16 + fr; const size_t off = (size_t)(u.pm * BM + r) * 1024 + col0;
#pragma unroll
                    for (int bj = 0; bj < 2; ++bj)
#pragma unroll
                        for (int n = 0; n < 2; ++n) *(f32x4*)(out + off + bj * HALF + n * 16) = acc[ai][bj][m][n]; }
        }
    }
};

template <class Epi, class Sched, bool ALIGN_EPI>
__device__ __forceinline__ void gemm_phase(PG8_LAS unsigned char* lds, const Gemm g, const Sched& S, const Epi& E, int tid0) {
    int tid_ = tid0; asm volatile("" : "+v"(tid_));
    const int tid = tid_, wid = __builtin_amdgcn_readfirstlane(tid >> 6), lane = tid & 63, wr = wid >> 2, wc = wid & 3, fr = lane & 15, fq = lane >> 4;
    const int K = g.K, nt = K / BK;
    unsigned voffA[2], voffB[2];
#pragma unroll
    for (int i = 0; i < 2; ++i) { int R, C; stage_rc(tid * 16 + i * 8192, R, C); const int Rb = Epi::PERM ? ((R & ~31) + perm32(R & 31)) : R;
        voffA[i] = (unsigned)(R * g.lda + C) * 2u; voffB[i] = (unsigned)(Rb * g.ldb + C) * 2u; }
    const size_t kstep = (size_t)(BK * 2);
    const size_t hstepA = (size_t)HALF * g.lda * 2, hstepB = (size_t)HALF * g.ldb * 2;
    const size_t tstepA = 2 * hstepA, tstepB = 2 * hstepB;
    const unsigned ldsw = (unsigned)wid * 1024u;
    const int aoff = lds_byte(wr * 64 + fr, fq * 8), boff = lds_byte(wc * 32 + fr, fq * 8);
#define PG8_SA(b, h) (((b) * 2 + (h)) * HTB)
#define PG8_SB(b, h) ((4 + (b) * 2 + (h)) * HTB)
#define PG8_STAGE(bufoff, gbase, voff) do { _Pragma("unroll") for (int _i = 0; _i < 2; ++_i) \
        __builtin_amdgcn_global_load_lds((const unsigned*)((const char*)(gbase) + (voff)[_i]), (PG8_LAS unsigned*)(lds + (bufoff) + ldsw + _i * 8192), 16, 0, 0); } while (0)
#define PG8_LDA(dst, b, h) do { _Pragma("unroll") for (int m = 0; m < 4; ++m) _Pragma("unroll") for (int k = 0; k < 2; ++k) dst[m][k] = *(const PG8_LAS bf16x8*)(lds + PG8_SA(b, h) + aoff + m * 2048 + k * 1024); } while (0)
#define PG8_LDB(dst, b, h) do { _Pragma("unroll") for (int n = 0; n < 2; ++n) _Pragma("unroll") for (int k = 0; k < 2; ++k) dst[n][k] = *(const PG8_LAS bf16x8*)(lds + PG8_SB(b, h) + boff + n * 2048 + k * 1024); } while (0)
#define PG8_MMA(ai, bj, At, Bt) do { __builtin_amdgcn_s_setprio(1); _Pragma("unroll") for (int m = 0; m < 4; ++m) _Pragma("unroll") for (int n = 0; n < 2; ++n) _Pragma("unroll") for (int k = 0; k < 2; ++k) \
        acc[ai][bj][m][n] = __builtin_amdgcn_mfma_f32_16x16x32_bf16(Bt[n][k], At[m][k], acc[ai][bj][m][n], 0, 0, 0); __builtin_amdgcn_s_setprio(0); } while (0)
#define PG8_WAIT_V(n) asm volatile("s_waitcnt vmcnt(" #n ")" ::: "memory")
#define PG8_WAIT_L(n) asm volatile("s_waitcnt lgkmcnt(" #n ")" ::: "memory")
#define PG8_BAR __builtin_amdgcn_s_barrier()
#define PG8_SCHED __builtin_amdgcn_sched_barrier(0)
    Unit cur, nxt; int ui = 0;
    if (!S.next(0, cur)) return;
    f32x4 acc[2][2][4][2];
#pragma unroll
    for (int a = 0; a < 2; ++a)
#pragma unroll
        for (int b = 0; b < 2; ++b)
#pragma unroll
            for (int m = 0; m < 4; ++m)
#pragma unroll
                for (int n = 0; n < 2; ++n) acc[a][b][m][n] = (f32x4){0.f, 0.f, 0.f, 0.f};
    bf16x8 At[4][2], B0[2][2], B1[2][2];
    const char* cA = (const char*)g.A + (size_t)cur.pm * tstepA + (size_t)(cur.pn >> 1) * (size_t)g.apn; const char* cB = (const char*)g.Bt + (size_t)cur.pn * tstepB;
    S.a_ready(cur);
    PG8_STAGE(PG8_SB(0, 0), cB, voffB); PG8_STAGE(PG8_SB(0, 1), cB + hstepB, voffB); PG8_STAGE(PG8_SA(0, 0), cA, voffA); PG8_STAGE(PG8_SA(0, 1), cA + hstepA, voffA);
    if (wr == 1) PG8_BAR;
    PG8_WAIT_V(2); PG8_BAR;
    PG8_STAGE(PG8_SB(1, 0), cB + kstep, voffB); PG8_STAGE(PG8_SA(1, 0), cA + kstep, voffA); PG8_STAGE(PG8_SB(1, 1), cB + hstepB + kstep, voffB);
    PG8_WAIT_V(6); PG8_BAR;
    for (;;) {
        const bool has_next = S.next(ui + 1, nxt);
        const char* nA = has_next ? (const char*)g.A + (size_t)nxt.pm * tstepA + (size_t)(nxt.pn >> 1) * (size_t)g.apn : cA; const char* nB = has_next ? (const char*)g.Bt + (size_t)nxt.pn * tstepB : cB;
        for (int t = 0; t < nt; t += 2) {
            const bool last = (t == nt - 2);
            const char* a1 = cA + (size_t)(t + 1) * kstep;
            const char* a2 = last ? nA : cA + (size_t)(t + 2) * kstep; const char* b2 = last ? nB : cB + (size_t)(t + 2) * kstep;
            const char* a3 = a2 + kstep; const char* b3 = b2 + kstep;
            if (last && has_next) S.a_ready(nxt);
            PG8_LDB(B0, 0, 0); PG8_LDB(B1, 0, 1); PG8_SCHED; PG8_LDA(At, 0, 0); PG8_STAGE(PG8_SA(1, 1), a1 + hstepA, voffA);
            PG8_WAIT_V(8); PG8_WAIT_L(0); PG8_BAR; PG8_MMA(0, 0, At, B0); PG8_MMA(0, 1, At, B1); PG8_BAR; PG8_SCHED;
            PG8_LDA(At, 0, 1); PG8_STAGE(PG8_SB(0, 0), b2, voffB); PG8_STAGE(PG8_SB(0, 1), b2 + hstepB, voffB); PG8_STAGE(PG8_SA(0, 0), a2, voffA);
            PG8_WAIT_V(8); PG8_WAIT_L(0); PG8_BAR; PG8_MMA(1, 0, At, B0); PG8_MMA(1, 1, At, B1); PG8_BAR; PG8_SCHED;
            PG8_LDB(B0, 1, 0); PG8_LDB(B1, 1, 1); PG8_SCHED; PG8_LDA(At, 1, 0); PG8_STAGE(PG8_SA(0, 1), a2 + hstepA, voffA);
            PG8_WAIT_V(8); PG8_WAIT_L(0); PG8_BAR; PG8_MMA(0, 0, At, B0); PG8_MMA(0, 1, At, B1); PG8_BAR; PG8_SCHED;
            PG8_LDA(At, 1, 1); PG8_STAGE(PG8_SB(1, 0), b3, voffB); PG8_STAGE(PG8_SB(1, 1), b3 + hstepB, voffB); PG8_STAGE(PG8_SA(1, 0), a3, voffA);
            PG8_WAIT_V(8); PG8_WAIT_L(0); PG8_BAR; PG8_MMA(1, 0, At, B0); PG8_MMA(1, 1, At, B1); PG8_BAR; PG8_SCHED;
        }
        if constexpr (ALIGN_EPI) { if (wr == 0) PG8_BAR; }
        if constexpr (Epi::FUSED) E.fused(acc, cur, wr, wc, fr, fq, wid, lane); else E(acc, cur, wr, wc, fr, fq);
        S.done(cur);
        if (!has_next) break;
#pragma unroll
        for (int a = 0; a < 2; ++a)
#pragma unroll
            for (int b = 0; b < 2; ++b)
#pragma unroll
                for (int m = 0; m < 4; ++m)
#pragma unroll
                    for (int n = 0; n < 2; ++n) acc[a][b][m][n] = (f32x4){0.f, 0.f, 0.f, 0.f};
        cur = nxt; cA = nA; cB = nB; ++ui;
        if constexpr (ALIGN_EPI) { if (wr == 1) PG8_BAR; }
    }
    PG8_WAIT_V(0);
    if constexpr (!ALIGN_EPI) { if (wr == 0) PG8_BAR; }
    PG8_BAR;
#undef PG8_SA
#undef PG8_SB
#undef PG8_STAGE
#undef PG8_LDA
#undef PG8_LDB
#undef PG8_MMA
#undef PG8_WAIT_V
#undef PG8_WAIT_L
#undef PG8_BAR
#undef PG8_SCHED
}
}
namespace att {
typedef unsigned short u16;
typedef short bf16x8 __attribute__((ext_vector_type(8)));
typedef short s16x4 __attribute__((ext_vector_type(4)));
typedef float f32x16 __attribute__((ext_vector_type(16)));
typedef float f32x4 __attribute__((ext_vector_type(4)));
typedef unsigned u32x4 __attribute__((ext_vector_type(4)));
constexpr int SEQ = 16384, NW = 8, QBLK = 32, KVBLK = 64, QB = NW * QBLK;
constexpr int LDQ = 1536, LDK = 2048, LDKR = 64, LDO = 1024;
#ifndef ATT_NQREG
#define ATT_NQREG 8
#endif
constexpr int NQREG = ATT_NQREG, NQREG_L = 8 - NQREG;
constexpr int SHM_V = KVBLK * 128 * 2, SHM_K = KVBLK * 128 * 2, SHM_KR = KVBLK * 64 * 2;
constexpr int OFF_V = 0, OFF_K = 2 * SHM_V, OFF_KR = OFF_K + 2 * SHM_K, OFF_WS = OFF_KR + 2 * SHM_KR, OFF_QR = OFF_WS + NW * 64 * 4, QR_WAVE = (NQREG_L + 4) * 1024, LDS_BYTES = OFF_QR + NW * QR_WAVE;
constexpr float SCALE = 0.07216878364870322f;
constexpr float THR = 8.f;

#define KSWZ(row, colB) ((row) * 256 + ((colB) ^ (((row) & 7) << 4)))
#define KRSWZ(row, colB) ((row) * 128 + ((colB) ^ (((row) & 7) << 4)))
#define SBAR() __builtin_amdgcn_sched_barrier(0)
__device__ __forceinline__ int v_st(int k, int c) { const int kk = (k & ~0xC) | ((k & 4) << 1) | ((k & 8) >> 1); return ((kk >> 3) * 4 + (c >> 5)) * 512 + ((kk & 7) * 32 + (c & 31)) * 2; }
__device__ __forceinline__ int v_rd_base(int lane) { return ((lane & 3) << 3) | (((lane >> 2) & 3) << 6) | (((lane >> 4) & 1) << 5) | (((lane >> 5) & 1) << 8); }
constexpr int v_rd_off(int d0, int ks, int half) { return d0 * 512 + ks * 4096 + half * 2048; }
__device__ __forceinline__ int crow(int r, int hi) { return (r & 3) + 8 * (r >> 2) + 4 * hi; }
__device__ __forceinline__ unsigned cvtpk(float lo, float hi) { unsigned r; asm volatile("v_cvt_pk_bf16_f32 %0, %1, %2" : "=v"(r) : "v"(lo), "v"(hi)); return r; }
__device__ __forceinline__ bf16x8 load8(const u16* p) { return *reinterpret_cast<const bf16x8*>(p); }
__device__ __forceinline__ void mask_tile(f32x16& p0, f32x16& p1, int dq, unsigned W) {
    const float NEG = -__builtin_inff();
#pragma unroll
    for (int r = 0; r < 16; ++r) {
        const int c = (r & 3) + 8 * (r >> 2);
        if ((unsigned)(dq - c) >= W) p0[r] = NEG;
        if ((unsigned)(dq - c - 32) >= W) p1[r] = NEG;
    }
}
__device__ __forceinline__ void partialSM(f32x16& p0, f32x16& p1, float& m_reg, float& mn, float& alpha) {
    float pmax = p0[0]; for (int r = 1; r < 16; ++r) pmax = fmaxf(pmax, p0[r]); for (int r = 0; r < 16; ++r) pmax = fmaxf(pmax, p1[r]);
    { auto rr = __builtin_amdgcn_permlane32_swap(__float_as_uint(pmax), __float_as_uint(pmax), false, false);
      pmax = fmaxf(__uint_as_float(rr[0]), __uint_as_float(rr[1])); }
    constexpr float C2 = 1.4426950408889634f * SCALE;
    if (__builtin_expect(__all((pmax - m_reg) * SCALE <= THR), 1)) { mn = m_reg; alpha = 1.f; }
    else { mn = fmaxf(m_reg, pmax); alpha = __builtin_amdgcn_exp2f((m_reg - mn) * C2); m_reg = mn; }
    const float mnL = -mn * C2;
    for (int r = 0; r < 16; ++r) p0[r] = fmaf(p0[r], C2, mnL); for (int r = 0; r < 16; ++r) p1[r] = fmaf(p1[r], C2, mnL);
}
__device__ __forceinline__ void finishSM(f32x16& p0, f32x16& p1, float alpha, float& l_reg, bf16x8& pa0, bf16x8& pa1, bf16x8& pa2, bf16x8& pa3) {
    for (int r = 0; r < 16; ++r) p0[r] = __builtin_amdgcn_exp2f(p0[r]);
    for (int r = 0; r < 16; ++r) p1[r] = __builtin_amdgcn_exp2f(p1[r]);
    float ps = 0; for (int r = 0; r < 16; ++r) ps += p0[r]; for (int r = 0; r < 16; ++r) ps += p1[r];
    { auto rr = __builtin_amdgcn_permlane32_swap(__float_as_uint(ps), __float_as_uint(ps), false, false);
      ps = __uint_as_float(rr[0]) + __uint_as_float(rr[1]); }
    l_reg = l_reg * alpha + ps;
#define PK4(P, B_, OUT) do { unsigned a0 = cvtpk(P[B_+0], P[B_+1]), a1 = cvtpk(P[B_+2], P[B_+3]);                          \
        unsigned b0 = cvtpk(P[B_+4], P[B_+5]), b1 = cvtpk(P[B_+6], P[B_+7]);                                             \
          \
          \
        u32x4 w = {a0, a1, b0, b1}; OUT = *reinterpret_cast<bf16x8*>(&w); } while (0)
    PK4(p0, 0, pa0); PK4(p0, 8, pa1); PK4(p1, 0, pa2); PK4(p1, 8, pa3);
#undef PK4
}
#ifndef ATT_PF
#define ATT_PF 1
#endif
#define QK_SB() __builtin_amdgcn_sched_barrier(0x406)
#define QK_LOAD(s, SET) do { if ((s) < 8) { const char* a_ = kb[(s) & 3] + ((s) >> 2) * 128; fb0[SET] = *reinterpret_cast<const bf16x8*>(a_); fb1[SET] = *reinterpret_cast<const bf16x8*>(a_ + 32 * 256); \
            if ((s) < NQREG) fq[SET] = qr[(s) < NQREG ? (s) : 0]; else fq[SET] = qrl[((s) - NQREG) * 64]; } \
        else { const char* a_ = krb[((s) - 8) & 3]; fb0[SET] = *reinterpret_cast<const bf16x8*>(a_); fb1[SET] = *reinterpret_cast<const bf16x8*>(a_ + 32 * 128); fq[SET] = qrl[(NQREG_L + (s) - 8) * 64]; } } while (0)
template <int KB>
__device__ __forceinline__ void qkt(f32x16& p0, f32x16& p1, const char* K_lds, const char* KR_lds, const bf16x8* qrl, int r32, int hi, const bf16x8* qr) {
    constexpr int PF = ATT_PF, NS = PF + 1;
    p0 = f32x16{}; p1 = f32x16{};
    const char* kb[4]; const char* krb[4];
#pragma unroll
    for (int dd = 0; dd < 4; ++dd) { kb[dd] = K_lds + KB * SHM_K + KSWZ(r32, (dd * 16 + hi * 8) * 2); krb[dd] = KR_lds + KB * SHM_KR + KRSWZ(r32, (dd * 16 + hi * 8) * 2); }
    bf16x8 fb0[NS], fb1[NS], fq[NS];
#pragma unroll
    for (int s = 0; s < PF; ++s) QK_LOAD(s, s % NS);
#pragma unroll
    for (int s = 0; s < 12; ++s) {
        QK_SB();
        if (s + PF < 12) QK_LOAD(s + PF, (s + PF) % NS);
        QK_SB();
        p0 = __builtin_amdgcn_mfma_f32_32x32x16_bf16(fb0[s % NS], fq[s % NS], p0, 0, 0, 0);
        p1 = __builtin_amdgcn_mfma_f32_32x32x16_bf16(fb1[s % NS], fq[s % NS], p1, 0, 0, 0);
    }
    QK_SB();
}
#define FSM_E(j) do { if ((j) < 16) { y0[(j) & 15] = __builtin_amdgcn_exp2f(y0[(j) & 15]); acc += y0[(j) & 15]; } else { y1[(j) & 15] = __builtin_amdgcn_exp2f(y1[(j) & 15]); acc += y1[(j) & 15]; } } while (0)
#define FSM_CVT(P, B_) do { ca0 = cvtpk(P[(B_) + 0], P[(B_) + 1]); ca1 = cvtpk(P[(B_) + 2], P[(B_) + 3]); cb0 = cvtpk(P[(B_) + 4], P[(B_) + 5]); cb1 = cvtpk(P[(B_) + 6], P[(B_) + 7]); } while (0)
#define FSM_SWP(OUT) do { u32x4 w_ = {ca0, ca1, cb0, cb1}; OUT = *reinterpret_cast<bf16x8*>(&w_); } while (0)
#define FSM_CHUNK(c) do { if ((c) < 12) { FSM_E(2 * (c)); FSM_E(2 * (c) + 1); } else if ((c) < 20) { FSM_E(24 + (c) - 12); } \
        if ((c) == 12) FSM_CVT(y0, 0); if ((c) == 13) FSM_SWP(pa0); if ((c) == 14) FSM_CVT(y0, 8); if ((c) == 15) FSM_SWP(pa1); \
        if ((c) == 16) FSM_CVT(y1, 0); if ((c) == 17) FSM_SWP(pa2); if ((c) == 20) FSM_CVT(y1, 8); if ((c) == 21) FSM_SWP(pa3); \
        if ((c) == 22) { auto rr_ = __builtin_amdgcn_permlane32_swap(__float_as_uint(acc), __float_as_uint(acc), false, false); acc = __uint_as_float(rr_[0]) + __uint_as_float(rr_[1]); } \
        if ((c) == 23) l_reg = l_reg * alpha + acc; } while (0)
#define SB0() __builtin_amdgcn_sched_barrier(0)
#define QKN(j) ((j) >= 12 ? 0 : ((j) < NQREG ? 2 : 3))
#define DSR128(dst, addr, off) asm volatile("ds_read_b128 %0, %1 offset:%2" : "=v"(dst) : "v"(addr), "i"(off) : "memory")
#define QKA_LOAD(s, SET) do { if ((s) < 8) { DSR128(fb0[SET], ka[(s) & 3], KB * SHM_K + ((s) >> 2) * 128); DSR128(fb1[SET], ka[(s) & 3], KB * SHM_K + ((s) >> 2) * 128 + 32 * 256); \
            if ((s) >= NQREG) DSR128(fq[SET], qa, (((s) - NQREG) & 15) * 1024); } \
        else if ((s) < 12) { DSR128(fb0[SET], kra[((s) - 8) & 3], KB * SHM_KR); DSR128(fb1[SET], kra[((s) - 8) & 3], KB * SHM_KR + 32 * 128); DSR128(fq[SET], qa, ((NQREG_L + (s) - 8) & 15) * 1024); } } while (0)
#define QKQ(s) ((s) < NQREG ? qr[(s) < NQREG ? (s) : 0] : fq[(s) % 3])
#define QKA_STEP(s) do { SB0(); QKA_LOAD((s) + 2, ((s) + 2) % 3); SB0(); \
        asm volatile("s_waitcnt lgkmcnt(%0)" :: "i"(QKN((s) + 1) + QKN((s) + 2)) : "memory"); SB0(); \
        p0 = __builtin_amdgcn_mfma_f32_32x32x16_bf16(fb0[(s) % 3], QKQ(s), p0, 0, 0, 0); SB0(); FSM_CHUNK(2 * (s)); SB0(); \
        p1 = __builtin_amdgcn_mfma_f32_32x32x16_bf16(fb1[(s) % 3], QKQ(s), p1, 0, 0, 0); SB0(); FSM_CHUNK(2 * (s) + 1); } while (0)
template <int KB>
__device__ __forceinline__ void qkt_fsm(f32x16& p0, f32x16& p1, const int (&ka)[4], const int (&kra)[4], int qa, bf16x8 (&fb0)[3], bf16x8 (&fb1)[3], bf16x8 (&fq)[3], const bf16x8* qr,
                                        f32x16& y0, f32x16& y1, float alpha, float& l_reg, bf16x8& pa0, bf16x8& pa1, bf16x8& pa2, bf16x8& pa3) {
    p0 = f32x16{}; p1 = f32x16{};
    float acc = 0.f; unsigned ca0 = 0, ca1 = 0, cb0 = 0, cb1 = 0;
    QKA_STEP(0); QKA_STEP(1); QKA_STEP(2); QKA_STEP(3); QKA_STEP(4); QKA_STEP(5); QKA_STEP(6); QKA_STEP(7); QKA_STEP(8); QKA_STEP(9); QKA_STEP(10); QKA_STEP(11);
    SB0();
}
#undef QKN
#undef QKQ
#undef QKA_STEP
#undef FSM_E
#undef FSM_CVT
#undef FSM_SWP
#undef FSM_CHUNK
#undef QK_LOAD
template <int VB>
__device__ __forceinline__ void pv_tile(f32x16* o, int vb0, bf16x8 pa0, bf16x8 pa1, bf16x8 pa2, bf16x8 pa3) {
#define TRRD(dst, off) asm volatile("ds_read_b64_tr_b16 %0, %1 offset:%2" : "=&v"(dst) : "v"(vb0), "i"(off) : "memory")
#define PV_D0(d0) do { s16x4 l0, l1, l2, l3, h0, h1, h2, h3; constexpr int b_ = OFF_V + VB * SHM_V + v_rd_off(d0, 0, 0); \
        TRRD(l0, b_); TRRD(h0, b_ + 2048); TRRD(l1, b_ + 4096); TRRD(h1, b_ + 6144); TRRD(l2, b_ + 8192); TRRD(h2, b_ + 10240); TRRD(l3, b_ + 12288); TRRD(h3, b_ + 14336); \
        asm volatile("s_waitcnt lgkmcnt(0)" ::: "memory"); SBAR();   \
        o[d0] = __builtin_amdgcn_mfma_f32_32x32x16_bf16(pa0, (bf16x8){l0[0], l0[1], l0[2], l0[3], h0[0], h0[1], h0[2], h0[3]}, o[d0], 0, 0, 0);   \
        o[d0] = __builtin_amdgcn_mfma_f32_32x32x16_bf16(pa1, (bf16x8){l1[0], l1[1], l1[2], l1[3], h1[0], h1[1], h1[2], h1[3]}, o[d0], 0, 0, 0);   \
        o[d0] = __builtin_amdgcn_mfma_f32_32x32x16_bf16(pa2, (bf16x8){l2[0], l2[1], l2[2], l2[3], h2[0], h2[1], h2[2], h2[3]}, o[d0], 0, 0, 0);   \
        o[d0] = __builtin_amdgcn_mfma_f32_32x32x16_bf16(pa3, (bf16x8){l3[0], l3[1], l3[2], l3[3], h3[0], h3[1], h3[2], h3[3]}, o[d0], 0, 0, 0); } while (0)
    PV_D0(0); PV_D0(1); PV_D0(2); PV_D0(3);
}
template <int VB>
__device__ __forceinline__ void pv_tile_sm(f32x16* o, int vb0, bf16x8 pa0, bf16x8 pa1, bf16x8 pa2, bf16x8 pa3, f32x16& p0, f32x16& p1, float& m_reg, float& mn, float& alpha) {
    constexpr float C2 = 1.4426950408889634f * SCALE;
    PV_D0(0);
    float pmax = p0[0];
#pragma unroll
    for (int r = 1; r < 16; ++r) pmax = fmaxf(pmax, p0[r]);
#pragma unroll
    for (int r = 0; r < 16; ++r) pmax = fmaxf(pmax, p1[r]);
    PV_D0(1);
    { auto rr = __builtin_amdgcn_permlane32_swap(__float_as_uint(pmax), __float_as_uint(pmax), false, false);
      pmax = fmaxf(__uint_as_float(rr[0]), __uint_as_float(rr[1])); }
    const bool keep = __all((pmax - m_reg) * SCALE <= THR);
    mn = keep ? m_reg : fmaxf(m_reg, pmax);
    alpha = __builtin_amdgcn_exp2f((m_reg - mn) * C2);
    m_reg = mn;
    const float mnL = -mn * C2;
#pragma unroll
    for (int r = 0; r < 16; ++r) p0[r] = fmaf(p0[r], C2, mnL);
    PV_D0(2);
#pragma unroll
    for (int r = 0; r < 16; ++r) p1[r] = fmaf(p1[r], C2, mnL);
    PV_D0(3);
}
#undef PV_D0
#undef TRRD

struct BlockRef { const u16* Q; const u16* K; const u16* V; const u16* KR; u16* O; int P0; int row0; };
#define VMW() asm volatile("s_waitcnt vmcnt(0)" ::: "memory")
#define ATT_LAS __attribute__((address_space(3)))
#define KDMA(Kp, KRp, k0, bf) do { \
        __builtin_amdgcn_global_load_lds((const unsigned*)((Kp) + (size_t)((k0) + sr) * LDK + ksc), (ATT_LAS unsigned*)(ldsL + OFF_K + (bf) * SHM_K + wid * 1024), 16, 0, 0); \
        __builtin_amdgcn_global_load_lds((const unsigned*)((Kp) + (size_t)((k0) + 32 + sr) * LDK + ksc), (ATT_LAS unsigned*)(ldsL + OFF_K + (bf) * SHM_K + 8192 + wid * 1024), 16, 0, 0); \
        __builtin_amdgcn_global_load_lds((const unsigned*)((KRp) + (size_t)((k0) + krr) * LDKR + krsc), (ATT_LAS unsigned*)(ldsL + OFF_KR + (bf) * SHM_KR + wid * 1024), 16, 0, 0); } while (0)
#define VDMA(Vp, k0, bf) do { \
        __builtin_amdgcn_global_load_lds((const unsigned*)((Vp) + (size_t)((k0) + vk) * LDK + vc), (ATT_LAS unsigned*)(ldsL + OFF_V + (bf) * SHM_V + wid * 1024), 16, 0, 0); \
        __builtin_amdgcn_global_load_lds((const unsigned*)((Vp) + (size_t)((k0) + 32 + vk) * LDK + vc), (ATT_LAS unsigned*)(ldsL + OFF_V + (bf) * SHM_V + 8192 + wid * 1024), 16, 0, 0); } while (0)
#define ATT_MAPS() const int sr = tid >> 4, ksc = ((tid & 15) ^ (sr & 7)) * 8, krr = tid >> 3, krsc = ((tid & 7) ^ (krr & 7)) * 8; ATT_LAS unsigned char* ldsL = (ATT_LAS unsigned char*)lds; \
    const int vk = ((tid >> 7) << 3) | ((tid >> 2) & 7), vc = ((tid >> 5) & 3) * 32 + (tid & 3) * 8
__device__ __forceinline__ void attn_prime(const BlockRef& cur, char* lds, int tid0) {
    int tid_ = tid0; asm volatile("" : "+v"(tid_));
    const int tid = tid_, wid = __builtin_amdgcn_readfirstlane(tid >> 6);
    ATT_MAPS();
    KDMA(cur.K, cur.KR, 0, 0); VDMA(cur.V, 0, 0); VMW();
    __syncthreads();
}
__device__ __forceinline__ void attn_block(const BlockRef& cur, const BlockRef& nxt, char* lds, int tid0, const float* ctab, const float* stab) {
    int tid_ = tid0; asm volatile("" : "+v"(tid_));
    const int tid = tid_, wid = __builtin_amdgcn_readfirstlane(tid >> 6), lane = tid & 63, r32 = lane & 31, hi = lane >> 5;
    const unsigned W = 0x40000000u;
    const int NT = (cur.P0 + QB - 1) / KVBLK + 1;
    const int qlo = cur.P0 + wid * QBLK, qm = qlo + r32 - 4 * hi;
    char* K_lds = lds + OFF_K; char* KR_lds = lds + OFF_KR;
    float* ws = (float*)(lds + OFF_WS) + wid * 64; float* li_l = ws, * al_l = ws + 32;
    bf16x8* qrl = (bf16x8*)(lds + OFF_QR + wid * QR_WAVE) + lane;
    float m_reg = -1e30f, l_reg = 0; f32x16 o[4] = {};
    ATT_MAPS();
    const int vb0 = (int)(uintptr_t)lds + v_rd_base(lane);
    const u16* Kh = cur.K; const u16* Vh = cur.V; const u16* KRh = cur.KR;
#define RESC(a) do { if (__any((a) < 1.f)) { if (hi == 0) al_l[r32] = (a); asm volatile("s_waitcnt lgkmcnt(0)" ::: "memory");              \
                     for (int d_ = 0; d_ < 4; ++d_) for (int r = 0; r < 16; ++r) o[d_][r] *= al_l[crow(r, hi)]; } } while (0)
#define KBASE(t) ((t) * KVBLK)
#define MASKT(P0_, P1_, t) do { const int kb_ = KBASE(t); if (kb_ + KVBLK - 1 > qlo) mask_tile(P0_, P1_, qm - kb_, W); } while (0)
    f32x16 pA0, pA1, pB0, pB1; float mnA, mnB, alA, alB; bf16x8 pa0, pa1, pa2, pa3;
    int ka[4], kra[4]; const int qa = (int)(uintptr_t)qrl; bf16x8 fb0[3], fb1[3], fq[3];
#pragma unroll
    for (int dd = 0; dd < 4; ++dd) { ka[dd] = (int)(uintptr_t)K_lds + KSWZ(r32, (dd * 16 + hi * 8) * 2); kra[dd] = (int)(uintptr_t)KR_lds + KRSWZ(r32, (dd * 16 + hi * 8) * 2); }
#define QK_PREFETCH(KBN) do { constexpr int KB = (KBN); SB0(); QKA_LOAD(0, 0); QKA_LOAD(1, 1); SB0(); } while (0)
    bf16x8 qr[NQREG > 0 ? NQREG : 1];
    { const u16* qp = cur.Q + (size_t)(wid * QBLK + r32) * LDQ + hi * 8;
#pragma unroll
      for (int d = 0; d < NQREG_L; ++d) qrl[d * 64] = load8(qp + (NQREG + d) * 16);
      const size_t trow = (size_t)(cur.row0 + wid * QBLK + r32) * 32 + hi * 8;
#pragma unroll
      for (int pr = 0; pr < 2; ++pr) {
          const bf16x8 x1 = load8(qp + 128 + pr * 16), x2 = load8(qp + 128 + 32 + pr * 16);
          const f32x4 c0 = *(const f32x4*)(ctab + trow + pr * 16), c1 = *(const f32x4*)(ctab + trow + pr * 16 + 4), s0 = *(const f32x4*)(stab + trow + pr * 16), s1 = *(const f32x4*)(stab + trow + pr * 16 + 4);
          float o1[8], o2[8];
#pragma unroll
          for (int e = 0; e < 8; ++e) { const float a = __uint_as_float(((unsigned)(unsigned short)x1[e]) << 16), b = __uint_as_float(((unsigned)(unsigned short)x2[e]) << 16);
              const float cc = e < 4 ? c0[e & 3] : c1[e & 3], ss = e < 4 ? s0[e & 3] : s1[e & 3]; o1[e] = a * cc - b * ss; o2[e] = b * cc + a * ss; }
          u32x4 w1 = {cvtpk(o1[0], o1[1]), cvtpk(o1[2], o1[3]), cvtpk(o1[4], o1[5]), cvtpk(o1[6], o1[7])}, w2 = {cvtpk(o2[0], o2[1]), cvtpk(o2[2], o2[3]), cvtpk(o2[4], o2[5]), cvtpk(o2[6], o2[7])};
          qrl[(NQREG_L + pr) * 64] = *reinterpret_cast<bf16x8*>(&w1); qrl[(NQREG_L + 2 + pr) * 64] = *reinterpret_cast<bf16x8*>(&w2); }
#pragma unroll
      for (int d0 = 0; d0 < NQREG; ++d0) qr[d0] = load8(qp + d0 * 16); }
    SBAR();
    KDMA(Kh, KRh, KBASE(1), 1); VDMA(Vh, KBASE(1), 1);
    SBAR(); qkt<0>(pA0, pA1, K_lds, KR_lds, qrl, r32, hi, qr);
    MASKT(pA0, pA1, 0); partialSM(pA0, pA1, m_reg, mnA, alA);
    VMW(); __syncthreads();
    QK_PREFETCH(1);
    KDMA(Kh, KRh, KBASE(2), 0);
#define HALF_STEP(PX0, PX1, mnX, alX, PY0, PY1, alY, t, KB, VB) do {                                                          \
        SBAR(); qkt_fsm<KB>(PX0, PX1, ka, kra, qa, fb0, fb1, fq, qr, PY0, PY1, alY, l_reg, pa0, pa1, pa2, pa3); SBAR();                       \
        MASKT(PX0, PX1, (t)); SBAR(); pv_tile_sm<VB>(o, vb0, pa0, pa1, pa2, pa3, PX0, PX1, m_reg, mnX, alX);                  \
        VMW(); __syncthreads();                                                                                               \
        QK_PREFETCH(1 - (KB));                             \
        if ((t) + 2 < NT) KDMA(Kh, KRh, KBASE((t) + 2), KB);                                                                  \
        if ((t) + 1 < NT) VDMA(Vh, KBASE((t) + 1), VB);                                                                       \
        SBAR(); RESC(alX); } while (0)
    for (int t = 1; t + 1 < NT; t += 2) {
        HALF_STEP(pB0, pB1, mnB, alB, pA0, pA1, alA, t, 1, 0);
        HALF_STEP(pA0, pA1, mnA, alA, pB0, pB1, alB, t + 1, 0, 1);
    }
    SBAR(); qkt_fsm<1>(pB0, pB1, ka, kra, qa, fb0, fb1, fq, qr, pA0, pA1, alA, l_reg, pa0, pa1, pa2, pa3); SBAR();
    MASKT(pB0, pB1, NT - 1); SBAR(); pv_tile_sm<0>(o, vb0, pa0, pa1, pa2, pa3, pB0, pB1, m_reg, mnB, alB);
    VMW(); __syncthreads();
    KDMA(nxt.K, nxt.KR, 0, 0); VDMA(nxt.V, 0, 0);
    SBAR(); RESC(alB);
    finishSM(pB0, pB1, alB, l_reg, pa0, pa1, pa2, pa3); SBAR(); pv_tile<1>(o, vb0, pa0, pa1, pa2, pa3);
    SBAR();
    if (hi == 0) li_l[r32] = l_reg; asm volatile("s_waitcnt lgkmcnt(0)" ::: "memory");
    float rli[16];
#pragma unroll
    for (int r = 0; r < 16; ++r) rli[r] = __builtin_amdgcn_rcpf(li_l[crow(r, hi)]);
    u16* Ow = cur.O + (size_t)(wid * QBLK) * LDO;
#pragma unroll
    for (int r = 0; r < 16; ++r) { const int orow = crow(r, hi);
#pragma unroll
        for (int d0 = 0; d0 < 4; ++d0) { const float v = o[d0][r] * rli[r];
            const float vn = xor1f(v);
            if ((r32 & 1) == 0) *(unsigned*)(Ow + (size_t)orow * LDO + d0 * 32 + r32) = cvtpk(v, vn); } }
    VMW(); __syncthreads();
#undef RESC
#undef KBASE
#undef MASKT
#undef HALF_STEP
#undef QK_PREFETCH
}
struct Tensors { const u16* q; const u16* kv; const u16* kr; u16* o; const float* ctab; const float* stab; };
__device__ __forceinline__ BlockRef make_ref(const Tensors& T, int L, int pass) {
    const int bh = (L & 7) + 8 * (L >> 8), x = (L >> 3) & 31, b = bh >> 3, h = bh & 7, qb = pass ? x : 63 - x;
    BlockRef r; const size_t row0 = (size_t)b * SEQ;
    r.Q = T.q + (row0 + (size_t)qb * QB) * LDQ + h * 192; r.K = T.kv + row0 * LDK + h * 256; r.V = r.K + 128; r.KR = T.kr + row0 * LDKR;
    r.O = T.o + (row0 + (size_t)qb * QB) * LDO + h * 128; r.P0 = qb * QB; r.row0 = b * SEQ + qb * QB;
    return r;
}
__device__ __forceinline__ void attn_phase(char* lds, const Tensors& T, int tid0) {
    const int total = 512, stride = gridDim.x;
    int L = blockIdx.x; if (L >= total) return;
    int pass = 0;
    BlockRef cur = make_ref(T, L, 0);
    attn_prime(cur, lds, tid0);
    for (;;) {
        const bool more_pass = pass == 0, more_item = L + stride < total, last = !more_pass && !more_item;
        int passn = pass + 1, Ln = L;
        if (!more_pass) { passn = 0; Ln = more_item ? L + stride : L; }
        const BlockRef nxt = last ? cur : make_ref(T, Ln, passn);
        attn_block(cur, nxt, lds, tid0, T.ctab, T.stab);
        if (last) break;
        cur = nxt; pass = passn; L = Ln;
    }
}
#undef VMW
#undef KDMA
#undef VDMA
#undef ATT_MAPS
#undef SBAR
}
namespace xb {
#define LAS __attribute__((address_space(3)))
#define XB_TMO      128
#define XB_XCNT(j)  (256  + 64 * (j))
#define XB_XSUB(j)  (1280 + 64 * (j))
#define XB_XGEN(j)  (2304 + 64 * (j))
#define XB_TOP      3328
#define XB_TOPGEN   3392
#define XCD_BAR_WORDS 3456
#define XB_SPIN_CAP (1u << 18)

__device__ __forceinline__ unsigned xb_ld(unsigned* p)              { return __hip_atomic_load(p, __ATOMIC_RELAXED, __HIP_MEMORY_SCOPE_AGENT); }
__device__ __forceinline__ unsigned xb_add(unsigned* p, unsigned v) { return __hip_atomic_fetch_add(p, v, __ATOMIC_RELAXED, __HIP_MEMORY_SCOPE_AGENT); }
__device__ __forceinline__ unsigned xb_xcc_id() { return (unsigned)__builtin_amdgcn_s_getreg((3 << 11) | 20) & 0xFu; }
#define XB_SPIN(cond, bar) do { unsigned _sp = 0; while (cond) { __builtin_amdgcn_s_sleep(1); \
    if ((++_sp & 255u) == 0u) { if (xb_ld(&(bar)[XB_TMO])) break; if (_sp > XB_SPIN_CAP) { atomicAdd(&(bar)[XB_TMO], 1u); break; } } } } while (0)

struct XcdBarrier {
    unsigned* bar; unsigned x;
    volatile LAS unsigned* st;
};

__device__ __forceinline__ XcdBarrier xcd_barrier_post(unsigned* bar, volatile LAS unsigned* st) {
    XcdBarrier b; b.bar = bar; b.x = xb_xcc_id(); b.st = st;
    if (threadIdx.x == 0) (void)xb_add(&bar[XB_XCNT(b.x)], 1u);
    return b;
}
__device__ __forceinline__ void xcd_barrier_complete(unsigned* bar, unsigned x, unsigned& nloc, unsigned& nx) {
    const unsigned G = gridDim.x * gridDim.y * gridDim.z;
    unsigned sum, cnt, mine, sp = 0u;
    for (;;) {
        sum = 0u; cnt = 0u; mine = 0u;
#pragma unroll
        for (unsigned j = 0; j < 16; ++j) { const unsigned c = xb_ld(&bar[XB_XCNT(j)]); sum += c; cnt += (c > 0u) ? 1u : 0u; mine = (j == x) ? c : mine; }
        if (sum == G) break;
        __builtin_amdgcn_s_sleep(1);
        if ((++sp & 255u) == 0u) { if (xb_ld(&bar[XB_TMO])) break; if (sp > XB_SPIN_CAP) { atomicAdd(&bar[XB_TMO], 1u); break; } }
    }
    nloc = mine > 0u ? mine : 1u; nx = cnt > 0u ? cnt : 1u;
}

__device__ __forceinline__ void xcd_barrier(const XcdBarrier& b, bool t0  ) {
    asm volatile("s_waitcnt vmcnt(0)" ::: "memory");
    __syncthreads();
    if (t0) {
        unsigned* bar = b.bar;
        __builtin_amdgcn_s_waitcnt(0);
        unsigned nloc = b.st[0], nx = b.st[1];
        if (nloc == 0u) { xcd_barrier_complete(bar, b.x, nloc, nx); b.st[0] = nloc; b.st[1] = nx; }
        const unsigned old = xb_add(&bar[XB_XSUB(b.x)], 1u);
        const unsigned gen = old / nloc;
        if (old + 1u == (gen + 1u) * nloc) {
            __builtin_amdgcn_fence(__ATOMIC_RELEASE, "agent");
            asm volatile("s_waitcnt vmcnt(0)" ::: "memory");
            const unsigned og = xb_add(&bar[XB_TOP], 1u);
            const unsigned tg = og / nx;
            if (og + 1u == (tg + 1u) * nx) xb_add(&bar[XB_TOPGEN], 1u);
            else XB_SPIN(xb_ld(&bar[XB_TOPGEN]) == tg, bar);
            __builtin_amdgcn_fence(__ATOMIC_ACQUIRE, "agent");
            xb_add(&bar[XB_XGEN(b.x)], 1u);
            asm volatile("s_waitcnt vmcnt(0)" ::: "memory");
        } else {
            XB_SPIN(xb_ld(&bar[XB_XGEN(b.x)]) == gen, bar);
            __builtin_amdgcn_fence(__ATOMIC_ACQUIRE, "agent");
            asm volatile("s_waitcnt vmcnt(0)" ::: "memory");
        }
    }
    __syncthreads();
}
#undef LAS
}
#ifndef PROBE_ATT_REPS
#define PROBE_ATT_REPS 1
#endif
#ifndef PROBE_SYNC_REPS
#define PROBE_SYNC_REPS 1
#endif
#ifndef PROBE_THIN_REPS
#define PROBE_THIN_REPS 1
#endif
#ifndef PROBE_PRO_REPS
#define PROBE_PRO_REPS 1
#endif
#ifndef STAGGER_TICKS
#define STAGGER_TICKS 0
#endif
#ifndef PROBE_GEMM_OP
#define PROBE_GEMM_OP -1
#endif
#ifndef PROBE_GEMM_REPS
#define PROBE_GEMM_REPS 1
#endif
namespace mk {
typedef unsigned short u16;
typedef float f32x4 __attribute__((ext_vector_type(4)));
constexpr int M = 32768, D = 1024, SEQ = 16384;
constexpr float EPS = 1e-6f;
constexpr size_t MB = (size_t)1 << 20;
__host__ __device__ constexpr size_t WT_MLA(int j) { return (size_t)j * 6 * MB; }
__host__ __device__ constexpr size_t WT_LRU(int j) { return 12 * MB + (size_t)j * 8 * MB; }
__host__ __device__ constexpr size_t WT_FFN(int l) { return 28 * MB + (size_t)l * 16 * MB; }
constexpr size_t OFF_UQ = 3 * MB / 2, OFF_UKV = 11 * MB / 4, OFF_WO = 15 * MB / 4, OFF_GT = 4 * MB, OFF_LOUT = 5 * MB, OFF_DOWN = 8 * MB;
constexpr size_t WS_COS = 96 * MB, WS_SIN = 100 * MB, WS_SA = 104 * MB, WS_SB = 105 * MB;
constexpr size_t WS_HN = 112 * MB, WS_Y = 176 * MB, WS_U = 240 * MB, WS_END = 496 * MB;
constexpr size_t U_PROJ = 64 * MB, U_CQ = 112 * MB, U_CKV = 136 * MB, U_KR = 152 * MB, U_Q = 160 * MB, U_O = 64 * MB;
constexpr size_t U_GATE = 0, U_XC = 64 * MB, U_REC = 128 * MB, U_LA = 128 * MB, U_B = 192 * MB;
constexpr size_t WS_XSA = 108 * MB, WS_XSB = 109 * MB;
constexpr size_t WS_RS = 108 * MB;
constexpr int SCAN_L = 128, SCAN_NC = SEQ / SCAN_L;

__device__ __forceinline__ unsigned f2bf(float f) { unsigned u = __float_as_uint(f); return (u + 0x7fffu + ((u >> 16) & 1u)) >> 16; }
__device__ __forceinline__ unsigned pk2(float lo, float hi) { return f2bf(lo) | (f2bf(hi) << 16); }
__device__ __forceinline__ float bflo(unsigned w) { return __uint_as_float(w << 16); }
__device__ __forceinline__ float bfhi(unsigned w) { return __uint_as_float(w & 0xffff0000u); }
__device__ __forceinline__ float bf1(u16 h) { return __uint_as_float(((unsigned)h) << 16); }
__device__ __forceinline__ float wave_sum(float v) {
    v += xor1f(v); v += xor2f(v); v += xor4f(v); v += xor8f(v); v += xor16f(v);
    return sum32f(v);
}
__device__ __forceinline__ void transpose_item(const float* W, int ldw, u16* WT, int ldt, int nblk, float* scr, int item, int lane) {
    const int kb = item / nblk, nb = item % nblk, k0 = 64 * kb, n0 = 32 * nb;
#pragma unroll
    for (int i = 0; i < 8; ++i) { const int kk = 8 * i + (lane >> 3); const f32x4 v = *(const f32x4*)(W + (size_t)(k0 + kk) * ldw + n0 + (lane & 7) * 4);
        float* s = scr + kk * 33 + (lane & 7) * 4; s[0] = v.x; s[1] = v.y; s[2] = v.z; s[3] = v.w; }
    asm volatile("s_waitcnt lgkmcnt(0)" ::: "memory");
    const int c = lane & 7;
#pragma unroll
    for (int j = 0; j < 4; ++j) { const int n = (lane >> 3) + 8 * j; const float* s = scr + (8 * c) * 33 + n;
        uint4 o; o.x = pk2(s[0 * 33], s[1 * 33]); o.y = pk2(s[2 * 33], s[3 * 33]); o.z = pk2(s[4 * 33], s[5 * 33]); o.w = pk2(s[6 * 33], s[7 * 33]);
        *(uint4*)(WT + (size_t)(n0 + n) * ldt + k0 + 8 * c) = o; }
    asm volatile("s_waitcnt lgkmcnt(0)" ::: "memory");
}
struct Params { const float* in[23]; float* out; unsigned char* ws; };
enum { I_X = 0, I_POS, I_MIXPRE, I_MIXPOST, I_FFNPRE, I_FFNPOST, I_MLA_WIN, I_MLA_QN, I_MLA_KVN, I_MLA_WUQ, I_MLA_WUKV, I_MLA_WO,
       I_LRU_WIN, I_LRU_CW, I_LRU_CB, I_LRU_WA, I_LRU_BA, I_LRU_WX, I_LRU_BX, I_LRU_LAM, I_LRU_WOUT, I_FFN_UP, I_FFN_DOWN };

__device__ __forceinline__ void prologue_weights(const __attribute__((address_space(4))) Params& p, float* scr, int gw, int NGW, int lane) {
    u16* wt = (u16*)p.ws;
    constexpr int IT_MLA = 352 + 288 + 256 + 512, IT_LRU = 1024 + 128 + 512, IT_FFN = 4096, TOTAL = 2 * IT_MLA + 2 * IT_LRU + 4 * IT_FFN;
    for (int it = gw; it < TOTAL; it += NGW) {
        int r = it; const float* W; int ldw, ldt, nblk; u16* WT;
        if (r < 2 * IT_MLA) { const int j = r / IT_MLA; r -= j * IT_MLA; u16* base = wt + WT_MLA(j) / 2;
            if (r < 352) { W = p.in[I_MLA_WIN] + (size_t)j * 1024 * 704; ldw = 704; nblk = 22; WT = base; ldt = 1024; }
            else if (r < 640) { r -= 352; W = p.in[I_MLA_WUQ] + (size_t)j * 384 * 1536; ldw = 1536; nblk = 48; WT = base + OFF_UQ / 2; ldt = 384; }
            else if (r < 896) { r -= 640; W = p.in[I_MLA_WUKV] + (size_t)j * 256 * 2048; ldw = 2048; nblk = 64; WT = base + OFF_UKV / 2; ldt = 256; }
            else { r -= 896; W = p.in[I_MLA_WO] + (size_t)j * 1024 * 1024; ldw = 1024; nblk = 32; WT = base + OFF_WO / 2; ldt = 1024; }
        } else if (r < 2 * IT_MLA + 2 * IT_LRU) { r -= 2 * IT_MLA; const int j = r / IT_LRU; r -= j * IT_LRU; u16* base = wt + WT_LRU(j) / 2;
            if (r < 1024) { W = p.in[I_LRU_WIN] + (size_t)j * 1024 * 2048; ldw = 2048; nblk = 64; WT = base; ldt = 1024; }
            else if (r < 1152) { r -= 1024; const int which = r >> 3, gt = which >> 3, n = which & 7; r &= 7;
                W = p.in[gt ? I_LRU_WX : I_LRU_WA] + (size_t)j * 8 * 128 * 128 + (size_t)n * 128 * 128; ldw = 128; nblk = 4;
                WT = base + OFF_GT / 2 + (size_t)(n * 256 + gt * 128) * 256 + 128 * (n & 1); ldt = 256; }
            else { r -= 1152; W = p.in[I_LRU_WOUT] + (size_t)j * 1024 * 1024; ldw = 1024; nblk = 32; WT = base + OFF_LOUT / 2; ldt = 1024; }
        } else { r -= 2 * IT_MLA + 2 * IT_LRU; const int l = r / IT_FFN; r -= l * IT_FFN; u16* base = wt + WT_FFN(l) / 2;
            if (r < 2048) { W = p.in[I_FFN_UP] + (size_t)l * 1024 * 4096; ldw = 4096; nblk = 128; WT = base; ldt = 1024; }
            else { r -= 2048; W = p.in[I_FFN_DOWN] + (size_t)l * 4096 * 1024; ldw = 1024; nblk = 32; WT = base + OFF_DOWN / 2; ldt = 4096; }
        }
        transpose_item(W, ldw, WT, ldt, nblk, scr, r, lane);
    }
}
__device__ __forceinline__ void rowop(const u16* y, const float* xin, float* xout, u16* hn, float* rs, const float* gpost, const float* gpre, int gw, int NGW, int lane) {
    f32x4 gp[4], gq[4];
#pragma unroll
    for (int j = 0; j < 4; ++j) { gp[j] = gpost ? *(const f32x4*)(gpost + j * 256 + lane * 4) : (f32x4){0.f, 0.f, 0.f, 0.f}; gq[j] = gpre ? *(const f32x4*)(gpre + j * 256 + lane * 4) : (f32x4){0.f, 0.f, 0.f, 0.f}; }
    for (int row = gw; row < M; row += NGW) {
        f32x4 xv[4];
#pragma unroll
        for (int j = 0; j < 4; ++j) xv[j] = *(const f32x4*)(xin + (size_t)row * D + j * 256 + lane * 4);
        if (y) {
            f32x4 yv[4]; float ss = 0.f;
#pragma unroll
            for (int j = 0; j < 4; ++j) { const uint2 w = *(const uint2*)(y + (size_t)row * D + j * 256 + lane * 4);
                yv[j] = (f32x4){bflo(w.x), bfhi(w.x), bflo(w.y), bfhi(w.y)}; ss += (yv[j].x * yv[j].x + yv[j].y * yv[j].y) + (yv[j].z * yv[j].z + yv[j].w * yv[j].w); }
            const float r = rsqrtf(wave_sum(ss) * (1.f / D) + EPS);
#pragma unroll
            for (int j = 0; j < 4; ++j) xv[j] = xv[j] + (yv[j] * r) * gp[j];
        }
        if (xout) {
#pragma unroll
        for (int j = 0; j < 4; ++j) *(f32x4*)(xout + (size_t)row * D + j * 256 + lane * 4) = xv[j]; }
        if (gpre) {
            float s2 = 0.f;
#pragma unroll
            for (int j = 0; j < 4; ++j) s2 += (xv[j].x * xv[j].x + xv[j].y * xv[j].y) + (xv[j].z * xv[j].z + xv[j].w * xv[j].w);
            const float tot2 = wave_sum(s2); const float r2 = 1.0f;
            if (rs && lane < 4) rs[(size_t)row * 4 + lane] = lane == 0 ? tot2 : 0.f;
#pragma unroll
            for (int j = 0; j < 4; ++j) { const f32x4 h = (xv[j] * r2) * gq[j]; uint2 w; w.x = pk2(h.x, h.y); w.y = pk2(h.z, h.w);
                *(uint2*)(hn + (size_t)row * D + j * 256 + lane * 4) = w; }
        }
    }
}
__device__ __forceinline__ void qkvnorm(const u16* proj, u16* cq, u16* ckv, u16* kr, const float* qn, const float* kvn, const float* ctab, const float* stab, const float* rss, int gw, int NGW, int lane) {
    float gA[8], gB[8];
    { const float* gp = lane < 48 ? qn + 8 * lane : kvn + (8 * lane - 384); const f32x4 g0 = *(const f32x4*)gp, g1 = *(const f32x4*)(gp + 4);
      gA[0] = g0[0]; gA[1] = g0[1]; gA[2] = g0[2]; gA[3] = g0[3]; gA[4] = g1[0]; gA[5] = g1[1]; gA[6] = g1[2]; gA[7] = g1[3]; }
    { f32x4 g0 = {0.f, 0.f, 0.f, 0.f}, g1 = {0.f, 0.f, 0.f, 0.f}; if (lane < 16) { g0 = *(const f32x4*)(kvn + 128 + 8 * lane); g1 = *(const f32x4*)(kvn + 132 + 8 * lane); }
      gB[0] = g0[0]; gB[1] = g0[1]; gB[2] = g0[2]; gB[3] = g0[3]; gB[4] = g1[0]; gB[5] = g1[1]; gB[6] = g1[2]; gB[7] = g1[3]; }
    const bool ropeL = lane >= 16 && lane < 24; const int rk = (lane & 3) * 8;
    const int cOff = lane < 20 ? 672 + rk : 640 + rk;
    for (int row0 = gw; row0 < M; row0 += 2 * NGW) {
        float A[2][8], B[2][8], C[2][8], rsc[2], sa[2], sb[2];
#pragma unroll
        for (int q = 0; q < 2; ++q) { const int row = row0 + q * NGW; const u16* pr = proj + (size_t)row * 768;
            const f32x4 pp = *(const f32x4*)(rss + (size_t)row * 4); rsc[q] = rsqrtf(((pp[0] + pp[1]) + (pp[2] + pp[3])) * (1.f / D) + EPS);
            const uint4 a = *(const uint4*)(pr + 8 * lane); uint4 b = make_uint4(0u, 0u, 0u, 0u), c = make_uint4(0u, 0u, 0u, 0u);
            if (lane < 24) b = *(const uint4*)(pr + 512 + 8 * lane);
            if (ropeL) c = *(const uint4*)(pr + cOff);
            A[q][0] = bflo(a.x); A[q][1] = bfhi(a.x); A[q][2] = bflo(a.y); A[q][3] = bfhi(a.y); A[q][4] = bflo(a.z); A[q][5] = bfhi(a.z); A[q][6] = bflo(a.w); A[q][7] = bfhi(a.w);
            B[q][0] = bflo(b.x); B[q][1] = bfhi(b.x); B[q][2] = bflo(b.y); B[q][3] = bfhi(b.y); B[q][4] = bflo(b.z); B[q][5] = bfhi(b.z); B[q][6] = bflo(b.w); B[q][7] = bfhi(b.w);
            C[q][0] = bflo(c.x); C[q][1] = bfhi(c.x); C[q][2] = bflo(c.y); C[q][3] = bfhi(c.y); C[q][4] = bflo(c.z); C[q][5] = bfhi(c.z); C[q][6] = bflo(c.w); C[q][7] = bfhi(c.w); }
#pragma unroll
        for (int q = 0; q < 2; ++q) { sa[q] = 0.f; sb[q] = 0.f;
#pragma unroll
            for (int e = 0; e < 8; ++e) { A[q][e] *= rsc[q]; B[q][e] *= rsc[q]; C[q][e] *= rsc[q]; sa[q] += A[q][e] * A[q][e]; sb[q] += B[q][e] * B[q][e]; } }
        float r1[2], r2[2];
#pragma unroll
        for (int q = 0; q < 2; ++q) { const float s1 = wave_sum(lane < 48 ? sa[q] : 0.f), s2 = wave_sum((lane >= 48 ? sa[q] : 0.f) + (lane < 16 ? sb[q] : 0.f));
            r1[q] = rsqrtf(s1 * (1.f / 384.f) + EPS); r2[q] = rsqrtf(s2 * (1.f / 256.f) + EPS); }
#pragma unroll
        for (int q = 0; q < 2; ++q) { const int row = row0 + q * NGW;
            { const float r = lane < 48 ? r1[q] : r2[q]; uint4 o; o.x = pk2(A[q][0] * r * gA[0], A[q][1] * r * gA[1]); o.y = pk2(A[q][2] * r * gA[2], A[q][3] * r * gA[3]);
              o.z = pk2(A[q][4] * r * gA[4], A[q][5] * r * gA[5]); o.w = pk2(A[q][6] * r * gA[6], A[q][7] * r * gA[7]);
              if (lane < 48) *(uint4*)(cq + (size_t)row * 384 + 8 * lane) = o; else *(uint4*)(ckv + (size_t)row * 256 + (8 * lane - 384)) = o; }
            if (lane < 16) { const float r = r2[q]; uint4 o; o.x = pk2(B[q][0] * r * gB[0], B[q][1] * r * gB[1]); o.y = pk2(B[q][2] * r * gB[2], B[q][3] * r * gB[3]);
              o.z = pk2(B[q][4] * r * gB[4], B[q][5] * r * gB[5]); o.w = pk2(B[q][6] * r * gB[6], B[q][7] * r * gB[7]);
              *(uint4*)(ckv + (size_t)row * 256 + 128 + 8 * lane) = o; }
            if (ropeL) { const f32x4 c0 = *(const f32x4*)(ctab + (size_t)row * 32 + rk), c1 = *(const f32x4*)(ctab + (size_t)row * 32 + rk + 4), s0 = *(const f32x4*)(stab + (size_t)row * 32 + rk), s1 = *(const f32x4*)(stab + (size_t)row * 32 + rk + 4);
              float ov[8];
#pragma unroll
              for (int e = 0; e < 8; ++e) { const float cc = e < 4 ? c0[e & 3] : c1[e & 3], ss = e < 4 ? s0[e & 3] : s1[e & 3];
                  ov[e] = lane < 20 ? B[q][e] * cc - C[q][e] * ss
                                    : B[q][e] * cc + C[q][e] * ss; }
              uint4 o; o.x = pk2(ov[0], ov[1]); o.y = pk2(ov[2], ov[3]); o.z = pk2(ov[4], ov[5]); o.w = pk2(ov[6], ov[7]);
              *(uint4*)(kr + (size_t)row * 64 + (lane < 20 ? 0 : 32) + rk) = o; }
        }
    }
}
__device__ __forceinline__ void qrope(u16* q, const float* ctab, const float* stab, int gw, int NGW, int lane) {
    for (int row = gw; row < M; row += NGW) {
        u16* qr = q + (size_t)row * 1536; const int i = lane & 31;
        const float c = ctab[(size_t)row * 32 + i], s = stab[(size_t)row * 32 + i];
#pragma unroll
        for (int j = 0; j < 4; ++j) { const int h = 2 * j + (lane >> 5); u16* pp = qr + h * 192 + 128 + i;
            const float x1 = bf1(pp[0]), x2 = bf1(pp[32]);
            pp[0] = (u16)f2bf(x1 * c - x2 * s); pp[32] = (u16)f2bf(x2 * c + x1 * s); }
    }
}
__device__ __forceinline__ void conv_phase(const u16* rec, u16* xc, const float* cw, const float* cb, int gtid, int NGT) {
    for (int idx = gtid; idx < (M / 32) * 128; idx += NGT) {
        const int r0 = (idx >> 7) * 32, c0 = (idx & 127) * 8;
        float w[4][8], bias[8], win[3][8];
#pragma unroll
        for (int e = 0; e < 8; ++e) { bias[e] = cb[c0 + e];
#pragma unroll
            for (int k = 0; k < 4; ++k) w[k][e] = cw[k * D + c0 + e]; }
        const bool first = (r0 & (SEQ - 1)) == 0;
#pragma unroll
        for (int k = 0; k < 3; ++k) { uint4 v = make_uint4(0u, 0u, 0u, 0u); if (!first) v = *(const uint4*)(rec + (size_t)(r0 - 3 + k) * D + c0);
            win[k][0] = bflo(v.x); win[k][1] = bfhi(v.x); win[k][2] = bflo(v.y); win[k][3] = bfhi(v.y); win[k][4] = bflo(v.z); win[k][5] = bfhi(v.z); win[k][6] = bflo(v.w); win[k][7] = bfhi(v.w); }
        for (int i0 = 0; i0 < 32; i0 += 8) {
            uint4 in[8];
#pragma unroll
            for (int u = 0; u < 8; ++u) in[u] = *(const uint4*)(rec + (size_t)(r0 + i0 + u) * D + c0);
#pragma unroll
            for (int u = 0; u < 8; ++u) {
                const float x[8] = {bflo(in[u].x), bfhi(in[u].x), bflo(in[u].y), bfhi(in[u].y), bflo(in[u].z), bfhi(in[u].z), bflo(in[u].w), bfhi(in[u].w)};
                float acc[8];
#pragma unroll
                for (int e = 0; e < 8; ++e) { acc[e] = bias[e] + win[0][e] * w[0][e] + win[1][e] * w[1][e] + win[2][e] * w[2][e] + x[e] * w[3][e]; win[0][e] = win[1][e]; win[1][e] = win[2][e]; win[2][e] = x[e]; }
                uint4 o; o.x = pk2(acc[0], acc[1]); o.y = pk2(acc[2], acc[3]); o.z = pk2(acc[4], acc[5]); o.w = pk2(acc[6], acc[7]);
                *(uint4*)(xc + (size_t)(r0 + i0 + u) * D + c0) = o;
            }
        }
    }
}
__device__ __forceinline__ void scanA(const u16* A, const u16* B, float* SA, float* SB, int tid) {
    for (int item = blockIdx.x; item < 2 * SCAN_NC; item += gridDim.x) {
        const int c = item % SCAN_NC, b = item / SCAN_NC, ch = 2 * tid;
        const size_t base = ((size_t)b * SEQ + (size_t)c * SCAN_L) * D + ch;
        float h0 = 0.f, h1 = 0.f, P0 = 1.f, P1 = 1.f;
        for (int t0 = 0; t0 < SCAN_L; t0 += 32) {
            unsigned aw[32], bw[32];
#pragma unroll
            for (int u = 0; u < 32; ++u) { aw[u] = *(const unsigned*)(A + base + (size_t)(t0 + u) * D); bw[u] = *(const unsigned*)(B + base + (size_t)(t0 + u) * D); }
#pragma unroll
            for (int u = 0; u < 32; ++u) { const float a0 = __expf(bflo(aw[u])), a1 = __expf(bfhi(aw[u])); h0 = a0 * h0 + bflo(bw[u]); h1 = a1 * h1 + bfhi(bw[u]); P0 *= a0; P1 *= a1; }
        }
        const size_t so = ((size_t)b * SCAN_NC + c) * D + ch;
        *(float2*)(SA + so) = make_float2(P0, P1); *(float2*)(SB + so) = make_float2(h0, h1);
    }
}
__device__ __forceinline__ void scanC(const u16* A, const u16* B, const float* SA, const float* SB, const u16* gate, u16* hg, int tid) {
    for (int item = blockIdx.x; item < 2 * SCAN_NC; item += gridDim.x) {
        const int c = item % SCAN_NC, b = item / SCAN_NC, ch = 2 * tid;
        const size_t base = ((size_t)b * SEQ + (size_t)c * SCAN_L) * D + ch;
        float h0 = 0.f, h1 = 0.f;
        for (int cc0 = 0; cc0 < c; cc0 += 16) {
            float2 pa[16], pb[16];
#pragma unroll
            for (int u = 0; u < 16; ++u) { const int cc = cc0 + u < c ? cc0 + u : c - 1; const size_t so = ((size_t)b * SCAN_NC + cc) * D + ch; pa[u] = *(const float2*)(SA + so); pb[u] = *(const float2*)(SB + so); }
#pragma unroll
            for (int u = 0; u < 16; ++u) { const bool in = cc0 + u < c; const float ax = in ? pa[u].x : 1.f, ay = in ? pa[u].y : 1.f, bx = in ? pb[u].x : 0.f, by = in ? pb[u].y : 0.f; h0 = ax * h0 + bx; h1 = ay * h1 + by; }
        }
        for (int t0 = 0; t0 < SCAN_L; t0 += 16) {
            unsigned aw[16], bw[16], gv[16];
#pragma unroll
            for (int u = 0; u < 16; ++u) { aw[u] = *(const unsigned*)(A + base + (size_t)(t0 + u) * D); bw[u] = *(const unsigned*)(B + base + (size_t)(t0 + u) * D); gv[u] = *(const unsigned*)(gate + base + (size_t)(t0 + u) * D); }
#pragma unroll
            for (int u = 0; u < 16; ++u) { h0 = __expf(bflo(aw[u])) * h0 + bflo(bw[u]); h1 = __expf(bfhi(aw[u])) * h1 + bfhi(bw[u]);
                *(unsigned*)(hg + base + (size_t)(t0 + u) * D) = pk2(bflo(gv[u]) * h0, bfhi(gv[u]) * h1); }
        }
    }
}

constexpr int LDS_GEMM = pg8::STAGE_BYTES + 8192, LDS_MAIN = att::LDS_BYTES > LDS_GEMM ? att::LDS_BYTES : LDS_GEMM, LDS_BYTES = LDS_MAIN + 16;
constexpr size_t WS_BAR = 106 * MB;
constexpr size_t WS_CNT1 = WS_BAR + 16384, WS_CNT2 = WS_BAR + 49152, CTL_BYTES = 81920, WS_XS1 = 107 * MB, WS_XS2 = 107 * MB + MB / 2;
constexpr int XL_OFF = 131072;
static_assert(XL_OFF + 8192 <= LDS_MAIN && XCD_BAR_WORDS * 4 <= 16384 && att::LDS_BYTES <= LDS_MAIN && pg8::STAGE_BYTES <= LDS_MAIN && LDS_BYTES <= 160 * 1024, "LDS map");

__global__ void __launch_bounds__(512, 2) fwd_mega(Params p_arg) {
    extern __shared__ __attribute__((aligned(16))) unsigned char lds[];
    cg::grid_group grid = cg::this_grid();
    (void)p_arg;
    volatile __attribute__((address_space(3))) unsigned* bst = (volatile __attribute__((address_space(3))) unsigned*)((__attribute__((address_space(3))) unsigned char*)lds + LDS_MAIN);
    if (threadIdx.x < 4) bst[threadIdx.x] = 0u;
    __syncthreads();
    const int wave_s = __builtin_amdgcn_readfirstlane(threadIdx.x >> 6);
    const unsigned bar_x = xb::xb_xcc_id();
    (void)xb::xcd_barrier_post((unsigned*)(p_arg.ws + WS_BAR), bst);
#define GRID_BAR() do { unsigned bx_ = bar_x; asm volatile("" : "+s"(bx_)); xb::XcdBarrier bb_; bb_.bar = (unsigned*)(ws + WS_BAR); bb_.x = bx_; bb_.st = bst; xb::xcd_barrier(bb_, tid == 0); } while (0)
    typedef const __attribute__((address_space(4))) Params* KParams;
    KParams pp = (KParams)__builtin_amdgcn_kernarg_segment_ptr();
#define FRESH() int tid_ = wave_s * 64 + lane_id_fresh(); asm volatile("" : "+v"(tid_)); asm volatile("" : "+s"(pp)); const __attribute__((address_space(4))) Params& p = *pp; \
    const int tid = tid_, lane = tid & 63, wave = __builtin_amdgcn_readfirstlane(tid >> 6); \
    const int G = gridDim.x, gw = blockIdx.x * 8 + wave, NGW = G * 8, gtid = blockIdx.x * 512 + tid, NGT = G * 512; \
    unsigned char* ws = p.ws; float* x = p.out; u16* hn = (u16*)(ws + WS_HN); u16* ybuf = (u16*)(ws + WS_Y); unsigned char* U = ws + WS_U; \
    float* ctab = (float*)(ws + WS_COS); float* stab = (float*)(ws + WS_SIN); float* SA = (float*)(ws + WS_SA); float* SB = (float*)(ws + WS_SB); \
    (void)lane; (void)wave; (void)gw; (void)NGW; (void)gtid; (void)NGT; (void)x; (void)hn; (void)ybuf; (void)U; (void)ctab; (void)stab; (void)SA; (void)SB;
    {
    FRESH();

    for (int prep = 0; prep < PROBE_PRO_REPS; ++prep) {
    prologue_weights(p, (float*)lds + wave * (64 * 33), gw, NGW, lane);
    for (int i = gtid; i < 2 * 2048 * 16; i += NGT) { const int j = i >> 15, row = (i >> 4) & 2047, chn = i & 15, n = row >> 8;
        *(uint4*)((u16*)(ws + WT_LRU(j) + OFF_GT) + (size_t)row * 256 + 128 * ((n & 1) ^ 1) + chn * 8) = make_uint4(0u, 0u, 0u, 0u); }
    { const int* pos = (const int*)p.in[I_POS];
      for (int i = gtid; i < M * 32; i += NGT) { const int row = i >> 5, f = i & 31;
        const float inv = __builtin_amdgcn_exp2f(-(float)f * (13.287712379549449f / 32.f));
        const float ang = (float)pos[row] * inv;
        double rev = (double)ang * 0.15915494309189535; rev -= __builtin_rint(rev);
        ctab[i] = __builtin_amdgcn_cosf((float)rev); stab[i] = __builtin_amdgcn_sinf((float)rev); } }
    rowop(nullptr, p.in[I_X], nullptr, hn, (float*)(ws + WS_XSB), nullptr, p.in[I_MIXPRE], gw, NGW, lane);
    }
    if (ws == nullptr) grid.sync();
    GRID_BAR();
    }

#pragma nounroll
    for (int layer = 0; layer < 4; ++layer) {
#pragma nounroll
        for (int op = 0; op < 10; ++op) {
            FRESH();
            const int j = layer >> 1; const bool lru = (layer & 1) != 0;
            const u16* wtm = (const u16*)(ws + WT_MLA(j)); const u16* wtl = (const u16*)(ws + WT_LRU(j)); const u16* wtf = (const u16*)(ws + WT_FFN(layer));
            int gk = 0;
            pg8::Gemm g{}; pg8::EpiB E{};
            if (op == 6 || op == 9) continue;
            const float* gprev = p.in[op == 5 ? I_MIXPRE : I_FFNPRE] + layer * D;
            const float* gpost = p.in[op == 5 ? I_MIXPOST : I_FFNPOST] + layer * D;
            const float* gpre = op == 5 ? p.in[I_FFNPRE] + layer * D : (layer < 3 ? p.in[I_MIXPRE] + (layer + 1) * D : nullptr);
            if (op == 7) { gk = 1; g = pg8::Gemm{hn, wtf, M, 4096, 1024, 1024, 1024, 0}; E = pg8::EpiB{(u16*)U, 4096, 0, 0, 1, nullptr}; }
            else if (op == 8) { gk = 3; g = pg8::Gemm{(const u16*)U, wtf + OFF_DOWN / 2, M, 1024, 4096, 4096, 4096, 0}; }
            else if (!lru) {
                u16* proj = (u16*)(U + U_PROJ); u16* cq = (u16*)(U + U_CQ); u16* ckv = (u16*)(U + U_CKV); u16* kr = (u16*)(U + U_KR); u16* q = (u16*)(U + U_Q); u16* o = (u16*)(U + U_O); u16* kv = ybuf;
                if (op == 0) { gk = 1; g = pg8::Gemm{hn, wtm, M, 768, 1024, 1024, 1024, 0}; E = pg8::EpiB{proj, 768, 0, 0, 0, nullptr}; }
                else if (op == 1) for (int rep = 0; rep < PROBE_THIN_REPS; ++rep) qkvnorm(proj, cq, ckv, kr, p.in[I_MLA_QN] + j * 384, p.in[I_MLA_KVN] + j * 256, ctab, stab, (const float*)(ws + WS_XSB), gw, NGW, lane);
                else if (op == 2) { gk = 1; g = pg8::Gemm{cq, wtm + OFF_UQ / 2, M, 1536, 384, 384, 384, 0}; E = pg8::EpiB{q, 1536, 0, 0, 0, nullptr}; }
                else if (op == 3) { gk = 1; g = pg8::Gemm{ckv, wtm + OFF_UKV / 2, M, 2048, 256, 256, 256, 0}; E = pg8::EpiB{kv, 2048, 0, 0, 0, nullptr}; }
                else if (op == 4) { const att::Tensors T{q, kv, kr, o, ctab, stab}; for (int rep = 0; rep < PROBE_ATT_REPS; ++rep) att::attn_phase((char*)lds, T, tid); }
                else { gk = 3; g = pg8::Gemm{o, wtm + OFF_WO / 2, M, 1024, 1024, 1024, 1024, 0}; }
            } else {
                u16* gate = (u16*)(U + U_GATE); u16* xc = (u16*)(U + U_XC); u16* rec = (u16*)(U + U_REC); u16* Bb = (u16*)(U + U_B); u16* Ab = (u16*)(U + U_LA); u16* hg = xc;
                if (op == 0) { gk = 1; g = pg8::Gemm{hn, wtl, M, 2048, 1024, 1024, 1024, 0}; E = pg8::EpiB{gate, 1024, 1024, (size_t)(U_REC - U_GATE) / 2, 2, (const float*)(ws + WS_XSB)}; }
                else if (op == 1) for (int rep = 0; rep < PROBE_THIN_REPS; ++rep) conv_phase(rec, xc, p.in[I_LRU_CW] + j * 4 * D, p.in[I_LRU_CB] + j * D, gtid, NGT);
                else if (op == 2) { gk = 2; g = pg8::Gemm{xc, wtl + OFF_GT / 2, M, 2048, 256, 1024, 256, 512}; }
                else if (op == 3) for (int rep = 0; rep < PROBE_THIN_REPS; ++rep) scanA(Ab, Bb, SA, SB, tid);
                else if (op == 4) for (int rep = 0; rep < PROBE_THIN_REPS; ++rep) scanC(Ab, Bb, SA, SB, gate, hg, tid);
                else { gk = 3; g = pg8::Gemm{hg, wtl + OFF_LOUT / 2, M, 1024, 1024, 1024, 1024, 0}; }
            }
            if (STAGGER_TICKS > 0 && op == 7) {
                unsigned bx_ = bar_x; asm volatile("" : "+s"(bx_));
                const unsigned long long t0_ = __builtin_amdgcn_s_memrealtime(), want_ = (unsigned long long)(bx_ & 7u) * STAGGER_TICKS;
                while (__builtin_amdgcn_s_memrealtime() - t0_ < want_) __builtin_amdgcn_s_sleep(8); }
            for (int rep = 0; rep < ((gk != 3 && (PROBE_GEMM_OP == -1 || op == PROBE_GEMM_OP || (PROBE_GEMM_OP == -2 && op != 7))) ? PROBE_GEMM_REPS : 1); ++rep)
            if (gk == 1) { pg8::StaticOrder S; S.init(g.M, g.N, G, (int)blockIdx.x);
                pg8::gemm_phase<pg8::EpiB, pg8::StaticOrder, true>((PG8_LAS unsigned char*)lds, g, S, E, tid); }
            else if (gk == 2) { pg8::StaticOrder S; S.init(g.M, g.N, G, (int)blockIdx.x);
                const pg8::EpiGate EG{(const u16*)(U + U_XC), (u16*)(U + U_LA), (u16*)(U + U_B), p.in[I_LRU_BA] + j * D, p.in[I_LRU_BX] + j * D, p.in[I_LRU_LAM] + j * D};
                pg8::gemm_phase<pg8::EpiGate, pg8::StaticOrder, true>((PG8_LAS unsigned char*)lds, g, S, EG, tid); }
            else if (gk == 3) { pg8::StaticOrder S; S.init(g.M, g.N, G, (int)blockIdx.x);
                const unsigned target = 32u * (unsigned)(layer * 2 + (op == 8 ? 2 : 1));
                const pg8::RowStats st1{(float*)(ws + WS_XS1), (unsigned*)(ws + WS_CNT1), target};
                const pg8::EpiNormRes EN{hn, (float*)(ws + (op == 8 ? WS_XSB : WS_XSA)), x, gprev, gpost, gpre, st1, (PG8_LAS unsigned char*)lds + XL_OFF, op == 8 ? (const float*)(ws + WS_XSA) : nullptr};
                pg8::gemm_phase<pg8::EpiNormRes, pg8::StaticOrder, true>((PG8_LAS unsigned char*)lds, g, S, EN, tid); }
            if (!(layer == 3 && op == 8) && !(!lru && op == 2)) { for (int rep = 0; rep < PROBE_SYNC_REPS; ++rep) GRID_BAR(); }
        }
    }
}
}

extern "C" void kernel_launch(void* const* d_in, const int* in_sizes, int n_in, void* d_out, int out_size, void* d_ws, size_t ws_size, hipStream_t stream) {
    static int grid = 0;
    if (grid == 0) {
        if (n_in != 23 || in_sizes[0] != mk::M * mk::D || out_size != mk::M * mk::D || ws_size < mk::WS_END) {
            fprintf(stderr, "kernel_launch: unexpected shapes (n_in %d, in0 %d, out %d, ws %zu); nothing launched\n", n_in, n_in > 0 ? in_sizes[0] : -1, out_size, ws_size); grid = -1; return; }
        int dev = 0, cus = 0, per_cu = 0;
        (void)hipGetDevice(&dev); (void)hipDeviceGetAttribute(&cus, hipDeviceAttributeMultiprocessorCount, dev);
        if (hipFuncSetAttribute((const void*)mk::fwd_mega, hipFuncAttributeMaxDynamicSharedMemorySize, mk::LDS_BYTES) != hipSuccess) { fprintf(stderr, "kernel_launch: hipFuncSetAttribute failed\n"); grid = -1; return; }
        if (hipOccupancyMaxActiveBlocksPerMultiprocessor(&per_cu, (const void*)mk::fwd_mega, 512, mk::LDS_BYTES) != hipSuccess || per_cu < 1) { fprintf(stderr, "kernel_launch: occupancy query says %d blocks per CU\n", per_cu); per_cu = 1; }
        (void)hipGetLastError();
        grid = cus > 0 ? cus : 256;
    }
    if (grid < 0) return;
    mk::Params p{};
    for (int i = 0; i < 23; ++i) p.in[i] = (const float*)d_in[i];
    p.out = (float*)d_out; p.ws = (unsigned char*)d_ws;
    if (hipMemsetAsync((char*)d_ws + mk::WS_BAR, 0, mk::CTL_BYTES, stream) != hipSuccess) { fprintf(stderr, "kernel_launch: hipMemsetAsync failed\n"); return; }
    void* args[] = {&p};
    hipError_t e = hipLaunchCooperativeKernel((const void*)mk::fwd_mega, dim3(grid), dim3(512), args, mk::LDS_BYTES, stream);
    if (e != hipSuccess) fprintf(stderr, "kernel_launch: cooperative launch failed: %s (grid %d)\n", hipGetErrorString(e), grid);
}
```

```cpp
#include <hip/hip_runtime.h>
#include <hip/hip_bf16.h>
#include <hip/hip_cooperative_groups.h>
#include <cstdio>
#include <cstdint>
namespace cg = cooperative_groups;

__device__ __forceinline__ float xor1f(float v)  { return __int_as_float(__builtin_amdgcn_mov_dpp(__float_as_int(v), 0xB1, 0xF, 0xF, false)); }
__device__ __forceinline__ float xor2f(float v)  { return __int_as_float(__builtin_amdgcn_mov_dpp(__float_as_int(v), 0x4E, 0xF, 0xF, false)); }
__device__ __forceinline__ float xor4f(float v)  { return __int_as_float(__builtin_amdgcn_ds_swizzle(__float_as_int(v), 0x101F)); }
__device__ __forceinline__ float xor8f(float v)  { return __int_as_float(__builtin_amdgcn_ds_swizzle(__float_as_int(v), 0x201F)); }
__device__ __forceinline__ float xor16f(float v) { return __int_as_float(__builtin_amdgcn_ds_swizzle(__float_as_int(v), 0x401F)); }
__device__ __forceinline__ float sum32f(float v) { auto rr = __builtin_amdgcn_permlane32_swap(__float_as_uint(v), __float_as_uint(v), false, false); return __uint_as_float(rr[0]) + __uint_as_float(rr[1]); }
__device__ __forceinline__ int lane_id_fresh() { int l; asm volatile("v_mbcnt_lo_u32_b32 %0, -1, 0\n\tv_mbcnt_hi_u32_b32 %0, -1, %0" : "=v"(l)); return l; }
namespace pg8 {
#define PG8_LAS __attribute__((address_space(3)))
typedef unsigned short bf16_t;
typedef short bf16x8 __attribute__((ext_vector_type(8)));
typedef float f32x4 __attribute__((ext_vector_type(4)));
typedef unsigned u32x4 __attribute__((ext_vector_type(4)));
constexpr int BM = 256, BK = 64, HALF = 128, HTB = HALF * BK * 2  , STAGE_BYTES = 8 * HTB, NXCD = 8, WGM = 8;

__host__ __device__ __forceinline__ int lds_byte(int r, int c) { const int st = (r >> 4) * 2 + (c >> 5), rr = r & 15, cc = c & 31, ob = rr * 64 + cc * 2; return st * 1024 + (ob ^ (((ob >> 9) & 1) << 5)); }
__host__ __device__ __forceinline__ void stage_rc(int b, int& R, int& C) { const int st = b / 1024, sb = b % 1024, swz = sb ^ (((sb >> 9) & 1) << 5); R = (st >> 1) * 16 + swz / 64; C = (st & 1) * 32 + (swz % 64) / 2; }
__host__ __device__ __forceinline__ int perm32(int rho) { const int n = rho >> 4, i = rho & 15; return 8 * (i >> 2) + 4 * n + (i & 3); }

struct Unit { int pm, pn; };
struct Gemm { const bf16_t* A; const bf16_t* Bt; int M, N, K; int lda, ldb; int apn; };

struct StaticOrder {
    int nM, nN, nwg, G, c;
    __host__ __device__ void init(int M, int N, int G_, int c_) { nM = M / BM; nN = N / BM; nwg = nM * nN; G = G_; c = c_; }
    __host__ __device__ bool next(int i, Unit& u) const {
        const long L = (long)i * G + c; if (L >= nwg) return false;
        int wgid = (int)L; { const int q = nwg / NXCD, r = nwg % NXCD, xcd = wgid % NXCD, off = wgid / NXCD; wgid = (xcd < r ? xcd * (q + 1) : r * (q + 1) + (xcd - r) * q) + off; }
        const int nig = WGM * nN, gid = wgid / nig, fm = gid * WGM, gsz = (nM - fm) < WGM ? (nM - fm) : WGM;
        u.pm = fm + ((wgid % nig) % gsz); u.pn = (wgid % nig) / gsz; return true;
    }
    __device__ __forceinline__ void a_ready(const Unit&) const {}
    __device__ __forceinline__ void done(const Unit&) const {}
};

__device__ __forceinline__ unsigned cvt_pk_bf16(float lo, float hi) { unsigned r; asm volatile("v_cvt_pk_bf16_f32 %0, %1, %2" : "=v"(r) : "v"(lo), "v"(hi)); return r; }
__device__ __forceinline__ float gelu_tanh(float x) {
    const float z = 0.7978845608028654f * (x + 0.044715f * x * x * x);
    const float e = __expf(2.0f * z);
    const float th = 1.0f - 2.0f * __builtin_amdgcn_rcpf(1.0f + e);
    return 0.5f * x * (1.0f + th);
}
struct EpiB {
    static constexpr bool PERM = true, AFTER_DRAIN = false, FUSED = false;
    bf16_t* O; int ldc; int split_cols; size_t split_stride; int mode;
    const float* rss;
    __device__ __forceinline__ void operator()(const f32x4 (&acc)[2][2][4][2], const Unit& u, int wr, int wc, int fr, int fq) const {
        const int row0 = u.pm * BM + wr * 64 + fr; int colt = u.pn * BM; bf16_t* base = O; int t = 0;
        if (split_cols) { t = colt / split_cols; base += (size_t)t * split_stride; colt -= t * split_cols; }
        const int act = (mode == 1) ? 1 : ((mode == 2 && t == 0) ? 2 : 0);
        const int col0 = colt + wc * 32 + 8 * fq;
#pragma unroll
        for (int ai = 0; ai < 2; ++ai)
#pragma unroll
            for (int m = 0; m < 4; ++m) { bf16_t* rowp = base + (size_t)(row0 + ai * HALF + m * 16) * ldc + col0;
                float rsc = 1.0f; if (rss) { const f32x4 pp = *(const f32x4*)(rss + (size_t)(row0 + ai * HALF + m * 16) * 4); rsc = rsqrtf(((pp[0] + pp[1]) + (pp[2] + pp[3])) * (1.0f / 1024.0f) + 1e-6f); }
#pragma unroll
                for (int bj = 0; bj < 2; ++bj) { f32x4 v0 = acc[ai][bj][m][0] * rsc, v1 = acc[ai][bj][m][1] * rsc;
                    if (act == 1) {
#pragma unroll
                        for (int e = 0; e < 4; ++e) { const float a = fmaxf(v0[e], 0.f), b = fmaxf(v1[e], 0.f); v0[e] = a * a; v1[e] = b * b; } }
                    else if (act == 2) {
#pragma unroll
                        for (int e = 0; e < 4; ++e) { v0[e] = gelu_tanh(v0[e]); v1[e] = gelu_tanh(v1[e]); } }
                    u32x4 w; w.x = cvt_pk_bf16(v0[0], v0[1]); w.y = cvt_pk_bf16(v0[2], v0[3]); w.z = cvt_pk_bf16(v1[0], v1[1]); w.w = cvt_pk_bf16(v1[2], v1[3]);
                    *(u32x4*)(rowp + bj * HALF) = w; } }
    }
};
__device__ __forceinline__ float bf2f(unsigned short h) { return __uint_as_float(((unsigned)h) << 16); }
__device__ __forceinline__ float sigmoidf_(float x) { return __builtin_amdgcn_rcpf(1.0f + __expf(-x)); }
__device__ __forceinline__ float one_minus_exp(float t) { const float ser = -t * (1.0f + t * (0.5f + t * (0.16666667f + t * (0.041666668f + t * 0.008333334f)))); return t > -0.25f ? ser : 1.0f - __expf(t); }
struct EpiGate {
    static constexpr bool PERM = false, AFTER_DRAIN = false, FUSED = false;
    const bf16_t* xc; bf16_t* Aout; bf16_t* Bout; const float* b_a; const float* b_x; const float* lam;
    __device__ __forceinline__ void operator()(const f32x4 (&acc)[2][2][4][2], const Unit& u, int wr, int wc, int fr, int fq) const {
#pragma unroll
        for (int n = 0; n < 2; ++n) {
            const int ch0 = 128 * u.pn + 32 * wc + 16 * n + 4 * fq;
            const f32x4 ba = *(const f32x4*)(b_a + ch0), bx = *(const f32x4*)(b_x + ch0), lm = *(const f32x4*)(lam + ch0);
            f32x4 sp;
#pragma unroll
            for (int e = 0; e < 4; ++e) sp[e] = -8.0f * log1pf(__expf(-lm[e]));
#pragma unroll
            for (int ai = 0; ai < 2; ++ai)
#pragma unroll
                for (int m = 0; m < 4; ++m) {
                    const size_t off = (size_t)(u.pm * BM + ai * HALF + wr * 64 + m * 16 + fr) * 1024 + ch0;
                    const uint2 xr = *(const uint2*)(xc + off);
                    float xv[4] = { __uint_as_float(xr.x << 16), __uint_as_float(xr.x & 0xffff0000u), __uint_as_float(xr.y << 16), __uint_as_float(xr.y & 0xffff0000u) };
                    f32x4 av, bv;
#pragma unroll
                    for (int e = 0; e < 4; ++e) {
                        const float r = sigmoidf_(acc[ai][0][m][n][e] + ba[e]);
                        const float ig = sigmoidf_(acc[ai][1][m][n][e] + bx[e]);
                        const float la = sp[e] * r;
                        av[e] = la;
                        bv[e] = __builtin_amdgcn_sqrtf(fmaxf(one_minus_exp(2.0f * la), 0.f)) * (ig * xv[e]);
                    }
                    uint2 wa, wb; wa.x = cvt_pk_bf16(av[0], av[1]); wa.y = cvt_pk_bf16(av[2], av[3]); wb.x = cvt_pk_bf16(bv[0], bv[1]); wb.y = cvt_pk_bf16(bv[2], bv[3]);
                    *(uint2*)(Aout + off) = wa; *(uint2*)(Bout + off) = wb;
                }
        }
    }
};

struct RowStats {
    float* xbuf;
    unsigned* cnt;
    unsigned target;
    __device__ __forceinline__ void run(const f32x4 (&v)[2][2][4][2], const Unit& u, int wr, int wc, int fr, int fq, PG8_LAS unsigned char* xl, int wid, int lane) const {
        PG8_LAS float* P = (PG8_LAS float*)xl;
        PG8_LAS float* S = (PG8_LAS float*)(xl + 4096);
#pragma unroll
        for (int ai = 0; ai < 2; ++ai)
#pragma unroll
            for (int m = 0; m < 4; ++m) {
                float s = 0.f;
#pragma unroll
                for (int bj = 0; bj < 2; ++bj)
#pragma unroll
                    for (int n = 0; n < 2; ++n) { const f32x4 x = v[ai][bj][m][n]; s += (x[0] * x[0] + x[1] * x[1]) + (x[2] * x[2] + x[3] * x[3]); }
                s += xor16f(s); s = sum32f(s);
                if (fq == 0) P[(ai * HALF + wr * 64 + m * 16 + fr) * 4 + wc] = s;
            }
        asm volatile("s_waitcnt lgkmcnt(0)" ::: "memory"); __builtin_amdgcn_s_barrier(); asm volatile("" ::: "memory");
        const int row = wid * 32 + (lane & 31);
        if (lane < 32) { const float t = (P[row * 4 + 0] + P[row * 4 + 1]) + (P[row * 4 + 2] + P[row * 4 + 3]);
            __hip_atomic_store(xbuf + (size_t)(u.pm * BM + row) * 4 + u.pn, t, __ATOMIC_RELAXED, __HIP_MEMORY_SCOPE_AGENT); }
        asm volatile("s_waitcnt vmcnt(0)" ::: "memory");
        if (lane == 0) __hip_atomic_fetch_add(cnt + 64 * u.pm, 1u, __ATOMIC_RELAXED, __HIP_MEMORY_SCOPE_AGENT);
        if (wid == 0) { unsigned sp = 0;
            while ((unsigned)__builtin_amdgcn_readfirstlane(__hip_atomic_load(cnt + 64 * u.pm, __ATOMIC_RELAXED, __HIP_MEMORY_SCOPE_AGENT)) < target) { __builtin_amdgcn_s_sleep(2); if (++sp > (1u << 18)) break; }
            __builtin_amdgcn_fence(__ATOMIC_ACQUIRE, "agent"); }
        asm volatile("s_waitcnt vmcnt(0) lgkmcnt(0)" ::: "memory"); __builtin_amdgcn_s_barrier(); asm volatile("" ::: "memory");
        if (lane < 32) { float* slot = xbuf + (size_t)(u.pm * BM + row) * 4; float t = 0.f;
#pragma unroll
            for (int k = 0; k < 4; ++k) t += __hip_atomic_load(slot + k, __ATOMIC_RELAXED, __HIP_MEMORY_SCOPE_AGENT);
            S[row] = t; }
        asm volatile("s_waitcnt lgkmcnt(0)" ::: "memory"); __builtin_amdgcn_s_barrier(); asm volatile("" ::: "memory");
    }
};
struct EpiNormRes {
    static constexpr bool PERM = false, AFTER_DRAIN = false, FUSED = true;
    bf16_t* hn; float* xs2; float* out; const float* gprev; const float* gpost; const float* gpre; RowStats st1; PG8_LAS unsigned char* xl;
    const float* s_in;
    __device__ __forceinline__ void fused(f32x4 (&acc)[2][2][4][2], const Unit& u, int wr, int wc, int fr, int fq, int wid, int lane) const {
        typedef unsigned u32x2v __attribute__((ext_vector_type(2)));
        PG8_LAS float* P = (PG8_LAS float*)xl;
        const PG8_LAS float* S = (const PG8_LAS float*)(xl + 4096);
        const int col0 = u.pn * BM + wc * 32 + 4 * fq;
        st1.run(acc, u, wr, wc, fr, fq, xl, wid, lane);
#pragma unroll
        for (int ai = 0; ai < 2; ++ai)
#pragma unroll
            for (int m = 0; m < 4; ++m) { const int r = ai * HALF + wr * 64 + m * 16 + fr; float rstd = rsqrtf(S[r] * (1.0f / 1024.0f) + 1e-6f); const size_t off = (size_t)(u.pm * BM + r) * 1024 + col0;
                if (s_in) { const f32x4 pp = *(const f32x4*)(s_in + (size_t)(u.pm * BM + r) * 4); const float s2 = __builtin_amdgcn_rcpf(((pp[0] + pp[1]) + (pp[2] + pp[3])) * (1.0f / 1024.0f) + 1e-6f);
                    rstd = rsqrtf(S[r] * (1.0f / 1024.0f) * s2 * s2 + 1e-6f) * s2; }
#pragma unroll
                for (int bj = 0; bj < 2; ++bj)
#pragma unroll
                    for (int n = 0; n < 2; ++n) { const u32x2v hw = *(const u32x2v*)(hn + off + bj * HALF + n * 16);
                        const f32x4 gp = *(const f32x4*)(gprev + col0 + bj * HALF + n * 16); const f32x4 gv = *(const f32x4*)(gpost + col0 + bj * HALF + n * 16);
                        f32x4 xs; xs[0] = __uint_as_float(hw.x << 16) * __builtin_amdgcn_rcpf(gp[0]); xs[1] = __uint_as_float(hw.x & 0xffff0000u) * __builtin_amdgcn_rcpf(gp[1]);
                        xs[2] = __uint_as_float(hw.y << 16) * __builtin_amdgcn_rcpf(gp[2]); xs[3] = __uint_as_float(hw.y & 0xffff0000u) * __builtin_amdgcn_rcpf(gp[3]);
                        acc[ai][bj][m][n] = xs + (acc[ai][bj][m][n] * rstd) * gv; }
                asm volatile("" : "+v"(acc[ai][0][m][0]), "+v"(acc[ai][0][m][1]), "+v"(acc[ai][1][m][0]), "+v"(acc[ai][1][m][1]));
                if (m & 1) asm volatile("" ::: "memory"); }
        if (gpre) {
#pragma unroll
            for (int ai = 0; ai < 2; ++ai)
#pragma unroll
                for (int m = 0; m < 4; ++m) {
                    float s = 0.f;
#pragma unroll
                    for (int bj = 0; bj < 2; ++bj)
#pragma unroll
                        for (int n = 0; n < 2; ++n) { const f32x4 x = acc[ai][bj][m][n]; s += (x[0] * x[0] + x[1] * x[1]) + (x[2] * x[2] + x[3] * x[3]); }
                    s += xor16f(s); s = sum32f(s);
                    if (fq == 0) P[(ai * HALF + wr * 64 + m * 16 + fr) * 4 + wc] = s;
                }
            asm volatile("s_waitcnt lgkmcnt(0)" ::: "memory"); __builtin_amdgcn_s_barrier(); asm volatile("" ::: "memory");
            { const int row = wid * 32 + (lane & 31);
              if (lane < 32) xs2[(size_t)(u.pm * BM + row) * 4 + u.pn] = (P[row * 4 + 0] + P[row * 4 + 1]) + (P[row * 4 + 2] + P[row * 4 + 3]); }
#pragma unroll
            for (int ai = 0; ai < 2; ++ai)
#pragma unroll
                for (int m = 0; m < 4; ++m) { const int r = ai * HALF + wr * 64 + m * 16 + fr; const size_t off = (size_t)(u.pm * BM + r) * 1024 + col0;
#pragma unroll
                    for (int bj = 0; bj < 2; ++bj)
#pragma unroll
                        for (int n = 0; n < 2; ++n) { const f32x4 gv = *(const f32x4*)(gpre + col0 + bj * HALF + n * 16); const f32x4 o = acc[ai][bj][m][n] * gv;
                            u32x2v w; w.x = cvt_pk_bf16(o[0], o[1]); w.y = cvt_pk_bf16(o[2], o[3]); *(u32x2v*)(hn + off + bj * HALF + n * 16) = w; }
                    asm volatile("" ::: "memory"); }
            asm volatile("s_waitcnt lgkmcnt(0)" ::: "memory"); __builtin_amdgcn_s_barrier(); asm volatile("" ::: "memory");
        } else {
#pragma unroll
            for (int ai = 0; ai < 2; ++ai)
#pragma unroll
                for (int m = 0; m < 4; ++m) { const int r = ai * HALF + wr * 64 + m * 16 + fr; const size_t off = (size_t)(u.pm * BM + r) * 1024 + col0;
#pragma unroll
                    for (int bj = 0; bj < 2; ++bj)
#pragma unroll
                        for (int n = 0; n < 2; ++n) *(f32x4*)(out + off + bj * HALF + n * 16) = acc[ai][bj][m][n]; }
        }
    }
};

template <class Epi, class Sched, bool ALIGN_EPI>
__device__ __forceinline__ void gemm_phase(PG8_LAS unsigned char* lds, const Gemm g, const Sched& S, const Epi& E, int tid0) {
    int tid_ = tid0; asm volatile("" : "+v"(tid_));
    const int tid = tid_, wid = __builtin_amdgcn_readfirstlane(tid >> 6), lane = tid & 63, wr = wid >> 2, wc = wid & 3, fr = lane & 15, fq = lane >> 4;
    const int K = g.K, nt = K / BK;
    unsigned voffA[2], voffB[2];
#pragma unroll
    for (int i = 0; i < 2; ++i) { int R, C; stage_rc(tid * 16 + i * 8192, R, C); const int Rb = Epi::PERM ? ((R & ~31) + perm32(R & 31)) : R;
        voffA[i] = (unsigned)(R * g.lda + C) * 2u; voffB[i] = (unsigned)(Rb * g.ldb + C) * 2u; }
    const size_t kstep = (size_t)(BK * 2);
    const size_t hstepA = (size_t)HALF * g.lda * 2, hstepB = (size_t)HALF * g.ldb * 2;
    const size_t tstepA = 2 * hstepA, tstepB = 2 * hstepB;
    const unsigned ldsw = (unsigned)wid * 1024u;
    const int aoff = lds_byte(wr * 64 + fr, fq * 8), boff = lds_byte(wc * 32 + fr, fq * 8);
#define PG8_SA(b, h) (((b) * 2 + (h)) * HTB)
#define PG8_SB(b, h) ((4 + (b) * 2 + (h)) * HTB)
#define PG8_STAGE(bufoff, gbase, voff) do { _Pragma("unroll") for (int _i = 0; _i < 2; ++_i) \
        __builtin_amdgcn_global_load_lds((const unsigned*)((const char*)(gbase) + (voff)[_i]), (PG8_LAS unsigned*)(lds + (bufoff) + ldsw + _i * 8192), 16, 0, 0); } while (0)
#define PG8_LDA(dst, b, h) do { _Pragma("unroll") for (int m = 0; m < 4; ++m) _Pragma("unroll") for (int k = 0; k < 2; ++k) dst[m][k] = *(const PG8_LAS bf16x8*)(lds + PG8_SA(b, h) + aoff + m * 2048 + k * 1024); } while (0)
#define PG8_LDB(dst, b, h) do { _Pragma("unroll") for (int n = 0; n < 2; ++n) _Pragma("unroll") for (int k = 0; k < 2; ++k) dst[n][k] = *(const PG8_LAS bf16x8*)(lds + PG8_SB(b, h) + boff + n * 2048 + k * 1024); } while (0)
#define PG8_MMA(ai, bj, At, Bt) do { __builtin_amdgcn_s_setprio(1); _Pragma("unroll") for (int m = 0; m < 4; ++m) _Pragma("unroll") for (int n = 0; n < 2; ++n) _Pragma("unroll") for (int k = 0; k < 2; ++k) \
        acc[ai][bj][m][n] = __builtin_amdgcn_mfma_f32_16x16x32_bf16(Bt[n][k], At[m][k], acc[ai][bj][m][n], 0, 0, 0); __builtin_amdgcn_s_setprio(0); } while (0)
#define PG8_WAIT_V(n) asm volatile("s_waitcnt vmcnt(" #n ")" ::: "memory")
#define PG8_WAIT_L(n) asm volatile("s_waitcnt lgkmcnt(" #n ")" ::: "memory")
#define PG8_BAR __builtin_amdgcn_s_barrier()
#define PG8_SCHED __builtin_amdgcn_sched_barrier(0)
    Unit cur, nxt; int ui = 0;
    if (!S.next(0, cur)) return;
    f32x4 acc[2][2][4][2];
#pragma unroll
    for (int a = 0; a < 2; ++a)
#pragma unroll
        for (int b = 0; b < 2; ++b)
#pragma unroll
            for (int m = 0; m < 4; ++m)
#pragma unroll
                for (int n = 0; n < 2; ++n) acc[a][b][m][n] = (f32x4){0.f, 0.f, 0.f, 0.f};
    bf16x8 At[4][2], B0[2][2], B1[2][2];
    const char* cA = (const char*)g.A + (size_t)cur.pm * tstepA + (size_t)(cur.pn >> 1) * (size_t)g.apn; const char* cB = (const char*)g.Bt + (size_t)cur.pn * tstepB;
    S.a_ready(cur);
    PG8_STAGE(PG8_SB(0, 0), cB, voffB); PG8_STAGE(PG8_SB(0, 1), cB + hstepB, voffB); PG8_STAGE(PG8_SA(0, 0), cA, voffA); PG8_STAGE(PG8_SA(0, 1), cA + hstepA, voffA);
    if (wr == 1) PG8_BAR;
    PG8_WAIT_V(2); PG8_BAR;
    PG8_STAGE(PG8_SB(1, 0), cB + kstep, voffB); PG8_STAGE(PG8_SA(1, 0), cA + kstep, voffA); PG8_STAGE(PG8_SB(1, 1), cB + hstepB + kstep, voffB);
    PG8_WAIT_V(6); PG8_BAR;
    for (;;) {
        const bool has_next = S.next(ui + 1, nxt);
        const char* nA = has_next ? (const char*)g.A + (size_t)nxt.pm * tstepA + (size_t)(nxt.pn >> 1) * (size_t)g.apn : cA; const char* nB = has_next ? (const char*)g.Bt + (size_t)nxt.pn * tstepB : cB;
        for (int t = 0; t < nt; t += 2) {
            const bool last = (t == nt - 2);
            const char* a1 = cA + (size_t)(t + 1) * kstep;
            const char* a2 = last ? nA : cA + (size_t)(t + 2) * kstep; const char* b2 = last ? nB : cB + (size_t)(t + 2) * kstep;
            const char* a3 = a2 + kstep; const char* b3 = b2 + kstep;
            if (last && has_next) S.a_ready(nxt);
            PG8_LDB(B0, 0, 0); PG8_LDB(B1, 0, 1); PG8_SCHED; PG8_LDA(At, 0, 0); PG8_STAGE(PG8_SA(1, 1), a1 + hstepA, voffA);
            PG8_WAIT_V(8); PG8_WAIT_L(0); PG8_BAR; PG8_MMA(0, 0, At, B0); PG8_MMA(0, 1, At, B1); PG8_BAR; PG8_SCHED;
            PG8_LDA(At, 0, 1); PG8_STAGE(PG8_SB(0, 0), b2, voffB); PG8_STAGE(PG8_SB(0, 1), b2 + hstepB, voffB); PG8_STAGE(PG8_SA(0, 0), a2, voffA);
            PG8_WAIT_V(8); PG8_WAIT_L(0); PG8_BAR; PG8_MMA(1, 0, At, B0); PG8_MMA(1, 1, At, B1); PG8_BAR; PG8_SCHED;
            PG8_LDB(B0, 1, 0); PG8_LDB(B1, 1, 1); PG8_SCHED; PG8_LDA(At, 1, 0); PG8_STAGE(PG8_SA(0, 1), a2 + hstepA, voffA);
            PG8_WAIT_V(8); PG8_WAIT_L(0); PG8_BAR; PG8_MMA(0, 0, At, B0); PG8_MMA(0, 1, At, B1); PG8_BAR; PG8_SCHED;
            PG8_LDA(At, 1, 1); PG8_STAGE(PG8_SB(1, 0), b3, voffB); PG8_STAGE(PG8_SB(1, 1), b3 + hstepB, voffB); PG8_STAGE(PG8_SA(1, 0), a3, voffA);
            PG8_WAIT_V(8); PG8_WAIT_L(0); PG8_BAR; PG8_MMA(1, 0, At, B0); PG8_MMA(1, 1, At, B1); PG8_BAR; PG8_SCHED;
        }
        if constexpr (ALIGN_EPI) { if (wr == 0) PG8_BAR; }
        if constexpr (Epi::FUSED) E.fused(acc, cur, wr, wc, fr, fq, wid, lane); else E(acc, cur, wr, wc, fr, fq);
        S.done(cur);
        if (!has_next) break;
#pragma unroll
        for (int a = 0; a < 2; ++a)
#pragma unroll
            for (int b = 0; b < 2; ++b)
#pragma unroll
                for (int m = 0; m < 4; ++m)
#pragma unroll
                    for (int n = 0; n < 2; ++n) acc[a][b][m][n] = (f32x4){0.f, 0.f, 0.f, 0.f};
        cur = nxt; cA = nA; cB = nB; ++ui;
        if constexpr (ALIGN_EPI) { if (wr == 1) PG8_BAR; }
    }
    PG8_WAIT_V(0);
    if constexpr (!ALIGN_EPI) { if (wr == 0) PG8_BAR; }
    PG8_BAR;
#undef PG8_SA
#undef PG8_SB
#undef PG8_STAGE
#undef PG8_LDA
#undef PG8_LDB
#undef PG8_MMA
#undef PG8_WAIT_V
#undef PG8_WAIT_L
#undef PG8_BAR
#undef PG8_SCHED
}
}
namespace att {
typedef unsigned short u16;
typedef short bf16x8 __attribute__((ext_vector_type(8)));
typedef short s16x4 __attribute__((ext_vector_type(4)));
typedef float f32x16 __attribute__((ext_vector_type(16)));
typedef float f32x4 __attribute__((ext_vector_type(4)));
typedef unsigned u32x4 __attribute__((ext_vector_type(4)));
constexpr int SEQ = 16384, NW = 8, QBLK = 32, KVBLK = 64, QB = NW * QBLK;
constexpr int LDQ = 1536, LDK = 2048, LDKR = 64, LDO = 1024;
#ifndef ATT_NQREG
#define ATT_NQREG 8
#endif
constexpr int NQREG = ATT_NQREG, NQREG_L = 8 - NQREG;
constexpr int SHM_V = KVBLK * 128 * 2, SHM_K = KVBLK * 128 * 2, SHM_KR = KVBLK * 64 * 2;
constexpr int OFF_V = 0, OFF_K = 2 * SHM_V, OFF_KR = OFF_K + 2 * SHM_K, OFF_WS = OFF_KR + 2 * SHM_KR, OFF_QR = OFF_WS + NW * 64 * 4, QR_WAVE = (NQREG_L + 4) * 1024, LDS_BYTES = OFF_QR + NW * QR_WAVE;
constexpr float SCALE = 0.07216878364870322f;
constexpr float THR = 8.f;

#define KSWZ(row, colB) ((row) * 256 + ((colB) ^ (((row) & 7) << 4)))
#define KRSWZ(row, colB) ((row) * 128 + ((colB) ^ (((row) & 7) << 4)))
#define SBAR() __builtin_amdgcn_sched_barrier(0)
__device__ __forceinline__ int v_st(int k, int c) { const int kk = (k & ~0xC) | ((k & 4) << 1) | ((k & 8) >> 1); return ((kk >> 3) * 4 + (c >> 5)) * 512 + ((kk & 7) * 32 + (c & 31)) * 2; }
__device__ __forceinline__ int v_rd_base(int lane) { return ((lane & 3) << 3) | (((lane >> 2) & 3) << 6) | (((lane >> 4) & 1) << 5) | (((lane >> 5) & 1) << 8); }
constexpr int v_rd_off(int d0, int ks, int half) { return d0 * 512 + ks * 4096 + half * 2048; }
__device__ __forceinline__ int crow(int r, int hi) { return (r & 3) + 8 * (r >> 2) + 4 * hi; }
__device__ __forceinline__ unsigned cvtpk(float lo, float hi) { unsigned r; asm volatile("v_cvt_pk_bf16_f32 %0, %1, %2" : "=v"(r) : "v"(lo), "v"(hi)); return r; }
__device__ __forceinline__ bf16x8 load8(const u16* p) { return *reinterpret_cast<const bf16x8*>(p); }
__device__ __forceinline__ void mask_tile(f32x16& p0, f32x16& p1, int dq, unsigned W) {
    const float NEG = -__builtin_inff();
#pragma unroll
    for (int r = 0; r < 16; ++r) {
        const int c = (r & 3) + 8 * (r >> 2);
        if ((unsigned)(dq - c) >= W) p0[r] = NEG;
        if ((unsigned)(dq - c - 32) >= W) p1[r] = NEG;
    }
}
__device__ __forceinline__ void partialSM(f32x16& p0, f32x16& p1, float& m_reg, float& mn, float& alpha) {
    float pmax = p0[0]; for (int r = 1; r < 16; ++r) pmax = fmaxf(pmax, p0[r]); for (int r = 0; r < 16; ++r) pmax = fmaxf(pmax, p1[r]);
    { auto rr = __builtin_amdgcn_permlane32_swap(__float_as_uint(pmax), __float_as_uint(pmax), false, false);
      pmax = fmaxf(__uint_as_float(rr[0]), __uint_as_float(rr[1])); }
    constexpr float C2 = 1.4426950408889634f * SCALE;
    if (__builtin_expect(__all((pmax - m_reg) * SCALE <= THR), 1)) { mn = m_reg; alpha = 1.f; }
    else { mn = fmaxf(m_reg, pmax); alpha = __builtin_amdgcn_exp2f((m_reg - mn) * C2); m_reg = mn; }
    const float mnL = -mn * C2;
    for (int r = 0; r < 16; ++r) p0[r] = fmaf(p0[r], C2, mnL); for (int r = 0; r < 16; ++r) p1[r] = fmaf(p1[r], C2, mnL);
}
__device__ __forceinline__ void finishSM(f32x16& p0, f32x16& p1, float alpha, float& l_reg, bf16x8& pa0, bf16x8& pa1, bf16x8& pa2, bf16x8& pa3) {
    for (int r = 0; r < 16; ++r) p0[r] = __builtin_amdgcn_exp2f(p0[r]);
    for (int r = 0; r < 16; ++r) p1[r] = __builtin_amdgcn_exp2f(p1[r]);
    float ps = 0; for (int r = 0; r < 16; ++r) ps += p0[r]; for (int r = 0; r < 16; ++r) ps += p1[r];
    { auto rr = __builtin_amdgcn_permlane32_swap(__float_as_uint(ps), __float_as_uint(ps), false, false);
      ps = __uint_as_float(rr[0]) + __uint_as_float(rr[1]); }
    l_reg = l_reg * alpha + ps;
#define PK4(P, B_, OUT) do { unsigned a0 = cvtpk(P[B_+0], P[B_+1]), a1 = cvtpk(P[B_+2], P[B_+3]);                          \
        unsigned b0 = cvtpk(P[B_+4], P[B_+5]), b1 = cvtpk(P[B_+6], P[B_+7]);                                             \
          \
          \
        u32x4 w = {a0, a1, b0, b1}; OUT = *reinterpret_cast<bf16x8*>(&w); } while (0)
    PK4(p0, 0, pa0); PK4(p0, 8, pa1); PK4(p1, 0, pa2); PK4(p1, 8, pa3);
#undef PK4
}
#ifndef ATT_PF
#define ATT_PF 1
#endif
#define QK_SB() __builtin_amdgcn_sched_barrier(0x406)
#define QK_LOAD(s, SET) do { if ((s) < 8) { const char* a_ = kb[(s) & 3] + ((s) >> 2) * 128; fb0[SET] = *reinterpret_cast<const bf16x8*>(a_); fb1[SET] = *reinterpret_cast<const bf16x8*>(a_ + 32 * 256); \
            if ((s) < NQREG) fq[SET] = qr[(s) < NQREG ? (s) : 0]; else fq[SET] = qrl[((s) - NQREG) * 64]; } \
        else { const char* a_ = krb[((s) - 8) & 3]; fb0[SET] = *reinterpret_cast<const bf16x8*>(a_); fb1[SET] = *reinterpret_cast<const bf16x8*>(a_ + 32 * 128); fq[SET] = qrl[(NQREG_L + (s) - 8) * 64]; } } while (0)
template <int KB>
__device__ __forceinline__ void qkt(f32x16& p0, f32x16& p1, const char* K_lds, const char* KR_lds, const bf16x8* qrl, int r32, int hi, const bf16x8* qr) {
    constexpr int PF = ATT_PF, NS = PF + 1;
    p0 = f32x16{}; p1 = f32x16{};
    const char* kb[4]; const char* krb[4];
#pragma unroll
    for (int dd = 0; dd < 4; ++dd) { kb[dd] = K_lds + KB * SHM_K + KSWZ(r32, (dd * 16 + hi * 8) * 2); krb[dd] = KR_lds + KB * SHM_KR + KRSWZ(r32, (dd * 16 + hi * 8) * 2); }
    bf16x8 fb0[NS], fb1[NS], fq[NS];
#pragma unroll
    for (int s = 0; s < PF; ++s) QK_LOAD(s, s % NS);
#pragma unroll
    for (int s = 0; s < 12; ++s) {
        QK_SB();
        if (s + PF < 12) QK_LOAD(s + PF, (s + PF) % NS);
        QK_SB();
        p0 = __builtin_amdgcn_mfma_f32_32x32x16_bf16(fb0[s % NS], fq[s % NS], p0, 0, 0, 0);
        p1 = __builtin_amdgcn_mfma_f32_32x32x16_bf16(fb1[s % NS], fq[s % NS], p1, 0, 0, 0);
    }
    QK_SB();
}
#define FSM_E(j) do { if ((j) < 16) { y0[(j) & 15] = __builtin_amdgcn_exp2f(y0[(j) & 15]); acc += y0[(j) & 15]; } else { y1[(j) & 15] = __builtin_amdgcn_exp2f(y1[(j) & 15]); acc += y1[(j) & 15]; } } while (0)
#define FSM_CVT(P, B_) do { ca0 = cvtpk(P[(B_) + 0], P[(B_) + 1]); ca1 = cvtpk(P[(B_) + 2], P[(B_) + 3]); cb0 = cvtpk(P[(B_) + 4], P[(B_) + 5]); cb1 = cvtpk(P[(B_) + 6], P[(B_) + 7]); } while (0)
#define FSM_SWP(OUT) do { u32x4 w_ = {ca0, ca1, cb0, cb1}; OUT = *reinterpret_cast<bf16x8*>(&w_); } while (0)
#define FSM_CHUNK(c) do { if ((c) < 12) { FSM_E(2 * (c)); FSM_E(2 * (c) + 1); } else if ((c) < 20) { FSM_E(24 + (c) - 12); } \
        if ((c) == 12) FSM_CVT(y0, 0); if ((c) == 13) FSM_SWP(pa0); if ((c) == 14) FSM_CVT(y0, 8); if ((c) == 15) FSM_SWP(pa1); \
        if ((c) == 16) FSM_CVT(y1, 0); if ((c) == 17) FSM_SWP(pa2); if ((c) == 20) FSM_CVT(y1, 8); if ((c) == 21) FSM_SWP(pa3); \
        if ((c) == 22) { auto rr_ = __builtin_amdgcn_permlane32_swap(__float_as_uint(acc), __float_as_uint(acc), false, false); acc = __uint_as_float(rr_[0]) + __uint_as_float(rr_[1]); } \
        if ((c) == 23) l_reg = l_reg * alpha + acc; } while (0)
#define SB0() __builtin_amdgcn_sched_barrier(0)
#define QKN(j) ((j) >= 12 ? 0 : ((j) < NQREG ? 2 : 3))
#define DSR128(dst, addr, off) asm volatile("ds_read_b128 %0, %1 offset:%2" : "=v"(dst) : "v"(addr), "i"(off) : "memory")
#define QKA_LOAD(s, SET) do { if ((s) < 8) { DSR128(fb0[SET], ka[(s) & 3], KB * SHM_K + ((s) >> 2) * 128); DSR128(fb1[SET], ka[(s) & 3], KB * SHM_K + ((s) >> 2) * 128 + 32 * 256); \
            if ((s) >= NQREG) DSR128(fq[SET], qa, (((s) - NQREG) & 15) * 1024); } \
        else if ((s) < 12) { DSR128(fb0[SET], kra[((s) - 8) & 3], KB * SHM_KR); DSR128(fb1[SET], kra[((s) - 8) & 3], KB * SHM_KR + 32 * 128); DSR128(fq[SET], qa, ((NQREG_L + (s) - 8) & 15) * 1024); } } while (0)
#define QKQ(s) ((s) < NQREG ? qr[(s) < NQREG ? (s) : 0] : fq[(s) % 3])
#define QKA_STEP(s) do { SB0(); QKA_LOAD((s) + 2, ((s) + 2) % 3); SB0(); \
        asm volatile("s_waitcnt lgkmcnt(%0)" :: "i"(QKN((s) + 1) + QKN((s) + 2)) : "memory"); SB0(); \
        p0 = __builtin_amdgcn_mfma_f32_32x32x16_bf16(fb0[(s) % 3], QKQ(s), p0, 0, 0, 0); SB0(); FSM_CHUNK(2 * (s)); SB0(); \
        p1 = __builtin_amdgcn_mfma_f32_32x32x16_bf16(fb1[(s) % 3], QKQ(s), p1, 0, 0, 0); SB0(); FSM_CHUNK(2 * (s) + 1); } while (0)
template <int KB>
__device__ __forceinline__ void qkt_fsm(f32x16& p0, f32x16& p1, const int (&ka)[4], const int (&kra)[4], int qa, bf16x8 (&fb0)[3], bf16x8 (&fb1)[3], bf16x8 (&fq)[3], const bf16x8* qr,
                                        f32x16& y0, f32x16& y1, float alpha, float& l_reg, bf16x8& pa0, bf16x8& pa1, bf16x8& pa2, bf16x8& pa3) {
    p0 = f32x16{}; p1 = f32x16{};
    float acc = 0.f; unsigned ca0 = 0, ca1 = 0, cb0 = 0, cb1 = 0;
    QKA_STEP(0); QKA_STEP(1); QKA_STEP(2); QKA_STEP(3); QKA_STEP(4); QKA_STEP(5); QKA_STEP(6); QKA_STEP(7); QKA_STEP(8); QKA_STEP(9); QKA_STEP(10); QKA_STEP(11);
    SB0();
}
#undef QKN
#undef QKQ
#undef QKA_STEP
#undef FSM_E
#undef FSM_CVT
#undef FSM_SWP
#undef FSM_CHUNK
#undef QK_LOAD
template <int VB>
__device__ __forceinline__ void pv_tile(f32x16* o, int vb0, bf16x8 pa0, bf16x8 pa1, bf16x8 pa2, bf16x8 pa3) {
#define TRRD(dst, off) asm volatile("ds_read_b64_tr_b16 %0, %1 offset:%2" : "=&v"(dst) : "v"(vb0), "i"(off) : "memory")
#define PV_D0(d0) do { s16x4 l0, l1, l2, l3, h0, h1, h2, h3; constexpr int b_ = OFF_V + VB * SHM_V + v_rd_off(d0, 0, 0); \
        TRRD(l0, b_); TRRD(h0, b_ + 2048); TRRD(l1, b_ + 4096); TRRD(h1, b_ + 6144); TRRD(l2, b_ + 8192); TRRD(h2, b_ + 10240); TRRD(l3, b_ + 12288); TRRD(h3, b_ + 14336); \
        asm volatile("s_waitcnt lgkmcnt(0)" ::: "memory"); SBAR();   \
        o[d0] = __builtin_amdgcn_mfma_f32_32x32x16_bf16(pa0, (bf16x8){l0[0], l0[1], l0[2], l0[3], h0[0], h0[1], h0[2], h0[3]}, o[d0], 0, 0, 0);   \
        o[d0] = __builtin_amdgcn_mfma_f32_32x32x16_bf16(pa1, (bf16x8){l1[0], l1[1], l1[2], l1[3], h1[0], h1[1], h1[2], h1[3]}, o[d0], 0, 0, 0);   \
        o[d0] = __builtin_amdgcn_mfma_f32_32x32x16_bf16(pa2, (bf16x8){l2[0], l2[1], l2[2], l2[3], h2[0], h2[1], h2[2], h2[3]}, o[d0], 0, 0, 0);   \
        o[d0] = __builtin_amdgcn_mfma_f32_32x32x16_bf16(pa3, (bf16x8){l3[0], l3[1], l3[2], l3[3], h3[0], h3[1], h3[2], h3[3]}, o[d0], 0, 0, 0); } while (0)
    PV_D0(0); PV_D0(1); PV_D0(2); PV_D0(3);
}
template <int VB>
__device__ __forceinline__ void pv_tile_sm(f32x16* o, int vb0, bf16x8 pa0, bf16x8 pa1, bf16x8 pa2, bf16x8 pa3, f32x16& p0, f32x16& p1, float& m_reg, float& mn, float& alpha) {
    constexpr float C2 = 1.4426950408889634f * SCALE;
    PV_D0(0);
    float pmax = p0[0];
#pragma unroll
    for (int r = 1; r < 16; ++r) pmax = fmaxf(pmax, p0[r]);
#pragma unroll
    for (int r = 0; r < 16; ++r) pmax = fmaxf(pmax, p1[r]);
    PV_D0(1);
    { auto rr = __builtin_amdgcn_permlane32_swap(__float_as_uint(pmax), __float_as_uint(pmax), false, false);
      pmax = fmaxf(__uint_as_float(rr[0]), __uint_as_float(rr[1])); }
    const bool keep = __all((pmax - m_reg) * SCALE <= THR);
    mn = keep ? m_reg : fmaxf(m_reg, pmax);
    alpha = __builtin_amdgcn_exp2f((m_reg - mn) * C2);
    m_reg = mn;
    const float mnL = -mn * C2;
#pragma unroll
    for (int r = 0; r < 16; ++r) p0[r] = fmaf(p0[r], C2, mnL);
    PV_D0(2);
#pragma unroll
    for (int r = 0; r < 16; ++r) p1[r] = fmaf(p1[r], C2, mnL);
    PV_D0(3);
}
#undef PV_D0
#undef TRRD

struct BlockRef { const u16* Q; const u16* K; const u16* V; const u16* KR; u16* O; int P0; int row0; };
#define VMW() asm volatile("s_waitcnt vmcnt(0)" ::: "memory")
#define ATT_LAS __attribute__((address_space(3)))
#define KDMA(Kp, KRp, k0, bf) do { \
        __builtin_amdgcn_global_load_lds((const unsigned*)((Kp) + (size_t)((k0) + sr) * LDK + ksc), (ATT_LAS unsigned*)(ldsL + OFF_K + (bf) * SHM_K + wid * 1024), 16, 0, 0); \
        __builtin_amdgcn_global_load_lds((const unsigned*)((Kp) + (size_t)((k0) + 32 + sr) * LDK + ksc), (ATT_LAS unsigned*)(ldsL + OFF_K + (bf) * SHM_K + 8192 + wid * 1024), 16, 0, 0); \
        __builtin_amdgcn_global_load_lds((const unsigned*)((KRp) + (size_t)((k0) + krr) * LDKR + krsc), (ATT_LAS unsigned*)(ldsL + OFF_KR + (bf) * SHM_KR + wid * 1024), 16, 0, 0); } while (0)
#define VDMA(Vp, k0, bf) do { \
        __builtin_amdgcn_global_load_lds((const unsigned*)((Vp) + (size_t)((k0) + vk) * LDK + vc), (ATT_LAS unsigned*)(ldsL + OFF_V + (bf) * SHM_V + wid * 1024), 16, 0, 0); \
        __builtin_amdgcn_global_load_lds((const unsigned*)((Vp) + (size_t)((k0) + 32 + vk) * LDK + vc), (ATT_LAS unsigned*)(ldsL + OFF_V + (bf) * SHM_V + 8192 + wid * 1024), 16, 0, 0); } while (0)
#define ATT_MAPS() const int sr = tid >> 4, ksc = ((tid & 15) ^ (sr & 7)) * 8, krr = tid >> 3, krsc = ((tid & 7) ^ (krr & 7)) * 8; ATT_LAS unsigned char* ldsL = (ATT_LAS unsigned char*)lds; \
    const int vk = ((tid >> 7) << 3) | ((tid >> 2) & 7), vc = ((tid >> 5) & 3) * 32 + (tid & 3) * 8
__device__ __forceinline__ void attn_prime(const BlockRef& cur, char* lds, int tid0) {
    int tid_ = tid0; asm volatile("" : "+v"(tid_));
    const int tid = tid_, wid = __builtin_amdgcn_readfirstlane(tid >> 6);
    ATT_MAPS();
    KDMA(cur.K, cur.KR, 0, 0); VDMA(cur.V, 0, 0); VMW();
    __syncthreads();
}
__device__ __forceinline__ void attn_block(const BlockRef& cur, const BlockRef& nxt, char* lds, int tid0, const float* ctab, const float* stab, bf16x8 (&qr)[NQREG > 0 ? NQREG : 1], bool first) {
    int tid_ = tid0; asm volatile("" : "+v"(tid_));
    const int tid = tid_, wid = __builtin_amdgcn_readfirstlane(tid >> 6), lane = tid & 63, r32 = lane & 31, hi = lane >> 5;
    const unsigned W = 0x40000000u;
    const int NT = (cur.P0 + QB - 1) / KVBLK + 1;
    const int qlo = cur.P0 + wid * QBLK, qm = qlo + r32 - 4 * hi;
    char* K_lds = lds + OFF_K; char* KR_lds = lds + OFF_KR;
    float* ws = (float*)(lds + OFF_WS) + wid * 64; float* li_l = ws, * al_l = ws + 32;
    bf16x8* qrl = (bf16x8*)(lds + OFF_QR + wid * QR_WAVE) + lane;
    float m_reg = -1e30f, l_reg = 0; f32x16 o[4] = {};
    ATT_MAPS();
    const int vb0 = (int)(uintptr_t)lds + v_rd_base(lane);
    const u16* Kh = cur.K; const u16* Vh = cur.V; const u16* KRh = cur.KR;
#define RESC(a) do { if (__any((a) < 1.f)) { if (hi == 0) al_l[r32] = (a); asm volatile("s_waitcnt lgkmcnt(0)" ::: "memory");              \
                     for (int d_ = 0; d_ < 4; ++d_) for (int r = 0; r < 16; ++r) o[d_][r] *= al_l[crow(r, hi)]; } } while (0)
#define KBASE(t) ((t) * KVBLK)
#define MASKT(P0_, P1_, t) do { const int kb_ = KBASE(t); if (kb_ + KVBLK - 1 > qlo) mask_tile(P0_, P1_, qm - kb_, W); } while (0)
    f32x16 pA0, pA1, pB0, pB1; float mnA, mnB, alA, alB; bf16x8 pa0, pa1, pa2, pa3;
    int ka[4], kra[4]; const int qa = (int)(uintptr_t)qrl; bf16x8 fb0[3], fb1[3], fq[3];
#pragma unroll
    for (int dd = 0; dd < 4; ++dd) { ka[dd] = (int)(uintptr_t)K_lds + KSWZ(r32, (dd * 16 + hi * 8) * 2); kra[dd] = (int)(uintptr_t)KR_lds + KRSWZ(r32, (dd * 16 + hi * 8) * 2); }
#define QK_PREFETCH(KBN) do { constexpr int KB = (KBN); SB0(); QKA_LOAD(0, 0); QKA_LOAD(1, 1); SB0(); } while (0)
    static_assert(NQREG == 8, "the block-seam Q prefetch below assumes every nope fragment lives in registers");
    if (first) { const u16* qp = cur.Q + (size_t)(wid * QBLK + r32) * LDQ + hi * 8;
#pragma unroll
      for (int d = 0; d < NQREG_L; ++d) qrl[d * 64] = load8(qp + (NQREG + d) * 16);
      const size_t trow = (size_t)(cur.row0 + wid * QBLK + r32) * 32 + hi * 8;
#pragma unroll
      for (int pr = 0; pr < 2; ++pr) {
          const bf16x8 x1 = load8(qp + 128 + pr * 16), x2 = load8(qp + 128 + 32 + pr * 16);
          const f32x4 c0 = *(const f32x4*)(ctab + trow + pr * 16), c1 = *(const f32x4*)(ctab + trow + pr * 16 + 4), s0 = *(const f32x4*)(stab + trow + pr * 16), s1 = *(const f32x4*)(stab + trow + pr * 16 + 4);
          float o1[8], o2[8];
#pragma unroll
          for (int e = 0; e < 8; ++e) { const float a = __uint_as_float(((unsigned)(unsigned short)x1[e]) << 16), b = __uint_as_float(((unsigned)(unsigned short)x2[e]) << 16);
              const float cc = e < 4 ? c0[e & 3] : c1[e & 3], ss = e < 4 ? s0[e & 3] : s1[e & 3]; o1[e] = a * cc - b * ss; o2[e] = b * cc + a * ss; }
          u32x4 w1 = {cvtpk(o1[0], o1[1]), cvtpk(o1[2], o1[3]), cvtpk(o1[4], o1[5]), cvtpk(o1[6], o1[7])}, w2 = {cvtpk(o2[0], o2[1]), cvtpk(o2[2], o2[3]), cvtpk(o2[4], o2[5]), cvtpk(o2[6], o2[7])};
          qrl[(NQREG_L + pr) * 64] = *reinterpret_cast<bf16x8*>(&w1); qrl[(NQREG_L + 2 + pr) * 64] = *reinterpret_cast<bf16x8*>(&w2); }
#pragma unroll
      for (int d0 = 0; d0 < NQREG; ++d0) qr[d0] = load8(qp + d0 * 16); }
    SBAR();
    KDMA(Kh, KRh, KBASE(1), 1); VDMA(Vh, KBASE(1), 1);
    SBAR(); qkt<0>(pA0, pA1, K_lds, KR_lds, qrl, r32, hi, qr);
    MASKT(pA0, pA1, 0); partialSM(pA0, pA1, m_reg, mnA, alA);
    VMW(); __syncthreads();
    QK_PREFETCH(1);
    KDMA(Kh, KRh, KBASE(2), 0);
#define HALF_STEP(PX0, PX1, mnX, alX, PY0, PY1, alY, t, KB, VB) do {                                                          \
        SBAR(); qkt_fsm<KB>(PX0, PX1, ka, kra, qa, fb0, fb1, fq, qr, PY0, PY1, alY, l_reg, pa0, pa1, pa2, pa3); SBAR();                       \
        MASKT(PX0, PX1, (t)); SBAR(); pv_tile_sm<VB>(o, vb0, pa0, pa1, pa2, pa3, PX0, PX1, m_reg, mnX, alX);                  \
        VMW(); __syncthreads();                                                                                               \
        QK_PREFETCH(1 - (KB));                             \
        if ((t) + 2 < NT) KDMA(Kh, KRh, KBASE((t) + 2), KB);                                                                  \
        if ((t) + 1 < NT) VDMA(Vh, KBASE((t) + 1), VB);                                                                       \
        SBAR(); RESC(alX); } while (0)
    for (int t = 1; t + 1 < NT; t += 2) {
        HALF_STEP(pB0, pB1, mnB, alB, pA0, pA1, alA, t, 1, 0);
        HALF_STEP(pA0, pA1, mnA, alA, pB0, pB1, alB, t + 1, 0, 1);
    }
    SBAR(); qkt_fsm<1>(pB0, pB1, ka, kra, qa, fb0, fb1, fq, qr, pA0, pA1, alA, l_reg, pa0, pa1, pa2, pa3); SBAR();
    MASKT(pB0, pB1, NT - 1); SBAR(); pv_tile_sm<0>(o, vb0, pa0, pa1, pa2, pa3, pB0, pB1, m_reg, mnB, alB);
    VMW(); __syncthreads();
    KDMA(nxt.K, nxt.KR, 0, 0); VDMA(nxt.V, 0, 0);
    const u16* nqp = nxt.Q + (size_t)(wid * QBLK + r32) * LDQ + hi * 8;
    bf16x8 nx1[2], nx2[2];
#pragma unroll
    for (int d0 = 0; d0 < NQREG; ++d0) qr[d0] = load8(nqp + d0 * 16);
#pragma unroll
    for (int pr = 0; pr < 2; ++pr) { nx1[pr] = load8(nqp + 128 + pr * 16); nx2[pr] = load8(nqp + 128 + 32 + pr * 16); }
    SBAR(); RESC(alB);
    finishSM(pB0, pB1, alB, l_reg, pa0, pa1, pa2, pa3); SBAR(); pv_tile<1>(o, vb0, pa0, pa1, pa2, pa3);
    SBAR();
    { const size_t trow = (size_t)(nxt.row0 + wid * QBLK + r32) * 32 + hi * 8;
#pragma unroll
      for (int pr = 0; pr < 2; ++pr) {
          const f32x4 c0 = *(const f32x4*)(ctab + trow + pr * 16), c1 = *(const f32x4*)(ctab + trow + pr * 16 + 4), s0 = *(const f32x4*)(stab + trow + pr * 16), s1 = *(const f32x4*)(stab + trow + pr * 16 + 4);
          float o1[8], o2[8];
#pragma unroll
          for (int e = 0; e < 8; ++e) { const float a = __uint_as_float(((unsigned)(unsigned short)nx1[pr][e]) << 16), b = __uint_as_float(((unsigned)(unsigned short)nx2[pr][e]) << 16);
              const float cc = e < 4 ? c0[e & 3] : c1[e & 3], ss = e < 4 ? s0[e & 3] : s1[e & 3]; o1[e] = a * cc - b * ss; o2[e] = b * cc + a * ss; }
          u32x4 w1 = {cvtpk(o1[0], o1[1]), cvtpk(o1[2], o1[3]), cvtpk(o1[4], o1[5]), cvtpk(o1[6], o1[7])}, w2 = {cvtpk(o2[0], o2[1]), cvtpk(o2[2], o2[3]), cvtpk(o2[4], o2[5]), cvtpk(o2[6], o2[7])};
          qrl[(NQREG_L + pr) * 64] = *reinterpret_cast<bf16x8*>(&w1); qrl[(NQREG_L + 2 + pr) * 64] = *reinterpret_cast<bf16x8*>(&w2); } }
    SBAR();
    if (hi == 0) li_l[r32] = l_reg; asm volatile("s_waitcnt lgkmcnt(0)" ::: "memory");
    float rli[16];
#pragma unroll
    for (int r = 0; r < 16; ++r) rli[r] = __builtin_amdgcn_rcpf(li_l[crow(r, hi)]);
    u16* Ow = cur.O + (size_t)(wid * QBLK) * LDO;
#pragma unroll
    for (int r = 0; r < 16; ++r) { const int orow = crow(r, hi);
#pragma unroll
        for (int d0 = 0; d0 < 4; ++d0) { const float v = o[d0][r] * rli[r];
            const float vn = xor1f(v);
            if ((r32 & 1) == 0) *(unsigned*)(Ow + (size_t)orow * LDO + d0 * 32 + r32) = cvtpk(v, vn); } }
    VMW(); __syncthreads();
#undef RESC
#undef KBASE
#undef MASKT
#undef HALF_STEP
#undef QK_PREFETCH
}
struct Tensors { const u16* q; const u16* kv; const u16* kr; u16* o; const float* ctab; const float* stab; };
__device__ __forceinline__ BlockRef make_ref(const Tensors& T, int L, int pass) {
    const int bh = (L & 7) + 8 * (L >> 8), x = (L >> 3) & 31, b = bh >> 3, h = bh & 7, qb = pass ? x : 63 - x;
    BlockRef r; const size_t row0 = (size_t)b * SEQ;
    r.Q = T.q + (row0 + (size_t)qb * QB) * LDQ + h * 192; r.K = T.kv + row0 * LDK + h * 256; r.V = r.K + 128; r.KR = T.kr + row0 * LDKR;
    r.O = T.o + (row0 + (size_t)qb * QB) * LDO + h * 128; r.P0 = qb * QB; r.row0 = b * SEQ + qb * QB;
    return r;
}
__device__ __forceinline__ void attn_phase(char* lds, const Tensors& T, int tid0) {
    const int total = 512, stride = gridDim.x;
    int L = blockIdx.x; if (L >= total) return;
    int pass = 0;
    BlockRef cur = make_ref(T, L, 0);
    attn_prime(cur, lds, tid0);
    bf16x8 qr[NQREG > 0 ? NQREG : 1]; bool first = true;
    for (;;) {
        const bool more_pass = pass == 0, more_item = L + stride < total, last = !more_pass && !more_item;
        int passn = pass + 1, Ln = L;
        if (!more_pass) { passn = 0; Ln = more_item ? L + stride : L; }
        const BlockRef nxt = last ? cur : make_ref(T, Ln, passn);
        attn_block(cur, nxt, lds, tid0, T.ctab, T.stab, qr, first); first = false;
        if (last) break;
        cur = nxt; pass = passn; L = Ln;
    }
}
#undef VMW
#undef KDMA
#undef VDMA
#undef ATT_MAPS
#undef SBAR
}
namespace xb {
#define LAS __attribute__((address_space(3)))
#define XB_TMO      128
#define XB_XCNT(j)  (256  + 64 * (j))
#define XB_XSUB(j)  (1280 + 64 * (j))
#define XB_XGEN(j)  (2304 + 64 * (j))
#define XB_TOP      3328
#define XB_TOPGEN   3392
#define XCD_BAR_WORDS 3456
#define XB_SPIN_CAP (1u << 18)

__device__ __forceinline__ unsigned xb_ld(unsigned* p)              { return __hip_atomic_load(p, __ATOMIC_RELAXED, __HIP_MEMORY_SCOPE_AGENT); }
__device__ __forceinline__ unsigned xb_add(unsigned* p, unsigned v) { return __hip_atomic_fetch_add(p, v, __ATOMIC_RELAXED, __HIP_MEMORY_SCOPE_AGENT); }
__device__ __forceinline__ unsigned xb_xcc_id() { return (unsigned)__builtin_amdgcn_s_getreg((3 << 11) | 20) & 0xFu; }
#define XB_SPIN(cond, bar) do { unsigned _sp = 0; while (cond) { __builtin_amdgcn_s_sleep(1); \
    if ((++_sp & 255u) == 0u) { if (xb_ld(&(bar)[XB_TMO])) break; if (_sp > XB_SPIN_CAP) { atomicAdd(&(bar)[XB_TMO], 1u); break; } } } } while (0)

struct XcdBarrier {
    unsigned* bar; unsigned x;
    volatile LAS unsigned* st;
};

__device__ __forceinline__ XcdBarrier xcd_barrier_post(unsigned* bar, volatile LAS unsigned* st) {
    XcdBarrier b; b.bar = bar; b.x = xb_xcc_id(); b.st = st;
    if (threadIdx.x == 0) (void)xb_add(&bar[XB_XCNT(b.x)], 1u);
    return b;
}
__device__ __forceinline__ void xcd_barrier_complete(unsigned* bar, unsigned x, unsigned& nloc, unsigned& nx) {
    const unsigned G = gridDim.x * gridDim.y * gridDim.z;
    unsigned sum, cnt, mine, sp = 0u;
    for (;;) {
        sum = 0u; cnt = 0u; mine = 0u;
#pragma unroll
        for (unsigned j = 0; j < 16; ++j) { const unsigned c = xb_ld(&bar[XB_XCNT(j)]); sum += c; cnt += (c > 0u) ? 1u : 0u; mine = (j == x) ? c : mine; }
        if (sum == G) break;
        __builtin_amdgcn_s_sleep(1);
        if ((++sp & 255u) == 0u) { if (xb_ld(&bar[XB_TMO])) break; if (sp > XB_SPIN_CAP) { atomicAdd(&bar[XB_TMO], 1u); break; } }
    }
    nloc = mine > 0u ? mine : 1u; nx = cnt > 0u ? cnt : 1u;
}

__device__ __forceinline__ void xcd_barrier(const XcdBarrier& b, bool t0  ) {
    asm volatile("s_waitcnt vmcnt(0)" ::: "memory");
    __syncthreads();
    if (t0) {
        unsigned* bar = b.bar;
        __builtin_amdgcn_s_waitcnt(0);
        unsigned nloc = b.st[0], nx = b.st[1];
        if (nloc == 0u) { xcd_barrier_complete(bar, b.x, nloc, nx); b.st[0] = nloc; b.st[1] = nx; }
        const unsigned old = xb_add(&bar[XB_XSUB(b.x)], 1u);
        const unsigned gen = old / nloc;
        if (old + 1u == (gen + 1u) * nloc) {
            __builtin_amdgcn_fence(__ATOMIC_RELEASE, "agent");
            asm volatile("s_waitcnt vmcnt(0)" ::: "memory");
            const unsigned og = xb_add(&bar[XB_TOP], 1u);
            const unsigned tg = og / nx;
            if (og + 1u == (tg + 1u) * nx) xb_add(&bar[XB_TOPGEN], 1u);
            else XB_SPIN(xb_ld(&bar[XB_TOPGEN]) == tg, bar);
            __builtin_amdgcn_fence(__ATOMIC_ACQUIRE, "agent");
            xb_add(&bar[XB_XGEN(b.x)], 1u);
            asm volatile("s_waitcnt vmcnt(0)" ::: "memory");
        } else {
            XB_SPIN(xb_ld(&bar[XB_XGEN(b.x)]) == gen, bar);
            __builtin_amdgcn_fence(__ATOMIC_ACQUIRE, "agent");
            asm volatile("s_waitcnt vmcnt(0)" ::: "memory");
        }
    }
    __syncthreads();
}
#undef LAS
}
#ifndef PROBE_ATT_REPS
#define PROBE_ATT_REPS 1
#endif
#ifndef PROBE_SYNC_REPS
#define PROBE_SYNC_REPS 1
#endif
#ifndef PROBE_THIN_REPS
#define PROBE_THIN_REPS 1
#endif
#ifndef PROBE_PRO_REPS
#define PROBE_PRO_REPS 1
#endif
#ifndef STAGGER_TICKS
#define STAGGER_TICKS 0
#endif
#ifndef PROBE_GEMM_OP
#define PROBE_GEMM_OP -1
#endif
#ifndef PROBE_GEMM_REPS
#define PROBE_GEMM_REPS 1
#endif
namespace mk {
typedef unsigned short u16;
typedef float f32x4 __attribute__((ext_vector_type(4)));
constexpr int M = 32768, D = 1024, SEQ = 16384;
constexpr float EPS = 1e-6f;
constexpr size_t MB = (size_t)1 << 20;
__host__ __device__ constexpr size_t WT_MLA(int j) { return (size_t)j * 6 * MB; }
__host__ __device__ constexpr size_t WT_LRU(int j) { return 12 * MB + (size_t)j * 8 * MB; }
__host__ __device__ constexpr size_t WT_FFN(int l) { return 28 * MB + (size_t)l * 16 * MB; }
constexpr size_t OFF_UQ = 3 * MB / 2, OFF_UKV = 11 * MB / 4, OFF_WO = 15 * MB / 4, OFF_GT = 4 * MB, OFF_LOUT = 5 * MB, OFF_DOWN = 8 * MB;
constexpr size_t WS_COS = 96 * MB, WS_SIN = 100 * MB, WS_SA = 104 * MB, WS_SB = 105 * MB;
constexpr size_t WS_HN = 112 * MB, WS_Y = 176 * MB, WS_U = 240 * MB, WS_END = 496 * MB;
constexpr size_t U_PROJ = 64 * MB, U_CQ = 112 * MB, U_CKV = 136 * MB, U_KR = 152 * MB, U_Q = 160 * MB, U_O = 64 * MB;
constexpr size_t U_GATE = 0, U_XC = 64 * MB, U_REC = 128 * MB, U_LA = 128 * MB, U_B = 192 * MB;
constexpr size_t WS_XSA = 108 * MB, WS_XSB = 109 * MB;
constexpr size_t WS_RS = 108 * MB;
constexpr int SCAN_L = 128, SCAN_NC = SEQ / SCAN_L;

__device__ __forceinline__ unsigned f2bf(float f) { unsigned u = __float_as_uint(f); return (u + 0x7fffu + ((u >> 16) & 1u)) >> 16; }
__device__ __forceinline__ unsigned pk2(float lo, float hi) { return f2bf(lo) | (f2bf(hi) << 16); }
__device__ __forceinline__ float bflo(unsigned w) { return __uint_as_float(w << 16); }
__device__ __forceinline__ float bfhi(unsigned w) { return __uint_as_float(w & 0xffff0000u); }
__device__ __forceinline__ float bf1(u16 h) { return __uint_as_float(((unsigned)h) << 16); }
__device__ __forceinline__ float wave_sum(float v) {
    v += xor1f(v); v += xor2f(v); v += xor4f(v); v += xor8f(v); v += xor16f(v);
    return sum32f(v);
}
__device__ __forceinline__ void transpose_item(const float* W, int ldw, u16* WT, int ldt, int nblk, float* scr, int item, int lane) {
    const int kb = item / nblk, nb = item % nblk, k0 = 64 * kb, n0 = 32 * nb;
#pragma unroll
    for (int i = 0; i < 8; ++i) { const int kk = 8 * i + (lane >> 3); const f32x4 v = *(const f32x4*)(W + (size_t)(k0 + kk) * ldw + n0 + (lane & 7) * 4);
        float* s = scr + kk * 33 + (lane & 7) * 4; s[0] = v.x; s[1] = v.y; s[2] = v.z; s[3] = v.w; }
    asm volatile("s_waitcnt lgkmcnt(0)" ::: "memory");
    const int c = lane & 7;
#pragma unroll
    for (int j = 0; j < 4; ++j) { const int n = (lane >> 3) + 8 * j; const float* s = scr + (8 * c) * 33 + n;
        uint4 o; o.x = pk2(s[0 * 33], s[1 * 33]); o.y = pk2(s[2 * 33], s[3 * 33]); o.z = pk2(s[4 * 33], s[5 * 33]); o.w = pk2(s[6 * 33], s[7 * 33]);
        *(uint4*)(WT + (size_t)(n0 + n) * ldt + k0 + 8 * c) = o; }
    asm volatile("s_waitcnt lgkmcnt(0)" ::: "memory");
}
struct Params { const float* in[23]; float* out; unsigned char* ws; };
enum { I_X = 0, I_POS, I_MIXPRE, I_MIXPOST, I_FFNPRE, I_FFNPOST, I_MLA_WIN, I_MLA_QN, I_MLA_KVN, I_MLA_WUQ, I_MLA_WUKV, I_MLA_WO,
       I_LRU_WIN, I_LRU_CW, I_LRU_CB, I_LRU_WA, I_LRU_BA, I_LRU_WX, I_LRU_BX, I_LRU_LAM, I_LRU_WOUT, I_FFN_UP, I_FFN_DOWN };

__device__ __forceinline__ void prologue_weights(const __attribute__((address_space(4))) Params& p, float* scr, int gw, int NGW, int lane) {
    u16* wt = (u16*)p.ws;
    constexpr int IT_MLA = 352 + 288 + 256 + 512, IT_LRU = 1024 + 128 + 512, IT_FFN = 4096, TOTAL = 2 * IT_MLA + 2 * IT_LRU + 4 * IT_FFN;
    for (int it = gw; it < TOTAL; it += NGW) {
        int r = it; const float* W; int ldw, ldt, nblk; u16* WT;
        if (r < 2 * IT_MLA) { const int j = r / IT_MLA; r -= j * IT_MLA; u16* base = wt + WT_MLA(j) / 2;
            if (r < 352) { W = p.in[I_MLA_WIN] + (size_t)j * 1024 * 704; ldw = 704; nblk = 22; WT = base; ldt = 1024; }
            else if (r < 640) { r -= 352; W = p.in[I_MLA_WUQ] + (size_t)j * 384 * 1536; ldw = 1536; nblk = 48; WT = base + OFF_UQ / 2; ldt = 384; }
            else if (r < 896) { r -= 640; W = p.in[I_MLA_WUKV] + (size_t)j * 256 * 2048; ldw = 2048; nblk = 64; WT = base + OFF_UKV / 2; ldt = 256; }
            else { r -= 896; W = p.in[I_MLA_WO] + (size_t)j * 1024 * 1024; ldw = 1024; nblk = 32; WT = base + OFF_WO / 2; ldt = 1024; }
        } else if (r < 2 * IT_MLA + 2 * IT_LRU) { r -= 2 * IT_MLA; const int j = r / IT_LRU; r -= j * IT_LRU; u16* base = wt + WT_LRU(j) / 2;
            if (r < 1024) { W = p.in[I_LRU_WIN] + (size_t)j * 1024 * 2048; ldw = 2048; nblk = 64; WT = base; ldt = 1024; }
            else if (r < 1152) { r -= 1024; const int which = r >> 3, gt = which >> 3, n = which & 7; r &= 7;
                W = p.in[gt ? I_LRU_WX : I_LRU_WA] + (size_t)j * 8 * 128 * 128 + (size_t)n * 128 * 128; ldw = 128; nblk = 4;
                WT = base + OFF_GT / 2 + (size_t)(n * 256 + gt * 128) * 256 + 128 * (n & 1); ldt = 256; }
            else { r -= 1152; W = p.in[I_LRU_WOUT] + (size_t)j * 1024 * 1024; ldw = 1024; nblk = 32; WT = base + OFF_LOUT / 2; ldt = 1024; }
        } else { r -= 2 * IT_MLA + 2 * IT_LRU; const int l = r / IT_FFN; r -= l * IT_FFN; u16* base = wt + WT_FFN(l) / 2;
            if (r < 2048) { W = p.in[I_FFN_UP] + (size_t)l * 1024 * 4096; ldw = 4096; nblk = 128; WT = base; ldt = 1024; }
            else { r -= 2048; W = p.in[I_FFN_DOWN] + (size_t)l * 4096 * 1024; ldw = 1024; nblk = 32; WT = base + OFF_DOWN / 2; ldt = 4096; }
        }
        transpose_item(W, ldw, WT, ldt, nblk, scr, r, lane);
    }
}
__device__ __forceinline__ void rowop(const u16* y, const float* xin, float* xout, u16* hn, float* rs, const float* gpost, const float* gpre, int gw, int NGW, int lane) {
    f32x4 gp[4], gq[4];
#pragma unroll
    for (int j = 0; j < 4; ++j) { gp[j] = gpost ? *(const f32x4*)(gpost + j * 256 + lane * 4) : (f32x4){0.f, 0.f, 0.f, 0.f}; gq[j] = gpre ? *(const f32x4*)(gpre + j * 256 + lane * 4) : (f32x4){0.f, 0.f, 0.f, 0.f}; }
    for (int row = gw; row < M; row += NGW) {
        f32x4 xv[4];
#pragma unroll
        for (int j = 0; j < 4; ++j) xv[j] = *(const f32x4*)(xin + (size_t)row * D + j * 256 + lane * 4);
        if (y) {
            f32x4 yv[4]; float ss = 0.f;
#pragma unroll
            for (int j = 0; j < 4; ++j) { const uint2 w = *(const uint2*)(y + (size_t)row * D + j * 256 + lane * 4);
                yv[j] = (f32x4){bflo(w.x), bfhi(w.x), bflo(w.y), bfhi(w.y)}; ss += (yv[j].x * yv[j].x + yv[j].y * yv[j].y) + (yv[j].z * yv[j].z + yv[j].w * yv[j].w); }
            const float r = rsqrtf(wave_sum(ss) * (1.f / D) + EPS);
#pragma unroll
            for (int j = 0; j < 4; ++j) xv[j] = xv[j] + (yv[j] * r) * gp[j];
        }
        if (xout) {
#pragma unroll
        for (int j = 0; j < 4; ++j) *(f32x4*)(xout + (size_t)row * D + j * 256 + lane * 4) = xv[j]; }
        if (gpre) {
            float s2 = 0.f;
#pragma unroll
            for (int j = 0; j < 4; ++j) s2 += (xv[j].x * xv[j].x + xv[j].y * xv[j].y) + (xv[j].z * xv[j].z + xv[j].w * xv[j].w);
            const float tot2 = wave_sum(s2); const float r2 = 1.0f;
            if (rs && lane < 4) rs[(size_t)row * 4 + lane] = lane == 0 ? tot2 : 0.f;
#pragma unroll
            for (int j = 0; j < 4; ++j) { const f32x4 h = (xv[j] * r2) * gq[j]; uint2 w; w.x = pk2(h.x, h.y); w.y = pk2(h.z, h.w);
                *(uint2*)(hn + (size_t)row * D + j * 256 + lane * 4) = w; }
        }
    }
}
__device__ __forceinline__ void qkvnorm(const u16* proj, u16* cq, u16* ckv, u16* kr, const float* qn, const float* kvn, const float* ctab, const float* stab, const float* rss, int gw, int NGW, int lane) {
    float gA[8], gB[8];
    { const float* gp = lane < 48 ? qn + 8 * lane : kvn + (8 * lane - 384); const f32x4 g0 = *(const f32x4*)gp, g1 = *(const f32x4*)(gp + 4);
      gA[0] = g0[0]; gA[1] = g0[1]; gA[2] = g0[2]; gA[3] = g0[3]; gA[4] = g1[0]; gA[5] = g1[1]; gA[6] = g1[2]; gA[7] = g1[3]; }
    { f32x4 g0 = {0.f, 0.f, 0.f, 0.f}, g1 = {0.f, 0.f, 0.f, 0.f}; if (lane < 16) { g0 = *(const f32x4*)(kvn + 128 + 8 * lane); g1 = *(const f32x4*)(kvn + 132 + 8 * lane); }
      gB[0] = g0[0]; gB[1] = g0[1]; gB[2] = g0[2]; gB[3] = g0[3]; gB[4] = g1[0]; gB[5] = g1[1]; gB[6] = g1[2]; gB[7] = g1[3]; }
    const bool ropeL = lane >= 16 && lane < 24; const int rk = (lane & 3) * 8;
    const int cOff = lane < 20 ? 672 + rk : 640 + rk;
    for (int row0 = gw; row0 < M; row0 += 2 * NGW) {
        float A[2][8], B[2][8], C[2][8], rsc[2], sa[2], sb[2];
#pragma unroll
        for (int q = 0; q < 2; ++q) { const int row = row0 + q * NGW; const u16* pr = proj + (size_t)row * 768;
            const f32x4 pp = *(const f32x4*)(rss + (size_t)row * 4); rsc[q] = rsqrtf(((pp[0] + pp[1]) + (pp[2] + pp[3])) * (1.f / D) + EPS);
            const uint4 a = *(const uint4*)(pr + 8 * lane); uint4 b = make_uint4(0u, 0u, 0u, 0u), c = make_uint4(0u, 0u, 0u, 0u);
            if (lane < 24) b = *(const uint4*)(pr + 512 + 8 * lane);
            if (ropeL) c = *(const uint4*)(pr + cOff);
            A[q][0] = bflo(a.x); A[q][1] = bfhi(a.x); A[q][2] = bflo(a.y); A[q][3] = bfhi(a.y); A[q][4] = bflo(a.z); A[q][5] = bfhi(a.z); A[q][6] = bflo(a.w); A[q][7] = bfhi(a.w);
            B[q][0] = bflo(b.x); B[q][1] = bfhi(b.x); B[q][2] = bflo(b.y); B[q][3] = bfhi(b.y); B[q][4] = bflo(b.z); B[q][5] = bfhi(b.z); B[q][6] = bflo(b.w); B[q][7] = bfhi(b.w);
            C[q][0] = bflo(c.x); C[q][1] = bfhi(c.x); C[q][2] = bflo(c.y); C[q][3] = bfhi(c.y); C[q][4] = bflo(c.z); C[q][5] = bfhi(c.z); C[q][6] = bflo(c.w); C[q][7] = bfhi(c.w); }
#pragma unroll
        for (int q = 0; q < 2; ++q) { sa[q] = 0.f; sb[q] = 0.f;
#pragma unroll
            for (int e = 0; e < 8; ++e) { A[q][e] *= rsc[q]; B[q][e] *= rsc[q]; C[q][e] *= rsc[q]; sa[q] += A[q][e] * A[q][e]; sb[q] += B[q][e] * B[q][e]; } }
        float r1[2], r2[2];
#pragma unroll
        for (int q = 0; q < 2; ++q) { const float s1 = wave_sum(lane < 48 ? sa[q] : 0.f), s2 = wave_sum((lane >= 48 ? sa[q] : 0.f) + (lane < 16 ? sb[q] : 0.f));
            r1[q] = rsqrtf(s1 * (1.f / 384.f) + EPS); r2[q] = rsqrtf(s2 * (1.f / 256.f) + EPS); }
#pragma unroll
        for (int q = 0; q < 2; ++q) { const int row = row0 + q * NGW;
            { const float r = lane < 48 ? r1[q] : r2[q]; uint4 o; o.x = pk2(A[q][0] * r * gA[0], A[q][1] * r * gA[1]); o.y = pk2(A[q][2] * r * gA[2], A[q][3] * r * gA[3]);
              o.z = pk2(A[q][4] * r * gA[4], A[q][5] * r * gA[5]); o.w = pk2(A[q][6] * r * gA[6], A[q][7] * r * gA[7]);
              if (lane < 48) *(uint4*)(cq + (size_t)row * 384 + 8 * lane) = o; else *(uint4*)(ckv + (size_t)row * 256 + (8 * lane - 384)) = o; }
            if (lane < 16) { const float r = r2[q]; uint4 o; o.x = pk2(B[q][0] * r * gB[0], B[q][1] * r * gB[1]); o.y = pk2(B[q][2] * r * gB[2], B[q][3] * r * gB[3]);
              o.z = pk2(B[q][4] * r * gB[4], B[q][5] * r * gB[5]); o.w = pk2(B[q][6] * r * gB[6], B[q][7] * r * gB[7]);
              *(uint4*)(ckv + (size_t)row * 256 + 128 + 8 * lane) = o; }
            if (ropeL) { const f32x4 c0 = *(const f32x4*)(ctab + (size_t)row * 32 + rk), c1 = *(const f32x4*)(ctab + (size_t)row * 32 + rk + 4), s0 = *(const f32x4*)(stab + (size_t)row * 32 + rk), s1 = *(const f32x4*)(stab + (size_t)row * 32 + rk + 4);
              float ov[8];
#pragma unroll
              for (int e = 0; e < 8; ++e) { const float cc = e < 4 ? c0[e & 3] : c1[e & 3], ss = e < 4 ? s0[e & 3] : s1[e & 3];
                  ov[e] = lane < 20 ? B[q][e] * cc - C[q][e] * ss
                                    : B[q][e] * cc + C[q][e] * ss; }
              uint4 o; o.x = pk2(ov[0], ov[1]); o.y = pk2(ov[2], ov[3]); o.z = pk2(ov[4], ov[5]); o.w = pk2(ov[6], ov[7]);
              *(uint4*)(kr + (size_t)row * 64 + (lane < 20 ? 0 : 32) + rk) = o; }
        }
    }
}
__device__ __forceinline__ void qrope(u16* q, const float* ctab, const float* stab, int gw, int NGW, int lane) {
    for (int row = gw; row < M; row += NGW) {
        u16* qr = q + (size_t)row * 1536; const int i = lane & 31;
        const float c = ctab[(size_t)row * 32 + i], s = stab[(size_t)row * 32 + i];
#pragma unroll
        for (int j = 0; j < 4; ++j) { const int h = 2 * j + (lane >> 5); u16* pp = qr + h * 192 + 128 + i;
            const float x1 = bf1(pp[0]), x2 = bf1(pp[32]);
            pp[0] = (u16)f2bf(x1 * c - x2 * s); pp[32] = (u16)f2bf(x2 * c + x1 * s); }
    }
}
__device__ __forceinline__ void conv_phase(const u16* rec, u16* xc, const float* cw, const float* cb, int gtid, int NGT) {
    for (int idx = gtid; idx < (M / 32) * 128; idx += NGT) {
        const int r0 = (idx >> 7) * 32, c0 = (idx & 127) * 8;
        float w[4][8], bias[8], win[3][8];
#pragma unroll
        for (int e = 0; e < 8; ++e) { bias[e] = cb[c0 + e];
#pragma unroll
            for (int k = 0; k < 4; ++k) w[k][e] = cw[k * D + c0 + e]; }
        const bool first = (r0 & (SEQ - 1)) == 0;
#pragma unroll
        for (int k = 0; k < 3; ++k) { uint4 v = make_uint4(0u, 0u, 0u, 0u); if (!first) v = *(const uint4*)(rec + (size_t)(r0 - 3 + k) * D + c0);
            win[k][0] = bflo(v.x); win[k][1] = bfhi(v.x); win[k][2] = bflo(v.y); win[k][3] = bfhi(v.y); win[k][4] = bflo(v.z); win[k][5] = bfhi(v.z); win[k][6] = bflo(v.w); win[k][7] = bfhi(v.w); }
        for (int i0 = 0; i0 < 32; i0 += 8) {
            uint4 in[8];
#pragma unroll
            for (int u = 0; u < 8; ++u) in[u] = *(const uint4*)(rec + (size_t)(r0 + i0 + u) * D + c0);
#pragma unroll
            for (int u = 0; u < 8; ++u) {
                const float x[8] = {bflo(in[u].x), bfhi(in[u].x), bflo(in[u].y), bfhi(in[u].y), bflo(in[u].z), bfhi(in[u].z), bflo(in[u].w), bfhi(in[u].w)};
                float acc[8];
#pragma unroll
                for (int e = 0; e < 8; ++e) { acc[e] = bias[e] + win[0][e] * w[0][e] + win[1][e] * w[1][e] + win[2][e] * w[2][e] + x[e] * w[3][e]; win[0][e] = win[1][e]; win[1][e] = win[2][e]; win[2][e] = x[e]; }
                uint4 o; o.x = pk2(acc[0], acc[1]); o.y = pk2(acc[2], acc[3]); o.z = pk2(acc[4], acc[5]); o.w = pk2(acc[6], acc[7]);
                *(uint4*)(xc + (size_t)(r0 + i0 + u) * D + c0) = o;
            }
        }
    }
}
__device__ __forceinline__ void scanA(const u16* A, const u16* B, float* SA, float* SB, int tid) {
    for (int item = blockIdx.x; item < 2 * SCAN_NC; item += gridDim.x) {
        const int c = item % SCAN_NC, b = item / SCAN_NC, ch = 2 * tid;
        const size_t base = ((size_t)b * SEQ + (size_t)c * SCAN_L) * D + ch;
        float h0 = 0.f, h1 = 0.f, P0 = 1.f, P1 = 1.f;
        for (int t0 = 0; t0 < SCAN_L; t0 += 32) {
            unsigned aw[32], bw[32];
#pragma unroll
            for (int u = 0; u < 32; ++u) { aw[u] = *(const unsigned*)(A + base + (size_t)(t0 + u) * D); bw[u] = *(const unsigned*)(B + base + (size_t)(t0 + u) * D); }
#pragma unroll
            for (int u = 0; u < 32; ++u) { const float a0 = __expf(bflo(aw[u])), a1 = __expf(bfhi(aw[u])); h0 = a0 * h0 + bflo(bw[u]); h1 = a1 * h1 + bfhi(bw[u]); P0 *= a0; P1 *= a1; }
        }
        const size_t so = ((size_t)b * SCAN_NC + c) * D + ch;
        *(float2*)(SA + so) = make_float2(P0, P1); *(float2*)(SB + so) = make_float2(h0, h1);
    }
}
__device__ __forceinline__ void scanC(const u16* A, const u16* B, const float* SA, const float* SB, const u16* gate, u16* hg, int tid) {
    for (int item = blockIdx.x; item < 2 * SCAN_NC; item += gridDim.x) {
        const int c = item % SCAN_NC, b = item / SCAN_NC, ch = 2 * tid;
        const size_t base = ((size_t)b * SEQ + (size_t)c * SCAN_L) * D + ch;
        float h0 = 0.f, h1 = 0.f;
        for (int cc0 = 0; cc0 < c; cc0 += 16) {
            float2 pa[16], pb[16];
#pragma unroll
            for (int u = 0; u < 16; ++u) { const int cc = cc0 + u < c ? cc0 + u : c - 1; const size_t so = ((size_t)b * SCAN_NC + cc) * D + ch; pa[u] = *(const float2*)(SA + so); pb[u] = *(const float2*)(SB + so); }
#pragma unroll
            for (int u = 0; u < 16; ++u) { const bool in = cc0 + u < c; const float ax = in ? pa[u].x : 1.f, ay = in ? pa[u].y : 1.f, bx = in ? pb[u].x : 0.f, by = in ? pb[u].y : 0.f; h0 = ax * h0 + bx; h1 = ay * h1 + by; }
        }
        for (int t0 = 0; t0 < SCAN_L; t0 += 16) {
            unsigned aw[16], bw[16], gv[16];
#pragma unroll
            for (int u = 0; u < 16; ++u) { aw[u] = *(const unsigned*)(A + base + (size_t)(t0 + u) * D); bw[u] = *(const unsigned*)(B + base + (size_t)(t0 + u) * D); gv[u] = *(const unsigned*)(gate + base + (size_t)(t0 + u) * D); }
#pragma unroll
            for (int u = 0; u < 16; ++u) { h0 = __expf(bflo(aw[u])) * h0 + bflo(bw[u]); h1 = __expf(bfhi(aw[u])) * h1 + bfhi(bw[u]);
                *(unsigned*)(hg + base + (size_t)(t0 + u) * D) = pk2(bflo(gv[u]) * h0, bfhi(gv[u]) * h1); }
        }
    }
}

constexpr int LDS_GEMM = pg8::STAGE_BYTES + 8192, LDS_MAIN = att::LDS_BYTES > LDS_GEMM ? att::LDS_BYTES : LDS_GEMM, LDS_BYTES = LDS_MAIN + 16;
constexpr size_t WS_BAR = 106 * MB;
constexpr size_t WS_CNT1 = WS_BAR + 16384, WS_CNT2 = WS_BAR + 49152, CTL_BYTES = 81920, WS_XS1 = 107 * MB, WS_XS2 = 107 * MB + MB / 2;
constexpr int XL_OFF = 131072;
static_assert(XL_OFF + 8192 <= LDS_MAIN && XCD_BAR_WORDS * 4 <= 16384 && att::LDS_BYTES <= LDS_MAIN && pg8::STAGE_BYTES <= LDS_MAIN && LDS_BYTES <= 160 * 1024, "LDS map");

__global__ void __launch_bounds__(512, 2) fwd_mega(Params p_arg) {
    extern __shared__ __attribute__((aligned(16))) unsigned char lds[];
    cg::grid_group grid = cg::this_grid();
    (void)p_arg;
    volatile __attribute__((address_space(3))) unsigned* bst = (volatile __attribute__((address_space(3))) unsigned*)((__attribute__((address_space(3))) unsigned char*)lds + LDS_MAIN);
    if (threadIdx.x < 4) bst[threadIdx.x] = 0u;
    __syncthreads();
    const int wave_s = __builtin_amdgcn_readfirstlane(threadIdx.x >> 6);
    const unsigned bar_x = xb::xb_xcc_id();
    (void)xb::xcd_barrier_post((unsigned*)(p_arg.ws + WS_BAR), bst);
#define GRID_BAR() do { unsigned bx_ = bar_x; asm volatile("" : "+s"(bx_)); xb::XcdBarrier bb_; bb_.bar = (unsigned*)(ws + WS_BAR); bb_.x = bx_; bb_.st = bst; xb::xcd_barrier(bb_, tid == 0); } while (0)
    typedef const __attribute__((address_space(4))) Params* KParams;
    KParams pp = (KParams)__builtin_amdgcn_kernarg_segment_ptr();
#define FRESH() int tid_ = wave_s * 64 + lane_id_fresh(); asm volatile("" : "+v"(tid_)); asm volatile("" : "+s"(pp)); const __attribute__((address_space(4))) Params& p = *pp; \
    const int tid = tid_, lane = tid & 63, wave = __builtin_amdgcn_readfirstlane(tid >> 6); \
    const int G = gridDim.x, gw = blockIdx.x * 8 + wave, NGW = G * 8, gtid = blockIdx.x * 512 + tid, NGT = G * 512; \
    unsigned char* ws = p.ws; float* x = p.out; u16* hn = (u16*)(ws + WS_HN); u16* ybuf = (u16*)(ws + WS_Y); unsigned char* U = ws + WS_U; \
    float* ctab = (float*)(ws + WS_COS); float* stab = (float*)(ws + WS_SIN); float* SA = (float*)(ws + WS_SA); float* SB = (float*)(ws + WS_SB); \
    (void)lane; (void)wave; (void)gw; (void)NGW; (void)gtid; (void)NGT; (void)x; (void)hn; (void)ybuf; (void)U; (void)ctab; (void)stab; (void)SA; (void)SB;
    {
    FRESH();

    for (int prep = 0; prep < PROBE_PRO_REPS; ++prep) {
    prologue_weights(p, (float*)lds + wave * (64 * 33), gw, NGW, lane);
    for (int i = gtid; i < 2 * 2048 * 16; i += NGT) { const int j = i >> 15, row = (i >> 4) & 2047, chn = i & 15, n = row >> 8;
        *(uint4*)((u16*)(ws + WT_LRU(j) + OFF_GT) + (size_t)row * 256 + 128 * ((n & 1) ^ 1) + chn * 8) = make_uint4(0u, 0u, 0u, 0u); }
    { const int* pos = (const int*)p.in[I_POS];
      for (int i = gtid; i < M * 32; i += NGT) { const int row = i >> 5, f = i & 31;
        const float inv = __builtin_amdgcn_exp2f(-(float)f * (13.287712379549449f / 32.f));
        const float ang = (float)pos[row] * inv;
        double rev = (double)ang * 0.15915494309189535; rev -= __builtin_rint(rev);
        ctab[i] = __builtin_amdgcn_cosf((float)rev); stab[i] = __builtin_amdgcn_sinf((float)rev); } }
    rowop(nullptr, p.in[I_X], nullptr, hn, (float*)(ws + WS_XSB), nullptr, p.in[I_MIXPRE], gw, NGW, lane);
    }
    if (ws == nullptr) grid.sync();
    GRID_BAR();
    }

#pragma nounroll
    for (int layer = 0; layer < 4; ++layer) {
#pragma nounroll
        for (int op = 0; op < 10; ++op) {
            FRESH();
            const int j = layer >> 1; const bool lru = (layer & 1) != 0;
            const u16* wtm = (const u16*)(ws + WT_MLA(j)); const u16* wtl = (const u16*)(ws + WT_LRU(j)); const u16* wtf = (const u16*)(ws + WT_FFN(layer));
            int gk = 0;
            pg8::Gemm g{}; pg8::EpiB E{};
            if (op == 6 || op == 9) continue;
            const float* gprev = p.in[op == 5 ? I_MIXPRE : I_FFNPRE] + layer * D;
            const float* gpost = p.in[op == 5 ? I_MIXPOST : I_FFNPOST] + layer * D;
            const float* gpre = op == 5 ? p.in[I_FFNPRE] + layer * D : (layer < 3 ? p.in[I_MIXPRE] + (layer + 1) * D : nullptr);
            if (op == 7) { gk = 1; g = pg8::Gemm{hn, wtf, M, 4096, 1024, 1024, 1024, 0}; E = pg8::EpiB{(u16*)U, 4096, 0, 0, 1, nullptr}; }
            else if (op == 8) { gk = 3; g = pg8::Gemm{(const u16*)U, wtf + OFF_DOWN / 2, M, 1024, 4096, 4096, 4096, 0}; }
            else if (!lru) {
                u16* proj = (u16*)(U + U_PROJ); u16* cq = (u16*)(U + U_CQ); u16* ckv = (u16*)(U + U_CKV); u16* kr = (u16*)(U + U_KR); u16* q = (u16*)(U + U_Q); u16* o = (u16*)(U + U_O); u16* kv = ybuf;
                if (op == 0) { gk = 1; g = pg8::Gemm{hn, wtm, M, 768, 1024, 1024, 1024, 0}; E = pg8::EpiB{proj, 768, 0, 0, 0, nullptr}; }
                else if (op == 1) for (int rep = 0; rep < PROBE_THIN_REPS; ++rep) qkvnorm(proj, cq, ckv, kr, p.in[I_MLA_QN] + j * 384, p.in[I_MLA_KVN] + j * 256, ctab, stab, (const float*)(ws + WS_XSB), gw, NGW, lane);
                else if (op == 2) { gk = 1; g = pg8::Gemm{cq, wtm + OFF_UQ / 2, M, 1536, 384, 384, 384, 0}; E = pg8::EpiB{q, 1536, 0, 0, 0, nullptr}; }
                else if (op == 3) { gk = 1; g = pg8::Gemm{ckv, wtm + OFF_UKV / 2, M, 2048, 256, 256, 256, 0}; E = pg8::EpiB{kv, 2048, 0, 0, 0, nullptr}; }
                else if (op == 4) { const att::Tensors T{q, kv, kr, o, ctab, stab}; for (int rep = 0; rep < PROBE_ATT_REPS; ++rep) att::attn_phase((char*)lds, T, tid); }
                else { gk = 3; g = pg8::Gemm{o, wtm + OFF_WO / 2, M, 1024, 1024, 1024, 1024, 0}; }
            } else {
                u16* gate = (u16*)(U + U_GATE); u16* xc = (u16*)(U + U_XC); u16* rec = (u16*)(U + U_REC); u16* Bb = (u16*)(U + U_B); u16* Ab = (u16*)(U + U_LA); u16* hg = xc;
                if (op == 0) { gk = 1; g = pg8::Gemm{hn, wtl, M, 2048, 1024, 1024, 1024, 0}; E = pg8::EpiB{gate, 1024, 1024, (size_t)(U_REC - U_GATE) / 2, 2, (const float*)(ws + WS_XSB)}; }
                else if (op == 1) for (int rep = 0; rep < PROBE_THIN_REPS; ++rep) conv_phase(rec, xc, p.in[I_LRU_CW] + j * 4 * D, p.in[I_LRU_CB] + j * D, gtid, NGT);
                else if (op == 2) { gk = 2; g = pg8::Gemm{xc, wtl + OFF_GT / 2, M, 2048, 256, 1024, 256, 512}; }
                else if (op == 3) for (int rep = 0; rep < PROBE_THIN_REPS; ++rep) scanA(Ab, Bb, SA, SB, tid);
                else if (op == 4) for (int rep = 0; rep < PROBE_THIN_REPS; ++rep) scanC(Ab, Bb, SA, SB, gate, hg, tid);
                else { gk = 3; g = pg8::Gemm{hg, wtl + OFF_LOUT / 2, M, 1024, 1024, 1024, 1024, 0}; }
            }
            if (STAGGER_TICKS > 0 && op == 7) {
                unsigned bx_ = bar_x; asm volatile("" : "+s"(bx_));
                const unsigned long long t0_ = __builtin_amdgcn_s_memrealtime(), want_ = (unsigned long long)(bx_ & 7u) * STAGGER_TICKS;
                while (__builtin_amdgcn_s_memrealtime() - t0_ < want_) __builtin_amdgcn_s_sleep(8); }
            for (int rep = 0; rep < ((gk != 3 && (PROBE_GEMM_OP == -1 || op == PROBE_GEMM_OP || (PROBE_GEMM_OP == -2 && op != 7))) ? PROBE_GEMM_REPS : 1); ++rep)
            if (gk == 1) { pg8::StaticOrder S; S.init(g.M, g.N, G, (int)blockIdx.x);
                pg8::gemm_phase<pg8::EpiB, pg8::StaticOrder, true>((PG8_LAS unsigned char*)lds, g, S, E, tid); }
            else if (gk == 2) { pg8::StaticOrder S; S.init(g.M, g.N, G, (int)blockIdx.x);
                const pg8::EpiGate EG{(const u16*)(U + U_XC), (u16*)(U + U_LA), (u16*)(U + U_B), p.in[I_LRU_BA] + j * D, p.in[I_LRU_BX] + j * D, p.in[I_LRU_LAM] + j * D};
                pg8::gemm_phase<pg8::EpiGate, pg8::StaticOrder, true>((PG8_LAS unsigned char*)lds, g, S, EG, tid); }
            else if (gk == 3) { pg8::StaticOrder S; S.init(g.M, g.N, G, (int)blockIdx.x);
                const unsigned target = 32u * (unsigned)(layer * 2 + (op == 8 ? 2 : 1));
                const pg8::RowStats st1{(float*)(ws + WS_XS1), (unsigned*)(ws + WS_CNT1), target};
                const pg8::EpiNormRes EN{hn, (float*)(ws + (op == 8 ? WS_XSB : WS_XSA)), x, gprev, gpost, gpre, st1, (PG8_LAS unsigned char*)lds + XL_OFF, op == 8 ? (const float*)(ws + WS_XSA) : nullptr};
                pg8::gemm_phase<pg8::EpiNormRes, pg8::StaticOrder, true>((PG8_LAS unsigned char*)lds, g, S, EN, tid); }
            if (!(layer == 3 && op == 8) && !(!lru && op == 2)) { for (int rep = 0; rep < PROBE_SYNC_REPS; ++rep) GRID_BAR(); }
        }
    }
}
}

extern "C" void kernel_launch(void* const* d_in, const int* in_sizes, int n_in, void* d_out, int out_size, void* d_ws, size_t ws_size, hipStream_t stream) {
    static int grid = 0;
    if (grid == 0) {
        if (n_in != 23 || in_sizes[0] != mk::M * mk::D || out_size != mk::M * mk::D || ws_size < mk::WS_END) {
            fprintf(stderr, "kernel_launch: unexpected shapes (n_in %d, in0 %d, out %d, ws %zu); nothing launched\n", n_in, n_in > 0 ? in_sizes[0] : -1, out_size, ws_size); grid = -1; return; }
        int dev = 0, cus = 0, per_cu = 0;
        (void)hipGetDevice(&dev); (void)hipDeviceGetAttribute(&cus, hipDeviceAttributeMultiprocessorCount, dev);
        if (hipFuncSetAttribute((const void*)mk::fwd_mega, hipFuncAttributeMaxDynamicSharedMemorySize, mk::LDS_BYTES) != hipSuccess) { fprintf(stderr, "kernel_launch: hipFuncSetAttribute failed\n"); grid = -1; return; }
        if (hipOccupancyMaxActiveBlocksPerMultiprocessor(&per_cu, (const void*)mk::fwd_mega, 512, mk::LDS_BYTES) != hipSuccess || per_cu < 1) { fprintf(stderr, "kernel_launch: occupancy query says %d blocks per CU\n", per_cu); per_cu = 1; }
        (void)hipGetLastError();
        grid = cus > 0 ? cus : 256;
    }
    if (grid < 0) return;
    mk::Params p{};
    for (int i = 0; i < 23; ++i) p.in[i] = (const float*)d_in[i];
    p.out = (float*)d_out; p.ws = (unsigned char*)d_ws;
    if (hipMemsetAsync((char*)d_ws + mk::WS_BAR, 0, mk::CTL_BYTES, stream) != hipSuccess) { fprintf(stderr, "kernel_launch: hipMemsetAsync failed\n"); return; }
    void* args[] = {&p};
    hipError_t e = hipLaunchCooperativeKernel((const void*)mk::fwd_mega, dim3(grid), dim3(512), args, mk::LDS_BYTES, stream);
    if (e != hipSuccess) fprintf(stderr, "kernel_launch: cooperative launch failed: %s (grid %d)\n", hipGetErrorString(e), grid);
}
```
